# Optimizing an MI355X kernel written in HIP

```python
import math
import jax, jax.numpy as jnp
from jax import lax
import numpy as np

D_MODEL = 1024
BATCH = 8
SEQ = 2048
DEPTH = 2

GRID_W = 64
CTX_LEN = 256
EPS = 1e-6
HA = 4
DKA = 128
DVA = 128
CONV_K = 3
CHUNK_A = 64
HB = 4
DKB = 64
DVB = 128
GATE_RANK = 16
GATE_NORM = 16.0
CHUNK_B = 16
HC = 4
DKC = 64
DVC = 128
Q_BLOCK = 128
ROPE_THETA = 10000.0
D_FF = 2816
N_EXPERTS = 8
TOP_K = 2
N_DENSE = (DEPTH + 1) // 2
N_MOE = DEPTH // 2
CONV_CH = 2 * HA * DKA + HA * DVA
IN_SIZES = (HA * DKA, HA * DKA, HA * DVA, HA * DVA, 2 * HA, 2 * HA,
            HB * DKB, HB * DKB, HB * DVB, HB * DVB, 2 * GATE_RANK,
            2 * HC * DKC, 2 * HC * DKC, HC * DVC,
            3 * D_MODEL)
IN_COLS = sum(IN_SIZES)

kernel_name = 'hybrid_deltanet_gla_diffattn_moe_dit'


def _rmsnorm(x, g):
    x32 = x.astype(jnp.float32)
    y = x32 * lax.rsqrt(jnp.mean(jnp.square(x32), axis=-1, keepdims=True) + EPS)
    return y * g.astype(jnp.float32)


def _modulate(x, g, shift, scale):
    return (_rmsnorm(x, g) * (1.0 + scale) + shift).astype(x.dtype)


def _l2norm(t):
    return t * lax.rsqrt(jnp.sum(jnp.square(t), axis=-1, keepdims=True) + EPS)


def _split(t, sizes):
    offsets, acc = [], 0
    for s in sizes[:-1]:
        acc += s
        offsets.append(acc)
    return jnp.split(t, offsets, axis=-1)


def _heads(t, n_heads):
    return t.reshape(t.shape[0], t.shape[1], n_heads, -1).transpose(0, 2, 1, 3)


def _short_conv(x, w):
    return lax.conv_general_dilated(x, w.astype(x.dtype)[:, None, :], window_strides=(1,),
                                    padding=[(CONV_K // 2, CONV_K // 2)],
                                    dimension_numbers=('NWC', 'WIO', 'NWC'),
                                    feature_group_count=x.shape[-1])


def _delta_chunks(q, k, v, g, beta, s0, with_out):
    bsz, nh, n, _ = q.shape
    nc = n // CHUNK_A
    q, k, v = (t.reshape(bsz, nh, nc, CHUNK_A, -1) for t in (q, k, v))
    gc = jnp.cumsum(g.reshape(bsz, nh, nc, CHUNK_A), axis=-1)
    beta = beta.reshape(bsz, nh, nc, CHUNK_A)[..., None]
    incl = jnp.tril(jnp.ones((CHUNK_A, CHUNK_A), bool))
    decay = jnp.exp(jnp.where(incl, gc[..., :, None] - gc[..., None, :], -jnp.inf))
    kb = k * beta
    eye = jnp.eye(CHUNK_A, dtype=jnp.float32)
    lmat = jnp.tril(jnp.einsum('bhnid,bhnjd->bhnij', kb, k) * decay, -1)
    tinv = lax.linalg.triangular_solve(eye + lmat, jnp.broadcast_to(eye, lmat.shape),
                                       left_side=True, lower=True, unit_diagonal=True)
    u = tinv @ (v * beta)
    w = tinv @ (kb * jnp.exp(gc)[..., None])
    kg = k * jnp.exp(gc[..., -1:] - gc)[..., None]
    glast = jnp.exp(gc[..., -1])[..., None, None]
    xs = (u, w, kg, glast)
    if with_out:
        qk = jnp.einsum('bhnid,bhnjd->bhnij', q, k) * decay
        xs = xs + (q * jnp.exp(gc)[..., None], qk)

    def step(s, xs_n):
        u_n, w_n, kg_n, gl_n, *rest = xs_n
        v_new = u_n - w_n @ s
        o = rest[0] @ s + rest[1] @ v_new if with_out else None
        return s * gl_n + jnp.swapaxes(kg_n, -1, -2) @ v_new, o

    s, o = lax.scan(step, s0, tuple(jnp.moveaxis(t, 2, 0) for t in xs))
    if with_out:
        o = jnp.moveaxis(o, 0, 2).reshape(bsz, nh, n, -1)
    return o, s


def _gla_chunks(q, k, v, glog, s0, with_out):
    bsz, nh, n, _ = q.shape
    nc = n // CHUNK_B
    q, k, v, glog = (t.reshape(bsz, nh, nc, CHUNK_B, -1) for t in (q, k, v, glog))
    gc = jnp.cumsum(glog, axis=3)
    kg = k * jnp.exp(gc[..., -1:, :] - gc)
    glast = jnp.exp(gc[..., -1, :])[..., None]
    xs = (kg, v, glast)
    if with_out:
        incl = jnp.tril(jnp.ones((CHUNK_B, CHUNK_B), bool))[..., None]
        rel = jnp.exp(jnp.where(incl, gc[..., :, None, :] - gc[..., None, :, :], -jnp.inf))
        o_intra = jnp.einsum('bhnid,bhnjd,bhnijd->bhnij', q, k, rel) @ v
        xs = xs + (q * jnp.exp(gc), o_intra)

    def step(s, xs_n):
        kg_n, v_n, gl_n, *rest = xs_n
        o = rest[0] @ s + rest[1] if with_out else None
        return s * gl_n + jnp.swapaxes(kg_n, -1, -2) @ v_n, o

    s, o = lax.scan(step, s0, tuple(jnp.moveaxis(t, 2, 0) for t in xs))
    if with_out:
        o = jnp.moveaxis(o, 0, 2).reshape(bsz, nh, n, -1)
    return o, s


def _bidir_scan(chunk_fn, ctx_dirs, lat_dirs, state_shape, ctx_out):
    o_ctx, o_lat = None, None
    for d in range(2):
        fl = (lambda t: jnp.flip(t, axis=2)) if d == 1 else (lambda t: t)
        oc, s_ctx = chunk_fn(*[fl(t) for t in ctx_dirs[d]], jnp.zeros(state_shape, jnp.float32), ctx_out)
        ol, _ = chunk_fn(*[fl(t) for t in lat_dirs[d]], s_ctx, True)
        o_lat = fl(ol) if o_lat is None else o_lat + fl(ol)
        if ctx_out:
            o_ctx = fl(oc) if o_ctx is None else o_ctx + fl(oc)
    return o_ctx, o_lat


def _deltanet_branch(pl, pc, conv_w, a_log, dt_bias, gn, ctx_out):
    def prep(p):
        q, k, v, z, b, a = p
        bsz, n = q.shape[:2]
        qkv = jax.nn.silu(_short_conv(jnp.concatenate([q, k, v], axis=-1), conv_w))
        q, k, v = jnp.split(qkv, [HA * DKA, 2 * HA * DKA], axis=-1)
        q = _l2norm(_heads(q, HA)) * DKA ** -0.5
        k = _l2norm(_heads(k, HA))
        v = _heads(v, HA)
        beta = jax.nn.sigmoid(b.reshape(bsz, n, 2, HA)).transpose(2, 0, 3, 1)
        g = (-jnp.exp(a_log) * jax.nn.softplus(a.reshape(bsz, n, 2, HA) + dt_bias)).transpose(2, 0, 3, 1)
        return [(q, k, v, g[d], beta[d]) for d in range(2)]

    o_c, o_l = _bidir_scan(_delta_chunks, prep(pc), prep(pl), (pl[0].shape[0], HA, DKA, DVA), ctx_out)

    def out(o, z):
        bsz, n = z.shape[:2]
        o = _rmsnorm(o.transpose(0, 2, 1, 3), gn) * jax.nn.silu(z.reshape(bsz, n, HA, DVA))
        return o.reshape(bsz, n, HA * DVA)

    return out(o_l, pl[3]), (out(o_c, pc[3]) if ctx_out else None)


def _gla_branch(pl, pc, w_gate2, b_gate, gn, ctx_out):
    def prep(p):
        q, k, v, r, glr = p
        bsz, n = q.shape[:2]
        q = _heads(q, HB) * DKB ** -0.5
        k = _heads(k, HB)
        v = _heads(v, HB)
        glr = glr.reshape(bsz, n, 2, GATE_RANK)
        return [(q, k, v, _heads(jax.nn.log_sigmoid(glr[:, :, d] @ w_gate2[d] + b_gate[d]) / GATE_NORM, HB))
                for d in range(2)]

    o_c, o_l = _bidir_scan(_gla_chunks, prep(pc), prep(pl), (pl[0].shape[0], HB, DKB, DVB), ctx_out)

    def out(o, r):
        bsz, n = r.shape[:2]
        o = _rmsnorm(o.transpose(0, 2, 1, 3), gn) * jax.nn.silu(r.reshape(bsz, n, HB, DVB))
        return o.reshape(bsz, n, HB * DVB)

    return out(o_l, pl[3]), (out(o_c, pc[3]) if ctx_out else None)


def _rope_tables(n_tokens):
    rows = n_tokens // GRID_W
    row = jnp.repeat(jnp.arange(rows, dtype=jnp.float32), GRID_W)
    col = jnp.tile(jnp.arange(GRID_W, dtype=jnp.float32), rows)
    n_freq = DKC // 4
    inv_freq = ROPE_THETA ** (-jnp.arange(n_freq, dtype=jnp.float32) / n_freq)
    ang_r = row[:, None] * inv_freq
    ang_c = col[:, None] * inv_freq
    return jnp.cos(ang_r), jnp.sin(ang_r), jnp.cos(ang_c), jnp.sin(ang_c)


def _rope_axis(x, cos, sin):
    x1, x2 = jnp.split(x, 2, axis=-1)
    return jnp.concatenate([x1 * cos - x2 * sin, x2 * cos + x1 * sin], axis=-1)


def _axial_rope(x, rope):
    cos_r, sin_r, cos_c, sin_c = rope
    xr, xc = jnp.split(x, 2, axis=-1)
    return jnp.concatenate([_rope_axis(xr, cos_r, sin_r), _rope_axis(xc, cos_c, sin_c)], axis=-1)


def _diff_branch(pl, pc, lam, gn, lam_init, ctx_out):
    def qk_heads(t):
        return t.reshape(t.shape[0], t.shape[1], HC, 2, DKC).transpose(0, 2, 3, 1, 4)

    ql, kl, vl = pl
    qc, kc, vc = pc
    bsz, n = ql.shape[:2]
    rope = _rope_tables(n)
    scale = DKC ** -0.5
    ql = _axial_rope(qk_heads(ql), rope) * scale
    kl = _axial_rope(qk_heads(kl), rope)
    qc = qk_heads(qc) * scale
    kc = qk_heads(kc)
    vl = _heads(vl, HC)
    vc = _heads(vc, HC)
    lam_f = (jnp.exp(jnp.sum(lam[0] * lam[1])) - jnp.exp(jnp.sum(lam[2] * lam[3])) + lam_init).astype(jnp.float32)

    def attend(qb, k, v):
        p = jax.nn.softmax(jnp.einsum('bhmqd,bhmkd->bhmqk', qb, k), axis=-1)
        return jnp.einsum('bhqk,bhkd->bhqd', p[:, :, 0] - lam_f * p[:, :, 1], v)

    k_all = jnp.concatenate([kc, kl], axis=3)
    v_all = jnp.concatenate([vc, vl], axis=2)
    n_blk = n // Q_BLOCK
    q_blocks = jnp.moveaxis(ql.reshape(bsz, HC, 2, n_blk, Q_BLOCK, DKC), 3, 0)
    o_l = lax.map(lambda qb: attend(qb, k_all, v_all), q_blocks)
    o_l = jnp.moveaxis(o_l, 0, 2).reshape(bsz, HC, n, DVC)

    def out(o):
        o = _rmsnorm(o, gn) * (1.0 - lam_init)
        return o.transpose(0, 2, 1, 3).reshape(o.shape[0], o.shape[2], HC * DVC)

    return out(o_l), (out(attend(qc, kc, vc)) if ctx_out else None)


def _mixer(hl, hc, w_in, conv_a, a_log, dt_bias, gn_a, w_gate2, b_gate, gn_b, lam_c, gn_c,
           w_o_a, w_o_b, w_o_c, w_out, lam_init, ctx_out):
    pl = _split((hl @ w_in).astype(jnp.float32), IN_SIZES)
    pc = _split((hc @ w_in).astype(jnp.float32), IN_SIZES)
    a_l, a_c = _deltanet_branch(pl[0:6], pc[0:6], conv_a, a_log, dt_bias, gn_a, ctx_out)
    b_l, b_c = _gla_branch(pl[6:11], pc[6:11], w_gate2, b_gate, gn_b, ctx_out)
    d_l, d_c = _diff_branch(pl[11:14], pc[11:14], lam_c, gn_c, lam_init, ctx_out)

    def merge(ya, yb, yd, gates):
        ga, gb, gd = jnp.split(jax.nn.sigmoid(gates), 3, axis=-1)
        return (ga * (ya @ w_o_a) + gb * (yb @ w_o_b) + gd * (yd @ w_o_c)) @ w_out

    return merge(a_l, b_l, d_l, pl[14]), (merge(a_c, b_c, d_c, pc[14]) if ctx_out else None)


def _swiglu(h, w1, w3, w2):
    return (jax.nn.silu(h @ w1) * (h @ w3)) @ w2


def _moe(h, router_w, w1, w3, w2):
    logits = (h @ router_w).astype(jnp.float32)
    top_val, top_idx = lax.top_k(logits, TOP_K)
    wts = jax.nn.softmax(top_val, axis=-1)
    gate = jnp.einsum('blk,blke->ble', wts, jax.nn.one_hot(top_idx, N_EXPERTS, dtype=jnp.float32))
    out = None
    for e in range(N_EXPERTS):
        contrib = gate[..., e:e + 1] * _swiglu(h, w1[e], w3[e], w2[e])
        out = contrib if out is None else out + contrib
    return out


def setup_inputs(seed: int = 0) -> dict:
    key = jax.random.key(seed)
    ks = iter(jax.random.split(key, 40))
    f32 = jnp.float32

    def nrm(shape, scale):
        return jax.random.normal(next(ks), shape, f32) * scale

    def gain(shape):
        return 1.0 + nrm(shape, 0.02)

    dt = jnp.exp(jax.random.uniform(next(ks), (DEPTH, 2, HA), f32, math.log(1e-3), math.log(1e-1)))
    return {
        'x': nrm((BATCH, SEQ, D_MODEL), 1.0),
        'c': nrm((BATCH, D_MODEL), 1.0),
        'ctx': nrm((BATCH, CTX_LEN, D_MODEL), 1.0),
        'c_ctx': nrm((D_MODEL,), 1.0),
        'w_mod': nrm((DEPTH, D_MODEL, 6 * D_MODEL), 0.5 * D_MODEL ** -0.5),
        'b_mod': nrm((DEPTH, 6 * D_MODEL), 0.01),
        'norm1_g': gain((DEPTH, D_MODEL)),
        'norm2_g': gain((DEPTH, D_MODEL)),
        'w_in': nrm((DEPTH, D_MODEL, IN_COLS), D_MODEL ** -0.5),
        'conv_a': nrm((DEPTH, CONV_K, CONV_CH), CONV_K ** -0.5),
        'a_log': jnp.log(jax.random.uniform(next(ks), (DEPTH, 2, HA), f32, 1.0, 16.0)),
        'dt_bias': dt + jnp.log(-jnp.expm1(-dt)),
        'gn_a': gain((DEPTH, DVA)),
        'w_gate2': nrm((DEPTH, 2, GATE_RANK, HB * DKB), GATE_RANK ** -0.5),
        'b_gate': nrm((DEPTH, 2, HB * DKB), 0.1),
        'gn_b': gain((DEPTH, DVB)),
        'lam_c': nrm((DEPTH, 4, DKC), 0.1),
        'gn_c': gain((DEPTH, DVC)),
        'w_o_a': nrm((DEPTH, HA * DVA, D_MODEL), (HA * DVA) ** -0.5),
        'w_o_b': nrm((DEPTH, HB * DVB, D_MODEL), (HB * DVB) ** -0.5),
        'w_o_c': nrm((DEPTH, HC * DVC, D_MODEL), (HC * DVC) ** -0.5),
        'w_out': nrm((DEPTH, D_MODEL, D_MODEL), D_MODEL ** -0.5),
        'ffn_w1': nrm((N_DENSE, D_MODEL, D_FF), D_MODEL ** -0.5),
        'ffn_w3': nrm((N_DENSE, D_MODEL, D_FF), D_MODEL ** -0.5),
        'ffn_w2': nrm((N_DENSE, D_FF, D_MODEL), D_FF ** -0.5),
        'router_w': nrm((N_MOE, D_MODEL, N_EXPERTS), D_MODEL ** -0.5),
        'moe_w1': nrm((N_MOE, N_EXPERTS, D_MODEL, D_FF), D_MODEL ** -0.5),
        'moe_w3': nrm((N_MOE, N_EXPERTS, D_MODEL, D_FF), D_MODEL ** -0.5),
        'moe_w2': nrm((N_MOE, N_EXPERTS, D_FF, D_MODEL), D_FF ** -0.5),
        'final_g': gain((D_MODEL,)),
    }


def reference(x, c, ctx, c_ctx, w_mod, b_mod, norm1_g, norm2_g, w_in, conv_a, a_log, dt_bias, gn_a,
              w_gate2, b_gate, gn_b, lam_c, gn_c, w_o_a, w_o_b, w_o_c, w_out, ffn_w1, ffn_w3, ffn_w2,
              router_w, moe_w1, moe_w3, moe_w2, final_g):
    xl, xc = x, ctx
    for l in range(DEPTH):
        ctx_out = l < DEPTH - 1
        lam_init = 0.8 - 0.6 * math.exp(-0.3 * l)
        mod_l = jnp.split((jax.nn.silu(c) @ w_mod[l] + b_mod[l])[:, None, :], 6, axis=-1)
        mod_c = jnp.split(jax.nn.silu(c_ctx) @ w_mod[l] + b_mod[l], 6, axis=-1)
        hl = _modulate(xl, norm1_g[l], mod_l[0], mod_l[1])
        hc = _modulate(xc, norm1_g[l], mod_c[0], mod_c[1])
        yl, yc = _mixer(hl, hc, w_in[l], conv_a[l], a_log[l], dt_bias[l], gn_a[l], w_gate2[l], b_gate[l],
                        gn_b[l], lam_c[l], gn_c[l], w_o_a[l], w_o_b[l], w_o_c[l], w_out[l], lam_init, ctx_out)
        xl = xl + (mod_l[2] * yl).astype(xl.dtype)
        if ctx_out:
            xc = xc + (mod_c[2] * yc).astype(xc.dtype)

        def ffn(h):
            i = l // 2
            if l % 2 == 0:
                return _swiglu(h, ffn_w1[i], ffn_w3[i], ffn_w2[i])
            return _moe(h, router_w[i], moe_w1[i], moe_w3[i], moe_w2[i])

        hl = _modulate(xl, norm2_g[l], mod_l[3], mod_l[4])
        xl = xl + (mod_l[5] * ffn(hl)).astype(xl.dtype)
        if ctx_out:
            hc = _modulate(xc, norm2_g[l], mod_c[3], mod_c[4])
            xc = xc + (mod_c[5] * ffn(hc)).astype(xc.dtype)
    return _rmsnorm(xl, final_g).astype(x.dtype)
```

```cpp
#include <hip/hip_runtime.h>
#include <hip/hip_cooperative_groups.h>
#include <cstdio>
#include <cstdint>
namespace cg = cooperative_groups;

namespace pg8 {
#define PG8_LAS __attribute__((address_space(3)))
typedef unsigned short bf16_t;
typedef short bf16x8 __attribute__((ext_vector_type(8)));
typedef float f32x4 __attribute__((ext_vector_type(4)));
typedef unsigned u32x4 __attribute__((ext_vector_type(4)));
constexpr int BM = 256, BK = 64, HALF = 128, HTB = HALF * BK * 2  , STAGE_BYTES = 8 * HTB, NXCD = 8, WGM = 8;

__host__ __device__ __forceinline__ int lds_byte(int r, int c) { const int st = (r >> 4) * 2 + (c >> 5), rr = r & 15, cc = c & 31, ob = rr * 64 + cc * 2; return st * 1024 + (ob ^ (((ob >> 9) & 1) << 5)); }
__host__ __device__ __forceinline__ void stage_rc(int b, int& R, int& C) { const int st = b / 1024, sb = b % 1024, swz = sb ^ (((sb >> 9) & 1) << 5); R = (st >> 1) * 16 + swz / 64; C = (st & 1) * 32 + (swz % 64) / 2; }
__host__ __device__ __forceinline__ int perm32(int rho) { const int n = rho >> 4, i = rho & 15; return 8 * (i >> 2) + 4 * n + (i & 3); }

struct Unit { int pm, pn; };
struct Gemm { const bf16_t* A; const bf16_t* Bt; int M, N, K, lda; };

struct StaticOrder {
    int nM, nN, nwg, G, c;
    __host__ __device__ void init(int M, int N, int G_, int c_) { nM = M / BM; nN = N / BM; nwg = nM * nN; G = G_; c = c_; }
    __host__ __device__ bool next(int i, Unit& u) const {
        const long L = (long)i * G + c; if (L >= nwg) return false;
        int wgid = (int)L; { const int q = nwg / NXCD, r = nwg % NXCD, xcd = wgid % NXCD, off = wgid / NXCD; wgid = (xcd < r ? xcd * (q + 1) : r * (q + 1) + (xcd - r) * q) + off; }
        const int nig = WGM * nN, gid = wgid / nig, fm = gid * WGM, gsz = (nM - fm) < WGM ? (nM - fm) : WGM;
        u.pm = fm + ((wgid % nig) % gsz); u.pn = (wgid % nig) / gsz; return true;
    }
    __device__ __forceinline__ void a_ready(const Unit&) const {}
    __device__ __forceinline__ void done(const Unit&) const {}
};


template <class Epi, class Sched, bool ALIGN_EPI = false, bool SP2 = false>
__device__ __forceinline__ void gemm_phase(PG8_LAS unsigned char* lds, const Gemm g, const Sched& S, const Epi& E) {
    int tid_o = threadIdx.x; asm volatile("" : "+v"(tid_o));
    const int tid = tid_o, wid = __builtin_amdgcn_readfirstlane(tid >> 6), lane = tid & 63, wr = wid >> 2, wc = wid & 3, fr = lane & 15, fq = lane >> 4;
    const int K = g.K, nt = K / BK;
    unsigned voffA[2], voffB[2];
#pragma unroll
    for (int i = 0; i < 2; ++i) { int R, C; stage_rc(tid * 16 + i * 8192, R, C); const int Rb = Epi::PERM ? ((R & ~31) + perm32(R & 31)) : R;
        voffA[i] = (unsigned)(R * g.lda + C) * 2u; voffB[i] = (unsigned)(Rb * K + C) * 2u; }
    const size_t kstep = (size_t)(BK * 2);
    const size_t hstepA = (size_t)HALF * g.lda * 2, hstepB = (size_t)HALF * K * 2;
    const size_t tstepA = 2 * hstepA, tstepB = 2 * hstepB;
    const unsigned ldsw = (unsigned)wid * 1024u;
    const int aoff = lds_byte(wr * 64 + fr, fq * 8), boff = lds_byte(wc * 32 + fr, fq * 8);
#define PG8_SA(b, h) (((b) * 2 + (h)) * HTB)
#define PG8_SB(b, h) ((4 + (b) * 2 + (h)) * HTB)
#define PG8_STAGE(bufoff, gbase, voff) do { _Pragma("unroll") for (int _i = 0; _i < 2; ++_i) \
        __builtin_amdgcn_global_load_lds((const unsigned*)((const char*)(gbase) + (voff)[_i]), (PG8_LAS unsigned*)(lds + (bufoff) + ldsw + _i * 8192), 16, 0, 0); } while (0)
#define PG8_LDA(dst, b, h) do { _Pragma("unroll") for (int m = 0; m < 4; ++m) _Pragma("unroll") for (int k = 0; k < 2; ++k) dst[m][k] = *(const PG8_LAS bf16x8*)(lds + PG8_SA(b, h) + aoff + m * 2048 + k * 1024); } while (0)
#define PG8_LDB(dst, b, h) do { _Pragma("unroll") for (int n = 0; n < 2; ++n) _Pragma("unroll") for (int k = 0; k < 2; ++k) dst[n][k] = *(const PG8_LAS bf16x8*)(lds + PG8_SB(b, h) + boff + n * 2048 + k * 1024); } while (0)
#define PG8_MMA(ai, bj, At, Bt) do { __builtin_amdgcn_s_setprio(1); _Pragma("unroll") for (int m = 0; m < 4; ++m) _Pragma("unroll") for (int n = 0; n < 2; ++n) _Pragma("unroll") for (int k = 0; k < 2; ++k) \
        acc[ai][bj][m][n] = __builtin_amdgcn_mfma_f32_16x16x32_bf16(Bt[n][k], At[m][k], acc[ai][bj][m][n], 0, 0, 0); __builtin_amdgcn_s_setprio(0); } while (0)
#define PG8_WAIT_V(n) asm volatile("s_waitcnt vmcnt(" #n ")" ::: "memory")
#define PG8_WAIT_L(n) asm volatile("s_waitcnt lgkmcnt(" #n ")" ::: "memory")
#define PG8_BAR __builtin_amdgcn_s_barrier()
#define PG8_SCHED __builtin_amdgcn_sched_barrier(0)
    Unit cur, nxt; int ui = 0;
    if (!S.next(0, cur)) return;
    f32x4 acc[2][2][4][2];
#pragma unroll
    for (int a = 0; a < 2; ++a)
#pragma unroll
        for (int b = 0; b < 2; ++b)
#pragma unroll
            for (int m = 0; m < 4; ++m)
#pragma unroll
                for (int n = 0; n < 2; ++n) acc[a][b][m][n] = (f32x4){0.f, 0.f, 0.f, 0.f};
    bf16x8 At[4][2], B0[2][2], B1[2][2];
    const char* cA = (const char*)g.A + (size_t)cur.pm * tstepA; const char* cB = (const char*)g.Bt + (size_t)cur.pn * tstepB;
    S.a_ready(cur);
    if constexpr (SP2) {
        PG8_STAGE(PG8_SB(0, 0), cB, voffB); PG8_STAGE(PG8_SB(0, 1), cB + hstepB, voffB); PG8_STAGE(PG8_SA(0, 0), cA, voffA); PG8_STAGE(PG8_SA(0, 1), cA + hstepA, voffA);
        if (wr == 1) PG8_BAR;
        PG8_WAIT_V(2); PG8_BAR;
        PG8_STAGE(PG8_SB(1, 0), cB + kstep, voffB); PG8_STAGE(PG8_SA(1, 0), cA + kstep, voffA); PG8_STAGE(PG8_SB(1, 1), cB + hstepB + kstep, voffB);
        PG8_WAIT_V(6); PG8_BAR;
    } else {
        PG8_STAGE(PG8_SB(0, 0), cB, voffB); PG8_STAGE(PG8_SA(0, 0), cA, voffA); PG8_STAGE(PG8_SB(0, 1), cB + hstepB, voffB); PG8_STAGE(PG8_SA(0, 1), cA + hstepA, voffA);
        if (wr == 1) PG8_BAR;
        PG8_WAIT_V(4); PG8_BAR;
        PG8_STAGE(PG8_SB(1, 0), cB + kstep, voffB); PG8_STAGE(PG8_SA(1, 0), cA + kstep, voffA); PG8_STAGE(PG8_SB(1, 1), cB + hstepB + kstep, voffB);
        PG8_WAIT_V(6); PG8_BAR;
    }
    for (;;) {
        const bool has_next = S.next(ui + 1, nxt);
        const char* nA = has_next ? (const char*)g.A + (size_t)nxt.pm * tstepA : cA; const char* nB = has_next ? (const char*)g.Bt + (size_t)nxt.pn * tstepB : cB;
        for (int t = 0; t < nt; t += 2) {
            const bool last = (t == nt - 2);
            const char* a1 = cA + (size_t)(t + 1) * kstep;
            const char* a2 = last ? nA : cA + (size_t)(t + 2) * kstep; const char* b2 = last ? nB : cB + (size_t)(t + 2) * kstep;
            const char* a3 = a2 + kstep; const char* b3 = b2 + kstep;
            if (last && has_next) S.a_ready(nxt);
            if constexpr (SP2) {
            PG8_LDB(B0, 0, 0); PG8_LDB(B1, 0, 1); PG8_SCHED; PG8_LDA(At, 0, 0); PG8_STAGE(PG8_SA(1, 1), a1 + hstepA, voffA);
            PG8_WAIT_V(8); PG8_WAIT_L(0); PG8_BAR; PG8_MMA(0, 0, At, B0); PG8_MMA(0, 1, At, B1); PG8_BAR; PG8_SCHED;
            PG8_LDA(At, 0, 1); PG8_STAGE(PG8_SB(0, 0), b2, voffB); PG8_STAGE(PG8_SB(0, 1), b2 + hstepB, voffB); PG8_STAGE(PG8_SA(0, 0), a2, voffA);
            PG8_WAIT_V(8); PG8_WAIT_L(0); PG8_BAR; PG8_MMA(1, 0, At, B0); PG8_MMA(1, 1, At, B1); PG8_BAR; PG8_SCHED;
            PG8_LDB(B0, 1, 0); PG8_LDB(B1, 1, 1); PG8_SCHED; PG8_LDA(At, 1, 0); PG8_STAGE(PG8_SA(0, 1), a2 + hstepA, voffA);
            PG8_WAIT_V(8); PG8_WAIT_L(0); PG8_BAR; PG8_MMA(0, 0, At, B0); PG8_MMA(0, 1, At, B1); PG8_BAR; PG8_SCHED;
            PG8_LDA(At, 1, 1); PG8_STAGE(PG8_SB(1, 0), b3, voffB); PG8_STAGE(PG8_SB(1, 1), b3 + hstepB, voffB); PG8_STAGE(PG8_SA(1, 0), a3, voffA);
            PG8_WAIT_V(8); PG8_WAIT_L(0); PG8_BAR; PG8_MMA(1, 0, At, B0); PG8_MMA(1, 1, At, B1); PG8_BAR; PG8_SCHED;
            } else {
            PG8_LDB(B0, 0, 0); PG8_SCHED; PG8_LDA(At, 0, 0); PG8_STAGE(PG8_SA(1, 1), a1 + hstepA, voffA);
            PG8_WAIT_L(8); PG8_BAR; PG8_WAIT_L(0); PG8_MMA(0, 0, At, B0); PG8_BAR; PG8_SCHED;
            PG8_LDB(B1, 0, 1); PG8_STAGE(PG8_SB(0, 0), b2, voffB);
            PG8_BAR; PG8_WAIT_L(0); PG8_MMA(0, 1, At, B1); PG8_BAR;
            PG8_LDA(At, 0, 1); PG8_STAGE(PG8_SA(0, 0), a2, voffA);
            PG8_BAR; PG8_WAIT_L(0); PG8_MMA(1, 0, At, B0); PG8_BAR; PG8_SCHED;
            PG8_STAGE(PG8_SB(0, 1), b2 + hstepB, voffB);
            PG8_WAIT_V(6); PG8_BAR; PG8_MMA(1, 1, At, B1); PG8_BAR;
            PG8_LDB(B0, 1, 0); PG8_SCHED; PG8_LDA(At, 1, 0); PG8_STAGE(PG8_SA(0, 1), a2 + hstepA, voffA);
            PG8_WAIT_L(8); PG8_BAR; PG8_WAIT_L(0); PG8_MMA(0, 0, At, B0); PG8_BAR; PG8_SCHED;
            PG8_LDB(B1, 1, 1); PG8_STAGE(PG8_SB(1, 0), b3, voffB);
            PG8_BAR; PG8_WAIT_L(0); PG8_MMA(0, 1, At, B1); PG8_BAR;
            PG8_LDA(At, 1, 1); PG8_STAGE(PG8_SA(1, 0), a3, voffA);
            PG8_BAR; PG8_WAIT_L(0); PG8_MMA(1, 0, At, B0); PG8_BAR; PG8_SCHED;
            PG8_STAGE(PG8_SB(1, 1), b3 + hstepB, voffB);
            PG8_WAIT_V(6); PG8_BAR; PG8_MMA(1, 1, At, B1); PG8_BAR;
            }
        }
        if constexpr (ALIGN_EPI) { if (wr == 0) PG8_BAR; }
        if constexpr (!Epi::AFTER_DRAIN) { E(acc, cur, wr, wc, fr, fq); S.done(cur); }
        if (!has_next) break;
#pragma unroll
        for (int a = 0; a < 2; ++a)
#pragma unroll
            for (int b = 0; b < 2; ++b)
#pragma unroll
                for (int m = 0; m < 4; ++m)
#pragma unroll
                    for (int n = 0; n < 2; ++n) acc[a][b][m][n] = (f32x4){0.f, 0.f, 0.f, 0.f};
        cur = nxt; cA = nA; cB = nB; ++ui;
        if constexpr (ALIGN_EPI) { if (wr == 1) PG8_BAR; }
    }
    PG8_WAIT_V(0);
    if constexpr (!ALIGN_EPI) { if (wr == 0) PG8_BAR; }
    PG8_BAR;
    if constexpr (Epi::AFTER_DRAIN) { E.fused(acc, cur, wr, wc, fr, fq, lds, wid, lane); S.done(cur); }
#undef PG8_SA
#undef PG8_SB
#undef PG8_STAGE
#undef PG8_LDA
#undef PG8_LDB
#undef PG8_MMA
#undef PG8_WAIT_V
#undef PG8_WAIT_L
#undef PG8_BAR
#undef PG8_SCHED
}
}


constexpr int BATCH = 8, SEQ = 2048, CTXL = 256, D = 1024, DEPTH = 2;
constexpr int TL = BATCH * SEQ, TC = BATCH * CTXL, T = TL + TC;
constexpr int NIN = 8448;
constexpr int DFF = 2816, NE = 8, NUP = 2 * DFF;
constexpr int MOE_ROWS = 2 * TL + NE * 256;
constexpr float EPS = 1e-6f;
constexpr int NTHREADS = 512, NWAVES = 8;
constexpr int LDS_BYTES = 147456;

typedef unsigned short bf16_t;
typedef float f32x4 __attribute__((ext_vector_type(4)));
typedef float f32x16 __attribute__((ext_vector_type(16)));
typedef unsigned u32x4 __attribute__((ext_vector_type(4)));
typedef unsigned u32x2 __attribute__((ext_vector_type(2)));
typedef short bf16x8 __attribute__((ext_vector_type(8)));
typedef short s16x4 __attribute__((ext_vector_type(4)));

constexpr size_t al256(size_t x) { return (x + 255) & ~(size_t)255; }
constexpr size_t WS_CTL   = 0;                                   constexpr size_t CTL_BYTES = 65536;
constexpr size_t WS_MOD   = WS_CTL + CTL_BYTES;                  constexpr size_t MOD_BYTES = (size_t)DEPTH * 9 * 6 * D * 4;
constexpr size_t WS_ROUTE = al256(WS_MOD + MOD_BYTES);           constexpr size_t ROUTE_BYTES = (size_t)TL * 16;
constexpr size_t WS_SLOT  = al256(WS_ROUTE + ROUTE_BYTES);       constexpr size_t SLOT_BYTES = (size_t)TL * 8;
constexpr size_t WS_MISC  = al256(WS_SLOT + SLOT_BYTES);         constexpr size_t MISC_BYTES = 4096;
constexpr size_t WS_GB    = al256(WS_MISC + MISC_BYTES);         constexpr size_t GB_BYTES = (size_t)T * 16 * 4;
constexpr size_t WS_SMALL = al256(WS_GB + GB_BYTES);             constexpr size_t SMALL_BYTES = (size_t)T * 64 * 4;
constexpr size_t WS_XC    = al256(WS_SMALL + SMALL_BYTES);       constexpr size_t XC_BYTES = (size_t)TC * D * 4;
constexpr size_t WS_WB    = al256(WS_XC + XC_BYTES);
constexpr size_t WB_WIN   = WS_WB;                               constexpr size_t WIN_BYTES = (size_t)NIN * D * 2;
constexpr size_t WB_WO    = WB_WIN + DEPTH * WIN_BYTES;          constexpr size_t WO_BYTES = (size_t)D * 512 * 2;
constexpr size_t WB_WOUT  = WB_WO + DEPTH * 3 * WO_BYTES;        constexpr size_t WOUT_BYTES = (size_t)D * D * 2;
constexpr size_t WB_WUP   = WB_WOUT + DEPTH * WOUT_BYTES;        constexpr size_t WUP_BYTES = (size_t)NUP * D * 2;
constexpr size_t WB_WDN   = WB_WUP + WUP_BYTES;                  constexpr size_t WDN_BYTES = (size_t)D * DFF * 2;
constexpr size_t WB_END   = WB_WDN + WDN_BYTES;
constexpr size_t WS_H     = al256(WB_END);                       constexpr size_t H_BYTES = (size_t)T * D * 2;
constexpr size_t WS_PAQ   = al256(WS_H + H_BYTES);               constexpr size_t PAQ_BYTES = (size_t)T * 1536 * 2;
constexpr size_t WS_PZ    = al256(WS_PAQ + PAQ_BYTES);           constexpr size_t PZ_BYTES = (size_t)T * 512 * 2;
constexpr size_t WS_PB    = al256(WS_PZ + PZ_BYTES);             constexpr size_t PB_BYTES = (size_t)T * 1536 * 2;
constexpr size_t WS_PC    = al256(WS_PB + PB_BYTES);             constexpr size_t PC_BYTES = (size_t)T * 1536 * 2;
constexpr size_t WS_PG    = al256(WS_PC + PC_BYTES);             constexpr size_t PG_BYTES = (size_t)T * 3072 * 2;
constexpr size_t WS_DNQKV = al256(WS_PG + PG_BYTES);             constexpr size_t DNQKV_BYTES = (size_t)T * 1536 * 2;
constexpr size_t WS_GLOG  = al256(WS_DNQKV + DNQKV_BYTES);       constexpr size_t GLOG_BYTES = (size_t)2 * T * 256 * 4;
constexpr size_t WS_END   = al256(WS_GLOG + GLOG_BYTES);
static_assert(WS_END <= (size_t)524288000, "d_ws map exceeds 500 MiB (documented minimum is 525,980,800 B)");
constexpr size_t WS_H1    = WS_PB;
static_assert((size_t)T * DFF * 2 <= PB_BYTES + PC_BYTES, "h1 overlay");
constexpr size_t WS_MWDN  = WS_WB;                                constexpr size_t MWDN_BYTES = (size_t)NE * D * DFF * 2;
static_assert(MWDN_BYTES <= WB_END - WS_WB, "moe wdn overlay");
constexpr size_t WS_MWUP  = WS_PAQ;                               constexpr size_t MWUP_BYTES = (size_t)NE * NUP * D * 2;
constexpr size_t WS_MA    = al256(WS_MWUP + MWUP_BYTES);          constexpr size_t MA_BYTES = (size_t)MOE_ROWS * D * 2;
constexpr size_t WS_MH1   = al256(WS_MA + MA_BYTES);              constexpr size_t MH1_BYTES = (size_t)MOE_ROWS * DFF * 2;
static_assert(WS_MH1 + MH1_BYTES <= WS_END, "moe overlay");
constexpr int CW_QUEUE = 0;
constexpr int CW_KMAX = 256;
constexpr int CW_ECNT = 512;
constexpr int CW_EFILL = 576;
constexpr int MI_LAMF = 0;
constexpr int MI_NTILES = 16;
constexpr int MI_EOFF = 32;
constexpr int MI_TILEE = 64;

__device__ __forceinline__ unsigned f2bf(float f) { unsigned u = __builtin_bit_cast(unsigned, f); return (u + 0x7fffu + ((u >> 16) & 1u)) >> 16; }
__device__ __forceinline__ unsigned pk2(float lo, float hi) { return f2bf(lo) | (f2bf(hi) << 16); }
__device__ __forceinline__ float bflo(unsigned w) { return __builtin_bit_cast(float, w << 16); }
__device__ __forceinline__ float bfhi(unsigned w) { return __builtin_bit_cast(float, w & 0xffff0000u); }
__device__ __forceinline__ float bf2f(bf16_t h) { return __builtin_bit_cast(float, (unsigned)h << 16); }
__device__ __forceinline__ float wave_sum(float v) {
#pragma unroll
    for (int o = 1; o < 64; o <<= 1) v += __shfl_xor(v, o);
    return v;
}
__device__ __forceinline__ int otid() { int t = threadIdx.x; asm volatile("" : "+v"(t)); return t; }
__device__ __forceinline__ float sigmoidf_(float x) { return 1.0f / (1.0f + __expf(-x)); }
__device__ __forceinline__ float siluf_(float x) { return x / (1.0f + __expf(-x)); }
__device__ __forceinline__ float softplusf_(float x) { return x > 20.f ? x : log1pf(expf(x)); }
__device__ __forceinline__ float logsigmoidf_(float x) { return fminf(x, 0.f) - log1pf(expf(-fabsf(x))); }

struct P {
    const float *x, *c, *ctx, *c_ctx, *w_mod, *b_mod, *norm1_g, *norm2_g, *w_in, *conv_a, *a_log, *dt_bias, *gn_a, *w_gate2, *b_gate, *gn_b,
                *lam_c, *gn_c, *w_o_a, *w_o_b, *w_o_c, *w_out, *ffn_w1, *ffn_w3, *ffn_w2, *router_w, *moe_w1, *moe_w3, *moe_w2, *final_g;
    float* out; unsigned char* ws;
};

template <class ColMap>
__device__ __forceinline__ void convert_T(const float* W, int K, int ldw, bf16_t* WT, int Nrows, ColMap cm, float* scr, int gw, int NGW, int lane) {
    const int nblk = Nrows / 32, items = (K / 64) * nblk;
    for (int it = gw; it < items; it += NGW) {
        const int kb = it / nblk, nb = it % nblk, k0 = 64 * kb, n0 = 32 * nb;
        const int sc = cm(n0 + (lane & 31));
#pragma unroll 8
        for (int i = 0; i < 32; ++i) { const int kk = 2 * i + (lane >> 5); scr[kk * 33 + (lane & 31)] = sc >= 0 ? W[(size_t)(k0 + kk) * ldw + sc] : 0.f; }
        asm volatile("s_waitcnt lgkmcnt(0)" ::: "memory");
        const int c = lane & 7;
#pragma unroll
        for (int j = 0; j < 4; ++j) { const int n = (lane >> 3) + 8 * j; const float* s = scr + (8 * c) * 33 + n;
            u32x4 o; o.x = pk2(s[0 * 33], s[1 * 33]); o.y = pk2(s[2 * 33], s[3 * 33]); o.z = pk2(s[4 * 33], s[5 * 33]); o.w = pk2(s[6 * 33], s[7 * 33]);
            *(u32x4*)(WT + (size_t)(n0 + n) * K + k0 + 8 * c) = o; }
        asm volatile("s_waitcnt lgkmcnt(0)" ::: "memory");
    }
}
struct CmIdent { __device__ int operator()(int n) const { return n; } };
struct CmWin { __device__ int operator()(int n) const {
    if (n < 2048) return n; if (n < 3584) return n + 16; if (n < 8192) return n + 48;
    const int j = n - 8192; if (j < 16) return 2048 + j; if (j < 48) return 3600 + (j - 16); return -1; } };

typedef const f32x4 (&AccRef)[2][2][4][2];
struct EpiWin {
    static constexpr bool PERM = true, AFTER_DRAIN = false;
    bf16_t *paq, *pz, *pb, *pc, *pg; float* small_;
    __device__ __forceinline__ void operator()(AccRef acc, const pg8::Unit& u, int wr, int wc, int fr, int fq) const {
        const int row0 = u.pm * 256 + wr * 64 + fr, pn = u.pn;
        if (pn == 32) {
            if (wc < 2) {
#pragma unroll
                for (int ai = 0; ai < 2; ++ai)
#pragma unroll
                    for (int m = 0; m < 4; ++m) { float* p = small_ + (size_t)(row0 + ai * 128 + m * 16) * 64 + wc * 32 + 8 * fq;
                        *(f32x4*)p = acc[ai][0][m][0]; *(f32x4*)(p + 4) = acc[ai][0][m][1]; }
            }
            return;
        }
        bf16_t* base; int ldc, c0;
        if (pn < 6) { base = paq; ldc = 1536; c0 = pn * 256; } else if (pn < 8) { base = pz; ldc = 512; c0 = (pn - 6) * 256; }
        else if (pn < 14) { base = pb; ldc = 1536; c0 = (pn - 8) * 256; } else if (pn < 20) { base = pc; ldc = 1536; c0 = (pn - 14) * 256; }
        else { base = pg; ldc = 3072; c0 = (pn - 20) * 256; }
        const int col = c0 + wc * 32 + 8 * fq;
#pragma unroll
        for (int ai = 0; ai < 2; ++ai)
#pragma unroll
            for (int m = 0; m < 4; ++m) { bf16_t* rowp = base + (size_t)(row0 + ai * 128 + m * 16) * ldc + col;
#pragma unroll
                for (int bj = 0; bj < 2; ++bj) { const f32x4 v0 = acc[ai][bj][m][0], v1 = acc[ai][bj][m][1];
                    u32x4 w; w.x = pk2(v0[0], v0[1]); w.y = pk2(v0[2], v0[3]); w.z = pk2(v1[0], v1[1]); w.w = pk2(v1[2], v1[3]);
                    *(u32x4*)(rowp + bj * 128) = w; } }
    }
};
struct EpiGate {
    static constexpr bool PERM = true, AFTER_DRAIN = false;
    bf16_t* Mo; const bf16_t* pg; int br;
    __device__ __forceinline__ void operator()(AccRef acc, const pg8::Unit& u, int wr, int wc, int fr, int fq) const {
        const int row0 = u.pm * 256 + wr * 64 + fr, col = u.pn * 256 + wc * 32 + 8 * fq;
#pragma unroll
        for (int ai = 0; ai < 2; ++ai)
#pragma unroll
            for (int m = 0; m < 4; ++m) { const size_t row = (size_t)(row0 + ai * 128 + m * 16);
#pragma unroll
                for (int bj = 0; bj < 2; ++bj) {
                    const u32x4 gw = *(const u32x4*)(pg + row * 3072 + br * 1024 + col + bj * 128);
                    bf16_t* mp = Mo + row * 1024 + col + bj * 128;
                    f32x4 v0 = acc[ai][bj][m][0], v1 = acc[ai][bj][m][1];
                    v0[0] *= sigmoidf_(bflo(gw.x)); v0[1] *= sigmoidf_(bfhi(gw.x)); v0[2] *= sigmoidf_(bflo(gw.y)); v0[3] *= sigmoidf_(bfhi(gw.y));
                    v1[0] *= sigmoidf_(bflo(gw.z)); v1[1] *= sigmoidf_(bfhi(gw.z)); v1[2] *= sigmoidf_(bflo(gw.w)); v1[3] *= sigmoidf_(bfhi(gw.w));
                    if (br != 0) { const u32x4 o = *(const u32x4*)mp;
                        v0[0] += bflo(o.x); v0[1] += bfhi(o.x); v0[2] += bflo(o.y); v0[3] += bfhi(o.y); v1[0] += bflo(o.z); v1[1] += bfhi(o.z); v1[2] += bflo(o.w); v1[3] += bfhi(o.w); }
                    u32x4 w; w.x = pk2(v0[0], v0[1]); w.y = pk2(v0[2], v0[3]); w.z = pk2(v1[0], v1[1]); w.w = pk2(v1[2], v1[3]);
                    *(u32x4*)mp = w; } }
    }
};
struct EpiResid {
    static constexpr bool PERM = false, AFTER_DRAIN = false;
    const float *old_l, *old_c; float *out_l, *out_c; const float* mod; int gidx;
    __device__ __forceinline__ void operator()(AccRef acc, const pg8::Unit& u, int wr, int wc, int fr, int fq) const {
        const int col0 = u.pn * 256 + wc * 32 + 4 * fq;
        const bool isctx = u.pm >= TL / 256; const int b = isctx ? 8 : u.pm / (SEQ / 256);
        const float* g = mod + (size_t)b * 6144 + gidx * 1024 + col0;
        const float* ob = isctx ? old_c - (size_t)TL * D : old_l; float* wb = isctx ? out_c - (size_t)TL * D : out_l;
        f32x4 gv[2][2];
#pragma unroll
        for (int bj = 0; bj < 2; ++bj)
#pragma unroll
            for (int n = 0; n < 2; ++n) gv[bj][n] = *(const f32x4*)(g + bj * 128 + n * 16);
#pragma unroll
        for (int ai = 0; ai < 2; ++ai)
#pragma unroll
            for (int m = 0; m < 4; ++m) { const size_t off = (size_t)(u.pm * 256 + ai * 128 + wr * 64 + m * 16 + fr) * D + col0;
#pragma unroll
                for (int bj = 0; bj < 2; ++bj)
#pragma unroll
                    for (int n = 0; n < 2; ++n) { const f32x4 xo = *(const f32x4*)(ob + off + bj * 128 + n * 16);
                        *(f32x4*)(wb + off + bj * 128 + n * 16) = xo + gv[bj][n] * acc[ai][bj][m][n]; } }
    }
};
struct EpiSwiglu {
    static constexpr bool PERM = true, AFTER_DRAIN = false;
    bf16_t* h1; int NJ;
    __device__ __forceinline__ void operator()(AccRef acc, const pg8::Unit& u, int wr, int wc, int fr, int fq) const {
        const int row0 = u.pm * 256 + wr * 64 + fr, col = (u.pn % NJ) * 128 + wc * 32 + 8 * fq;
#pragma unroll
        for (int ai = 0; ai < 2; ++ai)
#pragma unroll
            for (int m = 0; m < 4; ++m) { const f32x4 a0 = acc[ai][0][m][0], a1 = acc[ai][0][m][1], b0 = acc[ai][1][m][0], b1 = acc[ai][1][m][1];
                u32x4 w; w.x = pk2(siluf_(a0[0]) * b0[0], siluf_(a0[1]) * b0[1]); w.y = pk2(siluf_(a0[2]) * b0[2], siluf_(a0[3]) * b0[3]);
                w.z = pk2(siluf_(a1[0]) * b1[0], siluf_(a1[1]) * b1[1]); w.w = pk2(siluf_(a1[2]) * b1[2], siluf_(a1[3]) * b1[3]);
                *(u32x4*)(h1 + (size_t)(row0 + ai * 128 + m * 16) * DFF + col) = w; }
    }
};
struct EpiMoeDown {
    static constexpr bool PERM = true, AFTER_DRAIN = false;
    bf16_t* y;
    __device__ __forceinline__ void operator()(AccRef acc, const pg8::Unit& u, int wr, int wc, int fr, int fq) const {
        const int row0 = u.pm * 256 + wr * 64 + fr, col = (u.pn % 4) * 256 + wc * 32 + 8 * fq;
#pragma unroll
        for (int ai = 0; ai < 2; ++ai)
#pragma unroll
            for (int m = 0; m < 4; ++m) { bf16_t* rowp = y + (size_t)(row0 + ai * 128 + m * 16) * D + col;
#pragma unroll
                for (int bj = 0; bj < 2; ++bj) { const f32x4 v0 = acc[ai][bj][m][0], v1 = acc[ai][bj][m][1];
                    u32x4 w; w.x = pk2(v0[0], v0[1]); w.y = pk2(v0[2], v0[3]); w.z = pk2(v1[0], v1[1]); w.w = pk2(v1[2], v1[3]);
                    *(u32x4*)(rowp + bj * 128) = w; } }
    }
};
struct MoeOrder {
    int ntiles, NJ, G, c; const int* tile_e;
    __device__ bool next(int i, pg8::Unit& u) const { const long L = (long)i * G + c; if (L >= (long)ntiles * NJ) return false;
        const int t = (int)(L / NJ), j = (int)(L % NJ); u.pm = t; u.pn = tile_e[t] * NJ + j; return true; }
    __device__ __forceinline__ void a_ready(const pg8::Unit&) const {}
    __device__ __forceinline__ void done(const pg8::Unit&) const {}
};

__device__ __forceinline__ void phase_mod(const P& p, unsigned char* lds) {
    float* sc = (float*)lds;
    float* red = sc + 9 * 1024;
    const int tid = otid();
    for (int i = tid; i < 9 * 1024; i += NTHREADS) { const int r = i >> 10, k = i & 1023; const float v = r < 8 ? p.c[r * 1024 + k] : p.c_ctx[k]; sc[i] = siluf_(v); }
    __syncthreads();
    float* MOD = (float*)(p.ws + WS_MOD);
    const int cj = tid % 48, ks = tid / 48;
    for (int grp = blockIdx.x; grp < DEPTH * 6144 / 48; grp += gridDim.x) {
        const int l = grp / 128, j = (grp % 128) * 48 + cj;
        float a[9];
#pragma unroll
        for (int r = 0; r < 9; ++r) a[r] = 0.f;
        if (ks < 10) {
            const float* w = p.w_mod + (size_t)l * 1024 * 6144 + j;
            for (int k = ks; k < 1024; k += 10) { const float wv = w[(size_t)k * 6144];
#pragma unroll
                for (int r = 0; r < 9; ++r) a[r] += sc[r * 1024 + k] * wv; }
#pragma unroll
            for (int r = 0; r < 9; ++r) red[(ks * 9 + r) * 48 + cj] = a[r];
        }
        __syncthreads();
        if (tid < 9 * 48) { const int r = tid / 48, c2 = tid % 48; float s = 0.f;
#pragma unroll
            for (int q = 0; q < 10; ++q) s += red[(q * 9 + r) * 48 + c2];
            const int jj = (grp % 128) * 48 + c2;
            MOD[((size_t)l * 9 + r) * 6144 + jj] = s + p.b_mod[l * 6144 + jj]; }
        __syncthreads();
    }
}

__device__ __forceinline__ void phase_modulate(const float* src_l, const float* src_c, int nrows, const float* gain, const float* mod, int shift_idx,
                                               bf16_t* H, const float* router_w, int* route, unsigned* ecnt, int gw, int NGW, int lane) {
    for (int r = gw; r < nrows; r += NGW) {
        const bool isctx = r >= TL; const int b = isctx ? 8 : r / SEQ;
        const float* xr = isctx ? src_c + (size_t)(r - TL) * D : src_l + (size_t)r * D;
        const float* sh = mod + (size_t)b * 6144 + shift_idx * 1024; const float* scl = sh + 1024;
        f32x4 v[4]; float ss = 0.f;
#pragma unroll
        for (int j = 0; j < 4; ++j) { v[j] = *(const f32x4*)(xr + 4 * lane + 256 * j); ss += (v[j][0] * v[j][0] + v[j][1] * v[j][1]) + (v[j][2] * v[j][2] + v[j][3] * v[j][3]); }
        const float rs = 1.0f / sqrtf(wave_sum(ss) * (1.0f / D) + EPS);
#pragma unroll
        for (int j = 0; j < 4; ++j) { const int c = 4 * lane + 256 * j; const f32x4 g = *(const f32x4*)(gain + c), s1 = *(const f32x4*)(scl + c), s0 = *(const f32x4*)(sh + c);
            v[j] = v[j] * rs * g * (1.0f + s1) + s0;
            u32x2 w; w.x = pk2(v[j][0], v[j][1]); w.y = pk2(v[j][2], v[j][3]);
            *(u32x2*)(H + (size_t)r * D + c) = w; }
        if (router_w) {
            float lg[NE];
#pragma unroll
            for (int e = 0; e < NE; ++e) lg[e] = 0.f;
#pragma unroll
            for (int j = 0; j < 4; ++j)
#pragma unroll
                for (int q = 0; q < 4; ++q) { const float* rw = router_w + (size_t)(4 * lane + 256 * j + q) * NE; const f32x4 r0 = *(const f32x4*)rw, r1 = *(const f32x4*)(rw + 4); const float hv = v[j][q];
                    lg[0] += hv * r0[0]; lg[1] += hv * r0[1]; lg[2] += hv * r0[2]; lg[3] += hv * r0[3]; lg[4] += hv * r1[0]; lg[5] += hv * r1[1]; lg[6] += hv * r1[2]; lg[7] += hv * r1[3]; }
#pragma unroll
            for (int e = 0; e < NE; ++e) lg[e] = wave_sum(lg[e]);
            int e1 = 0; float v1 = lg[0];
#pragma unroll
            for (int e = 1; e < NE; ++e) if (lg[e] > v1) { v1 = lg[e]; e1 = e; }
            int e2 = -1; float v2 = -3.0e38f;
#pragma unroll
            for (int e = 0; e < NE; ++e) if (e != e1 && lg[e] > v2) { v2 = lg[e]; e2 = e; }
            const float w2 = 1.0f / (1.0f + expf(v1 - v2)), w1 = 1.0f - w2;
            if (lane == 0) { route[r * 4 + 0] = e1; route[r * 4 + 1] = e2; ((float*)route)[r * 4 + 2] = w1; ((float*)route)[r * 4 + 3] = w2;
                atomicAdd(ecnt + e1, 1u); atomicAdd(ecnt + e2, 1u); }
        }
    }
}

__device__ __forceinline__ void phase_prep(const P& p, int l, int gw, int NGW, int lane) {
    unsigned char* ws = p.ws;
    const bf16_t* PAQ = (const bf16_t*)(ws + WS_PAQ); bf16_t* DN = (bf16_t*)(ws + WS_DNQKV);
    const float* SMALL = (const float*)(ws + WS_SMALL); float* GB = (float*)(ws + WS_GB); float* GLOG = (float*)(ws + WS_GLOG);
    bf16_t* PC = (bf16_t*)(ws + WS_PC); unsigned* ctl = (unsigned*)(ws + WS_CTL);
    const float* cw = p.conv_a + (size_t)l * 3 * 1536;
    for (int it = gw; it < T * 12; it += NGW) {
        const int r = it / 12, gi = it % 12, col = gi * 128 + 2 * lane;
        const int t = r < TL ? (r % SEQ) : ((r - TL) % CTXL), L = r < TL ? SEQ : CTXL;
        const unsigned x1 = *(const unsigned*)(PAQ + (size_t)r * 1536 + col);
        const unsigned x0 = t > 0 ? *(const unsigned*)(PAQ + (size_t)(r - 1) * 1536 + col) : 0u;
        const unsigned x2 = t < L - 1 ? *(const unsigned*)(PAQ + (size_t)(r + 1) * 1536 + col) : 0u;
        float y0 = cw[col] * bflo(x0) + cw[1536 + col] * bflo(x1) + cw[3072 + col] * bflo(x2);
        float y1 = cw[col + 1] * bfhi(x0) + cw[1536 + col + 1] * bfhi(x1) + cw[3072 + col + 1] * bfhi(x2);
        y0 = siluf_(y0); y1 = siluf_(y1);
        if (gi < 8) { const float ss = wave_sum(y0 * y0 + y1 * y1); float sc = 1.0f / sqrtf(ss + EPS); if (gi < 4) sc *= 0.08838834764831845f; y0 *= sc; y1 *= sc; }
        *(unsigned*)(DN + (size_t)r * 1536 + col) = pk2(y0, y1);
    }
    const int gt = gw * 64 + lane, NGT = NGW * 64;
    for (int i = gt; i < T * 8; i += NGT) { const int r = i >> 3, q = i & 7;
        const float bb = SMALL[(size_t)r * 64 + q], aa = SMALL[(size_t)r * 64 + 8 + q];
        GB[(size_t)r * 16 + q] = -expf(p.a_log[l * 8 + q]) * softplusf_(aa + p.dt_bias[l * 8 + q]);
        GB[(size_t)r * 16 + 8 + q] = sigmoidf_(bb); }
    for (int it = gw; it < T * 2; it += NGW) { const int r = it >> 1, d = it & 1;
        const float* wg = p.w_gate2 + ((size_t)l * 2 + d) * 16 * 256 + 4 * lane; const float* glr = SMALL + (size_t)r * 64 + 16 + d * 16;
        f32x4 z = *(const f32x4*)(p.b_gate + ((size_t)l * 2 + d) * 256 + 4 * lane);
#pragma unroll
        for (int j = 0; j < 16; ++j) z += glr[j] * *(const f32x4*)(wg + j * 256);
        f32x4 o; o[0] = logsigmoidf_(z[0]) * 0.0625f; o[1] = logsigmoidf_(z[1]) * 0.0625f; o[2] = logsigmoidf_(z[2]) * 0.0625f; o[3] = logsigmoidf_(z[3]) * 0.0625f;
        *(f32x4*)(GLOG + ((size_t)d * T + r) * 256 + 4 * lane) = o; }
    for (long i = gt; i < (long)T * 512; i += NGT) {
        const int r = (int)(i >> 9), q = (int)(i & 511), seg = q >> 8, h = (q >> 6) & 3, m = (q >> 5) & 1, pi = q & 31;
        const int half = pi >> 4, fi = pi & 15, d1 = half * 32 + fi, d2 = d1 + 16;
        bf16_t* base = PC + (size_t)r * 1536 + seg * 512 + h * 128 + m * 64;
        float x1 = bf2f(base[d1]), x2 = bf2f(base[d2]);
        const bool lat = r < TL; const int b = lat ? r / SEQ : (r - TL) / CTXL;
        if (lat) { const int t = r % SEQ; const float pos = half ? (float)(t & 63) : (float)(t >> 6);
            const float ang = pos * exp2f(-(float)fi * 0.8304820237218406f);
            float sn, cs; sincosf(ang, &sn, &cs);
            const float o1 = x1 * cs - x2 * sn, o2 = x2 * cs + x1 * sn; x1 = o1; x2 = o2; }
        if (seg == 0) { x1 *= 0.125f; x2 *= 0.125f; }
        const bf16_t r1 = (bf16_t)f2bf(x1), r2 = (bf16_t)f2bf(x2);
        if (lat || seg == 0) { base[d1] = r1; base[d2] = r2; }
        float ss = bf2f(r1) * bf2f(r1) + bf2f(r2) * bf2f(r2);
#pragma unroll
        for (int o = 1; o < 32; o <<= 1) ss += __shfl_xor(ss, o);
        if (seg == 1 && (lane & 31) == 0) atomicMax(ctl + CW_KMAX + l * 64 + (b * 4 + h) * 2 + m, __builtin_bit_cast(unsigned, sqrtf(ss)));
    }
    if (gw == 0) { float a = 0.f, bq = 0.f; const float* lc = p.lam_c + (size_t)l * 256;
        a = wave_sum(lc[lane] * lc[64 + lane]); bq = wave_sum(lc[128 + lane] * lc[192 + lane]);
        const float lam_init = 0.8f - 0.6f * expf(-0.3f * (float)l);
        if (lane == 0) ((float*)(ws + WS_MISC))[MI_LAMF + l] = expf(a) - expf(bq) + lam_init; }
}

__device__ __forceinline__ void dn_chain(const P& p, int item, unsigned char* lds) {
    const int b = item >> 3, h = (item >> 1) & 3, dir = item & 1, tid = otid(), c = tid >> 2, ks = tid & 3;
    const bf16_t* DN = (const bf16_t*)(p.ws + WS_DNQKV); const float* GB = (const float*)(p.ws + WS_GB);
    bf16_t* OA = (bf16_t*)(p.ws + WS_H) + (size_t)dir * T * 512;
    constexpr int TB = 32;
    float* qs = (float*)lds; float* ksm = qs + TB * 128; float* vs = ksm + TB * 128; float* gs = vs + TB * 128; float* bs = gs + TB; float* ob = bs + TB;
    float S[32];
#pragma unroll
    for (int i = 0; i < 32; ++i) S[i] = 0.f;
    for (int part = 0; part < 2; ++part) {
        const int L = part == 0 ? CTXL : SEQ; const int rbase = part == 0 ? TL + b * CTXL : b * SEQ;
        for (int t0 = 0; t0 < L; t0 += TB) {
            __syncthreads();
            for (int i = tid; i < 3 * TB * 16; i += NTHREADS) { const int which = i / (TB * 16), rem = i % (TB * 16), tt = rem >> 4, ch = rem & 15;
                const int s = t0 + tt, t = dir ? L - 1 - s : s;
                const u32x4 w = *(const u32x4*)(DN + (size_t)(rbase + t) * 1536 + which * 512 + h * 128 + ch * 8);
                float* dst = (which == 0 ? qs : which == 1 ? ksm : vs) + tt * 128 + ch * 8;
                dst[0] = bflo(w.x); dst[1] = bfhi(w.x); dst[2] = bflo(w.y); dst[3] = bfhi(w.y); dst[4] = bflo(w.z); dst[5] = bfhi(w.z); dst[6] = bflo(w.w); dst[7] = bfhi(w.w); }
            if (tid < TB) { const int s = t0 + tid, t = dir ? L - 1 - s : s; gs[tid] = expf(GB[(size_t)(rbase + t) * 16 + dir * 4 + h]); bs[tid] = GB[(size_t)(rbase + t) * 16 + 8 + dir * 4 + h]; }
            __syncthreads();
            for (int tt = 0; tt < TB; ++tt) {
                const float eg = gs[tt], be = bs[tt];
                const float* kr = ksm + tt * 128 + ks * 32; const float* qr = qs + tt * 128 + ks * 32;
                float r = 0.f;
#pragma unroll
                for (int i = 0; i < 32; ++i) r += kr[i] * S[i];
                r += __shfl_xor(r, 1); r += __shfl_xor(r, 2);
                const float vn = be * (vs[tt * 128 + c] - eg * r);
                float o = 0.f;
#pragma unroll
                for (int i = 0; i < 32; ++i) { S[i] = eg * S[i] + kr[i] * vn; o += qr[i] * S[i]; }
                o += __shfl_xor(o, 1); o += __shfl_xor(o, 2);
                if (ks == 0) ob[tt * 128 + c] = o;
            }
            __syncthreads();
            for (int i = tid; i < TB * 64; i += NTHREADS) { const int tt = i >> 6, cp = i & 63; const int s = t0 + tt, t = dir ? L - 1 - s : s;
                *(unsigned*)(OA + (size_t)(rbase + t) * 512 + h * 128 + 2 * cp) = pk2(ob[tt * 128 + 2 * cp], ob[tt * 128 + 2 * cp + 1]); }
        }
    }
}
__device__ __forceinline__ void gla_chain(const P& p, int item, unsigned char* lds) {
    const int b = item >> 3, h = (item >> 1) & 3, dir = item & 1, tid = otid(), c = tid >> 2, ks = tid & 3;
    const bf16_t* PB = (const bf16_t*)(p.ws + WS_PB); const float* GLOG = (const float*)(p.ws + WS_GLOG) + (size_t)dir * T * 256;
    bf16_t* OB = (bf16_t*)(p.ws + WS_PAQ) + (size_t)dir * T * 512;
    constexpr int TB = 32;
    float* qs = (float*)lds; float* ksm = qs + TB * 64; float* es = ksm + TB * 64; float* vs = es + TB * 64; float* ob = vs + TB * 128;
    float S[16];
#pragma unroll
    for (int i = 0; i < 16; ++i) S[i] = 0.f;
    for (int part = 0; part < 2; ++part) {
        const int L = part == 0 ? CTXL : SEQ; const int rbase = part == 0 ? TL + b * CTXL : b * SEQ;
        for (int t0 = 0; t0 < L; t0 += TB) {
            __syncthreads();
            for (int i = tid; i < TB * 32; i += NTHREADS) {
                const int tt = i >> 5, ch = i & 31; const int s = t0 + tt, t = dir ? L - 1 - s : s; const size_t row = (size_t)(rbase + t);
                if (ch < 16) { const int which = ch >> 3, c8 = (ch & 7) * 8;
                    const u32x4 w = *(const u32x4*)(PB + row * 1536 + which * 256 + h * 64 + c8);
                    float* dst = (which == 0 ? qs : ksm) + tt * 64 + c8; const float sc = which == 0 ? 0.125f : 1.0f;
                    dst[0] = sc * bflo(w.x); dst[1] = sc * bfhi(w.x); dst[2] = sc * bflo(w.y); dst[3] = sc * bfhi(w.y); dst[4] = sc * bflo(w.z); dst[5] = sc * bfhi(w.z); dst[6] = sc * bflo(w.w); dst[7] = sc * bfhi(w.w);
                    if (which == 1) { const f32x4 g0 = *(const f32x4*)(GLOG + row * 256 + h * 64 + c8), g1 = *(const f32x4*)(GLOG + row * 256 + h * 64 + c8 + 4); float* e = es + tt * 64 + c8;
                        e[0] = expf(g0[0]); e[1] = expf(g0[1]); e[2] = expf(g0[2]); e[3] = expf(g0[3]); e[4] = expf(g1[0]); e[5] = expf(g1[1]); e[6] = expf(g1[2]); e[7] = expf(g1[3]); }
                } else { const int c8 = (ch - 16) * 8; const u32x4 w = *(const u32x4*)(PB + row * 1536 + 512 + h * 128 + c8); float* dst = vs + tt * 128 + c8;
                    dst[0] = bflo(w.x); dst[1] = bfhi(w.x); dst[2] = bflo(w.y); dst[3] = bfhi(w.y); dst[4] = bflo(w.z); dst[5] = bfhi(w.z); dst[6] = bflo(w.w); dst[7] = bfhi(w.w); }
            }
            __syncthreads();
            for (int tt = 0; tt < TB; ++tt) {
                const float* kr = ksm + tt * 64 + ks * 16; const float* qr = qs + tt * 64 + ks * 16; const float* er = es + tt * 64 + ks * 16;
                const float vv = vs[tt * 128 + c]; float o = 0.f;
#pragma unroll
                for (int i = 0; i < 16; ++i) { S[i] = er[i] * S[i] + kr[i] * vv; o += qr[i] * S[i]; }
                o += __shfl_xor(o, 1); o += __shfl_xor(o, 2);
                if (ks == 0) ob[tt * 128 + c] = o;
            }
            __syncthreads();
            for (int i = tid; i < TB * 64; i += NTHREADS) { const int tt = i >> 6, cp = i & 63; const int s = t0 + tt, t = dir ? L - 1 - s : s;
                *(unsigned*)(OB + (size_t)(rbase + t) * 512 + h * 128 + 2 * cp) = pk2(ob[tt * 128 + 2 * cp], ob[tt * 128 + 2 * cp + 1]); }
        }
    }
}
__device__ __forceinline__ void attn_tile(const P& p, int l, int b, int h, int qrow0  , bool ctxq, unsigned char* lds) {
    constexpr int QP = 72, KP = 72, VP = 72;
    bf16_t* Qs = (bf16_t*)lds;
    bf16_t* Ks = Qs + 2 * 128 * QP;
    bf16_t* Vt = Ks + 2 * 64 * KP;
    float* Oex = (float*)lds;
    bf16_t* PC = (bf16_t*)(p.ws + WS_PC);
    const int tid = otid(), lane = tid & 63, w = tid >> 6, m = w & 1, rg = w >> 1, q31 = lane & 31, hi = lane >> 5;
    __syncthreads();
    for (int i = tid; i < 128 * 16; i += NTHREADS) { const int r = i >> 4, ch = i & 15, mm = ch >> 3, c8 = (ch & 7) * 8;
        *(u32x4*)(Qs + (mm * 128 + r) * QP + c8) = *(const u32x4*)(PC + (size_t)(qrow0 + r) * 1536 + h * 128 + ch * 8); }
    __syncthreads();
    const bf16_t* qrow = Qs + (m * 128 + rg * 32 + q31) * QP;
    bf16x8 bq[4]; float qn = 0.f;
#pragma unroll
    for (int kk = 0; kk < 4; ++kk) bq[kk] = *(const bf16x8*)(qrow + 16 * kk + 8 * hi);
#pragma unroll
    for (int d8 = 0; d8 < 8; ++d8) { const u32x4 q4 = *(const u32x4*)(qrow + 8 * d8);
        qn += bflo(q4.x) * bflo(q4.x) + bfhi(q4.x) * bfhi(q4.x) + bflo(q4.y) * bflo(q4.y) + bfhi(q4.y) * bfhi(q4.y) + bflo(q4.z) * bflo(q4.z) + bfhi(q4.z) * bfhi(q4.z) + bflo(q4.w) * bflo(q4.w) + bfhi(q4.w) * bfhi(q4.w); }
    const float kmax = __builtin_bit_cast(float, ((const unsigned*)(p.ws + WS_CTL))[CW_KMAX + l * 64 + (b * 4 + h) * 2 + m]);
    const float mrow = sqrtf(qn) * kmax * 1.002f + 1e-3f;
    f32x16 o[4]; float lsum = 0.f;
#pragma unroll
    for (int dt = 0; dt < 4; ++dt)
#pragma unroll
        for (int r = 0; r < 16; ++r) o[dt][r] = 0.f;
    const int nkt = ctxq ? CTXL / 64 : (CTXL + SEQ) / 64;
    for (int kt = 0; kt < nkt; ++kt) {
        const int krow0 = kt < CTXL / 64 ? TL + b * CTXL + kt * 64 : b * SEQ + (kt - CTXL / 64) * 64;
        __syncthreads();
        for (int i = tid; i < 64 * 16; i += NTHREADS) { const int r = i >> 4, ch = i & 15, mm = ch >> 3, c8 = (ch & 7) * 8;
            *(u32x4*)(Ks + (mm * 64 + r) * KP + c8) = *(const u32x4*)(PC + (size_t)(krow0 + r) * 1536 + 512 + h * 128 + ch * 8); }
        for (int i = tid; i < 64 * 16; i += NTHREADS) { const int r = i >> 4, ch = i & 15;
            const u32x4 v = *(const u32x4*)(PC + (size_t)(krow0 + r) * 1536 + 1024 + h * 128 + ch * 8); bf16_t* d = Vt + (ch * 8) * VP + r;
            d[0] = (bf16_t)v.x; d[VP] = (bf16_t)(v.x >> 16); d[2 * VP] = (bf16_t)v.y; d[3 * VP] = (bf16_t)(v.y >> 16); d[4 * VP] = (bf16_t)v.z; d[5 * VP] = (bf16_t)(v.z >> 16); d[6 * VP] = (bf16_t)v.w; d[7 * VP] = (bf16_t)(v.w >> 16); }
        __syncthreads();
        f32x16 s[2];
#pragma unroll
        for (int kh = 0; kh < 2; ++kh) {
#pragma unroll
            for (int r = 0; r < 16; ++r) s[kh][r] = 0.f;
#pragma unroll
            for (int kk = 0; kk < 4; ++kk) { const bf16x8 a = *(const bf16x8*)(Ks + (m * 64 + kh * 32 + q31) * KP + 16 * kk + 8 * hi);
                s[kh] = __builtin_amdgcn_mfma_f32_32x32x16_bf16(a, bq[kk], s[kh], 0, 0, 0); }
#pragma unroll
            for (int r = 0; r < 16; ++r) { const float e = __expf(s[kh][r] - mrow); s[kh][r] = e; lsum += e; }
        }
#pragma unroll
        for (int st = 0; st < 4; ++st) {
            const int kh = st >> 1, r0 = 8 * (st & 1);
            union { bf16x8 v; unsigned u[4]; } bp;
            bp.u[0] = pk2(s[kh][r0 + 0], s[kh][r0 + 1]); bp.u[1] = pk2(s[kh][r0 + 2], s[kh][r0 + 3]); bp.u[2] = pk2(s[kh][r0 + 4], s[kh][r0 + 5]); bp.u[3] = pk2(s[kh][r0 + 6], s[kh][r0 + 7]);
#pragma unroll
            for (int dt = 0; dt < 4; ++dt) { const bf16_t* vr = Vt + (dt * 32 + q31) * VP + 16 * st + 4 * hi;
                union { bf16x8 v; s16x4 h2[2]; } av; av.h2[0] = *(const s16x4*)vr; av.h2[1] = *(const s16x4*)(vr + 8);
                o[dt] = __builtin_amdgcn_mfma_f32_32x32x16_bf16(av.v, bp.v, o[dt], 0, 0, 0); }
        }
    }
    lsum += __shfl_xor(lsum, 32);
    const float lamf = ((const float*)(p.ws + WS_MISC))[MI_LAMF + l];
    const float sc = (m == 0 ? 1.0f : lamf) / lsum;
    __syncthreads();
    float* ox = Oex + (rg * 32 + q31) * 132;
    if (m == 1) {
#pragma unroll
        for (int dt = 0; dt < 4; ++dt)
#pragma unroll
            for (int r = 0; r < 16; ++r) ox[dt * 32 + (r & 3) + 8 * (r >> 2) + 4 * hi] = o[dt][r] * sc;
    }
    __syncthreads();
    if (m == 0) {
        float ss = 0.f;
#pragma unroll
        for (int dt = 0; dt < 4; ++dt)
#pragma unroll
            for (int r = 0; r < 16; ++r) { const float v = o[dt][r] * sc - ox[dt * 32 + (r & 3) + 8 * (r >> 2) + 4 * hi]; o[dt][r] = v; ss += v * v; }
        ss += __shfl_xor(ss, 32);
        const float lam_init = 0.8f - 0.6f * expf(-0.3f * (float)l);
        const float rs = (1.0f - lam_init) / sqrtf(ss * (1.0f / 128.0f) + EPS);
        const float* gn = p.gn_c + l * 128;
        bf16_t* orow = PC + (size_t)(qrow0 + rg * 32 + q31) * 1536 + h * 128;
#pragma unroll
        for (int dt = 0; dt < 4; ++dt)
#pragma unroll
            for (int g4 = 0; g4 < 4; ++g4) { const int dv = dt * 32 + 8 * g4 + 4 * hi; const f32x4 gg = *(const f32x4*)(gn + dv);
                u32x2 wv; wv.x = pk2(o[dt][4 * g4 + 0] * rs * gg[0], o[dt][4 * g4 + 1] * rs * gg[1]); wv.y = pk2(o[dt][4 * g4 + 2] * rs * gg[2], o[dt][4 * g4 + 3] * rs * gg[3]);
                *(u32x2*)(orow + dv) = wv; }
    }
}
__device__ __forceinline__ void phase_mix(const P& p, int l, unsigned char* lds) {
    unsigned* qhead = (unsigned*)(p.ws + WS_CTL) + CW_QUEUE + 64 * l;
    volatile int* slot = (volatile int*)(lds + LDS_BYTES - 64);
    const int n_att_l = BATCH * 4 * (SEQ / 128), n_att_c = (l == 0) ? BATCH * 4 * (CTXL / 128) : 0;
    const int total = 128 + n_att_l + n_att_c;
    for (;;) {
        __syncthreads();
        if (otid() == 0) *slot = (int)atomicAdd(qhead, 1u);
        __syncthreads();
        const int it = *slot;
        if (it >= total) break;
        if (it < 64) dn_chain(p, it, lds);
        else if (it < 128) gla_chain(p, it - 64, lds);
        else if (it < 128 + n_att_l) { const int a = it - 128, b = a / (4 * (SEQ / 128)), rem = a % (4 * (SEQ / 128)), h = rem / (SEQ / 128), qt = rem % (SEQ / 128);
            attn_tile(p, l, b, h, b * SEQ + qt * 128, false, lds); }
        else { const int a = it - 128 - n_att_l, b = a / (4 * (CTXL / 128)), rem = a % (4 * (CTXL / 128)), h = rem / (CTXL / 128), qt = rem % (CTXL / 128);
            attn_tile(p, l, b, h, TL + b * CTXL + qt * 128, true, lds); }
    }
}

__device__ __forceinline__ void phase_post(const P& p, int l, int nrows, int gw, int NGW, int lane) {
    bf16_t* OA = (bf16_t*)(p.ws + WS_H); bf16_t* OB = (bf16_t*)(p.ws + WS_PAQ);
    const bf16_t* PZ = (const bf16_t*)(p.ws + WS_PZ); const bf16_t* PB = (const bf16_t*)(p.ws + WS_PB);
    for (int it = gw; it < nrows * 8; it += NGW) {
        const int r = it >> 3, br = (it >> 2) & 1, h = it & 3, col = h * 128 + 2 * lane;
        bf16_t* O = br ? OB : OA;
        const unsigned a = *(const unsigned*)(O + (size_t)r * 512 + col), bq = *(const unsigned*)(O + ((size_t)T + r) * 512 + col);
        const unsigned zz = br ? *(const unsigned*)(PB + (size_t)r * 1536 + 1024 + col) : *(const unsigned*)(PZ + (size_t)r * 512 + col);
        const float o0 = bflo(a) + bflo(bq), o1 = bfhi(a) + bfhi(bq);
        const float rs = 1.0f / sqrtf(wave_sum(o0 * o0 + o1 * o1) * (1.0f / 128.0f) + EPS);
        const float* gn = (br ? p.gn_b : p.gn_a) + l * 128 + 2 * lane;
        *(unsigned*)(O + (size_t)r * 512 + col) = pk2(o0 * rs * gn[0] * siluf_(bflo(zz)), o1 * rs * gn[1] * siluf_(bfhi(zz)));
    }
}

__device__ __forceinline__ void phase_moe_tables(const P& p, int tid) {
    const unsigned* ecnt = (const unsigned*)(p.ws + WS_CTL) + CW_ECNT; int* misc = (int*)(p.ws + WS_MISC);
    if (blockIdx.x == 0 && tid == 0) { int off = 0, nt = 0;
        for (int e = 0; e < NE; ++e) { misc[MI_EOFF + e] = off; const int tl = ((int)ecnt[e] + 255) / 256; for (int q = 0; q < tl; ++q) misc[MI_TILEE + nt + q] = e; nt += tl; off += tl * 256; }
        misc[MI_EOFF + NE] = off; misc[MI_NTILES] = nt; }
}
__device__ __forceinline__ void phase_moe_gather(const P& p, int gw, int NGW, int lane) {
    const int* route = (const int*)(p.ws + WS_ROUTE); int* slots = (int*)(p.ws + WS_SLOT); const int* misc = (const int*)(p.ws + WS_MISC);
    unsigned* efill = (unsigned*)(p.ws + WS_CTL) + CW_EFILL;
    const bf16_t* H = (const bf16_t*)(p.ws + WS_H); bf16_t* MA = (bf16_t*)(p.ws + WS_MA);
    for (int it = gw; it < TL * 2; it += NGW) { const int r = it >> 1, k = it & 1, e = route[r * 4 + k];
        int s = 0; if (lane == 0) s = misc[MI_EOFF + e] + (int)atomicAdd(efill + e, 1u);
        s = __shfl(s, 0);
        if (lane == 0) slots[r * 2 + k] = s;
        const u32x4* src = (const u32x4*)(H + (size_t)r * D); u32x4* dst = (u32x4*)(MA + (size_t)s * D);
        dst[lane] = src[lane]; dst[lane + 64] = src[lane + 64]; }
}
__device__ __forceinline__ void phase_final(const P& p, int gw, int NGW, int lane) {
    const int* route = (const int*)(p.ws + WS_ROUTE); const int* slots = (const int*)(p.ws + WS_SLOT); const bf16_t* Y = (const bf16_t*)(p.ws + WS_MA);
    const float* MOD = (const float*)(p.ws + WS_MOD) + (size_t)1 * 9 * 6144;
    for (int r = gw; r < TL; r += NGW) { const int b = r / SEQ; const float w1 = ((const float*)route)[r * 4 + 2], w2 = ((const float*)route)[r * 4 + 3];
        const bf16_t* y1 = Y + (size_t)slots[r * 2] * D, *y2 = Y + (size_t)slots[r * 2 + 1] * D; float* xr = p.out + (size_t)r * D; const float* g2 = MOD + (size_t)b * 6144 + 5 * 1024;
        f32x4 v[4]; float ss = 0.f;
#pragma unroll
        for (int j = 0; j < 4; ++j) { const int c = 4 * lane + 256 * j; const u32x2 a = *(const u32x2*)(y1 + c), bq = *(const u32x2*)(y2 + c); const f32x4 g = *(const f32x4*)(g2 + c);
            f32x4 y; y[0] = w1 * bflo(a.x) + w2 * bflo(bq.x); y[1] = w1 * bfhi(a.x) + w2 * bfhi(bq.x); y[2] = w1 * bflo(a.y) + w2 * bflo(bq.y); y[3] = w1 * bfhi(a.y) + w2 * bfhi(bq.y);
            v[j] = *(const f32x4*)(xr + c) + g * y; ss += (v[j][0] * v[j][0] + v[j][1] * v[j][1]) + (v[j][2] * v[j][2] + v[j][3] * v[j][3]); }
        const float rs = 1.0f / sqrtf(wave_sum(ss) * (1.0f / D) + EPS);
#pragma unroll
        for (int j = 0; j < 4; ++j) { const int c = 4 * lane + 256 * j; *(f32x4*)(xr + c) = v[j] * rs * *(const f32x4*)(p.final_g + c); }
    }
}

__device__ __forceinline__ void convert_up(const float* w1, const float* w3, int ne, bf16_t* up, float* scr, int gw, int NGW, int lane) {
    const int nblk = NUP / 32, items_e = (D / 64) * nblk;
    for (int it = gw; it < ne * items_e; it += NGW) {
        const int e = it / items_e, ie = it % items_e, kb = ie / nblk, nb = ie % nblk, k0 = 64 * kb, n0 = 32 * nb, n = n0 + (lane & 31), tile = n >> 8, rr = n & 255;
        const float* W = (rr < 128 ? w1 : w3) + (size_t)e * D * DFF; const int sc = tile * 128 + (rr & 127);
#pragma unroll 8
        for (int i = 0; i < 32; ++i) { const int kk = 2 * i + (lane >> 5); scr[kk * 33 + (lane & 31)] = W[(size_t)(k0 + kk) * DFF + sc]; }
        asm volatile("s_waitcnt lgkmcnt(0)" ::: "memory");
        const int c = lane & 7;
#pragma unroll
        for (int j = 0; j < 4; ++j) { const int nn = (lane >> 3) + 8 * j; const float* s = scr + (8 * c) * 33 + nn;
            u32x4 o; o.x = pk2(s[0 * 33], s[1 * 33]); o.y = pk2(s[2 * 33], s[3 * 33]); o.z = pk2(s[4 * 33], s[5 * 33]); o.w = pk2(s[6 * 33], s[7 * 33]);
            *(u32x4*)(up + ((size_t)e * NUP + n0 + nn) * D + k0 + 8 * c) = o; }
        asm volatile("s_waitcnt lgkmcnt(0)" ::: "memory");
    }
}
typedef __attribute__((address_space(4))) const P* KArgs;
#define LOADP(p) asm volatile("" : "+s"(kp)); P p; __builtin_memcpy(&p, kp, sizeof(P))
__global__ void __launch_bounds__(NTHREADS, 2) mk_fwd(P p_unused) {
    extern __shared__ __attribute__((aligned(16))) unsigned char lds[];
    cg::grid_group grid = cg::this_grid();
    KArgs kp = (KArgs)__builtin_amdgcn_kernarg_segment_ptr();
    const int G = gridDim.x, NGW = G * NWAVES;
#define IDS() const int tid = otid(), lane = tid & 63, wave = __builtin_amdgcn_readfirstlane(tid >> 6), gw = blockIdx.x * NWAVES + wave; (void)tid; (void)lane; (void)gw; (void)wave
    PG8_LAS unsigned char* glds = (PG8_LAS unsigned char*)lds;

    {
        LOADP(p); IDS(); unsigned char* ws = p.ws;
        float* scr = (float*)(lds + 49152) + wave * (64 * 33);
        for (int l = 0; l < DEPTH; ++l) {
            convert_T(p.w_in + (size_t)l * D * 8240, D, 8240, (bf16_t*)(ws + WB_WIN + l * WIN_BYTES), NIN, CmWin(), scr, (gw + 37 * l) % NGW, NGW, lane);
            convert_T(p.w_o_a + (size_t)l * 512 * D, 512, D, (bf16_t*)(ws + WB_WO + (l * 3 + 0) * WO_BYTES), D, CmIdent(), scr, (gw + 300 + 700 * l) % NGW, NGW, lane);
            convert_T(p.w_o_b + (size_t)l * 512 * D, 512, D, (bf16_t*)(ws + WB_WO + (l * 3 + 1) * WO_BYTES), D, CmIdent(), scr, (gw + 556 + 700 * l) % NGW, NGW, lane);
            convert_T(p.w_o_c + (size_t)l * 512 * D, 512, D, (bf16_t*)(ws + WB_WO + (l * 3 + 2) * WO_BYTES), D, CmIdent(), scr, (gw + 812 + 700 * l) % NGW, NGW, lane);
            convert_T(p.w_out + (size_t)l * D * D, D, D, (bf16_t*)(ws + WB_WOUT + l * WOUT_BYTES), D, CmIdent(), scr, (gw + 1068 + 512 * l) % NGW, NGW, lane);
        }
        convert_up(p.ffn_w1, p.ffn_w3, 1, (bf16_t*)(ws + WB_WUP), scr, (gw + 1500) % NGW, NGW, lane);
        convert_T(p.ffn_w2, DFF, D, (bf16_t*)(ws + WB_WDN), D, CmIdent(), scr, (gw + 900) % NGW, NGW, lane);
        __syncthreads();
        phase_mod(p, lds);
    }
    grid.sync();

    for (int l = 0; l < DEPTH; ++l) {
        const bool last = (l == DEPTH - 1);
        const int Mrows = last ? TL : T;
        { LOADP(p); IDS(); unsigned char* ws = p.ws;
          phase_modulate(l == 0 ? p.x : p.out, l == 0 ? p.ctx : (const float*)(ws + WS_XC), T, p.norm1_g + l * D, (const float*)(ws + WS_MOD) + (size_t)l * 9 * 6144, 0, (bf16_t*)(ws + WS_H), nullptr, nullptr, nullptr, gw, NGW, lane); }
        grid.sync();
        { LOADP(p); unsigned char* ws = p.ws;
            pg8::Gemm g{(const bf16_t*)(ws + WS_H), (const bf16_t*)(ws + WB_WIN + l * WIN_BYTES), T, NIN, D, D}; pg8::StaticOrder S; S.init(T, NIN, G, (int)blockIdx.x);
            EpiWin E{(bf16_t*)(ws + WS_PAQ), (bf16_t*)(ws + WS_PZ), (bf16_t*)(ws + WS_PB), (bf16_t*)(ws + WS_PC), (bf16_t*)(ws + WS_PG), (float*)(ws + WS_SMALL)};
            pg8::gemm_phase<EpiWin, pg8::StaticOrder, true, true>(glds, g, S, E);
        }
        grid.sync();
        { LOADP(p); IDS(); phase_prep(p, l, gw, NGW, lane); }
        grid.sync();
        { LOADP(p); phase_mix(p, l, lds); }
        grid.sync();
        { LOADP(p); IDS(); phase_post(p, l, Mrows, gw, NGW, lane); }
        grid.sync();
        for (int br = 0; br < 3; ++br) {
            LOADP(p); unsigned char* ws = p.ws;
            const bf16_t* A = br == 0 ? (const bf16_t*)(ws + WS_H) : br == 1 ? (const bf16_t*)(ws + WS_PAQ) : (const bf16_t*)(ws + WS_PC);
            pg8::Gemm g{A, (const bf16_t*)(ws + WB_WO + (l * 3 + br) * WO_BYTES), Mrows, D, 512, br == 2 ? 1536 : 512}; pg8::StaticOrder S; S.init(Mrows, D, G, (int)blockIdx.x);
            EpiGate E{(bf16_t*)(ws + WS_DNQKV), (const bf16_t*)(ws + WS_PG), br};
            pg8::gemm_phase<EpiGate, pg8::StaticOrder, true, true>(glds, g, S, E);
            __syncthreads();
        }
        grid.sync();
        { LOADP(p); unsigned char* ws = p.ws;
            pg8::Gemm g{(const bf16_t*)(ws + WS_DNQKV), (const bf16_t*)(ws + WB_WOUT + l * WOUT_BYTES), Mrows, D, D, D}; pg8::StaticOrder S; S.init(Mrows, D, G, (int)blockIdx.x);
            EpiResid E{l == 0 ? p.x : p.out, l == 0 ? p.ctx : (const float*)(ws + WS_XC), p.out, (float*)(ws + WS_XC), (const float*)(ws + WS_MOD) + (size_t)l * 9 * 6144, 2};
            pg8::gemm_phase<EpiResid, pg8::StaticOrder, true, true>(glds, g, S, E);
        }
        grid.sync();
        { LOADP(p); IDS(); unsigned char* ws = p.ws;
          phase_modulate(p.out, (const float*)(ws + WS_XC), Mrows, p.norm2_g + l * D, (const float*)(ws + WS_MOD) + (size_t)l * 9 * 6144, 3, (bf16_t*)(ws + WS_H), last ? p.router_w : nullptr, (int*)(ws + WS_ROUTE), (unsigned*)(ws + WS_CTL) + CW_ECNT, gw, NGW, lane); }
        if (!last) {
            grid.sync();
            { LOADP(p); unsigned char* ws = p.ws;
                pg8::Gemm g{(const bf16_t*)(ws + WS_H), (const bf16_t*)(ws + WB_WUP), T, NUP, D, D}; pg8::StaticOrder S; S.init(T, NUP, G, (int)blockIdx.x);
                EpiSwiglu E{(bf16_t*)(ws + WS_H1), NUP / 256};
                pg8::gemm_phase<EpiSwiglu, pg8::StaticOrder, true, true>(glds, g, S, E);
            }
            grid.sync();
            { LOADP(p); unsigned char* ws = p.ws;
                pg8::Gemm g{(const bf16_t*)(ws + WS_H1), (const bf16_t*)(ws + WB_WDN), T, D, DFF, DFF}; pg8::StaticOrder S; S.init(T, D, G, (int)blockIdx.x);
                EpiResid E{p.out, (const float*)(ws + WS_XC), p.out, (float*)(ws + WS_XC), (const float*)(ws + WS_MOD) + (size_t)l * 9 * 6144, 5};
                pg8::gemm_phase<EpiResid, pg8::StaticOrder, true, true>(glds, g, S, E);
            }
            grid.sync();
        } else {
            { LOADP(p); IDS(); unsigned char* ws = p.ws;
                float* scr = (float*)lds + wave * (64 * 33);
                convert_up(p.moe_w1, p.moe_w3, NE, (bf16_t*)(ws + WS_MWUP), scr, gw, NGW, lane);
                for (int e = 0; e < NE; ++e)
                    convert_T(p.moe_w2 + (size_t)e * DFF * D, DFF, D, (bf16_t*)(ws + WS_MWDN) + (size_t)e * D * DFF, D, CmIdent(), scr, (gw + 173 * e) % NGW, NGW, lane);
            }
            grid.sync();
            { LOADP(p); IDS(); phase_moe_tables(p, tid); }
            grid.sync();
            { LOADP(p); IDS(); phase_moe_gather(p, gw, NGW, lane); }
            grid.sync();
            { LOADP(p); unsigned char* ws = p.ws; const int* misc = (const int*)(ws + WS_MISC);
                pg8::Gemm g{(const bf16_t*)(ws + WS_MA), (const bf16_t*)(ws + WS_MWUP), MOE_ROWS, NE * NUP, D, D};
                MoeOrder S{misc[MI_NTILES], NUP / 256, G, (int)blockIdx.x, misc + MI_TILEE};
                EpiSwiglu E{(bf16_t*)(ws + WS_MH1), NUP / 256};
                pg8::gemm_phase<EpiSwiglu, MoeOrder, true, true>(glds, g, S, E);
            }
            grid.sync();
            { LOADP(p); unsigned char* ws = p.ws; const int* misc = (const int*)(ws + WS_MISC);
                pg8::Gemm g{(const bf16_t*)(ws + WS_MH1), (const bf16_t*)(ws + WS_MWDN), MOE_ROWS, NE * D, DFF, DFF};
                MoeOrder S{misc[MI_NTILES], D / 256, G, (int)blockIdx.x, misc + MI_TILEE};
                EpiMoeDown E{(bf16_t*)(ws + WS_MA)};
                pg8::gemm_phase<EpiMoeDown, MoeOrder, true, true>(glds, g, S, E);
            }
            grid.sync();
            { LOADP(p); IDS(); phase_final(p, gw, NGW, lane); }
        }
    }
}

extern "C" void kernel_launch(void* const* d_in, const int* in_sizes, int n_in, void* d_out, int out_size, void* d_ws, size_t ws_size, hipStream_t stream) {
    static int grid_blocks = 0;
    if (grid_blocks == 0) {
        if (n_in != 30 || in_sizes[0] != TL * D || out_size != TL * D || ws_size < WS_END) {
            fprintf(stderr, "kernel_launch: built for 30 inputs, x/out of %d floats, >= %zu bytes of d_ws; got n_in %d, in0 %d, out %d, ws %zu; nothing launched\n", TL * D, (size_t)WS_END, n_in, n_in > 0 ? in_sizes[0] : -1, out_size, ws_size);
            grid_blocks = -1; return; }
        int dev = 0, cus = 0, per_cu = 0;
        hipGetDevice(&dev);
        hipDeviceGetAttribute(&cus, hipDeviceAttributeMultiprocessorCount, dev);
        hipFuncSetAttribute((const void*)mk_fwd, hipFuncAttributeMaxDynamicSharedMemorySize, LDS_BYTES);
        hipOccupancyMaxActiveBlocksPerMultiprocessor(&per_cu, (const void*)mk_fwd, NTHREADS, LDS_BYTES);
        if (per_cu < 1) { fprintf(stderr, "kernel_launch: occupancy query reports %d blocks/CU; nothing launched\n", per_cu); grid_blocks = -1; return; }
        grid_blocks = cus;
    }
    if (grid_blocks < 0) return;
    hipMemsetAsync((char*)d_ws + WS_CTL, 0, CTL_BYTES, stream);
    P p{};
    const float** f = (const float**)&p;
    for (int i = 0; i < 30; ++i) f[i] = (const float*)d_in[i];
    p.out = (float*)d_out; p.ws = (unsigned char*)d_ws;
    void* args[] = {&p};
    hipError_t e = hipLaunchCooperativeKernel((const void*)mk_fwd, dim3(grid_blocks), dim3(NTHREADS), args, LDS_BYTES, stream);
    if (e != hipSuccess) fprintf(stderr, "kernel_launch: cooperative launch failed: %s (grid %d)\n", hipGetErrorString(e), grid_blocks);
}
```

```cpp
#include <hip/hip_runtime.h>
#include <hip/hip_cooperative_groups.h>
#include <cstdio>
#include <cstdint>
namespace cg = cooperative_groups;

namespace pg8 {
#define PG8_LAS __attribute__((address_space(3)))
typedef unsigned short bf16_t;
typedef short bf16x8 __attribute__((ext_vector_type(8)));
typedef float f32x4 __attribute__((ext_vector_type(4)));
typedef unsigned u32x4 __attribute__((ext_vector_type(4)));
constexpr int BM = 256, BK = 64, HALF = 128, HTB = HALF * BK * 2  , STAGE_BYTES = 8 * HTB, NXCD = 8, WGM = 8;

__host__ __device__ __forceinline__ int lds_byte(int r, int c) { const int st = (r >> 4) * 2 + (c >> 5), rr = r & 15, cc = c & 31, ob = rr * 64 + cc * 2; return st * 1024 + (ob ^ (((ob >> 9) & 1) << 5)); }
__host__ __device__ __forceinline__ void stage_rc(int b, int& R, int& C) { const int st = b / 1024, sb = b % 1024, swz = sb ^ (((sb >> 9) & 1) << 5); R = (st >> 1) * 16 + swz / 64; C = (st & 1) * 32 + (swz % 64) / 2; }
__host__ __device__ __forceinline__ int perm32(int rho) { const int n = rho >> 4, i = rho & 15; return 8 * (i >> 2) + 4 * n + (i & 3); }

struct Unit { int pm, pn; };
struct Gemm { const bf16_t* A; const bf16_t* Bt; int M, N, K, lda; };

struct StaticOrder {
    int nM, nN, nwg, G, c;
    __host__ __device__ void init(int M, int N, int G_, int c_) { nM = M / BM; nN = N / BM; nwg = nM * nN; G = G_; c = c_; }
    __host__ __device__ bool next(int i, Unit& u) const {
        const long L = (long)i * G + c; if (L >= nwg) return false;
        int wgid = (int)L; { const int q = nwg / NXCD, r = nwg % NXCD, xcd = wgid % NXCD, off = wgid / NXCD; wgid = (xcd < r ? xcd * (q + 1) : r * (q + 1) + (xcd - r) * q) + off; }
        const int nig = WGM * nN, gid = wgid / nig, fm = gid * WGM, gsz = (nM - fm) < WGM ? (nM - fm) : WGM;
        u.pm = fm + ((wgid % nig) % gsz); u.pn = (wgid % nig) / gsz; return true;
    }
    __device__ __forceinline__ void a_ready(const Unit&) const {}
    __device__ __forceinline__ void done(const Unit&) const {}
};


template <class Epi, class Sched, bool ALIGN_EPI = false, bool SP2 = false>
__device__ __forceinline__ void gemm_phase(PG8_LAS unsigned char* lds, const Gemm g, const Sched& S, const Epi& E) {
    int tid_o = threadIdx.x; asm volatile("" : "+v"(tid_o));
    const int tid = tid_o, wid = __builtin_amdgcn_readfirstlane(tid >> 6), lane = tid & 63, wr = wid >> 2, wc = wid & 3, fr = lane & 15, fq = lane >> 4;
    const int K = g.K, nt = K / BK;
    unsigned voffA[2], voffB[2];
#pragma unroll
    for (int i = 0; i < 2; ++i) { int R, C; stage_rc(tid * 16 + i * 8192, R, C); const int Rb = Epi::PERM ? ((R & ~31) + perm32(R & 31)) : R;
        voffA[i] = (unsigned)(R * g.lda + C) * 2u; voffB[i] = (unsigned)(Rb * K + C) * 2u; }
    const size_t kstep = (size_t)(BK * 2);
    const size_t hstepA = (size_t)HALF * g.lda * 2, hstepB = (size_t)HALF * K * 2;
    const size_t tstepA = 2 * hstepA, tstepB = 2 * hstepB;
    const unsigned ldsw = (unsigned)wid * 1024u;
    const int aoff = lds_byte(wr * 64 + fr, fq * 8), boff = lds_byte(wc * 32 + fr, fq * 8);
#define PG8_SA(b, h) (((b) * 2 + (h)) * HTB)
#define PG8_SB(b, h) ((4 + (b) * 2 + (h)) * HTB)
#define PG8_STAGE(bufoff, gbase, voff) do { _Pragma("unroll") for (int _i = 0; _i < 2; ++_i) \
        __builtin_amdgcn_global_load_lds((const unsigned*)((const char*)(gbase) + (voff)[_i]), (PG8_LAS unsigned*)(lds + (bufoff) + ldsw + _i * 8192), 16, 0, 0); } while (0)
#define PG8_LDA(dst, b, h) do { _Pragma("unroll") for (int m = 0; m < 4; ++m) _Pragma("unroll") for (int k = 0; k < 2; ++k) dst[m][k] = *(const PG8_LAS bf16x8*)(lds + PG8_SA(b, h) + aoff + m * 2048 + k * 1024); } while (0)
#define PG8_LDB(dst, b, h) do { _Pragma("unroll") for (int n = 0; n < 2; ++n) _Pragma("unroll") for (int k = 0; k < 2; ++k) dst[n][k] = *(const PG8_LAS bf16x8*)(lds + PG8_SB(b, h) + boff + n * 2048 + k * 1024); } while (0)
#define PG8_MMA(ai, bj, At, Bt) do { __builtin_amdgcn_s_setprio(1); _Pragma("unroll") for (int m = 0; m < 4; ++m) _Pragma("unroll") for (int n = 0; n < 2; ++n) _Pragma("unroll") for (int k = 0; k < 2; ++k) \
        acc[ai][bj][m][n] = __builtin_amdgcn_mfma_f32_16x16x32_bf16(Bt[n][k], At[m][k], acc[ai][bj][m][n], 0, 0, 0); __builtin_amdgcn_s_setprio(0); } while (0)
#define PG8_WAIT_V(n) asm volatile("s_waitcnt vmcnt(" #n ")" ::: "memory")
#define PG8_WAIT_L(n) asm volatile("s_waitcnt lgkmcnt(" #n ")" ::: "memory")
#define PG8_BAR __builtin_amdgcn_s_barrier()
#define PG8_SCHED __builtin_amdgcn_sched_barrier(0)
    Unit cur, nxt; int ui = 0;
    if (!S.next(0, cur)) return;
    f32x4 acc[2][2][4][2];
#pragma unroll
    for (int a = 0; a < 2; ++a)
#pragma unroll
        for (int b = 0; b < 2; ++b)
#pragma unroll
            for (int m = 0; m < 4; ++m)
#pragma unroll
                for (int n = 0; n < 2; ++n) acc[a][b][m][n] = (f32x4){0.f, 0.f, 0.f, 0.f};
    bf16x8 At[4][2], B0[2][2], B1[2][2];
    const char* cA = (const char*)g.A + (size_t)cur.pm * tstepA; const char* cB = (const char*)g.Bt + (size_t)cur.pn * tstepB;
    S.a_ready(cur);
    if constexpr (SP2) {
        PG8_STAGE(PG8_SB(0, 0), cB, voffB); PG8_STAGE(PG8_SB(0, 1), cB + hstepB, voffB); PG8_STAGE(PG8_SA(0, 0), cA, voffA); PG8_STAGE(PG8_SA(0, 1), cA + hstepA, voffA);
        if (wr == 1) PG8_BAR;
        PG8_WAIT_V(2); PG8_BAR;
        PG8_STAGE(PG8_SB(1, 0), cB + kstep, voffB); PG8_STAGE(PG8_SA(1, 0), cA + kstep, voffA); PG8_STAGE(PG8_SB(1, 1), cB + hstepB + kstep, voffB);
        PG8_WAIT_V(6); PG8_BAR;
    } else {
        PG8_STAGE(PG8_SB(0, 0), cB, voffB); PG8_STAGE(PG8_SA(0, 0), cA, voffA); PG8_STAGE(PG8_SB(0, 1), cB + hstepB, voffB); PG8_STAGE(PG8_SA(0, 1), cA + hstepA, voffA);
        if (wr == 1) PG8_BAR;
        PG8_WAIT_V(4); PG8_BAR;
        PG8_STAGE(PG8_SB(1, 0), cB + kstep, voffB); PG8_STAGE(PG8_SA(1, 0), cA + kstep, voffA); PG8_STAGE(PG8_SB(1, 1), cB + hstepB + kstep, voffB);
        PG8_WAIT_V(6); PG8_BAR;
    }
    for (;;) {
        const bool has_next = S.next(ui + 1, nxt);
        const char* nA = has_next ? (const char*)g.A + (size_t)nxt.pm * tstepA : cA; const char* nB = has_next ? (const char*)g.Bt + (size_t)nxt.pn * tstepB : cB;
        for (int t = 0; t < nt; t += 2) {
            const bool last = (t == nt - 2);
            const char* a1 = cA + (size_t)(t + 1) * kstep;
            const char* a2 = last ? nA : cA + (size_t)(t + 2) * kstep; const char* b2 = last ? nB : cB + (size_t)(t + 2) * kstep;
            const char* a3 = a2 + kstep; const char* b3 = b2 + kstep;
            if (last && has_next) S.a_ready(nxt);
            if constexpr (SP2) {
            PG8_LDB(B0, 0, 0); PG8_LDB(B1, 0, 1); PG8_SCHED; PG8_LDA(At, 0, 0); PG8_STAGE(PG8_SA(1, 1), a1 + hstepA, voffA);
            PG8_WAIT_V(8); PG8_WAIT_L(0); PG8_BAR; PG8_MMA(0, 0, At, B0); PG8_MMA(0, 1, At, B1); PG8_BAR; PG8_SCHED;
            PG8_LDA(At, 0, 1); PG8_STAGE(PG8_SB(0, 0), b2, voffB); PG8_STAGE(PG8_SB(0, 1), b2 + hstepB, voffB); PG8_STAGE(PG8_SA(0, 0), a2, voffA);
            PG8_WAIT_V(8); PG8_WAIT_L(0); PG8_BAR; PG8_MMA(1, 0, At, B0); PG8_MMA(1, 1, At, B1); PG8_BAR; PG8_SCHED;
            PG8_LDB(B0, 1, 0); PG8_LDB(B1, 1, 1); PG8_SCHED; PG8_LDA(At, 1, 0); PG8_STAGE(PG8_SA(0, 1), a2 + hstepA, voffA);
            PG8_WAIT_V(8); PG8_WAIT_L(0); PG8_BAR; PG8_MMA(0, 0, At, B0); PG8_MMA(0, 1, At, B1); PG8_BAR; PG8_SCHED;
            PG8_LDA(At, 1, 1); PG8_STAGE(PG8_SB(1, 0), b3, voffB); PG8_STAGE(PG8_SB(1, 1), b3 + hstepB, voffB); PG8_STAGE(PG8_SA(1, 0), a3, voffA);
            PG8_WAIT_V(8); PG8_WAIT_L(0); PG8_BAR; PG8_MMA(1, 0, At, B0); PG8_MMA(1, 1, At, B1); PG8_BAR; PG8_SCHED;
            } else {
            PG8_LDB(B0, 0, 0); PG8_SCHED; PG8_LDA(At, 0, 0); PG8_STAGE(PG8_SA(1, 1), a1 + hstepA, voffA);
            PG8_WAIT_L(8); PG8_BAR; PG8_WAIT_L(0); PG8_MMA(0, 0, At, B0); PG8_BAR; PG8_SCHED;
            PG8_LDB(B1, 0, 1); PG8_STAGE(PG8_SB(0, 0), b2, voffB);
            PG8_BAR; PG8_WAIT_L(0); PG8_MMA(0, 1, At, B1); PG8_BAR;
            PG8_LDA(At, 0, 1); PG8_STAGE(PG8_SA(0, 0), a2, voffA);
            PG8_BAR; PG8_WAIT_L(0); PG8_MMA(1, 0, At, B0); PG8_BAR; PG8_SCHED;
            PG8_STAGE(PG8_SB(0, 1), b2 + hstepB, voffB);
            PG8_WAIT_V(6); PG8_BAR; PG8_MMA(1, 1, At, B1); PG8_BAR;
            PG8_LDB(B0, 1, 0); PG8_SCHED; PG8_LDA(At, 1, 0); PG8_STAGE(PG8_SA(0, 1), a2 + hstepA, voffA);
            PG8_WAIT_L(8); PG8_BAR; PG8_WAIT_L(0); PG8_MMA(0, 0, At, B0); PG8_BAR; PG8_SCHED;
            PG8_LDB(B1, 1, 1); PG8_STAGE(PG8_SB(1, 0), b3, voffB);
            PG8_BAR; PG8_WAIT_L(0); PG8_MMA(0, 1, At, B1); PG8_BAR;
            PG8_LDA(At, 1, 1); PG8_STAGE(PG8_SA(1, 0), a3, voffA);
            PG8_BAR; PG8_WAIT_L(0); PG8_MMA(1, 0, At, B0); PG8_BAR; PG8_SCHED;
            PG8_STAGE(PG8_SB(1, 1), b3 + hstepB, voffB);
            PG8_WAIT_V(6); PG8_BAR; PG8_MMA(1, 1, At, B1); PG8_BAR;
            }
        }
        if constexpr (ALIGN_EPI) { if (wr == 0) PG8_BAR; }
        if constexpr (!Epi::AFTER_DRAIN) { E(acc, cur, wr, wc, fr, fq); S.done(cur); }
        if (!has_next) break;
#pragma unroll
        for (int a = 0; a < 2; ++a)
#pragma unroll
            for (int b = 0; b < 2; ++b)
#pragma unroll
                for (int m = 0; m < 4; ++m)
#pragma unroll
                    for (int n = 0; n < 2; ++n) acc[a][b][m][n] = (f32x4){0.f, 0.f, 0.f, 0.f};
        cur = nxt; cA = nA; cB = nB; ++ui;
        if constexpr (ALIGN_EPI) { if (wr == 1) PG8_BAR; }
    }
    PG8_WAIT_V(0);
    if constexpr (!ALIGN_EPI) { if (wr == 0) PG8_BAR; }
    PG8_BAR;
    if constexpr (Epi::AFTER_DRAIN) { E.fused(acc, cur, wr, wc, fr, fq, lds, wid, lane); S.done(cur); }
#undef PG8_SA
#undef PG8_SB
#undef PG8_STAGE
#undef PG8_LDA
#undef PG8_LDB
#undef PG8_MMA
#undef PG8_WAIT_V
#undef PG8_WAIT_L
#undef PG8_BAR
#undef PG8_SCHED
}
}


constexpr int BATCH = 8, SEQ = 2048, CTXL = 256, D = 1024, DEPTH = 2;
constexpr int TL = BATCH * SEQ, TC = BATCH * CTXL, T = TL + TC;
constexpr int NIN = 8448;
constexpr int DFF = 2816, NE = 8, NUP = 2 * DFF;
constexpr int MOE_ROWS = 2 * TL + NE * 256;
constexpr float EPS = 1e-6f;
constexpr int NTHREADS = 512, NWAVES = 8;
constexpr int LDS_BYTES = 147456;

typedef unsigned short bf16_t;
typedef float f32x4 __attribute__((ext_vector_type(4)));
typedef float f32x16 __attribute__((ext_vector_type(16)));
typedef unsigned u32x4 __attribute__((ext_vector_type(4)));
typedef unsigned u32x2 __attribute__((ext_vector_type(2)));
typedef short bf16x8 __attribute__((ext_vector_type(8)));
typedef short s16x4 __attribute__((ext_vector_type(4)));

constexpr size_t al256(size_t x) { return (x + 255) & ~(size_t)255; }
constexpr size_t WS_CTL   = 0;                                   constexpr size_t CTL_BYTES = 65536;
constexpr size_t WS_MOD   = WS_CTL + CTL_BYTES;                  constexpr size_t MOD_BYTES = (size_t)DEPTH * 9 * 6 * D * 4;
constexpr size_t WS_ROUTE = al256(WS_MOD + MOD_BYTES);           constexpr size_t ROUTE_BYTES = (size_t)TL * 16;
constexpr size_t WS_SLOT  = al256(WS_ROUTE + ROUTE_BYTES);       constexpr size_t SLOT_BYTES = (size_t)TL * 8;
constexpr size_t WS_MISC  = al256(WS_SLOT + SLOT_BYTES);         constexpr size_t MISC_BYTES = 4096;
constexpr size_t WS_GB    = al256(WS_MISC + MISC_BYTES);         constexpr size_t GB_BYTES = (size_t)T * 16 * 4;
constexpr size_t WS_SMALL = al256(WS_GB + GB_BYTES);             constexpr size_t SMALL_BYTES = (size_t)T * 64 * 4;
constexpr size_t WS_XC    = al256(WS_SMALL + SMALL_BYTES);       constexpr size_t XC_BYTES = (size_t)TC * D * 4;
constexpr size_t WS_WB    = al256(WS_XC + XC_BYTES);
constexpr size_t WB_WIN   = WS_WB;                               constexpr size_t WIN_BYTES = (size_t)NIN * D * 2;
constexpr size_t WB_WO    = WB_WIN + DEPTH * WIN_BYTES;          constexpr size_t WO_BYTES = (size_t)D * 512 * 2;
constexpr size_t WB_WOUT  = WB_WO + DEPTH * 3 * WO_BYTES;        constexpr size_t WOUT_BYTES = (size_t)D * D * 2;
constexpr size_t WB_WUP   = WB_WOUT + DEPTH * WOUT_BYTES;        constexpr size_t WUP_BYTES = (size_t)NUP * D * 2;
constexpr size_t WB_WDN   = WB_WUP + WUP_BYTES;                  constexpr size_t WDN_BYTES = (size_t)D * DFF * 2;
constexpr size_t WB_END   = WB_WDN + WDN_BYTES;
constexpr size_t WS_H     = al256(WB_END);                       constexpr size_t H_BYTES = (size_t)T * D * 2;
constexpr size_t WS_PAQ   = al256(WS_H + H_BYTES);               constexpr size_t PAQ_BYTES = (size_t)T * 1536 * 2;
constexpr size_t WS_PZ    = al256(WS_PAQ + PAQ_BYTES);           constexpr size_t PZ_BYTES = (size_t)T * 512 * 2;
constexpr size_t WS_PB    = al256(WS_PZ + PZ_BYTES);             constexpr size_t PB_BYTES = (size_t)T * 1536 * 2;
constexpr size_t WS_PC    = al256(WS_PB + PB_BYTES);             constexpr size_t PC_BYTES = (size_t)T * 1536 * 2;
constexpr size_t WS_PG    = al256(WS_PC + PC_BYTES);             constexpr size_t PG_BYTES = (size_t)T * 3072 * 2;
constexpr size_t WS_DNQKV = al256(WS_PG + PG_BYTES);             constexpr size_t DNQKV_BYTES = (size_t)T * 1536 * 2;
constexpr size_t WS_TQ    = al256(WS_DNQKV + DNQKV_BYTES);       constexpr size_t TQ_BYTES = (size_t)BATCH * 4 * 2 * ((CTXL + SEQ) / 64) * 16384;
constexpr size_t WS_VEC   = al256(WS_TQ + TQ_BYTES);             constexpr size_t VEC_BYTES = (size_t)BATCH * 4 * 2 * ((CTXL + SEQ) / 64) * 1024;
constexpr size_t WS_END   = al256(WS_VEC + VEC_BYTES);
static_assert(WS_END <= (size_t)524288000, "d_ws map exceeds 500 MiB (documented minimum is 525,980,800 B)");
constexpr size_t WS_H1    = WS_PB;
static_assert((size_t)T * DFF * 2 <= PB_BYTES + PC_BYTES, "h1 overlay");
constexpr size_t WS_MWDN  = WS_WB;                                constexpr size_t MWDN_BYTES = (size_t)NE * D * DFF * 2;
static_assert(MWDN_BYTES <= WB_END - WS_WB, "moe wdn overlay");
constexpr size_t WS_MWUP  = WS_PAQ;                               constexpr size_t MWUP_BYTES = (size_t)NE * NUP * D * 2;
constexpr size_t WS_MA    = al256(WS_MWUP + MWUP_BYTES);          constexpr size_t MA_BYTES = (size_t)MOE_ROWS * D * 2;
constexpr size_t WS_MH1   = al256(WS_MA + MA_BYTES);              constexpr size_t MH1_BYTES = (size_t)MOE_ROWS * DFF * 2;
static_assert(WS_MH1 + MH1_BYTES <= WS_END, "moe overlay");
constexpr int CW_QUEUE = 0;
constexpr int CW_KMAX = 256;
constexpr int CW_ECNT = 512;
constexpr int CW_EFILL = 576;
constexpr int MI_LAMF = 0;
constexpr int MI_NTILES = 16;
constexpr int MI_EOFF = 32;
constexpr int MI_TILEE = 64;

__device__ __forceinline__ unsigned f2bf(float f) { unsigned u = __builtin_bit_cast(unsigned, f); return (u + 0x7fffu + ((u >> 16) & 1u)) >> 16; }
__device__ __forceinline__ unsigned pk2(float lo, float hi) { return f2bf(lo) | (f2bf(hi) << 16); }
__device__ __forceinline__ float bflo(unsigned w) { return __builtin_bit_cast(float, w << 16); }
__device__ __forceinline__ float bfhi(unsigned w) { return __builtin_bit_cast(float, w & 0xffff0000u); }
__device__ __forceinline__ float bf2f(bf16_t h) { return __builtin_bit_cast(float, (unsigned)h << 16); }
__device__ __forceinline__ int otid() { int t = threadIdx.x; asm volatile("" : "+v"(t)); return t; }
__device__ __forceinline__ float shx(float v, int o) { const int idx = ((otid() & 63) ^ o) << 2; return __builtin_bit_cast(float, __builtin_amdgcn_ds_bpermute(idx, __builtin_bit_cast(int, v))); }
__device__ __forceinline__ float shup(float v, int o) { const int idx = (((otid() & 63) - o) & 63) << 2; return __builtin_bit_cast(float, __builtin_amdgcn_ds_bpermute(idx, __builtin_bit_cast(int, v))); }
__device__ __forceinline__ float shlane(float v, int src) { return __builtin_bit_cast(float, __builtin_amdgcn_ds_bpermute(src << 2, __builtin_bit_cast(int, v))); }
__device__ __forceinline__ int shlane_i(int v, int src) { return __builtin_amdgcn_ds_bpermute(src << 2, v); }
__device__ __forceinline__ float wave_sum(float v) {
#pragma unroll
    for (int o = 1; o < 64; o <<= 1) v += shx(v, o);
    return v;
}
__device__ __forceinline__ float sigmoidf_(float x) { return 1.0f / (1.0f + __expf(-x)); }
__device__ __forceinline__ float siluf_(float x) { return x / (1.0f + __expf(-x)); }
__device__ __forceinline__ float softplusf_(float x) { return x > 20.f ? x : log1pf(expf(x)); }
__device__ __forceinline__ float logsigmoidf_(float x) { return fminf(x, 0.f) - log1pf(expf(-fabsf(x))); }

struct P {
    const float *x, *c, *ctx, *c_ctx, *w_mod, *b_mod, *norm1_g, *norm2_g, *w_in, *conv_a, *a_log, *dt_bias, *gn_a, *w_gate2, *b_gate, *gn_b,
                *lam_c, *gn_c, *w_o_a, *w_o_b, *w_o_c, *w_out, *ffn_w1, *ffn_w3, *ffn_w2, *router_w, *moe_w1, *moe_w3, *moe_w2, *final_g;
    float* out; unsigned char* ws;
};

template <class ColMap>
__device__ __forceinline__ void convert_T(const float* W, int K, int ldw, bf16_t* WT, int Nrows, ColMap cm, float* scr, int gw, int NGW, int lane) {
    const int nblk = Nrows / 32, items = (K / 64) * nblk;
    for (int it = gw; it < items; it += NGW) {
        const int kb = it / nblk, nb = it % nblk, k0 = 64 * kb, n0 = 32 * nb;
        const int sc = cm(n0 + (lane & 31));
#pragma unroll 8
        for (int i = 0; i < 32; ++i) { const int kk = 2 * i + (lane >> 5); scr[kk * 33 + (lane & 31)] = sc >= 0 ? W[(size_t)(k0 + kk) * ldw + sc] : 0.f; }
        asm volatile("s_waitcnt lgkmcnt(0)" ::: "memory");
        const int c = lane & 7;
#pragma unroll
        for (int j = 0; j < 4; ++j) { const int n = (lane >> 3) + 8 * j; const float* s = scr + (8 * c) * 33 + n;
            u32x4 o; o.x = pk2(s[0 * 33], s[1 * 33]); o.y = pk2(s[2 * 33], s[3 * 33]); o.z = pk2(s[4 * 33], s[5 * 33]); o.w = pk2(s[6 * 33], s[7 * 33]);
            *(u32x4*)(WT + (size_t)(n0 + n) * K + k0 + 8 * c) = o; }
        asm volatile("s_waitcnt lgkmcnt(0)" ::: "memory");
    }
}
struct CmIdent { __device__ int operator()(int n) const { return n; } };
struct CmWin { __device__ int operator()(int n) const {
    if (n < 2048) return n; if (n < 3584) return n + 16; if (n < 8192) return n + 48;
    const int j = n - 8192; if (j < 16) return 2048 + j; if (j < 48) return 3600 + (j - 16); return -1; } };

typedef const f32x4 (&AccRef)[2][2][4][2];
struct EpiWin {
    static constexpr bool PERM = true, AFTER_DRAIN = false;
    bf16_t *paq, *pz, *pb, *pc, *pg; float* small_;
    __device__ __forceinline__ void operator()(AccRef acc, const pg8::Unit& u, int wr, int wc, int fr, int fq) const {
        const int row0 = u.pm * 256 + wr * 64 + fr, pn = u.pn;
        if (pn == 32) {
            if (wc < 2) {
#pragma unroll
                for (int ai = 0; ai < 2; ++ai)
#pragma unroll
                    for (int m = 0; m < 4; ++m) { float* p = small_ + (size_t)(row0 + ai * 128 + m * 16) * 64 + wc * 32 + 8 * fq;
                        *(f32x4*)p = acc[ai][0][m][0]; *(f32x4*)(p + 4) = acc[ai][0][m][1]; }
            }
            return;
        }
        bf16_t* base; int ldc, c0;
        if (pn < 6) { base = paq; ldc = 1536; c0 = pn * 256; } else if (pn < 8) { base = pz; ldc = 512; c0 = (pn - 6) * 256; }
        else if (pn < 14) { base = pb; ldc = 1536; c0 = (pn - 8) * 256; } else if (pn < 20) { base = pc; ldc = 1536; c0 = (pn - 14) * 256; }
        else { base = pg; ldc = 3072; c0 = (pn - 20) * 256; }
        const int col = c0 + wc * 32 + 8 * fq;
#pragma unroll
        for (int ai = 0; ai < 2; ++ai)
#pragma unroll
            for (int m = 0; m < 4; ++m) { bf16_t* rowp = base + (size_t)(row0 + ai * 128 + m * 16) * ldc + col;
#pragma unroll
                for (int bj = 0; bj < 2; ++bj) { const f32x4 v0 = acc[ai][bj][m][0], v1 = acc[ai][bj][m][1];
                    u32x4 w; w.x = pk2(v0[0], v0[1]); w.y = pk2(v0[2], v0[3]); w.z = pk2(v1[0], v1[1]); w.w = pk2(v1[2], v1[3]);
                    *(u32x4*)(rowp + bj * 128) = w; } }
    }
};
struct EpiGate {
    static constexpr bool PERM = true, AFTER_DRAIN = false;
    bf16_t* Mo; const bf16_t* pg; int br;
    __device__ __forceinline__ void operator()(AccRef acc, const pg8::Unit& u, int wr, int wc, int fr, int fq) const {
        const int row0 = u.pm * 256 + wr * 64 + fr, col = u.pn * 256 + wc * 32 + 8 * fq;
#pragma unroll
        for (int ai = 0; ai < 2; ++ai)
#pragma unroll
            for (int m = 0; m < 4; ++m) { const size_t row = (size_t)(row0 + ai * 128 + m * 16);
#pragma unroll
                for (int bj = 0; bj < 2; ++bj) {
                    const u32x4 gw = *(const u32x4*)(pg + row * 3072 + br * 1024 + col + bj * 128);
                    bf16_t* mp = Mo + row * 1024 + col + bj * 128;
                    f32x4 v0 = acc[ai][bj][m][0], v1 = acc[ai][bj][m][1];
                    v0[0] *= sigmoidf_(bflo(gw.x)); v0[1] *= sigmoidf_(bfhi(gw.x)); v0[2] *= sigmoidf_(bflo(gw.y)); v0[3] *= sigmoidf_(bfhi(gw.y));
                    v1[0] *= sigmoidf_(bflo(gw.z)); v1[1] *= sigmoidf_(bfhi(gw.z)); v1[2] *= sigmoidf_(bflo(gw.w)); v1[3] *= sigmoidf_(bfhi(gw.w));
                    if (br != 0) { const u32x4 o = *(const u32x4*)mp;
                        v0[0] += bflo(o.x); v0[1] += bfhi(o.x); v0[2] += bflo(o.y); v0[3] += bfhi(o.y); v1[0] += bflo(o.z); v1[1] += bfhi(o.z); v1[2] += bflo(o.w); v1[3] += bfhi(o.w); }
                    u32x4 w; w.x = pk2(v0[0], v0[1]); w.y = pk2(v0[2], v0[3]); w.z = pk2(v1[0], v1[1]); w.w = pk2(v1[2], v1[3]);
                    *(u32x4*)mp = w; } }
    }
};
struct EpiResid {
    static constexpr bool PERM = false, AFTER_DRAIN = false;
    const float *old_l, *old_c; float *out_l, *out_c; const float* mod; int gidx;
    __device__ __forceinline__ void operator()(AccRef acc, const pg8::Unit& u, int wr, int wc, int fr, int fq) const {
        const int col0 = u.pn * 256 + wc * 32 + 4 * fq;
        const bool isctx = u.pm >= TL / 256; const int b = isctx ? 8 : u.pm / (SEQ / 256);
        const float* g = mod + (size_t)b * 6144 + gidx * 1024 + col0;
        const float* ob = isctx ? old_c - (size_t)TL * D : old_l; float* wb = isctx ? out_c - (size_t)TL * D : out_l;
        f32x4 gv[2][2];
#pragma unroll
        for (int bj = 0; bj < 2; ++bj)
#pragma unroll
            for (int n = 0; n < 2; ++n) gv[bj][n] = *(const f32x4*)(g + bj * 128 + n * 16);
#pragma unroll
        for (int ai = 0; ai < 2; ++ai)
#pragma unroll
            for (int m = 0; m < 4; ++m) { const size_t off = (size_t)(u.pm * 256 + ai * 128 + wr * 64 + m * 16 + fr) * D + col0;
#pragma unroll
                for (int bj = 0; bj < 2; ++bj)
#pragma unroll
                    for (int n = 0; n < 2; ++n) { const f32x4 xo = *(const f32x4*)(ob + off + bj * 128 + n * 16);
                        *(f32x4*)(wb + off + bj * 128 + n * 16) = xo + gv[bj][n] * acc[ai][bj][m][n]; } }
    }
};
struct EpiSwiglu {
    static constexpr bool PERM = true, AFTER_DRAIN = false;
    bf16_t* h1; int NJ;
    __device__ __forceinline__ void operator()(AccRef acc, const pg8::Unit& u, int wr, int wc, int fr, int fq) const {
        const int row0 = u.pm * 256 + wr * 64 + fr, col = (u.pn % NJ) * 128 + wc * 32 + 8 * fq;
#pragma unroll
        for (int ai = 0; ai < 2; ++ai)
#pragma unroll
            for (int m = 0; m < 4; ++m) { const f32x4 a0 = acc[ai][0][m][0], a1 = acc[ai][0][m][1], b0 = acc[ai][1][m][0], b1 = acc[ai][1][m][1];
                u32x4 w; w.x = pk2(siluf_(a0[0]) * b0[0], siluf_(a0[1]) * b0[1]); w.y = pk2(siluf_(a0[2]) * b0[2], siluf_(a0[3]) * b0[3]);
                w.z = pk2(siluf_(a1[0]) * b1[0], siluf_(a1[1]) * b1[1]); w.w = pk2(siluf_(a1[2]) * b1[2], siluf_(a1[3]) * b1[3]);
                *(u32x4*)(h1 + (size_t)(row0 + ai * 128 + m * 16) * DFF + col) = w; }
    }
};
struct EpiMoeDown {
    static constexpr bool PERM = true, AFTER_DRAIN = false;
    bf16_t* y;
    __device__ __forceinline__ void operator()(AccRef acc, const pg8::Unit& u, int wr, int wc, int fr, int fq) const {
        const int row0 = u.pm * 256 + wr * 64 + fr, col = (u.pn % 4) * 256 + wc * 32 + 8 * fq;
#pragma unroll
        for (int ai = 0; ai < 2; ++ai)
#pragma unroll
            for (int m = 0; m < 4; ++m) { bf16_t* rowp = y + (size_t)(row0 + ai * 128 + m * 16) * D + col;
#pragma unroll
                for (int bj = 0; bj < 2; ++bj) { const f32x4 v0 = acc[ai][bj][m][0], v1 = acc[ai][bj][m][1];
                    u32x4 w; w.x = pk2(v0[0], v0[1]); w.y = pk2(v0[2], v0[3]); w.z = pk2(v1[0], v1[1]); w.w = pk2(v1[2], v1[3]);
                    *(u32x4*)(rowp + bj * 128) = w; } }
    }
};
struct MoeOrder {
    int ntiles, NJ, G, c; const int* tile_e;
    __device__ bool next(int i, pg8::Unit& u) const { const long L = (long)i * G + c; if (L >= (long)ntiles * NJ) return false;
        const int t = (int)(L / NJ), j = (int)(L % NJ); u.pm = t; u.pn = tile_e[t] * NJ + j; return true; }
    __device__ __forceinline__ void a_ready(const pg8::Unit&) const {}
    __device__ __forceinline__ void done(const pg8::Unit&) const {}
};

__device__ __forceinline__ void phase_mod(const P& p, unsigned char* lds) {
    float* sc = (float*)lds;
    float* red = sc + 9 * 1024;
    const int tid = otid();
    for (int i = tid; i < 9 * 1024; i += NTHREADS) { const int r = i >> 10, k = i & 1023; const float v = r < 8 ? p.c[r * 1024 + k] : p.c_ctx[k]; sc[i] = siluf_(v); }
    __syncthreads();
    float* MOD = (float*)(p.ws + WS_MOD);
    const int cj = tid % 48, ks = tid / 48;
    for (int grp = blockIdx.x; grp < DEPTH * 6144 / 48; grp += gridDim.x) {
        const int l = grp / 128, j = (grp % 128) * 48 + cj;
        float a[9];
#pragma unroll
        for (int r = 0; r < 9; ++r) a[r] = 0.f;
        if (ks < 10) {
            const float* w = p.w_mod + (size_t)l * 1024 * 6144 + j;
            for (int k = ks; k < 1024; k += 10) { const float wv = w[(size_t)k * 6144];
#pragma unroll
                for (int r = 0; r < 9; ++r) a[r] += sc[r * 1024 + k] * wv; }
#pragma unroll
            for (int r = 0; r < 9; ++r) red[(ks * 9 + r) * 48 + cj] = a[r];
        }
        __syncthreads();
        if (tid < 9 * 48) { const int r = tid / 48, c2 = tid % 48; float s = 0.f;
#pragma unroll
            for (int q = 0; q < 10; ++q) s += red[(q * 9 + r) * 48 + c2];
            const int jj = (grp % 128) * 48 + c2;
            MOD[((size_t)l * 9 + r) * 6144 + jj] = s + p.b_mod[l * 6144 + jj]; }
        __syncthreads();
    }
}

__device__ __forceinline__ void phase_modulate(const float* src_l, const float* src_c, int nrows, const float* gain, const float* mod, int shift_idx,
                                               bf16_t* H, const float* router_w, int* route, unsigned* ecnt, int gw, int NGW, int lane) {
    for (int r = gw; r < nrows; r += NGW) {
        const bool isctx = r >= TL; const int b = isctx ? 8 : r / SEQ;
        const float* xr = isctx ? src_c + (size_t)(r - TL) * D : src_l + (size_t)r * D;
        const float* sh = mod + (size_t)b * 6144 + shift_idx * 1024; const float* scl = sh + 1024;
        f32x4 v[4]; float ss = 0.f;
#pragma unroll
        for (int j = 0; j < 4; ++j) { v[j] = *(const f32x4*)(xr + 4 * lane + 256 * j); ss += (v[j][0] * v[j][0] + v[j][1] * v[j][1]) + (v[j][2] * v[j][2] + v[j][3] * v[j][3]); }
        const float rs = 1.0f / sqrtf(wave_sum(ss) * (1.0f / D) + EPS);
#pragma unroll
        for (int j = 0; j < 4; ++j) { const int c = 4 * lane + 256 * j; const f32x4 g = *(const f32x4*)(gain + c), s1 = *(const f32x4*)(scl + c), s0 = *(const f32x4*)(sh + c);
            v[j] = v[j] * rs * g * (1.0f + s1) + s0;
            u32x2 w; w.x = pk2(v[j][0], v[j][1]); w.y = pk2(v[j][2], v[j][3]);
            *(u32x2*)(H + (size_t)r * D + c) = w; }
        if (router_w) {
            float lg[NE];
#pragma unroll
            for (int e = 0; e < NE; ++e) lg[e] = 0.f;
#pragma unroll
            for (int j = 0; j < 4; ++j)
#pragma unroll
                for (int q = 0; q < 4; ++q) { const float* rw = router_w + (size_t)(4 * lane + 256 * j + q) * NE; const f32x4 r0 = *(const f32x4*)rw, r1 = *(const f32x4*)(rw + 4); const float hv = v[j][q];
                    lg[0] += hv * r0[0]; lg[1] += hv * r0[1]; lg[2] += hv * r0[2]; lg[3] += hv * r0[3]; lg[4] += hv * r1[0]; lg[5] += hv * r1[1]; lg[6] += hv * r1[2]; lg[7] += hv * r1[3]; }
#pragma unroll
            for (int e = 0; e < NE; ++e) lg[e] = wave_sum(lg[e]);
            int e1 = 0; float v1 = lg[0];
#pragma unroll
            for (int e = 1; e < NE; ++e) if (lg[e] > v1) { v1 = lg[e]; e1 = e; }
            int e2 = -1; float v2 = -3.0e38f;
#pragma unroll
            for (int e = 0; e < NE; ++e) if (e != e1 && lg[e] > v2) { v2 = lg[e]; e2 = e; }
            const float w2 = 1.0f / (1.0f + expf(v1 - v2)), w1 = 1.0f - w2;
            if (lane == 0) { route[r * 4 + 0] = e1; route[r * 4 + 1] = e2; ((float*)route)[r * 4 + 2] = w1; ((float*)route)[r * 4 + 3] = w2;
                atomicAdd(ecnt + e1, 1u); atomicAdd(ecnt + e2, 1u); }
        }
    }
}


typedef short v4i16_t __attribute__((ext_vector_type(4)));
__device__ __forceinline__ s16x4 lds_tr(const bf16_t* pp) { return __builtin_bit_cast(s16x4, __builtin_amdgcn_ds_read_tr16_b64_v4i16((__attribute__((address_space(3))) v4i16_t*)pp)); }
__device__ __forceinline__ bf16x8 cat8(s16x4 a, s16x4 b) { union { bf16x8 v; s16x4 h[2]; } u; u.h[0] = a; u.h[1] = b; return u.v; }
__device__ __forceinline__ bf16x8 pack8(f32x4 a, f32x4 b) { union { bf16x8 v; unsigned u[4]; } r; r.u[0] = pk2(a[0], a[1]); r.u[1] = pk2(a[2], a[3]); r.u[2] = pk2(b[0], b[1]); r.u[3] = pk2(b[2], b[3]); return r.v; }
constexpr int DN_NCH = (CTXL + SEQ) / 64;
constexpr int DN_ITEMS = BATCH * 4 * 2 * DN_NCH;
constexpr int PREP_WLDS = 16384 + 17408 + 512;

__device__ __forceinline__ int dn_row(int n, int s, int b, int dir) {
    const bool isctx = n < CTXL / 64; const int L = isctx ? CTXL : SEQ, c = isctx ? n : n - CTXL / 64, u = 64 * c + s, t = dir ? L - 1 - u : u;
    return (isctx ? TL + b * CTXL : b * SEQ) + t;
}
__device__ __forceinline__ void dn_prep_item(const P& p, int l, int item, unsigned char* wlds, int lane) {
    const int n = item % DN_NCH, bhd = item / DN_NCH, dir = bhd & 1, h = (bhd >> 1) & 3, b = bhd >> 3;
    const bool isctx = n < CTXL / 64; const int L = isctx ? CTXL : SEQ, cch = isctx ? n : n - CTXL / 64, rbase = isctx ? TL + b * CTXL : b * SEQ;
    const int i16 = lane & 15, g = lane >> 4;
    const bf16_t* PAQ = (const bf16_t*)(p.ws + WS_PAQ); bf16_t* DN = (bf16_t*)(p.ws + WS_DNQKV); const float* SMALL = (const float*)(p.ws + WS_SMALL);
    const float* cw = p.conv_a + (size_t)l * 3 * 1536;
    constexpr int KCP = 136;
    float* Ls = (float*)wlds; bf16_t* Kc = (bf16_t*)(wlds + 16384); float* Tl = (float*)(wlds + 16384);
    float* gcs = (float*)(wlds + 16384 + 17408); float* bes = gcs + 64;
    {
        const int r = dn_row(n, lane, b, dir);
        const float bb = SMALL[(size_t)r * 64 + dir * 4 + h], aa = SMALL[(size_t)r * 64 + 8 + dir * 4 + h];
        const float gv = -expf(p.a_log[l * 8 + dir * 4 + h]) * softplusf_(aa + p.dt_bias[l * 8 + dir * 4 + h]), be = sigmoidf_(bb);
        float gc = gv;
#pragma unroll
        for (int o = 1; o < 64; o <<= 1) { const float u = shup(gc, o); if (lane >= o) gc += u; }
        const float gl = shlane(gc, 63);
        gcs[lane] = gc; bes[lane] = be;
        float* vec = (float*)(p.ws + WS_VEC) + (size_t)item * 256;
        vec[lane] = expf(gc); vec[64 + lane] = expf(gl - gc); vec[128 + lane] = be; vec[192 + lane] = expf(gl);
    }
    auto conv_frag = [&](int seg, int mt, bf16x8 (&F)[4]) {
        const int u = 64 * cch + 16 * mt + i16, t = dir ? L - 1 - u : u; const size_t r = (size_t)(rbase + t);
        float y[4][8]; float ss = 0.f;
#pragma unroll
        for (int ks = 0; ks < 4; ++ks) { const int col = seg * 512 + h * 128 + 32 * ks + 8 * g;
            const u32x4 x1 = *(const u32x4*)(PAQ + r * 1536 + col);
            u32x4 x0 = (u32x4){0u, 0u, 0u, 0u}, x2 = (u32x4){0u, 0u, 0u, 0u};
            if (t > 0) x0 = *(const u32x4*)(PAQ + (r - 1) * 1536 + col);
            if (t < L - 1) x2 = *(const u32x4*)(PAQ + (r + 1) * 1536 + col);
            const f32x4 wa0 = *(const f32x4*)(cw + col), wa1 = *(const f32x4*)(cw + col + 4), wb0 = *(const f32x4*)(cw + 1536 + col), wb1 = *(const f32x4*)(cw + 1536 + col + 4),
                        wc0 = *(const f32x4*)(cw + 3072 + col), wc1 = *(const f32x4*)(cw + 3072 + col + 4);
            const unsigned xa[4] = {x0.x, x0.y, x0.z, x0.w}, xb[4] = {x1.x, x1.y, x1.z, x1.w}, xc[4] = {x2.x, x2.y, x2.z, x2.w};
#pragma unroll
            for (int q = 0; q < 4; ++q) { const f32x4& wa = q < 2 ? wa0 : wa1; const f32x4& wb = q < 2 ? wb0 : wb1; const f32x4& wc = q < 2 ? wc0 : wc1; const int e2 = (2 * q) & 3;
                const float v0 = siluf_(wa[e2] * bflo(xa[q]) + wb[e2] * bflo(xb[q]) + wc[e2] * bflo(xc[q])), v1 = siluf_(wa[e2 + 1] * bfhi(xa[q]) + wb[e2 + 1] * bfhi(xb[q]) + wc[e2 + 1] * bfhi(xc[q]));
                y[ks][2 * q] = v0; y[ks][2 * q + 1] = v1; ss += v0 * v0 + v1 * v1; }
            if (ks == 1) asm volatile("" ::: "memory");
        }
        float sc = 1.0f;
        if (seg < 2) { ss += shx(ss, 16); ss += shx(ss, 32); sc = 1.0f / sqrtf(ss + EPS); if (seg == 0) sc *= 0.08838834764831845f; }
#pragma unroll
        for (int ks = 0; ks < 4; ++ks) { union { bf16x8 v; u32x4 w; } f;
            f.w.x = pk2(y[ks][0] * sc, y[ks][1] * sc); f.w.y = pk2(y[ks][2] * sc, y[ks][3] * sc); f.w.z = pk2(y[ks][4] * sc, y[ks][5] * sc); f.w.w = pk2(y[ks][6] * sc, y[ks][7] * sc);
            F[ks] = f.v;
            if (dir == 0) *(u32x4*)(DN + r * 1536 + seg * 512 + h * 128 + 32 * ks + 8 * g) = f.w; }
    };
#pragma unroll 1
    for (int mt = 0; mt < 4; ++mt) { bf16x8 F[4]; conv_frag(1, mt, F);
#pragma unroll
        for (int ks = 0; ks < 4; ++ks) *(bf16x8*)(Kc + (16 * mt + i16) * KCP + 32 * ks + 8 * g) = F[ks]; }
    if (dir == 0) {
#pragma unroll 1
        for (int mt = 0; mt < 4; ++mt) { bf16x8 F[4]; conv_frag(2, mt, F); } }
    asm volatile("s_waitcnt lgkmcnt(0)" ::: "memory");
#pragma unroll 1
    for (int mt = 0; mt < 4; ++mt) {
        bf16x8 A[4];
#pragma unroll
        for (int ks = 0; ks < 4; ++ks) A[ks] = *(const bf16x8*)(Kc + (16 * mt + i16) * KCP + 32 * ks + 8 * g);
#pragma unroll 1
        for (int nt = 0; nt <= mt; ++nt) { f32x4 acc = (f32x4){0.f, 0.f, 0.f, 0.f};
#pragma unroll
            for (int ks = 0; ks < 4; ++ks) acc = __builtin_amdgcn_mfma_f32_16x16x32_bf16(A[ks], *(const bf16x8*)(Kc + (16 * nt + i16) * KCP + 32 * ks + 8 * g), acc, 0, 0, 0);
            const int j = 16 * nt + i16; const float gj = gcs[j];
#pragma unroll
            for (int rg = 0; rg < 4; ++rg) { const int i = 16 * mt + 4 * g + rg; Ls[i * 64 + j] = i > j ? bes[i] * acc[rg] * __expf(gcs[i] - gj) : 0.f; } }
    }
    bf16_t* QKg = (bf16_t*)(p.ws + WS_TQ + (size_t)item * 16384 + 8192);
#pragma unroll 1
    for (int mt = 0; mt < 4; ++mt) { bf16x8 Qf[4]; conv_frag(0, mt, Qf);
#pragma unroll 1
        for (int nt = 0; nt < 4; ++nt) { f32x4 acc = (f32x4){0.f, 0.f, 0.f, 0.f}; const int j = 16 * nt + i16;
            if (nt <= mt) {
#pragma unroll
                for (int ks = 0; ks < 4; ++ks) acc = __builtin_amdgcn_mfma_f32_16x16x32_bf16(Qf[ks], *(const bf16x8*)(Kc + (16 * nt + i16) * KCP + 32 * ks + 8 * g), acc, 0, 0, 0);
                const float gj = gcs[j];
#pragma unroll
                for (int rg = 0; rg < 4; ++rg) { const int i = 16 * mt + 4 * g + rg; acc[rg] = i >= j ? acc[rg] * __expf(gcs[i] - gj) : 0.f; } }
#pragma unroll
            for (int rg = 0; rg < 4; ++rg) QKg[(16 * mt + 4 * g + rg) * 64 + j] = (bf16_t)f2bf(acc[rg]); } }
    asm volatile("s_waitcnt lgkmcnt(0)" ::: "memory");
#pragma unroll 1
    for (int i = 0; i < 64; ++i) { float s0 = (i == lane) ? 1.f : 0.f, s1 = 0.f;
        int j = 0;
#pragma unroll 4
        for (; j + 1 < i; j += 2) { s0 -= Ls[i * 64 + j] * Tl[j * 64 + lane]; s1 -= Ls[i * 64 + j + 1] * Tl[(j + 1) * 64 + lane]; }
        if (j < i) s0 -= Ls[i * 64 + j] * Tl[j * 64 + lane];
        Tl[i * 64 + lane] = s0 + s1; }
    asm volatile("s_waitcnt lgkmcnt(0)" ::: "memory");
    bf16_t* Tg = (bf16_t*)(p.ws + WS_TQ + (size_t)item * 16384);
    for (int i = 0; i < 64; ++i) Tg[i * 64 + lane] = (bf16_t)f2bf(Tl[i * 64 + lane]);
    asm volatile("s_waitcnt lgkmcnt(0)" ::: "memory");
}

__device__ __forceinline__ void dn_chain_mfma(const P& p, int item, unsigned char* lds) {
    const int b = item >> 3, h = (item >> 1) & 3, dir = item & 1, tid = otid(), lane = tid & 63, w = tid >> 6, i16 = lane & 15, g = lane >> 4;
    constexpr int KP = 136, TP = 72;
    bf16_t* Ks = (bf16_t*)lds; bf16_t* Qs = Ks + 64 * KP; bf16_t* Vs = Qs + 64 * KP; bf16_t* Ts = Vs + 64 * KP; bf16_t* QKs = Ts + 64 * TP; float* vec = (float*)(QKs + 64 * TP);
    const bf16_t* DN = (const bf16_t*)(p.ws + WS_DNQKV); bf16_t* OA = (bf16_t*)(p.ws + WS_H) + (size_t)dir * T * 512;
    f32x4 S[8];
#pragma unroll
    for (int dt = 0; dt < 8; ++dt) S[dt] = (f32x4){0.f, 0.f, 0.f, 0.f};
    u32x4 pf[9];
    auto prefetch = [&](int n) {
        const int pitem = item * DN_NCH + n;
#pragma unroll
        for (int u = 0; u < 6; ++u) { const int q = tid + 512 * u, which = q >> 10, rem = q & 1023, s = rem >> 4, ch = rem & 15;
            pf[u] = *(const u32x4*)(DN + (size_t)dn_row(n, s, b, dir) * 1536 + (which == 0 ? 512 : which == 1 ? 0 : 1024) + h * 128 + ch * 8); }
#pragma unroll
        for (int u = 0; u < 2; ++u) pf[6 + u] = *(const u32x4*)(p.ws + WS_TQ + (size_t)pitem * 16384 + (size_t)u * 8192 + (size_t)tid * 16);
        if (tid < 64) pf[8] = *(const u32x4*)((const float*)(p.ws + WS_VEC) + (size_t)pitem * 256 + tid * 4);
    };
    prefetch(0);
    for (int n = 0; n < DN_NCH; ++n) {
        __syncthreads();
#pragma unroll
        for (int u = 0; u < 6; ++u) { const int q = tid + 512 * u, which = q >> 10, rem = q & 1023, s = rem >> 4, ch = rem & 15;
            *(u32x4*)((which == 0 ? Ks : which == 1 ? Qs : Vs) + s * KP + ch * 8) = pf[u]; }
#pragma unroll
        for (int u = 0; u < 2; ++u) *(u32x4*)((u == 0 ? Ts : QKs) + (tid >> 3) * TP + (tid & 7) * 8) = pf[6 + u];
        if (tid < 64) *(u32x4*)(vec + tid * 4) = pf[8];
        __syncthreads();
        if (n + 1 < DN_NCH) prefetch(n + 1);
        const float* egv = vec; const float* eklv = vec + 64; const float* bev = vec + 128; const float glast = vec[192];
        bf16x8 Sb[4];
#pragma unroll
        for (int ks = 0; ks < 4; ++ks) Sb[ks] = pack8(S[2 * ks], S[2 * ks + 1]);
        f32x4 r_[4], o_[4];
#pragma unroll
        for (int mt = 0; mt < 4; ++mt) { r_[mt] = (f32x4){0.f, 0.f, 0.f, 0.f}; o_[mt] = (f32x4){0.f, 0.f, 0.f, 0.f};
            const bf16_t* kr = Ks + (16 * mt + i16) * KP + 4 * g; const bf16_t* qr = Qs + (16 * mt + i16) * KP + 4 * g;
#pragma unroll
            for (int ks = 0; ks < 4; ++ks) { const bf16x8 ak = cat8(*(const s16x4*)(kr + 32 * ks), *(const s16x4*)(kr + 32 * ks + 16)), aq = cat8(*(const s16x4*)(qr + 32 * ks), *(const s16x4*)(qr + 32 * ks + 16));
                r_[mt] = __builtin_amdgcn_mfma_f32_16x16x32_bf16(ak, Sb[ks], r_[mt], 0, 0, 0); o_[mt] = __builtin_amdgcn_mfma_f32_16x16x32_bf16(aq, Sb[ks], o_[mt], 0, 0, 0); } }
        f32x4 eg[4];
#pragma unroll
        for (int mt = 0; mt < 4; ++mt) { eg[mt] = *(const f32x4*)(egv + 16 * mt + 4 * g); const f32x4 be = *(const f32x4*)(bev + 16 * mt + 4 * g);
#pragma unroll
            for (int rg = 0; rg < 4; ++rg) { const float v = bf2f(Vs[(16 * mt + 4 * g + rg) * KP + 16 * w + i16]); r_[mt][rg] = be[rg] * (v - eg[mt][rg] * r_[mt][rg]); o_[mt][rg] *= eg[mt][rg]; } }
        bf16x8 Rb[2];
#pragma unroll
        for (int k2 = 0; k2 < 2; ++k2) Rb[k2] = pack8(r_[2 * k2], r_[2 * k2 + 1]);
        f32x4 vn[4];
#pragma unroll
        for (int mt = 0; mt < 4; ++mt) { vn[mt] = (f32x4){0.f, 0.f, 0.f, 0.f}; const bf16_t* tr = Ts + (16 * mt + i16) * TP + 4 * g;
#pragma unroll
            for (int k2 = 0; k2 < 2; ++k2) vn[mt] = __builtin_amdgcn_mfma_f32_16x16x32_bf16(cat8(*(const s16x4*)(tr + 32 * k2), *(const s16x4*)(tr + 32 * k2 + 16)), Rb[k2], vn[mt], 0, 0, 0); }
        bf16x8 Vb[2], Wb[2];
#pragma unroll
        for (int k2 = 0; k2 < 2; ++k2) { Vb[k2] = pack8(vn[2 * k2], vn[2 * k2 + 1]);
            const f32x4 e0 = *(const f32x4*)(eklv + 32 * k2 + 4 * g), e1 = *(const f32x4*)(eklv + 32 * k2 + 16 + 4 * g); Wb[k2] = pack8(vn[2 * k2] * e0, vn[2 * k2 + 1] * e1); }
#pragma unroll
        for (int mt = 0; mt < 4; ++mt) { const bf16_t* qkr = QKs + (16 * mt + i16) * TP + 4 * g;
#pragma unroll
            for (int k2 = 0; k2 < 2; ++k2) o_[mt] = __builtin_amdgcn_mfma_f32_16x16x32_bf16(cat8(*(const s16x4*)(qkr + 32 * k2), *(const s16x4*)(qkr + 32 * k2 + 16)), Vb[k2], o_[mt], 0, 0, 0); }
#pragma unroll
        for (int dt = 0; dt < 8; ++dt) { S[dt] = S[dt] * glast;
#pragma unroll
            for (int k2 = 0; k2 < 2; ++k2) { const bf16_t* a0 = Ks + (32 * k2 + 4 * g + (i16 >> 2)) * KP + 16 * dt + 4 * (i16 & 3);
                S[dt] = __builtin_amdgcn_mfma_f32_16x16x32_bf16(cat8(lds_tr(a0), lds_tr(a0 + 16 * KP)), Wb[k2], S[dt], 0, 0, 0); } }
#pragma unroll
        for (int mt = 0; mt < 4; ++mt)
#pragma unroll
            for (int rg = 0; rg < 4; ++rg) OA[(size_t)dn_row(n, 16 * mt + 4 * g + rg, b, dir) * 512 + h * 128 + 16 * w + i16] = (bf16_t)f2bf(o_[mt][rg]);
    }
}

__device__ __forceinline__ void phase_prep(const P& p, int l, unsigned char* lds, int gw, int NGW, int lane) {
    unsigned char* ws = p.ws;
    bf16_t* PC = (bf16_t*)(ws + WS_PC); unsigned* ctl = (unsigned*)(ws + WS_CTL);
    const int wv = gw % NWAVES, blk = gw / NWAVES, G_ = NGW / NWAVES;
    if (wv < 4) { for (int it = blk * 4 + wv; it < DN_ITEMS; it += G_ * 4) dn_prep_item(p, l, it, lds + wv * PREP_WLDS, lane); return; }
    const int gt = (blk * 4 + (wv - 4)) * 64 + lane, NGT = G_ * 4 * 64;
    for (long i = gt; i < (long)T * 512; i += NGT) {
        const int r = (int)(i >> 9), q = (int)(i & 511), seg = q >> 8, h = (q >> 6) & 3, m = (q >> 5) & 1, pi = q & 31;
        const int half = pi >> 4, fi = pi & 15, d1 = half * 32 + fi, d2 = d1 + 16;
        bf16_t* base = PC + (size_t)r * 1536 + seg * 512 + h * 128 + m * 64;
        float x1 = bf2f(base[d1]), x2 = bf2f(base[d2]);
        const bool lat = r < TL; const int b = lat ? r / SEQ : (r - TL) / CTXL;
        if (lat) { const int t = r % SEQ; const float pos = half ? (float)(t & 63) : (float)(t >> 6);
            const float ang = pos * exp2f(-(float)fi * 0.8304820237218406f);
            float sn, cs; sincosf(ang, &sn, &cs);
            const float o1 = x1 * cs - x2 * sn, o2 = x2 * cs + x1 * sn; x1 = o1; x2 = o2; }
        if (seg == 0) { x1 *= 0.125f; x2 *= 0.125f; }
        const bf16_t r1 = (bf16_t)f2bf(x1), r2 = (bf16_t)f2bf(x2);
        if (lat || seg == 0) { base[d1] = r1; base[d2] = r2; }
        float ss = bf2f(r1) * bf2f(r1) + bf2f(r2) * bf2f(r2);
#pragma unroll
        for (int o = 1; o < 32; o <<= 1) ss += shx(ss, o);
        if (seg == 1 && (lane & 31) == 0) atomicMax(ctl + CW_KMAX + l * 64 + (b * 4 + h) * 2 + m, __builtin_bit_cast(unsigned, sqrtf(ss)));
    }
    if (blk == 0 && wv == 4) { float a = 0.f, bq = 0.f; const float* lc = p.lam_c + (size_t)l * 256;
        a = wave_sum(lc[lane] * lc[64 + lane]); bq = wave_sum(lc[128 + lane] * lc[192 + lane]);
        const float lam_init = 0.8f - 0.6f * expf(-0.3f * (float)l);
        if (lane == 0) ((float*)(ws + WS_MISC))[MI_LAMF + l] = expf(a) - expf(bq) + lam_init; }
}

__device__ __forceinline__ void dn_chain(const P& p, int item, unsigned char* lds) {
    const int b = item >> 3, h = (item >> 1) & 3, dir = item & 1, tid = otid(), c = tid >> 2, ks = tid & 3;
    const bf16_t* DN = (const bf16_t*)(p.ws + WS_DNQKV); const float* GB = (const float*)(p.ws + WS_GB);
    bf16_t* OA = (bf16_t*)(p.ws + WS_H) + (size_t)dir * T * 512;
    constexpr int TB = 32;
    float* qs = (float*)lds; float* ksm = qs + TB * 128; float* vs = ksm + TB * 128; float* gs = vs + TB * 128; float* bs = gs + TB; float* ob = bs + TB;
    float S[32];
#pragma unroll
    for (int i = 0; i < 32; ++i) S[i] = 0.f;
    for (int part = 0; part < 2; ++part) {
        const int L = part == 0 ? CTXL : SEQ; const int rbase = part == 0 ? TL + b * CTXL : b * SEQ;
        for (int t0 = 0; t0 < L; t0 += TB) {
            __syncthreads();
            for (int i = tid; i < 3 * TB * 16; i += NTHREADS) { const int which = i / (TB * 16), rem = i % (TB * 16), tt = rem >> 4, ch = rem & 15;
                const int s = t0 + tt, t = dir ? L - 1 - s : s;
                const u32x4 w = *(const u32x4*)(DN + (size_t)(rbase + t) * 1536 + which * 512 + h * 128 + ch * 8);
                float* dst = (which == 0 ? qs : which == 1 ? ksm : vs) + tt * 128 + ch * 8;
                dst[0] = bflo(w.x); dst[1] = bfhi(w.x); dst[2] = bflo(w.y); dst[3] = bfhi(w.y); dst[4] = bflo(w.z); dst[5] = bfhi(w.z); dst[6] = bflo(w.w); dst[7] = bfhi(w.w); }
            if (tid < TB) { const int s = t0 + tid, t = dir ? L - 1 - s : s; gs[tid] = expf(GB[(size_t)(rbase + t) * 16 + dir * 4 + h]); bs[tid] = GB[(size_t)(rbase + t) * 16 + 8 + dir * 4 + h]; }
            __syncthreads();
            for (int tt = 0; tt < TB; ++tt) {
                const float eg = gs[tt], be = bs[tt];
                const float* kr = ksm + tt * 128 + ks * 32; const float* qr = qs + tt * 128 + ks * 32;
                float r = 0.f;
#pragma unroll
                for (int i = 0; i < 32; ++i) r += kr[i] * S[i];
                r += shx(r, 1); r += shx(r, 2);
                const float vn = be * (vs[tt * 128 + c] - eg * r);
                float o = 0.f;
#pragma unroll
                for (int i = 0; i < 32; ++i) { S[i] = eg * S[i] + kr[i] * vn; o += qr[i] * S[i]; }
                o += shx(o, 1); o += shx(o, 2);
                if (ks == 0) ob[tt * 128 + c] = o;
            }
            __syncthreads();
            for (int i = tid; i < TB * 64; i += NTHREADS) { const int tt = i >> 6, cp = i & 63; const int s = t0 + tt, t = dir ? L - 1 - s : s;
                *(unsigned*)(OA + (size_t)(rbase + t) * 512 + h * 128 + 2 * cp) = pk2(ob[tt * 128 + 2 * cp], ob[tt * 128 + 2 * cp + 1]); }
        }
    }
}
__device__ __forceinline__ void gla_chain(const P& p, int l, int item, unsigned char* lds) {
    const int b = item >> 3, h = (item >> 1) & 3, dir = item & 1, tid = otid(), c = tid >> 2, ks = tid & 3;
    const bf16_t* PB = (const bf16_t*)(p.ws + WS_PB); const float* SMALL = (const float*)(p.ws + WS_SMALL);
    const float* wg = p.w_gate2 + ((size_t)l * 2 + dir) * 16 * 256 + h * 64; const float* bg = p.b_gate + ((size_t)l * 2 + dir) * 256 + h * 64;
    bf16_t* OB = (bf16_t*)(p.ws + WS_PAQ) + (size_t)dir * T * 512;
    constexpr int TB = 32;
    float* qs = (float*)lds; float* ksm = qs + TB * 64; float* es = ksm + TB * 64; float* vs = es + TB * 64; float* ob = vs + TB * 128;
    float S[16];
#pragma unroll
    for (int i = 0; i < 16; ++i) S[i] = 0.f;
    for (int part = 0; part < 2; ++part) {
        const int L = part == 0 ? CTXL : SEQ; const int rbase = part == 0 ? TL + b * CTXL : b * SEQ;
        for (int t0 = 0; t0 < L; t0 += TB) {
            __syncthreads();
            for (int i = tid; i < TB * 32; i += NTHREADS) {
                const int tt = i >> 5, ch = i & 31; const int s = t0 + tt, t = dir ? L - 1 - s : s; const size_t row = (size_t)(rbase + t);
                if (ch < 16) { const int which = ch >> 3, c8 = (ch & 7) * 8;
                    const u32x4 w = *(const u32x4*)(PB + row * 1536 + which * 256 + h * 64 + c8);
                    float* dst = (which == 0 ? qs : ksm) + tt * 64 + c8; const float sc = which == 0 ? 0.125f : 1.0f;
                    dst[0] = sc * bflo(w.x); dst[1] = sc * bfhi(w.x); dst[2] = sc * bflo(w.y); dst[3] = sc * bfhi(w.y); dst[4] = sc * bflo(w.z); dst[5] = sc * bfhi(w.z); dst[6] = sc * bflo(w.w); dst[7] = sc * bfhi(w.w);
                } else { const int c8 = (ch - 16) * 8; const u32x4 w = *(const u32x4*)(PB + row * 1536 + 512 + h * 128 + c8); float* dst = vs + tt * 128 + c8;
                    dst[0] = bflo(w.x); dst[1] = bfhi(w.x); dst[2] = bflo(w.y); dst[3] = bfhi(w.y); dst[4] = bflo(w.z); dst[5] = bfhi(w.z); dst[6] = bflo(w.w); dst[7] = bfhi(w.w); }
            }
            for (int i = tid; i < TB * 64; i += NTHREADS) { const int tt = i >> 6, d = i & 63; const int s = t0 + tt, t = dir ? L - 1 - s : s; const float* glr = SMALL + (size_t)(rbase + t) * 64 + 16 + dir * 16;
                float z = bg[d];
#pragma unroll
                for (int j = 0; j < 16; ++j) z += glr[j] * wg[j * 256 + d];
                es[tt * 64 + d] = expf(logsigmoidf_(z) * 0.0625f); }
            __syncthreads();
            for (int tt = 0; tt < TB; ++tt) {
                const float* kr = ksm + tt * 64 + ks * 16; const float* qr = qs + tt * 64 + ks * 16; const float* er = es + tt * 64 + ks * 16;
                const float vv = vs[tt * 128 + c]; float o = 0.f;
#pragma unroll
                for (int i = 0; i < 16; ++i) { S[i] = er[i] * S[i] + kr[i] * vv; o += qr[i] * S[i]; }
                o += shx(o, 1); o += shx(o, 2);
                if (ks == 0) ob[tt * 128 + c] = o;
            }
            __syncthreads();
            for (int i = tid; i < TB * 64; i += NTHREADS) { const int tt = i >> 6, cp = i & 63; const int s = t0 + tt, t = dir ? L - 1 - s : s;
                *(unsigned*)(OB + (size_t)(rbase + t) * 512 + h * 128 + 2 * cp) = pk2(ob[tt * 128 + 2 * cp], ob[tt * 128 + 2 * cp + 1]); }
        }
    }
}
__device__ __forceinline__ void attn_tile(const P& p, int l, int b, int h, int qrow0  , bool ctxq, unsigned char* lds) {
    constexpr int QP = 72, KP = 72, VP = 72;
    bf16_t* Qs = (bf16_t*)lds;
    bf16_t* Ks = Qs + 2 * 128 * QP;
    bf16_t* Vt = Ks + 2 * 64 * KP;
    float* Oex = (float*)lds;
    bf16_t* PC = (bf16_t*)(p.ws + WS_PC);
    const int tid = otid(), lane = tid & 63, w = tid >> 6, m = w & 1, rg = w >> 1, q31 = lane & 31, hi = lane >> 5;
    __syncthreads();
    for (int i = tid; i < 128 * 16; i += NTHREADS) { const int r = i >> 4, ch = i & 15, mm = ch >> 3, c8 = (ch & 7) * 8;
        *(u32x4*)(Qs + (mm * 128 + r) * QP + c8) = *(const u32x4*)(PC + (size_t)(qrow0 + r) * 1536 + h * 128 + ch * 8); }
    __syncthreads();
    const bf16_t* qrow = Qs + (m * 128 + rg * 32 + q31) * QP;
    bf16x8 bq[4]; float qn = 0.f;
#pragma unroll
    for (int kk = 0; kk < 4; ++kk) bq[kk] = *(const bf16x8*)(qrow + 16 * kk + 8 * hi);
#pragma unroll
    for (int d8 = 0; d8 < 8; ++d8) { const u32x4 q4 = *(const u32x4*)(qrow + 8 * d8);
        qn += bflo(q4.x) * bflo(q4.x) + bfhi(q4.x) * bfhi(q4.x) + bflo(q4.y) * bflo(q4.y) + bfhi(q4.y) * bfhi(q4.y) + bflo(q4.z) * bflo(q4.z) + bfhi(q4.z) * bfhi(q4.z) + bflo(q4.w) * bflo(q4.w) + bfhi(q4.w) * bfhi(q4.w); }
    const float kmax = __builtin_bit_cast(float, ((const unsigned*)(p.ws + WS_CTL))[CW_KMAX + l * 64 + (b * 4 + h) * 2 + m]);
    const float mrow = sqrtf(qn) * kmax * 1.002f + 1e-3f;
    f32x16 o[4]; float lsum = 0.f;
#pragma unroll
    for (int dt = 0; dt < 4; ++dt)
#pragma unroll
        for (int r = 0; r < 16; ++r) o[dt][r] = 0.f;
    const int nkt = ctxq ? CTXL / 64 : (CTXL + SEQ) / 64;
    for (int kt = 0; kt < nkt; ++kt) {
        const int krow0 = kt < CTXL / 64 ? TL + b * CTXL + kt * 64 : b * SEQ + (kt - CTXL / 64) * 64;
        __syncthreads();
        for (int i = tid; i < 64 * 16; i += NTHREADS) { const int r = i >> 4, ch = i & 15, mm = ch >> 3, c8 = (ch & 7) * 8;
            *(u32x4*)(Ks + (mm * 64 + r) * KP + c8) = *(const u32x4*)(PC + (size_t)(krow0 + r) * 1536 + 512 + h * 128 + ch * 8); }
        for (int i = tid; i < 64 * 16; i += NTHREADS) { const int r = i >> 4, ch = i & 15;
            const u32x4 v = *(const u32x4*)(PC + (size_t)(krow0 + r) * 1536 + 1024 + h * 128 + ch * 8); bf16_t* d = Vt + (ch * 8) * VP + r;
            d[0] = (bf16_t)v.x; d[VP] = (bf16_t)(v.x >> 16); d[2 * VP] = (bf16_t)v.y; d[3 * VP] = (bf16_t)(v.y >> 16); d[4 * VP] = (bf16_t)v.z; d[5 * VP] = (bf16_t)(v.z >> 16); d[6 * VP] = (bf16_t)v.w; d[7 * VP] = (bf16_t)(v.w >> 16); }
        __syncthreads();
        f32x16 s[2];
#pragma unroll
        for (int kh = 0; kh < 2; ++kh) {
#pragma unroll
            for (int r = 0; r < 16; ++r) s[kh][r] = 0.f;
#pragma unroll
            for (int kk = 0; kk < 4; ++kk) { const bf16x8 a = *(const bf16x8*)(Ks + (m * 64 + kh * 32 + q31) * KP + 16 * kk + 8 * hi);
                s[kh] = __builtin_amdgcn_mfma_f32_32x32x16_bf16(a, bq[kk], s[kh], 0, 0, 0); }
#pragma unroll
            for (int r = 0; r < 16; ++r) { const float e = __expf(s[kh][r] - mrow); s[kh][r] = e; lsum += e; }
        }
#pragma unroll
        for (int st = 0; st < 4; ++st) {
            const int kh = st >> 1, r0 = 8 * (st & 1);
            union { bf16x8 v; unsigned u[4]; } bp;
            bp.u[0] = pk2(s[kh][r0 + 0], s[kh][r0 + 1]); bp.u[1] = pk2(s[kh][r0 + 2], s[kh][r0 + 3]); bp.u[2] = pk2(s[kh][r0 + 4], s[kh][r0 + 5]); bp.u[3] = pk2(s[kh][r0 + 6], s[kh][r0 + 7]);
#pragma unroll
            for (int dt = 0; dt < 4; ++dt) { const bf16_t* vr = Vt + (dt * 32 + q31) * VP + 16 * st + 4 * hi;
                union { bf16x8 v; s16x4 h2[2]; } av; av.h2[0] = *(const s16x4*)vr; av.h2[1] = *(const s16x4*)(vr + 8);
                o[dt] = __builtin_amdgcn_mfma_f32_32x32x16_bf16(av.v, bp.v, o[dt], 0, 0, 0); }
        }
    }
    lsum += shx(lsum, 32);
    const float lamf = ((const float*)(p.ws + WS_MISC))[MI_LAMF + l];
    const float sc = (m == 0 ? 1.0f : lamf) / lsum;
    __syncthreads();
    float* ox = Oex + (rg * 32 + q31) * 132;
    if (m == 1) {
#pragma unroll
        for (int dt = 0; dt < 4; ++dt)
#pragma unroll
            for (int r = 0; r < 16; ++r) ox[dt * 32 + (r & 3) + 8 * (r >> 2) + 4 * hi] = o[dt][r] * sc;
    }
    __syncthreads();
    if (m == 0) {
        float ss = 0.f;
#pragma unroll
        for (int dt = 0; dt < 4; ++dt)
#pragma unroll
            for (int r = 0; r < 16; ++r) { const float v = o[dt][r] * sc - ox[dt * 32 + (r & 3) + 8 * (r >> 2) + 4 * hi]; o[dt][r] = v; ss += v * v; }
        ss += shx(ss, 32);
        const float lam_init = 0.8f - 0.6f * expf(-0.3f * (float)l);
        const float rs = (1.0f - lam_init) / sqrtf(ss * (1.0f / 128.0f) + EPS);
        const float* gn = p.gn_c + l * 128;
        bf16_t* orow = PC + (size_t)(qrow0 + rg * 32 + q31) * 1536 + h * 128;
#pragma unroll
        for (int dt = 0; dt < 4; ++dt)
#pragma unroll
            for (int g4 = 0; g4 < 4; ++g4) { const int dv = dt * 32 + 8 * g4 + 4 * hi; const f32x4 gg = *(const f32x4*)(gn + dv);
                u32x2 wv; wv.x = pk2(o[dt][4 * g4 + 0] * rs * gg[0], o[dt][4 * g4 + 1] * rs * gg[1]); wv.y = pk2(o[dt][4 * g4 + 2] * rs * gg[2], o[dt][4 * g4 + 3] * rs * gg[3]);
                *(u32x2*)(orow + dv) = wv; }
    }
}
__device__ __forceinline__ void phase_mix(const P& p, int l, unsigned char* lds) {
    unsigned* qhead = (unsigned*)(p.ws + WS_CTL) + CW_QUEUE + 64 * l;
    volatile int* slot = (volatile int*)(lds + LDS_BYTES - 64);
    const int n_att_l = BATCH * 4 * (SEQ / 128), n_att_c = (l == 0) ? BATCH * 4 * (CTXL / 128) : 0;
    const int total = 128 + n_att_l + n_att_c;
    for (;;) {
        __syncthreads();
        if (otid() == 0) *slot = (int)atomicAdd(qhead, 1u);
        __syncthreads();
        const int it = *slot;
        if (it >= total) break;
        if (it < 64) dn_chain_mfma(p, it, lds);
        else if (it < 128) gla_chain(p, l, it - 64, lds);
        else if (it < 128 + n_att_l) { const int a = it - 128, b = a / (4 * (SEQ / 128)), rem = a % (4 * (SEQ / 128)), h = rem / (SEQ / 128), qt = rem % (SEQ / 128);
            attn_tile(p, l, b, h, b * SEQ + qt * 128, false, lds); }
        else { const int a = it - 128 - n_att_l, b = a / (4 * (CTXL / 128)), rem = a % (4 * (CTXL / 128)), h = rem / (CTXL / 128), qt = rem % (CTXL / 128);
            attn_tile(p, l, b, h, TL + b * CTXL + qt * 128, true, lds); }
    }
}

__device__ __forceinline__ void phase_post(const P& p, int l, int nrows, int gw, int NGW, int lane) {
    const bf16_t* PZ = (const bf16_t*)(p.ws + WS_PZ); const bf16_t* PB = (const bf16_t*)(p.ws + WS_PB);
#pragma unroll
    for (int br = 0; br < 2; ++br) {
        bf16_t* O = (bf16_t*)(p.ws + (br ? WS_PAQ : WS_H));
        const float* gnb = (br ? p.gn_b : p.gn_a) + l * 128 + 2 * lane;
        const float g0 = gnb[0], g1 = gnb[1];
        for (int it = gw; it < nrows * 4; it += NGW) {
            const int r = it >> 2, h = it & 3, col = h * 128 + 2 * lane;
            const unsigned a = *(const unsigned*)(O + (size_t)r * 512 + col), bq = *(const unsigned*)(O + ((size_t)T + r) * 512 + col);
            const unsigned zz = br ? *(const unsigned*)(PB + (size_t)r * 1536 + 1024 + col) : *(const unsigned*)(PZ + (size_t)r * 512 + col);
            const float o0 = bflo(a) + bflo(bq), o1 = bfhi(a) + bfhi(bq);
            const float rs = 1.0f / sqrtf(wave_sum(o0 * o0 + o1 * o1) * (1.0f / 128.0f) + EPS);
            *(unsigned*)(O + (size_t)r * 512 + col) = pk2(o0 * rs * g0 * siluf_(bflo(zz)), o1 * rs * g1 * siluf_(bfhi(zz)));
        }
    }
}

__device__ __forceinline__ void phase_moe_tables(const P& p, int tid) {
    const unsigned* ecnt = (const unsigned*)(p.ws + WS_CTL) + CW_ECNT; int* misc = (int*)(p.ws + WS_MISC);
    if (blockIdx.x == 0 && tid == 0) { int off = 0, nt = 0;
#pragma unroll 1
        for (int e = 0; e < NE; ++e) { misc[MI_EOFF + e] = off; const int tl = ((int)ecnt[e] + 255) / 256; for (int q = 0; q < tl; ++q) misc[MI_TILEE + nt + q] = e; nt += tl; off += tl * 256; }
        misc[MI_EOFF + NE] = off; misc[MI_NTILES] = nt; }
}
__device__ __forceinline__ void phase_moe_gather(const P& p, int gw, int NGW, int lane) {
    const int* route = (const int*)(p.ws + WS_ROUTE); int* slots = (int*)(p.ws + WS_SLOT); const int* misc = (const int*)(p.ws + WS_MISC);
    unsigned* efill = (unsigned*)(p.ws + WS_CTL) + CW_EFILL;
    const bf16_t* H = (const bf16_t*)(p.ws + WS_H); bf16_t* MA = (bf16_t*)(p.ws + WS_MA);
    for (int it = gw; it < TL * 2; it += NGW) { const int r = it >> 1, k = it & 1, e = route[r * 4 + k];
        int s = 0; if (lane == 0) s = misc[MI_EOFF + e] + (int)atomicAdd(efill + e, 1u);
        s = shlane_i(s, 0);
        if (lane == 0) slots[r * 2 + k] = s;
        const u32x4* src = (const u32x4*)(H + (size_t)r * D); u32x4* dst = (u32x4*)(MA + (size_t)s * D);
        dst[lane] = src[lane]; dst[lane + 64] = src[lane + 64]; }
}
__device__ __forceinline__ void phase_final(const P& p, int gw, int NGW, int lane) {
    const int* route = (const int*)(p.ws + WS_ROUTE); const int* slots = (const int*)(p.ws + WS_SLOT); const bf16_t* Y = (const bf16_t*)(p.ws + WS_MA);
    const float* MOD = (const float*)(p.ws + WS_MOD) + (size_t)1 * 9 * 6144;
    for (int r = gw; r < TL; r += NGW) { const int b = r / SEQ; const float w1 = ((const float*)route)[r * 4 + 2], w2 = ((const float*)route)[r * 4 + 3];
        const bf16_t* y1 = Y + (size_t)slots[r * 2] * D, *y2 = Y + (size_t)slots[r * 2 + 1] * D; float* xr = p.out + (size_t)r * D; const float* g2 = MOD + (size_t)b * 6144 + 5 * 1024;
        f32x4 v[4]; float ss = 0.f;
#pragma unroll
        for (int j = 0; j < 4; ++j) { const int c = 4 * lane + 256 * j; const u32x2 a = *(const u32x2*)(y1 + c), bq = *(const u32x2*)(y2 + c); const f32x4 g = *(const f32x4*)(g2 + c);
            f32x4 y; y[0] = w1 * bflo(a.x) + w2 * bflo(bq.x); y[1] = w1 * bfhi(a.x) + w2 * bfhi(bq.x); y[2] = w1 * bflo(a.y) + w2 * bflo(bq.y); y[3] = w1 * bfhi(a.y) + w2 * bfhi(bq.y);
            v[j] = *(const f32x4*)(xr + c) + g * y; ss += (v[j][0] * v[j][0] + v[j][1] * v[j][1]) + (v[j][2] * v[j][2] + v[j][3] * v[j][3]); }
        const float rs = 1.0f / sqrtf(wave_sum(ss) * (1.0f / D) + EPS);
#pragma unroll
        for (int j = 0; j < 4; ++j) { const int c = 4 * lane + 256 * j; *(f32x4*)(xr + c) = v[j] * rs * *(const f32x4*)(p.final_g + c); }
    }
}

__device__ __forceinline__ void convert_up(const float* w1, const float* w3, int ne, bf16_t* up, float* scr, int gw, int NGW, int lane) {
    const int nblk = NUP / 32, items_e = (D / 64) * nblk;
    for (int it = gw; it < ne * items_e; it += NGW) {
        const int e = it / items_e, ie = it % items_e, kb = ie / nblk, nb = ie % nblk, k0 = 64 * kb, n0 = 32 * nb, n = n0 + (lane & 31), tile = n >> 8, rr = n & 255;
        const float* W = (rr < 128 ? w1 : w3) + (size_t)e * D * DFF; const int sc = tile * 128 + (rr & 127);
#pragma unroll 8
        for (int i = 0; i < 32; ++i) { const int kk = 2 * i + (lane >> 5); scr[kk * 33 + (lane & 31)] = W[(size_t)(k0 + kk) * DFF + sc]; }
        asm volatile("s_waitcnt lgkmcnt(0)" ::: "memory");
        const int c = lane & 7;
#pragma unroll
        for (int j = 0; j < 4; ++j) { const int nn = (lane >> 3) + 8 * j; const float* s = scr + (8 * c) * 33 + nn;
            u32x4 o; o.x = pk2(s[0 * 33], s[1 * 33]); o.y = pk2(s[2 * 33], s[3 * 33]); o.z = pk2(s[4 * 33], s[5 * 33]); o.w = pk2(s[6 * 33], s[7 * 33]);
            *(u32x4*)(up + ((size_t)e * NUP + n0 + nn) * D + k0 + 8 * c) = o; }
        asm volatile("s_waitcnt lgkmcnt(0)" ::: "memory");
    }
}
typedef __attribute__((address_space(4))) const P* KArgs;
#define LOADP(p) asm volatile("" : "+s"(kp)); P p; __builtin_memcpy(&p, kp, sizeof(P))
__global__ void __launch_bounds__(NTHREADS, 2) mk_fwd(P p_unused) {
    extern __shared__ __attribute__((aligned(16))) unsigned char lds[];
    cg::grid_group grid = cg::this_grid();
    KArgs kp = (KArgs)__builtin_amdgcn_kernarg_segment_ptr();
    const int G = gridDim.x, NGW = G * NWAVES;
#define IDS() const int tid = otid(), lane = tid & 63, wave = __builtin_amdgcn_readfirstlane(tid >> 6), gw = blockIdx.x * NWAVES + wave; (void)tid; (void)lane; (void)gw; (void)wave
    PG8_LAS unsigned char* glds = (PG8_LAS unsigned char*)lds;

    {
        LOADP(p); IDS(); unsigned char* ws = p.ws;
        float* scr = (float*)(lds + 49152) + wave * (64 * 33);
        for (int l = 0; l < DEPTH; ++l) {
            convert_T(p.w_in + (size_t)l * D * 8240, D, 8240, (bf16_t*)(ws + WB_WIN + l * WIN_BYTES), NIN, CmWin(), scr, (gw + 37 * l) % NGW, NGW, lane);
            convert_T(p.w_o_a + (size_t)l * 512 * D, 512, D, (bf16_t*)(ws + WB_WO + (l * 3 + 0) * WO_BYTES), D, CmIdent(), scr, (gw + 300 + 700 * l) % NGW, NGW, lane);
            convert_T(p.w_o_b + (size_t)l * 512 * D, 512, D, (bf16_t*)(ws + WB_WO + (l * 3 + 1) * WO_BYTES), D, CmIdent(), scr, (gw + 556 + 700 * l) % NGW, NGW, lane);
            convert_T(p.w_o_c + (size_t)l * 512 * D, 512, D, (bf16_t*)(ws + WB_WO + (l * 3 + 2) * WO_BYTES), D, CmIdent(), scr, (gw + 812 + 700 * l) % NGW, NGW, lane);
            convert_T(p.w_out + (size_t)l * D * D, D, D, (bf16_t*)(ws + WB_WOUT + l * WOUT_BYTES), D, CmIdent(), scr, (gw + 1068 + 512 * l) % NGW, NGW, lane);
        }
        convert_up(p.ffn_w1, p.ffn_w3, 1, (bf16_t*)(ws + WB_WUP), scr, (gw + 1500) % NGW, NGW, lane);
        convert_T(p.ffn_w2, DFF, D, (bf16_t*)(ws + WB_WDN), D, CmIdent(), scr, (gw + 900) % NGW, NGW, lane);
        __syncthreads();
        phase_mod(p, lds);
    }
    grid.sync();

    for (int l = 0; l < DEPTH; ++l) {
        const bool last = (l == DEPTH - 1);
        const int Mrows = last ? TL : T;
        { LOADP(p); IDS(); unsigned char* ws = p.ws;
          phase_modulate(l == 0 ? p.x : p.out, l == 0 ? p.ctx : (const float*)(ws + WS_XC), T, p.norm1_g + l * D, (const float*)(ws + WS_MOD) + (size_t)l * 9 * 6144, 0, (bf16_t*)(ws + WS_H), nullptr, nullptr, nullptr, gw, NGW, lane); }
        grid.sync();
        { LOADP(p); unsigned char* ws = p.ws;
            pg8::Gemm g{(const bf16_t*)(ws + WS_H), (const bf16_t*)(ws + WB_WIN + l * WIN_BYTES), T, NIN, D, D}; pg8::StaticOrder S; S.init(T, NIN, G, (int)blockIdx.x);
            EpiWin E{(bf16_t*)(ws + WS_PAQ), (bf16_t*)(ws + WS_PZ), (bf16_t*)(ws + WS_PB), (bf16_t*)(ws + WS_PC), (bf16_t*)(ws + WS_PG), (float*)(ws + WS_SMALL)};
            pg8::gemm_phase<EpiWin, pg8::StaticOrder, true, true>(glds, g, S, E);
        }
        grid.sync();
        { LOADP(p); IDS(); phase_prep(p, l, lds, gw, NGW, lane); }
        grid.sync();
        { LOADP(p); phase_mix(p, l, lds); }
        grid.sync();
        { LOADP(p); IDS(); phase_post(p, l, Mrows, gw, NGW, lane); }
        grid.sync();
        for (int br = 0; br < 3; ++br) {
            LOADP(p); unsigned char* ws = p.ws;
            const bf16_t* A = br == 0 ? (const bf16_t*)(ws + WS_H) : br == 1 ? (const bf16_t*)(ws + WS_PAQ) : (const bf16_t*)(ws + WS_PC);
            pg8::Gemm g{A, (const bf16_t*)(ws + WB_WO + (l * 3 + br) * WO_BYTES), Mrows, D, 512, br == 2 ? 1536 : 512}; pg8::StaticOrder S; S.init(Mrows, D, G, (int)blockIdx.x);
            EpiGate E{(bf16_t*)(ws + WS_DNQKV), (const bf16_t*)(ws + WS_PG), br};
            pg8::gemm_phase<EpiGate, pg8::StaticOrder, true, true>(glds, g, S, E);
            __syncthreads();
        }
        grid.sync();
        { LOADP(p); unsigned char* ws = p.ws;
            pg8::Gemm g{(const bf16_t*)(ws + WS_DNQKV), (const bf16_t*)(ws + WB_WOUT + l * WOUT_BYTES), Mrows, D, D, D}; pg8::StaticOrder S; S.init(Mrows, D, G, (int)blockIdx.x);
            EpiResid E{l == 0 ? p.x : p.out, l == 0 ? p.ctx : (const float*)(ws + WS_XC), p.out, (float*)(ws + WS_XC), (const float*)(ws + WS_MOD) + (size_t)l * 9 * 6144, 2};
            pg8::gemm_phase<EpiResid, pg8::StaticOrder, true, true>(glds, g, S, E);
        }
        grid.sync();
        { LOADP(p); IDS(); unsigned char* ws = p.ws;
          phase_modulate(p.out, (const float*)(ws + WS_XC), Mrows, p.norm2_g + l * D, (const float*)(ws + WS_MOD) + (size_t)l * 9 * 6144, 3, (bf16_t*)(ws + WS_H), last ? p.router_w : nullptr, (int*)(ws + WS_ROUTE), (unsigned*)(ws + WS_CTL) + CW_ECNT, gw, NGW, lane); }
        if (!last) {
            grid.sync();
            { LOADP(p); unsigned char* ws = p.ws;
                pg8::Gemm g{(const bf16_t*)(ws + WS_H), (const bf16_t*)(ws + WB_WUP), T, NUP, D, D}; pg8::StaticOrder S; S.init(T, NUP, G, (int)blockIdx.x);
                EpiSwiglu E{(bf16_t*)(ws + WS_H1), NUP / 256};
                pg8::gemm_phase<EpiSwiglu, pg8::StaticOrder, true, true>(glds, g, S, E);
            }
            grid.sync();
            { LOADP(p); unsigned char* ws = p.ws;
                pg8::Gemm g{(const bf16_t*)(ws + WS_H1), (const bf16_t*)(ws + WB_WDN), T, D, DFF, DFF}; pg8::StaticOrder S; S.init(T, D, G, (int)blockIdx.x);
                EpiResid E{p.out, (const float*)(ws + WS_XC), p.out, (float*)(ws + WS_XC), (const float*)(ws + WS_MOD) + (size_t)l * 9 * 6144, 5};
                pg8::gemm_phase<EpiResid, pg8::StaticOrder, true, true>(glds, g, S, E);
            }
            grid.sync();
        } else {
            { LOADP(p); IDS(); unsigned char* ws = p.ws;
                float* scr = (float*)lds + wave * (64 * 33);
                convert_up(p.moe_w1, p.moe_w3, NE, (bf16_t*)(ws + WS_MWUP), scr, gw, NGW, lane);
                for (int e = 0; e < NE; ++e)
                    convert_T(p.moe_w2 + (size_t)e * DFF * D, DFF, D, (bf16_t*)(ws + WS_MWDN) + (size_t)e * D * DFF, D, CmIdent(), scr, (gw + 173 * e) % NGW, NGW, lane);
            }
            grid.sync();
            { LOADP(p); IDS(); phase_moe_tables(p, tid); }
            grid.sync();
            { LOADP(p); IDS(); phase_moe_gather(p, gw, NGW, lane); }
            grid.sync();
            { LOADP(p); unsigned char* ws = p.ws; const int* misc = (const int*)(ws + WS_MISC);
                pg8::Gemm g{(const bf16_t*)(ws + WS_MA), (const bf16_t*)(ws + WS_MWUP), MOE_ROWS, NE * NUP, D, D};
                MoeOrder S{misc[MI_NTILES], NUP / 256, G, (int)blockIdx.x, misc + MI_TILEE};
                EpiSwiglu E{(bf16_t*)(ws + WS_MH1), NUP / 256};
                pg8::gemm_phase<EpiSwiglu, MoeOrder, true, true>(glds, g, S, E);
            }
            grid.sync();
            { LOADP(p); unsigned char* ws = p.ws; const int* misc = (const int*)(ws + WS_MISC);
                pg8::Gemm g{(const bf16_t*)(ws + WS_MH1), (const bf16_t*)(ws + WS_MWDN), MOE_ROWS, NE * D, DFF, DFF};
                MoeOrder S{misc[MI_NTILES], D / 256, G, (int)blockIdx.x, misc + MI_TILEE};
                EpiMoeDown E{(bf16_t*)(ws + WS_MA)};
                pg8::gemm_phase<EpiMoeDown, MoeOrder, true, true>(glds, g, S, E);
            }
            grid.sync();
            { LOADP(p); IDS(); phase_final(p, gw, NGW, lane); }
        }
    }
}

extern "C" void kernel_launch(void* const* d_in, const int* in_sizes, int n_in, void* d_out, int out_size, void* d_ws, size_t ws_size, hipStream_t stream) {
    static int grid_blocks = 0;
    if (grid_blocks == 0) {
        if (n_in != 30 || in_sizes[0] != TL * D || out_size != TL * D || ws_size < WS_END) {
            fprintf(stderr, "kernel_launch: built for 30 inputs, x/out of %d floats, >= %zu bytes of d_ws; got n_in %d, in0 %d, out %d, ws %zu; nothing launched\n", TL * D, (size_t)WS_END, n_in, n_in > 0 ? in_sizes[0] : -1, out_size, ws_size);
            grid_blocks = -1; return; }
        int dev = 0, cus = 0, per_cu = 0;
        hipGetDevice(&dev);
        hipDeviceGetAttribute(&cus, hipDeviceAttributeMultiprocessorCount, dev);
        hipFuncSetAttribute((const void*)mk_fwd, hipFuncAttributeMaxDynamicSharedMemorySize, LDS_BYTES);
        hipOccupancyMaxActiveBlocksPerMultiprocessor(&per_cu, (const void*)mk_fwd, NTHREADS, LDS_BYTES);
        if (per_cu < 1) { fprintf(stderr, "kernel_launch: occupancy query reports %d blocks/CU; nothing launched\n", per_cu); grid_blocks = -1; return; }
        grid_blocks = cus;
    }
    if (grid_blocks < 0) return;
    hipMemsetAsync((char*)d_ws + WS_CTL, 0, CTL_BYTES, stream);
    P p{};
    const float** f = (const float**)&p;
    for (int i = 0; i < 30; ++i) f[i] = (const float*)d_in[i];
    p.out = (float*)d_out; p.ws = (unsigned char*)d_ws;
    void* args[] = {&p};
    hipError_t e = hipLaunchCooperativeKernel((const void*)mk_fwd, dim3(grid_blocks), dim3(NTHREADS), args, LDS_BYTES, stream);
    if (e != hipSuccess) fprintf(stderr, "kernel_launch: cooperative launch failed: %s (grid %d)\n", hipGetErrorString(e), grid_blocks);
}
```

```cpp
#include <hip/hip_runtime.h>
#include <hip/hip_cooperative_groups.h>
#include <cstdio>
#include <cstdint>
namespace cg = cooperative_groups;

namespace pg8 {
#define PG8_LAS __attribute__((address_space(3)))
typedef unsigned short bf16_t;
typedef short bf16x8 __attribute__((ext_vector_type(8)));
typedef float f32x4 __attribute__((ext_vector_type(4)));
typedef unsigned u32x4 __attribute__((ext_vector_type(4)));
constexpr int BM = 256, BK = 64, HALF = 128, HTB = HALF * BK * 2  , STAGE_BYTES = 8 * HTB, NXCD = 8, WGM = 8;

__host__ __device__ __forceinline__ int lds_byte(int r, int c) { const int st = (r >> 4) * 2 + (c >> 5), rr = r & 15, cc = c & 31, ob = rr * 64 + cc * 2; return st * 1024 + (ob ^ (((ob >> 9) & 1) << 5)); }
__host__ __device__ __forceinline__ void stage_rc(int b, int& R, int& C) { const int st = b / 1024, sb = b % 1024, swz = sb ^ (((sb >> 9) & 1) << 5); R = (st >> 1) * 16 + swz / 64; C = (st & 1) * 32 + (swz % 64) / 2; }
__host__ __device__ __forceinline__ int perm32(int rho) { const int n = rho >> 4, i = rho & 15; return 8 * (i >> 2) + 4 * n + (i & 3); }

struct Unit { int pm, pn; };
struct Gemm { const bf16_t* A; const bf16_t* Bt; int M, N, K, lda; };

struct StaticOrder {
    int nM, nN, nwg, G, c;
    __host__ __device__ void init(int M, int N, int G_, int c_) { nM = M / BM; nN = N / BM; nwg = nM * nN; G = G_; c = c_; }
    __host__ __device__ bool next(int i, Unit& u) const {
        const long L = (long)i * G + c; if (L >= nwg) return false;
        int wgid = (int)L; { const int q = nwg / NXCD, r = nwg % NXCD, xcd = wgid % NXCD, off = wgid / NXCD; wgid = (xcd < r ? xcd * (q + 1) : r * (q + 1) + (xcd - r) * q) + off; }
        const int nig = WGM * nN, gid = wgid / nig, fm = gid * WGM, gsz = (nM - fm) < WGM ? (nM - fm) : WGM;
        u.pm = fm + ((wgid % nig) % gsz); u.pn = (wgid % nig) / gsz; return true;
    }
    __device__ __forceinline__ void a_ready(const Unit&) const {}
    __device__ __forceinline__ void done(const Unit&) const {}
};


template <class Epi, class Sched, bool ALIGN_EPI = false, bool SP2 = false>
__device__ __forceinline__ void gemm_phase(PG8_LAS unsigned char* lds, const Gemm g, const Sched& S, const Epi& E) {
    int tid_o = threadIdx.x; asm volatile("" : "+v"(tid_o));
    const int tid = tid_o, wid = __builtin_amdgcn_readfirstlane(tid >> 6), lane = tid & 63, wr = wid >> 2, wc = wid & 3, fr = lane & 15, fq = lane >> 4;
    const int K = g.K, nt = K / BK;
    unsigned voffA[2], voffB[2];
#pragma unroll
    for (int i = 0; i < 2; ++i) { int R, C; stage_rc(tid * 16 + i * 8192, R, C); const int Rb = Epi::PERM ? ((R & ~31) + perm32(R & 31)) : R;
        voffA[i] = (unsigned)(R * g.lda + C) * 2u; voffB[i] = (unsigned)(Rb * K + C) * 2u; }
    const size_t kstep = (size_t)(BK * 2);
    const size_t hstepA = (size_t)HALF * g.lda * 2, hstepB = (size_t)HALF * K * 2;
    const size_t tstepA = 2 * hstepA, tstepB = 2 * hstepB;
    const unsigned ldsw = (unsigned)wid * 1024u;
    const int aoff = lds_byte(wr * 64 + fr, fq * 8), boff = lds_byte(wc * 32 + fr, fq * 8);
#define PG8_SA(b, h) (((b) * 2 + (h)) * HTB)
#define PG8_SB(b, h) ((4 + (b) * 2 + (h)) * HTB)
#define PG8_STAGE(bufoff, gbase, voff) do { _Pragma("unroll") for (int _i = 0; _i < 2; ++_i) \
        __builtin_amdgcn_global_load_lds((const unsigned*)((const char*)(gbase) + (voff)[_i]), (PG8_LAS unsigned*)(lds + (bufoff) + ldsw + _i * 8192), 16, 0, 0); } while (0)
#define PG8_LDA(dst, b, h) do { _Pragma("unroll") for (int m = 0; m < 4; ++m) _Pragma("unroll") for (int k = 0; k < 2; ++k) dst[m][k] = *(const PG8_LAS bf16x8*)(lds + PG8_SA(b, h) + aoff + m * 2048 + k * 1024); } while (0)
#define PG8_LDB(dst, b, h) do { _Pragma("unroll") for (int n = 0; n < 2; ++n) _Pragma("unroll") for (int k = 0; k < 2; ++k) dst[n][k] = *(const PG8_LAS bf16x8*)(lds + PG8_SB(b, h) + boff + n * 2048 + k * 1024); } while (0)
#define PG8_MMA(ai, bj, At, Bt) do { __builtin_amdgcn_s_setprio(1); _Pragma("unroll") for (int m = 0; m < 4; ++m) _Pragma("unroll") for (int n = 0; n < 2; ++n) _Pragma("unroll") for (int k = 0; k < 2; ++k) \
        acc[ai][bj][m][n] = __builtin_amdgcn_mfma_f32_16x16x32_bf16(Bt[n][k], At[m][k], acc[ai][bj][m][n], 0, 0, 0); __builtin_amdgcn_s_setprio(0); } while (0)
#define PG8_WAIT_V(n) asm volatile("s_waitcnt vmcnt(" #n ")" ::: "memory")
#define PG8_WAIT_L(n) asm volatile("s_waitcnt lgkmcnt(" #n ")" ::: "memory")
#define PG8_BAR __builtin_amdgcn_s_barrier()
#define PG8_SCHED __builtin_amdgcn_sched_barrier(0)
    Unit cur, nxt; int ui = 0;
    if (!S.next(0, cur)) return;
    f32x4 acc[2][2][4][2];
#pragma unroll
    for (int a = 0; a < 2; ++a)
#pragma unroll
        for (int b = 0; b < 2; ++b)
#pragma unroll
            for (int m = 0; m < 4; ++m)
#pragma unroll
                for (int n = 0; n < 2; ++n) acc[a][b][m][n] = (f32x4){0.f, 0.f, 0.f, 0.f};
    bf16x8 At[4][2], B0[2][2], B1[2][2];
    const char* cA = (const char*)g.A + (size_t)cur.pm * tstepA; const char* cB = (const char*)g.Bt + (size_t)cur.pn * tstepB;
    S.a_ready(cur);
    if constexpr (SP2) {
        PG8_STAGE(PG8_SB(0, 0), cB, voffB); PG8_STAGE(PG8_SB(0, 1), cB + hstepB, voffB); PG8_STAGE(PG8_SA(0, 0), cA, voffA); PG8_STAGE(PG8_SA(0, 1), cA + hstepA, voffA);
        if (wr == 1) PG8_BAR;
        PG8_WAIT_V(2); PG8_BAR;
        PG8_STAGE(PG8_SB(1, 0), cB + kstep, voffB); PG8_STAGE(PG8_SA(1, 0), cA + kstep, voffA); PG8_STAGE(PG8_SB(1, 1), cB + hstepB + kstep, voffB);
        PG8_WAIT_V(6); PG8_BAR;
    } else {
        PG8_STAGE(PG8_SB(0, 0), cB, voffB); PG8_STAGE(PG8_SA(0, 0), cA, voffA); PG8_STAGE(PG8_SB(0, 1), cB + hstepB, voffB); PG8_STAGE(PG8_SA(0, 1), cA + hstepA, voffA);
        if (wr == 1) PG8_BAR;
        PG8_WAIT_V(4); PG8_BAR;
        PG8_STAGE(PG8_SB(1, 0), cB + kstep, voffB); PG8_STAGE(PG8_SA(1, 0), cA + kstep, voffA); PG8_STAGE(PG8_SB(1, 1), cB + hstepB + kstep, voffB);
        PG8_WAIT_V(6); PG8_BAR;
    }
    for (;;) {
        const bool has_next = S.next(ui + 1, nxt);
        const char* nA = has_next ? (const char*)g.A + (size_t)nxt.pm * tstepA : cA; const char* nB = has_next ? (const char*)g.Bt + (size_t)nxt.pn * tstepB : cB;
        for (int t = 0; t < nt; t += 2) {
            const bool last = (t == nt - 2);
            const char* a1 = cA + (size_t)(t + 1) * kstep;
            const char* a2 = last ? nA : cA + (size_t)(t + 2) * kstep; const char* b2 = last ? nB : cB + (size_t)(t + 2) * kstep;
            const char* a3 = a2 + kstep; const char* b3 = b2 + kstep;
            if (last && has_next) S.a_ready(nxt);
            if constexpr (SP2) {
            PG8_LDB(B0, 0, 0); PG8_LDB(B1, 0, 1); PG8_SCHED; PG8_LDA(At, 0, 0); PG8_STAGE(PG8_SA(1, 1), a1 + hstepA, voffA);
            PG8_WAIT_V(8); PG8_WAIT_L(0); PG8_BAR; PG8_MMA(0, 0, At, B0); PG8_MMA(0, 1, At, B1); PG8_BAR; PG8_SCHED;
            PG8_LDA(At, 0, 1); PG8_STAGE(PG8_SB(0, 0), b2, voffB); PG8_STAGE(PG8_SB(0, 1), b2 + hstepB, voffB); PG8_STAGE(PG8_SA(0, 0), a2, voffA);
            PG8_WAIT_V(8); PG8_WAIT_L(0); PG8_BAR; PG8_MMA(1, 0, At, B0); PG8_MMA(1, 1, At, B1); PG8_BAR; PG8_SCHED;
            PG8_LDB(B0, 1, 0); PG8_LDB(B1, 1, 1); PG8_SCHED; PG8_LDA(At, 1, 0); PG8_STAGE(PG8_SA(0, 1), a2 + hstepA, voffA);
            PG8_WAIT_V(8); PG8_WAIT_L(0); PG8_BAR; PG8_MMA(0, 0, At, B0); PG8_MMA(0, 1, At, B1); PG8_BAR; PG8_SCHED;
            PG8_LDA(At, 1, 1); PG8_STAGE(PG8_SB(1, 0), b3, voffB); PG8_STAGE(PG8_SB(1, 1), b3 + hstepB, voffB); PG8_STAGE(PG8_SA(1, 0), a3, voffA);
            PG8_WAIT_V(8); PG8_WAIT_L(0); PG8_BAR; PG8_MMA(1, 0, At, B0); PG8_MMA(1, 1, At, B1); PG8_BAR; PG8_SCHED;
            } else {
            PG8_LDB(B0, 0, 0); PG8_SCHED; PG8_LDA(At, 0, 0); PG8_STAGE(PG8_SA(1, 1), a1 + hstepA, voffA);
            PG8_WAIT_L(8); PG8_BAR; PG8_WAIT_L(0); PG8_MMA(0, 0, At, B0); PG8_BAR; PG8_SCHED;
            PG8_LDB(B1, 0, 1); PG8_STAGE(PG8_SB(0, 0), b2, voffB);
            PG8_BAR; PG8_WAIT_L(0); PG8_MMA(0, 1, At, B1); PG8_BAR;
            PG8_LDA(At, 0, 1); PG8_STAGE(PG8_SA(0, 0), a2, voffA);
            PG8_BAR; PG8_WAIT_L(0); PG8_MMA(1, 0, At, B0); PG8_BAR; PG8_SCHED;
            PG8_STAGE(PG8_SB(0, 1), b2 + hstepB, voffB);
            PG8_WAIT_V(6); PG8_BAR; PG8_MMA(1, 1, At, B1); PG8_BAR;
            PG8_LDB(B0, 1, 0); PG8_SCHED; PG8_LDA(At, 1, 0); PG8_STAGE(PG8_SA(0, 1), a2 + hstepA, voffA);
            PG8_WAIT_L(8); PG8_BAR; PG8_WAIT_L(0); PG8_MMA(0, 0, At, B0); PG8_BAR; PG8_SCHED;
            PG8_LDB(B1, 1, 1); PG8_STAGE(PG8_SB(1, 0), b3, voffB);
            PG8_BAR; PG8_WAIT_L(0); PG8_MMA(0, 1, At, B1); PG8_BAR;
            PG8_LDA(At, 1, 1); PG8_STAGE(PG8_SA(1, 0), a3, voffA);
            PG8_BAR; PG8_WAIT_L(0); PG8_MMA(1, 0, At, B0); PG8_BAR; PG8_SCHED;
            PG8_STAGE(PG8_SB(1, 1), b3 + hstepB, voffB);
            PG8_WAIT_V(6); PG8_BAR; PG8_MMA(1, 1, At, B1); PG8_BAR;
            }
        }
        if constexpr (ALIGN_EPI) { if (wr == 0) PG8_BAR; }
        if constexpr (!Epi::AFTER_DRAIN) { E(acc, cur, wr, wc, fr, fq); S.done(cur); }
        if (!has_next) break;
#pragma unroll
        for (int a = 0; a < 2; ++a)
#pragma unroll
            for (int b = 0; b < 2; ++b)
#pragma unroll
                for (int m = 0; m < 4; ++m)
#pragma unroll
                    for (int n = 0; n < 2; ++n) acc[a][b][m][n] = (f32x4){0.f, 0.f, 0.f, 0.f};
        cur = nxt; cA = nA; cB = nB; ++ui;
        if constexpr (ALIGN_EPI) { if (wr == 1) PG8_BAR; }
    }
    PG8_WAIT_V(0);
    if constexpr (!ALIGN_EPI) { if (wr == 0) PG8_BAR; }
    PG8_BAR;
    if constexpr (Epi::AFTER_DRAIN) { E.fused(acc, cur, wr, wc, fr, fq, lds, wid, lane); S.done(cur); }
#undef PG8_SA
#undef PG8_SB
#undef PG8_STAGE
#undef PG8_LDA
#undef PG8_LDB
#undef PG8_MMA
#undef PG8_WAIT_V
#undef PG8_WAIT_L
#undef PG8_BAR
#undef PG8_SCHED
}
}


constexpr int BATCH = 8, SEQ = 2048, CTXL = 256, D = 1024, DEPTH = 2;
constexpr int TL = BATCH * SEQ, TC = BATCH * CTXL, T = TL + TC;
constexpr int NIN = 8448;
constexpr int DFF = 2816, NE = 8, NUP = 2 * DFF;
constexpr int MOE_ROWS = 2 * TL + NE * 256;
constexpr float EPS = 1e-6f;
constexpr int NTHREADS = 512, NWAVES = 8;
constexpr int LDS_BYTES = 147456;

typedef unsigned short bf16_t;
typedef float f32x4 __attribute__((ext_vector_type(4)));
typedef float f32x16 __attribute__((ext_vector_type(16)));
typedef unsigned u32x4 __attribute__((ext_vector_type(4)));
typedef unsigned u32x2 __attribute__((ext_vector_type(2)));
typedef short bf16x8 __attribute__((ext_vector_type(8)));
typedef short s16x4 __attribute__((ext_vector_type(4)));

constexpr size_t al256(size_t x) { return (x + 255) & ~(size_t)255; }
constexpr size_t WS_CTL   = 0;                                   constexpr size_t CTL_BYTES = 65536;
constexpr size_t WS_MOD   = WS_CTL + CTL_BYTES;                  constexpr size_t MOD_BYTES = (size_t)DEPTH * 9 * 6 * D * 4;
constexpr size_t WS_ROUTE = al256(WS_MOD + MOD_BYTES);           constexpr size_t ROUTE_BYTES = (size_t)TL * 16;
constexpr size_t WS_SLOT  = al256(WS_ROUTE + ROUTE_BYTES);       constexpr size_t SLOT_BYTES = (size_t)TL * 8;
constexpr size_t WS_MISC  = al256(WS_SLOT + SLOT_BYTES);         constexpr size_t MISC_BYTES = 4096;
constexpr size_t WS_GB    = al256(WS_MISC + MISC_BYTES);         constexpr size_t GB_BYTES = (size_t)T * 16 * 4;
constexpr size_t WS_SMALL = al256(WS_GB + GB_BYTES);             constexpr size_t SMALL_BYTES = (size_t)T * 64 * 4;
constexpr size_t WS_XC    = al256(WS_SMALL + SMALL_BYTES);       constexpr size_t XC_BYTES = (size_t)TC * D * 4;
constexpr size_t WS_WB    = al256(WS_XC + XC_BYTES);
constexpr size_t WB_WIN   = WS_WB;                               constexpr size_t WIN_BYTES = (size_t)NIN * D * 2;
constexpr size_t WB_WO    = WB_WIN + DEPTH * WIN_BYTES;          constexpr size_t WO_BYTES = (size_t)D * 512 * 2;
constexpr size_t WB_WOUT  = WB_WO + DEPTH * 3 * WO_BYTES;        constexpr size_t WOUT_BYTES = (size_t)D * D * 2;
constexpr size_t WB_WUP   = WB_WOUT + DEPTH * WOUT_BYTES;        constexpr size_t WUP_BYTES = (size_t)NUP * D * 2;
constexpr size_t WB_WDN   = WB_WUP + WUP_BYTES;                  constexpr size_t WDN_BYTES = (size_t)D * DFF * 2;
constexpr size_t WB_END   = WB_WDN + WDN_BYTES;
constexpr size_t WS_H     = al256(WB_END);                       constexpr size_t H_BYTES = (size_t)T * D * 2;
constexpr size_t WS_PAQ   = al256(WS_H + H_BYTES);               constexpr size_t PAQ_BYTES = (size_t)T * 1536 * 2;
constexpr size_t WS_PZ    = al256(WS_PAQ + PAQ_BYTES);           constexpr size_t PZ_BYTES = (size_t)T * 512 * 2;
constexpr size_t WS_PB    = al256(WS_PZ + PZ_BYTES);             constexpr size_t PB_BYTES = (size_t)T * 1536 * 2;
constexpr size_t WS_PC    = al256(WS_PB + PB_BYTES);             constexpr size_t PC_BYTES = (size_t)T * 1536 * 2;
constexpr size_t WS_PG    = al256(WS_PC + PC_BYTES);             constexpr size_t PG_BYTES = (size_t)T * 3072 * 2;
constexpr size_t WS_DNQKV = al256(WS_PG + PG_BYTES);             constexpr size_t DNQKV_BYTES = (size_t)T * 1536 * 2;
constexpr size_t WS_TQ    = al256(WS_DNQKV + DNQKV_BYTES);       constexpr size_t TQ_BYTES = (size_t)BATCH * 4 * 2 * ((CTXL + SEQ) / 64) * 16384;
constexpr size_t WS_VEC   = al256(WS_TQ + TQ_BYTES);             constexpr size_t VEC_BYTES = (size_t)BATCH * 4 * 2 * ((CTXL + SEQ) / 64) * 1024;
constexpr size_t WS_END   = al256(WS_VEC + VEC_BYTES);
static_assert(WS_END <= (size_t)524288000, "d_ws map exceeds 500 MiB (documented minimum is 525,980,800 B)");
constexpr size_t WS_H1    = WS_PB;
static_assert((size_t)T * DFF * 2 <= PB_BYTES + PC_BYTES, "h1 overlay");
constexpr size_t WS_MWDN  = WS_WB;                                constexpr size_t MWDN_BYTES = (size_t)NE * D * DFF * 2;
static_assert(MWDN_BYTES <= WB_END - WS_WB, "moe wdn overlay");
constexpr size_t WS_MWUP  = WS_PAQ;                               constexpr size_t MWUP_BYTES = (size_t)NE * NUP * D * 2;
constexpr size_t WS_MA    = al256(WS_MWUP + MWUP_BYTES);          constexpr size_t MA_BYTES = (size_t)MOE_ROWS * D * 2;
constexpr size_t WS_MH1   = al256(WS_MA + MA_BYTES);              constexpr size_t MH1_BYTES = (size_t)MOE_ROWS * DFF * 2;
static_assert(WS_MH1 + MH1_BYTES <= WS_END, "moe overlay");
constexpr int CW_QUEUE = 0;
constexpr int CW_KMAX = 256;
constexpr int CW_ECNT = 512;
constexpr int CW_EFILL = 576;
constexpr int MI_LAMF = 0;
constexpr int MI_NTILES = 16;
constexpr int MI_EOFF = 32;
constexpr int MI_TILEE = 64;

__device__ __forceinline__ unsigned f2bf(float f) { unsigned u = __builtin_bit_cast(unsigned, f); return (u + 0x7fffu + ((u >> 16) & 1u)) >> 16; }
__device__ __forceinline__ unsigned pk2(float lo, float hi) { return f2bf(lo) | (f2bf(hi) << 16); }
__device__ __forceinline__ float bflo(unsigned w) { return __builtin_bit_cast(float, w << 16); }
__device__ __forceinline__ float bfhi(unsigned w) { return __builtin_bit_cast(float, w & 0xffff0000u); }
__device__ __forceinline__ float bf2f(bf16_t h) { return __builtin_bit_cast(float, (unsigned)h << 16); }
__device__ __forceinline__ int otid() { int t = threadIdx.x; asm volatile("" : "+v"(t)); return t; }
__device__ __forceinline__ float shx(float v, int o) { const int idx = ((otid() & 63) ^ o) << 2; return __builtin_bit_cast(float, __builtin_amdgcn_ds_bpermute(idx, __builtin_bit_cast(int, v))); }
__device__ __forceinline__ float shup(float v, int o) { const int idx = (((otid() & 63) - o) & 63) << 2; return __builtin_bit_cast(float, __builtin_amdgcn_ds_bpermute(idx, __builtin_bit_cast(int, v))); }
__device__ __forceinline__ float shlane(float v, int src) { return __builtin_bit_cast(float, __builtin_amdgcn_ds_bpermute(src << 2, __builtin_bit_cast(int, v))); }
__device__ __forceinline__ int shlane_i(int v, int src) { return __builtin_amdgcn_ds_bpermute(src << 2, v); }
__device__ __forceinline__ float wave_sum(float v) {
#pragma unroll
    for (int o = 1; o < 64; o <<= 1) v += shx(v, o);
    return v;
}
__device__ __forceinline__ float sigmoidf_(float x) { return 1.0f / (1.0f + __expf(-x)); }
__device__ __forceinline__ float siluf_(float x) { return x / (1.0f + __expf(-x)); }
__device__ __forceinline__ float softplusf_(float x) { return x > 20.f ? x : log1pf(expf(x)); }
__device__ __forceinline__ float logsigmoidf_(float x) { return fminf(x, 0.f) - log1pf(expf(-fabsf(x))); }

struct P {
    const float *x, *c, *ctx, *c_ctx, *w_mod, *b_mod, *norm1_g, *norm2_g, *w_in, *conv_a, *a_log, *dt_bias, *gn_a, *w_gate2, *b_gate, *gn_b,
                *lam_c, *gn_c, *w_o_a, *w_o_b, *w_o_c, *w_out, *ffn_w1, *ffn_w3, *ffn_w2, *router_w, *moe_w1, *moe_w3, *moe_w2, *final_g;
    float* out; unsigned char* ws;
};

template <class ColMap>
__device__ __forceinline__ void convert_T(const float* W, int K, int ldw, bf16_t* WT, int Nrows, ColMap cm, float* scr, int gw, int NGW, int lane) {
    const int nblk = Nrows / 32, items = (K / 64) * nblk;
    for (int it = gw; it < items; it += NGW) {
        const int kb = it / nblk, nb = it % nblk, k0 = 64 * kb, n0 = 32 * nb;
        const int sc = cm(n0 + (lane & 31));
#pragma unroll 8
        for (int i = 0; i < 32; ++i) { const int kk = 2 * i + (lane >> 5); scr[kk * 33 + (lane & 31)] = sc >= 0 ? W[(size_t)(k0 + kk) * ldw + sc] : 0.f; }
        asm volatile("s_waitcnt lgkmcnt(0)" ::: "memory");
        const int c = lane & 7;
#pragma unroll
        for (int j = 0; j < 4; ++j) { const int n = (lane >> 3) + 8 * j; const float* s = scr + (8 * c) * 33 + n;
            u32x4 o; o.x = pk2(s[0 * 33], s[1 * 33]); o.y = pk2(s[2 * 33], s[3 * 33]); o.z = pk2(s[4 * 33], s[5 * 33]); o.w = pk2(s[6 * 33], s[7 * 33]);
            *(u32x4*)(WT + (size_t)(n0 + n) * K + k0 + 8 * c) = o; }
        asm volatile("s_waitcnt lgkmcnt(0)" ::: "memory");
    }
}
struct CmIdent { __device__ int operator()(int n) const { return n; } };
struct CmWin { __device__ int operator()(int n) const {
    if (n < 2048) return n; if (n < 3584) return n + 16; if (n < 8192) return n + 48;
    const int j = n - 8192; if (j < 16) return 2048 + j; if (j < 48) return 3600 + (j - 16); return -1; } };

typedef const f32x4 (&AccRef)[2][2][4][2];
struct EpiWin {
    static constexpr bool PERM = true, AFTER_DRAIN = false;
    bf16_t *paq, *pz, *pb, *pc, *pg; float* small_;
    __device__ __forceinline__ void operator()(AccRef acc, const pg8::Unit& u, int wr, int wc, int fr, int fq) const {
        const int row0 = u.pm * 256 + wr * 64 + fr, pn = u.pn;
        if (pn == 32) {
            if (wc < 2) {
#pragma unroll
                for (int ai = 0; ai < 2; ++ai)
#pragma unroll
                    for (int m = 0; m < 4; ++m) { float* p = small_ + (size_t)(row0 + ai * 128 + m * 16) * 64 + wc * 32 + 8 * fq;
                        *(f32x4*)p = acc[ai][0][m][0]; *(f32x4*)(p + 4) = acc[ai][0][m][1]; }
            }
            return;
        }
        bf16_t* base; int ldc, c0;
        if (pn < 6) { base = paq; ldc = 1536; c0 = pn * 256; } else if (pn < 8) { base = pz; ldc = 512; c0 = (pn - 6) * 256; }
        else if (pn < 14) { base = pb; ldc = 1536; c0 = (pn - 8) * 256; } else if (pn < 20) { base = pc; ldc = 1536; c0 = (pn - 14) * 256; }
        else { base = pg; ldc = 3072; c0 = (pn - 20) * 256; }
        const int col = c0 + wc * 32 + 8 * fq;
#pragma unroll
        for (int ai = 0; ai < 2; ++ai)
#pragma unroll
            for (int m = 0; m < 4; ++m) { bf16_t* rowp = base + (size_t)(row0 + ai * 128 + m * 16) * ldc + col;
#pragma unroll
                for (int bj = 0; bj < 2; ++bj) { const f32x4 v0 = acc[ai][bj][m][0], v1 = acc[ai][bj][m][1];
                    u32x4 w; w.x = pk2(v0[0], v0[1]); w.y = pk2(v0[2], v0[3]); w.z = pk2(v1[0], v1[1]); w.w = pk2(v1[2], v1[3]);
                    *(u32x4*)(rowp + bj * 128) = w; } }
    }
};
struct EpiGate {
    static constexpr bool PERM = true, AFTER_DRAIN = false;
    bf16_t* Mo; const bf16_t* pg; int br;
    __device__ __forceinline__ void operator()(AccRef acc, const pg8::Unit& u, int wr, int wc, int fr, int fq) const {
        const int row0 = u.pm * 256 + wr * 64 + fr, col = u.pn * 256 + wc * 32 + 8 * fq;
#pragma unroll
        for (int ai = 0; ai < 2; ++ai)
#pragma unroll
            for (int m = 0; m < 4; ++m) { const size_t row = (size_t)(row0 + ai * 128 + m * 16);
#pragma unroll
                for (int bj = 0; bj < 2; ++bj) {
                    const u32x4 gw = *(const u32x4*)(pg + row * 3072 + br * 1024 + col + bj * 128);
                    bf16_t* mp = Mo + row * 1024 + col + bj * 128;
                    f32x4 v0 = acc[ai][bj][m][0], v1 = acc[ai][bj][m][1];
                    v0[0] *= sigmoidf_(bflo(gw.x)); v0[1] *= sigmoidf_(bfhi(gw.x)); v0[2] *= sigmoidf_(bflo(gw.y)); v0[3] *= sigmoidf_(bfhi(gw.y));
                    v1[0] *= sigmoidf_(bflo(gw.z)); v1[1] *= sigmoidf_(bfhi(gw.z)); v1[2] *= sigmoidf_(bflo(gw.w)); v1[3] *= sigmoidf_(bfhi(gw.w));
                    if (br != 0) { const u32x4 o = *(const u32x4*)mp;
                        v0[0] += bflo(o.x); v0[1] += bfhi(o.x); v0[2] += bflo(o.y); v0[3] += bfhi(o.y); v1[0] += bflo(o.z); v1[1] += bfhi(o.z); v1[2] += bflo(o.w); v1[3] += bfhi(o.w); }
                    u32x4 w; w.x = pk2(v0[0], v0[1]); w.y = pk2(v0[2], v0[3]); w.z = pk2(v1[0], v1[1]); w.w = pk2(v1[2], v1[3]);
                    *(u32x4*)mp = w; } }
    }
};
struct EpiResid {
    static constexpr bool PERM = false, AFTER_DRAIN = false;
    const float *old_l, *old_c; float *out_l, *out_c; const float* mod; int gidx;
    __device__ __forceinline__ void operator()(AccRef acc, const pg8::Unit& u, int wr, int wc, int fr, int fq) const {
        const int col0 = u.pn * 256 + wc * 32 + 4 * fq;
        const bool isctx = u.pm >= TL / 256; const int b = isctx ? 8 : u.pm / (SEQ / 256);
        const float* g = mod + (size_t)b * 6144 + gidx * 1024 + col0;
        const float* ob = isctx ? old_c - (size_t)TL * D : old_l; float* wb = isctx ? out_c - (size_t)TL * D : out_l;
        f32x4 gv[2][2];
#pragma unroll
        for (int bj = 0; bj < 2; ++bj)
#pragma unroll
            for (int n = 0; n < 2; ++n) gv[bj][n] = *(const f32x4*)(g + bj * 128 + n * 16);
#pragma unroll
        for (int ai = 0; ai < 2; ++ai)
#pragma unroll
            for (int m = 0; m < 4; ++m) { const size_t off = (size_t)(u.pm * 256 + ai * 128 + wr * 64 + m * 16 + fr) * D + col0;
#pragma unroll
                for (int bj = 0; bj < 2; ++bj)
#pragma unroll
                    for (int n = 0; n < 2; ++n) { const f32x4 xo = *(const f32x4*)(ob + off + bj * 128 + n * 16);
                        *(f32x4*)(wb + off + bj * 128 + n * 16) = xo + gv[bj][n] * acc[ai][bj][m][n]; } }
    }
};
struct EpiSwiglu {
    static constexpr bool PERM = true, AFTER_DRAIN = false;
    bf16_t* h1; int NJ;
    __device__ __forceinline__ void operator()(AccRef acc, const pg8::Unit& u, int wr, int wc, int fr, int fq) const {
        const int row0 = u.pm * 256 + wr * 64 + fr, col = (u.pn % NJ) * 128 + wc * 32 + 8 * fq;
#pragma unroll
        for (int ai = 0; ai < 2; ++ai)
#pragma unroll
            for (int m = 0; m < 4; ++m) { const f32x4 a0 = acc[ai][0][m][0], a1 = acc[ai][0][m][1], b0 = acc[ai][1][m][0], b1 = acc[ai][1][m][1];
                u32x4 w; w.x = pk2(siluf_(a0[0]) * b0[0], siluf_(a0[1]) * b0[1]); w.y = pk2(siluf_(a0[2]) * b0[2], siluf_(a0[3]) * b0[3]);
                w.z = pk2(siluf_(a1[0]) * b1[0], siluf_(a1[1]) * b1[1]); w.w = pk2(siluf_(a1[2]) * b1[2], siluf_(a1[3]) * b1[3]);
                *(u32x4*)(h1 + (size_t)(row0 + ai * 128 + m * 16) * DFF + col) = w; }
    }
};
struct EpiMoeDown {
    static constexpr bool PERM = true, AFTER_DRAIN = false;
    bf16_t* y;
    __device__ __forceinline__ void operator()(AccRef acc, const pg8::Unit& u, int wr, int wc, int fr, int fq) const {
        const int row0 = u.pm * 256 + wr * 64 + fr, col = (u.pn % 4) * 256 + wc * 32 + 8 * fq;
#pragma unroll
        for (int ai = 0; ai < 2; ++ai)
#pragma unroll
            for (int m = 0; m < 4; ++m) { bf16_t* rowp = y + (size_t)(row0 + ai * 128 + m * 16) * D + col;
#pragma unroll
                for (int bj = 0; bj < 2; ++bj) { const f32x4 v0 = acc[ai][bj][m][0], v1 = acc[ai][bj][m][1];
                    u32x4 w; w.x = pk2(v0[0], v0[1]); w.y = pk2(v0[2], v0[3]); w.z = pk2(v1[0], v1[1]); w.w = pk2(v1[2], v1[3]);
                    *(u32x4*)(rowp + bj * 128) = w; } }
    }
};
struct MoeOrder {
    int ntiles, NJ, G, c; const int* tile_e;
    __device__ bool next(int i, pg8::Unit& u) const { const long L = (long)i * G + c; if (L >= (long)ntiles * NJ) return false;
        const int t = (int)(L / NJ), j = (int)(L % NJ); u.pm = t; u.pn = tile_e[t] * NJ + j; return true; }
    __device__ __forceinline__ void a_ready(const pg8::Unit&) const {}
    __device__ __forceinline__ void done(const pg8::Unit&) const {}
};

__device__ __forceinline__ void phase_mod(const P& p, unsigned char* lds) {
    float* sc = (float*)lds;
    float* red = sc + 9 * 1024;
    const int tid = otid();
    for (int i = tid; i < 9 * 1024; i += NTHREADS) { const int r = i >> 10, k = i & 1023; const float v = r < 8 ? p.c[r * 1024 + k] : p.c_ctx[k]; sc[i] = siluf_(v); }
    __syncthreads();
    float* MOD = (float*)(p.ws + WS_MOD);
    const int cj = tid % 48, ks = tid / 48;
    for (int grp = blockIdx.x; grp < DEPTH * 6144 / 48; grp += gridDim.x) {
        const int l = grp / 128, j = (grp % 128) * 48 + cj;
        float a[9];
#pragma unroll
        for (int r = 0; r < 9; ++r) a[r] = 0.f;
        if (ks < 10) {
            const float* w = p.w_mod + (size_t)l * 1024 * 6144 + j;
            for (int k = ks; k < 1024; k += 10) { const float wv = w[(size_t)k * 6144];
#pragma unroll
                for (int r = 0; r < 9; ++r) a[r] += sc[r * 1024 + k] * wv; }
#pragma unroll
            for (int r = 0; r < 9; ++r) red[(ks * 9 + r) * 48 + cj] = a[r];
        }
        __syncthreads();
        if (tid < 9 * 48) { const int r = tid / 48, c2 = tid % 48; float s = 0.f;
#pragma unroll
            for (int q = 0; q < 10; ++q) s += red[(q * 9 + r) * 48 + c2];
            const int jj = (grp % 128) * 48 + c2;
            MOD[((size_t)l * 9 + r) * 6144 + jj] = s + p.b_mod[l * 6144 + jj]; }
        __syncthreads();
    }
}

__device__ __forceinline__ void phase_modulate(const float* src_l, const float* src_c, int nrows, const float* gain, const float* mod, int shift_idx,
                                               bf16_t* H, const float* router_w, int* route, unsigned* ecnt, int gw, int NGW, int lane) {
    for (int r = gw; r < nrows; r += NGW) {
        const bool isctx = r >= TL; const int b = isctx ? 8 : r / SEQ;
        const float* xr = isctx ? src_c + (size_t)(r - TL) * D : src_l + (size_t)r * D;
        const float* sh = mod + (size_t)b * 6144 + shift_idx * 1024; const float* scl = sh + 1024;
        f32x4 v[4]; float ss = 0.f;
#pragma unroll
        for (int j = 0; j < 4; ++j) { v[j] = *(const f32x4*)(xr + 4 * lane + 256 * j); ss += (v[j][0] * v[j][0] + v[j][1] * v[j][1]) + (v[j][2] * v[j][2] + v[j][3] * v[j][3]); }
        const float rs = 1.0f / sqrtf(wave_sum(ss) * (1.0f / D) + EPS);
#pragma unroll
        for (int j = 0; j < 4; ++j) { const int c = 4 * lane + 256 * j; const f32x4 g = *(const f32x4*)(gain + c), s1 = *(const f32x4*)(scl + c), s0 = *(const f32x4*)(sh + c);
            v[j] = v[j] * rs * g * (1.0f + s1) + s0;
            u32x2 w; w.x = pk2(v[j][0], v[j][1]); w.y = pk2(v[j][2], v[j][3]);
            *(u32x2*)(H + (size_t)r * D + c) = w; }
        if (router_w) {
            float lg[NE];
#pragma unroll
            for (int e = 0; e < NE; ++e) lg[e] = 0.f;
#pragma unroll
            for (int j = 0; j < 4; ++j)
#pragma unroll
                for (int q = 0; q < 4; ++q) { const float* rw = router_w + (size_t)(4 * lane + 256 * j + q) * NE; const f32x4 r0 = *(const f32x4*)rw, r1 = *(const f32x4*)(rw + 4); const float hv = v[j][q];
                    lg[0] += hv * r0[0]; lg[1] += hv * r0[1]; lg[2] += hv * r0[2]; lg[3] += hv * r0[3]; lg[4] += hv * r1[0]; lg[5] += hv * r1[1]; lg[6] += hv * r1[2]; lg[7] += hv * r1[3]; }
#pragma unroll
            for (int e = 0; e < NE; ++e) lg[e] = wave_sum(lg[e]);
            int e1 = 0; float v1 = lg[0];
#pragma unroll
            for (int e = 1; e < NE; ++e) if (lg[e] > v1) { v1 = lg[e]; e1 = e; }
            int e2 = -1; float v2 = -3.0e38f;
#pragma unroll
            for (int e = 0; e < NE; ++e) if (e != e1 && lg[e] > v2) { v2 = lg[e]; e2 = e; }
            const float w2 = 1.0f / (1.0f + expf(v1 - v2)), w1 = 1.0f - w2;
            if (lane == 0) { route[r * 4 + 0] = e1; route[r * 4 + 1] = e2; ((float*)route)[r * 4 + 2] = w1; ((float*)route)[r * 4 + 3] = w2;
                atomicAdd(ecnt + e1, 1u); atomicAdd(ecnt + e2, 1u); }
        }
    }
}


typedef short v4i16_t __attribute__((ext_vector_type(4)));
__device__ __forceinline__ s16x4 lds_tr(const bf16_t* pp) { return __builtin_bit_cast(s16x4, __builtin_amdgcn_ds_read_tr16_b64_v4i16((__attribute__((address_space(3))) v4i16_t*)pp)); }
__device__ __forceinline__ bf16x8 cat8(s16x4 a, s16x4 b) { union { bf16x8 v; s16x4 h[2]; } u; u.h[0] = a; u.h[1] = b; return u.v; }
__device__ __forceinline__ bf16x8 pack8(f32x4 a, f32x4 b) { union { bf16x8 v; unsigned u[4]; } r; r.u[0] = pk2(a[0], a[1]); r.u[1] = pk2(a[2], a[3]); r.u[2] = pk2(b[0], b[1]); r.u[3] = pk2(b[2], b[3]); return r.v; }
constexpr int DN_NCH = (CTXL + SEQ) / 64;
constexpr int DN_ITEMS = BATCH * 4 * 2 * DN_NCH;
constexpr int PREP_WLDS = 16384 + 17408 + 512;

__device__ __forceinline__ int dn_row(int n, int s, int b, int dir) {
    const bool isctx = n < CTXL / 64; const int L = isctx ? CTXL : SEQ, c = isctx ? n : n - CTXL / 64, u = 64 * c + s, t = dir ? L - 1 - u : u;
    return (isctx ? TL + b * CTXL : b * SEQ) + t;
}
__device__ __forceinline__ void dn_prep_item(const P& p, int l, int item, unsigned char* wlds, int lane) {
    const int n = item % DN_NCH, bhd = item / DN_NCH, dir = bhd & 1, h = (bhd >> 1) & 3, b = bhd >> 3;
    const bool isctx = n < CTXL / 64; const int L = isctx ? CTXL : SEQ, cch = isctx ? n : n - CTXL / 64, rbase = isctx ? TL + b * CTXL : b * SEQ;
    const int i16 = lane & 15, g = lane >> 4;
    const bf16_t* PAQ = (const bf16_t*)(p.ws + WS_PAQ); bf16_t* DN = (bf16_t*)(p.ws + WS_DNQKV); const float* SMALL = (const float*)(p.ws + WS_SMALL);
    const float* cw = p.conv_a + (size_t)l * 3 * 1536;
    constexpr int KCP = 136;
    float* Ls = (float*)wlds; bf16_t* Kc = (bf16_t*)(wlds + 16384); float* Tl = (float*)(wlds + 16384);
    float* gcs = (float*)(wlds + 16384 + 17408); float* bes = gcs + 64;
    {
        const int r = dn_row(n, lane, b, dir);
        const float bb = SMALL[(size_t)r * 64 + dir * 4 + h], aa = SMALL[(size_t)r * 64 + 8 + dir * 4 + h];
        const float gv = -expf(p.a_log[l * 8 + dir * 4 + h]) * softplusf_(aa + p.dt_bias[l * 8 + dir * 4 + h]), be = sigmoidf_(bb);
        float gc = gv;
#pragma unroll
        for (int o = 1; o < 64; o <<= 1) { const float u = shup(gc, o); if (lane >= o) gc += u; }
        const float gl = shlane(gc, 63);
        gcs[lane] = gc; bes[lane] = be;
        float* vec = (float*)(p.ws + WS_VEC) + (size_t)item * 256;
        vec[lane] = expf(gc); vec[64 + lane] = expf(gl - gc); vec[128 + lane] = be; vec[192 + lane] = expf(gl);
    }
    auto conv_frag = [&](int seg, int mt, bf16x8 (&F)[4]) {
        const int u = 64 * cch + 16 * mt + i16, t = dir ? L - 1 - u : u; const size_t r = (size_t)(rbase + t);
        float y[4][8]; float ss = 0.f;
#pragma unroll
        for (int ks = 0; ks < 4; ++ks) { const int col = seg * 512 + h * 128 + 32 * ks + 8 * g;
            const u32x4 x1 = *(const u32x4*)(PAQ + r * 1536 + col);
            u32x4 x0 = (u32x4){0u, 0u, 0u, 0u}, x2 = (u32x4){0u, 0u, 0u, 0u};
            if (t > 0) x0 = *(const u32x4*)(PAQ + (r - 1) * 1536 + col);
            if (t < L - 1) x2 = *(const u32x4*)(PAQ + (r + 1) * 1536 + col);
            const f32x4 wa0 = *(const f32x4*)(cw + col), wa1 = *(const f32x4*)(cw + col + 4), wb0 = *(const f32x4*)(cw + 1536 + col), wb1 = *(const f32x4*)(cw + 1536 + col + 4),
                        wc0 = *(const f32x4*)(cw + 3072 + col), wc1 = *(const f32x4*)(cw + 3072 + col + 4);
            const unsigned xa[4] = {x0.x, x0.y, x0.z, x0.w}, xb[4] = {x1.x, x1.y, x1.z, x1.w}, xc[4] = {x2.x, x2.y, x2.z, x2.w};
#pragma unroll
            for (int q = 0; q < 4; ++q) { const f32x4& wa = q < 2 ? wa0 : wa1; const f32x4& wb = q < 2 ? wb0 : wb1; const f32x4& wc = q < 2 ? wc0 : wc1; const int e2 = (2 * q) & 3;
                const float v0 = siluf_(wa[e2] * bflo(xa[q]) + wb[e2] * bflo(xb[q]) + wc[e2] * bflo(xc[q])), v1 = siluf_(wa[e2 + 1] * bfhi(xa[q]) + wb[e2 + 1] * bfhi(xb[q]) + wc[e2 + 1] * bfhi(xc[q]));
                y[ks][2 * q] = v0; y[ks][2 * q + 1] = v1; ss += v0 * v0 + v1 * v1; }
            if (ks == 1) asm volatile("" ::: "memory");
        }
        float sc = 1.0f;
        if (seg < 2) { ss += shx(ss, 16); ss += shx(ss, 32); sc = 1.0f / sqrtf(ss + EPS); if (seg == 0) sc *= 0.08838834764831845f; }
#pragma unroll
        for (int ks = 0; ks < 4; ++ks) { union { bf16x8 v; u32x4 w; } f;
            f.w.x = pk2(y[ks][0] * sc, y[ks][1] * sc); f.w.y = pk2(y[ks][2] * sc, y[ks][3] * sc); f.w.z = pk2(y[ks][4] * sc, y[ks][5] * sc); f.w.w = pk2(y[ks][6] * sc, y[ks][7] * sc);
            F[ks] = f.v;
            if (dir == 0) *(u32x4*)(DN + r * 1536 + seg * 512 + h * 128 + 32 * ks + 8 * g) = f.w; }
    };
#pragma unroll 1
    for (int mt = 0; mt < 4; ++mt) { bf16x8 F[4]; conv_frag(1, mt, F);
#pragma unroll
        for (int ks = 0; ks < 4; ++ks) *(bf16x8*)(Kc + (16 * mt + i16) * KCP + 32 * ks + 8 * g) = F[ks]; }
    if (dir == 0) {
#pragma unroll 1
        for (int mt = 0; mt < 4; ++mt) { bf16x8 F[4]; conv_frag(2, mt, F); } }
    asm volatile("s_waitcnt lgkmcnt(0)" ::: "memory");
#pragma unroll 1
    for (int mt = 0; mt < 4; ++mt) {
        bf16x8 A[4];
#pragma unroll
        for (int ks = 0; ks < 4; ++ks) A[ks] = *(const bf16x8*)(Kc + (16 * mt + i16) * KCP + 32 * ks + 8 * g);
#pragma unroll 1
        for (int nt = 0; nt <= mt; ++nt) { f32x4 acc = (f32x4){0.f, 0.f, 0.f, 0.f};
#pragma unroll
            for (int ks = 0; ks < 4; ++ks) acc = __builtin_amdgcn_mfma_f32_16x16x32_bf16(A[ks], *(const bf16x8*)(Kc + (16 * nt + i16) * KCP + 32 * ks + 8 * g), acc, 0, 0, 0);
            const int j = 16 * nt + i16; const float gj = gcs[j];
#pragma unroll
            for (int rg = 0; rg < 4; ++rg) { const int i = 16 * mt + 4 * g + rg; Ls[i * 64 + j] = i > j ? bes[i] * acc[rg] * __expf(gcs[i] - gj) : 0.f; } }
    }
    bf16_t* QKg = (bf16_t*)(p.ws + WS_TQ + (size_t)item * 16384 + 8192);
#pragma unroll 1
    for (int mt = 0; mt < 4; ++mt) { bf16x8 Qf[4]; conv_frag(0, mt, Qf);
#pragma unroll 1
        for (int nt = 0; nt < 4; ++nt) { f32x4 acc = (f32x4){0.f, 0.f, 0.f, 0.f}; const int j = 16 * nt + i16;
            if (nt <= mt) {
#pragma unroll
                for (int ks = 0; ks < 4; ++ks) acc = __builtin_amdgcn_mfma_f32_16x16x32_bf16(Qf[ks], *(const bf16x8*)(Kc + (16 * nt + i16) * KCP + 32 * ks + 8 * g), acc, 0, 0, 0);
                const float gj = gcs[j];
#pragma unroll
                for (int rg = 0; rg < 4; ++rg) { const int i = 16 * mt + 4 * g + rg; acc[rg] = i >= j ? acc[rg] * __expf(gcs[i] - gj) : 0.f; } }
#pragma unroll
            for (int rg = 0; rg < 4; ++rg) QKg[(16 * mt + 4 * g + rg) * 64 + j] = (bf16_t)f2bf(acc[rg]); } }
    asm volatile("s_waitcnt lgkmcnt(0)" ::: "memory");
#pragma unroll 1
    for (int i = 0; i < 64; ++i) { float s0 = (i == lane) ? 1.f : 0.f, s1 = 0.f;
        int j = 0;
#pragma unroll 4
        for (; j + 1 < i; j += 2) { s0 -= Ls[i * 64 + j] * Tl[j * 64 + lane]; s1 -= Ls[i * 64 + j + 1] * Tl[(j + 1) * 64 + lane]; }
        if (j < i) s0 -= Ls[i * 64 + j] * Tl[j * 64 + lane];
        Tl[i * 64 + lane] = s0 + s1; }
    asm volatile("s_waitcnt lgkmcnt(0)" ::: "memory");
    bf16_t* Tg = (bf16_t*)(p.ws + WS_TQ + (size_t)item * 16384);
    for (int i = 0; i < 64; ++i) Tg[i * 64 + lane] = (bf16_t)f2bf(Tl[i * 64 + lane]);
    asm volatile("s_waitcnt lgkmcnt(0)" ::: "memory");
}

__device__ __forceinline__ void dn_chain_mfma(const P& p, int item, unsigned char* lds) {
    const int b = item >> 3, h = (item >> 1) & 3, dir = item & 1, tid = otid(), lane = tid & 63, w = tid >> 6, i16 = lane & 15, g = lane >> 4;
    constexpr int KP = 136, TP = 72;
    bf16_t* Ks = (bf16_t*)lds; bf16_t* Qs = Ks + 64 * KP; bf16_t* Vs = Qs + 64 * KP; bf16_t* Ts = Vs + 64 * KP; bf16_t* QKs = Ts + 64 * TP; float* vec = (float*)(QKs + 64 * TP);
    const bf16_t* DN = (const bf16_t*)(p.ws + WS_DNQKV); bf16_t* OA = (bf16_t*)(p.ws + WS_H) + (size_t)dir * T * 512;
    f32x4 S[8];
#pragma unroll
    for (int dt = 0; dt < 8; ++dt) S[dt] = (f32x4){0.f, 0.f, 0.f, 0.f};
    u32x4 pf[9];
    auto prefetch = [&](int n) {
        const int pitem = item * DN_NCH + n;
#pragma unroll
        for (int u = 0; u < 6; ++u) { const int q = tid + 512 * u, which = q >> 10, rem = q & 1023, s = rem >> 4, ch = rem & 15;
            pf[u] = *(const u32x4*)(DN + (size_t)dn_row(n, s, b, dir) * 1536 + (which == 0 ? 512 : which == 1 ? 0 : 1024) + h * 128 + ch * 8); }
#pragma unroll
        for (int u = 0; u < 2; ++u) pf[6 + u] = *(const u32x4*)(p.ws + WS_TQ + (size_t)pitem * 16384 + (size_t)u * 8192 + (size_t)tid * 16);
        if (tid < 64) pf[8] = *(const u32x4*)((const float*)(p.ws + WS_VEC) + (size_t)pitem * 256 + tid * 4);
    };
    prefetch(0);
    for (int n = 0; n < DN_NCH; ++n) {
        __syncthreads();
#pragma unroll
        for (int u = 0; u < 6; ++u) { const int q = tid + 512 * u, which = q >> 10, rem = q & 1023, s = rem >> 4, ch = rem & 15;
            *(u32x4*)((which == 0 ? Ks : which == 1 ? Qs : Vs) + s * KP + ch * 8) = pf[u]; }
#pragma unroll
        for (int u = 0; u < 2; ++u) *(u32x4*)((u == 0 ? Ts : QKs) + (tid >> 3) * TP + (tid & 7) * 8) = pf[6 + u];
        if (tid < 64) *(u32x4*)(vec + tid * 4) = pf[8];
        __syncthreads();
        if (n + 1 < DN_NCH) prefetch(n + 1);
        const float* egv = vec; const float* eklv = vec + 64; const float* bev = vec + 128; const float glast = vec[192];
        bf16x8 Sb[4];
#pragma unroll
        for (int ks = 0; ks < 4; ++ks) Sb[ks] = pack8(S[2 * ks], S[2 * ks + 1]);
        f32x4 r_[4], o_[4];
#pragma unroll
        for (int mt = 0; mt < 4; ++mt) { r_[mt] = (f32x4){0.f, 0.f, 0.f, 0.f}; o_[mt] = (f32x4){0.f, 0.f, 0.f, 0.f};
            const bf16_t* kr = Ks + (16 * mt + i16) * KP + 4 * g; const bf16_t* qr = Qs + (16 * mt + i16) * KP + 4 * g;
#pragma unroll
            for (int ks = 0; ks < 4; ++ks) { const bf16x8 ak = cat8(*(const s16x4*)(kr + 32 * ks), *(const s16x4*)(kr + 32 * ks + 16)), aq = cat8(*(const s16x4*)(qr + 32 * ks), *(const s16x4*)(qr + 32 * ks + 16));
                r_[mt] = __builtin_amdgcn_mfma_f32_16x16x32_bf16(ak, Sb[ks], r_[mt], 0, 0, 0); o_[mt] = __builtin_amdgcn_mfma_f32_16x16x32_bf16(aq, Sb[ks], o_[mt], 0, 0, 0); } }
        f32x4 eg[4];
#pragma unroll
        for (int mt = 0; mt < 4; ++mt) { eg[mt] = *(const f32x4*)(egv + 16 * mt + 4 * g); const f32x4 be = *(const f32x4*)(bev + 16 * mt + 4 * g);
#pragma unroll
            for (int rg = 0; rg < 4; ++rg) { const float v = bf2f(Vs[(16 * mt + 4 * g + rg) * KP + 16 * w + i16]); r_[mt][rg] = be[rg] * (v - eg[mt][rg] * r_[mt][rg]); o_[mt][rg] *= eg[mt][rg]; } }
        bf16x8 Rb[2];
#pragma unroll
        for (int k2 = 0; k2 < 2; ++k2) Rb[k2] = pack8(r_[2 * k2], r_[2 * k2 + 1]);
        f32x4 vn[4];
#pragma unroll
        for (int mt = 0; mt < 4; ++mt) { vn[mt] = (f32x4){0.f, 0.f, 0.f, 0.f}; const bf16_t* tr = Ts + (16 * mt + i16) * TP + 4 * g;
#pragma unroll
            for (int k2 = 0; k2 < 2; ++k2) vn[mt] = __builtin_amdgcn_mfma_f32_16x16x32_bf16(cat8(*(const s16x4*)(tr + 32 * k2), *(const s16x4*)(tr + 32 * k2 + 16)), Rb[k2], vn[mt], 0, 0, 0); }
        bf16x8 Vb[2], Wb[2];
#pragma unroll
        for (int k2 = 0; k2 < 2; ++k2) { Vb[k2] = pack8(vn[2 * k2], vn[2 * k2 + 1]);
            const f32x4 e0 = *(const f32x4*)(eklv + 32 * k2 + 4 * g), e1 = *(const f32x4*)(eklv + 32 * k2 + 16 + 4 * g); Wb[k2] = pack8(vn[2 * k2] * e0, vn[2 * k2 + 1] * e1); }
#pragma unroll
        for (int mt = 0; mt < 4; ++mt) { const bf16_t* qkr = QKs + (16 * mt + i16) * TP + 4 * g;
#pragma unroll
            for (int k2 = 0; k2 < 2; ++k2) o_[mt] = __builtin_amdgcn_mfma_f32_16x16x32_bf16(cat8(*(const s16x4*)(qkr + 32 * k2), *(const s16x4*)(qkr + 32 * k2 + 16)), Vb[k2], o_[mt], 0, 0, 0); }
#pragma unroll
        for (int dt = 0; dt < 8; ++dt) { S[dt] = S[dt] * glast;
#pragma unroll
            for (int k2 = 0; k2 < 2; ++k2) { const bf16_t* a0 = Ks + (32 * k2 + 4 * g + (i16 >> 2)) * KP + 16 * dt + 4 * (i16 & 3);
                S[dt] = __builtin_amdgcn_mfma_f32_16x16x32_bf16(cat8(lds_tr(a0), lds_tr(a0 + 16 * KP)), Wb[k2], S[dt], 0, 0, 0); } }
#pragma unroll
        for (int mt = 0; mt < 4; ++mt)
#pragma unroll
            for (int rg = 0; rg < 4; ++rg) OA[(size_t)dn_row(n, 16 * mt + 4 * g + rg, b, dir) * 512 + h * 128 + 16 * w + i16] = (bf16_t)f2bf(o_[mt][rg]);
    }
}

__device__ __forceinline__ void phase_prep(const P& p, int l, unsigned char* lds, int gw, int NGW, int lane) {
    unsigned char* ws = p.ws;
    bf16_t* PC = (bf16_t*)(ws + WS_PC); unsigned* ctl = (unsigned*)(ws + WS_CTL);
    const int wv = gw % NWAVES, blk = gw / NWAVES, G_ = NGW / NWAVES;
    if (wv < 4) { for (int it = blk * 4 + wv; it < DN_ITEMS; it += G_ * 4) dn_prep_item(p, l, it, lds + wv * PREP_WLDS, lane); return; }
    const int gt = (blk * 4 + (wv - 4)) * 64 + lane, NGT = G_ * 4 * 64;
    for (long i = gt; i < (long)T * 512; i += NGT) {
        const int r = (int)(i >> 9), q = (int)(i & 511), seg = q >> 8, h = (q >> 6) & 3, m = (q >> 5) & 1, pi = q & 31;
        const int half = pi >> 4, fi = pi & 15, d1 = half * 32 + fi, d2 = d1 + 16;
        bf16_t* base = PC + (size_t)r * 1536 + seg * 512 + h * 128 + m * 64;
        float x1 = bf2f(base[d1]), x2 = bf2f(base[d2]);
        const bool lat = r < TL; const int b = lat ? r / SEQ : (r - TL) / CTXL;
        if (lat) { const int t = r % SEQ; const float pos = half ? (float)(t & 63) : (float)(t >> 6);
            const float ang = pos * exp2f(-(float)fi * 0.8304820237218406f);
            float sn, cs; sincosf(ang, &sn, &cs);
            const float o1 = x1 * cs - x2 * sn, o2 = x2 * cs + x1 * sn; x1 = o1; x2 = o2; }
        if (seg == 0) { x1 *= 0.125f; x2 *= 0.125f; }
        const bf16_t r1 = (bf16_t)f2bf(x1), r2 = (bf16_t)f2bf(x2);
        if (lat || seg == 0) { base[d1] = r1; base[d2] = r2; }
        float ss = bf2f(r1) * bf2f(r1) + bf2f(r2) * bf2f(r2);
#pragma unroll
        for (int o = 1; o < 32; o <<= 1) ss += shx(ss, o);
        if (seg == 1 && (lane & 31) == 0) atomicMax(ctl + CW_KMAX + l * 64 + (b * 4 + h) * 2 + m, __builtin_bit_cast(unsigned, sqrtf(ss)));
    }
    if (blk == 0 && wv == 4) { float a = 0.f, bq = 0.f; const float* lc = p.lam_c + (size_t)l * 256;
        a = wave_sum(lc[lane] * lc[64 + lane]); bq = wave_sum(lc[128 + lane] * lc[192 + lane]);
        const float lam_init = 0.8f - 0.6f * expf(-0.3f * (float)l);
        if (lane == 0) ((float*)(ws + WS_MISC))[MI_LAMF + l] = expf(a) - expf(bq) + lam_init; }
}

__device__ __forceinline__ void dn_chain(const P& p, int item, unsigned char* lds) {
    const int b = item >> 3, h = (item >> 1) & 3, dir = item & 1, tid = otid(), c = tid >> 2, ks = tid & 3;
    const bf16_t* DN = (const bf16_t*)(p.ws + WS_DNQKV); const float* GB = (const float*)(p.ws + WS_GB);
    bf16_t* OA = (bf16_t*)(p.ws + WS_H) + (size_t)dir * T * 512;
    constexpr int TB = 32;
    float* qs = (float*)lds; float* ksm = qs + TB * 128; float* vs = ksm + TB * 128; float* gs = vs + TB * 128; float* bs = gs + TB; float* ob = bs + TB;
    float S[32];
#pragma unroll
    for (int i = 0; i < 32; ++i) S[i] = 0.f;
    for (int part = 0; part < 2; ++part) {
        const int L = part == 0 ? CTXL : SEQ; const int rbase = part == 0 ? TL + b * CTXL : b * SEQ;
        for (int t0 = 0; t0 < L; t0 += TB) {
            __syncthreads();
            for (int i = tid; i < 3 * TB * 16; i += NTHREADS) { const int which = i / (TB * 16), rem = i % (TB * 16), tt = rem >> 4, ch = rem & 15;
                const int s = t0 + tt, t = dir ? L - 1 - s : s;
                const u32x4 w = *(const u32x4*)(DN + (size_t)(rbase + t) * 1536 + which * 512 + h * 128 + ch * 8);
                float* dst = (which == 0 ? qs : which == 1 ? ksm : vs) + tt * 128 + ch * 8;
                dst[0] = bflo(w.x); dst[1] = bfhi(w.x); dst[2] = bflo(w.y); dst[3] = bfhi(w.y); dst[4] = bflo(w.z); dst[5] = bfhi(w.z); dst[6] = bflo(w.w); dst[7] = bfhi(w.w); }
            if (tid < TB) { const int s = t0 + tid, t = dir ? L - 1 - s : s; gs[tid] = expf(GB[(size_t)(rbase + t) * 16 + dir * 4 + h]); bs[tid] = GB[(size_t)(rbase + t) * 16 + 8 + dir * 4 + h]; }
            __syncthreads();
            for (int tt = 0; tt < TB; ++tt) {
                const float eg = gs[tt], be = bs[tt];
                const float* kr = ksm + tt * 128 + ks * 32; const float* qr = qs + tt * 128 + ks * 32;
                float r = 0.f;
#pragma unroll
                for (int i = 0; i < 32; ++i) r += kr[i] * S[i];
                r += shx(r, 1); r += shx(r, 2);
                const float vn = be * (vs[tt * 128 + c] - eg * r);
                float o = 0.f;
#pragma unroll
                for (int i = 0; i < 32; ++i) { S[i] = eg * S[i] + kr[i] * vn; o += qr[i] * S[i]; }
                o += shx(o, 1); o += shx(o, 2);
                if (ks == 0) ob[tt * 128 + c] = o;
            }
            __syncthreads();
            for (int i = tid; i < TB * 64; i += NTHREADS) { const int tt = i >> 6, cp = i & 63; const int s = t0 + tt, t = dir ? L - 1 - s : s;
                *(unsigned*)(OA + (size_t)(rbase + t) * 512 + h * 128 + 2 * cp) = pk2(ob[tt * 128 + 2 * cp], ob[tt * 128 + 2 * cp + 1]); }
        }
    }
}
__device__ __forceinline__ void gla_chain_mfma(const P& p, int l, int item, unsigned char* lds) {
    const int b = item >> 3, h = (item >> 1) & 3, dir = item & 1, tid = otid(), lane = tid & 63, w = tid >> 6, i16 = lane & 15, g = lane >> 4;
    constexpr int RP = 72, VP = 72, OP = 136;
    bf16_t* qraw = (bf16_t*)lds;
    bf16_t* kraw = qraw + 64 * RP;
    bf16_t* Qt = kraw + 64 * RP;
    bf16_t* Kt = Qt + 64 * RP;
    bf16_t* KgT = Kt + 64 * RP;
    bf16_t* As = KgT + 64 * RP;
    bf16_t* Vt = As + 64 * RP;
    bf16_t* Os = Vt + 128 * VP;
    float* glr = (float*)(Os + 64 * OP);
    float* gts = glr + 64 * 16;
    float* gls = gts + 8 * 64;
    const bf16_t* PB = (const bf16_t*)(p.ws + WS_PB); const float* SMALL = (const float*)(p.ws + WS_SMALL);
    bf16_t* OB = (bf16_t*)(p.ws + WS_PAQ) + (size_t)dir * T * 512;
    float wgc[16];
#pragma unroll
    for (int j = 0; j < 16; ++j) wgc[j] = p.w_gate2[((size_t)l * 2 + dir) * 16 * 256 + j * 256 + h * 64 + lane];
    const float bgc = p.b_gate[((size_t)l * 2 + dir) * 256 + h * 64 + lane];
    f32x4 S[4];
#pragma unroll
    for (int dt = 0; dt < 4; ++dt) S[dt] = (f32x4){0.f, 0.f, 0.f, 0.f};
    __syncthreads();
    for (int i = tid; i < 64 * RP / 2; i += NTHREADS) ((unsigned*)As)[i] = 0u;
    u32x4 pf[5];
    auto prefetch = [&](int n) {
        { const int s = tid >> 3, ch = tid & 7; const size_t row = (size_t)dn_row(n, s, b, dir);
          pf[0] = *(const u32x4*)(PB + row * 1536 + h * 64 + ch * 8); pf[1] = *(const u32x4*)(PB + row * 1536 + 256 + h * 64 + ch * 8); }
#pragma unroll
        for (int u = 0; u < 2; ++u) { const int q = tid + 512 * u, s = q >> 4, ch = q & 15; pf[2 + u] = *(const u32x4*)(PB + (size_t)dn_row(n, s, b, dir) * 1536 + 512 + h * 128 + ch * 8); }
        if (tid < 256) { const int s = tid >> 2, ch = tid & 3; pf[4] = *(const u32x4*)(SMALL + (size_t)dn_row(n, s, b, dir) * 64 + 16 + dir * 16 + ch * 4); }
    };
    prefetch(0);
    for (int n = 0; n < DN_NCH; ++n) {
        __syncthreads();
        { const int s = tid >> 3, ch = tid & 7; *(u32x4*)(qraw + s * RP + ch * 8) = pf[0]; *(u32x4*)(kraw + s * RP + ch * 8) = pf[1]; }
#pragma unroll
        for (int u = 0; u < 2; ++u) { const int q = tid + 512 * u, s = q >> 4, ch = q & 15; const u32x4 v = pf[2 + u]; bf16_t* d = Vt + (ch * 8) * VP + s;
            d[0] = (bf16_t)v.x; d[VP] = (bf16_t)(v.x >> 16); d[2 * VP] = (bf16_t)v.y; d[3 * VP] = (bf16_t)(v.y >> 16); d[4 * VP] = (bf16_t)v.z; d[5 * VP] = (bf16_t)(v.z >> 16); d[6 * VP] = (bf16_t)v.w; d[7 * VP] = (bf16_t)(v.w >> 16); }
        if (tid < 256) *(u32x4*)(glr + tid * 4) = pf[4];
        __syncthreads();
        if (n + 1 < DN_NCH) prefetch(n + 1);
        float gcl[8];
        { float run = 0.f;
#pragma unroll
          for (int u = 0; u < 8; ++u) { const float* gr = glr + (8 * w + u) * 16; float z = bgc;
#pragma unroll
              for (int j = 0; j < 16; ++j) z += gr[j] * wgc[j];
              run += logsigmoidf_(z) * 0.0625f; gcl[u] = run; }
          gts[w * 64 + lane] = run; }
        __syncthreads();
        { float pre = 0.f, tot = 0.f;
#pragma unroll
          for (int q = 0; q < 8; ++q) { const float t_ = gts[q * 64 + lane]; tot += t_; if (q < w) pre += t_; }
          unsigned kgp[4];
#pragma unroll
          for (int u = 0; u < 8; ++u) { const float gc = pre + gcl[u]; const float qv = bf2f(qraw[(8 * w + u) * RP + lane]), kv = bf2f(kraw[(8 * w + u) * RP + lane]);
              Qt[(8 * w + u) * RP + lane] = (bf16_t)f2bf(0.125f * qv * __expf(gc)); Kt[(8 * w + u) * RP + lane] = (bf16_t)f2bf(kv * __expf(-gc));
              const unsigned kgb = f2bf(kv * __expf(tot - gc)); if (u & 1) kgp[u >> 1] |= kgb << 16; else kgp[u >> 1] = kgb; }
          *(u32x4*)(KgT + lane * RP + 8 * w) = (u32x4){kgp[0], kgp[1], kgp[2], kgp[3]};
          if (w == 0) gls[lane] = __expf(tot); }
        __syncthreads();
#pragma unroll
        for (int rep = 0; rep < 2; ++rep) { const int tix = w + 8 * rep;
            if (tix < 10) { const int mt = tix < 1 ? 0 : tix < 3 ? 1 : tix < 6 ? 2 : 3, nt = tix - (mt * (mt + 1)) / 2;
                f32x4 acc = (f32x4){0.f, 0.f, 0.f, 0.f};
#pragma unroll
                for (int ks = 0; ks < 2; ++ks) acc = __builtin_amdgcn_mfma_f32_16x16x32_bf16(*(const bf16x8*)(Qt + (16 * mt + i16) * RP + 32 * ks + 8 * g), *(const bf16x8*)(Kt + (16 * nt + i16) * RP + 32 * ks + 8 * g), acc, 0, 0, 0);
                const int j = 16 * nt + i16;
#pragma unroll
                for (int rg = 0; rg < 4; ++rg) { const int i = 16 * mt + 4 * g + rg; As[i * RP + j] = (bf16_t)f2bf(i >= j ? acc[rg] : 0.f); } } }
        __syncthreads();
        { bf16x8 Sb[2];
#pragma unroll
          for (int ks = 0; ks < 2; ++ks) Sb[ks] = pack8(S[2 * ks], S[2 * ks + 1]);
          bf16x8 Vb[2];
#pragma unroll
          for (int ks = 0; ks < 2; ++ks) Vb[ks] = *(const bf16x8*)(Vt + (16 * w + i16) * VP + 32 * ks + 8 * g);
#pragma unroll
          for (int mt = 0; mt < 4; ++mt) { f32x4 o = (f32x4){0.f, 0.f, 0.f, 0.f}; const bf16_t* qr = Qt + (16 * mt + i16) * RP + 4 * g; const bf16_t* ar = As + (16 * mt + i16) * RP + 8 * g;
#pragma unroll
              for (int ks = 0; ks < 2; ++ks) { o = __builtin_amdgcn_mfma_f32_16x16x32_bf16(cat8(*(const s16x4*)(qr + 32 * ks), *(const s16x4*)(qr + 32 * ks + 16)), Sb[ks], o, 0, 0, 0);
                  o = __builtin_amdgcn_mfma_f32_16x16x32_bf16(*(const bf16x8*)(ar + 32 * ks), Vb[ks], o, 0, 0, 0); }
#pragma unroll
              for (int rg = 0; rg < 4; ++rg) Os[(16 * mt + 4 * g + rg) * OP + 16 * w + i16] = (bf16_t)f2bf(o[rg]); }
#pragma unroll
          for (int dt = 0; dt < 4; ++dt) { const f32x4 gl = *(const f32x4*)(gls + 16 * dt + 4 * g); S[dt] = S[dt] * gl;
#pragma unroll
              for (int ks = 0; ks < 2; ++ks) S[dt] = __builtin_amdgcn_mfma_f32_16x16x32_bf16(*(const bf16x8*)(KgT + (16 * dt + i16) * RP + 32 * ks + 8 * g), Vb[ks], S[dt], 0, 0, 0); } }
        __syncthreads();
#pragma unroll
        for (int u = 0; u < 2; ++u) { const int q = tid + 512 * u, s = q >> 4, ch = q & 15;
            *(u32x4*)(OB + (size_t)dn_row(n, s, b, dir) * 512 + h * 128 + ch * 8) = *(const u32x4*)(Os + s * OP + ch * 8); }
    }
}
__device__ __forceinline__ void attn_tile(const P& p, int l, int b, int h, int qrow0  , bool ctxq, unsigned char* lds) {
    constexpr int QP = 72, KP = 72, VP = 72;
    bf16_t* Qs = (bf16_t*)lds;
    bf16_t* Ks = Qs + 2 * 128 * QP;
    bf16_t* Vt = Ks + 2 * 64 * KP;
    float* Oex = (float*)lds;
    bf16_t* PC = (bf16_t*)(p.ws + WS_PC);
    const int tid = otid(), lane = tid & 63, w = tid >> 6, m = w & 1, rg = w >> 1, q31 = lane & 31, hi = lane >> 5;
    __syncthreads();
    for (int i = tid; i < 128 * 16; i += NTHREADS) { const int r = i >> 4, ch = i & 15, mm = ch >> 3, c8 = (ch & 7) * 8;
        *(u32x4*)(Qs + (mm * 128 + r) * QP + c8) = *(const u32x4*)(PC + (size_t)(qrow0 + r) * 1536 + h * 128 + ch * 8); }
    __syncthreads();
    const bf16_t* qrow = Qs + (m * 128 + rg * 32 + q31) * QP;
    bf16x8 bq[4]; float qn = 0.f;
#pragma unroll
    for (int kk = 0; kk < 4; ++kk) bq[kk] = *(const bf16x8*)(qrow + 16 * kk + 8 * hi);
#pragma unroll
    for (int d8 = 0; d8 < 8; ++d8) { const u32x4 q4 = *(const u32x4*)(qrow + 8 * d8);
        qn += bflo(q4.x) * bflo(q4.x) + bfhi(q4.x) * bfhi(q4.x) + bflo(q4.y) * bflo(q4.y) + bfhi(q4.y) * bfhi(q4.y) + bflo(q4.z) * bflo(q4.z) + bfhi(q4.z) * bfhi(q4.z) + bflo(q4.w) * bflo(q4.w) + bfhi(q4.w) * bfhi(q4.w); }
    const float kmax = __builtin_bit_cast(float, ((const unsigned*)(p.ws + WS_CTL))[CW_KMAX + l * 64 + (b * 4 + h) * 2 + m]);
    const float mrow = sqrtf(qn) * kmax * 1.002f + 1e-3f;
    f32x16 o[4]; float lsum = 0.f;
#pragma unroll
    for (int dt = 0; dt < 4; ++dt)
#pragma unroll
        for (int r = 0; r < 16; ++r) o[dt][r] = 0.f;
    const int nkt = ctxq ? CTXL / 64 : (CTXL + SEQ) / 64;
    for (int kt = 0; kt < nkt; ++kt) {
        const int krow0 = kt < CTXL / 64 ? TL + b * CTXL + kt * 64 : b * SEQ + (kt - CTXL / 64) * 64;
        __syncthreads();
        for (int i = tid; i < 64 * 16; i += NTHREADS) { const int r = i >> 4, ch = i & 15, mm = ch >> 3, c8 = (ch & 7) * 8;
            *(u32x4*)(Ks + (mm * 64 + r) * KP + c8) = *(const u32x4*)(PC + (size_t)(krow0 + r) * 1536 + 512 + h * 128 + ch * 8); }
        for (int i = tid; i < 64 * 16; i += NTHREADS) { const int r = i >> 4, ch = i & 15;
            const u32x4 v = *(const u32x4*)(PC + (size_t)(krow0 + r) * 1536 + 1024 + h * 128 + ch * 8); bf16_t* d = Vt + (ch * 8) * VP + r;
            d[0] = (bf16_t)v.x; d[VP] = (bf16_t)(v.x >> 16); d[2 * VP] = (bf16_t)v.y; d[3 * VP] = (bf16_t)(v.y >> 16); d[4 * VP] = (bf16_t)v.z; d[5 * VP] = (bf16_t)(v.z >> 16); d[6 * VP] = (bf16_t)v.w; d[7 * VP] = (bf16_t)(v.w >> 16); }
        __syncthreads();
        f32x16 s[2];
#pragma unroll
        for (int kh = 0; kh < 2; ++kh) {
#pragma unroll
            for (int r = 0; r < 16; ++r) s[kh][r] = 0.f;
#pragma unroll
            for (int kk = 0; kk < 4; ++kk) { const bf16x8 a = *(const bf16x8*)(Ks + (m * 64 + kh * 32 + q31) * KP + 16 * kk + 8 * hi);
                s[kh] = __builtin_amdgcn_mfma_f32_32x32x16_bf16(a, bq[kk], s[kh], 0, 0, 0); }
#pragma unroll
            for (int r = 0; r < 16; ++r) { const float e = __expf(s[kh][r] - mrow); s[kh][r] = e; lsum += e; }
        }
#pragma unroll
        for (int st = 0; st < 4; ++st) {
            const int kh = st >> 1, r0 = 8 * (st & 1);
            union { bf16x8 v; unsigned u[4]; } bp;
            bp.u[0] = pk2(s[kh][r0 + 0], s[kh][r0 + 1]); bp.u[1] = pk2(s[kh][r0 + 2], s[kh][r0 + 3]); bp.u[2] = pk2(s[kh][r0 + 4], s[kh][r0 + 5]); bp.u[3] = pk2(s[kh][r0 + 6], s[kh][r0 + 7]);
#pragma unroll
            for (int dt = 0; dt < 4; ++dt) { const bf16_t* vr = Vt + (dt * 32 + q31) * VP + 16 * st + 4 * hi;
                union { bf16x8 v; s16x4 h2[2]; } av; av.h2[0] = *(const s16x4*)vr; av.h2[1] = *(const s16x4*)(vr + 8);
                o[dt] = __builtin_amdgcn_mfma_f32_32x32x16_bf16(av.v, bp.v, o[dt], 0, 0, 0); }
        }
    }
    lsum += shx(lsum, 32);
    const float lamf = ((const float*)(p.ws + WS_MISC))[MI_LAMF + l];
    const float sc = (m == 0 ? 1.0f : lamf) / lsum;
    __syncthreads();
    float* ox = Oex + (rg * 32 + q31) * 132;
    if (m == 1) {
#pragma unroll
        for (int dt = 0; dt < 4; ++dt)
#pragma unroll
            for (int r = 0; r < 16; ++r) ox[dt * 32 + (r & 3) + 8 * (r >> 2) + 4 * hi] = o[dt][r] * sc;
    }
    __syncthreads();
    if (m == 0) {
        float ss = 0.f;
#pragma unroll
        for (int dt = 0; dt < 4; ++dt)
#pragma unroll
            for (int r = 0; r < 16; ++r) { const float v = o[dt][r] * sc - ox[dt * 32 + (r & 3) + 8 * (r >> 2) + 4 * hi]; o[dt][r] = v; ss += v * v; }
        ss += shx(ss, 32);
        const float lam_init = 0.8f - 0.6f * expf(-0.3f * (float)l);
        const float rs = (1.0f - lam_init) / sqrtf(ss * (1.0f / 128.0f) + EPS);
        const float* gn = p.gn_c + l * 128;
        bf16_t* orow = PC + (size_t)(qrow0 + rg * 32 + q31) * 1536 + h * 128;
#pragma unroll
        for (int dt = 0; dt < 4; ++dt)
#pragma unroll
            for (int g4 = 0; g4 < 4; ++g4) { const int dv = dt * 32 + 8 * g4 + 4 * hi; const f32x4 gg = *(const f32x4*)(gn + dv);
                u32x2 wv; wv.x = pk2(o[dt][4 * g4 + 0] * rs * gg[0], o[dt][4 * g4 + 1] * rs * gg[1]); wv.y = pk2(o[dt][4 * g4 + 2] * rs * gg[2], o[dt][4 * g4 + 3] * rs * gg[3]);
                *(u32x2*)(orow + dv) = wv; }
    }
}
__device__ __forceinline__ void phase_mix(const P& p, int l, unsigned char* lds) {
    unsigned* qhead = (unsigned*)(p.ws + WS_CTL) + CW_QUEUE + 64 * l;
    volatile int* slot = (volatile int*)(lds + LDS_BYTES - 64);
    const int n_att_l = BATCH * 4 * (SEQ / 128), n_att_c = (l == 0) ? BATCH * 4 * (CTXL / 128) : 0;
    const int total = 128 + n_att_l + n_att_c;
    for (;;) {
        __syncthreads();
        if (otid() == 0) *slot = (int)atomicAdd(qhead, 1u);
        __syncthreads();
        const int it = *slot;
        if (it >= total) break;
        if (it < 64) dn_chain_mfma(p, it, lds);
        else if (it < 128) gla_chain_mfma(p, l, it - 64, lds);
        else if (it < 128 + n_att_l) { const int a = it - 128, b = a / (4 * (SEQ / 128)), rem = a % (4 * (SEQ / 128)), h = rem / (SEQ / 128), qt = rem % (SEQ / 128);
            attn_tile(p, l, b, h, b * SEQ + qt * 128, false, lds); }
        else { const int a = it - 128 - n_att_l, b = a / (4 * (CTXL / 128)), rem = a % (4 * (CTXL / 128)), h = rem / (CTXL / 128), qt = rem % (CTXL / 128);
            attn_tile(p, l, b, h, TL + b * CTXL + qt * 128, true, lds); }
    }
}

__device__ __forceinline__ void phase_post(const P& p, int l, int nrows, int gw, int NGW, int lane) {
    const bf16_t* PZ = (const bf16_t*)(p.ws + WS_PZ); const bf16_t* PB = (const bf16_t*)(p.ws + WS_PB);
#pragma unroll
    for (int br = 0; br < 2; ++br) {
        bf16_t* O = (bf16_t*)(p.ws + (br ? WS_PAQ : WS_H));
        const float* gnb = (br ? p.gn_b : p.gn_a) + l * 128 + 2 * lane;
        const float g0 = gnb[0], g1 = gnb[1];
        for (int it = gw; it < nrows * 4; it += NGW) {
            const int r = it >> 2, h = it & 3, col = h * 128 + 2 * lane;
            const unsigned a = *(const unsigned*)(O + (size_t)r * 512 + col), bq = *(const unsigned*)(O + ((size_t)T + r) * 512 + col);
            const unsigned zz = br ? *(const unsigned*)(PB + (size_t)r * 1536 + 1024 + col) : *(const unsigned*)(PZ + (size_t)r * 512 + col);
            const float o0 = bflo(a) + bflo(bq), o1 = bfhi(a) + bfhi(bq);
            const float rs = 1.0f / sqrtf(wave_sum(o0 * o0 + o1 * o1) * (1.0f / 128.0f) + EPS);
            *(unsigned*)(O + (size_t)r * 512 + col) = pk2(o0 * rs * g0 * siluf_(bflo(zz)), o1 * rs * g1 * siluf_(bfhi(zz)));
        }
    }
}

__device__ __forceinline__ void phase_moe_tables(const P& p, int tid) {
    const unsigned* ecnt = (const unsigned*)(p.ws + WS_CTL) + CW_ECNT; int* misc = (int*)(p.ws + WS_MISC);
    if (blockIdx.x == 0 && tid == 0) { int off = 0, nt = 0;
#pragma unroll 1
        for (int e = 0; e < NE; ++e) { misc[MI_EOFF + e] = off; const int tl = ((int)ecnt[e] + 255) / 256; for (int q = 0; q < tl; ++q) misc[MI_TILEE + nt + q] = e; nt += tl; off += tl * 256; }
        misc[MI_EOFF + NE] = off; misc[MI_NTILES] = nt; }
}
__device__ __forceinline__ void phase_moe_gather(const P& p, int gw, int NGW, int lane) {
    const int* route = (const int*)(p.ws + WS_ROUTE); int* slots = (int*)(p.ws + WS_SLOT); const int* misc = (const int*)(p.ws + WS_MISC);
    unsigned* efill = (unsigned*)(p.ws + WS_CTL) + CW_EFILL;
    const bf16_t* H = (const bf16_t*)(p.ws + WS_H); bf16_t* MA = (bf16_t*)(p.ws + WS_MA);
    for (int it = gw; it < TL * 2; it += NGW) { const int r = it >> 1, k = it & 1, e = route[r * 4 + k];
        int s = 0; if (lane == 0) s = misc[MI_EOFF + e] + (int)atomicAdd(efill + e, 1u);
        s = shlane_i(s, 0);
        if (lane == 0) slots[r * 2 + k] = s;
        const u32x4* src = (const u32x4*)(H + (size_t)r * D); u32x4* dst = (u32x4*)(MA + (size_t)s * D);
        dst[lane] = src[lane]; dst[lane + 64] = src[lane + 64]; }
}
__device__ __forceinline__ void phase_final(const P& p, int gw, int NGW, int lane) {
    const int* route = (const int*)(p.ws + WS_ROUTE); const int* slots = (const int*)(p.ws + WS_SLOT); const bf16_t* Y = (const bf16_t*)(p.ws + WS_MA);
    const float* MOD = (const float*)(p.ws + WS_MOD) + (size_t)1 * 9 * 6144;
    for (int r = gw; r < TL; r += NGW) { const int b = r / SEQ; const float w1 = ((const float*)route)[r * 4 + 2], w2 = ((const float*)route)[r * 4 + 3];
        const bf16_t* y1 = Y + (size_t)slots[r * 2] * D, *y2 = Y + (size_t)slots[r * 2 + 1] * D; float* xr = p.out + (size_t)r * D; const float* g2 = MOD + (size_t)b * 6144 + 5 * 1024;
        f32x4 v[4]; float ss = 0.f;
#pragma unroll
        for (int j = 0; j < 4; ++j) { const int c = 4 * lane + 256 * j; const u32x2 a = *(const u32x2*)(y1 + c), bq = *(const u32x2*)(y2 + c); const f32x4 g = *(const f32x4*)(g2 + c);
            f32x4 y; y[0] = w1 * bflo(a.x) + w2 * bflo(bq.x); y[1] = w1 * bfhi(a.x) + w2 * bfhi(bq.x); y[2] = w1 * bflo(a.y) + w2 * bflo(bq.y); y[3] = w1 * bfhi(a.y) + w2 * bfhi(bq.y);
            v[j] = *(const f32x4*)(xr + c) + g * y; ss += (v[j][0] * v[j][0] + v[j][1] * v[j][1]) + (v[j][2] * v[j][2] + v[j][3] * v[j][3]); }
        const float rs = 1.0f / sqrtf(wave_sum(ss) * (1.0f / D) + EPS);
#pragma unroll
        for (int j = 0; j < 4; ++j) { const int c = 4 * lane + 256 * j; *(f32x4*)(xr + c) = v[j] * rs * *(const f32x4*)(p.final_g + c); }
    }
}

__device__ __forceinline__ void convert_up(const float* w1, const float* w3, int ne, bf16_t* up, float* scr, int gw, int NGW, int lane) {
    const int nblk = NUP / 32, items_e = (D / 64) * nblk;
    for (int it = gw; it < ne * items_e; it += NGW) {
        const int e = it / items_e, ie = it % items_e, kb = ie / nblk, nb = ie % nblk, k0 = 64 * kb, n0 = 32 * nb, n = n0 + (lane & 31), tile = n >> 8, rr = n & 255;
        const float* W = (rr < 128 ? w1 : w3) + (size_t)e * D * DFF; const int sc = tile * 128 + (rr & 127);
#pragma unroll 8
        for (int i = 0; i < 32; ++i) { const int kk = 2 * i + (lane >> 5); scr[kk * 33 + (lane & 31)] = W[(size_t)(k0 + kk) * DFF + sc]; }
        asm volatile("s_waitcnt lgkmcnt(0)" ::: "memory");
        const int c = lane & 7;
#pragma unroll
        for (int j = 0; j < 4; ++j) { const int nn = (lane >> 3) + 8 * j; const float* s = scr + (8 * c) * 33 + nn;
            u32x4 o; o.x = pk2(s[0 * 33], s[1 * 33]); o.y = pk2(s[2 * 33], s[3 * 33]); o.z = pk2(s[4 * 33], s[5 * 33]); o.w = pk2(s[6 * 33], s[7 * 33]);
            *(u32x4*)(up + ((size_t)e * NUP + n0 + nn) * D + k0 + 8 * c) = o; }
        asm volatile("s_waitcnt lgkmcnt(0)" ::: "memory");
    }
}
typedef __attribute__((address_space(4))) const P* KArgs;
#define LOADP(p) asm volatile("" : "+s"(kp)); P p; __builtin_memcpy(&p, kp, sizeof(P))
__global__ void __launch_bounds__(NTHREADS, 2) mk_fwd(P p_unused) {
    extern __shared__ __attribute__((aligned(16))) unsigned char lds[];
    cg::grid_group grid = cg::this_grid();
    KArgs kp = (KArgs)__builtin_amdgcn_kernarg_segment_ptr();
    const int G = gridDim.x, NGW = G * NWAVES;
#define IDS() const int tid = otid(), lane = tid & 63, wave = __builtin_amdgcn_readfirstlane(tid >> 6), gw = blockIdx.x * NWAVES + wave; (void)tid; (void)lane; (void)gw; (void)wave
    PG8_LAS unsigned char* glds = (PG8_LAS unsigned char*)lds;

    {
        LOADP(p); IDS(); unsigned char* ws = p.ws;
        float* scr = (float*)(lds + 49152) + wave * (64 * 33);
        for (int l = 0; l < DEPTH; ++l) {
            convert_T(p.w_in + (size_t)l * D * 8240, D, 8240, (bf16_t*)(ws + WB_WIN + l * WIN_BYTES), NIN, CmWin(), scr, (gw + 37 * l) % NGW, NGW, lane);
            convert_T(p.w_o_a + (size_t)l * 512 * D, 512, D, (bf16_t*)(ws + WB_WO + (l * 3 + 0) * WO_BYTES), D, CmIdent(), scr, (gw + 300 + 700 * l) % NGW, NGW, lane);
            convert_T(p.w_o_b + (size_t)l * 512 * D, 512, D, (bf16_t*)(ws + WB_WO + (l * 3 + 1) * WO_BYTES), D, CmIdent(), scr, (gw + 556 + 700 * l) % NGW, NGW, lane);
            convert_T(p.w_o_c + (size_t)l * 512 * D, 512, D, (bf16_t*)(ws + WB_WO + (l * 3 + 2) * WO_BYTES), D, CmIdent(), scr, (gw + 812 + 700 * l) % NGW, NGW, lane);
            convert_T(p.w_out + (size_t)l * D * D, D, D, (bf16_t*)(ws + WB_WOUT + l * WOUT_BYTES), D, CmIdent(), scr, (gw + 1068 + 512 * l) % NGW, NGW, lane);
        }
        convert_up(p.ffn_w1, p.ffn_w3, 1, (bf16_t*)(ws + WB_WUP), scr, (gw + 1500) % NGW, NGW, lane);
        convert_T(p.ffn_w2, DFF, D, (bf16_t*)(ws + WB_WDN), D, CmIdent(), scr, (gw + 900) % NGW, NGW, lane);
        __syncthreads();
        phase_mod(p, lds);
    }
    grid.sync();

    for (int l = 0; l < DEPTH; ++l) {
        const bool last = (l == DEPTH - 1);
        const int Mrows = last ? TL : T;
        { LOADP(p); IDS(); unsigned char* ws = p.ws;
          phase_modulate(l == 0 ? p.x : p.out, l == 0 ? p.ctx : (const float*)(ws + WS_XC), T, p.norm1_g + l * D, (const float*)(ws + WS_MOD) + (size_t)l * 9 * 6144, 0, (bf16_t*)(ws + WS_H), nullptr, nullptr, nullptr, gw, NGW, lane); }
        grid.sync();
        { LOADP(p); unsigned char* ws = p.ws;
            pg8::Gemm g{(const bf16_t*)(ws + WS_H), (const bf16_t*)(ws + WB_WIN + l * WIN_BYTES), T, NIN, D, D}; pg8::StaticOrder S; S.init(T, NIN, G, (int)blockIdx.x);
            EpiWin E{(bf16_t*)(ws + WS_PAQ), (bf16_t*)(ws + WS_PZ), (bf16_t*)(ws + WS_PB), (bf16_t*)(ws + WS_PC), (bf16_t*)(ws + WS_PG), (float*)(ws + WS_SMALL)};
            pg8::gemm_phase<EpiWin, pg8::StaticOrder, true, true>(glds, g, S, E);
        }
        grid.sync();
        { LOADP(p); IDS(); phase_prep(p, l, lds, gw, NGW, lane); }
        grid.sync();
        { LOADP(p); phase_mix(p, l, lds); }
        grid.sync();
        { LOADP(p); IDS(); phase_post(p, l, Mrows, gw, NGW, lane); }
        grid.sync();
        for (int br = 0; br < 3; ++br) {
            LOADP(p); unsigned char* ws = p.ws;
            const bf16_t* A = br == 0 ? (const bf16_t*)(ws + WS_H) : br == 1 ? (const bf16_t*)(ws + WS_PAQ) : (const bf16_t*)(ws + WS_PC);
            pg8::Gemm g{A, (const bf16_t*)(ws + WB_WO + (l * 3 + br) * WO_BYTES), Mrows, D, 512, br == 2 ? 1536 : 512}; pg8::StaticOrder S; S.init(Mrows, D, G, (int)blockIdx.x);
            EpiGate E{(bf16_t*)(ws + WS_DNQKV), (const bf16_t*)(ws + WS_PG), br};
            pg8::gemm_phase<EpiGate, pg8::StaticOrder, true, true>(glds, g, S, E);
            __syncthreads();
        }
        grid.sync();
        { LOADP(p); unsigned char* ws = p.ws;
            pg8::Gemm g{(const bf16_t*)(ws + WS_DNQKV), (const bf16_t*)(ws + WB_WOUT + l * WOUT_BYTES), Mrows, D, D, D}; pg8::StaticOrder S; S.init(Mrows, D, G, (int)blockIdx.x);
            EpiResid E{l == 0 ? p.x : p.out, l == 0 ? p.ctx : (const float*)(ws + WS_XC), p.out, (float*)(ws + WS_XC), (const float*)(ws + WS_MOD) + (size_t)l * 9 * 6144, 2};
            pg8::gemm_phase<EpiResid, pg8::StaticOrder, true, true>(glds, g, S, E);
        }
        grid.sync();
        { LOADP(p); IDS(); unsigned char* ws = p.ws;
          phase_modulate(p.out, (const float*)(ws + WS_XC), Mrows, p.norm2_g + l * D, (const float*)(ws + WS_MOD) + (size_t)l * 9 * 6144, 3, (bf16_t*)(ws + WS_H), last ? p.router_w : nullptr, (int*)(ws + WS_ROUTE), (unsigned*)(ws + WS_CTL) + CW_ECNT, gw, NGW, lane); }
        if (!last) {
            grid.sync();
            { LOADP(p); unsigned char* ws = p.ws;
                pg8::Gemm g{(const bf16_t*)(ws + WS_H), (const bf16_t*)(ws + WB_WUP), T, NUP, D, D}; pg8::StaticOrder S; S.init(T, NUP, G, (int)blockIdx.x);
                EpiSwiglu E{(bf16_t*)(ws + WS_H1), NUP / 256};
                pg8::gemm_phase<EpiSwiglu, pg8::StaticOrder, true, true>(glds, g, S, E);
            }
            grid.sync();
            { LOADP(p); unsigned char* ws = p.ws;
                pg8::Gemm g{(const bf16_t*)(ws + WS_H1), (const bf16_t*)(ws + WB_WDN), T, D, DFF, DFF}; pg8::StaticOrder S; S.init(T, D, G, (int)blockIdx.x);
                EpiResid E{p.out, (const float*)(ws + WS_XC), p.out, (float*)(ws + WS_XC), (const float*)(ws + WS_MOD) + (size_t)l * 9 * 6144, 5};
                pg8::gemm_phase<EpiResid, pg8::StaticOrder, true, true>(glds, g, S, E);
            }
            grid.sync();
        } else {
            { LOADP(p); IDS(); unsigned char* ws = p.ws;
                float* scr = (float*)lds + wave * (64 * 33);
                convert_up(p.moe_w1, p.moe_w3, NE, (bf16_t*)(ws + WS_MWUP), scr, gw, NGW, lane);
                for (int e = 0; e < NE; ++e)
                    convert_T(p.moe_w2 + (size_t)e * DFF * D, DFF, D, (bf16_t*)(ws + WS_MWDN) + (size_t)e * D * DFF, D, CmIdent(), scr, (gw + 173 * e) % NGW, NGW, lane);
            }
            grid.sync();
            { LOADP(p); IDS(); phase_moe_tables(p, tid); }
            grid.sync();
            { LOADP(p); IDS(); phase_moe_gather(p, gw, NGW, lane); }
            grid.sync();
            { LOADP(p); unsigned char* ws = p.ws; const int* misc = (const int*)(ws + WS_MISC);
                pg8::Gemm g{(const bf16_t*)(ws + WS_MA), (const bf16_t*)(ws + WS_MWUP), MOE_ROWS, NE * NUP, D, D};
                MoeOrder S{misc[MI_NTILES], NUP / 256, G, (int)blockIdx.x, misc + MI_TILEE};
                EpiSwiglu E{(bf16_t*)(ws + WS_MH1), NUP / 256};
                pg8::gemm_phase<EpiSwiglu, MoeOrder, true, true>(glds, g, S, E);
            }
            grid.sync();
            { LOADP(p); unsigned char* ws = p.ws; const int* misc = (const int*)(ws + WS_MISC);
                pg8::Gemm g{(const bf16_t*)(ws + WS_MH1), (const bf16_t*)(ws + WS_MWDN), MOE_ROWS, NE * D, DFF, DFF};
                MoeOrder S{misc[MI_NTILES], D / 256, G, (int)blockIdx.x, misc + MI_TILEE};
                EpiMoeDown E{(bf16_t*)(ws + WS_MA)};
                pg8::gemm_phase<EpiMoeDown, MoeOrder, true, true>(glds, g, S, E);
            }
            grid.sync();
            { LOADP(p); IDS(); phase_final(p, gw, NGW, lane); }
        }
    }
}

extern "C" void kernel_launch(void* const* d_in, const int* in_sizes, int n_in, void* d_out, int out_size, void* d_ws, size_t ws_size, hipStream_t stream) {
    static int grid_blocks = 0;
    if (grid_blocks == 0) {
        if (n_in != 30 || in_sizes[0] != TL * D || out_size != TL * D || ws_size < WS_END) {
            fprintf(stderr, "kernel_launch: built for 30 inputs, x/out of %d floats, >= %zu bytes of d_ws; got n_in %d, in0 %d, out %d, ws %zu; nothing launched\n", TL * D, (size_t)WS_END, n_in, n_in > 0 ? in_sizes[0] : -1, out_size, ws_size);
            grid_blocks = -1; return; }
        int dev = 0, cus = 0, per_cu = 0;
        hipGetDevice(&dev);
        hipDeviceGetAttribute(&cus, hipDeviceAttributeMultiprocessorCount, dev);
        hipFuncSetAttribute((const void*)mk_fwd, hipFuncAttributeMaxDynamicSharedMemorySize, LDS_BYTES);
        hipOccupancyMaxActiveBlocksPerMultiprocessor(&per_cu, (const void*)mk_fwd, NTHREADS, LDS_BYTES);
        if (per_cu < 1) { fprintf(stderr, "kernel_launch: occupancy query reports %d blocks/CU; nothing launched\n", per_cu); grid_blocks = -1; return; }
        grid_blocks = cus;
    }
    if (grid_blocks < 0) return;
    hipMemsetAsync((char*)d_ws + WS_CTL, 0, CTL_BYTES, stream);
    P p{};
    const float** f = (const float**)&p;
    for (int i = 0; i < 30; ++i) f[i] = (const float*)d_in[i];
    p.out = (float*)d_out; p.ws = (unsigned char*)d_ws;
    void* args[] = {&p};
    hipError_t e = hipLaunchCooperativeKernel((const void*)mk_fwd, dim3(grid_blocks), dim3(NTHREADS), args, LDS_BYTES, stream);
    if (e != hipSuccess) fprintf(stderr, "kernel_launch: cooperative launch failed: %s (grid %d)\n", hipGetErrorString(e), grid_blocks);
}
```

```cpp
#include <hip/hip_runtime.h>
#include <hip/hip_cooperative_groups.h>
#include <cstdio>
#include <cstdint>
namespace cg = cooperative_groups;
#ifndef REP_P0
#define REP_P0 1
#endif
#ifndef REP_WIN
#define REP_WIN 1
#endif
#ifndef REP_CHAIN
#define REP_CHAIN 1
#endif
#ifndef REP_UP
#define REP_UP 1
#endif
#ifndef REP_SYNC
#define REP_SYNC 1
#endif
#ifndef REP_ATT
#define REP_ATT 1
#endif
#ifndef REP_DNPREP
#define REP_DNPREP 1
#endif
#ifndef REP_ELT
#define REP_ELT 1
#endif

namespace pg8 {
#define PG8_LAS __attribute__((address_space(3)))
typedef unsigned short bf16_t;
typedef short bf16x8 __attribute__((ext_vector_type(8)));
typedef float f32x4 __attribute__((ext_vector_type(4)));
typedef unsigned u32x4 __attribute__((ext_vector_type(4)));
constexpr int BM = 256, BK = 64, HALF = 128, HTB = HALF * BK * 2  , STAGE_BYTES = 8 * HTB, NXCD = 8, WGM = 8;

__host__ __device__ __forceinline__ int lds_byte(int r, int c) { const int st = (r >> 4) * 2 + (c >> 5), rr = r & 15, cc = c & 31, ob = rr * 64 + cc * 2; return st * 1024 + (ob ^ (((ob >> 9) & 1) << 5)); }
__host__ __device__ __forceinline__ void stage_rc(int b, int& R, int& C) { const int st = b / 1024, sb = b % 1024, swz = sb ^ (((sb >> 9) & 1) << 5); R = (st >> 1) * 16 + swz / 64; C = (st & 1) * 32 + (swz % 64) / 2; }
__host__ __device__ __forceinline__ int perm32(int rho) { const int n = rho >> 4, i = rho & 15; return 8 * (i >> 2) + 4 * n + (i & 3); }

struct Unit { int pm, pn; };
struct Gemm { const bf16_t* A; const bf16_t* Bt; int M, N, K, lda; };

struct StaticOrder {
    int nM, nN, nwg, G, c;
    __host__ __device__ void init(int M, int N, int G_, int c_) { nM = M / BM; nN = N / BM; nwg = nM * nN; G = G_; c = c_; }
    __host__ __device__ bool next(int i, Unit& u) const {
        const long L = (long)i * G + c; if (L >= nwg) return false;
        int wgid = (int)L; { const int q = nwg / NXCD, r = nwg % NXCD, xcd = wgid % NXCD, off = wgid / NXCD; wgid = (xcd < r ? xcd * (q + 1) : r * (q + 1) + (xcd - r) * q) + off; }
        const int nig = WGM * nN, gid = wgid / nig, fm = gid * WGM, gsz = (nM - fm) < WGM ? (nM - fm) : WGM;
        u.pm = fm + ((wgid % nig) % gsz); u.pn = (wgid % nig) / gsz; return true;
    }
    __device__ __forceinline__ void a_ready(const Unit&) const {}
    __device__ __forceinline__ void done(const Unit&) const {}
};


template <class Epi, class Sched, bool ALIGN_EPI = false, bool SP2 = false>
__device__ __forceinline__ void gemm_phase(PG8_LAS unsigned char* lds, const Gemm g, const Sched& S, const Epi& E) {
    int tid_o = threadIdx.x; asm volatile("" : "+v"(tid_o));
    const int tid = tid_o, wid = __builtin_amdgcn_readfirstlane(tid >> 6), lane = tid & 63, wr = wid >> 2, wc = wid & 3, fr = lane & 15, fq = lane >> 4;
    const int K = g.K, nt = K / BK;
    unsigned voffA[2], voffB[2];
#pragma unroll
    for (int i = 0; i < 2; ++i) { int R, C; stage_rc(tid * 16 + i * 8192, R, C); const int Rb = Epi::PERM ? ((R & ~31) + perm32(R & 31)) : R;
        voffA[i] = (unsigned)(R * g.lda + C) * 2u; voffB[i] = (unsigned)(Rb * K + C) * 2u; }
    const size_t kstep = (size_t)(BK * 2);
    const size_t hstepA = (size_t)HALF * g.lda * 2, hstepB = (size_t)HALF * K * 2;
    const size_t tstepA = 2 * hstepA, tstepB = 2 * hstepB;
    const unsigned ldsw = (unsigned)wid * 1024u;
    const int aoff = lds_byte(wr * 64 + fr, fq * 8), boff = lds_byte(wc * 32 + fr, fq * 8);
#define PG8_SA(b, h) (((b) * 2 + (h)) * HTB)
#define PG8_SB(b, h) ((4 + (b) * 2 + (h)) * HTB)
#define PG8_STAGE(bufoff, gbase, voff) do { _Pragma("unroll") for (int _i = 0; _i < 2; ++_i) \
        __builtin_amdgcn_global_load_lds((const unsigned*)((const char*)(gbase) + (voff)[_i]), (PG8_LAS unsigned*)(lds + (bufoff) + ldsw + _i * 8192), 16, 0, 0); } while (0)
#define PG8_LDA(dst, b, h) do { _Pragma("unroll") for (int m = 0; m < 4; ++m) _Pragma("unroll") for (int k = 0; k < 2; ++k) dst[m][k] = *(const PG8_LAS bf16x8*)(lds + PG8_SA(b, h) + aoff + m * 2048 + k * 1024); } while (0)
#define PG8_LDB(dst, b, h) do { _Pragma("unroll") for (int n = 0; n < 2; ++n) _Pragma("unroll") for (int k = 0; k < 2; ++k) dst[n][k] = *(const PG8_LAS bf16x8*)(lds + PG8_SB(b, h) + boff + n * 2048 + k * 1024); } while (0)
#define PG8_MMA(ai, bj, At, Bt) do { __builtin_amdgcn_s_setprio(1); _Pragma("unroll") for (int m = 0; m < 4; ++m) _Pragma("unroll") for (int n = 0; n < 2; ++n) _Pragma("unroll") for (int k = 0; k < 2; ++k) \
        acc[ai][bj][m][n] = __builtin_amdgcn_mfma_f32_16x16x32_bf16(Bt[n][k], At[m][k], acc[ai][bj][m][n], 0, 0, 0); __builtin_amdgcn_s_setprio(0); } while (0)
#define PG8_WAIT_V(n) asm volatile("s_waitcnt vmcnt(" #n ")" ::: "memory")
#define PG8_WAIT_L(n) asm volatile("s_waitcnt lgkmcnt(" #n ")" ::: "memory")
#define PG8_BAR __builtin_amdgcn_s_barrier()
#define PG8_SCHED __builtin_amdgcn_sched_barrier(0)
    Unit cur, nxt; int ui = 0;
    if (!S.next(0, cur)) return;
    f32x4 acc[2][2][4][2];
#pragma unroll
    for (int a = 0; a < 2; ++a)
#pragma unroll
        for (int b = 0; b < 2; ++b)
#pragma unroll
            for (int m = 0; m < 4; ++m)
#pragma unroll
                for (int n = 0; n < 2; ++n) acc[a][b][m][n] = (f32x4){0.f, 0.f, 0.f, 0.f};
    bf16x8 At[4][2], B0[2][2], B1[2][2];
    const char* cA = (const char*)g.A + (size_t)cur.pm * tstepA; const char* cB = (const char*)g.Bt + (size_t)cur.pn * tstepB;
    S.a_ready(cur);
    if constexpr (SP2) {
        PG8_STAGE(PG8_SB(0, 0), cB, voffB); PG8_STAGE(PG8_SB(0, 1), cB + hstepB, voffB); PG8_STAGE(PG8_SA(0, 0), cA, voffA); PG8_STAGE(PG8_SA(0, 1), cA + hstepA, voffA);
        if (wr == 1) PG8_BAR;
        PG8_WAIT_V(2); PG8_BAR;
        PG8_STAGE(PG8_SB(1, 0), cB + kstep, voffB); PG8_STAGE(PG8_SA(1, 0), cA + kstep, voffA); PG8_STAGE(PG8_SB(1, 1), cB + hstepB + kstep, voffB);
        PG8_WAIT_V(6); PG8_BAR;
    } else {
        PG8_STAGE(PG8_SB(0, 0), cB, voffB); PG8_STAGE(PG8_SA(0, 0), cA, voffA); PG8_STAGE(PG8_SB(0, 1), cB + hstepB, voffB); PG8_STAGE(PG8_SA(0, 1), cA + hstepA, voffA);
        if (wr == 1) PG8_BAR;
        PG8_WAIT_V(4); PG8_BAR;
        PG8_STAGE(PG8_SB(1, 0), cB + kstep, voffB); PG8_STAGE(PG8_SA(1, 0), cA + kstep, voffA); PG8_STAGE(PG8_SB(1, 1), cB + hstepB + kstep, voffB);
        PG8_WAIT_V(6); PG8_BAR;
    }
    for (;;) {
        const bool has_next = S.next(ui + 1, nxt);
        const char* nA = has_next ? (const char*)g.A + (size_t)nxt.pm * tstepA : cA; const char* nB = has_next ? (const char*)g.Bt + (size_t)nxt.pn * tstepB : cB;
        for (int t = 0; t < nt; t += 2) {
            const bool last = (t == nt - 2);
            const char* a1 = cA + (size_t)(t + 1) * kstep;
            const char* a2 = last ? nA : cA + (size_t)(t + 2) * kstep; const char* b2 = last ? nB : cB + (size_t)(t + 2) * kstep;
            const char* a3 = a2 + kstep; const char* b3 = b2 + kstep;
            if (last && has_next) S.a_ready(nxt);
            if constexpr (SP2) {
            PG8_LDB(B0, 0, 0); PG8_LDB(B1, 0, 1); PG8_SCHED; PG8_LDA(At, 0, 0); PG8_STAGE(PG8_SA(1, 1), a1 + hstepA, voffA);
            PG8_WAIT_V(8); PG8_WAIT_L(0); PG8_BAR; PG8_MMA(0, 0, At, B0); PG8_MMA(0, 1, At, B1); PG8_BAR; PG8_SCHED;
            PG8_LDA(At, 0, 1); PG8_STAGE(PG8_SB(0, 0), b2, voffB); PG8_STAGE(PG8_SB(0, 1), b2 + hstepB, voffB); PG8_STAGE(PG8_SA(0, 0), a2, voffA);
            PG8_WAIT_V(8); PG8_WAIT_L(0); PG8_BAR; PG8_MMA(1, 0, At, B0); PG8_MMA(1, 1, At, B1); PG8_BAR; PG8_SCHED;
            PG8_LDB(B0, 1, 0); PG8_LDB(B1, 1, 1); PG8_SCHED; PG8_LDA(At, 1, 0); PG8_STAGE(PG8_SA(0, 1), a2 + hstepA, voffA);
            PG8_WAIT_V(8); PG8_WAIT_L(0); PG8_BAR; PG8_MMA(0, 0, At, B0); PG8_MMA(0, 1, At, B1); PG8_BAR; PG8_SCHED;
            PG8_LDA(At, 1, 1); PG8_STAGE(PG8_SB(1, 0), b3, voffB); PG8_STAGE(PG8_SB(1, 1), b3 + hstepB, voffB); PG8_STAGE(PG8_SA(1, 0), a3, voffA);
            PG8_WAIT_V(8); PG8_WAIT_L(0); PG8_BAR; PG8_MMA(1, 0, At, B0); PG8_MMA(1, 1, At, B1); PG8_BAR; PG8_SCHED;
            } else {
            PG8_LDB(B0, 0, 0); PG8_SCHED; PG8_LDA(At, 0, 0); PG8_STAGE(PG8_SA(1, 1), a1 + hstepA, voffA);
            PG8_WAIT_L(8); PG8_BAR; PG8_WAIT_L(0); PG8_MMA(0, 0, At, B0); PG8_BAR; PG8_SCHED;
            PG8_LDB(B1, 0, 1); PG8_STAGE(PG8_SB(0, 0), b2, voffB);
            PG8_BAR; PG8_WAIT_L(0); PG8_MMA(0, 1, At, B1); PG8_BAR;
            PG8_LDA(At, 0, 1); PG8_STAGE(PG8_SA(0, 0), a2, voffA);
            PG8_BAR; PG8_WAIT_L(0); PG8_MMA(1, 0, At, B0); PG8_BAR; PG8_SCHED;
            PG8_STAGE(PG8_SB(0, 1), b2 + hstepB, voffB);
            PG8_WAIT_V(6); PG8_BAR; PG8_MMA(1, 1, At, B1); PG8_BAR;
            PG8_LDB(B0, 1, 0); PG8_SCHED; PG8_LDA(At, 1, 0); PG8_STAGE(PG8_SA(0, 1), a2 + hstepA, voffA);
            PG8_WAIT_L(8); PG8_BAR; PG8_WAIT_L(0); PG8_MMA(0, 0, At, B0); PG8_BAR; PG8_SCHED;
            PG8_LDB(B1, 1, 1); PG8_STAGE(PG8_SB(1, 0), b3, voffB);
            PG8_BAR; PG8_WAIT_L(0); PG8_MMA(0, 1, At, B1); PG8_BAR;
            PG8_LDA(At, 1, 1); PG8_STAGE(PG8_SA(1, 0), a3, voffA);
            PG8_BAR; PG8_WAIT_L(0); PG8_MMA(1, 0, At, B0); PG8_BAR; PG8_SCHED;
            PG8_STAGE(PG8_SB(1, 1), b3 + hstepB, voffB);
            PG8_WAIT_V(6); PG8_BAR; PG8_MMA(1, 1, At, B1); PG8_BAR;
            }
        }
        if constexpr (ALIGN_EPI) { if (wr == 0) PG8_BAR; }
        if constexpr (!Epi::AFTER_DRAIN) { E(acc, cur, wr, wc, fr, fq); S.done(cur); }
        if (!has_next) break;
#pragma unroll
        for (int a = 0; a < 2; ++a)
#pragma unroll
            for (int b = 0; b < 2; ++b)
#pragma unroll
                for (int m = 0; m < 4; ++m)
#pragma unroll
                    for (int n = 0; n < 2; ++n) acc[a][b][m][n] = (f32x4){0.f, 0.f, 0.f, 0.f};
        cur = nxt; cA = nA; cB = nB; ++ui;
        if constexpr (ALIGN_EPI) { if (wr == 1) PG8_BAR; }
    }
    PG8_WAIT_V(0);
    if constexpr (!ALIGN_EPI) { if (wr == 0) PG8_BAR; }
    PG8_BAR;
    if constexpr (Epi::AFTER_DRAIN) { E.fused(acc, cur, wr, wc, fr, fq, lds, wid, lane); S.done(cur); }
#undef PG8_SA
#undef PG8_SB
#undef PG8_STAGE
#undef PG8_LDA
#undef PG8_LDB
#undef PG8_MMA
#undef PG8_WAIT_V
#undef PG8_WAIT_L
#undef PG8_BAR
#undef PG8_SCHED
}
}


constexpr int BATCH = 8, SEQ = 2048, CTXL = 256, D = 1024, DEPTH = 2;
constexpr int TL = BATCH * SEQ, TC = BATCH * CTXL, T = TL + TC;
constexpr int NIN = 8448;
constexpr int DFF = 2816, NE = 8, NUP = 2 * DFF;
constexpr int MOE_ROWS = 2 * TL + NE * 256;
constexpr float EPS = 1e-6f;
constexpr int NTHREADS = 512, NWAVES = 8;
constexpr int LDS_BYTES = 147456;

typedef unsigned short bf16_t;
typedef float f32x4 __attribute__((ext_vector_type(4)));
typedef float f32x16 __attribute__((ext_vector_type(16)));
typedef unsigned u32x4 __attribute__((ext_vector_type(4)));
typedef unsigned u32x2 __attribute__((ext_vector_type(2)));
typedef short bf16x8 __attribute__((ext_vector_type(8)));
typedef short s16x4 __attribute__((ext_vector_type(4)));

constexpr size_t al256(size_t x) { return (x + 255) & ~(size_t)255; }
constexpr size_t WS_CTL   = 0;                                   constexpr size_t CTL_BYTES = 65536;
constexpr size_t WS_MOD   = WS_CTL + CTL_BYTES;                  constexpr size_t MOD_BYTES = (size_t)DEPTH * 9 * 6 * D * 4;
constexpr size_t WS_ROUTE = al256(WS_MOD + MOD_BYTES);           constexpr size_t ROUTE_BYTES = (size_t)TL * 16;
constexpr size_t WS_SLOT  = al256(WS_ROUTE + ROUTE_BYTES);       constexpr size_t SLOT_BYTES = (size_t)TL * 8;
constexpr size_t WS_MISC  = al256(WS_SLOT + SLOT_BYTES);         constexpr size_t MISC_BYTES = 4096;
constexpr size_t WS_GB    = al256(WS_MISC + MISC_BYTES);         constexpr size_t GB_BYTES = (size_t)T * 16 * 4;
constexpr size_t WS_SMALL = al256(WS_GB + GB_BYTES);             constexpr size_t SMALL_BYTES = (size_t)T * 64 * 4;
constexpr size_t WS_XC    = al256(WS_SMALL + SMALL_BYTES);       constexpr size_t XC_BYTES = (size_t)TC * D * 4;
constexpr size_t WS_WB    = al256(WS_XC + XC_BYTES);
constexpr size_t WB_WIN   = WS_WB;                               constexpr size_t WIN_BYTES = (size_t)NIN * D * 2;
constexpr size_t WB_WO    = WB_WIN + DEPTH * WIN_BYTES;          constexpr size_t WO_BYTES = (size_t)D * 512 * 2;
constexpr size_t WB_WOUT  = WB_WO + DEPTH * 3 * WO_BYTES;        constexpr size_t WOUT_BYTES = (size_t)D * D * 2;
constexpr size_t WB_WUP   = WB_WOUT + DEPTH * WOUT_BYTES;        constexpr size_t WUP_BYTES = (size_t)NUP * D * 2;
constexpr size_t WB_WDN   = WB_WUP + WUP_BYTES;                  constexpr size_t WDN_BYTES = (size_t)D * DFF * 2;
constexpr size_t WB_END   = WB_WDN + WDN_BYTES;
constexpr size_t WS_H     = al256(WB_END);                       constexpr size_t H_BYTES = (size_t)T * D * 2;
constexpr size_t WS_PAQ   = al256(WS_H + H_BYTES);               constexpr size_t PAQ_BYTES = (size_t)T * 1536 * 2;
constexpr size_t WS_PZ    = al256(WS_PAQ + PAQ_BYTES);           constexpr size_t PZ_BYTES = (size_t)T * 512 * 2;
constexpr size_t WS_PB    = al256(WS_PZ + PZ_BYTES);             constexpr size_t PB_BYTES = (size_t)T * 1536 * 2;
constexpr size_t WS_PC    = al256(WS_PB + PB_BYTES);             constexpr size_t PC_BYTES = (size_t)T * 1536 * 2;
constexpr size_t WS_PG    = al256(WS_PC + PC_BYTES);             constexpr size_t PG_BYTES = (size_t)T * 3072 * 2;
constexpr size_t WS_DNQKV = al256(WS_PG + PG_BYTES);             constexpr size_t DNQKV_BYTES = (size_t)T * 1536 * 2;
constexpr size_t WS_TQ    = al256(WS_DNQKV + DNQKV_BYTES);       constexpr size_t TQ_BYTES = (size_t)BATCH * 4 * 2 * ((CTXL + SEQ) / 64) * 16384;
constexpr size_t WS_VEC   = al256(WS_TQ + TQ_BYTES);             constexpr size_t VEC_BYTES = (size_t)BATCH * 4 * 2 * ((CTXL + SEQ) / 64) * 1024;
constexpr size_t WS_END   = al256(WS_VEC + VEC_BYTES);
static_assert(WS_END <= (size_t)524288000, "d_ws map exceeds 500 MiB (documented minimum is 525,980,800 B)");
constexpr size_t WS_H1    = WS_PB;
static_assert((size_t)T * DFF * 2 <= PB_BYTES + PC_BYTES, "h1 overlay");
constexpr size_t WS_MWDN  = WS_WB;                                constexpr size_t MWDN_BYTES = (size_t)NE * D * DFF * 2;
static_assert(MWDN_BYTES <= WB_END - WS_WB, "moe wdn overlay");
constexpr size_t WS_MWUP  = WS_PAQ;                               constexpr size_t MWUP_BYTES = (size_t)NE * NUP * D * 2;
constexpr size_t WS_MA    = al256(WS_MWUP + MWUP_BYTES);          constexpr size_t MA_BYTES = (size_t)MOE_ROWS * D * 2;
constexpr size_t WS_MH1   = al256(WS_MA + MA_BYTES);              constexpr size_t MH1_BYTES = (size_t)MOE_ROWS * DFF * 2;
static_assert(WS_MH1 + MH1_BYTES <= WS_END, "moe overlay");
constexpr int CW_QUEUE = 0;
constexpr int CW_KMAX = 256;
constexpr int CW_ECNT = 512;
constexpr int CW_EFILL = 576;
constexpr int CW_BAR = 4096;
constexpr int MI_LAMF = 0;
constexpr int MI_NTILES = 16;
constexpr int MI_EOFF = 32;
constexpr int MI_TILEE = 64;

__device__ __forceinline__ unsigned f2bf(float f) { unsigned u = __builtin_bit_cast(unsigned, f); return (u + 0x7fffu + ((u >> 16) & 1u)) >> 16; }
__device__ __forceinline__ unsigned pk2(float lo, float hi) { return f2bf(lo) | (f2bf(hi) << 16); }
__device__ __forceinline__ float bflo(unsigned w) { return __builtin_bit_cast(float, w << 16); }
__device__ __forceinline__ float bfhi(unsigned w) { return __builtin_bit_cast(float, w & 0xffff0000u); }
__device__ __forceinline__ float bf2f(bf16_t h) { return __builtin_bit_cast(float, (unsigned)h << 16); }
__device__ __forceinline__ int otid() { int t = threadIdx.x; asm volatile("" : "+v"(t)); return t; }
__device__ __forceinline__ float shx(float v, int o) { const int idx = ((otid() & 63) ^ o) << 2; return __builtin_bit_cast(float, __builtin_amdgcn_ds_bpermute(idx, __builtin_bit_cast(int, v))); }
__device__ __forceinline__ float shup(float v, int o) { const int idx = (((otid() & 63) - o) & 63) << 2; return __builtin_bit_cast(float, __builtin_amdgcn_ds_bpermute(idx, __builtin_bit_cast(int, v))); }
__device__ __forceinline__ float shlane(float v, int src) { return __builtin_bit_cast(float, __builtin_amdgcn_ds_bpermute(src << 2, __builtin_bit_cast(int, v))); }
__device__ __forceinline__ int shlane_i(int v, int src) { return __builtin_amdgcn_ds_bpermute(src << 2, v); }
__device__ __forceinline__ float wave_sum(float v) {
#pragma unroll
    for (int o = 1; o < 64; o <<= 1) v += shx(v, o);
    return v;
}
__device__ __forceinline__ float sigmoidf_(float x) { return 1.0f / (1.0f + __expf(-x)); }
__device__ __forceinline__ float siluf_(float x) { return x / (1.0f + __expf(-x)); }
__device__ __forceinline__ float softplusf_(float x) { return x > 20.f ? x : log1pf(expf(x)); }
__device__ __forceinline__ float logsigmoidf_(float x) { return fminf(x, 0.f) - log1pf(expf(-fabsf(x))); }

struct P {
    const float *x, *c, *ctx, *c_ctx, *w_mod, *b_mod, *norm1_g, *norm2_g, *w_in, *conv_a, *a_log, *dt_bias, *gn_a, *w_gate2, *b_gate, *gn_b,
                *lam_c, *gn_c, *w_o_a, *w_o_b, *w_o_c, *w_out, *ffn_w1, *ffn_w3, *ffn_w2, *router_w, *moe_w1, *moe_w3, *moe_w2, *final_g;
    float* out; unsigned char* ws;
};

template <class ColMap>
__device__ __forceinline__ void convert_T(const float* W, int K, int ldw, bf16_t* WT, int Nrows, ColMap cm, float* scr, int gw, int NGW, int lane) {
    const int nblk = Nrows / 32, items = (K / 64) * nblk;
    for (int it = gw; it < items; it += NGW) {
        const int kb = it / nblk, nb = it % nblk, k0 = 64 * kb, n0 = 32 * nb;
        const int sc = cm(n0 + (lane & 31));
#pragma unroll 8
        for (int i = 0; i < 32; ++i) { const int kk = 2 * i + (lane >> 5); scr[kk * 33 + (lane & 31)] = sc >= 0 ? W[(size_t)(k0 + kk) * ldw + sc] : 0.f; }
        asm volatile("s_waitcnt lgkmcnt(0)" ::: "memory");
        const int c = lane & 7;
#pragma unroll
        for (int j = 0; j < 4; ++j) { const int n = (lane >> 3) + 8 * j; const float* s = scr + (8 * c) * 33 + n;
            u32x4 o; o.x = pk2(s[0 * 33], s[1 * 33]); o.y = pk2(s[2 * 33], s[3 * 33]); o.z = pk2(s[4 * 33], s[5 * 33]); o.w = pk2(s[6 * 33], s[7 * 33]);
            *(u32x4*)(WT + (size_t)(n0 + n) * K + k0 + 8 * c) = o; }
        asm volatile("s_waitcnt lgkmcnt(0)" ::: "memory");
    }
}
struct CmIdent { __device__ int operator()(int n) const { return n; } };
struct CmWin { __device__ int operator()(int n) const {
    if (n < 2048) return n; if (n < 3584) return n + 16; if (n < 8192) return n + 48;
    const int j = n - 8192; if (j < 16) return 2048 + j; if (j < 48) return 3600 + (j - 16); return -1; } };

typedef const f32x4 (&AccRef)[2][2][4][2];
struct EpiWin {
    static constexpr bool PERM = true, AFTER_DRAIN = false;
    bf16_t *paq, *pz, *pb, *pc, *pg; float* small_;
    __device__ __forceinline__ void operator()(AccRef acc, const pg8::Unit& u, int wr, int wc, int fr, int fq) const {
        const int row0 = u.pm * 256 + wr * 64 + fr, pn = u.pn;
        if (pn == 32) {
            if (wc < 2) {
#pragma unroll
                for (int ai = 0; ai < 2; ++ai)
#pragma unroll
                    for (int m = 0; m < 4; ++m) { float* p = small_ + (size_t)(row0 + ai * 128 + m * 16) * 64 + wc * 32 + 8 * fq;
                        *(f32x4*)p = acc[ai][0][m][0]; *(f32x4*)(p + 4) = acc[ai][0][m][1]; }
            }
            return;
        }
        bf16_t* base; int ldc, c0;
        if (pn < 6) { base = paq; ldc = 1536; c0 = pn * 256; } else if (pn < 8) { base = pz; ldc = 512; c0 = (pn - 6) * 256; }
        else if (pn < 14) { base = pb; ldc = 1536; c0 = (pn - 8) * 256; } else if (pn < 20) { base = pc; ldc = 1536; c0 = (pn - 14) * 256; }
        else { base = pg; ldc = 3072; c0 = (pn - 20) * 256; }
        const int col = c0 + wc * 32 + 8 * fq;
#pragma unroll
        for (int ai = 0; ai < 2; ++ai)
#pragma unroll
            for (int m = 0; m < 4; ++m) { bf16_t* rowp = base + (size_t)(row0 + ai * 128 + m * 16) * ldc + col;
#pragma unroll
                for (int bj = 0; bj < 2; ++bj) { const f32x4 v0 = acc[ai][bj][m][0], v1 = acc[ai][bj][m][1];
                    u32x4 w; w.x = pk2(v0[0], v0[1]); w.y = pk2(v0[2], v0[3]); w.z = pk2(v1[0], v1[1]); w.w = pk2(v1[2], v1[3]);
                    *(u32x4*)(rowp + bj * 128) = w; } }
    }
};
struct EpiGate {
    static constexpr bool PERM = true, AFTER_DRAIN = false;
    bf16_t* Mo; const bf16_t* pg; int br;
    __device__ __forceinline__ void operator()(AccRef acc, const pg8::Unit& u, int wr, int wc, int fr, int fq) const {
        const int row0 = u.pm * 256 + wr * 64 + fr, col = u.pn * 256 + wc * 32 + 8 * fq;
#pragma unroll
        for (int ai = 0; ai < 2; ++ai)
#pragma unroll
            for (int m = 0; m < 4; ++m) { const size_t row = (size_t)(row0 + ai * 128 + m * 16);
#pragma unroll
                for (int bj = 0; bj < 2; ++bj) {
                    const u32x4 gw = *(const u32x4*)(pg + row * 3072 + br * 1024 + col + bj * 128);
                    bf16_t* mp = Mo + row * 1024 + col + bj * 128;
                    f32x4 v0 = acc[ai][bj][m][0], v1 = acc[ai][bj][m][1];
                    v0[0] *= sigmoidf_(bflo(gw.x)); v0[1] *= sigmoidf_(bfhi(gw.x)); v0[2] *= sigmoidf_(bflo(gw.y)); v0[3] *= sigmoidf_(bfhi(gw.y));
                    v1[0] *= sigmoidf_(bflo(gw.z)); v1[1] *= sigmoidf_(bfhi(gw.z)); v1[2] *= sigmoidf_(bflo(gw.w)); v1[3] *= sigmoidf_(bfhi(gw.w));
                    if (br != 0) { const u32x4 o = *(const u32x4*)mp;
                        v0[0] += bflo(o.x); v0[1] += bfhi(o.x); v0[2] += bflo(o.y); v0[3] += bfhi(o.y); v1[0] += bflo(o.z); v1[1] += bfhi(o.z); v1[2] += bflo(o.w); v1[3] += bfhi(o.w); }
                    u32x4 w; w.x = pk2(v0[0], v0[1]); w.y = pk2(v0[2], v0[3]); w.z = pk2(v1[0], v1[1]); w.w = pk2(v1[2], v1[3]);
                    *(u32x4*)mp = w; } }
    }
};
struct EpiResid {
    static constexpr bool PERM = false, AFTER_DRAIN = false;
    const float *old_l, *old_c; float *out_l, *out_c; const float* mod; int gidx;
    __device__ __forceinline__ void operator()(AccRef acc, const pg8::Unit& u, int wr, int wc, int fr, int fq) const {
        const int col0 = u.pn * 256 + wc * 32 + 4 * fq;
        const bool isctx = u.pm >= TL / 256; const int b = isctx ? 8 : u.pm / (SEQ / 256);
        const float* g = mod + (size_t)b * 6144 + gidx * 1024 + col0;
        const float* ob = isctx ? old_c - (size_t)TL * D : old_l; float* wb = isctx ? out_c - (size_t)TL * D : out_l;
        f32x4 gv[2][2];
#pragma unroll
        for (int bj = 0; bj < 2; ++bj)
#pragma unroll
            for (int n = 0; n < 2; ++n) gv[bj][n] = *(const f32x4*)(g + bj * 128 + n * 16);
#pragma unroll
        for (int ai = 0; ai < 2; ++ai)
#pragma unroll
            for (int m = 0; m < 4; ++m) { const size_t off = (size_t)(u.pm * 256 + ai * 128 + wr * 64 + m * 16 + fr) * D + col0;
#pragma unroll
                for (int bj = 0; bj < 2; ++bj)
#pragma unroll
                    for (int n = 0; n < 2; ++n) { const f32x4 xo = *(const f32x4*)(ob + off + bj * 128 + n * 16);
                        *(f32x4*)(wb + off + bj * 128 + n * 16) = xo + gv[bj][n] * acc[ai][bj][m][n]; } }
    }
};
struct EpiSwiglu {
    static constexpr bool PERM = true, AFTER_DRAIN = false;
    bf16_t* h1; int NJ;
    __device__ __forceinline__ void operator()(AccRef acc, const pg8::Unit& u, int wr, int wc, int fr, int fq) const {
        const int row0 = u.pm * 256 + wr * 64 + fr, col = (u.pn % NJ) * 128 + wc * 32 + 8 * fq;
#pragma unroll
        for (int ai = 0; ai < 2; ++ai)
#pragma unroll
            for (int m = 0; m < 4; ++m) { const f32x4 a0 = acc[ai][0][m][0], a1 = acc[ai][0][m][1], b0 = acc[ai][1][m][0], b1 = acc[ai][1][m][1];
                u32x4 w; w.x = pk2(siluf_(a0[0]) * b0[0], siluf_(a0[1]) * b0[1]); w.y = pk2(siluf_(a0[2]) * b0[2], siluf_(a0[3]) * b0[3]);
                w.z = pk2(siluf_(a1[0]) * b1[0], siluf_(a1[1]) * b1[1]); w.w = pk2(siluf_(a1[2]) * b1[2], siluf_(a1[3]) * b1[3]);
                *(u32x4*)(h1 + (size_t)(row0 + ai * 128 + m * 16) * DFF + col) = w; }
    }
};
struct EpiMoeDown {
    static constexpr bool PERM = true, AFTER_DRAIN = false;
    bf16_t* y;
    __device__ __forceinline__ void operator()(AccRef acc, const pg8::Unit& u, int wr, int wc, int fr, int fq) const {
        const int row0 = u.pm * 256 + wr * 64 + fr, col = (u.pn % 4) * 256 + wc * 32 + 8 * fq;
#pragma unroll
        for (int ai = 0; ai < 2; ++ai)
#pragma unroll
            for (int m = 0; m < 4; ++m) { bf16_t* rowp = y + (size_t)(row0 + ai * 128 + m * 16) * D + col;
#pragma unroll
                for (int bj = 0; bj < 2; ++bj) { const f32x4 v0 = acc[ai][bj][m][0], v1 = acc[ai][bj][m][1];
                    u32x4 w; w.x = pk2(v0[0], v0[1]); w.y = pk2(v0[2], v0[3]); w.z = pk2(v1[0], v1[1]); w.w = pk2(v1[2], v1[3]);
                    *(u32x4*)(rowp + bj * 128) = w; } }
    }
};
struct MoeOrder {
    int ntiles, NJ, G, c; const int* tile_e;
    __device__ bool next(int i, pg8::Unit& u) const { const long L = (long)i * G + c; if (L >= (long)ntiles * NJ) return false;
        const int t = (int)(L / NJ), j = (int)(L % NJ); u.pm = t; u.pn = tile_e[t] * NJ + j; return true; }
    __device__ __forceinline__ void a_ready(const pg8::Unit&) const {}
    __device__ __forceinline__ void done(const pg8::Unit&) const {}
};

#define XB_TMO      128
#define XB_XCNT(j)  (256  + 64 * (j))
#define XB_XSUB(j)  (1280 + 64 * (j))
#define XB_XGEN(j)  (2304 + 64 * (j))
#define XB_TOP      3328
#define XB_TOPGEN   3392
#define XCD_BAR_WORDS 3456
#define XB_SPIN_CAP (1u << 18)

__device__ __forceinline__ unsigned xb_ld(unsigned* p)              { return __hip_atomic_load(p, __ATOMIC_RELAXED, __HIP_MEMORY_SCOPE_AGENT); }
__device__ __forceinline__ unsigned xb_add(unsigned* p, unsigned v) { return __hip_atomic_fetch_add(p, v, __ATOMIC_RELAXED, __HIP_MEMORY_SCOPE_AGENT); }
__device__ __forceinline__ unsigned xb_xcc_id() { return (unsigned)__builtin_amdgcn_s_getreg((3 << 11) | 20) & 0xFu; }
#define XB_SPIN(cond, bar) do { unsigned _sp = 0; while (cond) { __builtin_amdgcn_s_sleep(1); \
    if ((++_sp & 255u) == 0u) { if (xb_ld(&(bar)[XB_TMO])) break; if (_sp > XB_SPIN_CAP) { atomicAdd(&(bar)[XB_TMO], 1u); break; } } } } while (0)

struct XcdBarrier {
    unsigned* bar; unsigned x;
    volatile unsigned* st;
};

__device__ __forceinline__ XcdBarrier xcd_barrier_post(unsigned* bar, volatile unsigned* st) {
    XcdBarrier b; b.bar = bar; b.x = xb_xcc_id(); b.st = st;
    if (threadIdx.x == 0) (void)xb_add(&bar[XB_XCNT(b.x)], 1u);
    return b;
}
__device__ __forceinline__ void xcd_barrier_complete(unsigned* bar, unsigned x, unsigned& nloc, unsigned& nx) {
    const unsigned G = gridDim.x * gridDim.y * gridDim.z;
    unsigned sum, cnt, mine, sp = 0u;
    for (;;) {
        sum = 0u; cnt = 0u; mine = 0u;
#pragma unroll
        for (unsigned j = 0; j < 16; ++j) { const unsigned c = xb_ld(&bar[XB_XCNT(j)]); sum += c; cnt += (c > 0u) ? 1u : 0u; mine = (j == x) ? c : mine; }
        if (sum == G) break;
        __builtin_amdgcn_s_sleep(1);
        if ((++sp & 255u) == 0u) { if (xb_ld(&bar[XB_TMO])) break; if (sp > XB_SPIN_CAP) { atomicAdd(&bar[XB_TMO], 1u); break; } }
    }
    nloc = mine > 0u ? mine : 1u; nx = cnt > 0u ? cnt : 1u;
}

__device__ __forceinline__ void xcd_barrier(const XcdBarrier& b) {
    asm volatile("s_waitcnt vmcnt(0)" ::: "memory");
    __syncthreads();
    if (threadIdx.x == 0) {
        unsigned* bar = b.bar;
        __builtin_amdgcn_s_waitcnt(0);
        unsigned nloc = b.st[0], nx = b.st[1];
        if (nloc == 0u) { xcd_barrier_complete(bar, b.x, nloc, nx); b.st[0] = nloc; b.st[1] = nx; }
        const unsigned old = xb_add(&bar[XB_XSUB(b.x)], 1u);
        const unsigned gen = old / nloc;
        if (old + 1u == (gen + 1u) * nloc) {
            __builtin_amdgcn_fence(__ATOMIC_RELEASE, "agent");
            asm volatile("s_waitcnt vmcnt(0)" ::: "memory");
            const unsigned og = xb_add(&bar[XB_TOP], 1u);
            const unsigned tg = og / nx;
            if (og + 1u == (tg + 1u) * nx) xb_add(&bar[XB_TOPGEN], 1u);
            else XB_SPIN(xb_ld(&bar[XB_TOPGEN]) == tg, bar);
            __builtin_amdgcn_fence(__ATOMIC_ACQUIRE, "agent");
            xb_add(&bar[XB_XGEN(b.x)], 1u);
            asm volatile("s_waitcnt vmcnt(0)" ::: "memory");
        } else {
            XB_SPIN(xb_ld(&bar[XB_XGEN(b.x)]) == gen, bar);
            __builtin_amdgcn_fence(__ATOMIC_ACQUIRE, "agent");
            asm volatile("s_waitcnt vmcnt(0)" ::: "memory");
        }
    }
    __syncthreads();
}

__device__ __forceinline__ void phase_mod(const P& p, unsigned char* lds) {
    float* sc = (float*)lds;
    float* red = sc + 9 * 1024;
    const int tid = otid();
    for (int i = tid; i < 9 * 1024; i += NTHREADS) { const int r = i >> 10, k = i & 1023; const float v = r < 8 ? p.c[r * 1024 + k] : p.c_ctx[k]; sc[i] = siluf_(v); }
    __syncthreads();
    float* MOD = (float*)(p.ws + WS_MOD);
    const int cj = tid % 48, ks = tid / 48;
    for (int grp = blockIdx.x; grp < DEPTH * 6144 / 48; grp += gridDim.x) {
        const int l = grp / 128, j = (grp % 128) * 48 + cj;
        float a[9];
#pragma unroll
        for (int r = 0; r < 9; ++r) a[r] = 0.f;
        if (ks < 10) {
            const float* w = p.w_mod + (size_t)l * 1024 * 6144 + j;
            for (int k = ks; k < 1024; k += 10) { const float wv = w[(size_t)k * 6144];
#pragma unroll
                for (int r = 0; r < 9; ++r) a[r] += sc[r * 1024 + k] * wv; }
#pragma unroll
            for (int r = 0; r < 9; ++r) red[(ks * 9 + r) * 48 + cj] = a[r];
        }
        __syncthreads();
        if (tid < 9 * 48) { const int r = tid / 48, c2 = tid % 48; float s = 0.f;
#pragma unroll
            for (int q = 0; q < 10; ++q) s += red[(q * 9 + r) * 48 + c2];
            const int jj = (grp % 128) * 48 + c2;
            MOD[((size_t)l * 9 + r) * 6144 + jj] = s + p.b_mod[l * 6144 + jj]; }
        __syncthreads();
    }
}

__device__ __forceinline__ void phase_modulate(const float* src_l, const float* src_c, int nrows, const float* gain, const float* mod, int shift_idx,
                                               bf16_t* H, const float* router_w, int* route, unsigned* ecnt, unsigned* lcnt  , int gw, int NGW, int lane) {
    if (router_w) { if (otid() < NE) lcnt[otid()] = 0u; __syncthreads(); }
    for (int r = gw; r < nrows; r += NGW) {
        const bool isctx = r >= TL; const int b = isctx ? 8 : r / SEQ;
        const float* xr = isctx ? src_c + (size_t)(r - TL) * D : src_l + (size_t)r * D;
        const float* sh = mod + (size_t)b * 6144 + shift_idx * 1024; const float* scl = sh + 1024;
        f32x4 v[4]; float ss = 0.f;
#pragma unroll
        for (int j = 0; j < 4; ++j) { v[j] = *(const f32x4*)(xr + 4 * lane + 256 * j); ss += (v[j][0] * v[j][0] + v[j][1] * v[j][1]) + (v[j][2] * v[j][2] + v[j][3] * v[j][3]); }
        const float rs = 1.0f / sqrtf(wave_sum(ss) * (1.0f / D) + EPS);
#pragma unroll
        for (int j = 0; j < 4; ++j) { const int c = 4 * lane + 256 * j; const f32x4 g = *(const f32x4*)(gain + c), s1 = *(const f32x4*)(scl + c), s0 = *(const f32x4*)(sh + c);
            v[j] = v[j] * rs * g * (1.0f + s1) + s0;
            u32x2 w; w.x = pk2(v[j][0], v[j][1]); w.y = pk2(v[j][2], v[j][3]);
            *(u32x2*)(H + (size_t)r * D + c) = w; }
        if (router_w) {
            float lg[NE];
#pragma unroll
            for (int e = 0; e < NE; ++e) lg[e] = 0.f;
#pragma unroll
            for (int j = 0; j < 4; ++j)
#pragma unroll
                for (int q = 0; q < 4; ++q) { const float* rw = router_w + (size_t)(4 * lane + 256 * j + q) * NE; const f32x4 r0 = *(const f32x4*)rw, r1 = *(const f32x4*)(rw + 4); const float hv = v[j][q];
                    lg[0] += hv * r0[0]; lg[1] += hv * r0[1]; lg[2] += hv * r0[2]; lg[3] += hv * r0[3]; lg[4] += hv * r1[0]; lg[5] += hv * r1[1]; lg[6] += hv * r1[2]; lg[7] += hv * r1[3]; }
#pragma unroll
            for (int e = 0; e < NE; ++e) lg[e] = wave_sum(lg[e]);
            int e1 = 0; float v1 = lg[0];
#pragma unroll
            for (int e = 1; e < NE; ++e) if (lg[e] > v1) { v1 = lg[e]; e1 = e; }
            int e2 = -1; float v2 = -3.0e38f;
#pragma unroll
            for (int e = 0; e < NE; ++e) if (e != e1 && lg[e] > v2) { v2 = lg[e]; e2 = e; }
            const float w2 = 1.0f / (1.0f + expf(v1 - v2)), w1 = 1.0f - w2;
            if (lane == 0) { route[r * 4 + 0] = e1; route[r * 4 + 1] = e2; ((float*)route)[r * 4 + 2] = w1; ((float*)route)[r * 4 + 3] = w2;
                atomicAdd(lcnt + e1, 1u); atomicAdd(lcnt + e2, 1u); }
        }
    }
    if (router_w) { __syncthreads(); if (otid() < NE && lcnt[otid()]) atomicAdd(ecnt + otid(), lcnt[otid()]); }
}


typedef short v4i16_t __attribute__((ext_vector_type(4)));
__device__ __forceinline__ s16x4 lds_tr(const bf16_t* pp) { return __builtin_bit_cast(s16x4, __builtin_amdgcn_ds_read_tr16_b64_v4i16((__attribute__((address_space(3))) v4i16_t*)pp)); }
__device__ __forceinline__ bf16x8 cat8(s16x4 a, s16x4 b) { union { bf16x8 v; s16x4 h[2]; } u; u.h[0] = a; u.h[1] = b; return u.v; }
__device__ __forceinline__ bf16x8 pack8(f32x4 a, f32x4 b) { union { bf16x8 v; unsigned u[4]; } r; r.u[0] = pk2(a[0], a[1]); r.u[1] = pk2(a[2], a[3]); r.u[2] = pk2(b[0], b[1]); r.u[3] = pk2(b[2], b[3]); return r.v; }
constexpr int DN_NCH = (CTXL + SEQ) / 64;
constexpr int DN_ITEMS = BATCH * 4 * 2 * DN_NCH;
constexpr int PREP_WLDS = 16384 + 17408 + 512;

__device__ __forceinline__ int dn_row(int n, int s, int b, int dir) {
    const bool isctx = n < CTXL / 64; const int L = isctx ? CTXL : SEQ, c = isctx ? n : n - CTXL / 64, u = 64 * c + s, t = dir ? L - 1 - u : u;
    return (isctx ? TL + b * CTXL : b * SEQ) + t;
}
__device__ __forceinline__ void dn_prep_item(const P& p, int l, int item, unsigned char* wlds, int lane) {
    const int n = item % DN_NCH, bhd = item / DN_NCH, dir = bhd & 1, h = (bhd >> 1) & 3, b = bhd >> 3;
    const bool isctx = n < CTXL / 64; const int L = isctx ? CTXL : SEQ, cch = isctx ? n : n - CTXL / 64, rbase = isctx ? TL + b * CTXL : b * SEQ;
    const int i16 = lane & 15, g = lane >> 4;
    const bf16_t* PAQ = (const bf16_t*)(p.ws + WS_PAQ); bf16_t* DN = (bf16_t*)(p.ws + WS_DNQKV); const float* SMALL = (const float*)(p.ws + WS_SMALL);
    const float* cw = p.conv_a + (size_t)l * 3 * 1536;
    constexpr int KCP = 136;
    float* Ls = (float*)wlds; bf16_t* Kc = (bf16_t*)(wlds + 16384); float* Tl = (float*)(wlds + 16384);
    float* gcs = (float*)(wlds + 16384 + 17408); float* bes = gcs + 64;
    {
        const int r = dn_row(n, lane, b, dir);
        const float bb = SMALL[(size_t)r * 64 + dir * 4 + h], aa = SMALL[(size_t)r * 64 + 8 + dir * 4 + h];
        const float gv = -expf(p.a_log[l * 8 + dir * 4 + h]) * softplusf_(aa + p.dt_bias[l * 8 + dir * 4 + h]), be = sigmoidf_(bb);
        float gc = gv;
#pragma unroll
        for (int o = 1; o < 64; o <<= 1) { const float u = shup(gc, o); if (lane >= o) gc += u; }
        const float gl = shlane(gc, 63);
        gcs[lane] = gc; bes[lane] = be;
        float* vec = (float*)(p.ws + WS_VEC) + (size_t)item * 256;
        vec[lane] = expf(gc); vec[64 + lane] = expf(gl - gc); vec[128 + lane] = be; vec[192 + lane] = expf(gl);
    }
    auto conv_frag = [&](int seg, int mt, bf16x8 (&F)[4]) {
        const int u = 64 * cch + 16 * mt + i16, t = dir ? L - 1 - u : u; const size_t r = (size_t)(rbase + t);
        float y[4][8]; float ss = 0.f;
#pragma unroll
        for (int ks = 0; ks < 4; ++ks) { const int col = seg * 512 + h * 128 + 32 * ks + 8 * g;
            const u32x4 x1 = *(const u32x4*)(PAQ + r * 1536 + col);
            u32x4 x0 = (u32x4){0u, 0u, 0u, 0u}, x2 = (u32x4){0u, 0u, 0u, 0u};
            if (t > 0) x0 = *(const u32x4*)(PAQ + (r - 1) * 1536 + col);
            if (t < L - 1) x2 = *(const u32x4*)(PAQ + (r + 1) * 1536 + col);
            const f32x4 wa0 = *(const f32x4*)(cw + col), wa1 = *(const f32x4*)(cw + col + 4), wb0 = *(const f32x4*)(cw + 1536 + col), wb1 = *(const f32x4*)(cw + 1536 + col + 4),
                        wc0 = *(const f32x4*)(cw + 3072 + col), wc1 = *(const f32x4*)(cw + 3072 + col + 4);
            const unsigned xa[4] = {x0.x, x0.y, x0.z, x0.w}, xb[4] = {x1.x, x1.y, x1.z, x1.w}, xc[4] = {x2.x, x2.y, x2.z, x2.w};
#pragma unroll
            for (int q = 0; q < 4; ++q) { const f32x4& wa = q < 2 ? wa0 : wa1; const f32x4& wb = q < 2 ? wb0 : wb1; const f32x4& wc = q < 2 ? wc0 : wc1; const int e2 = (2 * q) & 3;
                const float v0 = siluf_(wa[e2] * bflo(xa[q]) + wb[e2] * bflo(xb[q]) + wc[e2] * bflo(xc[q])), v1 = siluf_(wa[e2 + 1] * bfhi(xa[q]) + wb[e2 + 1] * bfhi(xb[q]) + wc[e2 + 1] * bfhi(xc[q]));
                y[ks][2 * q] = v0; y[ks][2 * q + 1] = v1; ss += v0 * v0 + v1 * v1; }
            if (ks == 1) asm volatile("" ::: "memory");
        }
        float sc = 1.0f;
        if (seg < 2) { ss += shx(ss, 16); ss += shx(ss, 32); sc = 1.0f / sqrtf(ss + EPS); if (seg == 0) sc *= 0.08838834764831845f; }
#pragma unroll
        for (int ks = 0; ks < 4; ++ks) { union { bf16x8 v; u32x4 w; } f;
            f.w.x = pk2(y[ks][0] * sc, y[ks][1] * sc); f.w.y = pk2(y[ks][2] * sc, y[ks][3] * sc); f.w.z = pk2(y[ks][4] * sc, y[ks][5] * sc); f.w.w = pk2(y[ks][6] * sc, y[ks][7] * sc);
            F[ks] = f.v;
            if (dir == 0) *(u32x4*)(DN + r * 1536 + seg * 512 + h * 128 + 32 * ks + 8 * g) = f.w; }
    };
#pragma unroll 1
    for (int mt = 0; mt < 4; ++mt) { bf16x8 F[4]; conv_frag(1, mt, F);
#pragma unroll
        for (int ks = 0; ks < 4; ++ks) *(bf16x8*)(Kc + (16 * mt + i16) * KCP + 32 * ks + 8 * g) = F[ks]; }
    if (dir == 0) {
#pragma unroll 1
        for (int mt = 0; mt < 4; ++mt) { bf16x8 F[4]; conv_frag(2, mt, F); } }
    asm volatile("s_waitcnt lgkmcnt(0)" ::: "memory");
#pragma unroll 1
    for (int mt = 0; mt < 4; ++mt) {
        bf16x8 A[4];
#pragma unroll
        for (int ks = 0; ks < 4; ++ks) A[ks] = *(const bf16x8*)(Kc + (16 * mt + i16) * KCP + 32 * ks + 8 * g);
#pragma unroll 1
        for (int nt = 0; nt <= mt; ++nt) { f32x4 acc = (f32x4){0.f, 0.f, 0.f, 0.f};
#pragma unroll
            for (int ks = 0; ks < 4; ++ks) acc = __builtin_amdgcn_mfma_f32_16x16x32_bf16(A[ks], *(const bf16x8*)(Kc + (16 * nt + i16) * KCP + 32 * ks + 8 * g), acc, 0, 0, 0);
            const int j = 16 * nt + i16; const float gj = gcs[j];
#pragma unroll
            for (int rg = 0; rg < 4; ++rg) { const int i = 16 * mt + 4 * g + rg; Ls[i * 64 + j] = i > j ? bes[i] * acc[rg] * __expf(gcs[i] - gj) : 0.f; } }
    }
    bf16_t* QKg = (bf16_t*)(p.ws + WS_TQ + (size_t)item * 16384 + 8192);
#pragma unroll 1
    for (int mt = 0; mt < 4; ++mt) { bf16x8 Qf[4]; conv_frag(0, mt, Qf);
#pragma unroll 1
        for (int nt = 0; nt < 4; ++nt) { f32x4 acc = (f32x4){0.f, 0.f, 0.f, 0.f}; const int j = 16 * nt + i16;
            if (nt <= mt) {
#pragma unroll
                for (int ks = 0; ks < 4; ++ks) acc = __builtin_amdgcn_mfma_f32_16x16x32_bf16(Qf[ks], *(const bf16x8*)(Kc + (16 * nt + i16) * KCP + 32 * ks + 8 * g), acc, 0, 0, 0);
                const float gj = gcs[j];
#pragma unroll
                for (int rg = 0; rg < 4; ++rg) { const int i = 16 * mt + 4 * g + rg; acc[rg] = i >= j ? acc[rg] * __expf(gcs[i] - gj) : 0.f; } }
#pragma unroll
            for (int rg = 0; rg < 4; ++rg) QKg[(16 * mt + 4 * g + rg) * 64 + j] = (bf16_t)f2bf(acc[rg]); } }
    asm volatile("s_waitcnt lgkmcnt(0)" ::: "memory");
#pragma unroll 1
    for (int i = 0; i < 64; ++i) { float s0 = (i == lane) ? 1.f : 0.f, s1 = 0.f;
        int j = 0;
#pragma unroll 4
        for (; j + 1 < i; j += 2) { s0 -= Ls[i * 64 + j] * Tl[j * 64 + lane]; s1 -= Ls[i * 64 + j + 1] * Tl[(j + 1) * 64 + lane]; }
        if (j < i) s0 -= Ls[i * 64 + j] * Tl[j * 64 + lane];
        Tl[i * 64 + lane] = s0 + s1; }
    asm volatile("s_waitcnt lgkmcnt(0)" ::: "memory");
    bf16_t* Tg = (bf16_t*)(p.ws + WS_TQ + (size_t)item * 16384);
    for (int i = 0; i < 64; ++i) Tg[i * 64 + lane] = (bf16_t)f2bf(Tl[i * 64 + lane]);
    asm volatile("s_waitcnt lgkmcnt(0)" ::: "memory");
}

__device__ __forceinline__ void dn_chain_mfma(const P& p, int item, unsigned char* lds) {
    const int b = item >> 3, h = (item >> 1) & 3, dir = item & 1, tid = otid(), lane = tid & 63, w = tid >> 6, i16 = lane & 15, g = lane >> 4;
    constexpr int KP = 136, TP = 72;
    bf16_t* Ks = (bf16_t*)lds; bf16_t* Qs = Ks + 64 * KP; bf16_t* Vs = Qs + 64 * KP; bf16_t* Ts = Vs + 64 * KP; bf16_t* QKs = Ts + 64 * TP; float* vec = (float*)(QKs + 64 * TP);
    const bf16_t* DN = (const bf16_t*)(p.ws + WS_DNQKV); bf16_t* OA = (bf16_t*)(p.ws + WS_H) + (size_t)dir * T * 512;
    f32x4 S[8];
#pragma unroll
    for (int dt = 0; dt < 8; ++dt) S[dt] = (f32x4){0.f, 0.f, 0.f, 0.f};
    u32x4 pf[9];
    auto prefetch = [&](int n) {
        const int pitem = item * DN_NCH + n;
#pragma unroll
        for (int u = 0; u < 6; ++u) { const int q = tid + 512 * u, which = q >> 10, rem = q & 1023, s = rem >> 4, ch = rem & 15;
            pf[u] = *(const u32x4*)(DN + (size_t)dn_row(n, s, b, dir) * 1536 + (which == 0 ? 512 : which == 1 ? 0 : 1024) + h * 128 + ch * 8); }
#pragma unroll
        for (int u = 0; u < 2; ++u) pf[6 + u] = *(const u32x4*)(p.ws + WS_TQ + (size_t)pitem * 16384 + (size_t)u * 8192 + (size_t)tid * 16);
        if (tid < 64) pf[8] = *(const u32x4*)((const float*)(p.ws + WS_VEC) + (size_t)pitem * 256 + tid * 4);
    };
    prefetch(0);
    for (int n = 0; n < DN_NCH; ++n) {
        __syncthreads();
#pragma unroll
        for (int u = 0; u < 6; ++u) { const int q = tid + 512 * u, which = q >> 10, rem = q & 1023, s = rem >> 4, ch = rem & 15;
            *(u32x4*)((which == 0 ? Ks : which == 1 ? Qs : Vs) + s * KP + ch * 8) = pf[u]; }
#pragma unroll
        for (int u = 0; u < 2; ++u) *(u32x4*)((u == 0 ? Ts : QKs) + (tid >> 3) * TP + (tid & 7) * 8) = pf[6 + u];
        if (tid < 64) *(u32x4*)(vec + tid * 4) = pf[8];
        __syncthreads();
        if (n + 1 < DN_NCH) prefetch(n + 1);
        const float* egv = vec; const float* eklv = vec + 64; const float* bev = vec + 128; const float glast = vec[192];
        bf16x8 Sb[4];
#pragma unroll
        for (int ks = 0; ks < 4; ++ks) Sb[ks] = pack8(S[2 * ks], S[2 * ks + 1]);
        f32x4 r_[4], o_[4];
#pragma unroll
        for (int mt = 0; mt < 4; ++mt) { r_[mt] = (f32x4){0.f, 0.f, 0.f, 0.f}; o_[mt] = (f32x4){0.f, 0.f, 0.f, 0.f};
            const bf16_t* kr = Ks + (16 * mt + i16) * KP + 4 * g; const bf16_t* qr = Qs + (16 * mt + i16) * KP + 4 * g;
#pragma unroll
            for (int ks = 0; ks < 4; ++ks) { const bf16x8 ak = cat8(*(const s16x4*)(kr + 32 * ks), *(const s16x4*)(kr + 32 * ks + 16)), aq = cat8(*(const s16x4*)(qr + 32 * ks), *(const s16x4*)(qr + 32 * ks + 16));
                r_[mt] = __builtin_amdgcn_mfma_f32_16x16x32_bf16(ak, Sb[ks], r_[mt], 0, 0, 0); o_[mt] = __builtin_amdgcn_mfma_f32_16x16x32_bf16(aq, Sb[ks], o_[mt], 0, 0, 0); } }
        f32x4 eg[4];
#pragma unroll
        for (int mt = 0; mt < 4; ++mt) { eg[mt] = *(const f32x4*)(egv + 16 * mt + 4 * g); const f32x4 be = *(const f32x4*)(bev + 16 * mt + 4 * g);
#pragma unroll
            for (int rg = 0; rg < 4; ++rg) { const float v = bf2f(Vs[(16 * mt + 4 * g + rg) * KP + 16 * w + i16]); r_[mt][rg] = be[rg] * (v - eg[mt][rg] * r_[mt][rg]); o_[mt][rg] *= eg[mt][rg]; } }
        bf16x8 Rb[2];
#pragma unroll
        for (int k2 = 0; k2 < 2; ++k2) Rb[k2] = pack8(r_[2 * k2], r_[2 * k2 + 1]);
        f32x4 vn[4];
#pragma unroll
        for (int mt = 0; mt < 4; ++mt) { vn[mt] = (f32x4){0.f, 0.f, 0.f, 0.f}; const bf16_t* tr = Ts + (16 * mt + i16) * TP + 4 * g;
#pragma unroll
            for (int k2 = 0; k2 < 2; ++k2) vn[mt] = __builtin_amdgcn_mfma_f32_16x16x32_bf16(cat8(*(const s16x4*)(tr + 32 * k2), *(const s16x4*)(tr + 32 * k2 + 16)), Rb[k2], vn[mt], 0, 0, 0); }
        bf16x8 Vb[2], Wb[2];
#pragma unroll
        for (int k2 = 0; k2 < 2; ++k2) { Vb[k2] = pack8(vn[2 * k2], vn[2 * k2 + 1]);
            const f32x4 e0 = *(const f32x4*)(eklv + 32 * k2 + 4 * g), e1 = *(const f32x4*)(eklv + 32 * k2 + 16 + 4 * g); Wb[k2] = pack8(vn[2 * k2] * e0, vn[2 * k2 + 1] * e1); }
#pragma unroll
        for (int mt = 0; mt < 4; ++mt) { const bf16_t* qkr = QKs + (16 * mt + i16) * TP + 4 * g;
#pragma unroll
            for (int k2 = 0; k2 < 2; ++k2) o_[mt] = __builtin_amdgcn_mfma_f32_16x16x32_bf16(cat8(*(const s16x4*)(qkr + 32 * k2), *(const s16x4*)(qkr + 32 * k2 + 16)), Vb[k2], o_[mt], 0, 0, 0); }
#pragma unroll
        for (int dt = 0; dt < 8; ++dt) { S[dt] = S[dt] * glast;
#pragma unroll
            for (int k2 = 0; k2 < 2; ++k2) { const bf16_t* a0 = Ks + (32 * k2 + 4 * g + (i16 >> 2)) * KP + 16 * dt + 4 * (i16 & 3);
                S[dt] = __builtin_amdgcn_mfma_f32_16x16x32_bf16(cat8(lds_tr(a0), lds_tr(a0 + 16 * KP)), Wb[k2], S[dt], 0, 0, 0); } }
#pragma unroll
        for (int mt = 0; mt < 4; ++mt)
#pragma unroll
            for (int rg = 0; rg < 4; ++rg) OA[(size_t)dn_row(n, 16 * mt + 4 * g + rg, b, dir) * 512 + h * 128 + 16 * w + i16] = (bf16_t)f2bf(o_[mt][rg]);
    }
}

__device__ __forceinline__ void phase_prep(const P& p, int l, unsigned char* lds, int gw, int NGW, int lane) {
    unsigned char* ws = p.ws;
    bf16_t* PC = (bf16_t*)(ws + WS_PC); unsigned* ctl = (unsigned*)(ws + WS_CTL);
    const int wv = gw % NWAVES, blk = gw / NWAVES, G_ = NGW / NWAVES;
    if (wv < 4) { for (int rep = 0; rep < REP_DNPREP; ++rep) for (int it = blk * 4 + wv; it < DN_ITEMS; it += G_ * 4) dn_prep_item(p, l, it, lds + wv * PREP_WLDS, lane); return; }
    const int gt = (blk * 4 + (wv - 4)) * 64 + lane, NGT = G_ * 4 * 64;
    float kmx = 0.f; int kbb = -1, kh = 0, km = 0;
    for (long i = gt; i < (long)T * 512; i += NGT) {
        const int r = (int)(i >> 9), q = (int)(i & 511), seg = q >> 8, h = (q >> 6) & 3, m = (q >> 5) & 1, pi = q & 31;
        const int half = pi >> 4, fi = pi & 15, d1 = half * 32 + fi, d2 = d1 + 16;
        bf16_t* base = PC + (size_t)r * 1536 + seg * 512 + h * 128 + m * 64;
        float x1 = bf2f(base[d1]), x2 = bf2f(base[d2]);
        const bool lat = r < TL; const int b = lat ? r / SEQ : (r - TL) / CTXL;
        if (lat) { const int t = r % SEQ; const float pos = half ? (float)(t & 63) : (float)(t >> 6);
            const float ang = pos * exp2f(-(float)fi * 0.8304820237218406f);
            float sn, cs; sincosf(ang, &sn, &cs);
            const float o1 = x1 * cs - x2 * sn, o2 = x2 * cs + x1 * sn; x1 = o1; x2 = o2; }
        if (seg == 0) { x1 *= 0.125f; x2 *= 0.125f; }
        const bf16_t r1 = (bf16_t)f2bf(x1), r2 = (bf16_t)f2bf(x2);
        if (lat || seg == 0) { base[d1] = r1; base[d2] = r2; }
        float ss = bf2f(r1) * bf2f(r1) + bf2f(r2) * bf2f(r2);
#pragma unroll
        for (int o = 1; o < 32; o <<= 1) ss += shx(ss, o);
        if (seg == 1) {
            if (b != kbb) { if (kbb >= 0 && (lane & 31) == 0) atomicMax(ctl + CW_KMAX + l * 64 + (kbb * 4 + kh) * 2 + km, __builtin_bit_cast(unsigned, sqrtf(kmx))); kbb = b; kmx = 0.f; }
            kh = h; km = m; kmx = fmaxf(kmx, ss); }
    }
    if (kbb >= 0 && (lane & 31) == 0) atomicMax(ctl + CW_KMAX + l * 64 + (kbb * 4 + kh) * 2 + km, __builtin_bit_cast(unsigned, sqrtf(kmx)));
    if (blk == 0 && wv == 4) { float a = 0.f, bq = 0.f; const float* lc = p.lam_c + (size_t)l * 256;
        a = wave_sum(lc[lane] * lc[64 + lane]); bq = wave_sum(lc[128 + lane] * lc[192 + lane]);
        const float lam_init = 0.8f - 0.6f * expf(-0.3f * (float)l);
        if (lane == 0) ((float*)(ws + WS_MISC))[MI_LAMF + l] = expf(a) - expf(bq) + lam_init; }
}

__device__ __forceinline__ void dn_chain(const P& p, int item, unsigned char* lds) {
    const int b = item >> 3, h = (item >> 1) & 3, dir = item & 1, tid = otid(), c = tid >> 2, ks = tid & 3;
    const bf16_t* DN = (const bf16_t*)(p.ws + WS_DNQKV); const float* GB = (const float*)(p.ws + WS_GB);
    bf16_t* OA = (bf16_t*)(p.ws + WS_H) + (size_t)dir * T * 512;
    constexpr int TB = 32;
    float* qs = (float*)lds; float* ksm = qs + TB * 128; float* vs = ksm + TB * 128; float* gs = vs + TB * 128; float* bs = gs + TB; float* ob = bs + TB;
    float S[32];
#pragma unroll
    for (int i = 0; i < 32; ++i) S[i] = 0.f;
    for (int part = 0; part < 2; ++part) {
        const int L = part == 0 ? CTXL : SEQ; const int rbase = part == 0 ? TL + b * CTXL : b * SEQ;
        for (int t0 = 0; t0 < L; t0 += TB) {
            __syncthreads();
            for (int i = tid; i < 3 * TB * 16; i += NTHREADS) { const int which = i / (TB * 16), rem = i % (TB * 16), tt = rem >> 4, ch = rem & 15;
                const int s = t0 + tt, t = dir ? L - 1 - s : s;
                const u32x4 w = *(const u32x4*)(DN + (size_t)(rbase + t) * 1536 + which * 512 + h * 128 + ch * 8);
                float* dst = (which == 0 ? qs : which == 1 ? ksm : vs) + tt * 128 + ch * 8;
                dst[0] = bflo(w.x); dst[1] = bfhi(w.x); dst[2] = bflo(w.y); dst[3] = bfhi(w.y); dst[4] = bflo(w.z); dst[5] = bfhi(w.z); dst[6] = bflo(w.w); dst[7] = bfhi(w.w); }
            if (tid < TB) { const int s = t0 + tid, t = dir ? L - 1 - s : s; gs[tid] = expf(GB[(size_t)(rbase + t) * 16 + dir * 4 + h]); bs[tid] = GB[(size_t)(rbase + t) * 16 + 8 + dir * 4 + h]; }
            __syncthreads();
            for (int tt = 0; tt < TB; ++tt) {
                const float eg = gs[tt], be = bs[tt];
                const float* kr = ksm + tt * 128 + ks * 32; const float* qr = qs + tt * 128 + ks * 32;
                float r = 0.f;
#pragma unroll
                for (int i = 0; i < 32; ++i) r += kr[i] * S[i];
                r += shx(r, 1); r += shx(r, 2);
                const float vn = be * (vs[tt * 128 + c] - eg * r);
                float o = 0.f;
#pragma unroll
                for (int i = 0; i < 32; ++i) { S[i] = eg * S[i] + kr[i] * vn; o += qr[i] * S[i]; }
                o += shx(o, 1); o += shx(o, 2);
                if (ks == 0) ob[tt * 128 + c] = o;
            }
            __syncthreads();
            for (int i = tid; i < TB * 64; i += NTHREADS) { const int tt = i >> 6, cp = i & 63; const int s = t0 + tt, t = dir ? L - 1 - s : s;
                *(unsigned*)(OA + (size_t)(rbase + t) * 512 + h * 128 + 2 * cp) = pk2(ob[tt * 128 + 2 * cp], ob[tt * 128 + 2 * cp + 1]); }
        }
    }
}
__device__ __forceinline__ void gla_chain_mfma(const P& p, int l, int item, unsigned char* lds) {
    const int b = item >> 3, h = (item >> 1) & 3, dir = item & 1, tid = otid(), lane = tid & 63, w = tid >> 6, i16 = lane & 15, g = lane >> 4;
    constexpr int RP = 72, VP = 72, OP = 136;
    bf16_t* qraw = (bf16_t*)lds;
    bf16_t* kraw = qraw + 64 * RP;
    bf16_t* Qt = kraw + 64 * RP;
    bf16_t* Kt = Qt + 64 * RP;
    bf16_t* KgT = Kt + 64 * RP;
    bf16_t* As = KgT + 64 * RP;
    bf16_t* Vt = As + 64 * RP;
    bf16_t* Os = Vt + 128 * VP;
    float* glr = (float*)(Os + 64 * OP);
    float* gts = glr + 64 * 16;
    float* gls = gts + 8 * 64;
    const bf16_t* PB = (const bf16_t*)(p.ws + WS_PB); const float* SMALL = (const float*)(p.ws + WS_SMALL);
    bf16_t* OB = (bf16_t*)(p.ws + WS_PAQ) + (size_t)dir * T * 512;
    float wgc[16];
#pragma unroll
    for (int j = 0; j < 16; ++j) wgc[j] = p.w_gate2[((size_t)l * 2 + dir) * 16 * 256 + j * 256 + h * 64 + lane];
    const float bgc = p.b_gate[((size_t)l * 2 + dir) * 256 + h * 64 + lane];
    f32x4 S[4];
#pragma unroll
    for (int dt = 0; dt < 4; ++dt) S[dt] = (f32x4){0.f, 0.f, 0.f, 0.f};
    __syncthreads();
    for (int i = tid; i < 64 * RP / 2; i += NTHREADS) ((unsigned*)As)[i] = 0u;
    u32x4 pf[5];
    auto prefetch = [&](int n) {
        { const int s = tid >> 3, ch = tid & 7; const size_t row = (size_t)dn_row(n, s, b, dir);
          pf[0] = *(const u32x4*)(PB + row * 1536 + h * 64 + ch * 8); pf[1] = *(const u32x4*)(PB + row * 1536 + 256 + h * 64 + ch * 8); }
#pragma unroll
        for (int u = 0; u < 2; ++u) { const int q = tid + 512 * u, s = q >> 4, ch = q & 15; pf[2 + u] = *(const u32x4*)(PB + (size_t)dn_row(n, s, b, dir) * 1536 + 512 + h * 128 + ch * 8); }
        if (tid < 256) { const int s = tid >> 2, ch = tid & 3; pf[4] = *(const u32x4*)(SMALL + (size_t)dn_row(n, s, b, dir) * 64 + 16 + dir * 16 + ch * 4); }
    };
    prefetch(0);
    for (int n = 0; n < DN_NCH; ++n) {
        __syncthreads();
        { const int s = tid >> 3, ch = tid & 7; *(u32x4*)(qraw + s * RP + ch * 8) = pf[0]; *(u32x4*)(kraw + s * RP + ch * 8) = pf[1]; }
#pragma unroll
        for (int u = 0; u < 2; ++u) { const int q = tid + 512 * u, s = q >> 4, ch = q & 15; const u32x4 v = pf[2 + u]; bf16_t* d = Vt + (ch * 8) * VP + s;
            d[0] = (bf16_t)v.x; d[VP] = (bf16_t)(v.x >> 16); d[2 * VP] = (bf16_t)v.y; d[3 * VP] = (bf16_t)(v.y >> 16); d[4 * VP] = (bf16_t)v.z; d[5 * VP] = (bf16_t)(v.z >> 16); d[6 * VP] = (bf16_t)v.w; d[7 * VP] = (bf16_t)(v.w >> 16); }
        if (tid < 256) *(u32x4*)(glr + tid * 4) = pf[4];
        __syncthreads();
        if (n + 1 < DN_NCH) prefetch(n + 1);
        float gcl[8];
        { float run = 0.f;
#pragma unroll
          for (int u = 0; u < 8; ++u) { const float* gr = glr + (8 * w + u) * 16; float z = bgc;
#pragma unroll
              for (int j = 0; j < 16; ++j) z += gr[j] * wgc[j];
              run += logsigmoidf_(z) * 0.0625f; gcl[u] = run; }
          gts[w * 64 + lane] = run; }
        __syncthreads();
        { float pre = 0.f, tot = 0.f;
#pragma unroll
          for (int q = 0; q < 8; ++q) { const float t_ = gts[q * 64 + lane]; tot += t_; if (q < w) pre += t_; }
          unsigned kgp[4];
#pragma unroll
          for (int u = 0; u < 8; ++u) { const float gc = pre + gcl[u]; const float qv = bf2f(qraw[(8 * w + u) * RP + lane]), kv = bf2f(kraw[(8 * w + u) * RP + lane]);
              Qt[(8 * w + u) * RP + lane] = (bf16_t)f2bf(0.125f * qv * __expf(gc)); Kt[(8 * w + u) * RP + lane] = (bf16_t)f2bf(kv * __expf(-gc));
              const unsigned kgb = f2bf(kv * __expf(tot - gc)); if (u & 1) kgp[u >> 1] |= kgb << 16; else kgp[u >> 1] = kgb; }
          *(u32x4*)(KgT + lane * RP + 8 * w) = (u32x4){kgp[0], kgp[1], kgp[2], kgp[3]};
          if (w == 0) gls[lane] = __expf(tot); }
        __syncthreads();
#pragma unroll
        for (int rep = 0; rep < 2; ++rep) { const int tix = w + 8 * rep;
            if (tix < 10) { const int mt = tix < 1 ? 0 : tix < 3 ? 1 : tix < 6 ? 2 : 3, nt = tix - (mt * (mt + 1)) / 2;
                f32x4 acc = (f32x4){0.f, 0.f, 0.f, 0.f};
#pragma unroll
                for (int ks = 0; ks < 2; ++ks) acc = __builtin_amdgcn_mfma_f32_16x16x32_bf16(*(const bf16x8*)(Qt + (16 * mt + i16) * RP + 32 * ks + 8 * g), *(const bf16x8*)(Kt + (16 * nt + i16) * RP + 32 * ks + 8 * g), acc, 0, 0, 0);
                const int j = 16 * nt + i16;
#pragma unroll
                for (int rg = 0; rg < 4; ++rg) { const int i = 16 * mt + 4 * g + rg; As[i * RP + j] = (bf16_t)f2bf(i >= j ? acc[rg] : 0.f); } } }
        __syncthreads();
        { bf16x8 Sb[2];
#pragma unroll
          for (int ks = 0; ks < 2; ++ks) Sb[ks] = pack8(S[2 * ks], S[2 * ks + 1]);
          bf16x8 Vb[2];
#pragma unroll
          for (int ks = 0; ks < 2; ++ks) Vb[ks] = *(const bf16x8*)(Vt + (16 * w + i16) * VP + 32 * ks + 8 * g);
#pragma unroll
          for (int mt = 0; mt < 4; ++mt) { f32x4 o = (f32x4){0.f, 0.f, 0.f, 0.f}; const bf16_t* qr = Qt + (16 * mt + i16) * RP + 4 * g; const bf16_t* ar = As + (16 * mt + i16) * RP + 8 * g;
#pragma unroll
              for (int ks = 0; ks < 2; ++ks) { o = __builtin_amdgcn_mfma_f32_16x16x32_bf16(cat8(*(const s16x4*)(qr + 32 * ks), *(const s16x4*)(qr + 32 * ks + 16)), Sb[ks], o, 0, 0, 0);
                  o = __builtin_amdgcn_mfma_f32_16x16x32_bf16(*(const bf16x8*)(ar + 32 * ks), Vb[ks], o, 0, 0, 0); }
#pragma unroll
              for (int rg = 0; rg < 4; ++rg) Os[(16 * mt + 4 * g + rg) * OP + 16 * w + i16] = (bf16_t)f2bf(o[rg]); }
#pragma unroll
          for (int dt = 0; dt < 4; ++dt) { const f32x4 gl = *(const f32x4*)(gls + 16 * dt + 4 * g); S[dt] = S[dt] * gl;
#pragma unroll
              for (int ks = 0; ks < 2; ++ks) S[dt] = __builtin_amdgcn_mfma_f32_16x16x32_bf16(*(const bf16x8*)(KgT + (16 * dt + i16) * RP + 32 * ks + 8 * g), Vb[ks], S[dt], 0, 0, 0); } }
        __syncthreads();
#pragma unroll
        for (int u = 0; u < 2; ++u) { const int q = tid + 512 * u, s = q >> 4, ch = q & 15;
            *(u32x4*)(OB + (size_t)dn_row(n, s, b, dir) * 512 + h * 128 + ch * 8) = *(const u32x4*)(Os + s * OP + ch * 8); }
    }
}
__device__ __forceinline__ void attn_tile(const P& p, int l, int b, int h, int qrow0  , bool ctxq, unsigned char* lds, bool do_store = true) {
    constexpr int QP = 72, KP = 72, VP = 72;
    bf16_t* Qs = (bf16_t*)lds;
    bf16_t* Ks = Qs + 2 * 128 * QP;
    bf16_t* Vt = Ks + 2 * 64 * KP;
    float* Oex = (float*)lds;
    bf16_t* PC = (bf16_t*)(p.ws + WS_PC);
    const int tid = otid(), lane = tid & 63, w = tid >> 6, m = w & 1, rg = w >> 1, q31 = lane & 31, hi = lane >> 5;
    __syncthreads();
    for (int i = tid; i < 128 * 16; i += NTHREADS) { const int r = i >> 4, ch = i & 15, mm = ch >> 3, c8 = (ch & 7) * 8;
        *(u32x4*)(Qs + (mm * 128 + r) * QP + c8) = *(const u32x4*)(PC + (size_t)(qrow0 + r) * 1536 + h * 128 + ch * 8); }
    __syncthreads();
    const bf16_t* qrow = Qs + (m * 128 + rg * 32 + q31) * QP;
    bf16x8 bq[4]; float qn = 0.f;
#pragma unroll
    for (int kk = 0; kk < 4; ++kk) bq[kk] = *(const bf16x8*)(qrow + 16 * kk + 8 * hi);
#pragma unroll
    for (int d8 = 0; d8 < 8; ++d8) { const u32x4 q4 = *(const u32x4*)(qrow + 8 * d8);
        qn += bflo(q4.x) * bflo(q4.x) + bfhi(q4.x) * bfhi(q4.x) + bflo(q4.y) * bflo(q4.y) + bfhi(q4.y) * bfhi(q4.y) + bflo(q4.z) * bflo(q4.z) + bfhi(q4.z) * bfhi(q4.z) + bflo(q4.w) * bflo(q4.w) + bfhi(q4.w) * bfhi(q4.w); }
    const float kmax = __builtin_bit_cast(float, ((const unsigned*)(p.ws + WS_CTL))[CW_KMAX + l * 64 + (b * 4 + h) * 2 + m]);
    const float mrow = sqrtf(qn) * kmax * 1.002f + 1e-3f;
    f32x16 o[4]; float lsum = 0.f;
#pragma unroll
    for (int dt = 0; dt < 4; ++dt)
#pragma unroll
        for (int r = 0; r < 16; ++r) o[dt][r] = 0.f;
    const int nkt = ctxq ? CTXL / 64 : (CTXL + SEQ) / 64;
    for (int kt = 0; kt < nkt; ++kt) {
        const int krow0 = kt < CTXL / 64 ? TL + b * CTXL + kt * 64 : b * SEQ + (kt - CTXL / 64) * 64;
        __syncthreads();
        for (int i = tid; i < 64 * 16; i += NTHREADS) { const int r = i >> 4, ch = i & 15, mm = ch >> 3, c8 = (ch & 7) * 8;
            *(u32x4*)(Ks + (mm * 64 + r) * KP + c8) = *(const u32x4*)(PC + (size_t)(krow0 + r) * 1536 + 512 + h * 128 + ch * 8); }
        for (int i = tid; i < 64 * 16; i += NTHREADS) { const int r = i >> 4, ch = i & 15;
            const u32x4 v = *(const u32x4*)(PC + (size_t)(krow0 + r) * 1536 + 1024 + h * 128 + ch * 8); bf16_t* d = Vt + (ch * 8) * VP + r;
            d[0] = (bf16_t)v.x; d[VP] = (bf16_t)(v.x >> 16); d[2 * VP] = (bf16_t)v.y; d[3 * VP] = (bf16_t)(v.y >> 16); d[4 * VP] = (bf16_t)v.z; d[5 * VP] = (bf16_t)(v.z >> 16); d[6 * VP] = (bf16_t)v.w; d[7 * VP] = (bf16_t)(v.w >> 16); }
        __syncthreads();
        f32x16 s[2];
#pragma unroll
        for (int kh = 0; kh < 2; ++kh) {
#pragma unroll
            for (int r = 0; r < 16; ++r) s[kh][r] = 0.f;
#pragma unroll
            for (int kk = 0; kk < 4; ++kk) { const bf16x8 a = *(const bf16x8*)(Ks + (m * 64 + kh * 32 + q31) * KP + 16 * kk + 8 * hi);
                s[kh] = __builtin_amdgcn_mfma_f32_32x32x16_bf16(a, bq[kk], s[kh], 0, 0, 0); }
#pragma unroll
            for (int r = 0; r < 16; ++r) { const float e = __expf(s[kh][r] - mrow); s[kh][r] = e; lsum += e; }
        }
#pragma unroll
        for (int st = 0; st < 4; ++st) {
            const int kh = st >> 1, r0 = 8 * (st & 1);
            union { bf16x8 v; unsigned u[4]; } bp;
            bp.u[0] = pk2(s[kh][r0 + 0], s[kh][r0 + 1]); bp.u[1] = pk2(s[kh][r0 + 2], s[kh][r0 + 3]); bp.u[2] = pk2(s[kh][r0 + 4], s[kh][r0 + 5]); bp.u[3] = pk2(s[kh][r0 + 6], s[kh][r0 + 7]);
#pragma unroll
            for (int dt = 0; dt < 4; ++dt) { const bf16_t* vr = Vt + (dt * 32 + q31) * VP + 16 * st + 4 * hi;
                union { bf16x8 v; s16x4 h2[2]; } av; av.h2[0] = *(const s16x4*)vr; av.h2[1] = *(const s16x4*)(vr + 8);
                o[dt] = __builtin_amdgcn_mfma_f32_32x32x16_bf16(av.v, bp.v, o[dt], 0, 0, 0); }
        }
    }
    lsum += shx(lsum, 32);
    const float lamf = ((const float*)(p.ws + WS_MISC))[MI_LAMF + l];
    const float sc = (m == 0 ? 1.0f : lamf) / lsum;
    __syncthreads();
    float* ox = Oex + (rg * 32 + q31) * 132;
    if (m == 1) {
#pragma unroll
        for (int dt = 0; dt < 4; ++dt)
#pragma unroll
            for (int r = 0; r < 16; ++r) ox[dt * 32 + (r & 3) + 8 * (r >> 2) + 4 * hi] = o[dt][r] * sc;
    }
    __syncthreads();
    if (m == 0) {
        float ss = 0.f;
#pragma unroll
        for (int dt = 0; dt < 4; ++dt)
#pragma unroll
            for (int r = 0; r < 16; ++r) { const float v = o[dt][r] * sc - ox[dt * 32 + (r & 3) + 8 * (r >> 2) + 4 * hi]; o[dt][r] = v; ss += v * v; }
        ss += shx(ss, 32);
        const float lam_init = 0.8f - 0.6f * expf(-0.3f * (float)l);
        const float rs = (1.0f - lam_init) / sqrtf(ss * (1.0f / 128.0f) + EPS);
        const float* gn = p.gn_c + l * 128;
        bf16_t* orow = PC + (size_t)(qrow0 + rg * 32 + q31) * 1536 + h * 128;
#pragma unroll
        for (int dt = 0; dt < 4; ++dt)
#pragma unroll
            for (int g4 = 0; g4 < 4; ++g4) { const int dv = dt * 32 + 8 * g4 + 4 * hi; const f32x4 gg = *(const f32x4*)(gn + dv);
                u32x2 wv; wv.x = pk2(o[dt][4 * g4 + 0] * rs * gg[0], o[dt][4 * g4 + 1] * rs * gg[1]); wv.y = pk2(o[dt][4 * g4 + 2] * rs * gg[2], o[dt][4 * g4 + 3] * rs * gg[3]);
                if (do_store) *(u32x2*)(orow + dv) = wv; }
    }
}
__device__ __forceinline__ void phase_mix(const P& p, int l, unsigned char* lds) {
    unsigned* qhead = (unsigned*)(p.ws + WS_CTL) + CW_QUEUE + 64 * l;
    volatile int* slot = (volatile int*)(lds + LDS_BYTES - 64);
    const int n_att_l = BATCH * 4 * (SEQ / 128), n_att_c = (l == 0) ? BATCH * 4 * (CTXL / 128) : 0;
    const int total = 128 + n_att_l + n_att_c;
    for (;;) {
        __syncthreads();
        if (otid() == 0) *slot = (int)atomicAdd(qhead, 1u);
        __syncthreads();
        const int it = *slot;
        if (it >= total) break;
        if (it < 64) { for (int rep = 0; rep < REP_CHAIN; ++rep) dn_chain_mfma(p, it, lds); }
        else if (it < 128) { for (int rep = 0; rep < REP_CHAIN; ++rep) gla_chain_mfma(p, l, it - 64, lds); }
        else if (it < 128 + n_att_l) { const int a = it - 128, b = a / (4 * (SEQ / 128)), rem = a % (4 * (SEQ / 128)), h = rem / (SEQ / 128), qt = rem % (SEQ / 128);
            for (int rep = 1; rep < REP_ATT; ++rep) attn_tile(p, l, b, h, b * SEQ + qt * 128, false, lds, false);
            attn_tile(p, l, b, h, b * SEQ + qt * 128, false, lds); }
        else { const int a = it - 128 - n_att_l, b = a / (4 * (CTXL / 128)), rem = a % (4 * (CTXL / 128)), h = rem / (CTXL / 128), qt = rem % (CTXL / 128);
            attn_tile(p, l, b, h, TL + b * CTXL + qt * 128, true, lds); }
    }
}

__device__ __forceinline__ void phase_post(const P& p, int l, int nrows, int gw, int NGW, int lane) {
    const bf16_t* PZ = (const bf16_t*)(p.ws + WS_PZ); const bf16_t* PB = (const bf16_t*)(p.ws + WS_PB);
#pragma unroll
    for (int br = 0; br < 2; ++br) {
        bf16_t* O = (bf16_t*)(p.ws + (br ? WS_PAQ : WS_H));
        const float* gnb = (br ? p.gn_b : p.gn_a) + l * 128 + 2 * lane;
        const float g0 = gnb[0], g1 = gnb[1];
        for (int it = gw; it < nrows * 4; it += NGW) {
            const int r = it >> 2, h = it & 3, col = h * 128 + 2 * lane;
            const unsigned a = *(const unsigned*)(O + (size_t)r * 512 + col), bq = *(const unsigned*)(O + ((size_t)T + r) * 512 + col);
            const unsigned zz = br ? *(const unsigned*)(PB + (size_t)r * 1536 + 1024 + col) : *(const unsigned*)(PZ + (size_t)r * 512 + col);
            const float o0 = bflo(a) + bflo(bq), o1 = bfhi(a) + bfhi(bq);
            const float rs = 1.0f / sqrtf(wave_sum(o0 * o0 + o1 * o1) * (1.0f / 128.0f) + EPS);
            *(unsigned*)(O + (size_t)r * 512 + col) = pk2(o0 * rs * g0 * siluf_(bflo(zz)), o1 * rs * g1 * siluf_(bfhi(zz)));
        }
    }
}

__device__ __forceinline__ void phase_moe_gather(const P& p, unsigned char* lds) {
    const int tid = otid();
    const int* route = (const int*)(p.ws + WS_ROUTE); int* slots = (int*)(p.ws + WS_SLOT); int* misc = (int*)(p.ws + WS_MISC);
    const unsigned* ecnt = (const unsigned*)(p.ws + WS_CTL) + CW_ECNT; unsigned* efill = (unsigned*)(p.ws + WS_CTL) + CW_EFILL;
    const bf16_t* H = (const bf16_t*)(p.ws + WS_H); bf16_t* MA = (bf16_t*)(p.ws + WS_MA);
    int* eoff = (int*)lds; unsigned* lcnt = (unsigned*)(eoff + 16); unsigned* lbase = lcnt + 8; int* myslot = (int*)(lbase + 8);
    if (tid == 0) { int off = 0, nt = 0;
#pragma unroll 1
        for (int e = 0; e < NE; ++e) { eoff[e] = off; const int tl = ((int)ecnt[e] + 255) / 256;
            if (blockIdx.x == 0) { for (int q = 0; q < tl; ++q) misc[MI_TILEE + nt + q] = e; }
            nt += tl; off += tl * 256; }
        eoff[NE] = off; if (blockIdx.x == 0) misc[MI_NTILES] = nt; }
    for (int grp = blockIdx.x; grp < TL / 64; grp += gridDim.x) {
        __syncthreads();
        if (tid < NE) lcnt[tid] = 0u;
        __syncthreads();
        int e = 0, rank = 0;
        if (tid < 128) { e = route[(grp * 64 + (tid >> 1)) * 4 + (tid & 1)]; rank = (int)atomicAdd(lcnt + e, 1u); }
        __syncthreads();
        if (tid < NE) lbase[tid] = lcnt[tid] ? atomicAdd(efill + tid, lcnt[tid]) : 0u;
        __syncthreads();
        if (tid < 128) { const int s = eoff[e] + (int)lbase[e] + rank; myslot[tid] = s; slots[(grp * 64 + (tid >> 1)) * 2 + (tid & 1)] = s; }
        __syncthreads();
        for (int i = tid; i < 128 * 128; i += NTHREADS) { const int a = i >> 7, ch = i & 127;
            ((u32x4*)(MA + (size_t)myslot[a] * D))[ch] = ((const u32x4*)(H + (size_t)(grp * 64 + (a >> 1)) * D))[ch]; }
    }
}
__device__ __forceinline__ void phase_final(const P& p, int gw, int NGW, int lane) {
    const int* route = (const int*)(p.ws + WS_ROUTE); const int* slots = (const int*)(p.ws + WS_SLOT); const bf16_t* Y = (const bf16_t*)(p.ws + WS_MA);
    const float* MOD = (const float*)(p.ws + WS_MOD) + (size_t)1 * 9 * 6144;
    for (int r = gw; r < TL; r += NGW) { const int b = r / SEQ; const float w1 = ((const float*)route)[r * 4 + 2], w2 = ((const float*)route)[r * 4 + 3];
        const bf16_t* y1 = Y + (size_t)slots[r * 2] * D, *y2 = Y + (size_t)slots[r * 2 + 1] * D; float* xr = p.out + (size_t)r * D; const float* g2 = MOD + (size_t)b * 6144 + 5 * 1024;
        f32x4 v[4]; float ss = 0.f;
#pragma unroll
        for (int j = 0; j < 4; ++j) { const int c = 4 * lane + 256 * j; const u32x2 a = *(const u32x2*)(y1 + c), bq = *(const u32x2*)(y2 + c); const f32x4 g = *(const f32x4*)(g2 + c);
            f32x4 y; y[0] = w1 * bflo(a.x) + w2 * bflo(bq.x); y[1] = w1 * bfhi(a.x) + w2 * bfhi(bq.x); y[2] = w1 * bflo(a.y) + w2 * bflo(bq.y); y[3] = w1 * bfhi(a.y) + w2 * bfhi(bq.y);
            v[j] = *(const f32x4*)(xr + c) + g * y; ss += (v[j][0] * v[j][0] + v[j][1] * v[j][1]) + (v[j][2] * v[j][2] + v[j][3] * v[j][3]); }
        const float rs = 1.0f / sqrtf(wave_sum(ss) * (1.0f / D) + EPS);
#pragma unroll
        for (int j = 0; j < 4; ++j) { const int c = 4 * lane + 256 * j; *(f32x4*)(xr + c) = v[j] * rs * *(const f32x4*)(p.final_g + c); }
    }
}

__device__ __forceinline__ void convert_up(const float* w1, const float* w3, int ne, bf16_t* up, float* scr, int gw, int NGW, int lane) {
    const int nblk = NUP / 32, items_e = (D / 64) * nblk;
    for (int it = gw; it < ne * items_e; it += NGW) {
        const int e = it / items_e, ie = it % items_e, kb = ie / nblk, nb = ie % nblk, k0 = 64 * kb, n0 = 32 * nb, n = n0 + (lane & 31), tile = n >> 8, rr = n & 255;
        const float* W = (rr < 128 ? w1 : w3) + (size_t)e * D * DFF; const int sc = tile * 128 + (rr & 127);
#pragma unroll 8
        for (int i = 0; i < 32; ++i) { const int kk = 2 * i + (lane >> 5); scr[kk * 33 + (lane & 31)] = W[(size_t)(k0 + kk) * DFF + sc]; }
        asm volatile("s_waitcnt lgkmcnt(0)" ::: "memory");
        const int c = lane & 7;
#pragma unroll
        for (int j = 0; j < 4; ++j) { const int nn = (lane >> 3) + 8 * j; const float* s = scr + (8 * c) * 33 + nn;
            u32x4 o; o.x = pk2(s[0 * 33], s[1 * 33]); o.y = pk2(s[2 * 33], s[3 * 33]); o.z = pk2(s[4 * 33], s[5 * 33]); o.w = pk2(s[6 * 33], s[7 * 33]);
            *(u32x4*)(up + ((size_t)e * NUP + n0 + nn) * D + k0 + 8 * c) = o; }
        asm volatile("s_waitcnt lgkmcnt(0)" ::: "memory");
    }
}
typedef __attribute__((address_space(4))) const P* KArgs;
#define LOADP(p) asm volatile("" : "+s"(kp)); P p; __builtin_memcpy(&p, kp, sizeof(P))
__global__ void __launch_bounds__(NTHREADS, 2) mk_fwd(P p_unused) {
    extern __shared__ __attribute__((aligned(16))) unsigned char lds[];
    cg::grid_group grid = cg::this_grid();
    KArgs kp = (KArgs)__builtin_amdgcn_kernarg_segment_ptr();
    const int G = gridDim.x, NGW = G * NWAVES;
#define IDS() const int tid = otid(), lane = tid & 63, wave = __builtin_amdgcn_readfirstlane(tid >> 6), gw = blockIdx.x * NWAVES + wave; (void)tid; (void)lane; (void)gw; (void)wave
    PG8_LAS unsigned char* glds = (PG8_LAS unsigned char*)lds;
    volatile unsigned* bst = (volatile unsigned*)(lds + LDS_BYTES - 128);
    if (otid() == 0) { bst[0] = 0u; bst[1] = 0u; }
    __syncthreads();
    { LOADP(p); (void)xcd_barrier_post((unsigned*)(p.ws + WS_CTL) + CW_BAR, bst); }
#define GSYNC() do { LOADP(pb_); XcdBarrier bb_; bb_.bar = (unsigned*)(pb_.ws + WS_CTL) + CW_BAR; bb_.x = xb_xcc_id(); bb_.st = bst; xcd_barrier(bb_); } while (0)

    {
        LOADP(p); IDS(); unsigned char* ws = p.ws;
        float* scr = (float*)(lds + 49152) + wave * (64 * 33);
        for (int rep = 0; rep < REP_P0; ++rep)
        for (int l = 0; l < DEPTH; ++l) {
            convert_T(p.w_in + (size_t)l * D * 8240, D, 8240, (bf16_t*)(ws + WB_WIN + l * WIN_BYTES), NIN, CmWin(), scr, (gw + 37 * l) % NGW, NGW, lane);
            convert_T(p.w_o_a + (size_t)l * 512 * D, 512, D, (bf16_t*)(ws + WB_WO + (l * 3 + 0) * WO_BYTES), D, CmIdent(), scr, (gw + 300 + 700 * l) % NGW, NGW, lane);
            convert_T(p.w_o_b + (size_t)l * 512 * D, 512, D, (bf16_t*)(ws + WB_WO + (l * 3 + 1) * WO_BYTES), D, CmIdent(), scr, (gw + 556 + 700 * l) % NGW, NGW, lane);
            convert_T(p.w_o_c + (size_t)l * 512 * D, 512, D, (bf16_t*)(ws + WB_WO + (l * 3 + 2) * WO_BYTES), D, CmIdent(), scr, (gw + 812 + 700 * l) % NGW, NGW, lane);
            convert_T(p.w_out + (size_t)l * D * D, D, D, (bf16_t*)(ws + WB_WOUT + l * WOUT_BYTES), D, CmIdent(), scr, (gw + 1068 + 512 * l) % NGW, NGW, lane);
        }
        convert_up(p.ffn_w1, p.ffn_w3, 1, (bf16_t*)(ws + WB_WUP), scr, (gw + 1500) % NGW, NGW, lane);
        convert_T(p.ffn_w2, DFF, D, (bf16_t*)(ws + WB_WDN), D, CmIdent(), scr, (gw + 900) % NGW, NGW, lane);
        __syncthreads();
        phase_mod(p, lds);
    }
    grid.sync();

    for (int l = 0; l < DEPTH; ++l) {
        const bool last = (l == DEPTH - 1);
        const int Mrows = last ? TL : T;
        for (int rep = 0; rep < REP_ELT; ++rep)
        { LOADP(p); IDS(); unsigned char* ws = p.ws;
          phase_modulate(l == 0 ? p.x : p.out, l == 0 ? p.ctx : (const float*)(ws + WS_XC), T, p.norm1_g + l * D, (const float*)(ws + WS_MOD) + (size_t)l * 9 * 6144, 0, (bf16_t*)(ws + WS_H), nullptr, nullptr, nullptr, nullptr, gw, NGW, lane); }
        GSYNC();
        for (int rep = 0; rep < REP_WIN; ++rep)
        { LOADP(p); unsigned char* ws = p.ws;
            pg8::Gemm g{(const bf16_t*)(ws + WS_H), (const bf16_t*)(ws + WB_WIN + l * WIN_BYTES), T, NIN, D, D}; pg8::StaticOrder S; S.init(T, NIN, G, (int)blockIdx.x);
            EpiWin E{(bf16_t*)(ws + WS_PAQ), (bf16_t*)(ws + WS_PZ), (bf16_t*)(ws + WS_PB), (bf16_t*)(ws + WS_PC), (bf16_t*)(ws + WS_PG), (float*)(ws + WS_SMALL)};
            pg8::gemm_phase<EpiWin, pg8::StaticOrder, true, true>(glds, g, S, E);
        }
        GSYNC();
        for (int rep = 1; rep < REP_SYNC; ++rep) GSYNC();
        { LOADP(p); IDS(); phase_prep(p, l, lds, gw, NGW, lane); }
        GSYNC();
        { LOADP(p); phase_mix(p, l, lds); }
        GSYNC();
        { LOADP(p); IDS(); phase_post(p, l, Mrows, gw, NGW, lane); }
        GSYNC();
        for (int br = 0; br < 3; ++br) {
            LOADP(p); unsigned char* ws = p.ws;
            const bf16_t* A = br == 0 ? (const bf16_t*)(ws + WS_H) : br == 1 ? (const bf16_t*)(ws + WS_PAQ) : (const bf16_t*)(ws + WS_PC);
            pg8::Gemm g{A, (const bf16_t*)(ws + WB_WO + (l * 3 + br) * WO_BYTES), Mrows, D, 512, br == 2 ? 1536 : 512}; pg8::StaticOrder S; S.init(Mrows, D, G, (int)blockIdx.x);
            EpiGate E{(bf16_t*)(ws + WS_DNQKV), (const bf16_t*)(ws + WS_PG), br};
            pg8::gemm_phase<EpiGate, pg8::StaticOrder, true, true>(glds, g, S, E);
            __syncthreads();
        }
        GSYNC();
        { LOADP(p); unsigned char* ws = p.ws;
            pg8::Gemm g{(const bf16_t*)(ws + WS_DNQKV), (const bf16_t*)(ws + WB_WOUT + l * WOUT_BYTES), Mrows, D, D, D}; pg8::StaticOrder S; S.init(Mrows, D, G, (int)blockIdx.x);
            EpiResid E{l == 0 ? p.x : p.out, l == 0 ? p.ctx : (const float*)(ws + WS_XC), p.out, (float*)(ws + WS_XC), (const float*)(ws + WS_MOD) + (size_t)l * 9 * 6144, 2};
            pg8::gemm_phase<EpiResid, pg8::StaticOrder, true, true>(glds, g, S, E);
        }
        GSYNC();
        { LOADP(p); IDS(); unsigned char* ws = p.ws;
          phase_modulate(p.out, (const float*)(ws + WS_XC), Mrows, p.norm2_g + l * D, (const float*)(ws + WS_MOD) + (size_t)l * 9 * 6144, 3, (bf16_t*)(ws + WS_H), last ? p.router_w : nullptr, (int*)(ws + WS_ROUTE), (unsigned*)(ws + WS_CTL) + CW_ECNT, (unsigned*)lds, gw, NGW, lane); }
        if (!last) {
            GSYNC();
            for (int rep = 0; rep < REP_UP; ++rep)
            { LOADP(p); unsigned char* ws = p.ws;
                pg8::Gemm g{(const bf16_t*)(ws + WS_H), (const bf16_t*)(ws + WB_WUP), T, NUP, D, D}; pg8::StaticOrder S; S.init(T, NUP, G, (int)blockIdx.x);
                EpiSwiglu E{(bf16_t*)(ws + WS_H1), NUP / 256};
                pg8::gemm_phase<EpiSwiglu, pg8::StaticOrder, true, true>(glds, g, S, E);
            }
            GSYNC();
            { LOADP(p); unsigned char* ws = p.ws;
                pg8::Gemm g{(const bf16_t*)(ws + WS_H1), (const bf16_t*)(ws + WB_WDN), T, D, DFF, DFF}; pg8::StaticOrder S; S.init(T, D, G, (int)blockIdx.x);
                EpiResid E{p.out, (const float*)(ws + WS_XC), p.out, (float*)(ws + WS_XC), (const float*)(ws + WS_MOD) + (size_t)l * 9 * 6144, 5};
                pg8::gemm_phase<EpiResid, pg8::StaticOrder, true, true>(glds, g, S, E);
            }
            GSYNC();
        } else {
            { LOADP(p); IDS(); unsigned char* ws = p.ws;
                float* scr = (float*)lds + wave * (64 * 33);
                convert_up(p.moe_w1, p.moe_w3, NE, (bf16_t*)(ws + WS_MWUP), scr, gw, NGW, lane);
                for (int e = 0; e < NE; ++e)
                    convert_T(p.moe_w2 + (size_t)e * DFF * D, DFF, D, (bf16_t*)(ws + WS_MWDN) + (size_t)e * D * DFF, D, CmIdent(), scr, (gw + 173 * e) % NGW, NGW, lane);
            }
            GSYNC();
            { LOADP(p); phase_moe_gather(p, lds); }
            GSYNC();
            for (int rep = 0; rep < REP_UP; ++rep)
            { LOADP(p); unsigned char* ws = p.ws; const int* misc = (const int*)(ws + WS_MISC);
                pg8::Gemm g{(const bf16_t*)(ws + WS_MA), (const bf16_t*)(ws + WS_MWUP), MOE_ROWS, NE * NUP, D, D};
                MoeOrder S{misc[MI_NTILES], NUP / 256, G, (int)blockIdx.x, misc + MI_TILEE};
                EpiSwiglu E{(bf16_t*)(ws + WS_MH1), NUP / 256};
                pg8::gemm_phase<EpiSwiglu, MoeOrder, true, true>(glds, g, S, E);
            }
            GSYNC();
            { LOADP(p); unsigned char* ws = p.ws; const int* misc = (const int*)(ws + WS_MISC);
                pg8::Gemm g{(const bf16_t*)(ws + WS_MH1), (const bf16_t*)(ws + WS_MWDN), MOE_ROWS, NE * D, DFF, DFF};
                MoeOrder S{misc[MI_NTILES], D / 256, G, (int)blockIdx.x, misc + MI_TILEE};
                EpiMoeDown E{(bf16_t*)(ws + WS_MA)};
                pg8::gemm_phase<EpiMoeDown, MoeOrder, true, true>(glds, g, S, E);
            }
            GSYNC();
            { LOADP(p); IDS(); phase_final(p, gw, NGW, lane); }
        }
    }
}

extern "C" void kernel_launch(void* const* d_in, const int* in_sizes, int n_in, void* d_out, int out_size, void* d_ws, size_t ws_size, hipStream_t stream) {
    static int grid_blocks = 0;
    if (grid_blocks == 0) {
        if (n_in != 30 || in_sizes[0] != TL * D || out_size != TL * D || ws_size < WS_END) {
            fprintf(stderr, "kernel_launch: built for 30 inputs, x/out of %d floats, >= %zu bytes of d_ws; got n_in %d, in0 %d, out %d, ws %zu; nothing launched\n", TL * D, (size_t)WS_END, n_in, n_in > 0 ? in_sizes[0] : -1, out_size, ws_size);
            grid_blocks = -1; return; }
        int dev = 0, cus = 0, per_cu = 0;
        hipGetDevice(&dev);
        hipDeviceGetAttribute(&cus, hipDeviceAttributeMultiprocessorCount, dev);
        hipFuncSetAttribute((const void*)mk_fwd, hipFuncAttributeMaxDynamicSharedMemorySize, LDS_BYTES);
        hipOccupancyMaxActiveBlocksPerMultiprocessor(&per_cu, (const void*)mk_fwd, NTHREADS, LDS_BYTES);
        if (per_cu < 1) { fprintf(stderr, "kernel_launch: occupancy query reports %d blocks/CU; nothing launched\n", per_cu); grid_blocks = -1; return; }
        grid_blocks = cus;
    }
    if (grid_blocks < 0) return;
    hipMemsetAsync((char*)d_ws + WS_CTL, 0, CTL_BYTES, stream);
    P p{};
    const float** f = (const float**)&p;
    for (int i = 0; i < 30; ++i) f[i] = (const float*)d_in[i];
    p.out = (float*)d_out; p.ws = (unsigned char*)d_ws;
    void* args[] = {&p};
    hipError_t e = hipLaunchCooperativeKernel((const void*)mk_fwd, dim3(grid_blocks), dim3(NTHREADS), args, LDS_BYTES, stream);
    if (e != hipSuccess) fprintf(stderr, "kernel_launch: cooperative launch failed: %s (grid %d)\n", hipGetErrorString(e), grid_blocks);
}
```

```cpp
#include <hip/hip_runtime.h>
#include <hip/hip_cooperative_groups.h>
#include <cstdio>
#include <cstdint>
namespace cg = cooperative_groups;
#ifndef REP_P0
#define REP_P0 1
#endif
#ifndef REP_WIN
#define REP_WIN 1
#endif
#ifndef REP_CHAIN
#define REP_CHAIN 1
#endif
#ifndef REP_UP
#define REP_UP 1
#endif
#ifndef REP_SYNC
#define REP_SYNC 1
#endif
#ifndef REP_ATT
#define REP_ATT 1
#endif
#ifndef REP_DNPREP
#define REP_DNPREP 1
#endif
#ifndef REP_ELT
#define REP_ELT 1
#endif

namespace pg8 {
#define PG8_LAS __attribute__((address_space(3)))
typedef unsigned short bf16_t;
typedef short bf16x8 __attribute__((ext_vector_type(8)));
typedef float f32x4 __attribute__((ext_vector_type(4)));
typedef unsigned u32x4 __attribute__((ext_vector_type(4)));
constexpr int BM = 256, BK = 64, HALF = 128, HTB = HALF * BK * 2  , STAGE_BYTES = 8 * HTB, NXCD = 8, WGM = 8;

__host__ __device__ __forceinline__ int lds_byte(int r, int c) { const int st = (r >> 4) * 2 + (c >> 5), rr = r & 15, cc = c & 31, ob = rr * 64 + cc * 2; return st * 1024 + (ob ^ (((ob >> 9) & 1) << 5)); }
__host__ __device__ __forceinline__ void stage_rc(int b, int& R, int& C) { const int st = b / 1024, sb = b % 1024, swz = sb ^ (((sb >> 9) & 1) << 5); R = (st >> 1) * 16 + swz / 64; C = (st & 1) * 32 + (swz % 64) / 2; }
__host__ __device__ __forceinline__ int perm32(int rho) { const int n = rho >> 4, i = rho & 15; return 8 * (i >> 2) + 4 * n + (i & 3); }

struct Unit { int pm, pn; };
struct Gemm { const bf16_t* A; const bf16_t* Bt; int M, N, K, lda; };

struct StaticOrder {
    int nM, nN, nwg, G, c;
    __host__ __device__ void init(int M, int N, int G_, int c_) { nM = M / BM; nN = N / BM; nwg = nM * nN; G = G_; c = c_; }
    __host__ __device__ bool next(int i, Unit& u) const {
        const long L = (long)i * G + c; if (L >= nwg) return false;
        int wgid = (int)L; { const int q = nwg / NXCD, r = nwg % NXCD, xcd = wgid % NXCD, off = wgid / NXCD; wgid = (xcd < r ? xcd * (q + 1) : r * (q + 1) + (xcd - r) * q) + off; }
        const int nig = WGM * nN, gid = wgid / nig, fm = gid * WGM, gsz = (nM - fm) < WGM ? (nM - fm) : WGM;
        u.pm = fm + ((wgid % nig) % gsz); u.pn = (wgid % nig) / gsz; return true;
    }
    __device__ __forceinline__ void a_ready(const Unit&) const {}
    __device__ __forceinline__ void done(const Unit&) const {}
};


template <class Epi, class Sched, bool ALIGN_EPI = false, bool SP2 = false>
__device__ __forceinline__ void gemm_phase(PG8_LAS unsigned char* lds, const Gemm g, const Sched& S, const Epi& E) {
    int tid_o = threadIdx.x; asm volatile("" : "+v"(tid_o));
    const int tid = tid_o, wid = __builtin_amdgcn_readfirstlane(tid >> 6), lane = tid & 63, wr = wid >> 2, wc = wid & 3, fr = lane & 15, fq = lane >> 4;
    const int K = g.K, nt = K / BK;
    unsigned voffA[2], voffB[2];
#pragma unroll
    for (int i = 0; i < 2; ++i) { int R, C; stage_rc(tid * 16 + i * 8192, R, C); const int Rb = Epi::PERM ? ((R & ~31) + perm32(R & 31)) : R;
        voffA[i] = (unsigned)(R * g.lda + C) * 2u; voffB[i] = (unsigned)(Rb * K + C) * 2u; }
    const size_t kstep = (size_t)(BK * 2);
    const size_t hstepA = (size_t)HALF * g.lda * 2, hstepB = (size_t)HALF * K * 2;
    const size_t tstepA = 2 * hstepA, tstepB = 2 * hstepB;
    const unsigned ldsw = (unsigned)wid * 1024u;
    const int aoff = lds_byte(wr * 64 + fr, fq * 8), boff = lds_byte(wc * 32 + fr, fq * 8);
#define PG8_SA(b, h) (((b) * 2 + (h)) * HTB)
#define PG8_SB(b, h) ((4 + (b) * 2 + (h)) * HTB)
#define PG8_STAGE(bufoff, gbase, voff) do { _Pragma("unroll") for (int _i = 0; _i < 2; ++_i) \
        __builtin_amdgcn_global_load_lds((const unsigned*)((const char*)(gbase) + (voff)[_i]), (PG8_LAS unsigned*)(lds + (bufoff) + ldsw + _i * 8192), 16, 0, 0); } while (0)
#define PG8_LDA(dst, b, h) do { _Pragma("unroll") for (int m = 0; m < 4; ++m) _Pragma("unroll") for (int k = 0; k < 2; ++k) dst[m][k] = *(const PG8_LAS bf16x8*)(lds + PG8_SA(b, h) + aoff + m * 2048 + k * 1024); } while (0)
#define PG8_LDB(dst, b, h) do { _Pragma("unroll") for (int n = 0; n < 2; ++n) _Pragma("unroll") for (int k = 0; k < 2; ++k) dst[n][k] = *(const PG8_LAS bf16x8*)(lds + PG8_SB(b, h) + boff + n * 2048 + k * 1024); } while (0)
#define PG8_MMA(ai, bj, At, Bt) do { __builtin_amdgcn_s_setprio(1); _Pragma("unroll") for (int m = 0; m < 4; ++m) _Pragma("unroll") for (int n = 0; n < 2; ++n) _Pragma("unroll") for (int k = 0; k < 2; ++k) \
        acc[ai][bj][m][n] = __builtin_amdgcn_mfma_f32_16x16x32_bf16(Bt[n][k], At[m][k], acc[ai][bj][m][n], 0, 0, 0); __builtin_amdgcn_s_setprio(0); } while (0)
#define PG8_WAIT_V(n) asm volatile("s_waitcnt vmcnt(" #n ")" ::: "memory")
#define PG8_WAIT_L(n) asm volatile("s_waitcnt lgkmcnt(" #n ")" ::: "memory")
#define PG8_BAR __builtin_amdgcn_s_barrier()
#define PG8_SCHED __builtin_amdgcn_sched_barrier(0)
    Unit cur, nxt; int ui = 0;
    if (!S.next(0, cur)) return;
    f32x4 acc[2][2][4][2];
#pragma unroll
    for (int a = 0; a < 2; ++a)
#pragma unroll
        for (int b = 0; b < 2; ++b)
#pragma unroll
            for (int m = 0; m < 4; ++m)
#pragma unroll
                for (int n = 0; n < 2; ++n) acc[a][b][m][n] = (f32x4){0.f, 0.f, 0.f, 0.f};
    bf16x8 At[4][2], B0[2][2], B1[2][2];
    const char* cA = (const char*)g.A + (size_t)cur.pm * tstepA; const char* cB = (const char*)g.Bt + (size_t)cur.pn * tstepB;
    S.a_ready(cur);
    if constexpr (SP2) {
        PG8_STAGE(PG8_SB(0, 0), cB, voffB); PG8_STAGE(PG8_SB(0, 1), cB + hstepB, voffB); PG8_STAGE(PG8_SA(0, 0), cA, voffA); PG8_STAGE(PG8_SA(0, 1), cA + hstepA, voffA);
        if (wr == 1) PG8_BAR;
        PG8_WAIT_V(2); PG8_BAR;
        PG8_STAGE(PG8_SB(1, 0), cB + kstep, voffB); PG8_STAGE(PG8_SA(1, 0), cA + kstep, voffA); PG8_STAGE(PG8_SB(1, 1), cB + hstepB + kstep, voffB);
        PG8_WAIT_V(6); PG8_BAR;
    } else {
        PG8_STAGE(PG8_SB(0, 0), cB, voffB); PG8_STAGE(PG8_SA(0, 0), cA, voffA); PG8_STAGE(PG8_SB(0, 1), cB + hstepB, voffB); PG8_STAGE(PG8_SA(0, 1), cA + hstepA, voffA);
        if (wr == 1) PG8_BAR;
        PG8_WAIT_V(4); PG8_BAR;
        PG8_STAGE(PG8_SB(1, 0), cB + kstep, voffB); PG8_STAGE(PG8_SA(1, 0), cA + kstep, voffA); PG8_STAGE(PG8_SB(1, 1), cB + hstepB + kstep, voffB);
        PG8_WAIT_V(6); PG8_BAR;
    }
    for (;;) {
        const bool has_next = S.next(ui + 1, nxt);
        const char* nA = has_next ? (const char*)g.A + (size_t)nxt.pm * tstepA : cA; const char* nB = has_next ? (const char*)g.Bt + (size_t)nxt.pn * tstepB : cB;
        for (int t = 0; t < nt; t += 2) {
            const bool last = (t == nt - 2);
            const char* a1 = cA + (size_t)(t + 1) * kstep;
            const char* a2 = last ? nA : cA + (size_t)(t + 2) * kstep; const char* b2 = last ? nB : cB + (size_t)(t + 2) * kstep;
            const char* a3 = a2 + kstep; const char* b3 = b2 + kstep;
            if (last && has_next) S.a_ready(nxt);
            if constexpr (SP2) {
            PG8_LDB(B0, 0, 0); PG8_LDB(B1, 0, 1); PG8_SCHED; PG8_LDA(At, 0, 0); PG8_STAGE(PG8_SA(1, 1), a1 + hstepA, voffA);
            PG8_WAIT_V(8); PG8_WAIT_L(0); PG8_BAR; PG8_MMA(0, 0, At, B0); PG8_MMA(0, 1, At, B1); PG8_BAR; PG8_SCHED;
            PG8_LDA(At, 0, 1); PG8_STAGE(PG8_SB(0, 0), b2, voffB); PG8_STAGE(PG8_SB(0, 1), b2 + hstepB, voffB); PG8_STAGE(PG8_SA(0, 0), a2, voffA);
            PG8_WAIT_V(8); PG8_WAIT_L(0); PG8_BAR; PG8_MMA(1, 0, At, B0); PG8_MMA(1, 1, At, B1); PG8_BAR; PG8_SCHED;
            PG8_LDB(B0, 1, 0); PG8_LDB(B1, 1, 1); PG8_SCHED; PG8_LDA(At, 1, 0); PG8_STAGE(PG8_SA(0, 1), a2 + hstepA, voffA);
            PG8_WAIT_V(8); PG8_WAIT_L(0); PG8_BAR; PG8_MMA(0, 0, At, B0); PG8_MMA(0, 1, At, B1); PG8_BAR; PG8_SCHED;
            PG8_LDA(At, 1, 1); PG8_STAGE(PG8_SB(1, 0), b3, voffB); PG8_STAGE(PG8_SB(1, 1), b3 + hstepB, voffB); PG8_STAGE(PG8_SA(1, 0), a3, voffA);
            PG8_WAIT_V(8); PG8_WAIT_L(0); PG8_BAR; PG8_MMA(1, 0, At, B0); PG8_MMA(1, 1, At, B1); PG8_BAR; PG8_SCHED;
            } else {
            PG8_LDB(B0, 0, 0); PG8_SCHED; PG8_LDA(At, 0, 0); PG8_STAGE(PG8_SA(1, 1), a1 + hstepA, voffA);
            PG8_WAIT_L(8); PG8_BAR; PG8_WAIT_L(0); PG8_MMA(0, 0, At, B0); PG8_BAR; PG8_SCHED;
            PG8_LDB(B1, 0, 1); PG8_STAGE(PG8_SB(0, 0), b2, voffB);
            PG8_BAR; PG8_WAIT_L(0); PG8_MMA(0, 1, At, B1); PG8_BAR;
            PG8_LDA(At, 0, 1); PG8_STAGE(PG8_SA(0, 0), a2, voffA);
            PG8_BAR; PG8_WAIT_L(0); PG8_MMA(1, 0, At, B0); PG8_BAR; PG8_SCHED;
            PG8_STAGE(PG8_SB(0, 1), b2 + hstepB, voffB);
            PG8_WAIT_V(6); PG8_BAR; PG8_MMA(1, 1, At, B1); PG8_BAR;
            PG8_LDB(B0, 1, 0); PG8_SCHED; PG8_LDA(At, 1, 0); PG8_STAGE(PG8_SA(0, 1), a2 + hstepA, voffA);
            PG8_WAIT_L(8); PG8_BAR; PG8_WAIT_L(0); PG8_MMA(0, 0, At, B0); PG8_BAR; PG8_SCHED;
            PG8_LDB(B1, 1, 1); PG8_STAGE(PG8_SB(1, 0), b3, voffB);
            PG8_BAR; PG8_WAIT_L(0); PG8_MMA(0, 1, At, B1); PG8_BAR;
            PG8_LDA(At, 1, 1); PG8_STAGE(PG8_SA(1, 0), a3, voffA);
            PG8_BAR; PG8_WAIT_L(0); PG8_MMA(1, 0, At, B0); PG8_BAR; PG8_SCHED;
            PG8_STAGE(PG8_SB(1, 1), b3 + hstepB, voffB);
            PG8_WAIT_V(6); PG8_BAR; PG8_MMA(1, 1, At, B1); PG8_BAR;
            }
        }
        if constexpr (ALIGN_EPI) { if (wr == 0) PG8_BAR; }
        if constexpr (!Epi::AFTER_DRAIN) { E(acc, cur, wr, wc, fr, fq); S.done(cur); }
        if (!has_next) break;
#pragma unroll
        for (int a = 0; a < 2; ++a)
#pragma unroll
            for (int b = 0; b < 2; ++b)
#pragma unroll
                for (int m = 0; m < 4; ++m)
#pragma unroll
                    for (int n = 0; n < 2; ++n) acc[a][b][m][n] = (f32x4){0.f, 0.f, 0.f, 0.f};
        cur = nxt; cA = nA; cB = nB; ++ui;
        if constexpr (ALIGN_EPI) { if (wr == 1) PG8_BAR; }
    }
    PG8_WAIT_V(0);
    if constexpr (!ALIGN_EPI) { if (wr == 0) PG8_BAR; }
    PG8_BAR;
    if constexpr (Epi::AFTER_DRAIN) { E.fused(acc, cur, wr, wc, fr, fq, lds, wid, lane); S.done(cur); }
#undef PG8_SA
#undef PG8_SB
#undef PG8_STAGE
#undef PG8_LDA
#undef PG8_LDB
#undef PG8_MMA
#undef PG8_WAIT_V
#undef PG8_WAIT_L
#undef PG8_BAR
#undef PG8_SCHED
}
}


constexpr int BATCH = 8, SEQ = 2048, CTXL = 256, D = 1024, DEPTH = 2;
constexpr int TL = BATCH * SEQ, TC = BATCH * CTXL, T = TL + TC;
constexpr int NIN = 8448;
constexpr int DFF = 2816, NE = 8, NUP = 2 * DFF;
constexpr int MOE_ROWS = 2 * TL + NE * 256;
constexpr float EPS = 1e-6f;
constexpr int NTHREADS = 512, NWAVES = 8;
constexpr int LDS_BYTES = 147456;

typedef unsigned short bf16_t;
typedef float f32x4 __attribute__((ext_vector_type(4)));
typedef float f32x16 __attribute__((ext_vector_type(16)));
typedef unsigned u32x4 __attribute__((ext_vector_type(4)));
typedef unsigned u32x2 __attribute__((ext_vector_type(2)));
typedef short bf16x8 __attribute__((ext_vector_type(8)));
typedef short s16x4 __attribute__((ext_vector_type(4)));

constexpr size_t al256(size_t x) { return (x + 255) & ~(size_t)255; }
constexpr size_t WS_CTL   = 0;                                   constexpr size_t CTL_BYTES = 65536;
constexpr size_t WS_MOD   = WS_CTL + CTL_BYTES;                  constexpr size_t MOD_BYTES = (size_t)DEPTH * 9 * 6 * D * 4;
constexpr size_t WS_ROUTE = al256(WS_MOD + MOD_BYTES);           constexpr size_t ROUTE_BYTES = (size_t)TL * 16;
constexpr size_t WS_SLOT  = al256(WS_ROUTE + ROUTE_BYTES);       constexpr size_t SLOT_BYTES = (size_t)TL * 8;
constexpr size_t WS_MISC  = al256(WS_SLOT + SLOT_BYTES);         constexpr size_t MISC_BYTES = 4096;
constexpr size_t WS_GB    = al256(WS_MISC + MISC_BYTES);         constexpr size_t GB_BYTES = (size_t)T * 16 * 4;
constexpr size_t WS_SMALL = al256(WS_GB + GB_BYTES);             constexpr size_t SMALL_BYTES = (size_t)T * 64 * 4;
constexpr size_t WS_XC    = al256(WS_SMALL + SMALL_BYTES);       constexpr size_t XC_BYTES = (size_t)TC * D * 4;
constexpr size_t WS_WB    = al256(WS_XC + XC_BYTES);
constexpr size_t WB_WIN   = WS_WB;                               constexpr size_t WIN_BYTES = (size_t)NIN * D * 2;
constexpr size_t WB_WO    = WB_WIN + DEPTH * WIN_BYTES;          constexpr size_t WO_BYTES = (size_t)D * 512 * 2;
constexpr size_t WB_WOUT  = WB_WO + DEPTH * 3 * WO_BYTES;        constexpr size_t WOUT_BYTES = (size_t)D * D * 2;
constexpr size_t WB_WUP   = WB_WOUT + DEPTH * WOUT_BYTES;        constexpr size_t WUP_BYTES = (size_t)NUP * D * 2;
constexpr size_t WB_WDN   = WB_WUP + WUP_BYTES;                  constexpr size_t WDN_BYTES = (size_t)D * DFF * 2;
constexpr size_t WB_END   = WB_WDN + WDN_BYTES;
constexpr size_t WS_H     = al256(WB_END);                       constexpr size_t H_BYTES = (size_t)T * D * 2;
constexpr size_t WS_PAQ   = al256(WS_H + H_BYTES);               constexpr size_t PAQ_BYTES = (size_t)T * 1536 * 2;
constexpr size_t WS_PZ    = al256(WS_PAQ + PAQ_BYTES);           constexpr size_t PZ_BYTES = (size_t)T * 512 * 2;
constexpr size_t WS_PB    = al256(WS_PZ + PZ_BYTES);             constexpr size_t PB_BYTES = (size_t)T * 1536 * 2;
constexpr size_t WS_PC    = al256(WS_PB + PB_BYTES);             constexpr size_t PC_BYTES = (size_t)T * 1536 * 2;
constexpr size_t WS_PG    = al256(WS_PC + PC_BYTES);             constexpr size_t PG_BYTES = (size_t)T * 3072 * 2;
constexpr size_t WS_DNQKV = al256(WS_PG + PG_BYTES);             constexpr size_t DNQKV_BYTES = (size_t)T * 1536 * 2;
constexpr size_t WS_TQ    = al256(WS_DNQKV + DNQKV_BYTES);       constexpr size_t TQ_BYTES = (size_t)BATCH * 4 * 2 * ((CTXL + SEQ) / 64) * 16384;
constexpr size_t WS_VEC   = al256(WS_TQ + TQ_BYTES);             constexpr size_t VEC_BYTES = (size_t)BATCH * 4 * 2 * ((CTXL + SEQ) / 64) * 1024;
constexpr size_t WS_END   = al256(WS_VEC + VEC_BYTES);
static_assert(WS_END <= (size_t)524288000, "d_ws map exceeds 500 MiB (documented minimum is 525,980,800 B)");
constexpr size_t WS_H1    = WS_PB;
static_assert((size_t)T * DFF * 2 <= PB_BYTES + PC_BYTES, "h1 overlay");
constexpr size_t WS_MWDN  = WS_WB;                                constexpr size_t MWDN_BYTES = (size_t)NE * D * DFF * 2;
static_assert(MWDN_BYTES <= WB_END - WS_WB, "moe wdn overlay");
constexpr size_t WS_MWUP  = WS_PAQ;                               constexpr size_t MWUP_BYTES = (size_t)NE * NUP * D * 2;
constexpr size_t WS_MA    = al256(WS_MWUP + MWUP_BYTES);          constexpr size_t MA_BYTES = (size_t)MOE_ROWS * D * 2;
constexpr size_t WS_MH1   = al256(WS_MA + MA_BYTES);              constexpr size_t MH1_BYTES = (size_t)MOE_ROWS * DFF * 2;
static_assert(WS_MH1 + MH1_BYTES <= WS_END, "moe overlay");
constexpr int CW_QUEUE = 0;
constexpr int CW_KMAX = 256;
constexpr int CW_ECNT = 512;
constexpr int CW_EFILL = 576;
constexpr int CW_BAR = 4096;
constexpr int MI_LAMF = 0;
constexpr int MI_NTILES = 16;
constexpr int MI_EOFF = 32;
constexpr int MI_TILEE = 64;

typedef __bf16 bf16v2_t __attribute__((ext_vector_type(2)));
typedef float f32v2_t __attribute__((ext_vector_type(2)));
__device__ __forceinline__ unsigned pk2(float lo, float hi) { const f32v2_t v = {lo, hi}; return __builtin_bit_cast(unsigned, __builtin_convertvector(v, bf16v2_t)); }
__device__ __forceinline__ unsigned f2bf(float f) { return pk2(f, 0.f) & 0xffffu; }
__device__ __forceinline__ float bflo(unsigned w) { return __builtin_bit_cast(float, w << 16); }
__device__ __forceinline__ float bfhi(unsigned w) { return __builtin_bit_cast(float, w & 0xffff0000u); }
__device__ __forceinline__ float bf2f(bf16_t h) { return __builtin_bit_cast(float, (unsigned)h << 16); }
__device__ __forceinline__ int otid() { int t = threadIdx.x; asm volatile("" : "+v"(t)); return t; }
__device__ __forceinline__ float shx(float v, int o) { const int idx = ((otid() & 63) ^ o) << 2; return __builtin_bit_cast(float, __builtin_amdgcn_ds_bpermute(idx, __builtin_bit_cast(int, v))); }
__device__ __forceinline__ float shup(float v, int o) { const int idx = (((otid() & 63) - o) & 63) << 2; return __builtin_bit_cast(float, __builtin_amdgcn_ds_bpermute(idx, __builtin_bit_cast(int, v))); }
__device__ __forceinline__ float shlane(float v, int src) { return __builtin_bit_cast(float, __builtin_amdgcn_ds_bpermute(src << 2, __builtin_bit_cast(int, v))); }
__device__ __forceinline__ int shlane_i(int v, int src) { return __builtin_amdgcn_ds_bpermute(src << 2, v); }
__device__ __forceinline__ float wave_sum(float v) {
#pragma unroll
    for (int o = 1; o < 64; o <<= 1) v += shx(v, o);
    return v;
}
__device__ __forceinline__ float sigmoidf_(float x) { return 1.0f / (1.0f + __expf(-x)); }
__device__ __forceinline__ float siluf_(float x) { return x / (1.0f + __expf(-x)); }
__device__ __forceinline__ float softplusf_(float x) { return x > 20.f ? x : log1pf(expf(x)); }
__device__ __forceinline__ float logsigmoidf_(float x) { return fminf(x, 0.f) - log1pf(expf(-fabsf(x))); }

struct P {
    const float *x, *c, *ctx, *c_ctx, *w_mod, *b_mod, *norm1_g, *norm2_g, *w_in, *conv_a, *a_log, *dt_bias, *gn_a, *w_gate2, *b_gate, *gn_b,
                *lam_c, *gn_c, *w_o_a, *w_o_b, *w_o_c, *w_out, *ffn_w1, *ffn_w3, *ffn_w2, *router_w, *moe_w1, *moe_w3, *moe_w2, *final_g;
    float* out; unsigned char* ws;
};

template <class ColMap>
__device__ __forceinline__ void convert_T(const float* W, int K, int ldw, bf16_t* WT, int Nrows, ColMap cm, float* scr, int gw, int NGW, int lane) {
    const int nblk = Nrows / 32, items = (K / 64) * nblk;
    for (int it = gw; it < items; it += NGW) {
        const int kb = it / nblk, nb = it % nblk, k0 = 64 * kb, n0 = 32 * nb;
        const int sc = cm(n0 + (lane & 31));
#pragma unroll 8
        for (int i = 0; i < 32; ++i) { const int kk = 2 * i + (lane >> 5); scr[kk * 33 + (lane & 31)] = sc >= 0 ? W[(size_t)(k0 + kk) * ldw + sc] : 0.f; }
        asm volatile("s_waitcnt lgkmcnt(0)" ::: "memory");
        const int c = lane & 7;
#pragma unroll
        for (int j = 0; j < 4; ++j) { const int n = (lane >> 3) + 8 * j; const float* s = scr + (8 * c) * 33 + n;
            u32x4 o; o.x = pk2(s[0 * 33], s[1 * 33]); o.y = pk2(s[2 * 33], s[3 * 33]); o.z = pk2(s[4 * 33], s[5 * 33]); o.w = pk2(s[6 * 33], s[7 * 33]);
            *(u32x4*)(WT + (size_t)(n0 + n) * K + k0 + 8 * c) = o; }
        asm volatile("s_waitcnt lgkmcnt(0)" ::: "memory");
    }
}
struct CmIdent { __device__ int operator()(int n) const { return n; } };
struct CmWin { __device__ int operator()(int n) const {
    if (n < 2048) return n; if (n < 3584) return n + 16; if (n < 8192) return n + 48;
    const int j = n - 8192; if (j < 16) return 2048 + j; if (j < 48) return 3600 + (j - 16); return -1; } };

typedef const f32x4 (&AccRef)[2][2][4][2];
struct EpiWin {
    static constexpr bool PERM = true, AFTER_DRAIN = false;
    bf16_t *paq, *pz, *pb, *pc, *pg; float* small_;
    __device__ __forceinline__ void operator()(AccRef acc, const pg8::Unit& u, int wr, int wc, int fr, int fq) const {
        const int row0 = u.pm * 256 + wr * 64 + fr, pn = u.pn;
        if (pn == 32) {
            if (wc < 2) {
#pragma unroll
                for (int ai = 0; ai < 2; ++ai)
#pragma unroll
                    for (int m = 0; m < 4; ++m) { float* p = small_ + (size_t)(row0 + ai * 128 + m * 16) * 64 + wc * 32 + 8 * fq;
                        *(f32x4*)p = acc[ai][0][m][0]; *(f32x4*)(p + 4) = acc[ai][0][m][1]; }
            }
            return;
        }
        bf16_t* base; int ldc, c0;
        if (pn < 6) { base = paq; ldc = 1536; c0 = pn * 256; } else if (pn < 8) { base = pz; ldc = 512; c0 = (pn - 6) * 256; }
        else if (pn < 14) { base = pb; ldc = 1536; c0 = (pn - 8) * 256; } else if (pn < 20) { base = pc; ldc = 1536; c0 = (pn - 14) * 256; }
        else { base = pg; ldc = 3072; c0 = (pn - 20) * 256; }
        const int col = c0 + wc * 32 + 8 * fq;
#pragma unroll
        for (int ai = 0; ai < 2; ++ai)
#pragma unroll
            for (int m = 0; m < 4; ++m) { bf16_t* rowp = base + (size_t)(row0 + ai * 128 + m * 16) * ldc + col;
#pragma unroll
                for (int bj = 0; bj < 2; ++bj) { const f32x4 v0 = acc[ai][bj][m][0], v1 = acc[ai][bj][m][1];
                    u32x4 w; w.x = pk2(v0[0], v0[1]); w.y = pk2(v0[2], v0[3]); w.z = pk2(v1[0], v1[1]); w.w = pk2(v1[2], v1[3]);
                    *(u32x4*)(rowp + bj * 128) = w; } }
    }
};
struct EpiGate {
    static constexpr bool PERM = true, AFTER_DRAIN = false;
    bf16_t* Mo; const bf16_t* pg; int br;
    __device__ __forceinline__ void operator()(AccRef acc, const pg8::Unit& u, int wr, int wc, int fr, int fq) const {
        const int row0 = u.pm * 256 + wr * 64 + fr, col = u.pn * 256 + wc * 32 + 8 * fq;
#pragma unroll
        for (int ai = 0; ai < 2; ++ai)
#pragma unroll
            for (int m = 0; m < 4; ++m) { const size_t row = (size_t)(row0 + ai * 128 + m * 16);
#pragma unroll
                for (int bj = 0; bj < 2; ++bj) {
                    const u32x4 gw = *(const u32x4*)(pg + row * 3072 + br * 1024 + col + bj * 128);
                    bf16_t* mp = Mo + row * 1024 + col + bj * 128;
                    f32x4 v0 = acc[ai][bj][m][0], v1 = acc[ai][bj][m][1];
                    v0[0] *= sigmoidf_(bflo(gw.x)); v0[1] *= sigmoidf_(bfhi(gw.x)); v0[2] *= sigmoidf_(bflo(gw.y)); v0[3] *= sigmoidf_(bfhi(gw.y));
                    v1[0] *= sigmoidf_(bflo(gw.z)); v1[1] *= sigmoidf_(bfhi(gw.z)); v1[2] *= sigmoidf_(bflo(gw.w)); v1[3] *= sigmoidf_(bfhi(gw.w));
                    if (br != 0) { const u32x4 o = *(const u32x4*)mp;
                        v0[0] += bflo(o.x); v0[1] += bfhi(o.x); v0[2] += bflo(o.y); v0[3] += bfhi(o.y); v1[0] += bflo(o.z); v1[1] += bfhi(o.z); v1[2] += bflo(o.w); v1[3] += bfhi(o.w); }
                    u32x4 w; w.x = pk2(v0[0], v0[1]); w.y = pk2(v0[2], v0[3]); w.z = pk2(v1[0], v1[1]); w.w = pk2(v1[2], v1[3]);
                    *(u32x4*)mp = w; } }
    }
};
struct EpiResid {
    static constexpr bool PERM = false, AFTER_DRAIN = false;
    const float *old_l, *old_c; float *out_l, *out_c; const float* mod; int gidx;
    __device__ __forceinline__ void operator()(AccRef acc, const pg8::Unit& u, int wr, int wc, int fr, int fq) const {
        const int col0 = u.pn * 256 + wc * 32 + 4 * fq;
        const bool isctx = u.pm >= TL / 256; const int b = isctx ? 8 : u.pm / (SEQ / 256);
        const float* g = mod + (size_t)b * 6144 + gidx * 1024 + col0;
        const float* ob = isctx ? old_c - (size_t)TL * D : old_l; float* wb = isctx ? out_c - (size_t)TL * D : out_l;
        f32x4 gv[2][2];
#pragma unroll
        for (int bj = 0; bj < 2; ++bj)
#pragma unroll
            for (int n = 0; n < 2; ++n) gv[bj][n] = *(const f32x4*)(g + bj * 128 + n * 16);
#pragma unroll
        for (int ai = 0; ai < 2; ++ai)
#pragma unroll
            for (int m = 0; m < 4; ++m) { const size_t off = (size_t)(u.pm * 256 + ai * 128 + wr * 64 + m * 16 + fr) * D + col0;
#pragma unroll
                for (int bj = 0; bj < 2; ++bj)
#pragma unroll
                    for (int n = 0; n < 2; ++n) { const f32x4 xo = *(const f32x4*)(ob + off + bj * 128 + n * 16);
                        *(f32x4*)(wb + off + bj * 128 + n * 16) = xo + gv[bj][n] * acc[ai][bj][m][n]; } }
    }
};
struct EpiSwiglu {
    static constexpr bool PERM = true, AFTER_DRAIN = false;
    bf16_t* h1; int NJ;
    __device__ __forceinline__ void operator()(AccRef acc, const pg8::Unit& u, int wr, int wc, int fr, int fq) const {
        const int row0 = u.pm * 256 + wr * 64 + fr, col = (u.pn % NJ) * 128 + wc * 32 + 8 * fq;
#pragma unroll
        for (int ai = 0; ai < 2; ++ai)
#pragma unroll
            for (int m = 0; m < 4; ++m) { const f32x4 a0 = acc[ai][0][m][0], a1 = acc[ai][0][m][1], b0 = acc[ai][1][m][0], b1 = acc[ai][1][m][1];
                u32x4 w; w.x = pk2(siluf_(a0[0]) * b0[0], siluf_(a0[1]) * b0[1]); w.y = pk2(siluf_(a0[2]) * b0[2], siluf_(a0[3]) * b0[3]);
                w.z = pk2(siluf_(a1[0]) * b1[0], siluf_(a1[1]) * b1[1]); w.w = pk2(siluf_(a1[2]) * b1[2], siluf_(a1[3]) * b1[3]);
                *(u32x4*)(h1 + (size_t)(row0 + ai * 128 + m * 16) * DFF + col) = w; }
    }
};
struct EpiMoeDown {
    static constexpr bool PERM = true, AFTER_DRAIN = false;
    bf16_t* y;
    __device__ __forceinline__ void operator()(AccRef acc, const pg8::Unit& u, int wr, int wc, int fr, int fq) const {
        const int row0 = u.pm * 256 + wr * 64 + fr, col = (u.pn % 4) * 256 + wc * 32 + 8 * fq;
#pragma unroll
        for (int ai = 0; ai < 2; ++ai)
#pragma unroll
            for (int m = 0; m < 4; ++m) { bf16_t* rowp = y + (size_t)(row0 + ai * 128 + m * 16) * D + col;
#pragma unroll
                for (int bj = 0; bj < 2; ++bj) { const f32x4 v0 = acc[ai][bj][m][0], v1 = acc[ai][bj][m][1];
                    u32x4 w; w.x = pk2(v0[0], v0[1]); w.y = pk2(v0[2], v0[3]); w.z = pk2(v1[0], v1[1]); w.w = pk2(v1[2], v1[3]);
                    *(u32x4*)(rowp + bj * 128) = w; } }
    }
};
struct MoeOrder {
    int ntiles, NJ, G, c; const int* tile_e;
    __device__ bool next(int i, pg8::Unit& u) const { const long L = (long)i * G + c; if (L >= (long)ntiles * NJ) return false;
        const int t = (int)(L / NJ), j = (int)(L % NJ); u.pm = t; u.pn = tile_e[t] * NJ + j; return true; }
    __device__ __forceinline__ void a_ready(const pg8::Unit&) const {}
    __device__ __forceinline__ void done(const pg8::Unit&) const {}
};

#define XB_TMO      128
#define XB_XCNT(j)  (256  + 64 * (j))
#define XB_XSUB(j)  (1280 + 64 * (j))
#define XB_XGEN(j)  (2304 + 64 * (j))
#define XB_TOP      3328
#define XB_TOPGEN   3392
#define XCD_BAR_WORDS 3456
#define XB_SPIN_CAP (1u << 18)

__device__ __forceinline__ unsigned xb_ld(unsigned* p)              { return __hip_atomic_load(p, __ATOMIC_RELAXED, __HIP_MEMORY_SCOPE_AGENT); }
__device__ __forceinline__ unsigned xb_add(unsigned* p, unsigned v) { return __hip_atomic_fetch_add(p, v, __ATOMIC_RELAXED, __HIP_MEMORY_SCOPE_AGENT); }
__device__ __forceinline__ unsigned xb_xcc_id() { return (unsigned)__builtin_amdgcn_s_getreg((3 << 11) | 20) & 0xFu; }
#define XB_SPIN(cond, bar) do { unsigned _sp = 0; while (cond) { __builtin_amdgcn_s_sleep(1); \
    if ((++_sp & 255u) == 0u) { if (xb_ld(&(bar)[XB_TMO])) break; if (_sp > XB_SPIN_CAP) { atomicAdd(&(bar)[XB_TMO], 1u); break; } } } } while (0)

struct XcdBarrier {
    unsigned* bar; unsigned x;
    volatile unsigned* st;
};

__device__ __forceinline__ XcdBarrier xcd_barrier_post(unsigned* bar, volatile unsigned* st) {
    XcdBarrier b; b.bar = bar; b.x = xb_xcc_id(); b.st = st;
    if (threadIdx.x == 0) (void)xb_add(&bar[XB_XCNT(b.x)], 1u);
    return b;
}
__device__ __forceinline__ void xcd_barrier_complete(unsigned* bar, unsigned x, unsigned& nloc, unsigned& nx) {
    const unsigned G = gridDim.x * gridDim.y * gridDim.z;
    unsigned sum, cnt, mine, sp = 0u;
    for (;;) {
        sum = 0u; cnt = 0u; mine = 0u;
#pragma unroll
        for (unsigned j = 0; j < 16; ++j) { const unsigned c = xb_ld(&bar[XB_XCNT(j)]); sum += c; cnt += (c > 0u) ? 1u : 0u; mine = (j == x) ? c : mine; }
        if (sum == G) break;
        __builtin_amdgcn_s_sleep(1);
        if ((++sp & 255u) == 0u) { if (xb_ld(&bar[XB_TMO])) break; if (sp > XB_SPIN_CAP) { atomicAdd(&bar[XB_TMO], 1u); break; } }
    }
    nloc = mine > 0u ? mine : 1u; nx = cnt > 0u ? cnt : 1u;
}

__device__ __forceinline__ void xcd_barrier(const XcdBarrier& b) {
    asm volatile("s_waitcnt vmcnt(0)" ::: "memory");
    __syncthreads();
    if (threadIdx.x == 0) {
        unsigned* bar = b.bar;
        __builtin_amdgcn_s_waitcnt(0);
        unsigned nloc = b.st[0], nx = b.st[1];
        if (nloc == 0u) { xcd_barrier_complete(bar, b.x, nloc, nx); b.st[0] = nloc; b.st[1] = nx; }
        const unsigned old = xb_add(&bar[XB_XSUB(b.x)], 1u);
        const unsigned gen = old / nloc;
        if (old + 1u == (gen + 1u) * nloc) {
            __builtin_amdgcn_fence(__ATOMIC_RELEASE, "agent");
            asm volatile("s_waitcnt vmcnt(0)" ::: "memory");
            const unsigned og = xb_add(&bar[XB_TOP], 1u);
            const unsigned tg = og / nx;
            if (og + 1u == (tg + 1u) * nx) xb_add(&bar[XB_TOPGEN], 1u);
            else XB_SPIN(xb_ld(&bar[XB_TOPGEN]) == tg, bar);
            __builtin_amdgcn_fence(__ATOMIC_ACQUIRE, "agent");
            xb_add(&bar[XB_XGEN(b.x)], 1u);
            asm volatile("s_waitcnt vmcnt(0)" ::: "memory");
        } else {
            XB_SPIN(xb_ld(&bar[XB_XGEN(b.x)]) == gen, bar);
            __builtin_amdgcn_fence(__ATOMIC_ACQUIRE, "agent");
            asm volatile("s_waitcnt vmcnt(0)" ::: "memory");
        }
    }
    __syncthreads();
}

__device__ __forceinline__ void phase_mod(const P& p, unsigned char* lds) {
    float* sc = (float*)lds;
    float* red = sc + 9 * 1024;
    const int tid = otid();
    for (int i = tid; i < 9 * 1024; i += NTHREADS) { const int r = i >> 10, k = i & 1023; const float v = r < 8 ? p.c[r * 1024 + k] : p.c_ctx[k]; sc[i] = siluf_(v); }
    __syncthreads();
    float* MOD = (float*)(p.ws + WS_MOD);
    const int cj = tid % 48, ks = tid / 48;
    for (int grp = blockIdx.x; grp < DEPTH * 6144 / 48; grp += gridDim.x) {
        const int l = grp / 128, j = (grp % 128) * 48 + cj;
        float a[9];
#pragma unroll
        for (int r = 0; r < 9; ++r) a[r] = 0.f;
        if (ks < 10) {
            const float* w = p.w_mod + (size_t)l * 1024 * 6144 + j;
            for (int k = ks; k < 1024; k += 10) { const float wv = w[(size_t)k * 6144];
#pragma unroll
                for (int r = 0; r < 9; ++r) a[r] += sc[r * 1024 + k] * wv; }
#pragma unroll
            for (int r = 0; r < 9; ++r) red[(ks * 9 + r) * 48 + cj] = a[r];
        }
        __syncthreads();
        if (tid < 9 * 48) { const int r = tid / 48, c2 = tid % 48; float s = 0.f;
#pragma unroll
            for (int q = 0; q < 10; ++q) s += red[(q * 9 + r) * 48 + c2];
            const int jj = (grp % 128) * 48 + c2;
            MOD[((size_t)l * 9 + r) * 6144 + jj] = s + p.b_mod[l * 6144 + jj]; }
        __syncthreads();
    }
}

__device__ __forceinline__ void phase_modulate(const float* src_l, const float* src_c, int nrows, const float* gain, const float* mod, int shift_idx,
                                               bf16_t* H, const float* router_w, int* route, unsigned* ecnt, unsigned* lcnt  , int gw, int NGW, int lane) {
    if (router_w) { if (otid() < NE) lcnt[otid()] = 0u; __syncthreads(); }
    for (int r = gw; r < nrows; r += NGW) {
        const bool isctx = r >= TL; const int b = isctx ? 8 : r / SEQ;
        const float* xr = isctx ? src_c + (size_t)(r - TL) * D : src_l + (size_t)r * D;
        const float* sh = mod + (size_t)b * 6144 + shift_idx * 1024; const float* scl = sh + 1024;
        f32x4 v[4]; float ss = 0.f;
#pragma unroll
        for (int j = 0; j < 4; ++j) { v[j] = *(const f32x4*)(xr + 4 * lane + 256 * j); ss += (v[j][0] * v[j][0] + v[j][1] * v[j][1]) + (v[j][2] * v[j][2] + v[j][3] * v[j][3]); }
        const float rs = 1.0f / sqrtf(wave_sum(ss) * (1.0f / D) + EPS);
#pragma unroll
        for (int j = 0; j < 4; ++j) { const int c = 4 * lane + 256 * j; const f32x4 g = *(const f32x4*)(gain + c), s1 = *(const f32x4*)(scl + c), s0 = *(const f32x4*)(sh + c);
            v[j] = v[j] * rs * g * (1.0f + s1) + s0;
            u32x2 w; w.x = pk2(v[j][0], v[j][1]); w.y = pk2(v[j][2], v[j][3]);
            *(u32x2*)(H + (size_t)r * D + c) = w; }
        if (router_w) {
            float lg[NE];
#pragma unroll
            for (int e = 0; e < NE; ++e) lg[e] = 0.f;
#pragma unroll
            for (int j = 0; j < 4; ++j)
#pragma unroll
                for (int q = 0; q < 4; ++q) { const float* rw = router_w + (size_t)(4 * lane + 256 * j + q) * NE; const f32x4 r0 = *(const f32x4*)rw, r1 = *(const f32x4*)(rw + 4); const float hv = v[j][q];
                    lg[0] += hv * r0[0]; lg[1] += hv * r0[1]; lg[2] += hv * r0[2]; lg[3] += hv * r0[3]; lg[4] += hv * r1[0]; lg[5] += hv * r1[1]; lg[6] += hv * r1[2]; lg[7] += hv * r1[3]; }
#pragma unroll
            for (int e = 0; e < NE; ++e) lg[e] = wave_sum(lg[e]);
            int e1 = 0; float v1 = lg[0];
#pragma unroll
            for (int e = 1; e < NE; ++e) if (lg[e] > v1) { v1 = lg[e]; e1 = e; }
            int e2 = e1 == 0 ? 1 : 0; float v2 = lg[e2];
#pragma unroll
            for (int e = 0; e < NE; ++e) if (e != e1 && lg[e] > v2) { v2 = lg[e]; e2 = e; }
            const float w2 = 1.0f / (1.0f + expf(v1 - v2)), w1 = 1.0f - w2;
            if (lane == 0) { route[r * 4 + 0] = e1; route[r * 4 + 1] = e2; ((float*)route)[r * 4 + 2] = w1; ((float*)route)[r * 4 + 3] = w2;
                atomicAdd(lcnt + e1, 1u); atomicAdd(lcnt + e2, 1u); }
        }
    }
    if (router_w) { __syncthreads(); if (otid() < NE && lcnt[otid()]) atomicAdd(ecnt + otid(), lcnt[otid()]); }
}


typedef short v4i16_t __attribute__((ext_vector_type(4)));
__device__ __forceinline__ s16x4 lds_tr(const bf16_t* pp) { return __builtin_bit_cast(s16x4, __builtin_amdgcn_ds_read_tr16_b64_v4i16((__attribute__((address_space(3))) v4i16_t*)pp)); }
__device__ __forceinline__ bf16x8 cat8(s16x4 a, s16x4 b) { union { bf16x8 v; s16x4 h[2]; } u; u.h[0] = a; u.h[1] = b; return u.v; }
__device__ __forceinline__ bf16x8 pack8(f32x4 a, f32x4 b) { union { bf16x8 v; unsigned u[4]; } r; r.u[0] = pk2(a[0], a[1]); r.u[1] = pk2(a[2], a[3]); r.u[2] = pk2(b[0], b[1]); r.u[3] = pk2(b[2], b[3]); return r.v; }
constexpr int DN_NCH = (CTXL + SEQ) / 64;
constexpr int DN_ITEMS = BATCH * 4 * 2 * DN_NCH;
constexpr int PREP_WLDS = 16384 + 17408 + 512;

__device__ __forceinline__ int dn_row(int n, int s, int b, int dir) {
    const bool isctx = n < CTXL / 64; const int L = isctx ? CTXL : SEQ, c = isctx ? n : n - CTXL / 64, u = 64 * c + s, t = dir ? L - 1 - u : u;
    return (isctx ? TL + b * CTXL : b * SEQ) + t;
}
__device__ __forceinline__ void dn_prep_item(const P& p, int l, int item, unsigned char* wlds, int lane) {
    const int n = item % DN_NCH, bhd = item / DN_NCH, dir = bhd & 1, h = (bhd >> 1) & 3, b = bhd >> 3;
    const bool isctx = n < CTXL / 64; const int L = isctx ? CTXL : SEQ, cch = isctx ? n : n - CTXL / 64, rbase = isctx ? TL + b * CTXL : b * SEQ;
    const int i16 = lane & 15, g = lane >> 4;
    const bf16_t* PAQ = (const bf16_t*)(p.ws + WS_PAQ); bf16_t* DN = (bf16_t*)(p.ws + WS_DNQKV); const float* SMALL = (const float*)(p.ws + WS_SMALL);
    const float* cw = p.conv_a + (size_t)l * 3 * 1536;
    constexpr int KCP = 136;
    float* Ls = (float*)wlds; bf16_t* Kc = (bf16_t*)(wlds + 16384); float* Tl = (float*)(wlds + 16384);
    float* gcs = (float*)(wlds + 16384 + 17408); float* bes = gcs + 64;
    {
        const int r = dn_row(n, lane, b, dir);
        const float bb = SMALL[(size_t)r * 64 + dir * 4 + h], aa = SMALL[(size_t)r * 64 + 8 + dir * 4 + h];
        const float gv = -expf(p.a_log[l * 8 + dir * 4 + h]) * softplusf_(aa + p.dt_bias[l * 8 + dir * 4 + h]), be = sigmoidf_(bb);
        float gc = gv;
#pragma unroll
        for (int o = 1; o < 64; o <<= 1) { const float u = shup(gc, o); if (lane >= o) gc += u; }
        const float gl = shlane(gc, 63);
        gcs[lane] = gc; bes[lane] = be;
        float* vec = (float*)(p.ws + WS_VEC) + (size_t)item * 256;
        vec[lane] = expf(gc); vec[64 + lane] = expf(gl - gc); vec[128 + lane] = be; vec[192 + lane] = expf(gl);
    }
    auto conv_frag = [&](int seg, int mt, bf16x8 (&F)[4]) {
        const int u = 64 * cch + 16 * mt + i16, t = dir ? L - 1 - u : u; const size_t r = (size_t)(rbase + t);
        float y[4][8]; float ss = 0.f;
#pragma unroll
        for (int ks = 0; ks < 4; ++ks) { const int col = seg * 512 + h * 128 + 32 * ks + 8 * g;
            const u32x4 x1 = *(const u32x4*)(PAQ + r * 1536 + col);
            u32x4 x0 = (u32x4){0u, 0u, 0u, 0u}, x2 = (u32x4){0u, 0u, 0u, 0u};
            if (t > 0) x0 = *(const u32x4*)(PAQ + (r - 1) * 1536 + col);
            if (t < L - 1) x2 = *(const u32x4*)(PAQ + (r + 1) * 1536 + col);
            const f32x4 wa0 = *(const f32x4*)(cw + col), wa1 = *(const f32x4*)(cw + col + 4), wb0 = *(const f32x4*)(cw + 1536 + col), wb1 = *(const f32x4*)(cw + 1536 + col + 4),
                        wc0 = *(const f32x4*)(cw + 3072 + col), wc1 = *(const f32x4*)(cw + 3072 + col + 4);
            const unsigned xa[4] = {x0.x, x0.y, x0.z, x0.w}, xb[4] = {x1.x, x1.y, x1.z, x1.w}, xc[4] = {x2.x, x2.y, x2.z, x2.w};
#pragma unroll
            for (int q = 0; q < 4; ++q) { const f32x4& wa = q < 2 ? wa0 : wa1; const f32x4& wb = q < 2 ? wb0 : wb1; const f32x4& wc = q < 2 ? wc0 : wc1; const int e2 = (2 * q) & 3;
                const float v0 = siluf_(wa[e2] * bflo(xa[q]) + wb[e2] * bflo(xb[q]) + wc[e2] * bflo(xc[q])), v1 = siluf_(wa[e2 + 1] * bfhi(xa[q]) + wb[e2 + 1] * bfhi(xb[q]) + wc[e2 + 1] * bfhi(xc[q]));
                y[ks][2 * q] = v0; y[ks][2 * q + 1] = v1; ss += v0 * v0 + v1 * v1; }
            if (ks == 1) asm volatile("" ::: "memory");
        }
        float sc = 1.0f;
        if (seg < 2) { ss += shx(ss, 16); ss += shx(ss, 32); sc = 1.0f / sqrtf(ss + EPS); if (seg == 0) sc *= 0.08838834764831845f; }
#pragma unroll
        for (int ks = 0; ks < 4; ++ks) { union { bf16x8 v; u32x4 w; } f;
            f.w.x = pk2(y[ks][0] * sc, y[ks][1] * sc); f.w.y = pk2(y[ks][2] * sc, y[ks][3] * sc); f.w.z = pk2(y[ks][4] * sc, y[ks][5] * sc); f.w.w = pk2(y[ks][6] * sc, y[ks][7] * sc);
            F[ks] = f.v;
            if (dir == 0) *(u32x4*)(DN + r * 1536 + seg * 512 + h * 128 + 32 * ks + 8 * g) = f.w; }
    };
#pragma unroll 1
    for (int mt = 0; mt < 4; ++mt) { bf16x8 F[4]; conv_frag(1, mt, F);
#pragma unroll
        for (int ks = 0; ks < 4; ++ks) *(bf16x8*)(Kc + (16 * mt + i16) * KCP + 32 * ks + 8 * g) = F[ks]; }
    if (dir == 0) {
#pragma unroll 1
        for (int mt = 0; mt < 4; ++mt) { bf16x8 F[4]; conv_frag(2, mt, F); } }
    asm volatile("s_waitcnt lgkmcnt(0)" ::: "memory");
#pragma unroll 1
    for (int mt = 0; mt < 4; ++mt) {
        bf16x8 A[4];
#pragma unroll
        for (int ks = 0; ks < 4; ++ks) A[ks] = *(const bf16x8*)(Kc + (16 * mt + i16) * KCP + 32 * ks + 8 * g);
#pragma unroll 1
        for (int nt = 0; nt <= mt; ++nt) { f32x4 acc = (f32x4){0.f, 0.f, 0.f, 0.f};
#pragma unroll
            for (int ks = 0; ks < 4; ++ks) acc = __builtin_amdgcn_mfma_f32_16x16x32_bf16(A[ks], *(const bf16x8*)(Kc + (16 * nt + i16) * KCP + 32 * ks + 8 * g), acc, 0, 0, 0);
            const int j = 16 * nt + i16; const float gj = gcs[j]; f32x4 lv;
#pragma unroll
            for (int rg = 0; rg < 4; ++rg) { const int i = 16 * mt + 4 * g + rg; lv[rg] = i > j ? bes[i] * acc[rg] * __expf(gcs[i] - gj) : 0.f; }
            *(f32x4*)(Ls + j * 64 + 16 * mt + 4 * g) = lv; }
    }
    bf16_t* QKg = (bf16_t*)(p.ws + WS_TQ + (size_t)item * 16384 + 8192);
#pragma unroll 1
    for (int mt = 0; mt < 4; ++mt) { bf16x8 Qf[4]; conv_frag(0, mt, Qf);
#pragma unroll 1
        for (int nt = 0; nt < 4; ++nt) { f32x4 acc = (f32x4){0.f, 0.f, 0.f, 0.f}; const int j = 16 * nt + i16;
            if (nt <= mt) {
#pragma unroll
                for (int ks = 0; ks < 4; ++ks) acc = __builtin_amdgcn_mfma_f32_16x16x32_bf16(Qf[ks], *(const bf16x8*)(Kc + (16 * nt + i16) * KCP + 32 * ks + 8 * g), acc, 0, 0, 0);
                const float gj = gcs[j];
#pragma unroll
                for (int rg = 0; rg < 4; ++rg) { const int i = 16 * mt + 4 * g + rg; acc[rg] = i >= j ? acc[rg] * __expf(gcs[i] - gj) : 0.f; } }
#pragma unroll
            for (int rg = 0; rg < 4; ++rg) QKg[(16 * mt + 4 * g + rg) * 64 + j] = (bf16_t)f2bf(acc[rg]); } }
    asm volatile("s_waitcnt lgkmcnt(0)" ::: "memory");
#pragma unroll 1
    for (int B = 0; B < 4; ++B) {
        float s[16];
#pragma unroll
        for (int ii = 0; ii < 16; ++ii) s[ii] = (16 * B + ii == lane) ? 1.f : 0.f;
#pragma unroll 2
        for (int j = 0; j < 16 * B; ++j) { const float tj = Tl[j * 64 + lane]; const float* lc = Ls + j * 64 + 16 * B;
            const f32x4 l0 = *(const f32x4*)lc, l1 = *(const f32x4*)(lc + 4), l2 = *(const f32x4*)(lc + 8), l3 = *(const f32x4*)(lc + 12);
#pragma unroll
            for (int q = 0; q < 4; ++q) { s[q] -= l0[q] * tj; s[4 + q] -= l1[q] * tj; s[8 + q] -= l2[q] * tj; s[12 + q] -= l3[q] * tj; } }
#pragma unroll
        for (int jj = 0; jj < 16; ++jj) { const float tj = s[jj]; Tl[(16 * B + jj) * 64 + lane] = tj; const float* lc = Ls + (16 * B + jj) * 64 + 16 * B;
            const f32x4 l0 = *(const f32x4*)lc, l1 = *(const f32x4*)(lc + 4), l2 = *(const f32x4*)(lc + 8), l3 = *(const f32x4*)(lc + 12);
#pragma unroll
            for (int q = 0; q < 4; ++q) { if (q > jj) s[q] -= l0[q] * tj; if (4 + q > jj) s[4 + q] -= l1[q] * tj; if (8 + q > jj) s[8 + q] -= l2[q] * tj; if (12 + q > jj) s[12 + q] -= l3[q] * tj; } }
        asm volatile("s_waitcnt lgkmcnt(0)" ::: "memory");
    }
    asm volatile("s_waitcnt lgkmcnt(0)" ::: "memory");
    bf16_t* Tg = (bf16_t*)(p.ws + WS_TQ + (size_t)item * 16384);
    for (int i = 0; i < 64; ++i) Tg[i * 64 + lane] = (bf16_t)f2bf(Tl[i * 64 + lane]);
    asm volatile("s_waitcnt lgkmcnt(0)" ::: "memory");
}

__device__ __forceinline__ void dn_chain_mfma(const P& p, int item, unsigned char* lds) {
    const int b = item >> 3, h = (item >> 1) & 3, dir = item & 1, tid = otid(), lane = tid & 63, w = tid >> 6, i16 = lane & 15, g = lane >> 4;
    constexpr int KP = 136, TP = 72;
    bf16_t* Ks = (bf16_t*)lds; bf16_t* Qs = Ks + 64 * KP; bf16_t* Vs = Qs + 64 * KP; bf16_t* Ts = Vs + 64 * KP; bf16_t* QKs = Ts + 64 * TP; float* vec = (float*)(QKs + 64 * TP);
    const bf16_t* DN = (const bf16_t*)(p.ws + WS_DNQKV); bf16_t* OA = (bf16_t*)(p.ws + WS_H) + (size_t)dir * T * 512;
    f32x4 S[8];
#pragma unroll
    for (int dt = 0; dt < 8; ++dt) S[dt] = (f32x4){0.f, 0.f, 0.f, 0.f};
    u32x4 pf[9];
    auto prefetch = [&](int n) {
        const int pitem = item * DN_NCH + n;
#pragma unroll
        for (int u = 0; u < 6; ++u) { const int q = tid + 512 * u, which = q >> 10, rem = q & 1023, s = rem >> 4, ch = rem & 15;
            pf[u] = *(const u32x4*)(DN + (size_t)dn_row(n, s, b, dir) * 1536 + (which == 0 ? 512 : which == 1 ? 0 : 1024) + h * 128 + ch * 8); }
#pragma unroll
        for (int u = 0; u < 2; ++u) pf[6 + u] = *(const u32x4*)(p.ws + WS_TQ + (size_t)pitem * 16384 + (size_t)u * 8192 + (size_t)tid * 16);
        if (tid < 64) pf[8] = *(const u32x4*)((const float*)(p.ws + WS_VEC) + (size_t)pitem * 256 + tid * 4);
    };
    prefetch(0);
    for (int n = 0; n < DN_NCH; ++n) {
        __syncthreads();
#pragma unroll
        for (int u = 0; u < 6; ++u) { const int q = tid + 512 * u, which = q >> 10, rem = q & 1023, s = rem >> 4, ch = rem & 15;
            *(u32x4*)((which == 0 ? Ks : which == 1 ? Qs : Vs) + s * KP + ch * 8) = pf[u]; }
#pragma unroll
        for (int u = 0; u < 2; ++u) *(u32x4*)((u == 0 ? Ts : QKs) + (tid >> 3) * TP + (tid & 7) * 8) = pf[6 + u];
        if (tid < 64) *(u32x4*)(vec + tid * 4) = pf[8];
        __syncthreads();
        if (n + 1 < DN_NCH) prefetch(n + 1);
        const float* egv = vec; const float* eklv = vec + 64; const float* bev = vec + 128; const float glast = vec[192];
        bf16x8 Sb[4];
#pragma unroll
        for (int ks = 0; ks < 4; ++ks) Sb[ks] = pack8(S[2 * ks], S[2 * ks + 1]);
        f32x4 r_[4], o_[4];
#pragma unroll
        for (int mt = 0; mt < 4; ++mt) { r_[mt] = (f32x4){0.f, 0.f, 0.f, 0.f}; o_[mt] = (f32x4){0.f, 0.f, 0.f, 0.f};
            const bf16_t* kr = Ks + (16 * mt + i16) * KP + 4 * g; const bf16_t* qr = Qs + (16 * mt + i16) * KP + 4 * g;
#pragma unroll
            for (int ks = 0; ks < 4; ++ks) { const bf16x8 ak = cat8(*(const s16x4*)(kr + 32 * ks), *(const s16x4*)(kr + 32 * ks + 16)), aq = cat8(*(const s16x4*)(qr + 32 * ks), *(const s16x4*)(qr + 32 * ks + 16));
                r_[mt] = __builtin_amdgcn_mfma_f32_16x16x32_bf16(ak, Sb[ks], r_[mt], 0, 0, 0); o_[mt] = __builtin_amdgcn_mfma_f32_16x16x32_bf16(aq, Sb[ks], o_[mt], 0, 0, 0); } }
        f32x4 eg[4];
#pragma unroll
        for (int mt = 0; mt < 4; ++mt) { eg[mt] = *(const f32x4*)(egv + 16 * mt + 4 * g); const f32x4 be = *(const f32x4*)(bev + 16 * mt + 4 * g);
#pragma unroll
            for (int rg = 0; rg < 4; ++rg) { const float v = bf2f(Vs[(16 * mt + 4 * g + rg) * KP + 16 * w + i16]); r_[mt][rg] = be[rg] * (v - eg[mt][rg] * r_[mt][rg]); o_[mt][rg] *= eg[mt][rg]; } }
        bf16x8 Rb[2];
#pragma unroll
        for (int k2 = 0; k2 < 2; ++k2) Rb[k2] = pack8(r_[2 * k2], r_[2 * k2 + 1]);
        f32x4 vn[4];
#pragma unroll
        for (int mt = 0; mt < 4; ++mt) { vn[mt] = (f32x4){0.f, 0.f, 0.f, 0.f}; const bf16_t* tr = Ts + (16 * mt + i16) * TP + 4 * g;
#pragma unroll
            for (int k2 = 0; k2 < 2; ++k2) vn[mt] = __builtin_amdgcn_mfma_f32_16x16x32_bf16(cat8(*(const s16x4*)(tr + 32 * k2), *(const s16x4*)(tr + 32 * k2 + 16)), Rb[k2], vn[mt], 0, 0, 0); }
        bf16x8 Vb[2], Wb[2];
#pragma unroll
        for (int k2 = 0; k2 < 2; ++k2) { Vb[k2] = pack8(vn[2 * k2], vn[2 * k2 + 1]);
            const f32x4 e0 = *(const f32x4*)(eklv + 32 * k2 + 4 * g), e1 = *(const f32x4*)(eklv + 32 * k2 + 16 + 4 * g); Wb[k2] = pack8(vn[2 * k2] * e0, vn[2 * k2 + 1] * e1); }
#pragma unroll
        for (int mt = 0; mt < 4; ++mt) { const bf16_t* qkr = QKs + (16 * mt + i16) * TP + 4 * g;
#pragma unroll
            for (int k2 = 0; k2 < 2; ++k2) o_[mt] = __builtin_amdgcn_mfma_f32_16x16x32_bf16(cat8(*(const s16x4*)(qkr + 32 * k2), *(const s16x4*)(qkr + 32 * k2 + 16)), Vb[k2], o_[mt], 0, 0, 0); }
#pragma unroll
        for (int dt = 0; dt < 8; ++dt) { S[dt] = S[dt] * glast;
#pragma unroll
            for (int k2 = 0; k2 < 2; ++k2) { const bf16_t* a0 = Ks + (32 * k2 + 4 * g + (i16 >> 2)) * KP + 16 * dt + 4 * (i16 & 3);
                S[dt] = __builtin_amdgcn_mfma_f32_16x16x32_bf16(cat8(lds_tr(a0), lds_tr(a0 + 16 * KP)), Wb[k2], S[dt], 0, 0, 0); } }
#pragma unroll
        for (int mt = 0; mt < 4; ++mt)
#pragma unroll
            for (int rg = 0; rg < 4; ++rg) OA[(size_t)dn_row(n, 16 * mt + 4 * g + rg, b, dir) * 512 + h * 128 + 16 * w + i16] = (bf16_t)f2bf(o_[mt][rg]);
    }
}

__device__ __forceinline__ void phase_prep(const P& p, int l, unsigned char* lds, int gw, int NGW, int lane) {
    unsigned char* ws = p.ws;
    bf16_t* PC = (bf16_t*)(ws + WS_PC); unsigned* ctl = (unsigned*)(ws + WS_CTL);
    const int wv = gw % NWAVES, blk = gw / NWAVES, G_ = NGW / NWAVES;
    if (wv < 4) { for (int rep = 0; rep < REP_DNPREP; ++rep) for (int it = blk * 4 + wv; it < DN_ITEMS; it += G_ * 4) dn_prep_item(p, l, it, lds + wv * PREP_WLDS, lane); return; }
    const int gt = (blk * 4 + (wv - 4)) * 64 + lane, NGT = G_ * 4 * 64;
    float kmx = 0.f; int kbb = -1, kh = 0, km = 0;
    for (long i = gt; i < (long)T * 512; i += NGT) {
        const int r = (int)(i >> 9), q = (int)(i & 511), seg = q >> 8, h = (q >> 6) & 3, m = (q >> 5) & 1, pi = q & 31;
        const int half = pi >> 4, fi = pi & 15, d1 = half * 32 + fi, d2 = d1 + 16;
        bf16_t* base = PC + (size_t)r * 1536 + seg * 512 + h * 128 + m * 64;
        float x1 = bf2f(base[d1]), x2 = bf2f(base[d2]);
        const bool lat = r < TL; const int b = lat ? r / SEQ : (r - TL) / CTXL;
        if (lat) { const int t = r % SEQ; const float pos = half ? (float)(t & 63) : (float)(t >> 6);
            const float ang = pos * exp2f(-(float)fi * 0.8304820237218406f);
            float sn, cs; sincosf(ang, &sn, &cs);
            const float o1 = x1 * cs - x2 * sn, o2 = x2 * cs + x1 * sn; x1 = o1; x2 = o2; }
        if (seg == 0) { x1 *= 0.125f; x2 *= 0.125f; }
        const bf16_t r1 = (bf16_t)f2bf(x1), r2 = (bf16_t)f2bf(x2);
        if (lat || seg == 0) { base[d1] = r1; base[d2] = r2; }
        float ss = bf2f(r1) * bf2f(r1) + bf2f(r2) * bf2f(r2);
#pragma unroll
        for (int o = 1; o < 32; o <<= 1) ss += shx(ss, o);
        if (seg == 1) {
            if (b != kbb) { if (kbb >= 0 && (lane & 31) == 0) atomicMax(ctl + CW_KMAX + l * 64 + (kbb * 4 + kh) * 2 + km, __builtin_bit_cast(unsigned, sqrtf(kmx))); kbb = b; kmx = 0.f; }
            kh = h; km = m; kmx = fmaxf(kmx, ss); }
    }
    if (kbb >= 0 && (lane & 31) == 0) atomicMax(ctl + CW_KMAX + l * 64 + (kbb * 4 + kh) * 2 + km, __builtin_bit_cast(unsigned, sqrtf(kmx)));
    if (blk == 0 && wv == 4) { float a = 0.f, bq = 0.f; const float* lc = p.lam_c + (size_t)l * 256;
        a = wave_sum(lc[lane] * lc[64 + lane]); bq = wave_sum(lc[128 + lane] * lc[192 + lane]);
        const float lam_init = 0.8f - 0.6f * expf(-0.3f * (float)l);
        if (lane == 0) ((float*)(ws + WS_MISC))[MI_LAMF + l] = expf(a) - expf(bq) + lam_init; }
}

__device__ __forceinline__ void dn_chain(const P& p, int item, unsigned char* lds) {
    const int b = item >> 3, h = (item >> 1) & 3, dir = item & 1, tid = otid(), c = tid >> 2, ks = tid & 3;
    const bf16_t* DN = (const bf16_t*)(p.ws + WS_DNQKV); const float* GB = (const float*)(p.ws + WS_GB);
    bf16_t* OA = (bf16_t*)(p.ws + WS_H) + (size_t)dir * T * 512;
    constexpr int TB = 32;
    float* qs = (float*)lds; float* ksm = qs + TB * 128; float* vs = ksm + TB * 128; float* gs = vs + TB * 128; float* bs = gs + TB; float* ob = bs + TB;
    float S[32];
#pragma unroll
    for (int i = 0; i < 32; ++i) S[i] = 0.f;
    for (int part = 0; part < 2; ++part) {
        const int L = part == 0 ? CTXL : SEQ; const int rbase = part == 0 ? TL + b * CTXL : b * SEQ;
        for (int t0 = 0; t0 < L; t0 += TB) {
            __syncthreads();
            for (int i = tid; i < 3 * TB * 16; i += NTHREADS) { const int which = i / (TB * 16), rem = i % (TB * 16), tt = rem >> 4, ch = rem & 15;
                const int s = t0 + tt, t = dir ? L - 1 - s : s;
                const u32x4 w = *(const u32x4*)(DN + (size_t)(rbase + t) * 1536 + which * 512 + h * 128 + ch * 8);
                float* dst = (which == 0 ? qs : which == 1 ? ksm : vs) + tt * 128 + ch * 8;
                dst[0] = bflo(w.x); dst[1] = bfhi(w.x); dst[2] = bflo(w.y); dst[3] = bfhi(w.y); dst[4] = bflo(w.z); dst[5] = bfhi(w.z); dst[6] = bflo(w.w); dst[7] = bfhi(w.w); }
            if (tid < TB) { const int s = t0 + tid, t = dir ? L - 1 - s : s; gs[tid] = expf(GB[(size_t)(rbase + t) * 16 + dir * 4 + h]); bs[tid] = GB[(size_t)(rbase + t) * 16 + 8 + dir * 4 + h]; }
            __syncthreads();
            for (int tt = 0; tt < TB; ++tt) {
                const float eg = gs[tt], be = bs[tt];
                const float* kr = ksm + tt * 128 + ks * 32; const float* qr = qs + tt * 128 + ks * 32;
                float r = 0.f;
#pragma unroll
                for (int i = 0; i < 32; ++i) r += kr[i] * S[i];
                r += shx(r, 1); r += shx(r, 2);
                const float vn = be * (vs[tt * 128 + c] - eg * r);
                float o = 0.f;
#pragma unroll
                for (int i = 0; i < 32; ++i) { S[i] = eg * S[i] + kr[i] * vn; o += qr[i] * S[i]; }
                o += shx(o, 1); o += shx(o, 2);
                if (ks == 0) ob[tt * 128 + c] = o;
            }
            __syncthreads();
            for (int i = tid; i < TB * 64; i += NTHREADS) { const int tt = i >> 6, cp = i & 63; const int s = t0 + tt, t = dir ? L - 1 - s : s;
                *(unsigned*)(OA + (size_t)(rbase + t) * 512 + h * 128 + 2 * cp) = pk2(ob[tt * 128 + 2 * cp], ob[tt * 128 + 2 * cp + 1]); }
        }
    }
}
__device__ __forceinline__ void gla_chain_mfma(const P& p, int l, int item, unsigned char* lds) {
    const int b = item >> 3, h = (item >> 1) & 3, dir = item & 1, tid = otid(), lane = tid & 63, w = tid >> 6, i16 = lane & 15, g = lane >> 4;
    constexpr int RP = 72, VP = 72, OP = 136;
    bf16_t* qraw = (bf16_t*)lds;
    bf16_t* kraw = qraw + 64 * RP;
    bf16_t* Qt = kraw + 64 * RP;
    bf16_t* Kt = Qt + 64 * RP;
    bf16_t* KgT = Kt + 64 * RP;
    bf16_t* As = KgT + 64 * RP;
    bf16_t* Vt = As + 64 * RP;
    bf16_t* Os = Vt + 128 * VP;
    float* glr = (float*)(Os + 64 * OP);
    float* gts = glr + 64 * 16;
    float* gls = gts + 8 * 64;
    const bf16_t* PB = (const bf16_t*)(p.ws + WS_PB); const float* SMALL = (const float*)(p.ws + WS_SMALL);
    bf16_t* OB = (bf16_t*)(p.ws + WS_PAQ) + (size_t)dir * T * 512;
    float wgc[16];
#pragma unroll
    for (int j = 0; j < 16; ++j) wgc[j] = p.w_gate2[((size_t)l * 2 + dir) * 16 * 256 + j * 256 + h * 64 + lane];
    const float bgc = p.b_gate[((size_t)l * 2 + dir) * 256 + h * 64 + lane];
    f32x4 S[4];
#pragma unroll
    for (int dt = 0; dt < 4; ++dt) S[dt] = (f32x4){0.f, 0.f, 0.f, 0.f};
    __syncthreads();
    for (int i = tid; i < 64 * RP / 2; i += NTHREADS) ((unsigned*)As)[i] = 0u;
    u32x4 pf[5];
    auto prefetch = [&](int n) {
        { const int s = tid >> 3, ch = tid & 7; const size_t row = (size_t)dn_row(n, s, b, dir);
          pf[0] = *(const u32x4*)(PB + row * 1536 + h * 64 + ch * 8); pf[1] = *(const u32x4*)(PB + row * 1536 + 256 + h * 64 + ch * 8); }
#pragma unroll
        for (int u = 0; u < 2; ++u) { const int q = tid + 512 * u, s = q >> 4, ch = q & 15; pf[2 + u] = *(const u32x4*)(PB + (size_t)dn_row(n, s, b, dir) * 1536 + 512 + h * 128 + ch * 8); }
        if (tid < 256) { const int s = tid >> 2, ch = tid & 3; pf[4] = *(const u32x4*)(SMALL + (size_t)dn_row(n, s, b, dir) * 64 + 16 + dir * 16 + ch * 4); }
    };
    prefetch(0);
    for (int n = 0; n < DN_NCH; ++n) {
        __syncthreads();
        { const int s = tid >> 3, ch = tid & 7; *(u32x4*)(qraw + s * RP + ch * 8) = pf[0]; *(u32x4*)(kraw + s * RP + ch * 8) = pf[1]; }
#pragma unroll
        for (int u = 0; u < 2; ++u) { const int q = tid + 512 * u, s = q >> 4, ch = q & 15; const u32x4 v = pf[2 + u]; bf16_t* d = Vt + (ch * 8) * VP + s;
            d[0] = (bf16_t)v.x; d[VP] = (bf16_t)(v.x >> 16); d[2 * VP] = (bf16_t)v.y; d[3 * VP] = (bf16_t)(v.y >> 16); d[4 * VP] = (bf16_t)v.z; d[5 * VP] = (bf16_t)(v.z >> 16); d[6 * VP] = (bf16_t)v.w; d[7 * VP] = (bf16_t)(v.w >> 16); }
        if (tid < 256) *(u32x4*)(glr + tid * 4) = pf[4];
        __syncthreads();
        if (n + 1 < DN_NCH) prefetch(n + 1);
        float gcl[8];
        { float run = 0.f;
#pragma unroll
          for (int u = 0; u < 8; ++u) { const float* gr = glr + (8 * w + u) * 16; float z = bgc;
#pragma unroll
              for (int j = 0; j < 16; ++j) z += gr[j] * wgc[j];
              run += logsigmoidf_(z) * 0.0625f; gcl[u] = run; }
          gts[w * 64 + lane] = run; }
        __syncthreads();
        { float pre = 0.f, tot = 0.f;
#pragma unroll
          for (int q = 0; q < 8; ++q) { const float t_ = gts[q * 64 + lane]; tot += t_; if (q < w) pre += t_; }
          unsigned kgp[4];
#pragma unroll
          for (int u = 0; u < 8; ++u) { const float gc = pre + gcl[u]; const float qv = bf2f(qraw[(8 * w + u) * RP + lane]), kv = bf2f(kraw[(8 * w + u) * RP + lane]);
              Qt[(8 * w + u) * RP + lane] = (bf16_t)f2bf(0.125f * qv * __expf(gc)); Kt[(8 * w + u) * RP + lane] = (bf16_t)f2bf(kv * __expf(-gc));
              const unsigned kgb = f2bf(kv * __expf(tot - gc)); if (u & 1) kgp[u >> 1] |= kgb << 16; else kgp[u >> 1] = kgb; }
          *(u32x4*)(KgT + lane * RP + 8 * w) = (u32x4){kgp[0], kgp[1], kgp[2], kgp[3]};
          if (w == 0) gls[lane] = __expf(tot); }
        __syncthreads();
#pragma unroll
        for (int rep = 0; rep < 2; ++rep) { const int tix = w + 8 * rep;
            if (tix < 10) { const int mt = tix < 1 ? 0 : tix < 3 ? 1 : tix < 6 ? 2 : 3, nt = tix - (mt * (mt + 1)) / 2;
                f32x4 acc = (f32x4){0.f, 0.f, 0.f, 0.f};
#pragma unroll
                for (int ks = 0; ks < 2; ++ks) acc = __builtin_amdgcn_mfma_f32_16x16x32_bf16(*(const bf16x8*)(Qt + (16 * mt + i16) * RP + 32 * ks + 8 * g), *(const bf16x8*)(Kt + (16 * nt + i16) * RP + 32 * ks + 8 * g), acc, 0, 0, 0);
                const int j = 16 * nt + i16;
#pragma unroll
                for (int rg = 0; rg < 4; ++rg) { const int i = 16 * mt + 4 * g + rg; As[i * RP + j] = (bf16_t)f2bf(i >= j ? acc[rg] : 0.f); } } }
        __syncthreads();
        { bf16x8 Sb[2];
#pragma unroll
          for (int ks = 0; ks < 2; ++ks) Sb[ks] = pack8(S[2 * ks], S[2 * ks + 1]);
          bf16x8 Vb[2];
#pragma unroll
          for (int ks = 0; ks < 2; ++ks) Vb[ks] = *(const bf16x8*)(Vt + (16 * w + i16) * VP + 32 * ks + 8 * g);
#pragma unroll
          for (int mt = 0; mt < 4; ++mt) { f32x4 o = (f32x4){0.f, 0.f, 0.f, 0.f}; const bf16_t* qr = Qt + (16 * mt + i16) * RP + 4 * g; const bf16_t* ar = As + (16 * mt + i16) * RP + 8 * g;
#pragma unroll
              for (int ks = 0; ks < 2; ++ks) { o = __builtin_amdgcn_mfma_f32_16x16x32_bf16(cat8(*(const s16x4*)(qr + 32 * ks), *(const s16x4*)(qr + 32 * ks + 16)), Sb[ks], o, 0, 0, 0);
                  o = __builtin_amdgcn_mfma_f32_16x16x32_bf16(*(const bf16x8*)(ar + 32 * ks), Vb[ks], o, 0, 0, 0); }
#pragma unroll
              for (int rg = 0; rg < 4; ++rg) Os[(16 * mt + 4 * g + rg) * OP + 16 * w + i16] = (bf16_t)f2bf(o[rg]); }
#pragma unroll
          for (int dt = 0; dt < 4; ++dt) { const f32x4 gl = *(const f32x4*)(gls + 16 * dt + 4 * g); S[dt] = S[dt] * gl;
#pragma unroll
              for (int ks = 0; ks < 2; ++ks) S[dt] = __builtin_amdgcn_mfma_f32_16x16x32_bf16(*(const bf16x8*)(KgT + (16 * dt + i16) * RP + 32 * ks + 8 * g), Vb[ks], S[dt], 0, 0, 0); } }
        __syncthreads();
#pragma unroll
        for (int u = 0; u < 2; ++u) { const int q = tid + 512 * u, s = q >> 4, ch = q & 15;
            *(u32x4*)(OB + (size_t)dn_row(n, s, b, dir) * 512 + h * 128 + ch * 8) = *(const u32x4*)(Os + s * OP + ch * 8); }
    }
}
__device__ __forceinline__ void attn_tile(const P& p, int l, int b, int h, int qrow0  , bool ctxq, unsigned char* lds, bool do_store = true) {
    constexpr int QP = 72, KP = 72, VP = 136;
    bf16_t* Qs = (bf16_t*)lds;
    bf16_t* Ks = Qs + 2 * 128 * QP;
    bf16_t* Vs = Ks + 2 * 64 * KP;
    float* Oex = (float*)lds;
    bf16_t* PC = (bf16_t*)(p.ws + WS_PC);
    const int tid = otid(), lane = tid & 63, w = tid >> 6, m = w & 1, rg = w >> 1, q31 = lane & 31, hi = lane >> 5, i16 = lane & 15, gg = lane >> 4;
    const int nkt = ctxq ? CTXL / 64 : (CTXL + SEQ) / 64;
    u32x4 pk_[2], pv_[2];
    auto prefetch = [&](int kt) { const int krow0 = kt < CTXL / 64 ? TL + b * CTXL + kt * 64 : b * SEQ + (kt - CTXL / 64) * 64;
#pragma unroll
        for (int u = 0; u < 2; ++u) { const int i = tid + 512 * u, r = i >> 4, ch = i & 15; const bf16_t* rowp = PC + (size_t)(krow0 + r) * 1536 + h * 128 + ch * 8;
            pk_[u] = *(const u32x4*)(rowp + 512); pv_[u] = *(const u32x4*)(rowp + 1024); } };
    prefetch(0);
    __syncthreads();
    for (int i = tid; i < 128 * 16; i += NTHREADS) { const int r = i >> 4, ch = i & 15, mm = ch >> 3, c8 = (ch & 7) * 8;
        *(u32x4*)(Qs + (mm * 128 + r) * QP + c8) = *(const u32x4*)(PC + (size_t)(qrow0 + r) * 1536 + h * 128 + ch * 8); }
    __syncthreads();
    const bf16_t* qrow = Qs + (m * 128 + rg * 32 + q31) * QP;
    bf16x8 bq[4]; float qn = 0.f;
#pragma unroll
    for (int kk = 0; kk < 4; ++kk) bq[kk] = *(const bf16x8*)(qrow + 16 * kk + 8 * hi);
#pragma unroll
    for (int d8 = 0; d8 < 8; ++d8) { const u32x4 q4 = *(const u32x4*)(qrow + 8 * d8);
        qn += bflo(q4.x) * bflo(q4.x) + bfhi(q4.x) * bfhi(q4.x) + bflo(q4.y) * bflo(q4.y) + bfhi(q4.y) * bfhi(q4.y) + bflo(q4.z) * bflo(q4.z) + bfhi(q4.z) * bfhi(q4.z) + bflo(q4.w) * bflo(q4.w) + bfhi(q4.w) * bfhi(q4.w); }
    const float kmax = __builtin_bit_cast(float, ((const unsigned*)(p.ws + WS_CTL))[CW_KMAX + l * 64 + (b * 4 + h) * 2 + m]);
    const float mrow = sqrtf(qn) * kmax * 1.002f + 1e-3f;
    f32x16 o[4]; float lsum = 0.f;
#pragma unroll
    for (int dt = 0; dt < 4; ++dt)
#pragma unroll
        for (int r = 0; r < 16; ++r) o[dt][r] = 0.f;
    for (int kt = 0; kt < nkt; ++kt) {
        __syncthreads();
#pragma unroll
        for (int u = 0; u < 2; ++u) { const int i = tid + 512 * u, r = i >> 4, ch = i & 15, mm = ch >> 3, c8 = (ch & 7) * 8;
            *(u32x4*)(Ks + (mm * 64 + r) * KP + c8) = pk_[u]; *(u32x4*)(Vs + r * VP + ch * 8) = pv_[u]; }
        __syncthreads();
        if (kt + 1 < nkt) prefetch(kt + 1);
        f32x16 s[2];
#pragma unroll
        for (int kh = 0; kh < 2; ++kh) {
#pragma unroll
            for (int r = 0; r < 16; ++r) s[kh][r] = 0.f;
#pragma unroll
            for (int kk = 0; kk < 4; ++kk) { const bf16x8 a = *(const bf16x8*)(Ks + (m * 64 + kh * 32 + q31) * KP + 16 * kk + 8 * hi);
                s[kh] = __builtin_amdgcn_mfma_f32_32x32x16_bf16(a, bq[kk], s[kh], 0, 0, 0); }
#pragma unroll
            for (int r = 0; r < 16; ++r) { const float ev = __expf(s[kh][r] - mrow); s[kh][r] = ev; lsum += ev; }
        }
#pragma unroll
        for (int st = 0; st < 4; ++st) {
            const int kh = st >> 1, r0 = 8 * (st & 1);
            union { bf16x8 v; unsigned u[4]; } bp;
            bp.u[0] = pk2(s[kh][r0 + 0], s[kh][r0 + 1]); bp.u[1] = pk2(s[kh][r0 + 2], s[kh][r0 + 3]); bp.u[2] = pk2(s[kh][r0 + 4], s[kh][r0 + 5]); bp.u[3] = pk2(s[kh][r0 + 6], s[kh][r0 + 7]);
            const bf16_t* v0 = Vs + (16 * st + 4 * hi + (i16 >> 2)) * VP + 16 * (gg & 1) + 4 * (i16 & 3);
#pragma unroll
            for (int dt = 0; dt < 4; ++dt)
                o[dt] = __builtin_amdgcn_mfma_f32_32x32x16_bf16(cat8(lds_tr(v0 + 32 * dt), lds_tr(v0 + 32 * dt + 8 * VP)), bp.v, o[dt], 0, 0, 0);
        }
    }
    lsum += shx(lsum, 32);
    const float lamf = ((const float*)(p.ws + WS_MISC))[MI_LAMF + l];
    const float sc = (m == 0 ? 1.0f : lamf) / lsum;
    __syncthreads();
    float* ox = Oex + (rg * 32 + q31) * 132;
    if (m == 1) {
#pragma unroll
        for (int dt = 0; dt < 4; ++dt)
#pragma unroll
            for (int r = 0; r < 16; ++r) ox[dt * 32 + (r & 3) + 8 * (r >> 2) + 4 * hi] = o[dt][r] * sc;
    }
    __syncthreads();
    if (m == 0) {
        float ss = 0.f;
#pragma unroll
        for (int dt = 0; dt < 4; ++dt)
#pragma unroll
            for (int r = 0; r < 16; ++r) { const float v = o[dt][r] * sc - ox[dt * 32 + (r & 3) + 8 * (r >> 2) + 4 * hi]; o[dt][r] = v; ss += v * v; }
        ss += shx(ss, 32);
        const float lam_init = 0.8f - 0.6f * expf(-0.3f * (float)l);
        const float rs = (1.0f - lam_init) / sqrtf(ss * (1.0f / 128.0f) + EPS);
        const float* gn = p.gn_c + l * 128;
        bf16_t* orow = PC + (size_t)(qrow0 + rg * 32 + q31) * 1536 + h * 128;
#pragma unroll
        for (int dt = 0; dt < 4; ++dt)
#pragma unroll
            for (int g4 = 0; g4 < 4; ++g4) { const int dv = dt * 32 + 8 * g4 + 4 * hi; const f32x4 gv = *(const f32x4*)(gn + dv);
                u32x2 wv; wv.x = pk2(o[dt][4 * g4 + 0] * rs * gv[0], o[dt][4 * g4 + 1] * rs * gv[1]); wv.y = pk2(o[dt][4 * g4 + 2] * rs * gv[2], o[dt][4 * g4 + 3] * rs * gv[3]);
                if (do_store) *(u32x2*)(orow + dv) = wv; }
    }
}
__device__ __forceinline__ void phase_mix(const P& p, int l, unsigned char* lds) {
    unsigned* qhead = (unsigned*)(p.ws + WS_CTL) + CW_QUEUE + 64 * l;
    volatile int* slot = (volatile int*)(lds + LDS_BYTES - 64);
    const int n_att_l = BATCH * 4 * (SEQ / 128), n_att_c = (l == 0) ? BATCH * 4 * (CTXL / 128) : 0;
    const int total = 128 + n_att_l + n_att_c;
    for (;;) {
        __syncthreads();
        if (otid() == 0) *slot = (int)atomicAdd(qhead, 1u);
        __syncthreads();
        const int it = *slot;
        if (it >= total) break;
        if (it < 64) { for (int rep = 0; rep < REP_CHAIN; ++rep) dn_chain_mfma(p, it, lds); }
        else if (it < 128) { for (int rep = 0; rep < REP_CHAIN; ++rep) gla_chain_mfma(p, l, it - 64, lds); }
        else if (it < 128 + n_att_l) { const int a = it - 128, b = a / (4 * (SEQ / 128)), rem = a % (4 * (SEQ / 128)), h = rem / (SEQ / 128), qt = rem % (SEQ / 128);
            for (int rep = 1; rep < REP_ATT; ++rep) attn_tile(p, l, b, h, b * SEQ + qt * 128, false, lds, false);
            attn_tile(p, l, b, h, b * SEQ + qt * 128, false, lds); }
        else { const int a = it - 128 - n_att_l, b = a / (4 * (CTXL / 128)), rem = a % (4 * (CTXL / 128)), h = rem / (CTXL / 128), qt = rem % (CTXL / 128);
            attn_tile(p, l, b, h, TL + b * CTXL + qt * 128, true, lds); }
    }
}

__device__ __forceinline__ void phase_post(const P& p, int l, int nrows, int gw, int NGW, int lane) {
    const bf16_t* PZ = (const bf16_t*)(p.ws + WS_PZ); const bf16_t* PB = (const bf16_t*)(p.ws + WS_PB);
#pragma unroll
    for (int br = 0; br < 2; ++br) {
        bf16_t* O = (bf16_t*)(p.ws + (br ? WS_PAQ : WS_H));
        const float* gnb = (br ? p.gn_b : p.gn_a) + l * 128 + 2 * lane;
        const float g0 = gnb[0], g1 = gnb[1];
        for (int it = gw; it < nrows * 4; it += NGW) {
            const int r = it >> 2, h = it & 3, col = h * 128 + 2 * lane;
            const unsigned a = *(const unsigned*)(O + (size_t)r * 512 + col), bq = *(const unsigned*)(O + ((size_t)T + r) * 512 + col);
            const unsigned zz = br ? *(const unsigned*)(PB + (size_t)r * 1536 + 1024 + col) : *(const unsigned*)(PZ + (size_t)r * 512 + col);
            const float o0 = bflo(a) + bflo(bq), o1 = bfhi(a) + bfhi(bq);
            const float rs = 1.0f / sqrtf(wave_sum(o0 * o0 + o1 * o1) * (1.0f / 128.0f) + EPS);
            *(unsigned*)(O + (size_t)r * 512 + col) = pk2(o0 * rs * g0 * siluf_(bflo(zz)), o1 * rs * g1 * siluf_(bfhi(zz)));
        }
    }
}

__device__ __forceinline__ void phase_moe_gather(const P& p, unsigned char* lds) {
    const int tid = otid();
    const int* route = (const int*)(p.ws + WS_ROUTE); int* slots = (int*)(p.ws + WS_SLOT); int* misc = (int*)(p.ws + WS_MISC);
    const unsigned* ecnt = (const unsigned*)(p.ws + WS_CTL) + CW_ECNT; unsigned* efill = (unsigned*)(p.ws + WS_CTL) + CW_EFILL;
    const bf16_t* H = (const bf16_t*)(p.ws + WS_H); bf16_t* MA = (bf16_t*)(p.ws + WS_MA);
    int* eoff = (int*)lds; unsigned* lcnt = (unsigned*)(eoff + 16); unsigned* lbase = lcnt + 8; int* myslot = (int*)(lbase + 8);
    if (tid == 0) { int off = 0, nt = 0;
#pragma unroll 1
        for (int e = 0; e < NE; ++e) { eoff[e] = off; const int tl = ((int)ecnt[e] + 255) / 256;
            if (blockIdx.x == 0) { for (int q = 0; q < tl; ++q) misc[MI_TILEE + nt + q] = e; }
            nt += tl; off += tl * 256; }
        eoff[NE] = off; if (blockIdx.x == 0) misc[MI_NTILES] = nt; }
    for (int grp = blockIdx.x; grp < TL / 64; grp += gridDim.x) {
        __syncthreads();
        if (tid < NE) lcnt[tid] = 0u;
        __syncthreads();
        int e = 0, rank = 0;
        if (tid < 128) { e = route[(grp * 64 + (tid >> 1)) * 4 + (tid & 1)]; rank = (int)atomicAdd(lcnt + e, 1u); }
        __syncthreads();
        if (tid < NE) lbase[tid] = lcnt[tid] ? atomicAdd(efill + tid, lcnt[tid]) : 0u;
        __syncthreads();
        if (tid < 128) { const int s = eoff[e] + (int)lbase[e] + rank; myslot[tid] = s; slots[(grp * 64 + (tid >> 1)) * 2 + (tid & 1)] = s; }
        __syncthreads();
        for (int i = tid; i < 128 * 128; i += NTHREADS) { const int a = i >> 7, ch = i & 127;
            ((u32x4*)(MA + (size_t)myslot[a] * D))[ch] = ((const u32x4*)(H + (size_t)(grp * 64 + (a >> 1)) * D))[ch]; }
    }
}
__device__ __forceinline__ void phase_final(const P& p, int gw, int NGW, int lane) {
    const int* route = (const int*)(p.ws + WS_ROUTE); const int* slots = (const int*)(p.ws + WS_SLOT); const bf16_t* Y = (const bf16_t*)(p.ws + WS_MA);
    const float* MOD = (const float*)(p.ws + WS_MOD) + (size_t)1 * 9 * 6144;
    for (int r = gw; r < TL; r += NGW) { const int b = r / SEQ; const float w1 = ((const float*)route)[r * 4 + 2], w2 = ((const float*)route)[r * 4 + 3];
        const bf16_t* y1 = Y + (size_t)slots[r * 2] * D, *y2 = Y + (size_t)slots[r * 2 + 1] * D; float* xr = p.out + (size_t)r * D; const float* g2 = MOD + (size_t)b * 6144 + 5 * 1024;
        f32x4 v[4]; float ss = 0.f;
#pragma unroll
        for (int j = 0; j < 4; ++j) { const int c = 4 * lane + 256 * j; const u32x2 a = *(const u32x2*)(y1 + c), bq = *(const u32x2*)(y2 + c); const f32x4 g = *(const f32x4*)(g2 + c);
            f32x4 y; y[0] = w1 * bflo(a.x) + w2 * bflo(bq.x); y[1] = w1 * bfhi(a.x) + w2 * bfhi(bq.x); y[2] = w1 * bflo(a.y) + w2 * bflo(bq.y); y[3] = w1 * bfhi(a.y) + w2 * bfhi(bq.y);
            v[j] = *(const f32x4*)(xr + c) + g * y; ss += (v[j][0] * v[j][0] + v[j][1] * v[j][1]) + (v[j][2] * v[j][2] + v[j][3] * v[j][3]); }
        const float rs = 1.0f / sqrtf(wave_sum(ss) * (1.0f / D) + EPS);
#pragma unroll
        for (int j = 0; j < 4; ++j) { const int c = 4 * lane + 256 * j; *(f32x4*)(xr + c) = v[j] * rs * *(const f32x4*)(p.final_g + c); }
    }
}

__device__ __forceinline__ void convert_up(const float* w1, const float* w3, int ne, bf16_t* up, float* scr, int gw, int NGW, int lane) {
    const int nblk = NUP / 32, items_e = (D / 64) * nblk;
    for (int it = gw; it < ne * items_e; it += NGW) {
        const int e = it / items_e, ie = it % items_e, kb = ie / nblk, nb = ie % nblk, k0 = 64 * kb, n0 = 32 * nb, n = n0 + (lane & 31), tile = n >> 8, rr = n & 255;
        const float* W = (rr < 128 ? w1 : w3) + (size_t)e * D * DFF; const int sc = tile * 128 + (rr & 127);
#pragma unroll 8
        for (int i = 0; i < 32; ++i) { const int kk = 2 * i + (lane >> 5); scr[kk * 33 + (lane & 31)] = W[(size_t)(k0 + kk) * DFF + sc]; }
        asm volatile("s_waitcnt lgkmcnt(0)" ::: "memory");
        const int c = lane & 7;
#pragma unroll
        for (int j = 0; j < 4; ++j) { const int nn = (lane >> 3) + 8 * j; const float* s = scr + (8 * c) * 33 + nn;
            u32x4 o; o.x = pk2(s[0 * 33], s[1 * 33]); o.y = pk2(s[2 * 33], s[3 * 33]); o.z = pk2(s[4 * 33], s[5 * 33]); o.w = pk2(s[6 * 33], s[7 * 33]);
            *(u32x4*)(up + ((size_t)e * NUP + n0 + nn) * D + k0 + 8 * c) = o; }
        asm volatile("s_waitcnt lgkmcnt(0)" ::: "memory");
    }
}
typedef __attribute__((address_space(4))) const P* KArgs;
#define LOADP(p) asm volatile("" : "+s"(kp)); P p; __builtin_memcpy(&p, kp, sizeof(P))
__global__ void __launch_bounds__(NTHREADS, 2) mk_fwd(P p_unused) {
    extern __shared__ __attribute__((aligned(16))) unsigned char lds[];
    cg::grid_group grid = cg::this_grid();
    KArgs kp = (KArgs)__builtin_amdgcn_kernarg_segment_ptr();
    const int G = gridDim.x, NGW = G * NWAVES;
#define IDS() const int tid = otid(), lane = tid & 63, wave = __builtin_amdgcn_readfirstlane(tid >> 6), gw = blockIdx.x * NWAVES + wave; (void)tid; (void)lane; (void)gw; (void)wave
    PG8_LAS unsigned char* glds = (PG8_LAS unsigned char*)lds;
    volatile unsigned* bst = (volatile unsigned*)(lds + LDS_BYTES - 128);
    if (otid() == 0) { bst[0] = 0u; bst[1] = 0u; }
    __syncthreads();
    { LOADP(p); (void)xcd_barrier_post((unsigned*)(p.ws + WS_CTL) + CW_BAR, bst); }
#define GSYNC() do { LOADP(pb_); XcdBarrier bb_; bb_.bar = (unsigned*)(pb_.ws + WS_CTL) + CW_BAR; bb_.x = xb_xcc_id(); bb_.st = bst; xcd_barrier(bb_); } while (0)

    {
        LOADP(p); IDS(); unsigned char* ws = p.ws;
        float* scr = (float*)(lds + 49152) + wave * (64 * 33);
        for (int rep = 0; rep < REP_P0; ++rep)
        for (int l = 0; l < DEPTH; ++l) {
            convert_T(p.w_in + (size_t)l * D * 8240, D, 8240, (bf16_t*)(ws + WB_WIN + l * WIN_BYTES), NIN, CmWin(), scr, (gw + 37 * l) % NGW, NGW, lane);
            convert_T(p.w_o_a + (size_t)l * 512 * D, 512, D, (bf16_t*)(ws + WB_WO + (l * 3 + 0) * WO_BYTES), D, CmIdent(), scr, (gw + 300 + 700 * l) % NGW, NGW, lane);
            convert_T(p.w_o_b + (size_t)l * 512 * D, 512, D, (bf16_t*)(ws + WB_WO + (l * 3 + 1) * WO_BYTES), D, CmIdent(), scr, (gw + 556 + 700 * l) % NGW, NGW, lane);
            convert_T(p.w_o_c + (size_t)l * 512 * D, 512, D, (bf16_t*)(ws + WB_WO + (l * 3 + 2) * WO_BYTES), D, CmIdent(), scr, (gw + 812 + 700 * l) % NGW, NGW, lane);
            convert_T(p.w_out + (size_t)l * D * D, D, D, (bf16_t*)(ws + WB_WOUT + l * WOUT_BYTES), D, CmIdent(), scr, (gw + 1068 + 512 * l) % NGW, NGW, lane);
        }
        convert_up(p.ffn_w1, p.ffn_w3, 1, (bf16_t*)(ws + WB_WUP), scr, (gw + 1500) % NGW, NGW, lane);
        convert_T(p.ffn_w2, DFF, D, (bf16_t*)(ws + WB_WDN), D, CmIdent(), scr, (gw + 900) % NGW, NGW, lane);
        __syncthreads();
        phase_mod(p, lds);
    }
    grid.sync();

    for (int l = 0; l < DEPTH; ++l) {
        const bool last = (l == DEPTH - 1);
        const int Mrows = last ? TL : T;
        for (int rep = 0; rep < REP_ELT; ++rep)
        { LOADP(p); IDS(); unsigned char* ws = p.ws;
          phase_modulate(l == 0 ? p.x : p.out, l == 0 ? p.ctx : (const float*)(ws + WS_XC), T, p.norm1_g + l * D, (const float*)(ws + WS_MOD) + (size_t)l * 9 * 6144, 0, (bf16_t*)(ws + WS_H), nullptr, nullptr, nullptr, nullptr, gw, NGW, lane); }
        GSYNC();
        for (int rep = 0; rep < REP_WIN; ++rep)
        { LOADP(p); unsigned char* ws = p.ws;
            pg8::Gemm g{(const bf16_t*)(ws + WS_H), (const bf16_t*)(ws + WB_WIN + l * WIN_BYTES), T, NIN, D, D}; pg8::StaticOrder S; S.init(T, NIN, G, (int)blockIdx.x);
            EpiWin E{(bf16_t*)(ws + WS_PAQ), (bf16_t*)(ws + WS_PZ), (bf16_t*)(ws + WS_PB), (bf16_t*)(ws + WS_PC), (bf16_t*)(ws + WS_PG), (float*)(ws + WS_SMALL)};
            pg8::gemm_phase<EpiWin, pg8::StaticOrder, true, true>(glds, g, S, E);
        }
        GSYNC();
        for (int rep = 1; rep < REP_SYNC; ++rep) GSYNC();
        { LOADP(p); IDS(); phase_prep(p, l, lds, gw, NGW, lane); }
        GSYNC();
        { LOADP(p); phase_mix(p, l, lds); }
        GSYNC();
        { LOADP(p); IDS(); phase_post(p, l, Mrows, gw, NGW, lane); }
        GSYNC();
        for (int br = 0; br < 3; ++br) {
            LOADP(p); unsigned char* ws = p.ws;
            const bf16_t* A = br == 0 ? (const bf16_t*)(ws + WS_H) : br == 1 ? (const bf16_t*)(ws + WS_PAQ) : (const bf16_t*)(ws + WS_PC);
            pg8::Gemm g{A, (const bf16_t*)(ws + WB_WO + (l * 3 + br) * WO_BYTES), Mrows, D, 512, br == 2 ? 1536 : 512}; pg8::StaticOrder S; S.init(Mrows, D, G, (int)blockIdx.x);
            EpiGate E{(bf16_t*)(ws + WS_DNQKV), (const bf16_t*)(ws + WS_PG), br};
            pg8::gemm_phase<EpiGate, pg8::StaticOrder, true, true>(glds, g, S, E);
            __syncthreads();
        }
        GSYNC();
        { LOADP(p); unsigned char* ws = p.ws;
            pg8::Gemm g{(const bf16_t*)(ws + WS_DNQKV), (const bf16_t*)(ws + WB_WOUT + l * WOUT_BYTES), Mrows, D, D, D}; pg8::StaticOrder S; S.init(Mrows, D, G, (int)blockIdx.x);
            EpiResid E{l == 0 ? p.x : p.out, l == 0 ? p.ctx : (const float*)(ws + WS_XC), p.out, (float*)(ws + WS_XC), (const float*)(ws + WS_MOD) + (size_t)l * 9 * 6144, 2};
            pg8::gemm_phase<EpiResid, pg8::StaticOrder, true, true>(glds, g, S, E);
        }
        GSYNC();
        { LOADP(p); IDS(); unsigned char* ws = p.ws;
          phase_modulate(p.out, (const float*)(ws + WS_XC), Mrows, p.norm2_g + l * D, (const float*)(ws + WS_MOD) + (size_t)l * 9 * 6144, 3, (bf16_t*)(ws + WS_H), last ? p.router_w : nullptr, (int*)(ws + WS_ROUTE), (unsigned*)(ws + WS_CTL) + CW_ECNT, (unsigned*)lds, gw, NGW, lane); }
        if (!last) {
            GSYNC();
            for (int rep = 0; rep < REP_UP; ++rep)
            { LOADP(p); unsigned char* ws = p.ws;
                pg8::Gemm g{(const bf16_t*)(ws + WS_H), (const bf16_t*)(ws + WB_WUP), T, NUP, D, D}; pg8::StaticOrder S; S.init(T, NUP, G, (int)blockIdx.x);
                EpiSwiglu E{(bf16_t*)(ws + WS_H1), NUP / 256};
                pg8::gemm_phase<EpiSwiglu, pg8::StaticOrder, true, true>(glds, g, S, E);
            }
            GSYNC();
            { LOADP(p); unsigned char* ws = p.ws;
                pg8::Gemm g{(const bf16_t*)(ws + WS_H1), (const bf16_t*)(ws + WB_WDN), T, D, DFF, DFF}; pg8::StaticOrder S; S.init(T, D, G, (int)blockIdx.x);
                EpiResid E{p.out, (const float*)(ws + WS_XC), p.out, (float*)(ws + WS_XC), (const float*)(ws + WS_MOD) + (size_t)l * 9 * 6144, 5};
                pg8::gemm_phase<EpiResid, pg8::StaticOrder, true, true>(glds, g, S, E);
            }
            GSYNC();
        } else {
            { LOADP(p); IDS(); unsigned char* ws = p.ws;
                float* scr = (float*)lds + wave * (64 * 33);
                convert_up(p.moe_w1, p.moe_w3, NE, (bf16_t*)(ws + WS_MWUP), scr, gw, NGW, lane);
                for (int e = 0; e < NE; ++e)
                    convert_T(p.moe_w2 + (size_t)e * DFF * D, DFF, D, (bf16_t*)(ws + WS_MWDN) + (size_t)e * D * DFF, D, CmIdent(), scr, (gw + 173 * e) % NGW, NGW, lane);
            }
            GSYNC();
            { LOADP(p); phase_moe_gather(p, lds); }
            GSYNC();
            for (int rep = 0; rep < REP_UP; ++rep)
            { LOADP(p); unsigned char* ws = p.ws; const int* misc = (const int*)(ws + WS_MISC);
                pg8::Gemm g{(const bf16_t*)(ws + WS_MA), (const bf16_t*)(ws + WS_MWUP), MOE_ROWS, NE * NUP, D, D};
                MoeOrder S{misc[MI_NTILES], NUP / 256, G, (int)blockIdx.x, misc + MI_TILEE};
                EpiSwiglu E{(bf16_t*)(ws + WS_MH1), NUP / 256};
                pg8::gemm_phase<EpiSwiglu, MoeOrder, true, true>(glds, g, S, E);
            }
            GSYNC();
            { LOADP(p); unsigned char* ws = p.ws; const int* misc = (const int*)(ws + WS_MISC);
                pg8::Gemm g{(const bf16_t*)(ws + WS_MH1), (const bf16_t*)(ws + WS_MWDN), MOE_ROWS, NE * D, DFF, DFF};
                MoeOrder S{misc[MI_NTILES], D / 256, G, (int)blockIdx.x, misc + MI_TILEE};
                EpiMoeDown E{(bf16_t*)(ws + WS_MA)};
                pg8::gemm_phase<EpiMoeDown, MoeOrder, true, true>(glds, g, S, E);
            }
            GSYNC();
            { LOADP(p); IDS(); phase_final(p, gw, NGW, lane); }
        }
    }
}

extern "C" void kernel_launch(void* const* d_in, const int* in_sizes, int n_in, void* d_out, int out_size, void* d_ws, size_t ws_size, hipStream_t stream) {
    static int grid_blocks = 0;
    if (grid_blocks == 0) {
        if (n_in != 30 || in_sizes[0] != TL * D || out_size != TL * D || ws_size < WS_END) {
            fprintf(stderr, "kernel_launch: built for 30 inputs, x/out of %d floats, >= %zu bytes of d_ws; got n_in %d, in0 %d, out %d, ws %zu; nothing launched\n", TL * D, (size_t)WS_END, n_in, n_in > 0 ? in_sizes[0] : -1, out_size, ws_size);
            grid_blocks = -1; return; }
        int dev = 0, cus = 0, per_cu = 0;
        hipGetDevice(&dev);
        hipDeviceGetAttribute(&cus, hipDeviceAttributeMultiprocessorCount, dev);
        hipFuncSetAttribute((const void*)mk_fwd, hipFuncAttributeMaxDynamicSharedMemorySize, LDS_BYTES);
        hipOccupancyMaxActiveBlocksPerMultiprocessor(&per_cu, (const void*)mk_fwd, NTHREADS, LDS_BYTES);
        if (per_cu < 1) { fprintf(stderr, "kernel_launch: occupancy query reports %d blocks/CU; nothing launched\n", per_cu); grid_blocks = -1; return; }
        grid_blocks = cus;
    }
    if (grid_blocks < 0) return;
    hipMemsetAsync((char*)d_ws + WS_CTL, 0, CTL_BYTES, stream);
    P p{};
    const float** f = (const float**)&p;
    for (int i = 0; i < 30; ++i) f[i] = (const float*)d_in[i];
    p.out = (float*)d_out; p.ws = (unsigned char*)d_ws;
    void* args[] = {&p};
    hipError_t e = hipLaunchCooperativeKernel((const void*)mk_fwd, dim3(grid_blocks), dim3(NTHREADS), args, LDS_BYTES, stream);
    if (e != hipSuccess) fprintf(stderr, "kernel_launch: cooperative launch failed: %s (grid %d)\n", hipGetErrorString(e), grid_blocks);
}
```

```cpp
#include <hip/hip_runtime.h>
#include <hip/hip_cooperative_groups.h>
#include <cstdio>
#include <cstdint>
namespace cg = cooperative_groups;
#ifndef REP_P0
#define REP_P0 1
#endif
#ifndef REP_WIN
#define REP_WIN 1
#endif
#ifndef REP_CHAIN
#define REP_CHAIN 1
#endif
#ifndef REP_UP
#define REP_UP 1
#endif
#ifndef REP_SYNC
#define REP_SYNC 1
#endif
#ifndef REP_ATT
#define REP_ATT 1
#endif
#ifndef REP_DNPREP
#define REP_DNPREP 1
#endif
#ifndef REP_ELT
#define REP_ELT 1
#endif
#ifndef REP_DN
#define REP_DN REP_CHAIN
#endif
#ifndef REP_GLA
#define REP_GLA REP_CHAIN
#endif
#ifndef REP_MERGE
#define REP_MERGE 1
#endif
#ifndef REP_WOUT0
#define REP_WOUT0 1
#endif

namespace pg8 {
#define PG8_LAS __attribute__((address_space(3)))
typedef unsigned short bf16_t;
typedef short bf16x8 __attribute__((ext_vector_type(8)));
typedef float f32x4 __attribute__((ext_vector_type(4)));
typedef unsigned u32x4 __attribute__((ext_vector_type(4)));
constexpr int BM = 256, BK = 64, HALF = 128, HTB = HALF * BK * 2  , STAGE_BYTES = 8 * HTB, NXCD = 8, WGM = 8;

__host__ __device__ __forceinline__ int lds_byte(int r, int c) { const int st = (r >> 4) * 2 + (c >> 5), rr = r & 15, cc = c & 31, ob = rr * 64 + cc * 2; return st * 1024 + (ob ^ (((ob >> 9) & 1) << 5)); }
__host__ __device__ __forceinline__ void stage_rc(int b, int& R, int& C) { const int st = b / 1024, sb = b % 1024, swz = sb ^ (((sb >> 9) & 1) << 5); R = (st >> 1) * 16 + swz / 64; C = (st & 1) * 32 + (swz % 64) / 2; }
__host__ __device__ __forceinline__ int perm32(int rho) { const int n = rho >> 4, i = rho & 15; return 8 * (i >> 2) + 4 * n + (i & 3); }

struct Unit { int pm, pn, br; };
struct Gemm { const bf16_t* A; const bf16_t* Bt; int M, N, K, lda; const bf16_t* A1; const bf16_t* A2; const bf16_t* B1; const bf16_t* B2; };

struct StaticOrder {
    int nM, nN, nwg, G, c;
    __host__ __device__ void init(int M, int N, int G_, int c_) { nM = M / BM; nN = N / BM; nwg = nM * nN; G = G_; c = c_; }
    __host__ __device__ bool next(int i, Unit& u) const {
        const long L = (long)i * G + c; if (L >= nwg) return false;
        int wgid = (int)L; { const int q = nwg / NXCD, r = nwg % NXCD, xcd = wgid % NXCD, off = wgid / NXCD; wgid = (xcd < r ? xcd * (q + 1) : r * (q + 1) + (xcd - r) * q) + off; }
        const int nig = WGM * nN, gid = wgid / nig, fm = gid * WGM, gsz = (nM - fm) < WGM ? (nM - fm) : WGM;
        u.pm = fm + ((wgid % nig) % gsz); u.pn = (wgid % nig) / gsz; u.br = 0; return true;
    }
    __device__ __forceinline__ void a_ready(const Unit&) const {}
    __device__ __forceinline__ void done(const Unit&) const {}
};


template <class Epi, class Sched, bool ALIGN_EPI = false, bool SP2 = false>
__device__ __forceinline__ void gemm_phase(PG8_LAS unsigned char* lds, const Gemm g, const Sched& S, const Epi& E) {
    int tid_o = threadIdx.x; asm volatile("" : "+v"(tid_o));
    const int tid = tid_o, wid = __builtin_amdgcn_readfirstlane(tid >> 6), lane = tid & 63, wr = wid >> 2, wc = wid & 3, fr = lane & 15, fq = lane >> 4;
    const int K = g.K, nt = K / BK;
    unsigned voffA[2], voffB[2];
#pragma unroll
    for (int i = 0; i < 2; ++i) { int R, C; stage_rc(tid * 16 + i * 8192, R, C); const int Rb = Epi::PERM ? ((R & ~31) + perm32(R & 31)) : R;
        voffA[i] = (unsigned)(R * g.lda + C) * 2u; voffB[i] = (unsigned)(Rb * K + C) * 2u; }
    const size_t kstep = (size_t)(BK * 2);
    const size_t hstepA = (size_t)HALF * g.lda * 2, hstepB = (size_t)HALF * K * 2;
    const size_t tstepA = 2 * hstepA, tstepB = 2 * hstepB;
    const unsigned ldsw = (unsigned)wid * 1024u;
    const int aoff = lds_byte(wr * 64 + fr, fq * 8), boff = lds_byte(wc * 32 + fr, fq * 8);
#define PG8_SA(b, h) (((b) * 2 + (h)) * HTB)
#define PG8_SB(b, h) ((4 + (b) * 2 + (h)) * HTB)
#define PG8_STAGE(bufoff, gbase, voff) do { _Pragma("unroll") for (int _i = 0; _i < 2; ++_i) \
        __builtin_amdgcn_global_load_lds((const unsigned*)((const char*)(gbase) + (voff)[_i]), (PG8_LAS unsigned*)(lds + (bufoff) + ldsw + _i * 8192), 16, 0, 0); } while (0)
#define PG8_LDA(dst, b, h) do { _Pragma("unroll") for (int m = 0; m < 4; ++m) _Pragma("unroll") for (int k = 0; k < 2; ++k) dst[m][k] = *(const PG8_LAS bf16x8*)(lds + PG8_SA(b, h) + aoff + m * 2048 + k * 1024); } while (0)
#define PG8_LDB(dst, b, h) do { _Pragma("unroll") for (int n = 0; n < 2; ++n) _Pragma("unroll") for (int k = 0; k < 2; ++k) dst[n][k] = *(const PG8_LAS bf16x8*)(lds + PG8_SB(b, h) + boff + n * 2048 + k * 1024); } while (0)
#define PG8_MMA(ai, bj, At, Bt) do { __builtin_amdgcn_s_setprio(1); _Pragma("unroll") for (int m = 0; m < 4; ++m) _Pragma("unroll") for (int n = 0; n < 2; ++n) _Pragma("unroll") for (int k = 0; k < 2; ++k) \
        acc[ai][bj][m][n] = __builtin_amdgcn_mfma_f32_16x16x32_bf16(Bt[n][k], At[m][k], acc[ai][bj][m][n], 0, 0, 0); __builtin_amdgcn_s_setprio(0); } while (0)
#define PG8_WAIT_V(n) asm volatile("s_waitcnt vmcnt(" #n ")" ::: "memory")
#define PG8_WAIT_L(n) asm volatile("s_waitcnt lgkmcnt(" #n ")" ::: "memory")
#define PG8_BAR __builtin_amdgcn_s_barrier()
#define PG8_SCHED __builtin_amdgcn_sched_barrier(0)
    Unit cur, nxt; int ui = 0;
    if (!S.next(0, cur)) return;
    f32x4 acc[2][2][4][2];
#pragma unroll
    for (int a = 0; a < 2; ++a)
#pragma unroll
        for (int b = 0; b < 2; ++b)
#pragma unroll
            for (int m = 0; m < 4; ++m)
#pragma unroll
                for (int n = 0; n < 2; ++n) acc[a][b][m][n] = (f32x4){0.f, 0.f, 0.f, 0.f};
    bf16x8 At[4][2], B0[2][2], B1[2][2];
    const char* cA = (const char*)(cur.br == 0 ? g.A : cur.br == 1 ? g.A1 : g.A2) + (size_t)cur.pm * tstepA; const char* cB = (const char*)(cur.br == 0 ? g.Bt : cur.br == 1 ? g.B1 : g.B2) + (size_t)cur.pn * tstepB;
    S.a_ready(cur);
    if constexpr (SP2) {
        PG8_STAGE(PG8_SB(0, 0), cB, voffB); PG8_STAGE(PG8_SB(0, 1), cB + hstepB, voffB); PG8_STAGE(PG8_SA(0, 0), cA, voffA); PG8_STAGE(PG8_SA(0, 1), cA + hstepA, voffA);
        if (wr == 1) PG8_BAR;
        PG8_WAIT_V(2); PG8_BAR;
        PG8_STAGE(PG8_SB(1, 0), cB + kstep, voffB); PG8_STAGE(PG8_SA(1, 0), cA + kstep, voffA); PG8_STAGE(PG8_SB(1, 1), cB + hstepB + kstep, voffB);
        PG8_WAIT_V(6); PG8_BAR;
    } else {
        PG8_STAGE(PG8_SB(0, 0), cB, voffB); PG8_STAGE(PG8_SA(0, 0), cA, voffA); PG8_STAGE(PG8_SB(0, 1), cB + hstepB, voffB); PG8_STAGE(PG8_SA(0, 1), cA + hstepA, voffA);
        if (wr == 1) PG8_BAR;
        PG8_WAIT_V(4); PG8_BAR;
        PG8_STAGE(PG8_SB(1, 0), cB + kstep, voffB); PG8_STAGE(PG8_SA(1, 0), cA + kstep, voffA); PG8_STAGE(PG8_SB(1, 1), cB + hstepB + kstep, voffB);
        PG8_WAIT_V(6); PG8_BAR;
    }
    for (;;) {
        const bool has_next = S.next(ui + 1, nxt);
        const char* nA = has_next ? (const char*)(nxt.br == 0 ? g.A : nxt.br == 1 ? g.A1 : g.A2) + (size_t)nxt.pm * tstepA : cA; const char* nB = has_next ? (const char*)(nxt.br == 0 ? g.Bt : nxt.br == 1 ? g.B1 : g.B2) + (size_t)nxt.pn * tstepB : cB;
        for (int t = 0; t < nt; t += 2) {
            const bool last = (t == nt - 2);
            const char* a1 = cA + (size_t)(t + 1) * kstep;
            const char* a2 = last ? nA : cA + (size_t)(t + 2) * kstep; const char* b2 = last ? nB : cB + (size_t)(t + 2) * kstep;
            const char* a3 = a2 + kstep; const char* b3 = b2 + kstep;
            if (last && has_next) S.a_ready(nxt);
            if constexpr (SP2) {
            PG8_LDB(B0, 0, 0); PG8_LDB(B1, 0, 1); PG8_SCHED; PG8_LDA(At, 0, 0); PG8_STAGE(PG8_SA(1, 1), a1 + hstepA, voffA);
            PG8_WAIT_V(8); PG8_WAIT_L(0); PG8_BAR; PG8_MMA(0, 0, At, B0); PG8_MMA(0, 1, At, B1); PG8_BAR; PG8_SCHED;
            PG8_LDA(At, 0, 1); PG8_STAGE(PG8_SB(0, 0), b2, voffB); PG8_STAGE(PG8_SB(0, 1), b2 + hstepB, voffB); PG8_STAGE(PG8_SA(0, 0), a2, voffA);
            PG8_WAIT_V(8); PG8_WAIT_L(0); PG8_BAR; PG8_MMA(1, 0, At, B0); PG8_MMA(1, 1, At, B1); PG8_BAR; PG8_SCHED;
            PG8_LDB(B0, 1, 0); PG8_LDB(B1, 1, 1); PG8_SCHED; PG8_LDA(At, 1, 0); PG8_STAGE(PG8_SA(0, 1), a2 + hstepA, voffA);
            PG8_WAIT_V(8); PG8_WAIT_L(0); PG8_BAR; PG8_MMA(0, 0, At, B0); PG8_MMA(0, 1, At, B1); PG8_BAR; PG8_SCHED;
            PG8_LDA(At, 1, 1); PG8_STAGE(PG8_SB(1, 0), b3, voffB); PG8_STAGE(PG8_SB(1, 1), b3 + hstepB, voffB); PG8_STAGE(PG8_SA(1, 0), a3, voffA);
            PG8_WAIT_V(8); PG8_WAIT_L(0); PG8_BAR; PG8_MMA(1, 0, At, B0); PG8_MMA(1, 1, At, B1); PG8_BAR; PG8_SCHED;
            } else {
            PG8_LDB(B0, 0, 0); PG8_SCHED; PG8_LDA(At, 0, 0); PG8_STAGE(PG8_SA(1, 1), a1 + hstepA, voffA);
            PG8_WAIT_L(8); PG8_BAR; PG8_WAIT_L(0); PG8_MMA(0, 0, At, B0); PG8_BAR; PG8_SCHED;
            PG8_LDB(B1, 0, 1); PG8_STAGE(PG8_SB(0, 0), b2, voffB);
            PG8_BAR; PG8_WAIT_L(0); PG8_MMA(0, 1, At, B1); PG8_BAR;
            PG8_LDA(At, 0, 1); PG8_STAGE(PG8_SA(0, 0), a2, voffA);
            PG8_BAR; PG8_WAIT_L(0); PG8_MMA(1, 0, At, B0); PG8_BAR; PG8_SCHED;
            PG8_STAGE(PG8_SB(0, 1), b2 + hstepB, voffB);
            PG8_WAIT_V(6); PG8_BAR; PG8_MMA(1, 1, At, B1); PG8_BAR;
            PG8_LDB(B0, 1, 0); PG8_SCHED; PG8_LDA(At, 1, 0); PG8_STAGE(PG8_SA(0, 1), a2 + hstepA, voffA);
            PG8_WAIT_L(8); PG8_BAR; PG8_WAIT_L(0); PG8_MMA(0, 0, At, B0); PG8_BAR; PG8_SCHED;
            PG8_LDB(B1, 1, 1); PG8_STAGE(PG8_SB(1, 0), b3, voffB);
            PG8_BAR; PG8_WAIT_L(0); PG8_MMA(0, 1, At, B1); PG8_BAR;
            PG8_LDA(At, 1, 1); PG8_STAGE(PG8_SA(1, 0), a3, voffA);
            PG8_BAR; PG8_WAIT_L(0); PG8_MMA(1, 0, At, B0); PG8_BAR; PG8_SCHED;
            PG8_STAGE(PG8_SB(1, 1), b3 + hstepB, voffB);
            PG8_WAIT_V(6); PG8_BAR; PG8_MMA(1, 1, At, B1); PG8_BAR;
            }
        }
        if constexpr (ALIGN_EPI) { if (wr == 0) PG8_BAR; }
        if constexpr (!Epi::AFTER_DRAIN) { E(acc, cur, wr, wc, fr, fq); S.done(cur); }
        if (!has_next) break;
        if (!(Epi::CHAIN && nxt.br != 0)) {
#pragma unroll
        for (int a = 0; a < 2; ++a)
#pragma unroll
            for (int b = 0; b < 2; ++b)
#pragma unroll
                for (int m = 0; m < 4; ++m)
#pragma unroll
                    for (int n = 0; n < 2; ++n) acc[a][b][m][n] = (f32x4){0.f, 0.f, 0.f, 0.f};
        }
        cur = nxt; cA = nA; cB = nB; ++ui;
        if constexpr (ALIGN_EPI) { if (wr == 1) PG8_BAR; }
    }
    PG8_WAIT_V(0);
    if constexpr (!ALIGN_EPI) { if (wr == 0) PG8_BAR; }
    PG8_BAR;
    if constexpr (Epi::AFTER_DRAIN) { E.fused(acc, cur, wr, wc, fr, fq, lds, wid, lane); S.done(cur); }
#undef PG8_SA
#undef PG8_SB
#undef PG8_STAGE
#undef PG8_LDA
#undef PG8_LDB
#undef PG8_MMA
#undef PG8_WAIT_V
#undef PG8_WAIT_L
#undef PG8_BAR
#undef PG8_SCHED
}
}


constexpr int BATCH = 8, SEQ = 2048, CTXL = 256, D = 1024, DEPTH = 2;
constexpr int TL = BATCH * SEQ, TC = BATCH * CTXL, T = TL + TC;
constexpr int NIN = 8448;
constexpr int DFF = 2816, NE = 8, NUP = 2 * DFF;
constexpr int MOE_ROWS = 2 * TL + NE * 256;
constexpr float EPS = 1e-6f;
constexpr int NTHREADS = 512, NWAVES = 8;
constexpr int LDS_BYTES = 147456;

typedef unsigned short bf16_t;
typedef float f32x4 __attribute__((ext_vector_type(4)));
typedef float f32x16 __attribute__((ext_vector_type(16)));
typedef unsigned u32x4 __attribute__((ext_vector_type(4)));
typedef unsigned u32x2 __attribute__((ext_vector_type(2)));
typedef short bf16x8 __attribute__((ext_vector_type(8)));
typedef short s16x4 __attribute__((ext_vector_type(4)));

constexpr size_t al256(size_t x) { return (x + 255) & ~(size_t)255; }
constexpr size_t WS_CTL   = 0;                                   constexpr size_t CTL_BYTES = 65536;
constexpr size_t WS_MOD   = WS_CTL + CTL_BYTES;                  constexpr size_t MOD_BYTES = (size_t)DEPTH * 9 * 6 * D * 4;
constexpr size_t WS_ROUTE = al256(WS_MOD + MOD_BYTES);           constexpr size_t ROUTE_BYTES = (size_t)TL * 16;
constexpr size_t WS_SLOT  = al256(WS_ROUTE + ROUTE_BYTES);       constexpr size_t SLOT_BYTES = (size_t)TL * 8;
constexpr size_t WS_MISC  = al256(WS_SLOT + SLOT_BYTES);         constexpr size_t MISC_BYTES = 4096;
constexpr size_t WS_GB    = al256(WS_MISC + MISC_BYTES);         constexpr size_t GB_BYTES = (size_t)T * 16 * 4;
constexpr size_t WS_SMALL = al256(WS_GB + GB_BYTES);             constexpr size_t SMALL_BYTES = (size_t)T * 64 * 4;
constexpr size_t WS_XC    = al256(WS_SMALL + SMALL_BYTES);       constexpr size_t XC_BYTES = (size_t)TC * D * 4;
constexpr size_t WS_WB    = al256(WS_XC + XC_BYTES);
constexpr size_t WB_WIN   = WS_WB;                               constexpr size_t WIN_BYTES = (size_t)NIN * D * 2;
constexpr size_t WB_WO    = WB_WIN + DEPTH * WIN_BYTES;          constexpr size_t WO_BYTES = (size_t)D * 512 * 2;
constexpr size_t WB_WOUT  = WB_WO + DEPTH * 3 * WO_BYTES;        constexpr size_t WOUT_BYTES = (size_t)D * D * 2;
constexpr size_t WB_WUP   = WB_WOUT + DEPTH * WOUT_BYTES;        constexpr size_t WUP_BYTES = (size_t)NUP * D * 2;
constexpr size_t WB_WDN   = WB_WUP + WUP_BYTES;                  constexpr size_t WDN_BYTES = (size_t)D * DFF * 2;
constexpr size_t WB_END   = WB_WDN + WDN_BYTES;
constexpr size_t WS_H     = al256(WB_END);                       constexpr size_t H_BYTES = (size_t)T * D * 2;
constexpr size_t WS_PAQ   = al256(WS_H + H_BYTES);               constexpr size_t PAQ_BYTES = (size_t)T * 1536 * 2;
constexpr size_t WS_PZ    = al256(WS_PAQ + PAQ_BYTES);           constexpr size_t PZ_BYTES = (size_t)T * 512 * 2;
constexpr size_t WS_PB    = al256(WS_PZ + PZ_BYTES);             constexpr size_t PB_BYTES = (size_t)T * 1536 * 2;
constexpr size_t WS_PC    = al256(WS_PB + PB_BYTES);             constexpr size_t PC_BYTES = (size_t)T * 1536 * 2;
constexpr size_t WS_PG    = al256(WS_PC + PC_BYTES);             constexpr size_t PG_BYTES = (size_t)T * 3072 * 2;
constexpr size_t WS_DNQKV = al256(WS_PG + PG_BYTES);             constexpr size_t DNQKV_BYTES = (size_t)T * 1536 * 2;
constexpr size_t WS_TQ    = al256(WS_DNQKV + DNQKV_BYTES);       constexpr size_t TQ_BYTES = (size_t)BATCH * 4 * 2 * ((CTXL + SEQ) / 64) * 16384;
constexpr size_t WS_VEC   = al256(WS_TQ + TQ_BYTES);             constexpr size_t VEC_BYTES = (size_t)BATCH * 4 * 2 * ((CTXL + SEQ) / 64) * 1024;
constexpr size_t WS_END   = al256(WS_VEC + VEC_BYTES);
static_assert(WS_END <= (size_t)524288000, "d_ws map exceeds 500 MiB (documented minimum is 525,980,800 B)");
constexpr size_t WS_YD    = WS_PAQ + (size_t)2 * T * 512 * 2;
static_assert((size_t)3 * T * 512 * 2 <= PAQ_BYTES, "yd overlay");
constexpr size_t WS_H1    = WS_PB;
static_assert((size_t)T * DFF * 2 <= PB_BYTES + PC_BYTES, "h1 overlay");
constexpr size_t WS_MWDN  = WS_WB;                                constexpr size_t MWDN_BYTES = (size_t)NE * D * DFF * 2;
static_assert(MWDN_BYTES <= WB_END - WS_WB, "moe wdn overlay");
constexpr size_t WS_MWUP  = WS_PAQ;                               constexpr size_t MWUP_BYTES = (size_t)NE * NUP * D * 2;
constexpr size_t WS_MA    = al256(WS_MWUP + MWUP_BYTES);          constexpr size_t MA_BYTES = (size_t)MOE_ROWS * D * 2;
constexpr size_t WS_MH1   = al256(WS_MA + MA_BYTES);              constexpr size_t MH1_BYTES = (size_t)MOE_ROWS * DFF * 2;
static_assert(WS_MH1 + MH1_BYTES <= WS_END, "moe overlay");
constexpr int CW_QUEUE = 0;
constexpr int CW_KMAX = 256;
constexpr int CW_ECNT = 512;
constexpr int CW_EFILL = 576;
constexpr int CW_BAR = 4096;
constexpr int MI_LAMF = 0;
constexpr int MI_NTILES = 16;
constexpr int MI_EOFF = 32;
constexpr int MI_TILEE = 64;

typedef __bf16 bf16v2_t __attribute__((ext_vector_type(2)));
typedef float f32v2_t __attribute__((ext_vector_type(2)));
__device__ __forceinline__ unsigned pk2(float lo, float hi) { const f32v2_t v = {lo, hi}; return __builtin_bit_cast(unsigned, __builtin_convertvector(v, bf16v2_t)); }
__device__ __forceinline__ unsigned f2bf(float f) { return pk2(f, 0.f) & 0xffffu; }
__device__ __forceinline__ float bflo(unsigned w) { return __builtin_bit_cast(float, w << 16); }
__device__ __forceinline__ float bfhi(unsigned w) { return __builtin_bit_cast(float, w & 0xffff0000u); }
__device__ __forceinline__ float bf2f(bf16_t h) { return __builtin_bit_cast(float, (unsigned)h << 16); }
__device__ __forceinline__ int otid() { int t = threadIdx.x; asm volatile("" : "+v"(t)); return t; }
__device__ __forceinline__ float shx(float v, int o) { const int idx = ((otid() & 63) ^ o) << 2; return __builtin_bit_cast(float, __builtin_amdgcn_ds_bpermute(idx, __builtin_bit_cast(int, v))); }
__device__ __forceinline__ float shup(float v, int o) { const int idx = (((otid() & 63) - o) & 63) << 2; return __builtin_bit_cast(float, __builtin_amdgcn_ds_bpermute(idx, __builtin_bit_cast(int, v))); }
__device__ __forceinline__ float shlane(float v, int src) { return __builtin_bit_cast(float, __builtin_amdgcn_ds_bpermute(src << 2, __builtin_bit_cast(int, v))); }
__device__ __forceinline__ int shlane_i(int v, int src) { return __builtin_amdgcn_ds_bpermute(src << 2, v); }
__device__ __forceinline__ float wave_sum(float v) {
#pragma unroll
    for (int o = 1; o < 64; o <<= 1) v += shx(v, o);
    return v;
}
__device__ __forceinline__ float sigmoidf_(float x) { return 1.0f / (1.0f + __expf(-x)); }
__device__ __forceinline__ float siluf_(float x) { return x / (1.0f + __expf(-x)); }
__device__ __forceinline__ float softplusf_(float x) { return x > 20.f ? x : log1pf(expf(x)); }
__device__ __forceinline__ float logsigmoidf_(float x) { return fminf(x, 0.f) - log1pf(expf(-fabsf(x))); }
__device__ __forceinline__ float logsigmoid_fast(float z) { z = fmaxf(z, -80.f); return -0.6931471806f * __builtin_amdgcn_logf(1.0f + __builtin_amdgcn_exp2f(-1.4426950409f * z)); }

struct P {
    const float *x, *c, *ctx, *c_ctx, *w_mod, *b_mod, *norm1_g, *norm2_g, *w_in, *conv_a, *a_log, *dt_bias, *gn_a, *w_gate2, *b_gate, *gn_b,
                *lam_c, *gn_c, *w_o_a, *w_o_b, *w_o_c, *w_out, *ffn_w1, *ffn_w3, *ffn_w2, *router_w, *moe_w1, *moe_w3, *moe_w2, *final_g;
    float* out; unsigned char* ws;
};

template <class SrcMap>
__device__ __forceinline__ void convert_T(int K, int ldw, bf16_t* WT, int Nrows, SrcMap sm, float* scr  , int gw, int NGW, int lane) {
    const int nblk = Nrows / 64, items = (K / 64) * nblk;
    for (int it = gw; it < items; it += NGW) {
        const int kb = it / nblk, nb = it % nblk, k0 = 64 * kb, n0 = 64 * nb;
        const float* src = sm(n0 + 4 * (lane & 15));
#pragma unroll 4
        for (int i = 0; i < 16; ++i) { const int kk = 4 * i + (lane >> 4);
            const f32x4 v = src ? *(const f32x4*)(src + (size_t)(k0 + kk) * ldw) : (f32x4){0.f, 0.f, 0.f, 0.f};
            float* d = scr + kk * 65 + 4 * (lane & 15); d[0] = v[0]; d[1] = v[1]; d[2] = v[2]; d[3] = v[3]; }
        asm volatile("s_waitcnt lgkmcnt(0)" ::: "memory");
        const int c = lane & 7;
#pragma unroll
        for (int j = 0; j < 8; ++j) { const int n = (lane >> 3) + 8 * j; const float* s = scr + (8 * c) * 65 + n;
            u32x4 o; o.x = pk2(s[0 * 65], s[1 * 65]); o.y = pk2(s[2 * 65], s[3 * 65]); o.z = pk2(s[4 * 65], s[5 * 65]); o.w = pk2(s[6 * 65], s[7 * 65]);
            *(u32x4*)(WT + (size_t)(n0 + n) * K + k0 + 8 * c) = o; }
        asm volatile("s_waitcnt lgkmcnt(0)" ::: "memory");
    }
}
struct SmPlain { const float* W; __device__ const float* operator()(int n) const { return W + n; } };
struct SmWin { const float* W; __device__ const float* operator()(int n) const {
    if (n < 2048) return W + n; if (n < 3584) return W + n + 16; if (n < 8192) return W + n + 48;
    const int j = n - 8192; if (j < 16) return W + 2048 + j; if (j < 48) return W + 3600 + (j - 16); return nullptr; } };
struct SmUp { const float* w1; const float* w3; __device__ const float* operator()(int n) const {
    const int tile = n >> 8, rr = n & 255; const long d31 = (long)(w3 - w1); return w1 + (rr < 128 ? 0L : d31) + tile * 128 + (rr & 127); } };
constexpr int CONV_WLDS = 64 * 65 * 4;
typedef const f32x4 (&AccRef)[2][2][4][2];
struct EpiWin {
    static constexpr bool PERM = true, AFTER_DRAIN = false, CHAIN = false;
    bf16_t *paq, *pz, *pb, *pc, *pg; float* small_;
    __device__ __forceinline__ void operator()(AccRef acc, const pg8::Unit& u, int wr, int wc, int fr, int fq) const {
        const int row0 = u.pm * 256 + wr * 64 + fr, pn = u.pn;
        if (pn == 32) {
            if (wc < 2) {
#pragma unroll
                for (int ai = 0; ai < 2; ++ai)
#pragma unroll
                    for (int m = 0; m < 4; ++m) { float* p = small_ + (size_t)(row0 + ai * 128 + m * 16) * 64 + wc * 32 + 8 * fq;
                        *(f32x4*)p = acc[ai][0][m][0]; *(f32x4*)(p + 4) = acc[ai][0][m][1]; }
            }
            return;
        }
        bf16_t* base; int ldc, c0;
        if (pn < 6) { base = paq; ldc = 1536; c0 = pn * 256; } else if (pn < 8) { base = pz; ldc = 512; c0 = (pn - 6) * 256; }
        else if (pn < 14) { base = pb; ldc = 1536; c0 = (pn - 8) * 256; } else if (pn < 20) { base = pc; ldc = 1536; c0 = (pn - 14) * 256; }
        else { base = pg; ldc = 3072; c0 = (pn - 20) * 256; }
        const int col = c0 + wc * 32 + 8 * fq;
#pragma unroll
        for (int ai = 0; ai < 2; ++ai)
#pragma unroll
            for (int m = 0; m < 4; ++m) { bf16_t* rowp = base + (size_t)(row0 + ai * 128 + m * 16) * ldc + col;
#pragma unroll
                for (int bj = 0; bj < 2; ++bj) { const f32x4 v0 = acc[ai][bj][m][0], v1 = acc[ai][bj][m][1];
                    u32x4 w; w.x = pk2(v0[0], v0[1]); w.y = pk2(v0[2], v0[3]); w.z = pk2(v1[0], v1[1]); w.w = pk2(v1[2], v1[3]);
                    *(u32x4*)(rowp + bj * 128) = w; } }
    }
};
struct EpiGate {
    static constexpr bool PERM = true, AFTER_DRAIN = false, CHAIN = true;
    bf16_t* Mo; const bf16_t* pg;
    static __device__ __forceinline__ float em(float x) { return __expf(-fminf(fmaxf(x, -30.f), 30.f)); }
    __device__ __forceinline__ void operator()(f32x4 (&acc)[2][2][4][2], const pg8::Unit& u, int wr, int wc, int fr, int fq) const {
        const int row0 = u.pm * 256 + wr * 64 + fr, col = u.pn * 256 + wc * 32 + 8 * fq, br = u.br;
#pragma unroll
        for (int ai = 0; ai < 2; ++ai) {
            u32x4 gc[4][2], gn[4][2];
#pragma unroll
            for (int m = 0; m < 4; ++m)
#pragma unroll
                for (int bj = 0; bj < 2; ++bj) { const size_t row = (size_t)(row0 + ai * 128 + m * 16);
                    gc[m][bj] = *(const u32x4*)(pg + row * 3072 + br * 1024 + col + bj * 128);
                    gn[m][bj] = *(const u32x4*)(pg + row * 3072 + (br < 2 ? br + 1 : br) * 1024 + col + bj * 128); }
#pragma unroll
            for (int m = 0; m < 4; ++m) { const size_t row = (size_t)(row0 + ai * 128 + m * 16);
#pragma unroll
                for (int bj = 0; bj < 2; ++bj) {
                    const unsigned gcw[4] = {gc[m][bj].x, gc[m][bj].y, gc[m][bj].z, gc[m][bj].w}, gnw[4] = {gn[m][bj].x, gn[m][bj].y, gn[m][bj].z, gn[m][bj].w};
                    f32x4& v0 = acc[ai][bj][m][0]; f32x4& v1 = acc[ai][bj][m][1];
                    if (br < 2) {
#pragma unroll
                        for (int q = 0; q < 4; ++q) { const float r0 = (1.0f + em(bflo(gnw[q]))) / (1.0f + em(bflo(gcw[q]))), r1 = (1.0f + em(bfhi(gnw[q]))) / (1.0f + em(bfhi(gcw[q])));
                            if (q < 2) { v0[2 * q] *= r0; v0[2 * q + 1] *= r1; } else { v1[2 * q - 4] *= r0; v1[2 * q - 3] *= r1; } }
                    } else {
#pragma unroll
                        for (int q = 0; q < 4; ++q) { const float s0 = 1.0f / (1.0f + em(bflo(gcw[q]))), s1 = 1.0f / (1.0f + em(bfhi(gcw[q])));
                            if (q < 2) { v0[2 * q] *= s0; v0[2 * q + 1] *= s1; } else { v1[2 * q - 4] *= s0; v1[2 * q - 3] *= s1; } }
                        u32x4 w; w.x = pk2(v0[0], v0[1]); w.y = pk2(v0[2], v0[3]); w.z = pk2(v1[0], v1[1]); w.w = pk2(v1[2], v1[3]);
                        *(u32x4*)(Mo + row * 1024 + col + bj * 128) = w; } } }
        }
    }
};
struct MergeOrder {
    pg8::StaticOrder so;
    __device__ bool next(int i, pg8::Unit& u) const { const int t = i / 3; if (!so.next(t, u)) return false; u.br = i - 3 * t; return true; }
    __device__ __forceinline__ void a_ready(const pg8::Unit&) const {}
    __device__ __forceinline__ void done(const pg8::Unit&) const {}
};
struct EpiResid {
    static constexpr bool PERM = false, AFTER_DRAIN = false, CHAIN = false;
    const float *old_l, *old_c; float *out_l, *out_c; const float* mod; int gidx;
    __device__ __forceinline__ void operator()(AccRef acc, const pg8::Unit& u, int wr, int wc, int fr, int fq) const {
        const int col0 = u.pn * 256 + wc * 32 + 4 * fq;
        const bool isctx = u.pm >= TL / 256; const int b = isctx ? 8 : u.pm / (SEQ / 256);
        const float* g = mod + (size_t)b * 6144 + gidx * 1024 + col0;
        const float* ob = isctx ? old_c - (size_t)TL * D : old_l; float* wb = isctx ? out_c - (size_t)TL * D : out_l;
        f32x4 gv[2][2];
#pragma unroll
        for (int bj = 0; bj < 2; ++bj)
#pragma unroll
            for (int n = 0; n < 2; ++n) gv[bj][n] = *(const f32x4*)(g + bj * 128 + n * 16);
#pragma unroll
        for (int ai = 0; ai < 2; ++ai) {
            f32x4 xo[4][2][2];
#pragma unroll
            for (int m = 0; m < 4; ++m) { const size_t off = (size_t)(u.pm * 256 + ai * 128 + wr * 64 + m * 16 + fr) * D + col0;
#pragma unroll
                for (int bj = 0; bj < 2; ++bj)
#pragma unroll
                    for (int n = 0; n < 2; ++n) xo[m][bj][n] = *(const f32x4*)(ob + off + bj * 128 + n * 16); }
#pragma unroll
            for (int m = 0; m < 4; ++m) { const size_t off = (size_t)(u.pm * 256 + ai * 128 + wr * 64 + m * 16 + fr) * D + col0;
#pragma unroll
                for (int bj = 0; bj < 2; ++bj)
#pragma unroll
                    for (int n = 0; n < 2; ++n) *(f32x4*)(wb + off + bj * 128 + n * 16) = xo[m][bj][n] + gv[bj][n] * acc[ai][bj][m][n]; }
        }
    }
};
struct EpiSwiglu {
    static constexpr bool PERM = true, AFTER_DRAIN = false, CHAIN = false;
    bf16_t* h1; int NJ;
    __device__ __forceinline__ void operator()(AccRef acc, const pg8::Unit& u, int wr, int wc, int fr, int fq) const {
        const int row0 = u.pm * 256 + wr * 64 + fr, col = (u.pn % NJ) * 128 + wc * 32 + 8 * fq;
#pragma unroll
        for (int ai = 0; ai < 2; ++ai)
#pragma unroll
            for (int m = 0; m < 4; ++m) { const f32x4 a0 = acc[ai][0][m][0], a1 = acc[ai][0][m][1], b0 = acc[ai][1][m][0], b1 = acc[ai][1][m][1];
                u32x4 w; w.x = pk2(siluf_(a0[0]) * b0[0], siluf_(a0[1]) * b0[1]); w.y = pk2(siluf_(a0[2]) * b0[2], siluf_(a0[3]) * b0[3]);
                w.z = pk2(siluf_(a1[0]) * b1[0], siluf_(a1[1]) * b1[1]); w.w = pk2(siluf_(a1[2]) * b1[2], siluf_(a1[3]) * b1[3]);
                *(u32x4*)(h1 + (size_t)(row0 + ai * 128 + m * 16) * DFF + col) = w; }
    }
};
struct EpiMoeDown {
    static constexpr bool PERM = true, AFTER_DRAIN = false, CHAIN = false;
    bf16_t* y;
    __device__ __forceinline__ void operator()(AccRef acc, const pg8::Unit& u, int wr, int wc, int fr, int fq) const {
        const int row0 = u.pm * 256 + wr * 64 + fr, col = (u.pn % 4) * 256 + wc * 32 + 8 * fq;
#pragma unroll
        for (int ai = 0; ai < 2; ++ai)
#pragma unroll
            for (int m = 0; m < 4; ++m) { bf16_t* rowp = y + (size_t)(row0 + ai * 128 + m * 16) * D + col;
#pragma unroll
                for (int bj = 0; bj < 2; ++bj) { const f32x4 v0 = acc[ai][bj][m][0], v1 = acc[ai][bj][m][1];
                    u32x4 w; w.x = pk2(v0[0], v0[1]); w.y = pk2(v0[2], v0[3]); w.z = pk2(v1[0], v1[1]); w.w = pk2(v1[2], v1[3]);
                    *(u32x4*)(rowp + bj * 128) = w; } }
    }
};
struct MoeOrder {
    int ntiles, NJ, G, c; const int* tile_e;
    __device__ bool next(int i, pg8::Unit& u) const { const long L = (long)i * G + c; if (L >= (long)ntiles * NJ) return false;
        const int t = (int)(L / NJ), j = (int)(L % NJ); u.pm = t; u.pn = tile_e[t] * NJ + j; return true; }
    __device__ __forceinline__ void a_ready(const pg8::Unit&) const {}
    __device__ __forceinline__ void done(const pg8::Unit&) const {}
};

#define XB_TMO      128
#define XB_XCNT(j)  (256  + 64 * (j))
#define XB_XSUB(j)  (1280 + 64 * (j))
#define XB_XGEN(j)  (2304 + 64 * (j))
#define XB_TOP      3328
#define XB_TOPGEN   3392
#define XCD_BAR_WORDS 3456
#define XB_SPIN_CAP (1u << 18)

__device__ __forceinline__ unsigned xb_ld(unsigned* p)              { return __hip_atomic_load(p, __ATOMIC_RELAXED, __HIP_MEMORY_SCOPE_AGENT); }
__device__ __forceinline__ unsigned xb_add(unsigned* p, unsigned v) { return __hip_atomic_fetch_add(p, v, __ATOMIC_RELAXED, __HIP_MEMORY_SCOPE_AGENT); }
__device__ __forceinline__ unsigned xb_xcc_id() { return (unsigned)__builtin_amdgcn_s_getreg((3 << 11) | 20) & 0xFu; }
#define XB_SPIN(cond, bar) do { unsigned _sp = 0; while (cond) { __builtin_amdgcn_s_sleep(1); \
    if ((++_sp & 255u) == 0u) { if (xb_ld(&(bar)[XB_TMO])) break; if (_sp > XB_SPIN_CAP) { atomicAdd(&(bar)[XB_TMO], 1u); break; } } } } while (0)

struct XcdBarrier {
    unsigned* bar; unsigned x;
    volatile unsigned* st;
};

__device__ __forceinline__ XcdBarrier xcd_barrier_post(unsigned* bar, volatile unsigned* st) {
    XcdBarrier b; b.bar = bar; b.x = xb_xcc_id(); b.st = st;
    if (threadIdx.x == 0) (void)xb_add(&bar[XB_XCNT(b.x)], 1u);
    return b;
}
__device__ __forceinline__ void xcd_barrier_complete(unsigned* bar, unsigned x, unsigned& nloc, unsigned& nx) {
    const unsigned G = gridDim.x * gridDim.y * gridDim.z;
    unsigned sum, cnt, mine, sp = 0u;
    for (;;) {
        sum = 0u; cnt = 0u; mine = 0u;
#pragma unroll
        for (unsigned j = 0; j < 16; ++j) { const unsigned c = xb_ld(&bar[XB_XCNT(j)]); sum += c; cnt += (c > 0u) ? 1u : 0u; mine = (j == x) ? c : mine; }
        if (sum == G) break;
        __builtin_amdgcn_s_sleep(1);
        if ((++sp & 255u) == 0u) { if (xb_ld(&bar[XB_TMO])) break; if (sp > XB_SPIN_CAP) { atomicAdd(&bar[XB_TMO], 1u); break; } }
    }
    nloc = mine > 0u ? mine : 1u; nx = cnt > 0u ? cnt : 1u;
}

__device__ __forceinline__ void xcd_barrier(const XcdBarrier& b) {
    asm volatile("s_waitcnt vmcnt(0)" ::: "memory");
    __syncthreads();
    if (threadIdx.x == 0) {
        unsigned* bar = b.bar;
        __builtin_amdgcn_s_waitcnt(0);
        unsigned nloc = b.st[0], nx = b.st[1];
        if (nloc == 0u) { xcd_barrier_complete(bar, b.x, nloc, nx); b.st[0] = nloc; b.st[1] = nx; }
        const unsigned old = xb_add(&bar[XB_XSUB(b.x)], 1u);
        const unsigned gen = old / nloc;
        if (old + 1u == (gen + 1u) * nloc) {
            __builtin_amdgcn_fence(__ATOMIC_RELEASE, "agent");
            asm volatile("s_waitcnt vmcnt(0)" ::: "memory");
            const unsigned og = xb_add(&bar[XB_TOP], 1u);
            const unsigned tg = og / nx;
            if (og + 1u == (tg + 1u) * nx) xb_add(&bar[XB_TOPGEN], 1u);
            else XB_SPIN(xb_ld(&bar[XB_TOPGEN]) == tg, bar);
            __builtin_amdgcn_fence(__ATOMIC_ACQUIRE, "agent");
            xb_add(&bar[XB_XGEN(b.x)], 1u);
            asm volatile("s_waitcnt vmcnt(0)" ::: "memory");
        } else {
            XB_SPIN(xb_ld(&bar[XB_XGEN(b.x)]) == gen, bar);
            __builtin_amdgcn_fence(__ATOMIC_ACQUIRE, "agent");
            asm volatile("s_waitcnt vmcnt(0)" ::: "memory");
        }
    }
    __syncthreads();
}

__device__ __forceinline__ void phase_mod(const P& p, unsigned char* lds) {
    float* sc = (float*)lds;
    float* red = sc + 9 * 1024;
    const int tid = otid();
    for (int i = tid; i < 9 * 1024; i += NTHREADS) { const int r = i >> 10, k = i & 1023; const float v = r < 8 ? p.c[r * 1024 + k] : p.c_ctx[k]; sc[i] = siluf_(v); }
    __syncthreads();
    float* MOD = (float*)(p.ws + WS_MOD);
    const int cj = tid % 48, ks = tid / 48;
    for (int grp = blockIdx.x; grp < DEPTH * 6144 / 48; grp += gridDim.x) {
        const int l = grp / 128, j = (grp % 128) * 48 + cj;
        float a[9];
#pragma unroll
        for (int r = 0; r < 9; ++r) a[r] = 0.f;
        if (ks < 10) {
            const float* w = p.w_mod + (size_t)l * 1024 * 6144 + j;
            for (int k = ks; k < 1024; k += 10) { const float wv = w[(size_t)k * 6144];
#pragma unroll
                for (int r = 0; r < 9; ++r) a[r] += sc[r * 1024 + k] * wv; }
#pragma unroll
            for (int r = 0; r < 9; ++r) red[(ks * 9 + r) * 48 + cj] = a[r];
        }
        __syncthreads();
        if (tid < 9 * 48) { const int r = tid / 48, c2 = tid % 48; float s = 0.f;
#pragma unroll
            for (int q = 0; q < 10; ++q) s += red[(q * 9 + r) * 48 + c2];
            const int jj = (grp % 128) * 48 + c2;
            MOD[((size_t)l * 9 + r) * 6144 + jj] = s + p.b_mod[l * 6144 + jj]; }
        __syncthreads();
    }
}

__device__ __forceinline__ void phase_modulate(const float* src_l, const float* src_c, int nrows, const float* gain, const float* mod, int shift_idx,
                                               bf16_t* H, const float* router_w, int* route, unsigned* ecnt, unsigned* lcnt  , int gw, int NGW, int lane) {
    if (router_w) { if (otid() < NE) lcnt[otid()] = 0u; __syncthreads(); }
    for (int r = gw; r < nrows; r += NGW) {
        const bool isctx = r >= TL; const int b = isctx ? 8 : r / SEQ;
        const float* xr = isctx ? src_c + (size_t)(r - TL) * D : src_l + (size_t)r * D;
        const float* sh = mod + (size_t)b * 6144 + shift_idx * 1024; const float* scl = sh + 1024;
        f32x4 v[4]; float ss = 0.f;
#pragma unroll
        for (int j = 0; j < 4; ++j) { v[j] = *(const f32x4*)(xr + 4 * lane + 256 * j); ss += (v[j][0] * v[j][0] + v[j][1] * v[j][1]) + (v[j][2] * v[j][2] + v[j][3] * v[j][3]); }
        const float rs = 1.0f / sqrtf(wave_sum(ss) * (1.0f / D) + EPS);
#pragma unroll
        for (int j = 0; j < 4; ++j) { const int c = 4 * lane + 256 * j; const f32x4 g = *(const f32x4*)(gain + c), s1 = *(const f32x4*)(scl + c), s0 = *(const f32x4*)(sh + c);
            v[j] = v[j] * rs * g * (1.0f + s1) + s0;
            u32x2 w; w.x = pk2(v[j][0], v[j][1]); w.y = pk2(v[j][2], v[j][3]);
            *(u32x2*)(H + (size_t)r * D + c) = w; }
        if (router_w) {
            float lg[NE];
#pragma unroll
            for (int e = 0; e < NE; ++e) lg[e] = 0.f;
#pragma unroll
            for (int j = 0; j < 4; ++j)
#pragma unroll
                for (int q = 0; q < 4; ++q) { const float* rw = router_w + (size_t)(4 * lane + 256 * j + q) * NE; const f32x4 r0 = *(const f32x4*)rw, r1 = *(const f32x4*)(rw + 4); const float hv = v[j][q];
                    lg[0] += hv * r0[0]; lg[1] += hv * r0[1]; lg[2] += hv * r0[2]; lg[3] += hv * r0[3]; lg[4] += hv * r1[0]; lg[5] += hv * r1[1]; lg[6] += hv * r1[2]; lg[7] += hv * r1[3]; }
#pragma unroll
            for (int e = 0; e < NE; ++e) lg[e] = wave_sum(lg[e]);
            int e1 = 0; float v1 = lg[0];
#pragma unroll
            for (int e = 1; e < NE; ++e) if (lg[e] > v1) { v1 = lg[e]; e1 = e; }
            int e2 = e1 == 0 ? 1 : 0; float v2 = lg[e2];
#pragma unroll
            for (int e = 0; e < NE; ++e) if (e != e1 && lg[e] > v2) { v2 = lg[e]; e2 = e; }
            const float w2 = 1.0f / (1.0f + expf(v1 - v2)), w1 = 1.0f - w2;
            if (lane == 0) { route[r * 4 + 0] = e1; route[r * 4 + 1] = e2; ((float*)route)[r * 4 + 2] = w1; ((float*)route)[r * 4 + 3] = w2;
                atomicAdd(lcnt + e1, 1u); atomicAdd(lcnt + e2, 1u); }
        }
    }
    if (router_w) { __syncthreads(); if (otid() < NE && lcnt[otid()]) atomicAdd(ecnt + otid(), lcnt[otid()]); }
}


typedef short v4i16_t __attribute__((ext_vector_type(4)));
__device__ __forceinline__ s16x4 lds_tr(const bf16_t* pp) { return __builtin_bit_cast(s16x4, __builtin_amdgcn_ds_read_tr16_b64_v4i16((__attribute__((address_space(3))) v4i16_t*)pp)); }
__device__ __forceinline__ bf16x8 cat8(s16x4 a, s16x4 b) { union { bf16x8 v; s16x4 h[2]; } u; u.h[0] = a; u.h[1] = b; return u.v; }
__device__ __forceinline__ bf16x8 pack8(f32x4 a, f32x4 b) { union { bf16x8 v; unsigned u[4]; } r; r.u[0] = pk2(a[0], a[1]); r.u[1] = pk2(a[2], a[3]); r.u[2] = pk2(b[0], b[1]); r.u[3] = pk2(b[2], b[3]); return r.v; }
constexpr int DN_NCH = (CTXL + SEQ) / 64;
constexpr int DN_ITEMS = BATCH * 4 * 2 * DN_NCH;
constexpr int PREP_WLDS = 16384 + 17408 + 512;

__device__ __forceinline__ int dn_row(int n, int s, int b, int dir) {
    const bool isctx = n < CTXL / 64; const int L = isctx ? CTXL : SEQ, c = isctx ? n : n - CTXL / 64, u = 64 * c + s, t = dir ? L - 1 - u : u;
    return (isctx ? TL + b * CTXL : b * SEQ) + t;
}
__device__ __forceinline__ void dn_prep_item(const P& p, int l, int item, unsigned char* wlds, int lane) {
    const int n = item % DN_NCH, bhd = item / DN_NCH, dir = bhd & 1, h = (bhd >> 1) & 3, b = bhd >> 3;
    const bool isctx = n < CTXL / 64; const int L = isctx ? CTXL : SEQ, cch = isctx ? n : n - CTXL / 64, rbase = isctx ? TL + b * CTXL : b * SEQ;
    const int i16 = lane & 15, g = lane >> 4;
    const bf16_t* PAQ = (const bf16_t*)(p.ws + WS_PAQ); bf16_t* DN = (bf16_t*)(p.ws + WS_DNQKV); const float* SMALL = (const float*)(p.ws + WS_SMALL);
    const float* cw = p.conv_a + (size_t)l * 3 * 1536;
    constexpr int KCP = 136;
    float* Ls = (float*)wlds; bf16_t* Kc = (bf16_t*)(wlds + 16384); float* Tl = (float*)(wlds + 16384);
    float* gcs = (float*)(wlds + 16384 + 17408); float* bes = gcs + 64;
    {
        const int r = dn_row(n, lane, b, dir);
        const float bb = SMALL[(size_t)r * 64 + dir * 4 + h], aa = SMALL[(size_t)r * 64 + 8 + dir * 4 + h];
        const float gv = -expf(p.a_log[l * 8 + dir * 4 + h]) * softplusf_(aa + p.dt_bias[l * 8 + dir * 4 + h]), be = sigmoidf_(bb);
        float gc = gv;
#pragma unroll
        for (int o = 1; o < 64; o <<= 1) { const float u = shup(gc, o); if (lane >= o) gc += u; }
        const float gl = shlane(gc, 63);
        gcs[lane] = gc; bes[lane] = be;
        float* vec = (float*)(p.ws + WS_VEC) + (size_t)item * 256;
        vec[lane] = expf(gc); vec[64 + lane] = expf(gl - gc); vec[128 + lane] = be; vec[192 + lane] = expf(gl);
    }
    auto conv_frag = [&](int seg, int mt, bf16x8 (&F)[4]) {
        const int u = 64 * cch + 16 * mt + i16, t = dir ? L - 1 - u : u; const size_t r = (size_t)(rbase + t);
        float y[4][8]; float ss = 0.f;
#pragma unroll
        for (int ks = 0; ks < 4; ++ks) { const int col = seg * 512 + h * 128 + 32 * ks + 8 * g;
            const u32x4 x1 = *(const u32x4*)(PAQ + r * 1536 + col);
            u32x4 x0 = (u32x4){0u, 0u, 0u, 0u}, x2 = (u32x4){0u, 0u, 0u, 0u};
            if (t > 0) x0 = *(const u32x4*)(PAQ + (r - 1) * 1536 + col);
            if (t < L - 1) x2 = *(const u32x4*)(PAQ + (r + 1) * 1536 + col);
            const f32x4 wa0 = *(const f32x4*)(cw + col), wa1 = *(const f32x4*)(cw + col + 4), wb0 = *(const f32x4*)(cw + 1536 + col), wb1 = *(const f32x4*)(cw + 1536 + col + 4),
                        wc0 = *(const f32x4*)(cw + 3072 + col), wc1 = *(const f32x4*)(cw + 3072 + col + 4);
            const unsigned xa[4] = {x0.x, x0.y, x0.z, x0.w}, xb[4] = {x1.x, x1.y, x1.z, x1.w}, xc[4] = {x2.x, x2.y, x2.z, x2.w};
#pragma unroll
            for (int q = 0; q < 4; ++q) { const f32x4& wa = q < 2 ? wa0 : wa1; const f32x4& wb = q < 2 ? wb0 : wb1; const f32x4& wc = q < 2 ? wc0 : wc1; const int e2 = (2 * q) & 3;
                const float v0 = siluf_(wa[e2] * bflo(xa[q]) + wb[e2] * bflo(xb[q]) + wc[e2] * bflo(xc[q])), v1 = siluf_(wa[e2 + 1] * bfhi(xa[q]) + wb[e2 + 1] * bfhi(xb[q]) + wc[e2 + 1] * bfhi(xc[q]));
                y[ks][2 * q] = v0; y[ks][2 * q + 1] = v1; ss += v0 * v0 + v1 * v1; }
            if (ks == 1) asm volatile("" ::: "memory");
        }
        float sc = 1.0f;
        if (seg < 2) { ss += shx(ss, 16); ss += shx(ss, 32); sc = 1.0f / sqrtf(ss + EPS); if (seg == 0) sc *= 0.08838834764831845f; }
#pragma unroll
        for (int ks = 0; ks < 4; ++ks) { union { bf16x8 v; u32x4 w; } f;
            f.w.x = pk2(y[ks][0] * sc, y[ks][1] * sc); f.w.y = pk2(y[ks][2] * sc, y[ks][3] * sc); f.w.z = pk2(y[ks][4] * sc, y[ks][5] * sc); f.w.w = pk2(y[ks][6] * sc, y[ks][7] * sc);
            F[ks] = f.v;
            if (dir == 0) *(u32x4*)(DN + r * 1536 + seg * 512 + h * 128 + 32 * ks + 8 * g) = f.w; }
    };
#pragma unroll 1
    for (int mt = 0; mt < 4; ++mt) { bf16x8 F[4]; conv_frag(1, mt, F);
#pragma unroll
        for (int ks = 0; ks < 4; ++ks) *(bf16x8*)(Kc + (16 * mt + i16) * KCP + 32 * ks + 8 * g) = F[ks]; }
    if (dir == 0) {
#pragma unroll 1
        for (int mt = 0; mt < 4; ++mt) { bf16x8 F[4]; conv_frag(2, mt, F); } }
    asm volatile("s_waitcnt lgkmcnt(0)" ::: "memory");
#pragma unroll 1
    for (int mt = 0; mt < 4; ++mt) {
        bf16x8 A[4];
#pragma unroll
        for (int ks = 0; ks < 4; ++ks) A[ks] = *(const bf16x8*)(Kc + (16 * mt + i16) * KCP + 32 * ks + 8 * g);
#pragma unroll 1
        for (int nt = 0; nt <= mt; ++nt) { f32x4 acc = (f32x4){0.f, 0.f, 0.f, 0.f};
#pragma unroll
            for (int ks = 0; ks < 4; ++ks) acc = __builtin_amdgcn_mfma_f32_16x16x32_bf16(A[ks], *(const bf16x8*)(Kc + (16 * nt + i16) * KCP + 32 * ks + 8 * g), acc, 0, 0, 0);
            const int j = 16 * nt + i16; const float gj = gcs[j]; f32x4 lv;
#pragma unroll
            for (int rg = 0; rg < 4; ++rg) { const int i = 16 * mt + 4 * g + rg; lv[rg] = i > j ? bes[i] * acc[rg] * __expf(gcs[i] - gj) : 0.f; }
            *(f32x4*)(Ls + j * 64 + 16 * mt + 4 * g) = lv; }
    }
    bf16_t* QKg = (bf16_t*)(p.ws + WS_TQ + (size_t)item * 16384 + 8192);
#pragma unroll 1
    for (int mt = 0; mt < 4; ++mt) { bf16x8 Qf[4]; conv_frag(0, mt, Qf);
#pragma unroll 1
        for (int nt = 0; nt < 4; ++nt) { f32x4 acc = (f32x4){0.f, 0.f, 0.f, 0.f}; const int j = 16 * nt + i16;
            if (nt <= mt) {
#pragma unroll
                for (int ks = 0; ks < 4; ++ks) acc = __builtin_amdgcn_mfma_f32_16x16x32_bf16(Qf[ks], *(const bf16x8*)(Kc + (16 * nt + i16) * KCP + 32 * ks + 8 * g), acc, 0, 0, 0);
                const float gj = gcs[j];
#pragma unroll
                for (int rg = 0; rg < 4; ++rg) { const int i = 16 * mt + 4 * g + rg; acc[rg] = i >= j ? acc[rg] * __expf(gcs[i] - gj) : 0.f; } }
#pragma unroll
            for (int rg = 0; rg < 4; ++rg) QKg[(16 * mt + 4 * g + rg) * 64 + j] = (bf16_t)f2bf(acc[rg]); } }
    asm volatile("s_waitcnt lgkmcnt(0)" ::: "memory");
#pragma unroll 1
    for (int B = 0; B < 4; ++B) {
        float s[16];
#pragma unroll
        for (int ii = 0; ii < 16; ++ii) s[ii] = (16 * B + ii == lane) ? 1.f : 0.f;
#pragma unroll 2
        for (int j = 0; j < 16 * B; ++j) { const float tj = Tl[j * 64 + lane]; const float* lc = Ls + j * 64 + 16 * B;
            const f32x4 l0 = *(const f32x4*)lc, l1 = *(const f32x4*)(lc + 4), l2 = *(const f32x4*)(lc + 8), l3 = *(const f32x4*)(lc + 12);
#pragma unroll
            for (int q = 0; q < 4; ++q) { s[q] -= l0[q] * tj; s[4 + q] -= l1[q] * tj; s[8 + q] -= l2[q] * tj; s[12 + q] -= l3[q] * tj; } }
#pragma unroll
        for (int jj = 0; jj < 16; ++jj) { const float tj = s[jj]; Tl[(16 * B + jj) * 64 + lane] = tj; const float* lc = Ls + (16 * B + jj) * 64 + 16 * B;
            const f32x4 l0 = *(const f32x4*)lc, l1 = *(const f32x4*)(lc + 4), l2 = *(const f32x4*)(lc + 8), l3 = *(const f32x4*)(lc + 12);
#pragma unroll
            for (int q = 0; q < 4; ++q) { if (q > jj) s[q] -= l0[q] * tj; if (4 + q > jj) s[4 + q] -= l1[q] * tj; if (8 + q > jj) s[8 + q] -= l2[q] * tj; if (12 + q > jj) s[12 + q] -= l3[q] * tj; } }
        asm volatile("s_waitcnt lgkmcnt(0)" ::: "memory");
    }
    asm volatile("s_waitcnt lgkmcnt(0)" ::: "memory");
    bf16_t* Tg = (bf16_t*)(p.ws + WS_TQ + (size_t)item * 16384);
    for (int i = 0; i < 64; ++i) Tg[i * 64 + lane] = (bf16_t)f2bf(Tl[i * 64 + lane]);
    asm volatile("s_waitcnt lgkmcnt(0)" ::: "memory");
}

__device__ __forceinline__ void dn_chain_mfma(const P& p, int item, unsigned char* lds) {
    const int b = item >> 3, h = (item >> 1) & 3, dir = item & 1, tid = otid(), lane = tid & 63, w = tid >> 6, i16 = lane & 15, g = lane >> 4;
    constexpr int KP = 136, TP = 72;
    bf16_t* Ks = (bf16_t*)lds; bf16_t* Qs = Ks + 64 * KP; bf16_t* Vs = Qs + 64 * KP; bf16_t* Ts = Vs + 64 * KP; bf16_t* QKs = Ts + 64 * TP; float* vec = (float*)(QKs + 64 * TP);
    const bf16_t* DN = (const bf16_t*)(p.ws + WS_DNQKV); bf16_t* OA = (bf16_t*)(p.ws + WS_H) + (size_t)dir * T * 512;
    f32x4 S[8];
#pragma unroll
    for (int dt = 0; dt < 8; ++dt) S[dt] = (f32x4){0.f, 0.f, 0.f, 0.f};
    u32x4 pf[9];
    auto prefetch = [&](int n) {
        const int pitem = item * DN_NCH + n;
#pragma unroll
        for (int u = 0; u < 6; ++u) { const int q = tid + 512 * u, which = q >> 10, rem = q & 1023, s = rem >> 4, ch = rem & 15;
            pf[u] = *(const u32x4*)(DN + (size_t)dn_row(n, s, b, dir) * 1536 + (which == 0 ? 512 : which == 1 ? 0 : 1024) + h * 128 + ch * 8); }
#pragma unroll
        for (int u = 0; u < 2; ++u) pf[6 + u] = *(const u32x4*)(p.ws + WS_TQ + (size_t)pitem * 16384 + (size_t)u * 8192 + (size_t)tid * 16);
        if (tid < 64) pf[8] = *(const u32x4*)((const float*)(p.ws + WS_VEC) + (size_t)pitem * 256 + tid * 4);
    };
    prefetch(0);
    for (int n = 0; n < DN_NCH; ++n) {
        __syncthreads();
#pragma unroll
        for (int u = 0; u < 6; ++u) { const int q = tid + 512 * u, which = q >> 10, rem = q & 1023, s = rem >> 4, ch = rem & 15;
            *(u32x4*)((which == 0 ? Ks : which == 1 ? Qs : Vs) + s * KP + ch * 8) = pf[u]; }
#pragma unroll
        for (int u = 0; u < 2; ++u) *(u32x4*)((u == 0 ? Ts : QKs) + (tid >> 3) * TP + (tid & 7) * 8) = pf[6 + u];
        if (tid < 64) *(u32x4*)(vec + tid * 4) = pf[8];
        __syncthreads();
        if (n + 1 < DN_NCH) prefetch(n + 1);
        const float* egv = vec; const float* eklv = vec + 64; const float* bev = vec + 128; const float glast = vec[192];
        bf16x8 Sb[4];
#pragma unroll
        for (int ks = 0; ks < 4; ++ks) Sb[ks] = pack8(S[2 * ks], S[2 * ks + 1]);
        f32x4 r_[4], o_[4];
#pragma unroll
        for (int mt = 0; mt < 4; ++mt) { r_[mt] = (f32x4){0.f, 0.f, 0.f, 0.f}; o_[mt] = (f32x4){0.f, 0.f, 0.f, 0.f};
            const bf16_t* kr = Ks + (16 * mt + i16) * KP + 4 * g; const bf16_t* qr = Qs + (16 * mt + i16) * KP + 4 * g;
#pragma unroll
            for (int ks = 0; ks < 4; ++ks) { const bf16x8 ak = cat8(*(const s16x4*)(kr + 32 * ks), *(const s16x4*)(kr + 32 * ks + 16)), aq = cat8(*(const s16x4*)(qr + 32 * ks), *(const s16x4*)(qr + 32 * ks + 16));
                r_[mt] = __builtin_amdgcn_mfma_f32_16x16x32_bf16(ak, Sb[ks], r_[mt], 0, 0, 0); o_[mt] = __builtin_amdgcn_mfma_f32_16x16x32_bf16(aq, Sb[ks], o_[mt], 0, 0, 0); } }
        f32x4 eg[4];
#pragma unroll
        for (int mt = 0; mt < 4; ++mt) { eg[mt] = *(const f32x4*)(egv + 16 * mt + 4 * g); const f32x4 be = *(const f32x4*)(bev + 16 * mt + 4 * g);
#pragma unroll
            for (int rg = 0; rg < 4; ++rg) { const float v = bf2f(Vs[(16 * mt + 4 * g + rg) * KP + 16 * w + i16]); r_[mt][rg] = be[rg] * (v - eg[mt][rg] * r_[mt][rg]); o_[mt][rg] *= eg[mt][rg]; } }
        bf16x8 Rb[2];
#pragma unroll
        for (int k2 = 0; k2 < 2; ++k2) Rb[k2] = pack8(r_[2 * k2], r_[2 * k2 + 1]);
        f32x4 vn[4];
#pragma unroll
        for (int mt = 0; mt < 4; ++mt) { vn[mt] = (f32x4){0.f, 0.f, 0.f, 0.f}; const bf16_t* tr = Ts + (16 * mt + i16) * TP + 4 * g;
#pragma unroll
            for (int k2 = 0; k2 < 2; ++k2) vn[mt] = __builtin_amdgcn_mfma_f32_16x16x32_bf16(cat8(*(const s16x4*)(tr + 32 * k2), *(const s16x4*)(tr + 32 * k2 + 16)), Rb[k2], vn[mt], 0, 0, 0); }
        bf16x8 Vb[2], Wb[2];
#pragma unroll
        for (int k2 = 0; k2 < 2; ++k2) { Vb[k2] = pack8(vn[2 * k2], vn[2 * k2 + 1]);
            const f32x4 e0 = *(const f32x4*)(eklv + 32 * k2 + 4 * g), e1 = *(const f32x4*)(eklv + 32 * k2 + 16 + 4 * g); Wb[k2] = pack8(vn[2 * k2] * e0, vn[2 * k2 + 1] * e1); }
#pragma unroll
        for (int mt = 0; mt < 4; ++mt) { const bf16_t* qkr = QKs + (16 * mt + i16) * TP + 4 * g;
#pragma unroll
            for (int k2 = 0; k2 < 2; ++k2) o_[mt] = __builtin_amdgcn_mfma_f32_16x16x32_bf16(cat8(*(const s16x4*)(qkr + 32 * k2), *(const s16x4*)(qkr + 32 * k2 + 16)), Vb[k2], o_[mt], 0, 0, 0); }
#pragma unroll
        for (int dt = 0; dt < 8; ++dt) { S[dt] = S[dt] * glast;
#pragma unroll
            for (int k2 = 0; k2 < 2; ++k2) { const bf16_t* a0 = Ks + (32 * k2 + 4 * g + (i16 >> 2)) * KP + 16 * dt + 4 * (i16 & 3);
                S[dt] = __builtin_amdgcn_mfma_f32_16x16x32_bf16(cat8(lds_tr(a0), lds_tr(a0 + 16 * KP)), Wb[k2], S[dt], 0, 0, 0); } }
#pragma unroll
        for (int mt = 0; mt < 4; ++mt)
#pragma unroll
            for (int rg = 0; rg < 4; ++rg) OA[(size_t)dn_row(n, 16 * mt + 4 * g + rg, b, dir) * 512 + h * 128 + 16 * w + i16] = (bf16_t)f2bf(o_[mt][rg]);
    }
}

__device__ __forceinline__ void phase_prep(const P& p, int l, unsigned char* lds, int gw, int NGW, int lane) {
    unsigned char* ws = p.ws;
    bf16_t* PC = (bf16_t*)(ws + WS_PC); unsigned* ctl = (unsigned*)(ws + WS_CTL);
    const int wv = gw % NWAVES, blk = gw / NWAVES, G_ = NGW / NWAVES;
    if (wv < 4) { for (int rep = 0; rep < REP_DNPREP; ++rep) for (int it = blk * 4 + wv; it < DN_ITEMS; it += G_ * 4) dn_prep_item(p, l, it, lds + wv * PREP_WLDS, lane); return; }
    const int gt = (blk * 4 + (wv - 4)) * 64 + lane, NGT = G_ * 4 * 64;
    float kmx = 0.f; int kbb = -1, kh = 0, km = 0;
    for (long i = gt; i < (long)T * 512; i += NGT) {
        const int r = (int)(i >> 9), q = (int)(i & 511), seg = q >> 8, h = (q >> 6) & 3, m = (q >> 5) & 1, pi = q & 31;
        const int half = pi >> 4, fi = pi & 15, d1 = half * 32 + fi, d2 = d1 + 16;
        bf16_t* base = PC + (size_t)r * 1536 + seg * 512 + h * 128 + m * 64;
        float x1 = bf2f(base[d1]), x2 = bf2f(base[d2]);
        const bool lat = r < TL; const int b = lat ? r / SEQ : (r - TL) / CTXL;
        if (lat) { const int t = r % SEQ; const float pos = half ? (float)(t & 63) : (float)(t >> 6);
            const float ang = pos * exp2f(-(float)fi * 0.8304820237218406f);
            float sn, cs; sincosf(ang, &sn, &cs);
            const float o1 = x1 * cs - x2 * sn, o2 = x2 * cs + x1 * sn; x1 = o1; x2 = o2; }
        if (seg == 0) { x1 *= 0.18033688011112042f; x2 *= 0.18033688011112042f; }
        const bf16_t r1 = (bf16_t)f2bf(x1), r2 = (bf16_t)f2bf(x2);
        if (lat || seg == 0) { base[d1] = r1; base[d2] = r2; }
        float ss = bf2f(r1) * bf2f(r1) + bf2f(r2) * bf2f(r2);
#pragma unroll
        for (int o = 1; o < 32; o <<= 1) ss += shx(ss, o);
        if (seg == 1) {
            if (b != kbb) { if (kbb >= 0 && (lane & 31) == 0) atomicMax(ctl + CW_KMAX + l * 64 + (kbb * 4 + kh) * 2 + km, __builtin_bit_cast(unsigned, sqrtf(kmx))); kbb = b; kmx = 0.f; }
            kh = h; km = m; kmx = fmaxf(kmx, ss); }
    }
    if (kbb >= 0 && (lane & 31) == 0) atomicMax(ctl + CW_KMAX + l * 64 + (kbb * 4 + kh) * 2 + km, __builtin_bit_cast(unsigned, sqrtf(kmx)));
    if (blk == 0 && wv == 4) { float a = 0.f, bq = 0.f; const float* lc = p.lam_c + (size_t)l * 256;
        a = wave_sum(lc[lane] * lc[64 + lane]); bq = wave_sum(lc[128 + lane] * lc[192 + lane]);
        const float lam_init = 0.8f - 0.6f * expf(-0.3f * (float)l);
        if (lane == 0) ((float*)(ws + WS_MISC))[MI_LAMF + l] = expf(a) - expf(bq) + lam_init; }
}

__device__ __forceinline__ void dn_chain(const P& p, int item, unsigned char* lds) {
    const int b = item >> 3, h = (item >> 1) & 3, dir = item & 1, tid = otid(), c = tid >> 2, ks = tid & 3;
    const bf16_t* DN = (const bf16_t*)(p.ws + WS_DNQKV); const float* GB = (const float*)(p.ws + WS_GB);
    bf16_t* OA = (bf16_t*)(p.ws + WS_H) + (size_t)dir * T * 512;
    constexpr int TB = 32;
    float* qs = (float*)lds; float* ksm = qs + TB * 128; float* vs = ksm + TB * 128; float* gs = vs + TB * 128; float* bs = gs + TB; float* ob = bs + TB;
    float S[32];
#pragma unroll
    for (int i = 0; i < 32; ++i) S[i] = 0.f;
    for (int part = 0; part < 2; ++part) {
        const int L = part == 0 ? CTXL : SEQ; const int rbase = part == 0 ? TL + b * CTXL : b * SEQ;
        for (int t0 = 0; t0 < L; t0 += TB) {
            __syncthreads();
            for (int i = tid; i < 3 * TB * 16; i += NTHREADS) { const int which = i / (TB * 16), rem = i % (TB * 16), tt = rem >> 4, ch = rem & 15;
                const int s = t0 + tt, t = dir ? L - 1 - s : s;
                const u32x4 w = *(const u32x4*)(DN + (size_t)(rbase + t) * 1536 + which * 512 + h * 128 + ch * 8);
                float* dst = (which == 0 ? qs : which == 1 ? ksm : vs) + tt * 128 + ch * 8;
                dst[0] = bflo(w.x); dst[1] = bfhi(w.x); dst[2] = bflo(w.y); dst[3] = bfhi(w.y); dst[4] = bflo(w.z); dst[5] = bfhi(w.z); dst[6] = bflo(w.w); dst[7] = bfhi(w.w); }
            if (tid < TB) { const int s = t0 + tid, t = dir ? L - 1 - s : s; gs[tid] = expf(GB[(size_t)(rbase + t) * 16 + dir * 4 + h]); bs[tid] = GB[(size_t)(rbase + t) * 16 + 8 + dir * 4 + h]; }
            __syncthreads();
            for (int tt = 0; tt < TB; ++tt) {
                const float eg = gs[tt], be = bs[tt];
                const float* kr = ksm + tt * 128 + ks * 32; const float* qr = qs + tt * 128 + ks * 32;
                float r = 0.f;
#pragma unroll
                for (int i = 0; i < 32; ++i) r += kr[i] * S[i];
                r += shx(r, 1); r += shx(r, 2);
                const float vn = be * (vs[tt * 128 + c] - eg * r);
                float o = 0.f;
#pragma unroll
                for (int i = 0; i < 32; ++i) { S[i] = eg * S[i] + kr[i] * vn; o += qr[i] * S[i]; }
                o += shx(o, 1); o += shx(o, 2);
                if (ks == 0) ob[tt * 128 + c] = o;
            }
            __syncthreads();
            for (int i = tid; i < TB * 64; i += NTHREADS) { const int tt = i >> 6, cp = i & 63; const int s = t0 + tt, t = dir ? L - 1 - s : s;
                *(unsigned*)(OA + (size_t)(rbase + t) * 512 + h * 128 + 2 * cp) = pk2(ob[tt * 128 + 2 * cp], ob[tt * 128 + 2 * cp + 1]); }
        }
    }
}
__device__ __forceinline__ void gla_chain_mfma(const P& p, int l, int item, unsigned char* lds) {
    const int b = item >> 3, h = (item >> 1) & 3, dir = item & 1, tid = otid(), lane = tid & 63, w = tid >> 6, i16 = lane & 15, g = lane >> 4;
    constexpr int RP = 72, VP = 72, OP = 136;
    bf16_t* qraw = (bf16_t*)lds;
    bf16_t* kraw = qraw + 64 * RP;
    bf16_t* Qt = kraw + 64 * RP;
    bf16_t* Kt = Qt + 64 * RP;
    bf16_t* KgT = Kt + 64 * RP;
    bf16_t* As = KgT + 64 * RP;
    bf16_t* Vt = As + 64 * RP;
    bf16_t* Os = Vt + 128 * VP;
    float* glr = (float*)(Os + 64 * OP);
    float* gts = glr + 64 * 16;
    float* gls = gts + 8 * 64;
    const bf16_t* PB = (const bf16_t*)(p.ws + WS_PB); const float* SMALL = (const float*)(p.ws + WS_SMALL);
    bf16_t* OB = (bf16_t*)(p.ws + WS_PAQ) + (size_t)dir * T * 512;
    float wgc[16];
#pragma unroll
    for (int j = 0; j < 16; ++j) wgc[j] = p.w_gate2[((size_t)l * 2 + dir) * 16 * 256 + j * 256 + h * 64 + lane];
    const float bgc = p.b_gate[((size_t)l * 2 + dir) * 256 + h * 64 + lane];
    f32x4 S[4];
#pragma unroll
    for (int dt = 0; dt < 4; ++dt) S[dt] = (f32x4){0.f, 0.f, 0.f, 0.f};
    __syncthreads();
    for (int i = tid; i < 64 * RP / 2; i += NTHREADS) ((unsigned*)As)[i] = 0u;
    u32x4 pf[5];
    auto prefetch = [&](int n) {
        { const int s = tid >> 3, ch = tid & 7; const size_t row = (size_t)dn_row(n, s, b, dir);
          pf[0] = *(const u32x4*)(PB + row * 1536 + h * 64 + ch * 8); pf[1] = *(const u32x4*)(PB + row * 1536 + 256 + h * 64 + ch * 8); }
#pragma unroll
        for (int u = 0; u < 2; ++u) { const int q = tid + 512 * u, s = q >> 4, ch = q & 15; pf[2 + u] = *(const u32x4*)(PB + (size_t)dn_row(n, s, b, dir) * 1536 + 512 + h * 128 + ch * 8); }
        if (tid < 256) { const int s = tid >> 2, ch = tid & 3; pf[4] = *(const u32x4*)(SMALL + (size_t)dn_row(n, s, b, dir) * 64 + 16 + dir * 16 + ch * 4); }
    };
    prefetch(0);
    for (int n = 0; n < DN_NCH; ++n) {
        __syncthreads();
        { const int s = tid >> 3, ch = tid & 7; *(u32x4*)(qraw + s * RP + ch * 8) = pf[0]; *(u32x4*)(kraw + s * RP + ch * 8) = pf[1]; }
#pragma unroll
        for (int u = 0; u < 2; ++u) { const int q = tid + 512 * u, s = q >> 4, ch = q & 15; const u32x4 v = pf[2 + u]; bf16_t* d = Vt + (ch * 8) * VP + s;
            d[0] = (bf16_t)v.x; d[VP] = (bf16_t)(v.x >> 16); d[2 * VP] = (bf16_t)v.y; d[3 * VP] = (bf16_t)(v.y >> 16); d[4 * VP] = (bf16_t)v.z; d[5 * VP] = (bf16_t)(v.z >> 16); d[6 * VP] = (bf16_t)v.w; d[7 * VP] = (bf16_t)(v.w >> 16); }
        if (tid < 256) *(u32x4*)(glr + tid * 4) = pf[4];
        __syncthreads();
        if (n + 1 < DN_NCH) prefetch(n + 1);
        float gcl[8];
        { float run = 0.f;
#pragma unroll
          for (int u = 0; u < 8; ++u) { const float* gr = glr + (8 * w + u) * 16; float z = bgc;
#pragma unroll
              for (int j = 0; j < 16; ++j) z += gr[j] * wgc[j];
              run += logsigmoid_fast(z) * 0.0625f; gcl[u] = run; }
          gts[w * 64 + lane] = run; }
        __syncthreads();
        { float pre = 0.f, tot = 0.f;
#pragma unroll
          for (int q = 0; q < 8; ++q) { const float t_ = gts[q * 64 + lane]; tot += t_; if (q < w) pre += t_; }
          unsigned kgp[4];
#pragma unroll
          for (int u = 0; u < 8; ++u) { const float gc = pre + gcl[u]; const float qv = bf2f(qraw[(8 * w + u) * RP + lane]), kv = bf2f(kraw[(8 * w + u) * RP + lane]);
              Qt[(8 * w + u) * RP + lane] = (bf16_t)f2bf(0.125f * qv * __expf(gc)); Kt[(8 * w + u) * RP + lane] = (bf16_t)f2bf(kv * __expf(-gc));
              const unsigned kgb = f2bf(kv * __expf(tot - gc)); if (u & 1) kgp[u >> 1] |= kgb << 16; else kgp[u >> 1] = kgb; }
          *(u32x4*)(KgT + lane * RP + 8 * w) = (u32x4){kgp[0], kgp[1], kgp[2], kgp[3]};
          if (w == 0) gls[lane] = __expf(tot); }
        __syncthreads();
#pragma unroll
        for (int rep = 0; rep < 2; ++rep) { const int tix = w + 8 * rep;
            if (tix < 10) { const int mt = tix < 1 ? 0 : tix < 3 ? 1 : tix < 6 ? 2 : 3, nt = tix - (mt * (mt + 1)) / 2;
                f32x4 acc = (f32x4){0.f, 0.f, 0.f, 0.f};
#pragma unroll
                for (int ks = 0; ks < 2; ++ks) acc = __builtin_amdgcn_mfma_f32_16x16x32_bf16(*(const bf16x8*)(Qt + (16 * mt + i16) * RP + 32 * ks + 8 * g), *(const bf16x8*)(Kt + (16 * nt + i16) * RP + 32 * ks + 8 * g), acc, 0, 0, 0);
                const int j = 16 * nt + i16;
#pragma unroll
                for (int rg = 0; rg < 4; ++rg) { const int i = 16 * mt + 4 * g + rg; As[i * RP + j] = (bf16_t)f2bf(i >= j ? acc[rg] : 0.f); } } }
        __syncthreads();
        { bf16x8 Sb[2];
#pragma unroll
          for (int ks = 0; ks < 2; ++ks) Sb[ks] = pack8(S[2 * ks], S[2 * ks + 1]);
          bf16x8 Vb[2];
#pragma unroll
          for (int ks = 0; ks < 2; ++ks) Vb[ks] = *(const bf16x8*)(Vt + (16 * w + i16) * VP + 32 * ks + 8 * g);
#pragma unroll
          for (int mt = 0; mt < 4; ++mt) { f32x4 o = (f32x4){0.f, 0.f, 0.f, 0.f}; const bf16_t* qr = Qt + (16 * mt + i16) * RP + 4 * g; const bf16_t* ar = As + (16 * mt + i16) * RP + 8 * g;
#pragma unroll
              for (int ks = 0; ks < 2; ++ks) { o = __builtin_amdgcn_mfma_f32_16x16x32_bf16(cat8(*(const s16x4*)(qr + 32 * ks), *(const s16x4*)(qr + 32 * ks + 16)), Sb[ks], o, 0, 0, 0);
                  o = __builtin_amdgcn_mfma_f32_16x16x32_bf16(*(const bf16x8*)(ar + 32 * ks), Vb[ks], o, 0, 0, 0); }
#pragma unroll
              for (int rg = 0; rg < 4; ++rg) Os[(16 * mt + 4 * g + rg) * OP + 16 * w + i16] = (bf16_t)f2bf(o[rg]); }
#pragma unroll
          for (int dt = 0; dt < 4; ++dt) { const f32x4 gl = *(const f32x4*)(gls + 16 * dt + 4 * g); S[dt] = S[dt] * gl;
#pragma unroll
              for (int ks = 0; ks < 2; ++ks) S[dt] = __builtin_amdgcn_mfma_f32_16x16x32_bf16(*(const bf16x8*)(KgT + (16 * dt + i16) * RP + 32 * ks + 8 * g), Vb[ks], S[dt], 0, 0, 0); } }
        __syncthreads();
#pragma unroll
        for (int u = 0; u < 2; ++u) { const int q = tid + 512 * u, s = q >> 4, ch = q & 15;
            *(u32x4*)(OB + (size_t)dn_row(n, s, b, dir) * 512 + h * 128 + ch * 8) = *(const u32x4*)(Os + s * OP + ch * 8); }
    }
}
__device__ __forceinline__ void attn_tile(const P& p, int l, int b, int h, int qrow0  , bool ctxq, unsigned char* lds, bool do_store = true) {
    constexpr int QP = 72, KP = 72, VP = 160;
    bf16_t* Qs = (bf16_t*)lds;
    constexpr int KVB = 2 * 64 * KP + 64 * VP;
    bf16_t* KV0 = Qs + 2 * 128 * QP;
    float* Oex = (float*)lds;
    bf16_t* PC = (bf16_t*)(p.ws + WS_PC);
    const int tid = otid(), lane = tid & 63, w = tid >> 6, m = w & 1, rg = w >> 1, q31 = lane & 31, hi = lane >> 5, i16 = lane & 15, gg = lane >> 4;
    const int nkt = ctxq ? CTXL / 64 : (CTXL + SEQ) / 64;
    u32x4 pk_[2], pv_[2];
    auto prefetch = [&](int kt) { const int krow0 = kt < CTXL / 64 ? TL + b * CTXL + kt * 64 : b * SEQ + (kt - CTXL / 64) * 64;
#pragma unroll
        for (int u = 0; u < 2; ++u) { const int i = tid + 512 * u, r = i >> 4, ch = i & 15; const bf16_t* rowp = PC + (size_t)(krow0 + r) * 1536 + h * 128 + ch * 8;
            pk_[u] = *(const u32x4*)(rowp + 512); pv_[u] = *(const u32x4*)(rowp + 1024); } };
    prefetch(0);
    __syncthreads();
    for (int i = tid; i < 128 * 16; i += NTHREADS) { const int r = i >> 4, ch = i & 15, mm = ch >> 3, c8 = (ch & 7) * 8;
        *(u32x4*)(Qs + (mm * 128 + r) * QP + c8) = *(const u32x4*)(PC + (size_t)(qrow0 + r) * 1536 + h * 128 + ch * 8); }
    __syncthreads();
    const bf16_t* qrow = Qs + (m * 128 + rg * 32 + q31) * QP;
    bf16x8 bq[4]; float qn = 0.f;
#pragma unroll
    for (int kk = 0; kk < 4; ++kk) bq[kk] = *(const bf16x8*)(qrow + 16 * kk + 8 * hi);
#pragma unroll
    for (int d8 = 0; d8 < 8; ++d8) { const u32x4 q4 = *(const u32x4*)(qrow + 8 * d8);
        qn += bflo(q4.x) * bflo(q4.x) + bfhi(q4.x) * bfhi(q4.x) + bflo(q4.y) * bflo(q4.y) + bfhi(q4.y) * bfhi(q4.y) + bflo(q4.z) * bflo(q4.z) + bfhi(q4.z) * bfhi(q4.z) + bflo(q4.w) * bflo(q4.w) + bfhi(q4.w) * bfhi(q4.w); }
    const float kmax = __builtin_bit_cast(float, ((const unsigned*)(p.ws + WS_CTL))[CW_KMAX + l * 64 + (b * 4 + h) * 2 + m]);
    const float mrow = sqrtf(qn) * kmax * 1.002f + 1e-3f;
    f32x16 o[4]; float lsum = 0.f;
#pragma unroll
    for (int dt = 0; dt < 4; ++dt)
#pragma unroll
        for (int r = 0; r < 16; ++r) o[dt][r] = 0.f;
    auto stage = [&](int buf) { bf16_t* Ks = KV0 + buf * KVB; bf16_t* Vs = Ks + 2 * 64 * KP;
#pragma unroll
        for (int u = 0; u < 2; ++u) { const int i = tid + 512 * u, r = i >> 4, ch = i & 15, mm = ch >> 3, c8 = (ch & 7) * 8;
            *(u32x4*)(Ks + (mm * 64 + r) * KP + c8) = pk_[u]; *(u32x4*)(Vs + r * VP + ch * 8) = pv_[u]; } };
    stage(0);
    if (nkt > 1) prefetch(1);
    __syncthreads();
    for (int kt = 0; kt < nkt; ++kt) {
        const bf16_t* Ks = KV0 + (kt & 1) * KVB; const bf16_t* Vs = Ks + 2 * 64 * KP;
        f32x16 s[2];
#pragma unroll
        for (int kh = 0; kh < 2; ++kh) {
#pragma unroll
            for (int r = 0; r < 16; ++r) s[kh][r] = 0.f;
#pragma unroll
            for (int kk = 0; kk < 4; ++kk) { const bf16x8 a = *(const bf16x8*)(Ks + (m * 64 + kh * 32 + q31) * KP + 16 * kk + 8 * hi);
                s[kh] = __builtin_amdgcn_mfma_f32_32x32x16_bf16(a, bq[kk], s[kh], 0, 0, 0); }
#pragma unroll
            for (int r = 0; r < 16; ++r) { const float ev = __builtin_amdgcn_exp2f(s[kh][r] - mrow); s[kh][r] = ev; lsum += ev; }
        }
        if (kt + 1 < nkt) { stage((kt + 1) & 1); if (kt + 2 < nkt) prefetch(kt + 2); }
#pragma unroll
        for (int st = 0; st < 4; ++st) {
            const int kh = st >> 1, r0 = 8 * (st & 1);
            union { bf16x8 v; unsigned u[4]; } bp;
            bp.u[0] = pk2(s[kh][r0 + 0], s[kh][r0 + 1]); bp.u[1] = pk2(s[kh][r0 + 2], s[kh][r0 + 3]); bp.u[2] = pk2(s[kh][r0 + 4], s[kh][r0 + 5]); bp.u[3] = pk2(s[kh][r0 + 6], s[kh][r0 + 7]);
            const bf16_t* v0 = Vs + (16 * st + 4 * hi + (i16 >> 2)) * VP + 16 * (gg & 1) + 4 * (i16 & 3);
#pragma unroll
            for (int dt = 0; dt < 4; ++dt)
                o[dt] = __builtin_amdgcn_mfma_f32_32x32x16_bf16(cat8(lds_tr(v0 + 32 * dt), lds_tr(v0 + 32 * dt + 8 * VP)), bp.v, o[dt], 0, 0, 0);
        }
        __syncthreads();
    }
    lsum += shx(lsum, 32);
    const float lamf = ((const float*)(p.ws + WS_MISC))[MI_LAMF + l];
    const float sc = (m == 0 ? 1.0f : lamf) / lsum;
    __syncthreads();
    float* ox = Oex + (rg * 32 + q31) * 132;
    if (m == 1) {
#pragma unroll
        for (int dt = 0; dt < 4; ++dt)
#pragma unroll
            for (int r = 0; r < 16; ++r) ox[dt * 32 + (r & 3) + 8 * (r >> 2) + 4 * hi] = o[dt][r] * sc;
    }
    __syncthreads();
    if (m == 0) {
        float ss = 0.f;
#pragma unroll
        for (int dt = 0; dt < 4; ++dt)
#pragma unroll
            for (int r = 0; r < 16; ++r) { const float v = o[dt][r] * sc - ox[dt * 32 + (r & 3) + 8 * (r >> 2) + 4 * hi]; o[dt][r] = v; ss += v * v; }
        ss += shx(ss, 32);
        const float lam_init = 0.8f - 0.6f * expf(-0.3f * (float)l);
        const float rs = (1.0f - lam_init) / sqrtf(ss * (1.0f / 128.0f) + EPS);
        const float* gn = p.gn_c + l * 128;
        bf16_t* orow = (bf16_t*)(p.ws + WS_YD) + (size_t)(qrow0 + rg * 32 + q31) * 512 + h * 128;
#pragma unroll
        for (int dt = 0; dt < 4; ++dt)
#pragma unroll
            for (int g4 = 0; g4 < 4; ++g4) { const int dv = dt * 32 + 8 * g4 + 4 * hi; const f32x4 gv = *(const f32x4*)(gn + dv);
                u32x2 wv; wv.x = pk2(o[dt][4 * g4 + 0] * rs * gv[0], o[dt][4 * g4 + 1] * rs * gv[1]); wv.y = pk2(o[dt][4 * g4 + 2] * rs * gv[2], o[dt][4 * g4 + 3] * rs * gv[3]);
                if (do_store) *(u32x2*)(orow + dv) = wv; }
    }
}
__device__ __forceinline__ void phase_mix(const P& p, int l, unsigned char* lds) {
    unsigned* qhead = (unsigned*)(p.ws + WS_CTL) + CW_QUEUE + 64 * l;
    volatile int* slot = (volatile int*)(lds + LDS_BYTES - 64);
    const int n_att_l = BATCH * 4 * (SEQ / 128), n_att_c = (l == 0) ? BATCH * 4 * (CTXL / 128) : 0;
    const int total = 128 + n_att_l + n_att_c;
    for (;;) {
        __syncthreads();
        if (otid() == 0) *slot = (int)atomicAdd(qhead, 1u);
        __syncthreads();
        const int it = *slot;
        if (it >= total) break;
        if (it < 64) { for (int rep = 0; rep < REP_DN; ++rep) dn_chain_mfma(p, it, lds); }
        else if (it < 128) { for (int rep = 0; rep < REP_GLA; ++rep) gla_chain_mfma(p, l, it - 64, lds); }
        else if (it < 128 + n_att_l) { const int a = it - 128, b = a / (4 * (SEQ / 128)), rem = a % (4 * (SEQ / 128)), h = rem / (SEQ / 128), qt = rem % (SEQ / 128);
            for (int rep = 1; rep < REP_ATT; ++rep) attn_tile(p, l, b, h, b * SEQ + qt * 128, false, lds, false);
            attn_tile(p, l, b, h, b * SEQ + qt * 128, false, lds); }
        else { const int a = it - 128 - n_att_l, b = a / (4 * (CTXL / 128)), rem = a % (4 * (CTXL / 128)), h = rem / (CTXL / 128), qt = rem % (CTXL / 128);
            attn_tile(p, l, b, h, TL + b * CTXL + qt * 128, true, lds); }
    }
}

__device__ __forceinline__ void phase_post(const P& p, int l, int nrows, int gw, int NGW, int lane) {
    const bf16_t* PZ = (const bf16_t*)(p.ws + WS_PZ); const bf16_t* PB = (const bf16_t*)(p.ws + WS_PB);
#pragma unroll
    for (int br = 0; br < 2; ++br) {
        bf16_t* O = (bf16_t*)(p.ws + (br ? WS_PAQ : WS_H));
        const float* gnb = (br ? p.gn_b : p.gn_a) + l * 128 + 2 * lane;
        const float g0 = gnb[0], g1 = gnb[1];
        for (int it = gw; it < nrows * 4; it += NGW) {
            const int r = it >> 2, h = it & 3, col = h * 128 + 2 * lane;
            const unsigned a = *(const unsigned*)(O + (size_t)r * 512 + col), bq = *(const unsigned*)(O + ((size_t)T + r) * 512 + col);
            const unsigned zz = br ? *(const unsigned*)(PB + (size_t)r * 1536 + 1024 + col) : *(const unsigned*)(PZ + (size_t)r * 512 + col);
            const float o0 = bflo(a) + bflo(bq), o1 = bfhi(a) + bfhi(bq);
            const float rs = 1.0f / sqrtf(wave_sum(o0 * o0 + o1 * o1) * (1.0f / 128.0f) + EPS);
            *(unsigned*)(O + (size_t)r * 512 + col) = pk2(o0 * rs * g0 * siluf_(bflo(zz)), o1 * rs * g1 * siluf_(bfhi(zz)));
        }
    }
}

__device__ __forceinline__ void phase_moe_gather(const P& p, unsigned char* lds) {
    const int tid = otid();
    const int* route = (const int*)(p.ws + WS_ROUTE); int* slots = (int*)(p.ws + WS_SLOT); int* misc = (int*)(p.ws + WS_MISC);
    const unsigned* ecnt = (const unsigned*)(p.ws + WS_CTL) + CW_ECNT; unsigned* efill = (unsigned*)(p.ws + WS_CTL) + CW_EFILL;
    const bf16_t* H = (const bf16_t*)(p.ws + WS_H); bf16_t* MA = (bf16_t*)(p.ws + WS_MA);
    int* eoff = (int*)lds; unsigned* lcnt = (unsigned*)(eoff + 16); unsigned* lbase = lcnt + 8; int* myslot = (int*)(lbase + 8);
    if (tid == 0) { int off = 0, nt = 0;
#pragma unroll 1
        for (int e = 0; e < NE; ++e) { eoff[e] = off; const int tl = ((int)ecnt[e] + 255) / 256;
            if (blockIdx.x == 0) { for (int q = 0; q < tl; ++q) misc[MI_TILEE + nt + q] = e; }
            nt += tl; off += tl * 256; }
        eoff[NE] = off; if (blockIdx.x == 0) misc[MI_NTILES] = nt; }
    for (int grp = blockIdx.x; grp < TL / 64; grp += gridDim.x) {
        __syncthreads();
        if (tid < NE) lcnt[tid] = 0u;
        __syncthreads();
        int e = 0, rank = 0;
        if (tid < 128) { e = route[(grp * 64 + (tid >> 1)) * 4 + (tid & 1)]; rank = (int)atomicAdd(lcnt + e, 1u); }
        __syncthreads();
        if (tid < NE) lbase[tid] = lcnt[tid] ? atomicAdd(efill + tid, lcnt[tid]) : 0u;
        __syncthreads();
        if (tid < 128) { const int s = eoff[e] + (int)lbase[e] + rank; myslot[tid] = s; slots[(grp * 64 + (tid >> 1)) * 2 + (tid & 1)] = s; }
        __syncthreads();
        for (int i = tid; i < 128 * 128; i += NTHREADS) { const int a = i >> 7, ch = i & 127;
            ((u32x4*)(MA + (size_t)myslot[a] * D))[ch] = ((const u32x4*)(H + (size_t)(grp * 64 + (a >> 1)) * D))[ch]; }
    }
}
__device__ __forceinline__ void phase_final(const P& p, int gw, int NGW, int lane) {
    const int* route = (const int*)(p.ws + WS_ROUTE); const int* slots = (const int*)(p.ws + WS_SLOT); const bf16_t* Y = (const bf16_t*)(p.ws + WS_MA);
    const float* MOD = (const float*)(p.ws + WS_MOD) + (size_t)1 * 9 * 6144;
    for (int r = gw; r < TL; r += NGW) { const int b = r / SEQ; const float w1 = ((const float*)route)[r * 4 + 2], w2 = ((const float*)route)[r * 4 + 3];
        const bf16_t* y1 = Y + (size_t)slots[r * 2] * D, *y2 = Y + (size_t)slots[r * 2 + 1] * D; float* xr = p.out + (size_t)r * D; const float* g2 = MOD + (size_t)b * 6144 + 5 * 1024;
        f32x4 v[4]; float ss = 0.f;
#pragma unroll
        for (int j = 0; j < 4; ++j) { const int c = 4 * lane + 256 * j; const u32x2 a = *(const u32x2*)(y1 + c), bq = *(const u32x2*)(y2 + c); const f32x4 g = *(const f32x4*)(g2 + c);
            f32x4 y; y[0] = w1 * bflo(a.x) + w2 * bflo(bq.x); y[1] = w1 * bfhi(a.x) + w2 * bfhi(bq.x); y[2] = w1 * bflo(a.y) + w2 * bflo(bq.y); y[3] = w1 * bfhi(a.y) + w2 * bfhi(bq.y);
            v[j] = *(const f32x4*)(xr + c) + g * y; ss += (v[j][0] * v[j][0] + v[j][1] * v[j][1]) + (v[j][2] * v[j][2] + v[j][3] * v[j][3]); }
        const float rs = 1.0f / sqrtf(wave_sum(ss) * (1.0f / D) + EPS);
#pragma unroll
        for (int j = 0; j < 4; ++j) { const int c = 4 * lane + 256 * j; *(f32x4*)(xr + c) = v[j] * rs * *(const f32x4*)(p.final_g + c); }
    }
}

typedef __attribute__((address_space(4))) const P* KArgs;
#define LOADP(p) asm volatile("" : "+s"(kp)); P p; __builtin_memcpy(&p, kp, sizeof(P))
__global__ void __launch_bounds__(NTHREADS, 2) mk_fwd(P p_unused) {
    extern __shared__ __attribute__((aligned(16))) unsigned char lds[];
    cg::grid_group grid = cg::this_grid();
    KArgs kp = (KArgs)__builtin_amdgcn_kernarg_segment_ptr();
    const int G = gridDim.x, NGW = G * NWAVES;
#define IDS() const int tid = otid(), lane = tid & 63, wave = __builtin_amdgcn_readfirstlane(tid >> 6), gw = blockIdx.x * NWAVES + wave; (void)tid; (void)lane; (void)gw; (void)wave
    PG8_LAS unsigned char* glds = (PG8_LAS unsigned char*)lds;
    volatile unsigned* bst = (volatile unsigned*)(lds + LDS_BYTES - 128);
    if (otid() == 0) { bst[0] = 0u; bst[1] = 0u; }
    __syncthreads();
    { LOADP(p); (void)xcd_barrier_post((unsigned*)(p.ws + WS_CTL) + CW_BAR, bst); }
#define GSYNC() do { LOADP(pb_); XcdBarrier bb_; bb_.bar = (unsigned*)(pb_.ws + WS_CTL) + CW_BAR; bb_.x = xb_xcc_id(); bb_.st = bst; xcd_barrier(bb_); } while (0)

    {
        LOADP(p); IDS(); unsigned char* ws = p.ws;
        float* scr = (float*)(lds + wave * CONV_WLDS);
        for (int rep = 0; rep < REP_P0; ++rep)
        for (int l = 0; l < DEPTH; ++l) {
            convert_T(D, 8240, (bf16_t*)(ws + WB_WIN + l * WIN_BYTES), NIN, SmWin{p.w_in + (size_t)l * D * 8240}, scr, (gw + 37 * l) % NGW, NGW, lane);
            convert_T(512, D, (bf16_t*)(ws + WB_WO + (l * 3 + 0) * WO_BYTES), D, SmPlain{p.w_o_a + (size_t)l * 512 * D}, scr, (gw + 300 + 700 * l) % NGW, NGW, lane);
            convert_T(512, D, (bf16_t*)(ws + WB_WO + (l * 3 + 1) * WO_BYTES), D, SmPlain{p.w_o_b + (size_t)l * 512 * D}, scr, (gw + 556 + 700 * l) % NGW, NGW, lane);
            convert_T(512, D, (bf16_t*)(ws + WB_WO + (l * 3 + 2) * WO_BYTES), D, SmPlain{p.w_o_c + (size_t)l * 512 * D}, scr, (gw + 812 + 700 * l) % NGW, NGW, lane);
            convert_T(D, D, (bf16_t*)(ws + WB_WOUT + l * WOUT_BYTES), D, SmPlain{p.w_out + (size_t)l * D * D}, scr, (gw + 1068 + 512 * l) % NGW, NGW, lane);
        }
        convert_T(D, DFF, (bf16_t*)(ws + WB_WUP), NUP, SmUp{p.ffn_w1, p.ffn_w3}, scr, (gw + 1500) % NGW, NGW, lane);
        convert_T(DFF, D, (bf16_t*)(ws + WB_WDN), D, SmPlain{p.ffn_w2}, scr, (gw + 900) % NGW, NGW, lane);
        __syncthreads();
        phase_mod(p, lds);
    }
    grid.sync();

    for (int l = 0; l < DEPTH; ++l) {
        const bool last = (l == DEPTH - 1);
        const int Mrows = last ? TL : T;
        for (int rep = 0; rep < REP_ELT; ++rep)
        { LOADP(p); IDS(); unsigned char* ws = p.ws;
          phase_modulate(l == 0 ? p.x : p.out, l == 0 ? p.ctx : (const float*)(ws + WS_XC), T, p.norm1_g + l * D, (const float*)(ws + WS_MOD) + (size_t)l * 9 * 6144, 0, (bf16_t*)(ws + WS_H), nullptr, nullptr, nullptr, nullptr, gw, NGW, lane); }
        GSYNC();
        for (int rep = 0; rep < REP_WIN; ++rep)
        { LOADP(p); unsigned char* ws = p.ws;
            pg8::Gemm g{(const bf16_t*)(ws + WS_H), (const bf16_t*)(ws + WB_WIN + l * WIN_BYTES), T, NIN, D, D}; pg8::StaticOrder S; S.init(T, NIN, G, (int)blockIdx.x);
            EpiWin E{(bf16_t*)(ws + WS_PAQ), (bf16_t*)(ws + WS_PZ), (bf16_t*)(ws + WS_PB), (bf16_t*)(ws + WS_PC), (bf16_t*)(ws + WS_PG), (float*)(ws + WS_SMALL)};
            pg8::gemm_phase<EpiWin, pg8::StaticOrder, true, true>(glds, g, S, E);
        }
        GSYNC();
        for (int rep = 1; rep < REP_SYNC; ++rep) GSYNC();
        { LOADP(p); IDS(); phase_prep(p, l, lds, gw, NGW, lane); }
        GSYNC();
        { LOADP(p); phase_mix(p, l, lds); }
        GSYNC();
        { LOADP(p); IDS(); phase_post(p, l, Mrows, gw, NGW, lane); }
        GSYNC();
        for (int rep = 0; rep < REP_MERGE; ++rep)
        { LOADP(p); unsigned char* ws = p.ws;
            pg8::Gemm g{(const bf16_t*)(ws + WS_H), (const bf16_t*)(ws + WB_WO + (l * 3 + 0) * WO_BYTES), Mrows, D, 512, 512,
                        (const bf16_t*)(ws + WS_PAQ), (const bf16_t*)(ws + WS_YD), (const bf16_t*)(ws + WB_WO + (l * 3 + 1) * WO_BYTES), (const bf16_t*)(ws + WB_WO + (l * 3 + 2) * WO_BYTES)};
            MergeOrder S; S.so.init(Mrows, D, G, (int)blockIdx.x);
            EpiGate E{(bf16_t*)(ws + WS_DNQKV), (const bf16_t*)(ws + WS_PG)};
            pg8::gemm_phase<EpiGate, MergeOrder, true, true>(glds, g, S, E);
        }
        GSYNC();
        for (int rep = 0; rep < (l == 0 ? REP_WOUT0 : 1); ++rep)
        { LOADP(p); unsigned char* ws = p.ws;
            pg8::Gemm g{(const bf16_t*)(ws + WS_DNQKV), (const bf16_t*)(ws + WB_WOUT + l * WOUT_BYTES), Mrows, D, D, D}; pg8::StaticOrder S; S.init(Mrows, D, G, (int)blockIdx.x);
            EpiResid E{l == 0 ? p.x : p.out, l == 0 ? p.ctx : (const float*)(ws + WS_XC), p.out, (float*)(ws + WS_XC), (const float*)(ws + WS_MOD) + (size_t)l * 9 * 6144, 2};
            pg8::gemm_phase<EpiResid, pg8::StaticOrder, true, true>(glds, g, S, E);
        }
        GSYNC();
        { LOADP(p); IDS(); unsigned char* ws = p.ws;
          phase_modulate(p.out, (const float*)(ws + WS_XC), Mrows, p.norm2_g + l * D, (const float*)(ws + WS_MOD) + (size_t)l * 9 * 6144, 3, (bf16_t*)(ws + WS_H), last ? p.router_w : nullptr, (int*)(ws + WS_ROUTE), (unsigned*)(ws + WS_CTL) + CW_ECNT, (unsigned*)lds, gw, NGW, lane); }
        if (!last) {
            GSYNC();
            for (int rep = 0; rep < REP_UP; ++rep)
            { LOADP(p); unsigned char* ws = p.ws;
                pg8::Gemm g{(const bf16_t*)(ws + WS_H), (const bf16_t*)(ws + WB_WUP), T, NUP, D, D}; pg8::StaticOrder S; S.init(T, NUP, G, (int)blockIdx.x);
                EpiSwiglu E{(bf16_t*)(ws + WS_H1), NUP / 256};
                pg8::gemm_phase<EpiSwiglu, pg8::StaticOrder, true, true>(glds, g, S, E);
            }
            GSYNC();
            { LOADP(p); unsigned char* ws = p.ws;
                pg8::Gemm g{(const bf16_t*)(ws + WS_H1), (const bf16_t*)(ws + WB_WDN), T, D, DFF, DFF}; pg8::StaticOrder S; S.init(T, D, G, (int)blockIdx.x);
                EpiResid E{p.out, (const float*)(ws + WS_XC), p.out, (float*)(ws + WS_XC), (const float*)(ws + WS_MOD) + (size_t)l * 9 * 6144, 5};
                pg8::gemm_phase<EpiResid, pg8::StaticOrder, true, true>(glds, g, S, E);
            }
            GSYNC();
        } else {
            { LOADP(p); IDS(); unsigned char* ws = p.ws;
                float* scr = (float*)(lds + wave * CONV_WLDS);
                for (int e = 0; e < NE; ++e) {
                    convert_T(D, DFF, (bf16_t*)(ws + WS_MWUP) + (size_t)e * NUP * D, NUP, SmUp{p.moe_w1 + (size_t)e * D * DFF, p.moe_w3 + (size_t)e * D * DFF}, scr, (gw + 211 * e) % NGW, NGW, lane);
                    convert_T(DFF, D, (bf16_t*)(ws + WS_MWDN) + (size_t)e * D * DFF, D, SmPlain{p.moe_w2 + (size_t)e * DFF * D}, scr, (gw + 173 * e + 1000) % NGW, NGW, lane); }
            }
            GSYNC();
            { LOADP(p); phase_moe_gather(p, lds); }
            GSYNC();
            for (int rep = 0; rep < REP_UP; ++rep)
            { LOADP(p); unsigned char* ws = p.ws; const int* misc = (const int*)(ws + WS_MISC);
                pg8::Gemm g{(const bf16_t*)(ws + WS_MA), (const bf16_t*)(ws + WS_MWUP), MOE_ROWS, NE * NUP, D, D};
                MoeOrder S{misc[MI_NTILES], NUP / 256, G, (int)blockIdx.x, misc + MI_TILEE};
                EpiSwiglu E{(bf16_t*)(ws + WS_MH1), NUP / 256};
                pg8::gemm_phase<EpiSwiglu, MoeOrder, true, true>(glds, g, S, E);
            }
            GSYNC();
            { LOADP(p); unsigned char* ws = p.ws; const int* misc = (const int*)(ws + WS_MISC);
                pg8::Gemm g{(const bf16_t*)(ws + WS_MH1), (const bf16_t*)(ws + WS_MWDN), MOE_ROWS, NE * D, DFF, DFF};
                MoeOrder S{misc[MI_NTILES], D / 256, G, (int)blockIdx.x, misc + MI_TILEE};
                EpiMoeDown E{(bf16_t*)(ws + WS_MA)};
                pg8::gemm_phase<EpiMoeDown, MoeOrder, true, true>(glds, g, S, E);
            }
            GSYNC();
            { LOADP(p); IDS(); phase_final(p, gw, NGW, lane); }
        }
    }
}

extern "C" void kernel_launch(void* const* d_in, const int* in_sizes, int n_in, void* d_out, int out_size, void* d_ws, size_t ws_size, hipStream_t stream) {
    static int grid_blocks = 0;
    if (grid_blocks == 0) {
        if (n_in != 30 || in_sizes[0] != TL * D || out_size != TL * D || ws_size < WS_END) {
            fprintf(stderr, "kernel_launch: built for 30 inputs, x/out of %d floats, >= %zu bytes of d_ws; got n_in %d, in0 %d, out %d, ws %zu; nothing launched\n", TL * D, (size_t)WS_END, n_in, n_in > 0 ? in_sizes[0] : -1, out_size, ws_size);
            grid_blocks = -1; return; }
        int dev = 0, cus = 0, per_cu = 0;
        hipGetDevice(&dev);
        hipDeviceGetAttribute(&cus, hipDeviceAttributeMultiprocessorCount, dev);
        hipFuncSetAttribute((const void*)mk_fwd, hipFuncAttributeMaxDynamicSharedMemorySize, LDS_BYTES);
        hipOccupancyMaxActiveBlocksPerMultiprocessor(&per_cu, (const void*)mk_fwd, NTHREADS, LDS_BYTES);
        if (per_cu < 1) { fprintf(stderr, "kernel_launch: occupancy query reports %d blocks/CU; nothing launched\n", per_cu); grid_blocks = -1; return; }
        grid_blocks = cus;
    }
    if (grid_blocks < 0) return;
    hipMemsetAsync((char*)d_ws + WS_CTL, 0, CTL_BYTES, stream);
    P p{};
    const float** f = (const float**)&p;
    for (int i = 0; i < 30; ++i) f[i] = (const float*)d_in[i];
    p.out = (float*)d_out; p.ws = (unsigned char*)d_ws;
    void* args[] = {&p};
    hipError_t e = hipLaunchCooperativeKernel((const void*)mk_fwd, dim3(grid_blocks), dim3(NTHREADS), args, LDS_BYTES, stream);
    if (e != hipSuccess) fprintf(stderr, "kernel_launch: cooperative launch failed: %s (grid %d)\n", hipGetErrorString(e), grid_blocks);
}
```

```cpp
#include <hip/hip_runtime.h>
#include <hip/hip_cooperative_groups.h>
#include <cstdio>
#include <cstdint>
namespace cg = cooperative_groups;
#ifndef REP_P0
#define REP_P0 1
#endif
#ifndef REP_WIN
#define REP_WIN 1
#endif
#ifndef REP_CHAIN
#define REP_CHAIN 1
#endif
#ifndef REP_UP
#define REP_UP 1
#endif
#ifndef REP_SYNC
#define REP_SYNC 1
#endif
#ifndef REP_ATT
#define REP_ATT 1
#endif
#ifndef REP_DNPREP
#define REP_DNPREP 1
#endif
#ifndef REP_ELT
#define REP_ELT 1
#endif
#ifndef REP_DN
#define REP_DN REP_CHAIN
#endif
#ifndef REP_GLA
#define REP_GLA REP_CHAIN
#endif
#ifndef REP_MERGE
#define REP_MERGE 1
#endif
#ifndef REP_WOUT0
#define REP_WOUT0 1
#endif
#ifndef PROBE_MASK
#define PROBE_MASK 0u
#endif
#define PH_BEGIN(k) const unsigned long long pt0_ = ((PROBE_MASK >> (k)) & 1u) ? __builtin_amdgcn_s_memrealtime() : 0ull
#define PH_END(k) do { if ((PROBE_MASK >> (k)) & 1u) { const unsigned long long pt1_ = __builtin_amdgcn_s_memrealtime(); while (__builtin_amdgcn_s_memrealtime() - pt1_ < pt1_ - pt0_) __builtin_amdgcn_s_sleep(4); } } while (0)

namespace pg8 {
#define PG8_LAS __attribute__((address_space(3)))
typedef unsigned short bf16_t;
typedef short bf16x8 __attribute__((ext_vector_type(8)));
typedef float f32x4 __attribute__((ext_vector_type(4)));
typedef unsigned u32x4 __attribute__((ext_vector_type(4)));
constexpr int BM = 256, BK = 64, HALF = 128, HTB = HALF * BK * 2  , STAGE_BYTES = 8 * HTB, NXCD = 8, WGM = 8;

__host__ __device__ __forceinline__ int lds_byte(int r, int c) { const int st = (r >> 4) * 2 + (c >> 5), rr = r & 15, cc = c & 31, ob = rr * 64 + cc * 2; return st * 1024 + (ob ^ (((ob >> 9) & 1) << 5)); }
__host__ __device__ __forceinline__ void stage_rc(int b, int& R, int& C) { const int st = b / 1024, sb = b % 1024, swz = sb ^ (((sb >> 9) & 1) << 5); R = (st >> 1) * 16 + swz / 64; C = (st & 1) * 32 + (swz % 64) / 2; }
__host__ __device__ __forceinline__ int perm32(int rho) { const int n = rho >> 4, i = rho & 15; return 8 * (i >> 2) + 4 * n + (i & 3); }

struct Unit { int pm, pn, br; };
struct Gemm { const bf16_t* A; const bf16_t* Bt; int M, N, K, lda; const bf16_t* A1; const bf16_t* A2; const bf16_t* B1; const bf16_t* B2; };

struct StaticOrder {
    int nM, nN, nwg, G, c;
    __host__ __device__ void init(int M, int N, int G_, int c_) { nM = M / BM; nN = N / BM; nwg = nM * nN; G = G_; c = c_; }
    __host__ __device__ bool next(int i, Unit& u) const {
        const long L = (long)i * G + c; if (L >= nwg) return false;
        int wgid = (int)L; { const int q = nwg / NXCD, r = nwg % NXCD, xcd = wgid % NXCD, off = wgid / NXCD; wgid = (xcd < r ? xcd * (q + 1) : r * (q + 1) + (xcd - r) * q) + off; }
        const int nig = WGM * nN, gid = wgid / nig, fm = gid * WGM, gsz = (nM - fm) < WGM ? (nM - fm) : WGM;
        u.pm = fm + ((wgid % nig) % gsz); u.pn = (wgid % nig) / gsz; u.br = 0; return true;
    }
    __device__ __forceinline__ void a_ready(const Unit&) const {}
    __device__ __forceinline__ void done(const Unit&) const {}
};


template <class Epi, class Sched, bool ALIGN_EPI = false, bool SP2 = false>
__device__ __forceinline__ void gemm_phase(PG8_LAS unsigned char* lds, const Gemm g, const Sched& S, const Epi& E) {
    int tid_o = threadIdx.x; asm volatile("" : "+v"(tid_o));
    const int tid = tid_o, wid = __builtin_amdgcn_readfirstlane(tid >> 6), lane = tid & 63, wr = wid >> 2, wc = wid & 3, fr = lane & 15, fq = lane >> 4;
    const int K = g.K, nt = K / BK;
    unsigned voffA[2], voffB[2];
#pragma unroll
    for (int i = 0; i < 2; ++i) { int R, C; stage_rc(tid * 16 + i * 8192, R, C); const int Rb = Epi::PERM ? ((R & ~31) + perm32(R & 31)) : R;
        voffA[i] = (unsigned)(R * g.lda + C) * 2u; voffB[i] = (unsigned)(Rb * K + C) * 2u; }
    const size_t kstep = (size_t)(BK * 2);
    const size_t hstepA = (size_t)HALF * g.lda * 2, hstepB = (size_t)HALF * K * 2;
    const size_t tstepA = 2 * hstepA, tstepB = 2 * hstepB;
    const unsigned ldsw = (unsigned)wid * 1024u;
    const int aoff = lds_byte(wr * 64 + fr, fq * 8), boff = lds_byte(wc * 32 + fr, fq * 8);
#define PG8_SA(b, h) (((b) * 2 + (h)) * HTB)
#define PG8_SB(b, h) ((4 + (b) * 2 + (h)) * HTB)
#define PG8_STAGE(bufoff, gbase, voff) do { _Pragma("unroll") for (int _i = 0; _i < 2; ++_i) \
        __builtin_amdgcn_global_load_lds((const unsigned*)((const char*)(gbase) + (voff)[_i]), (PG8_LAS unsigned*)(lds + (bufoff) + ldsw + _i * 8192), 16, 0, 0); } while (0)
#define PG8_LDA(dst, b, h) do { _Pragma("unroll") for (int m = 0; m < 4; ++m) _Pragma("unroll") for (int k = 0; k < 2; ++k) dst[m][k] = *(const PG8_LAS bf16x8*)(lds + PG8_SA(b, h) + aoff + m * 2048 + k * 1024); } while (0)
#define PG8_LDB(dst, b, h) do { _Pragma("unroll") for (int n = 0; n < 2; ++n) _Pragma("unroll") for (int k = 0; k < 2; ++k) dst[n][k] = *(const PG8_LAS bf16x8*)(lds + PG8_SB(b, h) + boff + n * 2048 + k * 1024); } while (0)
#define PG8_MMA(ai, bj, At, Bt) do { __builtin_amdgcn_s_setprio(1); _Pragma("unroll") for (int m = 0; m < 4; ++m) _Pragma("unroll") for (int n = 0; n < 2; ++n) _Pragma("unroll") for (int k = 0; k < 2; ++k) \
        acc[ai][bj][m][n] = __builtin_amdgcn_mfma_f32_16x16x32_bf16(Bt[n][k], At[m][k], acc[ai][bj][m][n], 0, 0, 0); __builtin_amdgcn_s_setprio(0); } while (0)
#define PG8_WAIT_V(n) asm volatile("s_waitcnt vmcnt(" #n ")" ::: "memory")
#define PG8_WAIT_L(n) asm volatile("s_waitcnt lgkmcnt(" #n ")" ::: "memory")
#define PG8_BAR __builtin_amdgcn_s_barrier()
#define PG8_SCHED __builtin_amdgcn_sched_barrier(0)
    Unit cur, nxt; int ui = 0;
    if (!S.next(0, cur)) return;
    f32x4 acc[2][2][4][2];
#pragma unroll
    for (int a = 0; a < 2; ++a)
#pragma unroll
        for (int b = 0; b < 2; ++b)
#pragma unroll
            for (int m = 0; m < 4; ++m)
#pragma unroll
                for (int n = 0; n < 2; ++n) acc[a][b][m][n] = (f32x4){0.f, 0.f, 0.f, 0.f};
    bf16x8 At[4][2], B0[2][2], B1[2][2];
    const char* cA = (const char*)(cur.br == 0 ? g.A : cur.br == 1 ? g.A1 : g.A2) + (size_t)cur.pm * tstepA; const char* cB = (const char*)(cur.br == 0 ? g.Bt : cur.br == 1 ? g.B1 : g.B2) + (size_t)cur.pn * tstepB;
    S.a_ready(cur);
    if constexpr (SP2) {
        PG8_STAGE(PG8_SB(0, 0), cB, voffB); PG8_STAGE(PG8_SB(0, 1), cB + hstepB, voffB); PG8_STAGE(PG8_SA(0, 0), cA, voffA); PG8_STAGE(PG8_SA(0, 1), cA + hstepA, voffA);
        if (wr == 1) PG8_BAR;
        PG8_WAIT_V(2); PG8_BAR;
        PG8_STAGE(PG8_SB(1, 0), cB + kstep, voffB); PG8_STAGE(PG8_SA(1, 0), cA + kstep, voffA); PG8_STAGE(PG8_SB(1, 1), cB + hstepB + kstep, voffB);
        PG8_WAIT_V(6); PG8_BAR;
    } else {
        PG8_STAGE(PG8_SB(0, 0), cB, voffB); PG8_STAGE(PG8_SA(0, 0), cA, voffA); PG8_STAGE(PG8_SB(0, 1), cB + hstepB, voffB); PG8_STAGE(PG8_SA(0, 1), cA + hstepA, voffA);
        if (wr == 1) PG8_BAR;
        PG8_WAIT_V(4); PG8_BAR;
        PG8_STAGE(PG8_SB(1, 0), cB + kstep, voffB); PG8_STAGE(PG8_SA(1, 0), cA + kstep, voffA); PG8_STAGE(PG8_SB(1, 1), cB + hstepB + kstep, voffB);
        PG8_WAIT_V(6); PG8_BAR;
    }
    for (;;) {
        const bool has_next = S.next(ui + 1, nxt);
        const char* nA = has_next ? (const char*)(nxt.br == 0 ? g.A : nxt.br == 1 ? g.A1 : g.A2) + (size_t)nxt.pm * tstepA : cA; const char* nB = has_next ? (const char*)(nxt.br == 0 ? g.Bt : nxt.br == 1 ? g.B1 : g.B2) + (size_t)nxt.pn * tstepB : cB;
        for (int t = 0; t < nt; t += 2) {
            const bool last = (t == nt - 2);
            const char* a1 = cA + (size_t)(t + 1) * kstep;
            const char* a2 = last ? nA : cA + (size_t)(t + 2) * kstep; const char* b2 = last ? nB : cB + (size_t)(t + 2) * kstep;
            const char* a3 = a2 + kstep; const char* b3 = b2 + kstep;
            if (last && has_next) S.a_ready(nxt);
            if constexpr (SP2) {
            PG8_LDB(B0, 0, 0); PG8_LDB(B1, 0, 1); PG8_SCHED; PG8_LDA(At, 0, 0); PG8_STAGE(PG8_SA(1, 1), a1 + hstepA, voffA);
            PG8_WAIT_V(8); PG8_WAIT_L(0); PG8_BAR; PG8_MMA(0, 0, At, B0); PG8_MMA(0, 1, At, B1); PG8_BAR; PG8_SCHED;
            PG8_LDA(At, 0, 1); PG8_STAGE(PG8_SB(0, 0), b2, voffB); PG8_STAGE(PG8_SB(0, 1), b2 + hstepB, voffB); PG8_STAGE(PG8_SA(0, 0), a2, voffA);
            PG8_WAIT_V(8); PG8_WAIT_L(0); PG8_BAR; PG8_MMA(1, 0, At, B0); PG8_MMA(1, 1, At, B1); PG8_BAR; PG8_SCHED;
            PG8_LDB(B0, 1, 0); PG8_LDB(B1, 1, 1); PG8_SCHED; PG8_LDA(At, 1, 0); PG8_STAGE(PG8_SA(0, 1), a2 + hstepA, voffA);
            PG8_WAIT_V(8); PG8_WAIT_L(0); PG8_BAR; PG8_MMA(0, 0, At, B0); PG8_MMA(0, 1, At, B1); PG8_BAR; PG8_SCHED;
            PG8_LDA(At, 1, 1); PG8_STAGE(PG8_SB(1, 0), b3, voffB); PG8_STAGE(PG8_SB(1, 1), b3 + hstepB, voffB); PG8_STAGE(PG8_SA(1, 0), a3, voffA);
            PG8_WAIT_V(8); PG8_WAIT_L(0); PG8_BAR; PG8_MMA(1, 0, At, B0); PG8_MMA(1, 1, At, B1); PG8_BAR; PG8_SCHED;
            } else {
            PG8_LDB(B0, 0, 0); PG8_SCHED; PG8_LDA(At, 0, 0); PG8_STAGE(PG8_SA(1, 1), a1 + hstepA, voffA);
            PG8_WAIT_L(8); PG8_BAR; PG8_WAIT_L(0); PG8_MMA(0, 0, At, B0); PG8_BAR; PG8_SCHED;
            PG8_LDB(B1, 0, 1); PG8_STAGE(PG8_SB(0, 0), b2, voffB);
            PG8_BAR; PG8_WAIT_L(0); PG8_MMA(0, 1, At, B1); PG8_BAR;
            PG8_LDA(At, 0, 1); PG8_STAGE(PG8_SA(0, 0), a2, voffA);
            PG8_BAR; PG8_WAIT_L(0); PG8_MMA(1, 0, At, B0); PG8_BAR; PG8_SCHED;
            PG8_STAGE(PG8_SB(0, 1), b2 + hstepB, voffB);
            PG8_WAIT_V(6); PG8_BAR; PG8_MMA(1, 1, At, B1); PG8_BAR;
            PG8_LDB(B0, 1, 0); PG8_SCHED; PG8_LDA(At, 1, 0); PG8_STAGE(PG8_SA(0, 1), a2 + hstepA, voffA);
            PG8_WAIT_L(8); PG8_BAR; PG8_WAIT_L(0); PG8_MMA(0, 0, At, B0); PG8_BAR; PG8_SCHED;
            PG8_LDB(B1, 1, 1); PG8_STAGE(PG8_SB(1, 0), b3, voffB);
            PG8_BAR; PG8_WAIT_L(0); PG8_MMA(0, 1, At, B1); PG8_BAR;
            PG8_LDA(At, 1, 1); PG8_STAGE(PG8_SA(1, 0), a3, voffA);
            PG8_BAR; PG8_WAIT_L(0); PG8_MMA(1, 0, At, B0); PG8_BAR; PG8_SCHED;
            PG8_STAGE(PG8_SB(1, 1), b3 + hstepB, voffB);
            PG8_WAIT_V(6); PG8_BAR; PG8_MMA(1, 1, At, B1); PG8_BAR;
            }
        }
        if constexpr (ALIGN_EPI) { if (wr == 0) PG8_BAR; }
        if constexpr (!Epi::AFTER_DRAIN) { E(acc, cur, wr, wc, fr, fq); S.done(cur); }
        if (!has_next) break;
        if (!(Epi::CHAIN && nxt.br != 0)) {
#pragma unroll
        for (int a = 0; a < 2; ++a)
#pragma unroll
            for (int b = 0; b < 2; ++b)
#pragma unroll
                for (int m = 0; m < 4; ++m)
#pragma unroll
                    for (int n = 0; n < 2; ++n) acc[a][b][m][n] = (f32x4){0.f, 0.f, 0.f, 0.f};
        }
        cur = nxt; cA = nA; cB = nB; ++ui;
        if constexpr (ALIGN_EPI) { if (wr == 1) PG8_BAR; }
    }
    PG8_WAIT_V(0);
    if constexpr (!ALIGN_EPI) { if (wr == 0) PG8_BAR; }
    PG8_BAR;
    if constexpr (Epi::AFTER_DRAIN) { E.fused(acc, cur, wr, wc, fr, fq, lds, wid, lane); S.done(cur); }
#undef PG8_SA
#undef PG8_SB
#undef PG8_STAGE
#undef PG8_LDA
#undef PG8_LDB
#undef PG8_MMA
#undef PG8_WAIT_V
#undef PG8_WAIT_L
#undef PG8_BAR
#undef PG8_SCHED
}
}


constexpr int BATCH = 8, SEQ = 2048, CTXL = 256, D = 1024, DEPTH = 2;
constexpr int TL = BATCH * SEQ, TC = BATCH * CTXL, T = TL + TC;
constexpr int NIN = 8448;
constexpr int DFF = 2816, NE = 8, NUP = 2 * DFF;
constexpr int MOE_ROWS = 2 * TL + NE * 256;
constexpr float EPS = 1e-6f;
constexpr int NTHREADS = 512, NWAVES = 8;
constexpr int LDS_BYTES = 163840;

typedef unsigned short bf16_t;
typedef float f32x4 __attribute__((ext_vector_type(4)));
typedef float f32x16 __attribute__((ext_vector_type(16)));
typedef unsigned u32x4 __attribute__((ext_vector_type(4)));
typedef unsigned u32x2 __attribute__((ext_vector_type(2)));
typedef short bf16x8 __attribute__((ext_vector_type(8)));
typedef short s16x4 __attribute__((ext_vector_type(4)));

constexpr size_t al256(size_t x) { return (x + 255) & ~(size_t)255; }
constexpr size_t WS_CTL   = 0;                                   constexpr size_t CTL_BYTES = 65536;
constexpr size_t WS_MOD   = WS_CTL + CTL_BYTES;                  constexpr size_t MOD_BYTES = (size_t)DEPTH * 9 * 6 * D * 4;
constexpr size_t WS_ROUTE = al256(WS_MOD + MOD_BYTES);           constexpr size_t ROUTE_BYTES = (size_t)TL * 16;
constexpr size_t WS_SLOT  = al256(WS_ROUTE + ROUTE_BYTES);       constexpr size_t SLOT_BYTES = (size_t)TL * 8;
constexpr size_t WS_MISC  = al256(WS_SLOT + SLOT_BYTES);         constexpr size_t MISC_BYTES = 4096;
constexpr size_t WS_GB    = al256(WS_MISC + MISC_BYTES);         constexpr size_t GB_BYTES = (size_t)T * 16 * 4;
constexpr size_t WS_SMALL = al256(WS_GB + GB_BYTES);             constexpr size_t SMALL_BYTES = (size_t)T * 64 * 4;
constexpr size_t WS_XC    = al256(WS_SMALL + SMALL_BYTES);       constexpr size_t XC_BYTES = (size_t)TC * D * 4;
constexpr size_t WS_WB    = al256(WS_XC + XC_BYTES);
constexpr size_t WB_WIN   = WS_WB;                               constexpr size_t WIN_BYTES = (size_t)NIN * D * 2;
constexpr size_t WB_WO    = WB_WIN + DEPTH * WIN_BYTES;          constexpr size_t WO_BYTES = (size_t)D * 512 * 2;
constexpr size_t WB_WOUT  = WB_WO + DEPTH * 3 * WO_BYTES;        constexpr size_t WOUT_BYTES = (size_t)D * D * 2;
constexpr size_t WB_WUP   = WB_WOUT + DEPTH * WOUT_BYTES;        constexpr size_t WUP_BYTES = (size_t)NUP * D * 2;
constexpr size_t WB_WDN   = WB_WUP + WUP_BYTES;                  constexpr size_t WDN_BYTES = (size_t)D * DFF * 2;
constexpr size_t WB_END   = WB_WDN + WDN_BYTES;
constexpr size_t WS_H     = al256(WB_END);                       constexpr size_t H_BYTES = (size_t)T * D * 2;
constexpr size_t WS_PAQ   = al256(WS_H + H_BYTES);               constexpr size_t PAQ_BYTES = (size_t)T * 1536 * 2;
constexpr size_t WS_PZ    = al256(WS_PAQ + PAQ_BYTES);           constexpr size_t PZ_BYTES = (size_t)T * 512 * 2;
constexpr size_t WS_PB    = al256(WS_PZ + PZ_BYTES);             constexpr size_t PB_BYTES = (size_t)T * 1536 * 2;
constexpr size_t WS_PC    = al256(WS_PB + PB_BYTES);             constexpr size_t PC_BYTES = (size_t)T * 1536 * 2;
constexpr size_t WS_PG    = al256(WS_PC + PC_BYTES);             constexpr size_t PG_BYTES = (size_t)T * 3072 * 2;
constexpr size_t WS_DNQKV = al256(WS_PG + PG_BYTES);             constexpr size_t DNQKV_BYTES = (size_t)T * 1536 * 2;
constexpr size_t WS_TQ    = al256(WS_DNQKV + DNQKV_BYTES);       constexpr size_t TQ_BYTES = (size_t)BATCH * 4 * 2 * ((CTXL + SEQ) / 64) * 16384;
constexpr size_t WS_VEC   = al256(WS_TQ + TQ_BYTES);             constexpr size_t VEC_BYTES = (size_t)BATCH * 4 * 2 * ((CTXL + SEQ) / 64) * 1024;
constexpr size_t WS_END   = al256(WS_VEC + VEC_BYTES);
static_assert(WS_END <= (size_t)524288000, "d_ws map exceeds 500 MiB (documented minimum is 525,980,800 B)");
constexpr size_t WS_YD    = WS_PAQ + (size_t)2 * T * 512 * 2;
static_assert((size_t)3 * T * 512 * 2 <= PAQ_BYTES, "yd overlay");
constexpr size_t WS_H1    = WS_PB;
static_assert((size_t)T * DFF * 2 <= PB_BYTES + PC_BYTES, "h1 overlay");
constexpr size_t WS_MWDN  = WS_WB;                                constexpr size_t MWDN_BYTES = (size_t)NE * D * DFF * 2;
static_assert(MWDN_BYTES <= WB_END - WS_WB, "moe wdn overlay");
constexpr size_t WS_MWUP  = WS_PAQ;                               constexpr size_t MWUP_BYTES = (size_t)NE * NUP * D * 2;
constexpr size_t WS_MA    = al256(WS_MWUP + MWUP_BYTES);          constexpr size_t MA_BYTES = (size_t)MOE_ROWS * D * 2;
constexpr size_t WS_MH1   = al256(WS_MA + MA_BYTES);              constexpr size_t MH1_BYTES = (size_t)MOE_ROWS * DFF * 2;
static_assert(WS_MH1 + MH1_BYTES <= WS_END, "moe overlay");
constexpr int CW_QUEUE = 0;
constexpr int CW_KMAX = 256;
constexpr int CW_ECNT = 512;
constexpr int CW_EFILL = 576;
constexpr int CW_BAR = 4096;
constexpr int MI_LAMF = 0;
constexpr int MI_NTILES = 16;
constexpr int MI_EOFF = 32;
constexpr int MI_TILEE = 64;

typedef __bf16 bf16v2_t __attribute__((ext_vector_type(2)));
typedef float f32v2_t __attribute__((ext_vector_type(2)));
__device__ __forceinline__ unsigned pk2(float lo, float hi) { const f32v2_t v = {lo, hi}; return __builtin_bit_cast(unsigned, __builtin_convertvector(v, bf16v2_t)); }
__device__ __forceinline__ unsigned f2bf(float f) { return pk2(f, 0.f) & 0xffffu; }
__device__ __forceinline__ float bflo(unsigned w) { return __builtin_bit_cast(float, w << 16); }
__device__ __forceinline__ float bfhi(unsigned w) { return __builtin_bit_cast(float, w & 0xffff0000u); }
__device__ __forceinline__ float bf2f(bf16_t h) { return __builtin_bit_cast(float, (unsigned)h << 16); }
__device__ __forceinline__ int otid() { int t = threadIdx.x; asm volatile("" : "+v"(t)); return t; }
__device__ __forceinline__ float shx(float v, int o) { const int idx = ((otid() & 63) ^ o) << 2; return __builtin_bit_cast(float, __builtin_amdgcn_ds_bpermute(idx, __builtin_bit_cast(int, v))); }
__device__ __forceinline__ float shup(float v, int o) { const int idx = (((otid() & 63) - o) & 63) << 2; return __builtin_bit_cast(float, __builtin_amdgcn_ds_bpermute(idx, __builtin_bit_cast(int, v))); }
__device__ __forceinline__ float shlane(float v, int src) { return __builtin_bit_cast(float, __builtin_amdgcn_ds_bpermute(src << 2, __builtin_bit_cast(int, v))); }
__device__ __forceinline__ int shlane_i(int v, int src) { return __builtin_amdgcn_ds_bpermute(src << 2, v); }
__device__ __forceinline__ float wave_sum(float v) {
#pragma unroll
    for (int o = 1; o < 64; o <<= 1) v += shx(v, o);
    return v;
}
__device__ __forceinline__ float sigmoidf_(float x) { return 1.0f / (1.0f + __expf(-x)); }
__device__ __forceinline__ float siluf_(float x) { return x / (1.0f + __expf(-x)); }
__device__ __forceinline__ float softplusf_(float x) { return x > 20.f ? x : (x < -10.f ? __expf(x) : 0.6931471806f * __builtin_amdgcn_logf(1.0f + __builtin_amdgcn_exp2f(1.4426950409f * x))); }
__device__ __forceinline__ float logsigmoidf_(float x) { return fminf(x, 0.f) - log1pf(expf(-fabsf(x))); }
__device__ __forceinline__ float logsigmoid_fast(float z) { z = fmaxf(z, -80.f); return -0.6931471806f * __builtin_amdgcn_logf(1.0f + __builtin_amdgcn_exp2f(-1.4426950409f * z)); }

struct P {
    const float *x, *c, *ctx, *c_ctx, *w_mod, *b_mod, *norm1_g, *norm2_g, *w_in, *conv_a, *a_log, *dt_bias, *gn_a, *w_gate2, *b_gate, *gn_b,
                *lam_c, *gn_c, *w_o_a, *w_o_b, *w_o_c, *w_out, *ffn_w1, *ffn_w3, *ffn_w2, *router_w, *moe_w1, *moe_w3, *moe_w2, *final_g;
    float* out; unsigned char* ws;
};

constexpr long SM_ZERO = (long)1 << 62;
template <class SrcMap>
__device__ __forceinline__ void convert_T(int K, int ldw, bf16_t* WT, int Nrows, SrcMap sm, float* scr  , int gw, int NGW, int lane) {
    const int nblk = Nrows / 64, items = (K / 64) * nblk;
    for (int it = gw; it < items; it += NGW) {
        const int kb = it / nblk, nb = it % nblk, k0 = 64 * kb, n0 = 64 * nb;
        const long so_ = sm(n0 + 4 * (lane & 15)); const float* src = sm.W + (so_ != SM_ZERO ? so_ : 0L);
        f32x4 v[16];
#pragma unroll
        for (int i = 0; i < 16; ++i) { const int kk = 4 * i + (lane >> 4); const f32x4 ld = *(const f32x4*)(src + (size_t)(k0 + kk) * ldw); v[i] = so_ != SM_ZERO ? ld : (f32x4){0.f, 0.f, 0.f, 0.f}; }
#pragma unroll
        for (int i = 0; i < 16; ++i) { const int kk = 4 * i + (lane >> 4); float* d = scr + kk * 65 + 4 * (lane & 15); d[0] = v[i][0]; d[1] = v[i][1]; d[2] = v[i][2]; d[3] = v[i][3]; }
        asm volatile("s_waitcnt lgkmcnt(0)" ::: "memory");
        const int c = lane & 7;
#pragma unroll
        for (int j = 0; j < 8; ++j) { const int n = (lane >> 3) + 8 * j; const float* s = scr + (8 * c) * 65 + n;
            u32x4 o; o.x = pk2(s[0 * 65], s[1 * 65]); o.y = pk2(s[2 * 65], s[3 * 65]); o.z = pk2(s[4 * 65], s[5 * 65]); o.w = pk2(s[6 * 65], s[7 * 65]);
            *(u32x4*)(WT + (size_t)(n0 + n) * K + k0 + 8 * c) = o; }
        asm volatile("s_waitcnt lgkmcnt(0)" ::: "memory");
    }
}
struct SmPlain { const float* W; __device__ long operator()(int n) const { return n; } };
struct SmWin { const float* W; __device__ long operator()(int n) const {
    if (n < 2048) return n; if (n < 3584) return n + 16; if (n < 8192) return n + 48;
    const int j = n - 8192; if (j < 16) return 2048 + j; if (j < 48) return 3600 + (j - 16); return SM_ZERO; } };
struct SmUp { const float* W; long d31; __device__ long operator()(int n) const {
    const int tile = n >> 8, rr = n & 255; return (rr < 128 ? 0L : d31) + tile * 128 + (rr & 127); } };
constexpr int CONV_WLDS = 64 * 65 * 4;
typedef const f32x4 (&AccRef)[2][2][4][2];
struct EpiWin {
    static constexpr bool PERM = true, AFTER_DRAIN = false, CHAIN = false;
    bf16_t *paq, *pz, *pb, *pc, *pg; float* small_;
    __device__ __forceinline__ void operator()(AccRef acc, const pg8::Unit& u, int wr, int wc, int fr, int fq) const {
        const int row0 = u.pm * 256 + wr * 64 + fr, pn = u.pn;
        if (pn == 32) {
            if (wc < 2) {
#pragma unroll
                for (int ai = 0; ai < 2; ++ai)
#pragma unroll
                    for (int m = 0; m < 4; ++m) { float* p = small_ + (size_t)(row0 + ai * 128 + m * 16) * 64 + wc * 32 + 8 * fq;
                        *(f32x4*)p = acc[ai][0][m][0]; *(f32x4*)(p + 4) = acc[ai][0][m][1]; }
            }
            return;
        }
        bf16_t* base; int ldc, c0;
        if (pn < 6) { base = paq; ldc = 1536; c0 = pn * 256; } else if (pn < 8) { base = pz; ldc = 512; c0 = (pn - 6) * 256; }
        else if (pn < 14) { base = pb; ldc = 1536; c0 = (pn - 8) * 256; } else if (pn < 20) { base = pc; ldc = 1536; c0 = (pn - 14) * 256; }
        else { base = pg; ldc = 3072; c0 = (pn - 20) * 256; }
        const int col = c0 + wc * 32 + 8 * fq;
#pragma unroll
        for (int ai = 0; ai < 2; ++ai)
#pragma unroll
            for (int m = 0; m < 4; ++m) { bf16_t* rowp = base + (size_t)(row0 + ai * 128 + m * 16) * ldc + col;
#pragma unroll
                for (int bj = 0; bj < 2; ++bj) { const f32x4 v0 = acc[ai][bj][m][0], v1 = acc[ai][bj][m][1];
                    u32x4 w; w.x = pk2(v0[0], v0[1]); w.y = pk2(v0[2], v0[3]); w.z = pk2(v1[0], v1[1]); w.w = pk2(v1[2], v1[3]);
                    *(u32x4*)(rowp + bj * 128) = w; } }
    }
};
struct EpiGate {
    static constexpr bool PERM = true, AFTER_DRAIN = false, CHAIN = true;
    bf16_t* Mo; const bf16_t* pg;
    static __device__ __forceinline__ float em(float x) { return __expf(-fminf(fmaxf(x, -30.f), 30.f)); }
    __device__ __forceinline__ void operator()(f32x4 (&acc)[2][2][4][2], const pg8::Unit& u, int wr, int wc, int fr, int fq) const {
        const int row0 = u.pm * 256 + wr * 64 + fr, col = u.pn * 256 + wc * 32 + 8 * fq, br = u.br;
#pragma unroll
        for (int ai = 0; ai < 2; ++ai) {
            u32x4 gc[4][2], gn[4][2];
#pragma unroll
            for (int m = 0; m < 4; ++m)
#pragma unroll
                for (int bj = 0; bj < 2; ++bj) { const size_t row = (size_t)(row0 + ai * 128 + m * 16);
                    gc[m][bj] = *(const u32x4*)(pg + row * 3072 + br * 1024 + col + bj * 128);
                    gn[m][bj] = *(const u32x4*)(pg + row * 3072 + (br < 2 ? br + 1 : br) * 1024 + col + bj * 128); }
#pragma unroll
            for (int m = 0; m < 4; ++m) { const size_t row = (size_t)(row0 + ai * 128 + m * 16);
#pragma unroll
                for (int bj = 0; bj < 2; ++bj) {
                    const unsigned gcw[4] = {gc[m][bj].x, gc[m][bj].y, gc[m][bj].z, gc[m][bj].w}, gnw[4] = {gn[m][bj].x, gn[m][bj].y, gn[m][bj].z, gn[m][bj].w};
                    f32x4& v0 = acc[ai][bj][m][0]; f32x4& v1 = acc[ai][bj][m][1];
                    if (br < 2) {
#pragma unroll
                        for (int q = 0; q < 4; ++q) { const float r0 = (1.0f + em(bflo(gnw[q]))) / (1.0f + em(bflo(gcw[q]))), r1 = (1.0f + em(bfhi(gnw[q]))) / (1.0f + em(bfhi(gcw[q])));
                            if (q < 2) { v0[2 * q] *= r0; v0[2 * q + 1] *= r1; } else { v1[2 * q - 4] *= r0; v1[2 * q - 3] *= r1; } }
                    } else {
#pragma unroll
                        for (int q = 0; q < 4; ++q) { const float s0 = 1.0f / (1.0f + em(bflo(gcw[q]))), s1 = 1.0f / (1.0f + em(bfhi(gcw[q])));
                            if (q < 2) { v0[2 * q] *= s0; v0[2 * q + 1] *= s1; } else { v1[2 * q - 4] *= s0; v1[2 * q - 3] *= s1; } }
                        u32x4 w; w.x = pk2(v0[0], v0[1]); w.y = pk2(v0[2], v0[3]); w.z = pk2(v1[0], v1[1]); w.w = pk2(v1[2], v1[3]);
                        *(u32x4*)(Mo + row * 1024 + col + bj * 128) = w; } } }
        }
    }
};
struct MergeOrder {
    pg8::StaticOrder so;
    __device__ bool next(int i, pg8::Unit& u) const { const int t = i / 3; if (!so.next(t, u)) return false; u.br = i - 3 * t; return true; }
    __device__ __forceinline__ void a_ready(const pg8::Unit&) const {}
    __device__ __forceinline__ void done(const pg8::Unit&) const {}
};
struct WinLastOrder {
    pg8::StaticOrder so; int G, c, nextra;
    __device__ bool next(int i, pg8::Unit& u) const {
        pg8::Unit t; const bool ok = so.next(i, t);
        const int L = i * G + c - so.nwg; const bool ex = !ok && L >= 0 && L < nextra;
        const int q = L % 12, pn2 = q < 4 ? 2 + q : q < 7 ? 5 + q : q < 11 ? 9 + q : 32;
        u.pm = ok ? t.pm : TL / 256 + L / 12; u.pn = ok ? t.pn : pn2; u.br = 0; return ok || ex; }
    __device__ __forceinline__ void a_ready(const pg8::Unit&) const {}
    __device__ __forceinline__ void done(const pg8::Unit&) const {}
};
struct EpiResid {
    static constexpr bool PERM = false, AFTER_DRAIN = false, CHAIN = false;
    const float *old_l, *old_c; float *out_l, *out_c; const float* mod; int gidx;
    __device__ __forceinline__ void operator()(AccRef acc, const pg8::Unit& u, int wr, int wc, int fr, int fq) const {
        const int col0 = u.pn * 256 + wc * 32 + 4 * fq;
        const bool isctx = u.pm >= TL / 256; const int b = isctx ? 8 : u.pm / (SEQ / 256);
        const float* g = mod + (size_t)b * 6144 + gidx * 1024 + col0;
        const float* ob = isctx ? old_c - (size_t)TL * D : old_l; float* wb = isctx ? out_c - (size_t)TL * D : out_l;
        f32x4 gv[2][2];
#pragma unroll
        for (int bj = 0; bj < 2; ++bj)
#pragma unroll
            for (int n = 0; n < 2; ++n) gv[bj][n] = *(const f32x4*)(g + bj * 128 + n * 16);
#pragma unroll
        for (int ai = 0; ai < 2; ++ai) {
            f32x4 xo[4][2][2];
#pragma unroll
            for (int m = 0; m < 4; ++m) { const size_t off = (size_t)(u.pm * 256 + ai * 128 + wr * 64 + m * 16 + fr) * D + col0;
#pragma unroll
                for (int bj = 0; bj < 2; ++bj)
#pragma unroll
                    for (int n = 0; n < 2; ++n) xo[m][bj][n] = *(const f32x4*)(ob + off + bj * 128 + n * 16); }
#pragma unroll
            for (int m = 0; m < 4; ++m) { const size_t off = (size_t)(u.pm * 256 + ai * 128 + wr * 64 + m * 16 + fr) * D + col0;
#pragma unroll
                for (int bj = 0; bj < 2; ++bj)
#pragma unroll
                    for (int n = 0; n < 2; ++n) *(f32x4*)(wb + off + bj * 128 + n * 16) = xo[m][bj][n] + gv[bj][n] * acc[ai][bj][m][n]; }
        }
    }
};
struct EpiSwiglu {
    static constexpr bool PERM = true, AFTER_DRAIN = false, CHAIN = false;
    bf16_t* h1; int NJ;
    __device__ __forceinline__ void operator()(AccRef acc, const pg8::Unit& u, int wr, int wc, int fr, int fq) const {
        const int row0 = u.pm * 256 + wr * 64 + fr, col = (u.pn % NJ) * 128 + wc * 32 + 8 * fq;
#pragma unroll
        for (int ai = 0; ai < 2; ++ai)
#pragma unroll
            for (int m = 0; m < 4; ++m) { const f32x4 a0 = acc[ai][0][m][0], a1 = acc[ai][0][m][1], b0 = acc[ai][1][m][0], b1 = acc[ai][1][m][1];
                u32x4 w; w.x = pk2(siluf_(a0[0]) * b0[0], siluf_(a0[1]) * b0[1]); w.y = pk2(siluf_(a0[2]) * b0[2], siluf_(a0[3]) * b0[3]);
                w.z = pk2(siluf_(a1[0]) * b1[0], siluf_(a1[1]) * b1[1]); w.w = pk2(siluf_(a1[2]) * b1[2], siluf_(a1[3]) * b1[3]);
                *(u32x4*)(h1 + (size_t)(row0 + ai * 128 + m * 16) * DFF + col) = w; }
    }
};
struct EpiMoeDown {
    static constexpr bool PERM = true, AFTER_DRAIN = false, CHAIN = false;
    bf16_t* y;
    __device__ __forceinline__ void operator()(AccRef acc, const pg8::Unit& u, int wr, int wc, int fr, int fq) const {
        const int row0 = u.pm * 256 + wr * 64 + fr, col = (u.pn % 4) * 256 + wc * 32 + 8 * fq;
#pragma unroll
        for (int ai = 0; ai < 2; ++ai)
#pragma unroll
            for (int m = 0; m < 4; ++m) { bf16_t* rowp = y + (size_t)(row0 + ai * 128 + m * 16) * D + col;
#pragma unroll
                for (int bj = 0; bj < 2; ++bj) { const f32x4 v0 = acc[ai][bj][m][0], v1 = acc[ai][bj][m][1];
                    u32x4 w; w.x = pk2(v0[0], v0[1]); w.y = pk2(v0[2], v0[3]); w.z = pk2(v1[0], v1[1]); w.w = pk2(v1[2], v1[3]);
                    *(u32x4*)(rowp + bj * 128) = w; } }
    }
};
struct MoeOrder {
    int ntiles, NJ, G, c; const int* tile_e;
    __device__ bool next(int i, pg8::Unit& u) const { const long L = (long)i * G + c; if (L >= (long)ntiles * NJ) return false;
        const int t = (int)(L / NJ), j = (int)(L % NJ); u.pm = t; u.pn = tile_e[t] * NJ + j; u.br = 0; return true; }
    __device__ __forceinline__ void a_ready(const pg8::Unit&) const {}
    __device__ __forceinline__ void done(const pg8::Unit&) const {}
};

#define XB_TMO      128
#define XB_XCNT(j)  (256  + 64 * (j))
#define XB_XSUB(j)  (1280 + 64 * (j))
#define XB_XGEN(j)  (2304 + 64 * (j))
#define XB_TOP      3328
#define XB_TOPGEN   3392
#define XCD_BAR_WORDS 3456
#define XB_SPIN_CAP (1u << 18)

__device__ __forceinline__ unsigned xb_ld(unsigned* p)              { return __hip_atomic_load(p, __ATOMIC_RELAXED, __HIP_MEMORY_SCOPE_AGENT); }
__device__ __forceinline__ unsigned xb_add(unsigned* p, unsigned v) { return __hip_atomic_fetch_add(p, v, __ATOMIC_RELAXED, __HIP_MEMORY_SCOPE_AGENT); }
__device__ __forceinline__ unsigned xb_xcc_id() { return (unsigned)__builtin_amdgcn_s_getreg((3 << 11) | 20) & 0xFu; }
#define XB_SPIN(cond, bar) do { unsigned _sp = 0; while (cond) { __builtin_amdgcn_s_sleep(1); \
    if ((++_sp & 255u) == 0u) { if (xb_ld(&(bar)[XB_TMO])) break; if (_sp > XB_SPIN_CAP) { atomicAdd(&(bar)[XB_TMO], 1u); break; } } } } while (0)

struct XcdBarrier {
    unsigned* bar; unsigned x;
    volatile unsigned* st;
};

__device__ __forceinline__ XcdBarrier xcd_barrier_post(unsigned* bar, volatile unsigned* st) {
    XcdBarrier b; b.bar = bar; b.x = xb_xcc_id(); b.st = st;
    if (threadIdx.x == 0) (void)xb_add(&bar[XB_XCNT(b.x)], 1u);
    return b;
}
__device__ __forceinline__ void xcd_barrier_complete(unsigned* bar, unsigned x, unsigned& nloc, unsigned& nx) {
    const unsigned G = gridDim.x * gridDim.y * gridDim.z;
    unsigned sum, cnt, mine, sp = 0u;
    for (;;) {
        sum = 0u; cnt = 0u; mine = 0u;
#pragma unroll
        for (unsigned j = 0; j < 16; ++j) { const unsigned c = xb_ld(&bar[XB_XCNT(j)]); sum += c; cnt += (c > 0u) ? 1u : 0u; mine = (j == x) ? c : mine; }
        if (sum == G) break;
        __builtin_amdgcn_s_sleep(1);
        if ((++sp & 255u) == 0u) { if (xb_ld(&bar[XB_TMO])) break; if (sp > XB_SPIN_CAP) { atomicAdd(&bar[XB_TMO], 1u); break; } }
    }
    nloc = mine > 0u ? mine : 1u; nx = cnt > 0u ? cnt : 1u;
}

__device__ __forceinline__ void xcd_barrier(const XcdBarrier& b) {
    asm volatile("s_waitcnt vmcnt(0)" ::: "memory");
    __syncthreads();
    if (threadIdx.x == 0) {
        unsigned* bar = b.bar;
        __builtin_amdgcn_s_waitcnt(0);
        unsigned nloc = b.st[0], nx = b.st[1];
        if (nloc == 0u) { xcd_barrier_complete(bar, b.x, nloc, nx); b.st[0] = nloc; b.st[1] = nx; }
        const unsigned old = xb_add(&bar[XB_XSUB(b.x)], 1u);
        const unsigned gen = old / nloc;
        if (old + 1u == (gen + 1u) * nloc) {
            __builtin_amdgcn_fence(__ATOMIC_RELEASE, "agent");
            asm volatile("s_waitcnt vmcnt(0)" ::: "memory");
            const unsigned og = xb_add(&bar[XB_TOP], 1u);
            const unsigned tg = og / nx;
            if (og + 1u == (tg + 1u) * nx) xb_add(&bar[XB_TOPGEN], 1u);
            else XB_SPIN(xb_ld(&bar[XB_TOPGEN]) == tg, bar);
            __builtin_amdgcn_fence(__ATOMIC_ACQUIRE, "agent");
            xb_add(&bar[XB_XGEN(b.x)], 1u);
            asm volatile("s_waitcnt vmcnt(0)" ::: "memory");
        } else {
            XB_SPIN(xb_ld(&bar[XB_XGEN(b.x)]) == gen, bar);
            __builtin_amdgcn_fence(__ATOMIC_ACQUIRE, "agent");
            asm volatile("s_waitcnt vmcnt(0)" ::: "memory");
        }
    }
    __syncthreads();
}

__device__ __forceinline__ void phase_mod(const P& p, unsigned char* lds) {
    float* sc = (float*)lds;
    float* red = sc + 9 * 1024;
    const int tid = otid();
    for (int i = tid; i < 9 * 1024; i += NTHREADS) { const int r = i >> 10, k = i & 1023; const float v = r < 8 ? p.c[r * 1024 + k] : p.c_ctx[k]; sc[i] = siluf_(v); }
    __syncthreads();
    float* MOD = (float*)(p.ws + WS_MOD);
    const int cj = tid % 48, ks = tid / 48;
    for (int grp = blockIdx.x; grp < DEPTH * 6144 / 48; grp += gridDim.x) {
        const int l = grp / 128, j = (grp % 128) * 48 + cj;
        float a[9];
#pragma unroll
        for (int r = 0; r < 9; ++r) a[r] = 0.f;
        if (ks < 10) {
            const float* w = p.w_mod + (size_t)l * 1024 * 6144 + j;
            for (int k = ks; k < 1024; k += 10) { const float wv = w[(size_t)k * 6144];
#pragma unroll
                for (int r = 0; r < 9; ++r) a[r] += sc[r * 1024 + k] * wv; }
#pragma unroll
            for (int r = 0; r < 9; ++r) red[(ks * 9 + r) * 48 + cj] = a[r];
        }
        __syncthreads();
        if (tid < 9 * 48) { const int r = tid / 48, c2 = tid % 48; float s = 0.f;
#pragma unroll
            for (int q = 0; q < 10; ++q) s += red[(q * 9 + r) * 48 + c2];
            const int jj = (grp % 128) * 48 + c2;
            MOD[((size_t)l * 9 + r) * 6144 + jj] = s + p.b_mod[l * 6144 + jj]; }
        __syncthreads();
    }
}

__device__ __forceinline__ void phase_modulate(const float* src_l, const float* src_c, int nrows, const float* gain, const float* mod, int shift_idx,
                                               bf16_t* H, const float* router_w, int* route, unsigned* ecnt, unsigned* lcnt  , int gw, int NGW, int lane) {
    if (router_w) { if (otid() < NE) lcnt[otid()] = 0u; __syncthreads(); }
    for (int r0_ = gw; r0_ < nrows; r0_ += 4 * NGW)
#pragma unroll
    for (int rr_ = 0; rr_ < 4; ++rr_) { const int r = r0_ + rr_ * NGW; if (r >= nrows) break;
        const bool isctx = r >= TL; const int b = isctx ? 8 : r / SEQ;
        const float* xr = isctx ? src_c + (size_t)(r - TL) * D : src_l + (size_t)r * D;
        const float* sh = mod + (size_t)b * 6144 + shift_idx * 1024; const float* scl = sh + 1024;
        f32x4 v[4]; float ss = 0.f;
#pragma unroll
        for (int j = 0; j < 4; ++j) { v[j] = *(const f32x4*)(xr + 4 * lane + 256 * j); ss += (v[j][0] * v[j][0] + v[j][1] * v[j][1]) + (v[j][2] * v[j][2] + v[j][3] * v[j][3]); }
        const float rs = 1.0f / sqrtf(wave_sum(ss) * (1.0f / D) + EPS);
#pragma unroll
        for (int j = 0; j < 4; ++j) { const int c = 4 * lane + 256 * j; const f32x4 g = *(const f32x4*)(gain + c), s1 = *(const f32x4*)(scl + c), s0 = *(const f32x4*)(sh + c);
            v[j] = v[j] * rs * g * (1.0f + s1) + s0;
            u32x2 w; w.x = pk2(v[j][0], v[j][1]); w.y = pk2(v[j][2], v[j][3]);
            *(u32x2*)(H + (size_t)r * D + c) = w; }
        if (router_w) {
            float lg[NE];
#pragma unroll
            for (int e = 0; e < NE; ++e) lg[e] = 0.f;
#pragma unroll
            for (int j = 0; j < 4; ++j)
#pragma unroll
                for (int q = 0; q < 4; ++q) { const float* rw = router_w + (size_t)(4 * lane + 256 * j + q) * NE; const f32x4 r0 = *(const f32x4*)rw, r1 = *(const f32x4*)(rw + 4); const float hv = v[j][q];
                    lg[0] += hv * r0[0]; lg[1] += hv * r0[1]; lg[2] += hv * r0[2]; lg[3] += hv * r0[3]; lg[4] += hv * r1[0]; lg[5] += hv * r1[1]; lg[6] += hv * r1[2]; lg[7] += hv * r1[3]; }
#pragma unroll
            for (int e = 0; e < NE; ++e) lg[e] = wave_sum(lg[e]);
            int e1 = 0; float v1 = lg[0];
#pragma unroll
            for (int e = 1; e < NE; ++e) if (lg[e] > v1) { v1 = lg[e]; e1 = e; }
            int e2 = e1 == 0 ? 1 : 0; float v2 = lg[e2];
#pragma unroll
            for (int e = 0; e < NE; ++e) if (e != e1 && lg[e] > v2) { v2 = lg[e]; e2 = e; }
            const float w2 = 1.0f / (1.0f + expf(v1 - v2)), w1 = 1.0f - w2;
            if (lane == 0) { route[r * 4 + 0] = e1; route[r * 4 + 1] = e2; ((float*)route)[r * 4 + 2] = w1; ((float*)route)[r * 4 + 3] = w2;
                atomicAdd(lcnt + e1, 1u); atomicAdd(lcnt + e2, 1u); }
        }
    }
    if (router_w) { __syncthreads(); if (otid() < NE && lcnt[otid()]) atomicAdd(ecnt + otid(), lcnt[otid()]); }
}


typedef short v4i16_t __attribute__((ext_vector_type(4)));
__device__ __forceinline__ s16x4 lds_tr(const bf16_t* pp) { return __builtin_bit_cast(s16x4, __builtin_amdgcn_ds_read_tr16_b64_v4i16((__attribute__((address_space(3))) v4i16_t*)pp)); }
__device__ __forceinline__ bf16x8 cat8(s16x4 a, s16x4 b) { union { bf16x8 v; s16x4 h[2]; } u; u.h[0] = a; u.h[1] = b; return u.v; }
__device__ __forceinline__ bf16x8 pack8(f32x4 a, f32x4 b) { union { bf16x8 v; unsigned u[4]; } r; r.u[0] = pk2(a[0], a[1]); r.u[1] = pk2(a[2], a[3]); r.u[2] = pk2(b[0], b[1]); r.u[3] = pk2(b[2], b[3]); return r.v; }
constexpr int DN_NCH = (CTXL + SEQ) / 64;
constexpr int DN_ITEMS = BATCH * 4 * DN_NCH;
constexpr int PREP_WLDS = 10240 + 17408 + 1024 + 2304;
constexpr int PREP_NW = 5;

__device__ __forceinline__ int dn_row(int n, int s, int b, int dir) {
    const bool isctx = n < CTXL / 64; const int L = isctx ? CTXL : SEQ, c = isctx ? n : n - CTXL / 64, u = 64 * c + s, t = dir ? L - 1 - u : u;
    return (isctx ? TL + b * CTXL : b * SEQ) + t;
}
__device__ __forceinline__ void dn_prep_item(const P& p, int l, int item, unsigned char* wlds, int lane) {
    asm volatile("" : "+v"(lane));
    const int cn = item % DN_NCH, bh = item / DN_NCH, h = bh & 3, b = bh >> 2;
    const bool isctx = cn < CTXL / 64; const int L = isctx ? CTXL : SEQ, cch = isctx ? cn : cn - CTXL / 64, rbase = isctx ? TL + b * CTXL : b * SEQ, nchp = L / 64;
    const int item0 = (bh * 2 + 0) * DN_NCH + cn, item1 = (bh * 2 + 1) * DN_NCH + (isctx ? nchp - 1 - cch : CTXL / 64 + nchp - 1 - cch);
    const int i16 = lane & 15, g = lane >> 4;
    const bf16_t* PAQ = (const bf16_t*)(p.ws + WS_PAQ); bf16_t* DN = (bf16_t*)(p.ws + WS_DNQKV); const float* SMALL = (const float*)(p.ws + WS_SMALL);
    const float* cw = p.conv_a + (size_t)l * 3 * 1536;
    constexpr int KCP = 136;
    float* Ls = (float*)wlds; bf16_t* Kc = (bf16_t*)(wlds + 10240); bf16_t* Tl = (bf16_t*)(wlds + 10240 + 9216);
    float* gc0 = (float*)(wlds + 10240 + 17408); float* be0 = gc0 + 64; float* sf1 = be0 + 64; float* be1 = sf1 + 64;
    bf16_t* cwl = (bf16_t*)(wlds + 10240 + 17408 + 1024);
    for (int i = lane; i < 3 * 384 / 2; i += 64) { const int tap = i / 192, c2 = (i % 192) * 2, sg = c2 >> 7, cc = c2 & 127; const float* src_ = cw + tap * 1536 + sg * 512 + h * 128 + cc;
        *(unsigned*)(cwl + tap * 384 + c2) = pk2(src_[0], src_[1]); }
    {
        const size_t r = (size_t)(rbase + 64 * cch + lane);
        const f32x4 s0 = *(const f32x4*)(SMALL + r * 64), s1 = *(const f32x4*)(SMALL + r * 64 + 4), s2 = *(const f32x4*)(SMALL + r * 64 + 8), s3 = *(const f32x4*)(SMALL + r * 64 + 12);
        const float g0v = -expf(p.a_log[l * 8 + h]) * softplusf_(s2[h] + p.dt_bias[l * 8 + h]), g1v = -expf(p.a_log[l * 8 + 4 + h]) * softplusf_(s3[h] + p.dt_bias[l * 8 + 4 + h]);
        const float b0v = sigmoidf_(s0[h]), b1v = sigmoidf_(s1[h]);
        float c0 = g0v, c1 = g1v;
#pragma unroll
        for (int o = 1; o < 64; o <<= 1) { const float u0 = shup(c0, o), u1 = shup(c1, o); if (lane >= o) { c0 += u0; c1 += u1; } }
        const float t0 = shlane(c0, 63), t1 = shlane(c1, 63), sf = t1 - c1 + g1v;
        gc0[lane] = c0; be0[lane] = b0v; sf1[lane] = sf; be1[lane] = b1v;
        float* v0 = (float*)(p.ws + WS_VEC) + (size_t)item0 * 256; float* v1 = (float*)(p.ws + WS_VEC) + (size_t)item1 * 256;
        v0[lane] = expf(c0); v0[64 + lane] = expf(t0 - c0); v0[128 + lane] = b0v; v0[192 + lane] = expf(t0);
        v1[63 - lane] = expf(sf); v1[64 + 63 - lane] = expf(t1 - sf); v1[128 + 63 - lane] = b1v; v1[192 + lane] = expf(t1);
    }
    struct SegRows { u32x4 x[6][4]; };
    auto seg_load = [&](int seg, SegRows& Sg) {
        int lo_ = lane; asm volatile("" : "+v"(lo_));
        const int i16 = lo_ & 15, g = lo_ >> 4;
#pragma unroll
        for (int f = 0; f < 6; ++f) { const int t = 64 * cch + 16 * (f - 1) + i16; const bool ok = t >= 0 && t < L; const size_t r = (size_t)(rbase + (ok ? t : 0));
#pragma unroll
            for (int ks = 0; ks < 4; ++ks) { Sg.x[f][ks] = (u32x4){0u, 0u, 0u, 0u}; if (ok) Sg.x[f][ks] = *(const u32x4*)(PAQ + r * 1536 + seg * 512 + h * 128 + 32 * ks + 8 * g); } }
    };
    auto tap_prev = [&](unsigned own, unsigned before) -> unsigned {
        const int t0 = __builtin_amdgcn_update_dpp(0, (int)before, 0x121  , 0xF, 0xF, false);
        return (unsigned)__builtin_amdgcn_update_dpp(t0, (int)own, 0x111  , 0xF, 0xF, false); };
    auto tap_next = [&](unsigned own, unsigned after) -> unsigned {
        const int t0 = __builtin_amdgcn_update_dpp(0, (int)after, 0x12F  , 0xF, 0xF, false);
        return (unsigned)__builtin_amdgcn_update_dpp(t0, (int)own, 0x101  , 0xF, 0xF, false); };
    auto conv_compute = [&](int seg, int mt, const SegRows& Sg, bf16x8 (&F)[4]) {
        const int t = 64 * cch + 16 * mt + i16; const size_t r = (size_t)(rbase + t);
        float y[4][8]; float ss = 0.f;
#pragma unroll
        for (int ks = 0; ks < 4; ++ks) {
            const int wo_ = seg * 128 + 32 * ks + 8 * g;
            const u32x4 wa = *(const u32x4*)(cwl + wo_), wb = *(const u32x4*)(cwl + 384 + wo_), wc = *(const u32x4*)(cwl + 768 + wo_);
            const u32x4 o_ = Sg.x[1 + mt][ks], pb_ = Sg.x[mt][ks], nb_ = Sg.x[2 + mt][ks];
            const unsigned xb[4] = {o_.x, o_.y, o_.z, o_.w}, xa[4] = {tap_prev(o_.x, pb_.x), tap_prev(o_.y, pb_.y), tap_prev(o_.z, pb_.z), tap_prev(o_.w, pb_.w)}, xc[4] = {tap_next(o_.x, nb_.x), tap_next(o_.y, nb_.y), tap_next(o_.z, nb_.z), tap_next(o_.w, nb_.w)};
            const unsigned wA[4] = {wa.x, wa.y, wa.z, wa.w}, wB[4] = {wb.x, wb.y, wb.z, wb.w}, wC[4] = {wc.x, wc.y, wc.z, wc.w};
#pragma unroll
            for (int q = 0; q < 4; ++q) {
                const float v0 = siluf_(bflo(wA[q]) * bflo(xa[q]) + bflo(wB[q]) * bflo(xb[q]) + bflo(wC[q]) * bflo(xc[q])), v1 = siluf_(bfhi(wA[q]) * bfhi(xa[q]) + bfhi(wB[q]) * bfhi(xb[q]) + bfhi(wC[q]) * bfhi(xc[q]));
                y[ks][2 * q] = v0; y[ks][2 * q + 1] = v1; ss += v0 * v0 + v1 * v1; }
        }
        float sc = 1.0f;
        if (seg < 2) { ss += shx(ss, 16); ss += shx(ss, 32); sc = 1.0f / sqrtf(ss + EPS); if (seg == 0) sc *= 0.08838834764831845f; }
#pragma unroll
        for (int ks = 0; ks < 4; ++ks) { union { bf16x8 v; u32x4 w; } f;
            f.w.x = pk2(y[ks][0] * sc, y[ks][1] * sc); f.w.y = pk2(y[ks][2] * sc, y[ks][3] * sc); f.w.z = pk2(y[ks][4] * sc, y[ks][5] * sc); f.w.w = pk2(y[ks][6] * sc, y[ks][7] * sc);
            F[ks] = f.v;
            *(u32x4*)(DN + r * 1536 + seg * 512 + h * 128 + 32 * ks + 8 * g) = f.w; }
    };
    { PH_BEGIN(12); {
#pragma unroll 1
      for (int sg = 0; sg < 2; ++sg) { const int seg = sg == 0 ? 1 : 2;
        SegRows Sg; seg_load(seg, Sg);
#pragma unroll
        for (int mt = 0; mt < 4; ++mt) { bf16x8 F[4];
            conv_compute(seg, mt, Sg, F);
            if (seg == 1) {
#pragma unroll
                for (int ks = 0; ks < 4; ++ks) *(bf16x8*)(Kc + (16 * mt + i16) * KCP + 32 * ks + 8 * g) = F[ks]; } } } } PH_END(12); }
    asm volatile("s_waitcnt lgkmcnt(0)" ::: "memory");
    f32x4 Ut[10];
    { PH_BEGIN(13);
    bf16_t* QK0g = (bf16_t*)(p.ws + WS_TQ + (size_t)item0 * 16384 + 8192); bf16_t* QK1g = (bf16_t*)(p.ws + WS_TQ + (size_t)item1 * 16384 + 8192);
    auto qk_tiles = [&](int mt, const bf16x8 (&Qf)[4]) {
#pragma unroll 1
        for (int nt = 0; nt < 4; ++nt) { f32x4 acc = (f32x4){0.f, 0.f, 0.f, 0.f}; const int j = 16 * nt + i16;
#pragma unroll
            for (int ks = 0; ks < 4; ++ks) acc = __builtin_amdgcn_mfma_f32_16x16x32_bf16(Qf[ks], *(const bf16x8*)(Kc + (16 * nt + i16) * KCP + 32 * ks + 8 * g), acc, 0, 0, 0);
            const float gj = gc0[j], sj = sf1[j];
#pragma unroll
            for (int rg = 0; rg < 4; ++rg) { const int i = 16 * mt + 4 * g + rg;
                const float q0 = i >= j ? acc[rg] * __expf(gc0[i] - gj) : 0.f, q1 = i <= j ? acc[rg] * __expf(sf1[i] - sj) : 0.f;
                QK0g[i * 64 + j] = (bf16_t)f2bf(q0); QK1g[(63 - i) * 64 + (63 - j)] = (bf16_t)f2bf(q1); } } };
    { SegRows Sg; seg_load(0, Sg);
#pragma unroll
      for (int mt = 0; mt < 4; ++mt) { bf16x8 Qf[4]; conv_compute(0, mt, Sg, Qf); qk_tiles(mt, Qf); } }
#pragma unroll
    for (int mt = 0; mt < 4; ++mt) {
        bf16x8 A[4];
#pragma unroll
        for (int ks = 0; ks < 4; ++ks) A[ks] = *(const bf16x8*)(Kc + (16 * mt + i16) * KCP + 32 * ks + 8 * g);
#pragma unroll
        for (int nt = 0; nt < 4; ++nt) { f32x4 acc = (f32x4){0.f, 0.f, 0.f, 0.f};
#pragma unroll
            for (int ks = 0; ks < 4; ++ks) acc = __builtin_amdgcn_mfma_f32_16x16x32_bf16(A[ks], *(const bf16x8*)(Kc + (16 * nt + i16) * KCP + 32 * ks + 8 * g), acc, 0, 0, 0);
            const int j = 16 * nt + i16;
            if (mt >= nt) { const float gj = gc0[j]; f32x4 lv;
#pragma unroll
                for (int rg = 0; rg < 4; ++rg) { const int i = 16 * mt + 4 * g + rg; lv[rg] = i > j ? be0[i] * acc[rg] * __expf(gc0[i] - gj) : 0.f; }
                *(f32x4*)(Ls + ((mt * (mt + 1)) / 2 + nt) * 256 + i16 * 16 + 4 * g) = lv; }
            if (mt <= nt) { const float sj = sf1[j]; f32x4 uv;
#pragma unroll
                for (int rg = 0; rg < 4; ++rg) { const int i = 16 * mt + 4 * g + rg; uv[rg] = i < j ? be1[i] * acc[rg] * __expf(sf1[i] - sj) : 0.f; }
                Ut[(nt * (nt + 1)) / 2 + mt] = uv; }
            asm volatile("" ::: "memory"); }
    }
    PH_END(13); }
    asm volatile("s_waitcnt lgkmcnt(0)" ::: "memory");
    auto solve = [&](int itemd) {
        constexpr int LP = 72;
        bf16_t* Lb = (bf16_t*)(wlds + 10240); bf16_t* Tt = (bf16_t*)wlds; bf16_t* Dv = (bf16_t*)(wlds + 10240 + 17408 + 1024);
        {
            const int Bq = lane >> 4, cq = lane & 15; const float* lblk = Ls + ((Bq * (Bq + 1)) / 2 + Bq) * 256;
            float x[16];
#pragma unroll
            for (int ii = 0; ii < 16; ++ii) x[ii] = (ii == cq) ? 1.f : 0.f;
#pragma unroll
            for (int jj = 0; jj < 15; ++jj) { const float tj = x[jj]; const float* lc = lblk + jj * 16;
                const f32x4 l0 = *(const f32x4*)lc, l1 = *(const f32x4*)(lc + 4), l2 = *(const f32x4*)(lc + 8), l3 = *(const f32x4*)(lc + 12);
#pragma unroll
                for (int q = 0; q < 4; ++q) { if (q > jj) x[q] -= l0[q] * tj; if (4 + q > jj) x[4 + q] -= l1[q] * tj; if (8 + q > jj) x[8 + q] -= l2[q] * tj; if (12 + q > jj) x[12 + q] -= l3[q] * tj; } }
#pragma unroll
            for (int ii = 0; ii < 16; ++ii) Dv[(Bq * 16 + ii) * 16 + cq] = (bf16_t)f2bf(x[ii]);
        }
        {
            const int jl = lane >> 2, iq = lane & 3;
#pragma unroll
            for (int bi = 0; bi < 4; ++bi)
#pragma unroll
                for (int bj = 0; bj <= bi; ++bj) { const f32x4 lv = *(const f32x4*)(Ls + ((bi * (bi + 1)) / 2 + bj) * 256 + jl * 16 + 4 * iq);
#pragma unroll
                    for (int q = 0; q < 4; ++q) Lb[(16 * bi + 4 * iq + q) * LP + 16 * bj + jl] = (bf16_t)f2bf(lv[q]); }
        }
        asm volatile("s_waitcnt lgkmcnt(0)" ::: "memory");
        unsigned z_ = 0u; asm volatile("" : "+v"(z_));
        const u32x4 zz = (u32x4){z_, z_, z_, z_};
#pragma unroll
        for (int q = 0; q < 9; ++q) ((u32x4*)Tt)[q * 64 + lane] = zz;
#pragma unroll
        for (int q = 0; q < 8; ++q) ((u32x4*)Tl)[q * 64 + lane] = zz;
        asm volatile("s_waitcnt lgkmcnt(0)" ::: "memory");
#pragma unroll
        for (int B = 0; B < 4; ++B) {
            const bf16x8 aD = cat8(*(const s16x4*)(Dv + (B * 16 + i16) * 16 + 4 * g), (s16x4){0, 0, 0, 0});
#pragma unroll
            for (int nt = 0; nt <= B; ++nt) {
                f32x4 acc = (f32x4){0.f, 0.f, 0.f, 0.f};
#pragma unroll
                for (int ks = 0; ks < (B + 1) / 2; ++ks)
                    acc = __builtin_amdgcn_mfma_f32_16x16x32_bf16(*(const bf16x8*)(Lb + (16 * B + i16) * LP + 32 * ks + 8 * g), *(const bf16x8*)(Tt + (16 * nt + i16) * LP + 32 * ks + 8 * g), acc, 0, 0, 0);
                f32x4 sv;
#pragma unroll
                for (int r = 0; r < 4; ++r) sv[r] = ((nt == B && 4 * g + r == i16) ? 1.f : 0.f) - acc[r];
                const f32x4 tv = __builtin_amdgcn_mfma_f32_16x16x32_bf16(aD, pack8(sv, (f32x4){0.f, 0.f, 0.f, 0.f}), (f32x4){0.f, 0.f, 0.f, 0.f}, 0, 0, 0);
                u32x2 tw; tw.x = pk2(tv[0], tv[1]); tw.y = pk2(tv[2], tv[3]);
                *(u32x2*)(Tt + (16 * nt + i16) * LP + 16 * B + 4 * g) = tw;
#pragma unroll
                for (int r = 0; r < 4; ++r) Tl[(16 * B + 4 * g + r) * 64 + 16 * nt + i16] = (bf16_t)f2bf(tv[r]);
            }
            asm volatile("s_waitcnt lgkmcnt(0)" ::: "memory");
        }
        { const u32x4* srcl = (const u32x4*)Tl; u32x4* dstg = (u32x4*)(p.ws + WS_TQ + (size_t)itemd * 16384);
#pragma unroll
          for (int q = 0; q < 8; ++q) dstg[q * 64 + lane] = srcl[q * 64 + lane]; }
        asm volatile("s_waitcnt lgkmcnt(0)" ::: "memory");
    };
    { PH_BEGIN(14);
    solve(item0);
#pragma unroll
    for (int nt = 0; nt < 4; ++nt)
#pragma unroll
        for (int mt = 0; mt <= nt; ++mt) { const f32x4 uv = Ut[(nt * (nt + 1)) / 2 + mt]; const int bi_ = 3 - mt, bj_ = 3 - nt;
            *(f32x4*)(Ls + ((bi_ * (bi_ + 1)) / 2 + bj_) * 256 + (15 - i16) * 16 + (12 - 4 * g)) = (f32x4){uv[3], uv[2], uv[1], uv[0]}; }
    asm volatile("s_waitcnt lgkmcnt(0)" ::: "memory");
    solve(item1);
    PH_END(14); }
}

__device__ __forceinline__ void dn_chain_mfma(const P& p, int item, unsigned char* lds) {
    const int b = item >> 3, h = (item >> 1) & 3, dir = item & 1, tid = otid(), lane = tid & 63, w = tid >> 6, i16 = lane & 15, g = lane >> 4;
    constexpr int KP = 136, TP = 72;
    bf16_t* Ks = (bf16_t*)lds; bf16_t* Qs = Ks + 64 * KP; bf16_t* Vs = Qs + 64 * KP; bf16_t* Ts = Vs + 64 * KP; bf16_t* QKs = Ts + 64 * TP; float* vec = (float*)(QKs + 64 * TP);
    const bf16_t* DN = (const bf16_t*)(p.ws + WS_DNQKV); bf16_t* OA = (bf16_t*)(p.ws + WS_H) + (size_t)dir * T * 512;
    f32x4 S[8];
#pragma unroll
    for (int dt = 0; dt < 8; ++dt) S[dt] = (f32x4){0.f, 0.f, 0.f, 0.f};
    u32x4 pf[9];
    auto prefetch = [&](int n) {
        const int pitem = item * DN_NCH + n;
#pragma unroll
        for (int u = 0; u < 6; ++u) { const int q = tid + 512 * u, which = q >> 10, rem = q & 1023, s = rem >> 4, ch = rem & 15;
            pf[u] = *(const u32x4*)(DN + (size_t)dn_row(n, s, b, dir) * 1536 + (which == 0 ? 512 : which == 1 ? 0 : 1024) + h * 128 + ch * 8); }
#pragma unroll
        for (int u = 0; u < 2; ++u) pf[6 + u] = *(const u32x4*)(p.ws + WS_TQ + (size_t)pitem * 16384 + (size_t)u * 8192 + (size_t)tid * 16);
        if (tid < 64) pf[8] = *(const u32x4*)((const float*)(p.ws + WS_VEC) + (size_t)pitem * 256 + tid * 4);
    };
    prefetch(0);
    for (int n = 0; n < DN_NCH; ++n) {
        __syncthreads();
#pragma unroll
        for (int u = 0; u < 6; ++u) { const int q = tid + 512 * u, which = q >> 10, rem = q & 1023, s = rem >> 4, ch = rem & 15;
            *(u32x4*)((which == 0 ? Ks : which == 1 ? Qs : Vs) + s * KP + ch * 8) = pf[u]; }
#pragma unroll
        for (int u = 0; u < 2; ++u) *(u32x4*)((u == 0 ? Ts : QKs) + (tid >> 3) * TP + (tid & 7) * 8) = pf[6 + u];
        if (tid < 64) *(u32x4*)(vec + tid * 4) = pf[8];
        __syncthreads();
        if (n + 1 < DN_NCH) prefetch(n + 1);
        const float* egv = vec; const float* eklv = vec + 64; const float* bev = vec + 128; const float glast = vec[192];
#define SB __builtin_amdgcn_sched_barrier(0)
        bf16x8 Sb[4];
#pragma unroll
        for (int ks = 0; ks < 4; ++ks) Sb[ks] = pack8(S[2 * ks], S[2 * ks + 1]);
        f32x4 r_[4], o_[4];
        bf16x8 akA[4], aqA[4], akB[4], aqB[4];
#define DN_LDKQ(mt_, ak_, aq_) do { const bf16_t* kr = Ks + (16 * (mt_) + i16) * KP + 4 * g; const bf16_t* qr = Qs + (16 * (mt_) + i16) * KP + 4 * g; \
            _Pragma("unroll") for (int ks = 0; ks < 4; ++ks) { ak_[ks] = cat8(*(const s16x4*)(kr + 32 * ks), *(const s16x4*)(kr + 32 * ks + 16)); aq_[ks] = cat8(*(const s16x4*)(qr + 32 * ks), *(const s16x4*)(qr + 32 * ks + 16)); } } while (0)
#define DN_MMKQ(mt_, ak_, aq_) do { r_[mt_] = (f32x4){0.f, 0.f, 0.f, 0.f}; o_[mt_] = (f32x4){0.f, 0.f, 0.f, 0.f}; \
            _Pragma("unroll") for (int ks = 0; ks < 4; ++ks) { r_[mt_] = __builtin_amdgcn_mfma_f32_16x16x32_bf16(ak_[ks], Sb[ks], r_[mt_], 0, 0, 0); o_[mt_] = __builtin_amdgcn_mfma_f32_16x16x32_bf16(aq_[ks], Sb[ks], o_[mt_], 0, 0, 0); } } while (0)
        DN_LDKQ(0, akA, aqA); SB;
        DN_LDKQ(1, akB, aqB); DN_MMKQ(0, akA, aqA); SB;
        DN_LDKQ(2, akA, aqA); DN_MMKQ(1, akB, aqB); SB;
        DN_LDKQ(3, akB, aqB); DN_MMKQ(2, akA, aqA); SB;
        f32x4 eg[4], be[4]; float vv[4][4];
#pragma unroll
        for (int mt = 0; mt < 4; ++mt) { eg[mt] = *(const f32x4*)(egv + 16 * mt + 4 * g); be[mt] = *(const f32x4*)(bev + 16 * mt + 4 * g);
#pragma unroll
            for (int rg = 0; rg < 4; ++rg) vv[mt][rg] = bf2f(Vs[(16 * mt + 4 * g + rg) * KP + 16 * w + i16]); }
        DN_MMKQ(3, akB, aqB); SB;
#undef DN_LDKQ
#undef DN_MMKQ
        bf16x8 tf[4][2], qf[4][2];
#pragma unroll
        for (int mt = 0; mt < 4; ++mt) { const bf16_t* tr = Ts + (16 * mt + i16) * TP + 4 * g;
#pragma unroll
            for (int k2 = 0; k2 < 2; ++k2) tf[mt][k2] = cat8(*(const s16x4*)(tr + 32 * k2), *(const s16x4*)(tr + 32 * k2 + 16)); }
        f32x4 e0v[2], e1v[2];
#pragma unroll
        for (int k2 = 0; k2 < 2; ++k2) { e0v[k2] = *(const f32x4*)(eklv + 32 * k2 + 4 * g); e1v[k2] = *(const f32x4*)(eklv + 32 * k2 + 16 + 4 * g); }
#pragma unroll
        for (int mt = 0; mt < 4; ++mt)
#pragma unroll
            for (int rg = 0; rg < 4; ++rg) { r_[mt][rg] = be[mt][rg] * (vv[mt][rg] - eg[mt][rg] * r_[mt][rg]); o_[mt][rg] *= eg[mt][rg]; }
        bf16x8 Rb[2];
#pragma unroll
        for (int k2 = 0; k2 < 2; ++k2) Rb[k2] = pack8(r_[2 * k2], r_[2 * k2 + 1]);
        SB;
#pragma unroll
        for (int mt = 0; mt < 4; ++mt) { const bf16_t* qkr = QKs + (16 * mt + i16) * TP + 4 * g;
#pragma unroll
            for (int k2 = 0; k2 < 2; ++k2) qf[mt][k2] = cat8(*(const s16x4*)(qkr + 32 * k2), *(const s16x4*)(qkr + 32 * k2 + 16)); }
        f32x4 vn[4];
#pragma unroll
        for (int mt = 0; mt < 4; ++mt) { vn[mt] = (f32x4){0.f, 0.f, 0.f, 0.f};
#pragma unroll
            for (int k2 = 0; k2 < 2; ++k2) vn[mt] = __builtin_amdgcn_mfma_f32_16x16x32_bf16(tf[mt][k2], Rb[k2], vn[mt], 0, 0, 0); }
        SB;
        bf16x8 Vb[2], Wb[2];
#pragma unroll
        for (int k2 = 0; k2 < 2; ++k2) { Vb[k2] = pack8(vn[2 * k2], vn[2 * k2 + 1]); Wb[k2] = pack8(vn[2 * k2] * e0v[k2], vn[2 * k2 + 1] * e1v[k2]); }
        bf16x8 ktA[4][2], ktB[4][2];
#pragma unroll
        for (int dt = 0; dt < 4; ++dt)
#pragma unroll
            for (int k2 = 0; k2 < 2; ++k2) { const bf16_t* a0 = Ks + (32 * k2 + 4 * g + (i16 >> 2)) * KP + 16 * dt + 4 * (i16 & 3); ktA[dt][k2] = cat8(lds_tr(a0), lds_tr(a0 + 16 * KP)); }
#pragma unroll
        for (int mt = 0; mt < 4; ++mt)
#pragma unroll
            for (int k2 = 0; k2 < 2; ++k2) o_[mt] = __builtin_amdgcn_mfma_f32_16x16x32_bf16(qf[mt][k2], Vb[k2], o_[mt], 0, 0, 0);
        SB;
#pragma unroll
        for (int dt = 0; dt < 4; ++dt)
#pragma unroll
            for (int k2 = 0; k2 < 2; ++k2) { const bf16_t* a0 = Ks + (32 * k2 + 4 * g + (i16 >> 2)) * KP + 16 * (dt + 4) + 4 * (i16 & 3); ktB[dt][k2] = cat8(lds_tr(a0), lds_tr(a0 + 16 * KP)); }
#pragma unroll
        for (int dt = 0; dt < 4; ++dt) { S[dt] = S[dt] * glast;
#pragma unroll
            for (int k2 = 0; k2 < 2; ++k2) S[dt] = __builtin_amdgcn_mfma_f32_16x16x32_bf16(ktA[dt][k2], Wb[k2], S[dt], 0, 0, 0); }
        SB;
#pragma unroll
        for (int dt = 0; dt < 4; ++dt) { S[dt + 4] = S[dt + 4] * glast;
#pragma unroll
            for (int k2 = 0; k2 < 2; ++k2) S[dt + 4] = __builtin_amdgcn_mfma_f32_16x16x32_bf16(ktB[dt][k2], Wb[k2], S[dt + 4], 0, 0, 0); }
#undef SB
#pragma unroll
        for (int mt = 0; mt < 4; ++mt)
#pragma unroll
            for (int rg = 0; rg < 4; ++rg) OA[(size_t)dn_row(n, 16 * mt + 4 * g + rg, b, dir) * 512 + h * 128 + 16 * w + i16] = (bf16_t)f2bf(o_[mt][rg]);
    }
}

__device__ __forceinline__ void phase_prep(const P& p, int l, unsigned char* lds, int gw, int NGW, int lane) {
    unsigned char* ws = p.ws;
    bf16_t* PC = (bf16_t*)(ws + WS_PC); unsigned* ctl = (unsigned*)(ws + WS_CTL);
    float* rtab = (float*)(lds + PREP_NW * PREP_WLDS);
    { const int tid = otid();
#pragma unroll
      for (int u = 0; u < 2; ++u) { const int e = tid + 512 * u, pos = e >> 4, fi = e & 15; const float ang = (float)pos * exp2f(-(float)fi * 0.8304820237218406f);
          float sn, cs; sincosf(ang, &sn, &cs); rtab[2 * e] = cs; rtab[2 * e + 1] = sn; }
      __syncthreads(); }
    const int wv = gw % NWAVES, blk = gw / NWAVES, G_ = NGW / NWAVES;
    if (wv < PREP_NW) { for (int rep = 0; rep < REP_DNPREP; ++rep) for (int it = blk * PREP_NW + wv; it < DN_ITEMS; it += G_ * PREP_NW) dn_prep_item(p, l, it, lds + wv * PREP_WLDS, lane); return; }
    const int gt = (blk * (NWAVES - PREP_NW) + (wv - PREP_NW)) * 64 + lane, NGT = G_ * (NWAVES - PREP_NW) * 64;
    float kmx = 0.f; int kbb = -1;
    const int q_ = gt & 31, seg = q_ >> 4, hh = (q_ >> 2) & 3, mm = (q_ >> 1) & 1, half = q_ & 1;
    const int rows_per = (T + NGT / 32 - 1) / (NGT / 32);
    for (int k_ = 0; k_ < rows_per; ++k_) {
        const int r = (gt >> 5) * rows_per + k_; if (r >= T) break; const bool lat = r < TL; const int b = lat ? r / SEQ : (r - TL) / CTXL;
        bf16_t* base = PC + (size_t)r * 1536 + seg * 512 + hh * 128 + mm * 64 + half * 32;
        const u32x4 a0 = *(const u32x4*)base, a1 = *(const u32x4*)(base + 8), b0 = *(const u32x4*)(base + 16), b1 = *(const u32x4*)(base + 24);
        const unsigned xa[8] = {a0.x, a0.y, a0.z, a0.w, a1.x, a1.y, a1.z, a1.w}, xb[8] = {b0.x, b0.y, b0.z, b0.w, b1.x, b1.y, b1.z, b1.w};
        const int t = r % SEQ, pos = half ? (t & 63) : (t >> 6); const float* tb = rtab + pos * 32;
        const float sc = seg == 0 ? 0.18033688011112042f : 1.0f;
        unsigned o1[8], o2[8]; float ss = 0.f;
#pragma unroll
        for (int w2 = 0; w2 < 8; ++w2) { float x1[2] = {bflo(xa[w2]), bfhi(xa[w2])}, x2[2] = {bflo(xb[w2]), bfhi(xb[w2])}, y1[2], y2[2];
            const f32x4 cssn = *(const f32x4*)(tb + 4 * w2);
#pragma unroll
            for (int e = 0; e < 2; ++e) { const float cs = lat ? cssn[2 * e] : 1.0f, sn = lat ? cssn[2 * e + 1] : 0.0f;
                y1[e] = (x1[e] * cs - x2[e] * sn) * sc; y2[e] = (x2[e] * cs + x1[e] * sn) * sc; }
            o1[w2] = pk2(y1[0], y1[1]); o2[w2] = pk2(y2[0], y2[1]);
            ss += bflo(o1[w2]) * bflo(o1[w2]) + bfhi(o1[w2]) * bfhi(o1[w2]) + bflo(o2[w2]) * bflo(o2[w2]) + bfhi(o2[w2]) * bfhi(o2[w2]); }
        if (lat || seg == 0) { *(u32x4*)base = (u32x4){o1[0], o1[1], o1[2], o1[3]}; *(u32x4*)(base + 8) = (u32x4){o1[4], o1[5], o1[6], o1[7]};
                               *(u32x4*)(base + 16) = (u32x4){o2[0], o2[1], o2[2], o2[3]}; *(u32x4*)(base + 24) = (u32x4){o2[4], o2[5], o2[6], o2[7]}; }
        ss += shx(ss, 1);
        if (seg == 1) { if (b != kbb) { if (kbb >= 0 && half == 0) atomicMax(ctl + CW_KMAX + l * 64 + (kbb * 4 + hh) * 2 + mm, __builtin_bit_cast(unsigned, sqrtf(kmx))); kbb = b; kmx = 0.f; }
            kmx = fmaxf(kmx, ss); }
    }
    if (seg == 1 && kbb >= 0 && half == 0) atomicMax(ctl + CW_KMAX + l * 64 + (kbb * 4 + hh) * 2 + mm, __builtin_bit_cast(unsigned, sqrtf(kmx)));
    if (blk == 0 && wv == PREP_NW) { float a = 0.f, bq = 0.f; const float* lc = p.lam_c + (size_t)l * 256;
        a = wave_sum(lc[lane] * lc[64 + lane]); bq = wave_sum(lc[128 + lane] * lc[192 + lane]);
        const float lam_init = l == 0 ? 0.2f : 0.35550906758f;
        if (lane == 0) ((float*)(ws + WS_MISC))[MI_LAMF + l] = expf(a) - expf(bq) + lam_init; }
}

__device__ __forceinline__ void dn_chain(const P& p, int item, unsigned char* lds) {
    const int b = item >> 3, h = (item >> 1) & 3, dir = item & 1, tid = otid(), c = tid >> 2, ks = tid & 3;
    const bf16_t* DN = (const bf16_t*)(p.ws + WS_DNQKV); const float* GB = (const float*)(p.ws + WS_GB);
    bf16_t* OA = (bf16_t*)(p.ws + WS_H) + (size_t)dir * T * 512;
    constexpr int TB = 32;
    float* qs = (float*)lds; float* ksm = qs + TB * 128; float* vs = ksm + TB * 128; float* gs = vs + TB * 128; float* bs = gs + TB; float* ob = bs + TB;
    float S[32];
#pragma unroll
    for (int i = 0; i < 32; ++i) S[i] = 0.f;
    for (int part = 0; part < 2; ++part) {
        const int L = part == 0 ? CTXL : SEQ; const int rbase = part == 0 ? TL + b * CTXL : b * SEQ;
        for (int t0 = 0; t0 < L; t0 += TB) {
            __syncthreads();
            for (int i = tid; i < 3 * TB * 16; i += NTHREADS) { const int which = i / (TB * 16), rem = i % (TB * 16), tt = rem >> 4, ch = rem & 15;
                const int s = t0 + tt, t = dir ? L - 1 - s : s;
                const u32x4 w = *(const u32x4*)(DN + (size_t)(rbase + t) * 1536 + which * 512 + h * 128 + ch * 8);
                float* dst = (which == 0 ? qs : which == 1 ? ksm : vs) + tt * 128 + ch * 8;
                dst[0] = bflo(w.x); dst[1] = bfhi(w.x); dst[2] = bflo(w.y); dst[3] = bfhi(w.y); dst[4] = bflo(w.z); dst[5] = bfhi(w.z); dst[6] = bflo(w.w); dst[7] = bfhi(w.w); }
            if (tid < TB) { const int s = t0 + tid, t = dir ? L - 1 - s : s; gs[tid] = expf(GB[(size_t)(rbase + t) * 16 + dir * 4 + h]); bs[tid] = GB[(size_t)(rbase + t) * 16 + 8 + dir * 4 + h]; }
            __syncthreads();
            for (int tt = 0; tt < TB; ++tt) {
                const float eg = gs[tt], be = bs[tt];
                const float* kr = ksm + tt * 128 + ks * 32; const float* qr = qs + tt * 128 + ks * 32;
                float r = 0.f;
#pragma unroll
                for (int i = 0; i < 32; ++i) r += kr[i] * S[i];
                r += shx(r, 1); r += shx(r, 2);
                const float vn = be * (vs[tt * 128 + c] - eg * r);
                float o = 0.f;
#pragma unroll
                for (int i = 0; i < 32; ++i) { S[i] = eg * S[i] + kr[i] * vn; o += qr[i] * S[i]; }
                o += shx(o, 1); o += shx(o, 2);
                if (ks == 0) ob[tt * 128 + c] = o;
            }
            __syncthreads();
            for (int i = tid; i < TB * 64; i += NTHREADS) { const int tt = i >> 6, cp = i & 63; const int s = t0 + tt, t = dir ? L - 1 - s : s;
                *(unsigned*)(OA + (size_t)(rbase + t) * 512 + h * 128 + 2 * cp) = pk2(ob[tt * 128 + 2 * cp], ob[tt * 128 + 2 * cp + 1]); }
        }
    }
}
__device__ __forceinline__ void gla_chain_mfma(const P& p, int l, int item, unsigned char* lds) {
    const int b = item >> 3, h = (item >> 1) & 3, dir = item & 1, tid = otid(), lane = tid & 63, w = tid >> 6, i16 = lane & 15, g = lane >> 4;
    constexpr int RP = 72, VP = 136, GP = 40;
    constexpr int RAWE = 2 * 64 * RP + 64 * VP + 64 * GP;
    bf16_t* Qt = (bf16_t*)lds;
    bf16_t* Kt = Qt + 64 * RP;
    bf16_t* KgT = Kt + 64 * RP;
    bf16_t* raw0 = KgT + 64 * RP;
    float* tot = (float*)(raw0 + 2 * RAWE);
    float* gls = tot + 128;
    const bf16_t* PB = (const bf16_t*)(p.ws + WS_PB); const float* SMALL = (const float*)(p.ws + WS_SMALL);
    bf16_t* OB = (bf16_t*)(p.ws + WS_PAQ) + (size_t)dir * T * 512;
    const int nt_ = w & 3, hf = w >> 2, ch = 16 * nt_ + i16;
    bf16x8 wgB;
    { float wv[8];
#pragma unroll
      for (int j = 0; j < 8; ++j) wv[j] = g < 2 ? p.w_gate2[((size_t)l * 2 + dir) * 16 * 256 + (8 * g + j) * 256 + h * 64 + ch] : 0.f;
      union { bf16x8 v; unsigned u[4]; } t_; t_.u[0] = pk2(wv[0], wv[1]); t_.u[1] = pk2(wv[2], wv[3]); t_.u[2] = pk2(wv[4], wv[5]); t_.u[3] = pk2(wv[6], wv[7]); wgB = t_.v; }
    const float bgc = p.b_gate[((size_t)l * 2 + dir) * 256 + h * 64 + ch];
    f32x4 S[4];
#pragma unroll
    for (int dt = 0; dt < 4; ++dt) S[dt] = (f32x4){0.f, 0.f, 0.f, 0.f};
    __syncthreads();
    for (int i = tid; i < 64 * GP / 2; i += NTHREADS) { ((unsigned*)(raw0 + 2 * 64 * RP + 64 * VP))[i] = 0u; ((unsigned*)(raw0 + RAWE + 2 * 64 * RP + 64 * VP))[i] = 0u; }
    u32x4 pf[5];
    auto prefetch = [&](int n) {
        { const int s = tid >> 3, c8 = tid & 7; const size_t row = (size_t)dn_row(n, s, b, dir);
          pf[0] = *(const u32x4*)(PB + row * 1536 + h * 64 + c8 * 8); pf[1] = *(const u32x4*)(PB + row * 1536 + 256 + h * 64 + c8 * 8); }
#pragma unroll
        for (int u = 0; u < 2; ++u) { const int q = tid + 512 * u, s = q >> 4, c8 = q & 15; pf[2 + u] = *(const u32x4*)(PB + (size_t)dn_row(n, s, b, dir) * 1536 + 512 + h * 128 + c8 * 8); }
        if (tid < 256) { const int s = tid >> 2, c4 = tid & 3; pf[4] = *(const u32x4*)(SMALL + (size_t)dn_row(n, s, b, dir) * 64 + 16 + dir * 16 + c4 * 4); }
    };
    auto stage = [&](int bsel) { bf16_t* qraw = raw0 + bsel * RAWE; bf16_t* kraw = qraw + 64 * RP; bf16_t* Vs = kraw + 64 * RP; bf16_t* Gl = Vs + 64 * VP;
        { const int s = tid >> 3, c8 = tid & 7; *(u32x4*)(qraw + s * RP + c8 * 8) = pf[0]; *(u32x4*)(kraw + s * RP + c8 * 8) = pf[1]; }
#pragma unroll
        for (int u = 0; u < 2; ++u) { const int q = tid + 512 * u, s = q >> 4, c8 = q & 15; *(u32x4*)(Vs + s * VP + c8 * 8) = pf[2 + u]; }
        if (tid < 256) { const int s = tid >> 2, c4 = tid & 3; const f32x4 gv = __builtin_bit_cast(f32x4, pf[4]); u32x2 o2; o2.x = pk2(gv[0], gv[1]); o2.y = pk2(gv[2], gv[3]); *(u32x2*)(Gl + s * GP + 4 * c4) = o2; }
    };
    prefetch(0);
    __syncthreads();
    stage(0); prefetch(1);
    for (int n = 0; n < DN_NCH; ++n) {
        const bf16_t* qraw = raw0 + (n & 1) * RAWE; const bf16_t* kraw = qraw + 64 * RP; const bf16_t* Vs = kraw + 64 * RP; const bf16_t* Gl = Vs + 64 * VP;
        __syncthreads();
        f32x4 pr[2]; float E_[2], TT0;
        {
#pragma unroll
            for (int t = 0; t < 2; ++t) { const int mt = 2 * hf + t;
                f32x4 z = __builtin_amdgcn_mfma_f32_16x16x32_bf16(*(const bf16x8*)(Gl + (16 * mt + i16) * GP + 8 * g), wgB, (f32x4){bgc, bgc, bgc, bgc}, 0, 0, 0);
                float run = 0.f;
#pragma unroll
                for (int r = 0; r < 4; ++r) { run += logsigmoid_fast(z[r]) * 0.0625f; pr[t][r] = run; } }
            float TT[2];
#pragma unroll
            for (int t = 0; t < 2; ++t) { const float T_ = pr[t][3]; const float y1 = shup(T_, 16); const float s1 = T_ + (g >= 1 ? y1 : 0.f); const float y2 = shup(s1, 32); const float s2 = s1 + (g >= 2 ? y2 : 0.f);
                E_[t] = s2 - T_; TT[t] = shlane(s2, i16 + 48); }
            TT0 = TT[0];
            if (g == 0) tot[hf * 64 + ch] = TT[0] + TT[1];
        }
        __syncthreads();
        {
            const float t0 = tot[ch], t1 = tot[64 + ch], total = t0 + t1, base = hf ? t0 : 0.f;
            float qv_[2][4], kv_[2][4];
#pragma unroll
            for (int t = 0; t < 2; ++t)
#pragma unroll
                for (int r = 0; r < 4; ++r) { const int tk = 16 * (2 * hf + t) + 4 * g + r; qv_[t][r] = bf2f(qraw[tk * RP + ch]); kv_[t][r] = bf2f(kraw[tk * RP + ch]); }
            __builtin_amdgcn_sched_barrier(0);
            const float etot = __expf(total);
#pragma unroll
            for (int t = 0; t < 2; ++t) { const int mt = 2 * hf + t; const float off = base + (t ? TT0 : 0.f) + E_[t]; float kgv[4];
#pragma unroll
                for (int r = 0; r < 4; ++r) { const int tk = 16 * mt + 4 * g + r; const float gc = off + pr[t][r]; const float eg = __expf(gc), ieg = __builtin_amdgcn_rcpf(eg);
                    Qt[tk * RP + ch] = (bf16_t)f2bf(0.125f * qv_[t][r] * eg); const float kie = kv_[t][r] * ieg; Kt[tk * RP + ch] = (bf16_t)f2bf(kie); kgv[r] = kie * etot; }
                u32x2 kw; kw.x = pk2(kgv[0], kgv[1]); kw.y = pk2(kgv[2], kgv[3]); *(u32x2*)(KgT + ch * RP + 16 * mt + 4 * g) = kw; }
            if (hf == 0 && g == 0) gls[ch] = etot;
        }
        __syncthreads();
        if (n + 1 < DN_NCH) { stage((n + 1) & 1); if (n + 2 < DN_NCH) prefetch(n + 2); }
        { bf16x8 Sb[2], Vb[2];
#pragma unroll
          for (int ks = 0; ks < 2; ++ks) { Sb[ks] = pack8(S[2 * ks], S[2 * ks + 1]);
              const bf16_t* v0 = Vs + (32 * ks + 4 * g + (i16 >> 2)) * VP + 16 * w + 4 * (i16 & 3); Vb[ks] = cat8(lds_tr(v0), lds_tr(v0 + 16 * VP)); }
          bf16x8 aq[4][2], aa[4][2], ak[4][2];
          { bf16x8 kf[4][2], qn_[4][2];
#pragma unroll
            for (int t4 = 0; t4 < 4; ++t4)
#pragma unroll
                for (int k2 = 0; k2 < 2; ++k2) { kf[t4][k2] = *(const bf16x8*)(Kt + (16 * t4 + i16) * RP + 32 * k2 + 8 * g); qn_[t4][k2] = *(const bf16x8*)(Qt + (16 * t4 + i16) * RP + 32 * k2 + 8 * g); }
#pragma unroll
            for (int mt = 0; mt < 4; ++mt)
#pragma unroll
                for (int ks = 0; ks < 2; ++ks) { f32x4 th[2];
#pragma unroll
                    for (int hh = 0; hh < 2; ++hh) { const int jb = 2 * ks + hh; th[hh] = (f32x4){0.f, 0.f, 0.f, 0.f};
                        if (jb <= mt) {
#pragma unroll
                            for (int k2 = 0; k2 < 2; ++k2) th[hh] = __builtin_amdgcn_mfma_f32_16x16x32_bf16(kf[jb][k2], qn_[mt][k2], th[hh], 0, 0, 0);
                            if (jb == mt) {
#pragma unroll
                                for (int rg = 0; rg < 4; ++rg) th[hh][rg] = (i16 >= 4 * g + rg) ? th[hh][rg] : 0.f; } } }
                    aa[mt][ks] = pack8(th[0], th[1]); } }
#pragma unroll
          for (int mt = 0; mt < 4; ++mt)
#pragma unroll
              for (int ks = 0; ks < 2; ++ks) { const int o_ = (16 * mt + i16) * RP + 32 * ks + 4 * g;
                  aq[mt][ks] = cat8(*(const s16x4*)(Qt + o_), *(const s16x4*)(Qt + o_ + 16)); ak[mt][ks] = cat8(*(const s16x4*)(KgT + o_), *(const s16x4*)(KgT + o_ + 16)); }
#pragma unroll
          for (int mt = 0; mt < 4; ++mt) { f32x4 o = (f32x4){0.f, 0.f, 0.f, 0.f};
#pragma unroll
              for (int ks = 0; ks < 2; ++ks) { o = __builtin_amdgcn_mfma_f32_16x16x32_bf16(aq[mt][ks], Sb[ks], o, 0, 0, 0); o = __builtin_amdgcn_mfma_f32_16x16x32_bf16(aa[mt][ks], Vb[ks], o, 0, 0, 0); }
#pragma unroll
              for (int rg = 0; rg < 4; ++rg) OB[(size_t)dn_row(n, 16 * mt + 4 * g + rg, b, dir) * 512 + h * 128 + 16 * w + i16] = (bf16_t)f2bf(o[rg]); }
#pragma unroll
          for (int dt = 0; dt < 4; ++dt) { const f32x4 gl = *(const f32x4*)(gls + 16 * dt + 4 * g); S[dt] = S[dt] * gl;
#pragma unroll
              for (int ks = 0; ks < 2; ++ks) S[dt] = __builtin_amdgcn_mfma_f32_16x16x32_bf16(ak[dt][ks], Vb[ks], S[dt], 0, 0, 0); } }
    }
}
__device__ __forceinline__ void attn_tile(const P& p, int l, int b, int h, int qrow0  , bool ctxq, unsigned char* lds, bool do_store = true) {
    constexpr int QP = 72, KP = 72, VP = 160;
    bf16_t* Qs = (bf16_t*)lds;
    constexpr int KVB = 2 * 64 * KP + 64 * VP;
    bf16_t* KV0 = Qs + 2 * 128 * QP;
    float* Oex = (float*)lds;
    bf16_t* PC = (bf16_t*)(p.ws + WS_PC);
    const int tid = otid(), lane = tid & 63, w = tid >> 6, m = w & 1, rg = w >> 1, q31 = lane & 31, hi = lane >> 5, i16 = lane & 15, gg = lane >> 4;
    const int nkt = ctxq ? CTXL / 64 : (CTXL + SEQ) / 64;
    u32x4 pk_[2], pv_[2];
    auto prefetch = [&](int kt) { const int krow0 = kt < CTXL / 64 ? TL + b * CTXL + kt * 64 : b * SEQ + (kt - CTXL / 64) * 64;
#pragma unroll
        for (int u = 0; u < 2; ++u) { const int i = tid + 512 * u, r = i >> 4, ch = i & 15; const bf16_t* rowp = PC + (size_t)(krow0 + r) * 1536 + h * 128 + ch * 8;
            pk_[u] = *(const u32x4*)(rowp + 512); pv_[u] = *(const u32x4*)(rowp + 1024); } };
    prefetch(0);
    __syncthreads();
    for (int i = tid; i < 128 * 16; i += NTHREADS) { const int r = i >> 4, ch = i & 15, mm = ch >> 3, c8 = (ch & 7) * 8;
        *(u32x4*)(Qs + (mm * 128 + r) * QP + c8) = *(const u32x4*)(PC + (size_t)(qrow0 + r) * 1536 + h * 128 + ch * 8); }
    __syncthreads();
    const bf16_t* qrow = Qs + (m * 128 + rg * 32 + q31) * QP;
    bf16x8 bq[4]; float qn = 0.f;
#pragma unroll
    for (int kk = 0; kk < 4; ++kk) bq[kk] = *(const bf16x8*)(qrow + 16 * kk + 8 * hi);
#pragma unroll
    for (int d8 = 0; d8 < 8; ++d8) { const u32x4 q4 = *(const u32x4*)(qrow + 8 * d8);
        qn += bflo(q4.x) * bflo(q4.x) + bfhi(q4.x) * bfhi(q4.x) + bflo(q4.y) * bflo(q4.y) + bfhi(q4.y) * bfhi(q4.y) + bflo(q4.z) * bflo(q4.z) + bfhi(q4.z) * bfhi(q4.z) + bflo(q4.w) * bflo(q4.w) + bfhi(q4.w) * bfhi(q4.w); }
    const float kmax = __builtin_bit_cast(float, ((const unsigned*)(p.ws + WS_CTL))[CW_KMAX + l * 64 + (b * 4 + h) * 2 + m]);
    const float mrow = sqrtf(qn) * kmax * 1.002f + 1e-3f;
    f32x16 o[4]; float lsum4[4] = {0.f, 0.f, 0.f, 0.f};
#pragma unroll
    for (int dt = 0; dt < 4; ++dt)
#pragma unroll
        for (int r = 0; r < 16; ++r) o[dt][r] = 0.f;
    auto stage = [&](int buf) { bf16_t* Ks = KV0 + buf * KVB; bf16_t* Vs = Ks + 2 * 64 * KP;
#pragma unroll
        for (int u = 0; u < 2; ++u) { const int i = tid + 512 * u, r = i >> 4, ch = i & 15, mm = ch >> 3, c8 = (ch & 7) * 8;
            *(u32x4*)(Ks + (mm * 64 + r) * KP + c8) = pk_[u]; *(u32x4*)(Vs + r * VP + ch * 8) = pv_[u]; } };
    stage(0);
    if (nkt > 1) prefetch(1);
    __syncthreads();
    for (int kt = 0; kt < nkt; ++kt) {
        const bf16_t* Ks = KV0 + (kt & 1) * KVB; const bf16_t* Vs = Ks + 2 * 64 * KP;
        bf16x8 ka[2][4];
#pragma unroll
        for (int kh = 0; kh < 2; ++kh)
#pragma unroll
            for (int kk = 0; kk < 4; ++kk) ka[kh][kk] = *(const bf16x8*)(Ks + (m * 64 + kh * 32 + q31) * KP + 16 * kk + 8 * hi);
        s16x4 vlo[4][4], vhi[4][4];
#pragma unroll
        for (int st = 0; st < 1; ++st) { const bf16_t* v0 = Vs + (16 * st + 4 * hi + (i16 >> 2)) * VP + 16 * (gg & 1) + 4 * (i16 & 3);
#pragma unroll
            for (int dt = 0; dt < 4; ++dt) { vlo[st][dt] = lds_tr(v0 + 32 * dt); vhi[st][dt] = lds_tr(v0 + 32 * dt + 8 * VP); } }
        __builtin_amdgcn_sched_barrier(0);
        f32x16 s[2];
#pragma unroll
        for (int kh = 0; kh < 2; ++kh) {
#pragma unroll
            for (int r = 0; r < 16; ++r) s[kh][r] = 0.f;
#pragma unroll
            for (int kk = 0; kk < 4; ++kk) s[kh] = __builtin_amdgcn_mfma_f32_32x32x16_bf16(ka[kh][kk], bq[kk], s[kh], 0, 0, 0);
        }
#pragma unroll
        for (int st = 1; st < 4; ++st) { const bf16_t* v0 = Vs + (16 * st + 4 * hi + (i16 >> 2)) * VP + 16 * (gg & 1) + 4 * (i16 & 3);
#pragma unroll
            for (int dt = 0; dt < 4; ++dt) { vlo[st][dt] = lds_tr(v0 + 32 * dt); vhi[st][dt] = lds_tr(v0 + 32 * dt + 8 * VP); } }
        __builtin_amdgcn_sched_barrier(0);
#pragma unroll
        for (int kh = 0; kh < 2; ++kh)
#pragma unroll
            for (int r = 0; r < 16; ++r) { const float ev = __builtin_amdgcn_exp2f(s[kh][r] - mrow); s[kh][r] = ev; lsum4[r & 3] += ev; }
        if (kt + 1 < nkt) { stage((kt + 1) & 1); if (kt + 2 < nkt) prefetch(kt + 2); }
#pragma unroll
        for (int st = 0; st < 4; ++st) {
            const int kh = st >> 1, r0 = 8 * (st & 1);
            union { bf16x8 v; unsigned u[4]; } bp;
            bp.u[0] = pk2(s[kh][r0 + 0], s[kh][r0 + 1]); bp.u[1] = pk2(s[kh][r0 + 2], s[kh][r0 + 3]); bp.u[2] = pk2(s[kh][r0 + 4], s[kh][r0 + 5]); bp.u[3] = pk2(s[kh][r0 + 6], s[kh][r0 + 7]);
    #pragma unroll
            for (int dt = 0; dt < 4; ++dt) o[dt] = __builtin_amdgcn_mfma_f32_32x32x16_bf16(cat8(vlo[st][dt], vhi[st][dt]), bp.v, o[dt], 0, 0, 0);
            }
        __syncthreads();
    }
    float lsum = (lsum4[0] + lsum4[1]) + (lsum4[2] + lsum4[3]);
    const int tid_e = otid(), w_e = tid_e >> 6, m_e = w_e & 1, rg_e = w_e >> 1, q31_e = tid_e & 31, hi_e = (tid_e & 63) >> 5;
    lsum += shx(lsum, 32);
    const float lamf = ((const float*)(p.ws + WS_MISC))[MI_LAMF + l];
    const float sc = (m_e == 0 ? 1.0f : lamf) / lsum;
    __syncthreads();
    float* ox = Oex + (rg_e * 32 + q31_e) * 132;
    if (m_e == 1) {
#pragma unroll
        for (int dt = 0; dt < 4; ++dt)
#pragma unroll
            for (int r = 0; r < 16; ++r) ox[dt * 32 + (r & 3) + 8 * (r >> 2) + 4 * hi_e] = o[dt][r] * sc;
    }
    __syncthreads();
    if (m_e == 0) {
        float ss = 0.f;
#pragma unroll
        for (int dt = 0; dt < 4; ++dt)
#pragma unroll
            for (int r = 0; r < 16; ++r) { const float v = o[dt][r] * sc - ox[dt * 32 + (r & 3) + 8 * (r >> 2) + 4 * hi_e]; o[dt][r] = v; ss += v * v; }
        ss += shx(ss, 32);
        int lo_ = l; asm volatile("" : "+s"(lo_));
        const float lam_init = lo_ == 0 ? 0.2f : 0.35550906758f;
        const float rs = (1.0f - lam_init) / sqrtf(ss * (1.0f / 128.0f) + EPS);
        const float* gn = p.gn_c + l * 128;
        bf16_t* orow = (bf16_t*)(p.ws + WS_YD) + (size_t)(qrow0 + rg_e * 32 + q31_e) * 512 + h * 128;
#pragma unroll
        for (int dt = 0; dt < 4; ++dt)
#pragma unroll
            for (int g4 = 0; g4 < 4; ++g4) { const int dv = dt * 32 + 8 * g4 + 4 * hi_e; const f32x4 gv = *(const f32x4*)(gn + dv);
                u32x2 wv; wv.x = pk2(o[dt][4 * g4 + 0] * rs * gv[0], o[dt][4 * g4 + 1] * rs * gv[1]); wv.y = pk2(o[dt][4 * g4 + 2] * rs * gv[2], o[dt][4 * g4 + 3] * rs * gv[3]);
                if (do_store) *(u32x2*)(orow + dv) = wv; }
    }
}
__device__ __forceinline__ void phase_mix(const P& p, int l, unsigned char* lds) {
    unsigned* qhead = (unsigned*)(p.ws + WS_CTL) + CW_QUEUE + 64 * l;
    volatile int* slot = (volatile int*)(lds + LDS_BYTES - 64);
    const int n_att_l = BATCH * 4 * (SEQ / 128), n_att_c = (l == 0) ? BATCH * 4 * (CTXL / 128) : 0;
    const int total = 128 + n_att_l + n_att_c;
    for (;;) {
        __syncthreads();
        if (otid() == 0) *slot = (int)atomicAdd(qhead, 1u);
        __syncthreads();
        const int it = *slot;
        if (it >= total) break;
        if (it < 64) { for (int rep = 0; rep < REP_DN; ++rep) dn_chain_mfma(p, it, lds); }
        else if (it < 128) { for (int rep = 0; rep < REP_GLA; ++rep) gla_chain_mfma(p, l, it - 64, lds); }
        else if (it < 128 + n_att_l) { const int a = it - 128, b = a / (4 * (SEQ / 128)), rem = a % (4 * (SEQ / 128)), h = rem / (SEQ / 128), qt = rem % (SEQ / 128);
            for (int rep = 1; rep < REP_ATT; ++rep) attn_tile(p, l, b, h, b * SEQ + qt * 128, false, lds, false);
            attn_tile(p, l, b, h, b * SEQ + qt * 128, false, lds); }
        else { const int a = it - 128 - n_att_l, b = a / (4 * (CTXL / 128)), rem = a % (4 * (CTXL / 128)), h = rem / (CTXL / 128), qt = rem % (CTXL / 128);
            attn_tile(p, l, b, h, TL + b * CTXL + qt * 128, true, lds); }
    }
}

__device__ __forceinline__ void phase_post(const P& p, int l, int nrows, int gw, int NGW, int lane) {
    bf16_t* OA = (bf16_t*)(p.ws + WS_H); bf16_t* OBb = (bf16_t*)(p.ws + WS_PAQ);
    const bf16_t* PZ = (const bf16_t*)(p.ws + WS_PZ); const bf16_t* PB = (const bf16_t*)(p.ws + WS_PB);
    const int c8 = 8 * lane, cg = c8 & 127;
    const f32x4 ga0 = *(const f32x4*)(p.gn_a + l * 128 + cg), ga1 = *(const f32x4*)(p.gn_a + l * 128 + cg + 4), gb0 = *(const f32x4*)(p.gn_b + l * 128 + cg), gb1 = *(const f32x4*)(p.gn_b + l * 128 + cg + 4);
    for (int r0_ = gw; r0_ < nrows; r0_ += 2 * NGW)
#pragma unroll
    for (int rr_ = 0; rr_ < 2; ++rr_) { const int r = r0_ + rr_ * NGW; if (r >= nrows) break;
        const u32x4 af = *(const u32x4*)(OA + (size_t)r * 512 + c8), ab = *(const u32x4*)(OA + ((size_t)T + r) * 512 + c8), az = *(const u32x4*)(PZ + (size_t)r * 512 + c8);
        const u32x4 bf_ = *(const u32x4*)(OBb + (size_t)r * 512 + c8), bb = *(const u32x4*)(OBb + ((size_t)T + r) * 512 + c8), bz = *(const u32x4*)(PB + (size_t)r * 1536 + 1024 + c8);
        const unsigned afw[4] = {af.x, af.y, af.z, af.w}, abw[4] = {ab.x, ab.y, ab.z, ab.w}, azw[4] = {az.x, az.y, az.z, az.w}, bfw[4] = {bf_.x, bf_.y, bf_.z, bf_.w}, bbw[4] = {bb.x, bb.y, bb.z, bb.w}, bzw[4] = {bz.x, bz.y, bz.z, bz.w};
        float oa[8], ob[8], sa = 0.f, sb = 0.f;
#pragma unroll
        for (int q = 0; q < 4; ++q) { oa[2 * q] = bflo(afw[q]) + bflo(abw[q]); oa[2 * q + 1] = bfhi(afw[q]) + bfhi(abw[q]); ob[2 * q] = bflo(bfw[q]) + bflo(bbw[q]); ob[2 * q + 1] = bfhi(bfw[q]) + bfhi(bbw[q]);
            sa += oa[2 * q] * oa[2 * q] + oa[2 * q + 1] * oa[2 * q + 1]; sb += ob[2 * q] * ob[2 * q] + ob[2 * q + 1] * ob[2 * q + 1]; }
#pragma unroll
        for (int o = 1; o < 16; o <<= 1) { sa += shx(sa, o); sb += shx(sb, o); }
        const float ra = 1.0f / sqrtf(sa * (1.0f / 128.0f) + EPS), rb = 1.0f / sqrtf(sb * (1.0f / 128.0f) + EPS);
        unsigned wa[4], wb[4];
#pragma unroll
        for (int q = 0; q < 4; ++q) { const float g0 = q < 2 ? ga0[2 * q] : ga1[2 * q - 4], g1 = q < 2 ? ga0[2 * q + 1] : ga1[2 * q - 3], h0 = q < 2 ? gb0[2 * q] : gb1[2 * q - 4], h1 = q < 2 ? gb0[2 * q + 1] : gb1[2 * q - 3];
            wa[q] = pk2(oa[2 * q] * ra * g0 * siluf_(bflo(azw[q])), oa[2 * q + 1] * ra * g1 * siluf_(bfhi(azw[q])));
            wb[q] = pk2(ob[2 * q] * rb * h0 * siluf_(bflo(bzw[q])), ob[2 * q + 1] * rb * h1 * siluf_(bfhi(bzw[q]))); }
        *(u32x4*)(OA + (size_t)r * 512 + c8) = (u32x4){wa[0], wa[1], wa[2], wa[3]};
        *(u32x4*)(OBb + (size_t)r * 512 + c8) = (u32x4){wb[0], wb[1], wb[2], wb[3]};
    }
}

__device__ __forceinline__ void phase_moe_gather(const P& p, unsigned char* lds) {
    const int tid = otid();
    const int* route = (const int*)(p.ws + WS_ROUTE); int* slots = (int*)(p.ws + WS_SLOT); int* misc = (int*)(p.ws + WS_MISC);
    const unsigned* ecnt = (const unsigned*)(p.ws + WS_CTL) + CW_ECNT; unsigned* efill = (unsigned*)(p.ws + WS_CTL) + CW_EFILL;
    const bf16_t* H = (const bf16_t*)(p.ws + WS_H); bf16_t* MA = (bf16_t*)(p.ws + WS_MA);
    int* eoff = (int*)lds; unsigned* lcnt = (unsigned*)(eoff + 16); unsigned* lbase = lcnt + 8; int* myslot = (int*)(lbase + 8);
    if (tid == 0) { int off = 0, nt = 0;
#pragma unroll 1
        for (int e = 0; e < NE; ++e) { eoff[e] = off; const int tl = ((int)ecnt[e] + 255) / 256;
            if (blockIdx.x == 0) { for (int q = 0; q < tl; ++q) misc[MI_TILEE + nt + q] = e; }
            nt += tl; off += tl * 256; }
        eoff[NE] = off; if (blockIdx.x == 0) misc[MI_NTILES] = nt; }
    for (int grp = blockIdx.x; grp < TL / 64; grp += gridDim.x) {
        __syncthreads();
        if (tid < NE) lcnt[tid] = 0u;
        __syncthreads();
        int e = 0, rank = 0;
        if (tid < 128) { e = route[(grp * 64 + (tid >> 1)) * 4 + (tid & 1)]; rank = (int)atomicAdd(lcnt + e, 1u); }
        __syncthreads();
        if (tid < NE) lbase[tid] = lcnt[tid] ? atomicAdd(efill + tid, lcnt[tid]) : 0u;
        __syncthreads();
        if (tid < 128) { const int s = eoff[e] + (int)lbase[e] + rank; myslot[tid] = s; slots[(grp * 64 + (tid >> 1)) * 2 + (tid & 1)] = s; }
        __syncthreads();
        for (int i0 = tid; i0 < 128 * 128; i0 += 8 * NTHREADS) { u32x4 v[8];
#pragma unroll
            for (int u = 0; u < 8; ++u) { const int i = i0 + u * NTHREADS, a = i >> 7, ch = i & 127; v[u] = ((const u32x4*)(H + (size_t)(grp * 64 + (a >> 1)) * D))[ch]; }
#pragma unroll
            for (int u = 0; u < 8; ++u) { const int i = i0 + u * NTHREADS, a = i >> 7, ch = i & 127; ((u32x4*)(MA + (size_t)myslot[a] * D))[ch] = v[u]; } }
    }
}
__device__ __forceinline__ void phase_final(const P& p, int gw, int NGW, int lane) {
    const int* route = (const int*)(p.ws + WS_ROUTE); const int* slots = (const int*)(p.ws + WS_SLOT); const bf16_t* Y = (const bf16_t*)(p.ws + WS_MA);
    const float* MOD = (const float*)(p.ws + WS_MOD) + (size_t)1 * 9 * 6144;
    for (int r0_ = gw; r0_ < TL; r0_ += 2 * NGW)
#pragma unroll
    for (int rr_ = 0; rr_ < 2; ++rr_) { const int r = r0_ + rr_ * NGW; if (r >= TL) break; const int b = r / SEQ; const float w1 = ((const float*)route)[r * 4 + 2], w2 = ((const float*)route)[r * 4 + 3];
        const bf16_t* y1 = Y + (size_t)slots[r * 2] * D, *y2 = Y + (size_t)slots[r * 2 + 1] * D; float* xr = p.out + (size_t)r * D; const float* g2 = MOD + (size_t)b * 6144 + 5 * 1024;
        f32x4 v[4]; float ss = 0.f;
#pragma unroll
        for (int j = 0; j < 4; ++j) { const int c = 4 * lane + 256 * j; const u32x2 a = *(const u32x2*)(y1 + c), bq = *(const u32x2*)(y2 + c); const f32x4 g = *(const f32x4*)(g2 + c);
            f32x4 y; y[0] = w1 * bflo(a.x) + w2 * bflo(bq.x); y[1] = w1 * bfhi(a.x) + w2 * bfhi(bq.x); y[2] = w1 * bflo(a.y) + w2 * bflo(bq.y); y[3] = w1 * bfhi(a.y) + w2 * bfhi(bq.y);
            v[j] = *(const f32x4*)(xr + c) + g * y; ss += (v[j][0] * v[j][0] + v[j][1] * v[j][1]) + (v[j][2] * v[j][2] + v[j][3] * v[j][3]); }
        const float rs = 1.0f / sqrtf(wave_sum(ss) * (1.0f / D) + EPS);
#pragma unroll
        for (int j = 0; j < 4; ++j) { const int c = 4 * lane + 256 * j; *(f32x4*)(xr + c) = v[j] * rs * *(const f32x4*)(p.final_g + c); }
    }
}

typedef __attribute__((address_space(4))) const P* KArgs;
#define LOADP(p) asm volatile("" : "+s"(kp)); P p; __builtin_memcpy(&p, kp, sizeof(P))
__global__ void __launch_bounds__(NTHREADS, 2) mk_fwd(P p_unused) {
    extern __shared__ __attribute__((aligned(16))) unsigned char lds[];
    cg::grid_group grid = cg::this_grid();
    KArgs kp = (KArgs)__builtin_amdgcn_kernarg_segment_ptr();
    const int G = gridDim.x, NGW = G * NWAVES;
#define IDS() const int tid = otid(), lane = tid & 63, wave = __builtin_amdgcn_readfirstlane(tid >> 6), gw = blockIdx.x * NWAVES + wave; (void)tid; (void)lane; (void)gw; (void)wave
    PG8_LAS unsigned char* glds = (PG8_LAS unsigned char*)lds;
    volatile unsigned* bst = (volatile unsigned*)(lds + LDS_BYTES - 128);
    if (otid() == 0) { bst[0] = 0u; bst[1] = 0u; }
    __syncthreads();
    { LOADP(p); (void)xcd_barrier_post((unsigned*)(p.ws + WS_CTL) + CW_BAR, bst); }
#define GSYNC() do { LOADP(pb_); XcdBarrier bb_; bb_.bar = (unsigned*)(pb_.ws + WS_CTL) + CW_BAR; bb_.x = xb_xcc_id(); bb_.st = (volatile unsigned*)(lds + LDS_BYTES - 128); xcd_barrier(bb_); } while (0)

    { PH_BEGIN(31);
    {
        LOADP(p); IDS(); unsigned char* ws = p.ws;
        float* scr = (float*)(lds + wave * CONV_WLDS);
        for (int rep = 0; rep < REP_P0; ++rep)
        for (int l = 0; l < DEPTH; ++l) {
            convert_T(D, 8240, (bf16_t*)(ws + WB_WIN + l * WIN_BYTES), NIN, SmWin{p.w_in + (size_t)l * D * 8240}, scr, (gw + 37 * l) % NGW, NGW, lane);
            convert_T(512, D, (bf16_t*)(ws + WB_WO + (l * 3 + 0) * WO_BYTES), D, SmPlain{p.w_o_a + (size_t)l * 512 * D}, scr, (gw + 300 + 700 * l) % NGW, NGW, lane);
            convert_T(512, D, (bf16_t*)(ws + WB_WO + (l * 3 + 1) * WO_BYTES), D, SmPlain{p.w_o_b + (size_t)l * 512 * D}, scr, (gw + 556 + 700 * l) % NGW, NGW, lane);
            convert_T(512, D, (bf16_t*)(ws + WB_WO + (l * 3 + 2) * WO_BYTES), D, SmPlain{p.w_o_c + (size_t)l * 512 * D}, scr, (gw + 812 + 700 * l) % NGW, NGW, lane);
            convert_T(D, D, (bf16_t*)(ws + WB_WOUT + l * WOUT_BYTES), D, SmPlain{p.w_out + (size_t)l * D * D}, scr, (gw + 1068 + 512 * l) % NGW, NGW, lane);
        }
        convert_T(D, DFF, (bf16_t*)(ws + WB_WUP), NUP, SmUp{p.ffn_w1, (long)(p.ffn_w3 - p.ffn_w1)}, scr, (gw + 1500) % NGW, NGW, lane);
        convert_T(DFF, D, (bf16_t*)(ws + WB_WDN), D, SmPlain{p.ffn_w2}, scr, (gw + 900) % NGW, NGW, lane);
        __syncthreads();
        phase_mod(p, lds);
    }
    PH_END(31); }
    grid.sync();

    for (int l = 0; l < DEPTH; ++l) {
        const bool last = (l == DEPTH - 1);
        const int Mrows = last ? TL : T;
{ PH_BEGIN((l * 16 + 0));
        for (int rep = 0; rep < REP_ELT; ++rep)
        { LOADP(p); IDS(); unsigned char* ws = p.ws;
          phase_modulate(l == 0 ? p.x : p.out, l == 0 ? p.ctx : (const float*)(ws + WS_XC), T, p.norm1_g + l * D, (const float*)(ws + WS_MOD) + (size_t)l * 9 * 6144, 0, (bf16_t*)(ws + WS_H), nullptr, nullptr, nullptr, nullptr, gw, NGW, lane); }
        PH_END((l * 16 + 0)); }
        GSYNC();
{ PH_BEGIN((l * 16 + 1));
        for (int rep = 0; rep < REP_WIN; ++rep)
        { LOADP(p); unsigned char* ws = p.ws;
            pg8::Gemm g{(const bf16_t*)(ws + WS_H), (const bf16_t*)(ws + WB_WIN + l * WIN_BYTES), T, NIN, D, D};
            EpiWin E{(bf16_t*)(ws + WS_PAQ), (bf16_t*)(ws + WS_PZ), (bf16_t*)(ws + WS_PB), (bf16_t*)(ws + WS_PC), (bf16_t*)(ws + WS_PG), (float*)(ws + WS_SMALL)};
            WinLastOrder S; S.so.init(last ? TL : T, NIN, G, (int)blockIdx.x); S.G = G; S.c = (int)blockIdx.x; S.nextra = last ? (TC / 256) * 12 : 0;
            pg8::gemm_phase<EpiWin, WinLastOrder, true, true>(glds, g, S, E);
        }
        PH_END((l * 16 + 1)); }
        GSYNC();
{ PH_BEGIN((l * 16 + 2));
        for (int rep = 1; rep < REP_SYNC; ++rep) GSYNC();
        { LOADP(p); IDS(); phase_prep(p, l, lds, gw, NGW, lane); }
        PH_END((l * 16 + 2)); }
        GSYNC();
{ PH_BEGIN((l * 16 + 3));
        { LOADP(p); phase_mix(p, l, lds); }
        PH_END((l * 16 + 3)); }
        GSYNC();
{ PH_BEGIN((l * 16 + 4));
        { LOADP(p); IDS(); phase_post(p, l, Mrows, gw, NGW, lane); }
        PH_END((l * 16 + 4)); }
        GSYNC();
{ PH_BEGIN((l * 16 + 5));
        for (int rep = 0; rep < REP_MERGE; ++rep)
        { LOADP(p); unsigned char* ws = p.ws;
            pg8::Gemm g{(const bf16_t*)(ws + WS_H), (const bf16_t*)(ws + WB_WO + (l * 3 + 0) * WO_BYTES), Mrows, D, 512, 512,
                        (const bf16_t*)(ws + WS_PAQ), (const bf16_t*)(ws + WS_YD), (const bf16_t*)(ws + WB_WO + (l * 3 + 1) * WO_BYTES), (const bf16_t*)(ws + WB_WO + (l * 3 + 2) * WO_BYTES)};
            MergeOrder S; S.so.init(Mrows, D, G, (int)blockIdx.x);
            EpiGate E{(bf16_t*)(ws + WS_DNQKV), (const bf16_t*)(ws + WS_PG)};
            pg8::gemm_phase<EpiGate, MergeOrder, true, true>(glds, g, S, E);
        }
        PH_END((l * 16 + 5)); }
        GSYNC();
{ PH_BEGIN((l * 16 + 6));
        for (int rep = 0; rep < (l == 0 ? REP_WOUT0 : 1); ++rep)
        { LOADP(p); unsigned char* ws = p.ws;
            pg8::Gemm g{(const bf16_t*)(ws + WS_DNQKV), (const bf16_t*)(ws + WB_WOUT + l * WOUT_BYTES), Mrows, D, D, D}; pg8::StaticOrder S; S.init(Mrows, D, G, (int)blockIdx.x);
            EpiResid E{l == 0 ? p.x : p.out, l == 0 ? p.ctx : (const float*)(ws + WS_XC), p.out, (float*)(ws + WS_XC), (const float*)(ws + WS_MOD) + (size_t)l * 9 * 6144, 2};
            pg8::gemm_phase<EpiResid, pg8::StaticOrder, true, true>(glds, g, S, E);
        }
        PH_END((l * 16 + 6)); }
        GSYNC();
{ PH_BEGIN((l * 16 + 7));
        { LOADP(p); IDS(); unsigned char* ws = p.ws;
          phase_modulate(p.out, (const float*)(ws + WS_XC), Mrows, p.norm2_g + l * D, (const float*)(ws + WS_MOD) + (size_t)l * 9 * 6144, 3, (bf16_t*)(ws + WS_H), last ? p.router_w : nullptr, (int*)(ws + WS_ROUTE), (unsigned*)(ws + WS_CTL) + CW_ECNT, (unsigned*)lds, gw, NGW, lane); }
        PH_END((l * 16 + 7)); }
        if (!last) {
            GSYNC();
{ PH_BEGIN(8);
            for (int rep = 0; rep < REP_UP; ++rep)
            { LOADP(p); unsigned char* ws = p.ws;
                pg8::Gemm g{(const bf16_t*)(ws + WS_H), (const bf16_t*)(ws + WB_WUP), T, NUP, D, D}; pg8::StaticOrder S; S.init(T, NUP, G, (int)blockIdx.x);
                EpiSwiglu E{(bf16_t*)(ws + WS_H1), NUP / 256};
                pg8::gemm_phase<EpiSwiglu, pg8::StaticOrder, true, true>(glds, g, S, E);
            }
        PH_END(8); }
            GSYNC();
{ PH_BEGIN(9);
            { LOADP(p); unsigned char* ws = p.ws;
                pg8::Gemm g{(const bf16_t*)(ws + WS_H1), (const bf16_t*)(ws + WB_WDN), T, D, DFF, DFF}; pg8::StaticOrder S; S.init(T, D, G, (int)blockIdx.x);
                EpiResid E{p.out, (const float*)(ws + WS_XC), p.out, (float*)(ws + WS_XC), (const float*)(ws + WS_MOD) + (size_t)l * 9 * 6144, 5};
                pg8::gemm_phase<EpiResid, pg8::StaticOrder, true, true>(glds, g, S, E);
            }
        PH_END(9); }
            GSYNC();
        } else {
{ PH_BEGIN(24);
            { LOADP(p); IDS(); unsigned char* ws = p.ws;
                float* scr = (float*)(lds + wave * CONV_WLDS);
                for (int e = 0; e < NE; ++e) {
                    convert_T(D, DFF, (bf16_t*)(ws + WS_MWUP) + (size_t)e * NUP * D, NUP, SmUp{p.moe_w1 + (size_t)e * D * DFF, (long)(p.moe_w3 - p.moe_w1)}, scr, (gw + 211 * e) % NGW, NGW, lane);
                    convert_T(DFF, D, (bf16_t*)(ws + WS_MWDN) + (size_t)e * D * DFF, D, SmPlain{p.moe_w2 + (size_t)e * DFF * D}, scr, (gw + 173 * e + 1000) % NGW, NGW, lane); }
            }
        PH_END(24); }
            GSYNC();
{ PH_BEGIN(25);
            { LOADP(p); phase_moe_gather(p, lds); }
        PH_END(25); }
            GSYNC();
{ PH_BEGIN(26);
            for (int rep = 0; rep < REP_UP; ++rep)
            { LOADP(p); unsigned char* ws = p.ws; const int* misc = (const int*)(ws + WS_MISC);
                pg8::Gemm g{(const bf16_t*)(ws + WS_MA), (const bf16_t*)(ws + WS_MWUP), MOE_ROWS, NE * NUP, D, D};
                MoeOrder S{misc[MI_NTILES], NUP / 256, G, (int)blockIdx.x, misc + MI_TILEE};
                EpiSwiglu E{(bf16_t*)(ws + WS_MH1), NUP / 256};
                pg8::gemm_phase<EpiSwiglu, MoeOrder, true, true>(glds, g, S, E);
            }
        PH_END(26); }
            GSYNC();
{ PH_BEGIN(27);
            { LOADP(p); unsigned char* ws = p.ws; const int* misc = (const int*)(ws + WS_MISC);
                pg8::Gemm g{(const bf16_t*)(ws + WS_MH1), (const bf16_t*)(ws + WS_MWDN), MOE_ROWS, NE * D, DFF, DFF};
                MoeOrder S{misc[MI_NTILES], D / 256, G, (int)blockIdx.x, misc + MI_TILEE};
                EpiMoeDown E{(bf16_t*)(ws + WS_MA)};
                pg8::gemm_phase<EpiMoeDown, MoeOrder, true, true>(glds, g, S, E);
            }
        PH_END(27); }
            GSYNC();
{ PH_BEGIN(28);
            { LOADP(p); IDS(); phase_final(p, gw, NGW, lane); }
        PH_END(28); }
        }
    }
}

extern "C" void kernel_launch(void* const* d_in, const int* in_sizes, int n_in, void* d_out, int out_size, void* d_ws, size_t ws_size, hipStream_t stream) {
    static int grid_blocks = 0;
    if (grid_blocks == 0) {
        if (n_in != 30 || in_sizes[0] != TL * D || out_size != TL * D || ws_size < WS_END) {
            fprintf(stderr, "kernel_launch: built for 30 inputs, x/out of %d floats, >= %zu bytes of d_ws; got n_in %d, in0 %d, out %d, ws %zu; nothing launched\n", TL * D, (size_t)WS_END, n_in, n_in > 0 ? in_sizes[0] : -1, out_size, ws_size);
            grid_blocks = -1; return; }
        int dev = 0, cus = 0, per_cu = 0;
        hipGetDevice(&dev);
        hipDeviceGetAttribute(&cus, hipDeviceAttributeMultiprocessorCount, dev);
        hipFuncSetAttribute((const void*)mk_fwd, hipFuncAttributeMaxDynamicSharedMemorySize, LDS_BYTES);
        hipOccupancyMaxActiveBlocksPerMultiprocessor(&per_cu, (const void*)mk_fwd, NTHREADS, LDS_BYTES);
        if (per_cu < 1) { fprintf(stderr, "kernel_launch: occupancy query reports %d blocks/CU; nothing launched\n", per_cu); grid_blocks = -1; return; }
        grid_blocks = cus;
    }
    if (grid_blocks < 0) return;
    hipMemsetAsync((char*)d_ws + WS_CTL, 0, CTL_BYTES, stream);
    P p{};
    const float** f = (const float**)&p;
    for (int i = 0; i < 30; ++i) f[i] = (const float*)d_in[i];
    p.out = (float*)d_out; p.ws = (unsigned char*)d_ws;
    void* args[] = {&p};
    hipError_t e = hipLaunchCooperativeKernel((const void*)mk_fwd, dim3(grid_blocks), dim3(NTHREADS), args, LDS_BYTES, stream);
    if (e != hipSuccess) fprintf(stderr, "kernel_launch: cooperative launch failed: %s (grid %d)\n", hipGetErrorString(e), grid_blocks);
}
```

```cpp
#include <hip/hip_runtime.h>
#include <hip/hip_cooperative_groups.h>
#include <cstdio>
#include <cstdint>
namespace cg = cooperative_groups;
#ifndef REP_P0
#define REP_P0 1
#endif
#ifndef REP_WIN
#define REP_WIN 1
#endif
#ifndef REP_CHAIN
#define REP_CHAIN 1
#endif
#ifndef REP_UP
#define REP_UP 1
#endif
#ifndef REP_SYNC
#define REP_SYNC 1
#endif
#ifndef REP_ATT
#define REP_ATT 1
#endif
#ifndef REP_DNPREP
#define REP_DNPREP 1
#endif
#ifndef REP_ELT
#define REP_ELT 1
#endif
#ifndef REP_DN
#define REP_DN REP_CHAIN
#endif
#ifndef REP_GLA
#define REP_GLA REP_CHAIN
#endif
#ifndef REP_MERGE
#define REP_MERGE 1
#endif
#ifndef REP_WOUT0
#define REP_WOUT0 1
#endif
#ifndef PROBE_MASK
#define PROBE_MASK 0u
#endif
#define PH_BEGIN(k) const unsigned long long pt0_ = ((PROBE_MASK >> (k)) & 1u) ? __builtin_amdgcn_s_memrealtime() : 0ull
#define PH_END(k) do { if ((PROBE_MASK >> (k)) & 1u) { const unsigned long long pt1_ = __builtin_amdgcn_s_memrealtime(); while (__builtin_amdgcn_s_memrealtime() - pt1_ < pt1_ - pt0_) __builtin_amdgcn_s_sleep(4); } } while (0)

namespace pg8 {
#define PG8_LAS __attribute__((address_space(3)))
typedef unsigned short bf16_t;
typedef short bf16x8 __attribute__((ext_vector_type(8)));
typedef float f32x4 __attribute__((ext_vector_type(4)));
typedef unsigned u32x4 __attribute__((ext_vector_type(4)));
constexpr int BM = 256, BK = 64, HALF = 128, HTB = HALF * BK * 2  , STAGE_BYTES = 8 * HTB, NXCD = 8, WGM = 8;

__host__ __device__ __forceinline__ int lds_byte(int r, int c) { const int st = (r >> 4) * 2 + (c >> 5), rr = r & 15, cc = c & 31, ob = rr * 64 + cc * 2; return st * 1024 + (ob ^ (((ob >> 9) & 1) << 5)); }
__host__ __device__ __forceinline__ void stage_rc(int b, int& R, int& C) { const int st = b / 1024, sb = b % 1024, swz = sb ^ (((sb >> 9) & 1) << 5); R = (st >> 1) * 16 + swz / 64; C = (st & 1) * 32 + (swz % 64) / 2; }
__host__ __device__ __forceinline__ int perm32(int rho) { const int n = rho >> 4, i = rho & 15; return 8 * (i >> 2) + 4 * n + (i & 3); }

struct Unit { int pm, pn, br; };
struct Gemm { const bf16_t* A; const bf16_t* Bt; int M, N, K, lda; const bf16_t* A1; const bf16_t* A2; const bf16_t* B1; const bf16_t* B2; };

struct StaticOrder {
    int nM, nN, nwg, G, c;
    __host__ __device__ void init(int M, int N, int G_, int c_) { nM = M / BM; nN = N / BM; nwg = nM * nN; G = G_; c = c_; }
    __host__ __device__ bool next(int i, Unit& u) const {
        const long L = (long)i * G + c; if (L >= nwg) return false;
        int wgid = (int)L; { const int q = nwg / NXCD, r = nwg % NXCD, xcd = wgid % NXCD, off = wgid / NXCD; wgid = (xcd < r ? xcd * (q + 1) : r * (q + 1) + (xcd - r) * q) + off; }
        const int nig = WGM * nN, gid = wgid / nig, fm = gid * WGM, gsz = (nM - fm) < WGM ? (nM - fm) : WGM;
        u.pm = fm + ((wgid % nig) % gsz); u.pn = (wgid % nig) / gsz; u.br = 0; return true;
    }
    __device__ __forceinline__ void a_ready(const Unit&) const {}
    __device__ __forceinline__ void done(const Unit&) const {}
};


template <class Epi, class Sched, bool ALIGN_EPI = false, bool SP2 = false>
__device__ __forceinline__ void gemm_phase(PG8_LAS unsigned char* lds, const Gemm g, const Sched& S, const Epi& E) {
    int tid_o = threadIdx.x; asm volatile("" : "+v"(tid_o));
    const int tid = tid_o, wid = __builtin_amdgcn_readfirstlane(tid >> 6), lane = tid & 63, wr = wid >> 2, wc = wid & 3, fr = lane & 15, fq = lane >> 4;
    const int K = g.K, nt = K / BK;
    unsigned voffA[2], voffB[2];
#pragma unroll
    for (int i = 0; i < 2; ++i) { int R, C; stage_rc(tid * 16 + i * 8192, R, C); const int Rb = Epi::PERM ? ((R & ~31) + perm32(R & 31)) : R;
        voffA[i] = (unsigned)(R * g.lda + C) * 2u; voffB[i] = (unsigned)(Rb * K + C) * 2u; }
    const size_t kstep = (size_t)(BK * 2);
    const size_t hstepA = (size_t)HALF * g.lda * 2, hstepB = (size_t)HALF * K * 2;
    const size_t tstepA = 2 * hstepA, tstepB = 2 * hstepB;
    const unsigned ldsw = (unsigned)wid * 1024u;
    const int aoff = lds_byte(wr * 64 + fr, fq * 8), boff = lds_byte(wc * 32 + fr, fq * 8);
#define PG8_SA(b, h) (((b) * 2 + (h)) * HTB)
#define PG8_SB(b, h) ((4 + (b) * 2 + (h)) * HTB)
#define PG8_STAGE(bufoff, gbase, voff) do { _Pragma("unroll") for (int _i = 0; _i < 2; ++_i) \
        __builtin_amdgcn_global_load_lds((const unsigned*)((const char*)(gbase) + (voff)[_i]), (PG8_LAS unsigned*)(lds + (bufoff) + ldsw + _i * 8192), 16, 0, 0); } while (0)
#define PG8_LDA(dst, b, h) do { _Pragma("unroll") for (int m = 0; m < 4; ++m) _Pragma("unroll") for (int k = 0; k < 2; ++k) dst[m][k] = *(const PG8_LAS bf16x8*)(lds + PG8_SA(b, h) + aoff + m * 2048 + k * 1024); } while (0)
#define PG8_LDB(dst, b, h) do { _Pragma("unroll") for (int n = 0; n < 2; ++n) _Pragma("unroll") for (int k = 0; k < 2; ++k) dst[n][k] = *(const PG8_LAS bf16x8*)(lds + PG8_SB(b, h) + boff + n * 2048 + k * 1024); } while (0)
#define PG8_MMA(ai, bj, At, Bt) do { __builtin_amdgcn_s_setprio(1); _Pragma("unroll") for (int m = 0; m < 4; ++m) _Pragma("unroll") for (int n = 0; n < 2; ++n) _Pragma("unroll") for (int k = 0; k < 2; ++k) \
        acc[ai][bj][m][n] = __builtin_amdgcn_mfma_f32_16x16x32_bf16(Bt[n][k], At[m][k], acc[ai][bj][m][n], 0, 0, 0); __builtin_amdgcn_s_setprio(0); } while (0)
#define PG8_WAIT_V(n) asm volatile("s_waitcnt vmcnt(" #n ")" ::: "memory")
#define PG8_WAIT_L(n) asm volatile("s_waitcnt lgkmcnt(" #n ")" ::: "memory")
#define PG8_BAR __builtin_amdgcn_s_barrier()
#define PG8_SCHED __builtin_amdgcn_sched_barrier(0)
    Unit cur, nxt; int ui = 0;
    if (!S.next(0, cur)) return;
    f32x4 acc[2][2][4][2];
#pragma unroll
    for (int a = 0; a < 2; ++a)
#pragma unroll
        for (int b = 0; b < 2; ++b)
#pragma unroll
            for (int m = 0; m < 4; ++m)
#pragma unroll
                for (int n = 0; n < 2; ++n) acc[a][b][m][n] = (f32x4){0.f, 0.f, 0.f, 0.f};
    bf16x8 At[4][2], B0[2][2], B1[2][2];
    const char* cA = (const char*)(cur.br == 0 ? g.A : cur.br == 1 ? g.A1 : g.A2) + (size_t)cur.pm * tstepA; const char* cB = (const char*)(cur.br == 0 ? g.Bt : cur.br == 1 ? g.B1 : g.B2) + (size_t)cur.pn * tstepB;
    S.a_ready(cur);
    if constexpr (SP2) {
        PG8_STAGE(PG8_SB(0, 0), cB, voffB); PG8_STAGE(PG8_SB(0, 1), cB + hstepB, voffB); PG8_STAGE(PG8_SA(0, 0), cA, voffA); PG8_STAGE(PG8_SA(0, 1), cA + hstepA, voffA);
        if (wr == 1) PG8_BAR;
        PG8_WAIT_V(2); PG8_BAR;
        PG8_STAGE(PG8_SB(1, 0), cB + kstep, voffB); PG8_STAGE(PG8_SA(1, 0), cA + kstep, voffA); PG8_STAGE(PG8_SB(1, 1), cB + hstepB + kstep, voffB);
        PG8_WAIT_V(6); PG8_BAR;
    } else {
        PG8_STAGE(PG8_SB(0, 0), cB, voffB); PG8_STAGE(PG8_SA(0, 0), cA, voffA); PG8_STAGE(PG8_SB(0, 1), cB + hstepB, voffB); PG8_STAGE(PG8_SA(0, 1), cA + hstepA, voffA);
        if (wr == 1) PG8_BAR;
        PG8_WAIT_V(4); PG8_BAR;
        PG8_STAGE(PG8_SB(1, 0), cB + kstep, voffB); PG8_STAGE(PG8_SA(1, 0), cA + kstep, voffA); PG8_STAGE(PG8_SB(1, 1), cB + hstepB + kstep, voffB);
        PG8_WAIT_V(6); PG8_BAR;
    }
    for (;;) {
        const bool has_next = S.next(ui + 1, nxt);
        const char* nA = has_next ? (const char*)(nxt.br == 0 ? g.A : nxt.br == 1 ? g.A1 : g.A2) + (size_t)nxt.pm * tstepA : cA; const char* nB = has_next ? (const char*)(nxt.br == 0 ? g.Bt : nxt.br == 1 ? g.B1 : g.B2) + (size_t)nxt.pn * tstepB : cB;
        for (int t = 0; t < nt; t += 2) {
            const bool last = (t == nt - 2);
            const char* a1 = cA + (size_t)(t + 1) * kstep;
            const char* a2 = last ? nA : cA + (size_t)(t + 2) * kstep; const char* b2 = last ? nB : cB + (size_t)(t + 2) * kstep;
            const char* a3 = a2 + kstep; const char* b3 = b2 + kstep;
            if (last && has_next) S.a_ready(nxt);
            if constexpr (SP2) {
            PG8_LDB(B0, 0, 0); PG8_LDB(B1, 0, 1); PG8_SCHED; PG8_LDA(At, 0, 0); PG8_STAGE(PG8_SA(1, 1), a1 + hstepA, voffA);
            PG8_WAIT_V(8); PG8_WAIT_L(0); PG8_BAR; PG8_MMA(0, 0, At, B0); PG8_MMA(0, 1, At, B1); PG8_BAR; PG8_SCHED;
            PG8_LDA(At, 0, 1); PG8_STAGE(PG8_SB(0, 0), b2, voffB); PG8_STAGE(PG8_SB(0, 1), b2 + hstepB, voffB); PG8_STAGE(PG8_SA(0, 0), a2, voffA);
            PG8_WAIT_V(8); PG8_WAIT_L(0); PG8_BAR; PG8_MMA(1, 0, At, B0); PG8_MMA(1, 1, At, B1); PG8_BAR; PG8_SCHED;
            PG8_LDB(B0, 1, 0); PG8_LDB(B1, 1, 1); PG8_SCHED; PG8_LDA(At, 1, 0); PG8_STAGE(PG8_SA(0, 1), a2 + hstepA, voffA);
            PG8_WAIT_V(8); PG8_WAIT_L(0); PG8_BAR; PG8_MMA(0, 0, At, B0); PG8_MMA(0, 1, At, B1); PG8_BAR; PG8_SCHED;
            PG8_LDA(At, 1, 1); PG8_STAGE(PG8_SB(1, 0), b3, voffB); PG8_STAGE(PG8_SB(1, 1), b3 + hstepB, voffB); PG8_STAGE(PG8_SA(1, 0), a3, voffA);
            PG8_WAIT_V(8); PG8_WAIT_L(0); PG8_BAR; PG8_MMA(1, 0, At, B0); PG8_MMA(1, 1, At, B1); PG8_BAR; PG8_SCHED;
            } else {
            PG8_LDB(B0, 0, 0); PG8_SCHED; PG8_LDA(At, 0, 0); PG8_STAGE(PG8_SA(1, 1), a1 + hstepA, voffA);
            PG8_WAIT_L(8); PG8_BAR; PG8_WAIT_L(0); PG8_MMA(0, 0, At, B0); PG8_BAR; PG8_SCHED;
            PG8_LDB(B1, 0, 1); PG8_STAGE(PG8_SB(0, 0), b2, voffB);
            PG8_BAR; PG8_WAIT_L(0); PG8_MMA(0, 1, At, B1); PG8_BAR;
            PG8_LDA(At, 0, 1); PG8_STAGE(PG8_SA(0, 0), a2, voffA);
            PG8_BAR; PG8_WAIT_L(0); PG8_MMA(1, 0, At, B0); PG8_BAR; PG8_SCHED;
            PG8_STAGE(PG8_SB(0, 1), b2 + hstepB, voffB);
            PG8_WAIT_V(6); PG8_BAR; PG8_MMA(1, 1, At, B1); PG8_BAR;
            PG8_LDB(B0, 1, 0); PG8_SCHED; PG8_LDA(At, 1, 0); PG8_STAGE(PG8_SA(0, 1), a2 + hstepA, voffA);
            PG8_WAIT_L(8); PG8_BAR; PG8_WAIT_L(0); PG8_MMA(0, 0, At, B0); PG8_BAR; PG8_SCHED;
            PG8_LDB(B1, 1, 1); PG8_STAGE(PG8_SB(1, 0), b3, voffB);
            PG8_BAR; PG8_WAIT_L(0); PG8_MMA(0, 1, At, B1); PG8_BAR;
            PG8_LDA(At, 1, 1); PG8_STAGE(PG8_SA(1, 0), a3, voffA);
            PG8_BAR; PG8_WAIT_L(0); PG8_MMA(1, 0, At, B0); PG8_BAR; PG8_SCHED;
            PG8_STAGE(PG8_SB(1, 1), b3 + hstepB, voffB);
            PG8_WAIT_V(6); PG8_BAR; PG8_MMA(1, 1, At, B1); PG8_BAR;
            }
        }
        if constexpr (ALIGN_EPI) { if (wr == 0) PG8_BAR; }
        if constexpr (!Epi::AFTER_DRAIN) { E(acc, cur, wr, wc, fr, fq); S.done(cur); }
        if (!has_next) break;
        if (!(Epi::CHAIN && nxt.br != 0)) {
#pragma unroll
        for (int a = 0; a < 2; ++a)
#pragma unroll
            for (int b = 0; b < 2; ++b)
#pragma unroll
                for (int m = 0; m < 4; ++m)
#pragma unroll
                    for (int n = 0; n < 2; ++n) acc[a][b][m][n] = (f32x4){0.f, 0.f, 0.f, 0.f};
        }
        cur = nxt; cA = nA; cB = nB; ++ui;
        if constexpr (ALIGN_EPI) { if (wr == 1) PG8_BAR; }
    }
    PG8_WAIT_V(0);
    if constexpr (!ALIGN_EPI) { if (wr == 0) PG8_BAR; }
    PG8_BAR;
    if constexpr (Epi::AFTER_DRAIN) { E.fused(acc, cur, wr, wc, fr, fq, lds, wid, lane); S.done(cur); }
#undef PG8_SA
#undef PG8_SB
#undef PG8_STAGE
#undef PG8_LDA
#undef PG8_LDB
#undef PG8_MMA
#undef PG8_WAIT_V
#undef PG8_WAIT_L
#undef PG8_BAR
#undef PG8_SCHED
}
}


constexpr int BATCH = 8, SEQ = 2048, CTXL = 256, D = 1024, DEPTH = 2;
constexpr int TL = BATCH * SEQ, TC = BATCH * CTXL, T = TL + TC;
constexpr int NIN = 8448;
constexpr int DFF = 2816, NE = 8, NUP = 2 * DFF;
constexpr int MOE_ROWS = 2 * TL + NE * 256;
constexpr float EPS = 1e-6f;
constexpr int NTHREADS = 512, NWAVES = 8;
constexpr int LDS_BYTES = 163840;

typedef unsigned short bf16_t;
typedef float f32x4 __attribute__((ext_vector_type(4)));
typedef float f32x16 __attribute__((ext_vector_type(16)));
typedef unsigned u32x4 __attribute__((ext_vector_type(4)));
typedef unsigned u32x2 __attribute__((ext_vector_type(2)));
typedef short bf16x8 __attribute__((ext_vector_type(8)));
typedef short s16x4 __attribute__((ext_vector_type(4)));

constexpr size_t al256(size_t x) { return (x + 255) & ~(size_t)255; }
constexpr size_t WS_CTL   = 0;                                   constexpr size_t CTL_BYTES = 65536;
constexpr size_t WS_MOD   = WS_CTL + CTL_BYTES;                  constexpr size_t MOD_BYTES = (size_t)DEPTH * 9 * 6 * D * 4;
constexpr size_t WS_ROUTE = al256(WS_MOD + MOD_BYTES);           constexpr size_t ROUTE_BYTES = (size_t)TL * 16;
constexpr size_t WS_SLOT  = al256(WS_ROUTE + ROUTE_BYTES);       constexpr size_t SLOT_BYTES = (size_t)TL * 8;
constexpr size_t WS_MISC  = al256(WS_SLOT + SLOT_BYTES);         constexpr size_t MISC_BYTES = 4096;
constexpr size_t WS_GB    = al256(WS_MISC + MISC_BYTES);         constexpr size_t GB_BYTES = (size_t)T * 16 * 4;
constexpr size_t WS_SMALL = al256(WS_GB + GB_BYTES);             constexpr size_t SMALL_BYTES = (size_t)T * 64 * 4;
constexpr size_t WS_XC    = al256(WS_SMALL + SMALL_BYTES);       constexpr size_t XC_BYTES = (size_t)TC * D * 4;
constexpr size_t WS_WB    = al256(WS_XC + XC_BYTES);
constexpr size_t WB_WIN   = WS_WB;                               constexpr size_t WIN_BYTES = (size_t)NIN * D * 2;
constexpr size_t WB_WO    = WB_WIN + DEPTH * WIN_BYTES;          constexpr size_t WO_BYTES = (size_t)D * 512 * 2;
constexpr size_t WB_WOUT  = WB_WO + DEPTH * 3 * WO_BYTES;        constexpr size_t WOUT_BYTES = (size_t)D * D * 2;
constexpr size_t WB_WUP   = WB_WOUT + DEPTH * WOUT_BYTES;        constexpr size_t WUP_BYTES = (size_t)NUP * D * 2;
constexpr size_t WB_WDN   = WB_WUP + WUP_BYTES;                  constexpr size_t WDN_BYTES = (size_t)D * DFF * 2;
constexpr size_t WB_END   = WB_WDN + WDN_BYTES;
constexpr size_t WS_H     = al256(WB_END);                       constexpr size_t H_BYTES = (size_t)T * D * 2;
constexpr size_t WS_PAQ   = al256(WS_H + H_BYTES);               constexpr size_t PAQ_BYTES = (size_t)T * 1536 * 2;
constexpr size_t WS_PZ    = al256(WS_PAQ + PAQ_BYTES);           constexpr size_t PZ_BYTES = (size_t)T * 512 * 2;
constexpr size_t WS_PB    = al256(WS_PZ + PZ_BYTES);             constexpr size_t PB_BYTES = (size_t)T * 1536 * 2;
constexpr size_t WS_PC    = al256(WS_PB + PB_BYTES);             constexpr size_t PC_BYTES = (size_t)T * 1536 * 2;
constexpr size_t WS_PG    = al256(WS_PC + PC_BYTES);             constexpr size_t PG_BYTES = (size_t)T * 3072 * 2;
constexpr size_t WS_DNQKV = al256(WS_PG + PG_BYTES);             constexpr size_t DNQKV_BYTES = (size_t)T * 1536 * 2;
constexpr size_t WS_TQ    = al256(WS_DNQKV + DNQKV_BYTES);       constexpr size_t TQ_BYTES = (size_t)BATCH * 4 * 2 * ((CTXL + SEQ) / 64) * 16384;
constexpr size_t WS_VEC   = al256(WS_TQ + TQ_BYTES);             constexpr size_t VEC_BYTES = (size_t)BATCH * 4 * 2 * ((CTXL + SEQ) / 64) * 1024;
constexpr size_t WS_END   = al256(WS_VEC + VEC_BYTES);
static_assert(WS_END <= (size_t)524288000, "d_ws map exceeds 500 MiB (documented minimum is 525,980,800 B)");
constexpr size_t WS_YD    = WS_PAQ + (size_t)2 * T * 512 * 2;
static_assert((size_t)3 * T * 512 * 2 <= PAQ_BYTES, "yd overlay");
constexpr size_t WS_H1    = WS_PB;
static_assert((size_t)T * DFF * 2 <= PB_BYTES + PC_BYTES, "h1 overlay");
constexpr size_t WS_MWDN  = WS_WB;                                constexpr size_t MWDN_BYTES = (size_t)NE * D * DFF * 2;
static_assert(MWDN_BYTES <= WB_END - WS_WB, "moe wdn overlay");
constexpr size_t WS_MWUP  = WS_PAQ;                               constexpr size_t MWUP_BYTES = (size_t)NE * NUP * D * 2;
constexpr size_t WS_MA    = al256(WS_MWUP + MWUP_BYTES);          constexpr size_t MA_BYTES = (size_t)MOE_ROWS * D * 2;
constexpr size_t WS_MH1   = al256(WS_MA + MA_BYTES);              constexpr size_t MH1_BYTES = (size_t)MOE_ROWS * DFF * 2;
static_assert(WS_MH1 + MH1_BYTES <= WS_END, "moe overlay");
constexpr int CW_QUEUE = 0;
constexpr int CW_KMAX = 256;
constexpr int CW_ECNT = 512;
constexpr int CW_EFILL = 576;
constexpr int CW_BAR = 4096;
constexpr int MI_LAMF = 0;
constexpr int MI_NTILES = 16;
constexpr int MI_EOFF = 32;
constexpr int MI_TILEE = 64;

typedef __bf16 bf16v2_t __attribute__((ext_vector_type(2)));
typedef float f32v2_t __attribute__((ext_vector_type(2)));
__device__ __forceinline__ unsigned pk2(float lo, float hi) { const f32v2_t v = {lo, hi}; return __builtin_bit_cast(unsigned, __builtin_convertvector(v, bf16v2_t)); }
__device__ __forceinline__ unsigned f2bf(float f) { return pk2(f, 0.f) & 0xffffu; }
__device__ __forceinline__ float bflo(unsigned w) { return __builtin_bit_cast(float, w << 16); }
__device__ __forceinline__ float bfhi(unsigned w) { return __builtin_bit_cast(float, w & 0xffff0000u); }
__device__ __forceinline__ float bf2f(bf16_t h) { return __builtin_bit_cast(float, (unsigned)h << 16); }
__device__ __forceinline__ int otid() { int t = threadIdx.x; asm volatile("" : "+v"(t)); return t; }
__device__ __forceinline__ float shx(float v, int o) { const int idx = ((otid() & 63) ^ o) << 2; return __builtin_bit_cast(float, __builtin_amdgcn_ds_bpermute(idx, __builtin_bit_cast(int, v))); }
__device__ __forceinline__ float shup(float v, int o) { const int idx = (((otid() & 63) - o) & 63) << 2; return __builtin_bit_cast(float, __builtin_amdgcn_ds_bpermute(idx, __builtin_bit_cast(int, v))); }
__device__ __forceinline__ float shlane(float v, int src) { return __builtin_bit_cast(float, __builtin_amdgcn_ds_bpermute(src << 2, __builtin_bit_cast(int, v))); }
__device__ __forceinline__ int shlane_i(int v, int src) { return __builtin_amdgcn_ds_bpermute(src << 2, v); }
__device__ __forceinline__ float wave_sum(float v) {
#pragma unroll
    for (int o = 1; o < 64; o <<= 1) v += shx(v, o);
    return v;
}
__device__ __forceinline__ float sigmoidf_(float x) { return __builtin_amdgcn_rcpf(1.0f + __expf(-x)); }
__device__ __forceinline__ float siluf_(float x) { return x * __builtin_amdgcn_rcpf(1.0f + __expf(-x)); }
__device__ __forceinline__ float softplusf_(float x) { return x > 20.f ? x : (x < -10.f ? __expf(x) : 0.6931471806f * __builtin_amdgcn_logf(1.0f + __builtin_amdgcn_exp2f(1.4426950409f * x))); }
__device__ __forceinline__ float logsigmoidf_(float x) { return fminf(x, 0.f) - log1pf(expf(-fabsf(x))); }
__device__ __forceinline__ float logsigmoid_fast(float z) { z = fmaxf(z, -80.f); return -0.6931471806f * __builtin_amdgcn_logf(1.0f + __builtin_amdgcn_exp2f(-1.4426950409f * z)); }

struct P {
    const float *x, *c, *ctx, *c_ctx, *w_mod, *b_mod, *norm1_g, *norm2_g, *w_in, *conv_a, *a_log, *dt_bias, *gn_a, *w_gate2, *b_gate, *gn_b,
                *lam_c, *gn_c, *w_o_a, *w_o_b, *w_o_c, *w_out, *ffn_w1, *ffn_w3, *ffn_w2, *router_w, *moe_w1, *moe_w3, *moe_w2, *final_g;
    float* out; unsigned char* ws;
};

constexpr long SM_ZERO = (long)1 << 62;
template <class SrcMap>
__device__ __forceinline__ void convert_T(int K, int ldw, bf16_t* WT, int Nrows, SrcMap sm, float* scr  , int gw, int NGW, int lane) {
    const int nblk = Nrows / 64, items = (K / 64) * nblk;
    for (int it = gw; it < items; it += NGW) {
        const int kb = it / nblk, nb = it % nblk, k0 = 64 * kb, n0 = 64 * nb;
        const long so_ = sm(n0 + 4 * (lane & 15)); const float* src = sm.W + (so_ != SM_ZERO ? so_ : 0L);
        f32x4 v[16];
#pragma unroll
        for (int i = 0; i < 16; ++i) { const int kk = 4 * i + (lane >> 4); const f32x4 ld = *(const f32x4*)(src + (size_t)(k0 + kk) * ldw); v[i] = so_ != SM_ZERO ? ld : (f32x4){0.f, 0.f, 0.f, 0.f}; }
#pragma unroll
        for (int i = 0; i < 16; ++i) { const int kk = 4 * i + (lane >> 4); float* d = scr + kk * 65 + 4 * (lane & 15); d[0] = v[i][0]; d[1] = v[i][1]; d[2] = v[i][2]; d[3] = v[i][3]; }
        asm volatile("s_waitcnt lgkmcnt(0)" ::: "memory");
        const int c = lane & 7;
#pragma unroll
        for (int j = 0; j < 8; ++j) { const int n = (lane >> 3) + 8 * j; const float* s = scr + (8 * c) * 65 + n;
            u32x4 o; o.x = pk2(s[0 * 65], s[1 * 65]); o.y = pk2(s[2 * 65], s[3 * 65]); o.z = pk2(s[4 * 65], s[5 * 65]); o.w = pk2(s[6 * 65], s[7 * 65]);
            *(u32x4*)(WT + (size_t)(n0 + n) * K + k0 + 8 * c) = o; }
        asm volatile("s_waitcnt lgkmcnt(0)" ::: "memory");
    }
}
struct SmPlain { const float* W; __device__ long operator()(int n) const { return n; } };
struct SmWin { const float* W; __device__ long operator()(int n) const {
    if (n < 2048) return n; if (n < 3584) return n + 16; if (n < 8192) return n + 48;
    const int j = n - 8192; if (j < 16) return 2048 + j; if (j < 48) return 3600 + (j - 16); return SM_ZERO; } };
struct SmUp { const float* W; long d31; __device__ long operator()(int n) const {
    const int tile = n >> 8, rr = n & 255; return (rr < 128 ? 0L : d31) + tile * 128 + (rr & 127); } };
constexpr int CONV_WLDS = 64 * 65 * 4;
typedef const f32x4 (&AccRef)[2][2][4][2];
struct EpiWin {
    static constexpr bool PERM = true, AFTER_DRAIN = false, CHAIN = false;
    bf16_t *paq, *pz, *pb, *pc, *pg; float* small_;
    __device__ __forceinline__ void operator()(AccRef acc, const pg8::Unit& u, int wr, int wc, int fr, int fq) const {
        const int row0 = u.pm * 256 + wr * 64 + fr, pn = u.pn;
        if (pn == 32) {
            if (wc < 2) {
#pragma unroll
                for (int ai = 0; ai < 2; ++ai)
#pragma unroll
                    for (int m = 0; m < 4; ++m) { float* p = small_ + (size_t)(row0 + ai * 128 + m * 16) * 64 + wc * 32 + 8 * fq;
                        *(f32x4*)p = acc[ai][0][m][0]; *(f32x4*)(p + 4) = acc[ai][0][m][1]; }
            }
            return;
        }
        bf16_t* base; int ldc, c0;
        if (pn < 6) { base = paq; ldc = 1536; c0 = pn * 256; } else if (pn < 8) { base = pz; ldc = 512; c0 = (pn - 6) * 256; }
        else if (pn < 14) { base = pb; ldc = 1536; c0 = (pn - 8) * 256; } else if (pn < 20) { base = pc; ldc = 1536; c0 = (pn - 14) * 256; }
        else { base = pg; ldc = 3072; c0 = (pn - 20) * 256; }
        const int col = c0 + wc * 32 + 8 * fq;
#pragma unroll
        for (int ai = 0; ai < 2; ++ai)
#pragma unroll
            for (int m = 0; m < 4; ++m) { bf16_t* rowp = base + (size_t)(row0 + ai * 128 + m * 16) * ldc + col;
#pragma unroll
                for (int bj = 0; bj < 2; ++bj) { const f32x4 v0 = acc[ai][bj][m][0], v1 = acc[ai][bj][m][1];
                    u32x4 w; w.x = pk2(v0[0], v0[1]); w.y = pk2(v0[2], v0[3]); w.z = pk2(v1[0], v1[1]); w.w = pk2(v1[2], v1[3]);
                    *(u32x4*)(rowp + bj * 128) = w; } }
    }
};
struct EpiGate {
    static constexpr bool PERM = true, AFTER_DRAIN = false, CHAIN = true;
    bf16_t* Mo; const bf16_t* pg;
    static __device__ __forceinline__ float em(float x) { return __expf(-fminf(fmaxf(x, -30.f), 30.f)); }
    __device__ __forceinline__ void operator()(f32x4 (&acc)[2][2][4][2], const pg8::Unit& u, int wr, int wc, int fr, int fq) const {
        const int row0 = u.pm * 256 + wr * 64 + fr, col = u.pn * 256 + wc * 32 + 8 * fq, br = u.br;
#pragma unroll
        for (int ai = 0; ai < 2; ++ai) {
            u32x4 gc[4][2], gn[4][2];
#pragma unroll
            for (int m = 0; m < 4; ++m)
#pragma unroll
                for (int bj = 0; bj < 2; ++bj) { const size_t row = (size_t)(row0 + ai * 128 + m * 16);
                    gc[m][bj] = *(const u32x4*)(pg + row * 3072 + br * 1024 + col + bj * 128);
                    gn[m][bj] = *(const u32x4*)(pg + row * 3072 + (br < 2 ? br + 1 : br) * 1024 + col + bj * 128); }
#pragma unroll
            for (int m = 0; m < 4; ++m) { const size_t row = (size_t)(row0 + ai * 128 + m * 16);
#pragma unroll
                for (int bj = 0; bj < 2; ++bj) {
                    const unsigned gcw[4] = {gc[m][bj].x, gc[m][bj].y, gc[m][bj].z, gc[m][bj].w}, gnw[4] = {gn[m][bj].x, gn[m][bj].y, gn[m][bj].z, gn[m][bj].w};
                    f32x4& v0 = acc[ai][bj][m][0]; f32x4& v1 = acc[ai][bj][m][1];
                    if (br < 2) {
#pragma unroll
                        for (int q = 0; q < 4; ++q) { const float r0 = (1.0f + em(bflo(gnw[q]))) * __builtin_amdgcn_rcpf(1.0f + em(bflo(gcw[q]))), r1 = (1.0f + em(bfhi(gnw[q]))) * __builtin_amdgcn_rcpf(1.0f + em(bfhi(gcw[q])));
                            if (q < 2) { v0[2 * q] *= r0; v0[2 * q + 1] *= r1; } else { v1[2 * q - 4] *= r0; v1[2 * q - 3] *= r1; } }
                    } else {
#pragma unroll
                        for (int q = 0; q < 4; ++q) { const float s0 = __builtin_amdgcn_rcpf(1.0f + em(bflo(gcw[q]))), s1 = __builtin_amdgcn_rcpf(1.0f + em(bfhi(gcw[q])));
                            if (q < 2) { v0[2 * q] *= s0; v0[2 * q + 1] *= s1; } else { v1[2 * q - 4] *= s0; v1[2 * q - 3] *= s1; } }
                        u32x4 w; w.x = pk2(v0[0], v0[1]); w.y = pk2(v0[2], v0[3]); w.z = pk2(v1[0], v1[1]); w.w = pk2(v1[2], v1[3]);
                        *(u32x4*)(Mo + row * 1024 + col + bj * 128) = w; } } }
        }
    }
};
struct MergeOrder {
    pg8::StaticOrder so;
    __device__ bool next(int i, pg8::Unit& u) const { const int t = i / 3; if (!so.next(t, u)) return false; u.br = i - 3 * t; return true; }
    __device__ __forceinline__ void a_ready(const pg8::Unit&) const {}
    __device__ __forceinline__ void done(const pg8::Unit&) const {}
};
struct WinLastOrder {
    pg8::StaticOrder so; int G, c, nextra;
    __device__ bool next(int i, pg8::Unit& u) const {
        pg8::Unit t; const bool ok = so.next(i, t);
        const int L = i * G + c - so.nwg; const bool ex = !ok && L >= 0 && L < nextra;
        const int q = L % 12, pn2 = q < 4 ? 2 + q : q < 7 ? 5 + q : q < 11 ? 9 + q : 32;
        u.pm = ok ? t.pm : TL / 256 + L / 12; u.pn = ok ? t.pn : pn2; u.br = 0; return ok || ex; }
    __device__ __forceinline__ void a_ready(const pg8::Unit&) const {}
    __device__ __forceinline__ void done(const pg8::Unit&) const {}
};
struct EpiResid {
    static constexpr bool PERM = false, AFTER_DRAIN = false, CHAIN = false;
    const float *old_l, *old_c; float *out_l, *out_c; const float* mod; int gidx;
    __device__ __forceinline__ void operator()(AccRef acc, const pg8::Unit& u, int wr, int wc, int fr, int fq) const {
        const int col0 = u.pn * 256 + wc * 32 + 4 * fq;
        const bool isctx = u.pm >= TL / 256; const int b = isctx ? 8 : u.pm / (SEQ / 256);
        const float* g = mod + (size_t)b * 6144 + gidx * 1024 + col0;
        const float* ob = isctx ? old_c - (size_t)TL * D : old_l; float* wb = isctx ? out_c - (size_t)TL * D : out_l;
        f32x4 gv[2][2];
#pragma unroll
        for (int bj = 0; bj < 2; ++bj)
#pragma unroll
            for (int n = 0; n < 2; ++n) gv[bj][n] = *(const f32x4*)(g + bj * 128 + n * 16);
#pragma unroll
        for (int ai = 0; ai < 2; ++ai) {
            f32x4 xo[4][2][2];
#pragma unroll
            for (int m = 0; m < 4; ++m) { const size_t off = (size_t)(u.pm * 256 + ai * 128 + wr * 64 + m * 16 + fr) * D + col0;
#pragma unroll
                for (int bj = 0; bj < 2; ++bj)
#pragma unroll
                    for (int n = 0; n < 2; ++n) xo[m][bj][n] = *(const f32x4*)(ob + off + bj * 128 + n * 16); }
#pragma unroll
            for (int m = 0; m < 4; ++m) { const size_t off = (size_t)(u.pm * 256 + ai * 128 + wr * 64 + m * 16 + fr) * D + col0;
#pragma unroll
                for (int bj = 0; bj < 2; ++bj)
#pragma unroll
                    for (int n = 0; n < 2; ++n) *(f32x4*)(wb + off + bj * 128 + n * 16) = xo[m][bj][n] + gv[bj][n] * acc[ai][bj][m][n]; }
        }
    }
};
struct EpiSwiglu {
    static constexpr bool PERM = true, AFTER_DRAIN = false, CHAIN = false;
    bf16_t* h1; int NJ;
    __device__ __forceinline__ void operator()(AccRef acc, const pg8::Unit& u, int wr, int wc, int fr, int fq) const {
        const int row0 = u.pm * 256 + wr * 64 + fr, col = (u.pn % NJ) * 128 + wc * 32 + 8 * fq;
#pragma unroll
        for (int ai = 0; ai < 2; ++ai)
#pragma unroll
            for (int m = 0; m < 4; ++m) { const f32x4 a0 = acc[ai][0][m][0], a1 = acc[ai][0][m][1], b0 = acc[ai][1][m][0], b1 = acc[ai][1][m][1];
                u32x4 w; w.x = pk2(siluf_(a0[0]) * b0[0], siluf_(a0[1]) * b0[1]); w.y = pk2(siluf_(a0[2]) * b0[2], siluf_(a0[3]) * b0[3]);
                w.z = pk2(siluf_(a1[0]) * b1[0], siluf_(a1[1]) * b1[1]); w.w = pk2(siluf_(a1[2]) * b1[2], siluf_(a1[3]) * b1[3]);
                *(u32x4*)(h1 + (size_t)(row0 + ai * 128 + m * 16) * DFF + col) = w; }
    }
};
struct EpiMoeDown {
    static constexpr bool PERM = true, AFTER_DRAIN = false, CHAIN = false;
    bf16_t* y;
    __device__ __forceinline__ void operator()(AccRef acc, const pg8::Unit& u, int wr, int wc, int fr, int fq) const {
        const int row0 = u.pm * 256 + wr * 64 + fr, col = (u.pn % 4) * 256 + wc * 32 + 8 * fq;
#pragma unroll
        for (int ai = 0; ai < 2; ++ai)
#pragma unroll
            for (int m = 0; m < 4; ++m) { bf16_t* rowp = y + (size_t)(row0 + ai * 128 + m * 16) * D + col;
#pragma unroll
                for (int bj = 0; bj < 2; ++bj) { const f32x4 v0 = acc[ai][bj][m][0], v1 = acc[ai][bj][m][1];
                    u32x4 w; w.x = pk2(v0[0], v0[1]); w.y = pk2(v0[2], v0[3]); w.z = pk2(v1[0], v1[1]); w.w = pk2(v1[2], v1[3]);
                    *(u32x4*)(rowp + bj * 128) = w; } }
    }
};
struct MoeOrder {
    int ntiles, NJ, G, c; const int* tile_e;
    __device__ bool next(int i, pg8::Unit& u) const { const long L = (long)i * G + c; if (L >= (long)ntiles * NJ) return false;
        const int t = (int)(L / NJ), j = (int)(L % NJ); u.pm = t; u.pn = tile_e[t] * NJ + j; u.br = 0; return true; }
    __device__ __forceinline__ void a_ready(const pg8::Unit&) const {}
    __device__ __forceinline__ void done(const pg8::Unit&) const {}
};

#define XB_TMO      128
#define XB_XCNT(j)  (256  + 64 * (j))
#define XB_XSUB(j)  (1280 + 64 * (j))
#define XB_XGEN(j)  (2304 + 64 * (j))
#define XB_TOP      3328
#define XB_TOPGEN   3392
#define XCD_BAR_WORDS 3456
#define XB_SPIN_CAP (1u << 18)

__device__ __forceinline__ unsigned xb_ld(unsigned* p)              { return __hip_atomic_load(p, __ATOMIC_RELAXED, __HIP_MEMORY_SCOPE_AGENT); }
__device__ __forceinline__ unsigned xb_add(unsigned* p, unsigned v) { return __hip_atomic_fetch_add(p, v, __ATOMIC_RELAXED, __HIP_MEMORY_SCOPE_AGENT); }
__device__ __forceinline__ unsigned xb_xcc_id() { return (unsigned)__builtin_amdgcn_s_getreg((3 << 11) | 20) & 0xFu; }
#define XB_SPIN(cond, bar) do { unsigned _sp = 0; while (cond) { __builtin_amdgcn_s_sleep(1); \
    if ((++_sp & 255u) == 0u) { if (xb_ld(&(bar)[XB_TMO])) break; if (_sp > XB_SPIN_CAP) { atomicAdd(&(bar)[XB_TMO], 1u); break; } } } } while (0)

struct XcdBarrier {
    unsigned* bar; unsigned x;
    volatile unsigned* st;
};

__device__ __forceinline__ XcdBarrier xcd_barrier_post(unsigned* bar, volatile unsigned* st) {
    XcdBarrier b; b.bar = bar; b.x = xb_xcc_id(); b.st = st;
    if (threadIdx.x == 0) (void)xb_add(&bar[XB_XCNT(b.x)], 1u);
    return b;
}
__device__ __forceinline__ void xcd_barrier_complete(unsigned* bar, unsigned x, unsigned& nloc, unsigned& nx) {
    const unsigned G = gridDim.x * gridDim.y * gridDim.z;
    unsigned sum, cnt, mine, sp = 0u;
    for (;;) {
        sum = 0u; cnt = 0u; mine = 0u;
#pragma unroll
        for (unsigned j = 0; j < 16; ++j) { const unsigned c = xb_ld(&bar[XB_XCNT(j)]); sum += c; cnt += (c > 0u) ? 1u : 0u; mine = (j == x) ? c : mine; }
        if (sum == G) break;
        __builtin_amdgcn_s_sleep(1);
        if ((++sp & 255u) == 0u) { if (xb_ld(&bar[XB_TMO])) break; if (sp > XB_SPIN_CAP) { atomicAdd(&bar[XB_TMO], 1u); break; } }
    }
    nloc = mine > 0u ? mine : 1u; nx = cnt > 0u ? cnt : 1u;
}

__device__ __forceinline__ void xcd_barrier(const XcdBarrier& b) {
    asm volatile("s_waitcnt vmcnt(0)" ::: "memory");
    __syncthreads();
    if (threadIdx.x == 0) {
        unsigned* bar = b.bar;
        __builtin_amdgcn_s_waitcnt(0);
        unsigned nloc = b.st[0], nx = b.st[1];
        if (nloc == 0u) { xcd_barrier_complete(bar, b.x, nloc, nx); b.st[0] = nloc; b.st[1] = nx; }
        const unsigned old = xb_add(&bar[XB_XSUB(b.x)], 1u);
        const unsigned gen = old / nloc;
        if (old + 1u == (gen + 1u) * nloc) {
            __builtin_amdgcn_fence(__ATOMIC_RELEASE, "agent");
            asm volatile("s_waitcnt vmcnt(0)" ::: "memory");
            const unsigned og = xb_add(&bar[XB_TOP], 1u);
            const unsigned tg = og / nx;
            if (og + 1u == (tg + 1u) * nx) xb_add(&bar[XB_TOPGEN], 1u);
            else XB_SPIN(xb_ld(&bar[XB_TOPGEN]) == tg, bar);
            __builtin_amdgcn_fence(__ATOMIC_ACQUIRE, "agent");
            xb_add(&bar[XB_XGEN(b.x)], 1u);
            asm volatile("s_waitcnt vmcnt(0)" ::: "memory");
        } else {
            XB_SPIN(xb_ld(&bar[XB_XGEN(b.x)]) == gen, bar);
            __builtin_amdgcn_fence(__ATOMIC_ACQUIRE, "agent");
            asm volatile("s_waitcnt vmcnt(0)" ::: "memory");
        }
    }
    __syncthreads();
}

__device__ __forceinline__ void phase_mod(const P& p, unsigned char* lds) {
    float* sc = (float*)lds;
    float* red = sc + 9 * 1024;
    const int tid = otid();
    for (int i = tid; i < 9 * 1024; i += NTHREADS) { const int r = i >> 10, k = i & 1023; const float v = r < 8 ? p.c[r * 1024 + k] : p.c_ctx[k]; sc[i] = siluf_(v); }
    __syncthreads();
    float* MOD = (float*)(p.ws + WS_MOD);
    const int cj = tid % 48, ks = tid / 48;
    for (int grp = blockIdx.x; grp < DEPTH * 6144 / 48; grp += gridDim.x) {
        const int l = grp / 128, j = (grp % 128) * 48 + cj;
        float a[9];
#pragma unroll
        for (int r = 0; r < 9; ++r) a[r] = 0.f;
        if (ks < 10) {
            const float* w = p.w_mod + (size_t)l * 1024 * 6144 + j;
            for (int k = ks; k < 1024; k += 10) { const float wv = w[(size_t)k * 6144];
#pragma unroll
                for (int r = 0; r < 9; ++r) a[r] += sc[r * 1024 + k] * wv; }
#pragma unroll
            for (int r = 0; r < 9; ++r) red[(ks * 9 + r) * 48 + cj] = a[r];
        }
        __syncthreads();
        if (tid < 9 * 48) { const int r = tid / 48, c2 = tid % 48; float s = 0.f;
#pragma unroll
            for (int q = 0; q < 10; ++q) s += red[(q * 9 + r) * 48 + c2];
            const int jj = (grp % 128) * 48 + c2;
            MOD[((size_t)l * 9 + r) * 6144 + jj] = s + p.b_mod[l * 6144 + jj]; }
        __syncthreads();
    }
}

__device__ __forceinline__ void phase_modulate(const float* src_l, const float* src_c, int nrows, const float* gain, const float* mod, int shift_idx,
                                               bf16_t* H, const float* router_w, int* route, unsigned* ecnt, unsigned* lcnt  , int gw, int NGW, int lane) {
    if (router_w) { if (otid() < NE) lcnt[otid()] = 0u; __syncthreads(); }
    for (int r0_ = gw; r0_ < nrows; r0_ += 4 * NGW)
#pragma unroll
    for (int rr_ = 0; rr_ < 4; ++rr_) { const int r = r0_ + rr_ * NGW; if (r >= nrows) break;
        const bool isctx = r >= TL; const int b = isctx ? 8 : r / SEQ;
        const float* xr = isctx ? src_c + (size_t)(r - TL) * D : src_l + (size_t)r * D;
        const float* sh = mod + (size_t)b * 6144 + shift_idx * 1024; const float* scl = sh + 1024;
        f32x4 v[4]; float ss = 0.f;
#pragma unroll
        for (int j = 0; j < 4; ++j) { v[j] = *(const f32x4*)(xr + 4 * lane + 256 * j); ss += (v[j][0] * v[j][0] + v[j][1] * v[j][1]) + (v[j][2] * v[j][2] + v[j][3] * v[j][3]); }
        const float rs = 1.0f / sqrtf(wave_sum(ss) * (1.0f / D) + EPS);
#pragma unroll
        for (int j = 0; j < 4; ++j) { const int c = 4 * lane + 256 * j; const f32x4 g = *(const f32x4*)(gain + c), s1 = *(const f32x4*)(scl + c), s0 = *(const f32x4*)(sh + c);
            v[j] = v[j] * rs * g * (1.0f + s1) + s0;
            u32x2 w; w.x = pk2(v[j][0], v[j][1]); w.y = pk2(v[j][2], v[j][3]);
            *(u32x2*)(H + (size_t)r * D + c) = w; }
        if (router_w) {
            float lg[NE];
#pragma unroll
            for (int e = 0; e < NE; ++e) lg[e] = 0.f;
#pragma unroll
            for (int j = 0; j < 4; ++j)
#pragma unroll
                for (int q = 0; q < 4; ++q) { const float* rw = router_w + (size_t)(4 * lane + 256 * j + q) * NE; const f32x4 r0 = *(const f32x4*)rw, r1 = *(const f32x4*)(rw + 4); const float hv = v[j][q];
                    lg[0] += hv * r0[0]; lg[1] += hv * r0[1]; lg[2] += hv * r0[2]; lg[3] += hv * r0[3]; lg[4] += hv * r1[0]; lg[5] += hv * r1[1]; lg[6] += hv * r1[2]; lg[7] += hv * r1[3]; }
#pragma unroll
            for (int e = 0; e < NE; ++e) lg[e] = wave_sum(lg[e]);
            int e1 = 0; float v1 = lg[0];
#pragma unroll
            for (int e = 1; e < NE; ++e) if (lg[e] > v1) { v1 = lg[e]; e1 = e; }
            int e2 = e1 == 0 ? 1 : 0; float v2 = lg[e2];
#pragma unroll
            for (int e = 0; e < NE; ++e) if (e != e1 && lg[e] > v2) { v2 = lg[e]; e2 = e; }
            const float w2 = 1.0f / (1.0f + expf(v1 - v2)), w1 = 1.0f - w2;
            if (lane == 0) { route[r * 4 + 0] = e1; route[r * 4 + 1] = e2; ((float*)route)[r * 4 + 2] = w1; ((float*)route)[r * 4 + 3] = w2;
                atomicAdd(lcnt + e1, 1u); atomicAdd(lcnt + e2, 1u); }
        }
    }
    if (router_w) { __syncthreads(); if (otid() < NE && lcnt[otid()]) atomicAdd(ecnt + otid(), lcnt[otid()]); }
}


typedef short v4i16_t __attribute__((ext_vector_type(4)));
__device__ __forceinline__ s16x4 lds_tr(const bf16_t* pp) { return __builtin_bit_cast(s16x4, __builtin_amdgcn_ds_read_tr16_b64_v4i16((__attribute__((address_space(3))) v4i16_t*)pp)); }
__device__ __forceinline__ bf16x8 cat8(s16x4 a, s16x4 b) { union { bf16x8 v; s16x4 h[2]; } u; u.h[0] = a; u.h[1] = b; return u.v; }
__device__ __forceinline__ bf16x8 pack8(f32x4 a, f32x4 b) { union { bf16x8 v; unsigned u[4]; } r; r.u[0] = pk2(a[0], a[1]); r.u[1] = pk2(a[2], a[3]); r.u[2] = pk2(b[0], b[1]); r.u[3] = pk2(b[2], b[3]); return r.v; }
constexpr int DN_NCH = (CTXL + SEQ) / 64;
constexpr int DN_ITEMS = BATCH * 4 * DN_NCH;
constexpr int PREP_WLDS = 10240 + 17408 + 1024 + 2304;
constexpr int PREP_NW = 5;

__device__ __forceinline__ int dn_row(int n, int s, int b, int dir) {
    const bool isctx = n < CTXL / 64; const int L = isctx ? CTXL : SEQ, c = isctx ? n : n - CTXL / 64, u = 64 * c + s, t = dir ? L - 1 - u : u;
    return (isctx ? TL + b * CTXL : b * SEQ) + t;
}
__device__ __forceinline__ void dn_prep_item(const P& p, int l, int item, unsigned char* wlds, int lane) {
    asm volatile("" : "+v"(lane));
    const int cn = item % DN_NCH, bh = item / DN_NCH, h = bh & 3, b = bh >> 2;
    const bool isctx = cn < CTXL / 64; const int L = isctx ? CTXL : SEQ, cch = isctx ? cn : cn - CTXL / 64, rbase = isctx ? TL + b * CTXL : b * SEQ, nchp = L / 64;
    const int item0 = (bh * 2 + 0) * DN_NCH + cn, item1 = (bh * 2 + 1) * DN_NCH + (isctx ? nchp - 1 - cch : CTXL / 64 + nchp - 1 - cch);
    const int i16 = lane & 15, g = lane >> 4;
    const bf16_t* PAQ = (const bf16_t*)(p.ws + WS_PAQ); bf16_t* DN = (bf16_t*)(p.ws + WS_DNQKV); const float* SMALL = (const float*)(p.ws + WS_SMALL);
    const float* cw = p.conv_a + (size_t)l * 3 * 1536;
    constexpr int KCP = 136;
    float* Ls = (float*)wlds; bf16_t* Kc = (bf16_t*)(wlds + 10240); bf16_t* Tl = (bf16_t*)(wlds + 10240 + 9216);
    float* gc0 = (float*)(wlds + 10240 + 17408); float* be0 = gc0 + 64; float* sf1 = be0 + 64; float* be1 = sf1 + 64;
    bf16_t* cwl = (bf16_t*)(wlds + 10240 + 17408 + 1024);
    for (int i = lane; i < 3 * 384 / 2; i += 64) { const int tap = i / 192, c2 = (i % 192) * 2, sg = c2 >> 7, cc = c2 & 127; const float* src_ = cw + tap * 1536 + sg * 512 + h * 128 + cc;
        *(unsigned*)(cwl + tap * 384 + c2) = pk2(src_[0], src_[1]); }
    {
        const size_t r = (size_t)(rbase + 64 * cch + lane);
        const f32x4 s0 = *(const f32x4*)(SMALL + r * 64), s1 = *(const f32x4*)(SMALL + r * 64 + 4), s2 = *(const f32x4*)(SMALL + r * 64 + 8), s3 = *(const f32x4*)(SMALL + r * 64 + 12);
        const float g0v = -expf(p.a_log[l * 8 + h]) * softplusf_(s2[h] + p.dt_bias[l * 8 + h]), g1v = -expf(p.a_log[l * 8 + 4 + h]) * softplusf_(s3[h] + p.dt_bias[l * 8 + 4 + h]);
        const float b0v = sigmoidf_(s0[h]), b1v = sigmoidf_(s1[h]);
        float c0 = g0v, c1 = g1v;
#pragma unroll
        for (int o = 1; o < 64; o <<= 1) { const float u0 = shup(c0, o), u1 = shup(c1, o); if (lane >= o) { c0 += u0; c1 += u1; } }
        const float t0 = shlane(c0, 63), t1 = shlane(c1, 63), sf = t1 - c1 + g1v;
        gc0[lane] = c0; be0[lane] = b0v; sf1[lane] = sf; be1[lane] = b1v;
        float* v0 = (float*)(p.ws + WS_VEC) + (size_t)item0 * 256; float* v1 = (float*)(p.ws + WS_VEC) + (size_t)item1 * 256;
        v0[lane] = expf(c0); v0[64 + lane] = expf(t0 - c0); v0[128 + lane] = b0v; v0[192 + lane] = expf(t0);
        v1[63 - lane] = expf(sf); v1[64 + 63 - lane] = expf(t1 - sf); v1[128 + 63 - lane] = b1v; v1[192 + lane] = expf(t1);
    }
    struct SegRows { u32x4 x[6][4]; };
    auto seg_load = [&](int seg, SegRows& Sg) {
        int lo_ = lane; asm volatile("" : "+v"(lo_));
        const int i16 = lo_ & 15, g = lo_ >> 4;
#pragma unroll
        for (int f = 0; f < 6; ++f) { const int t = 64 * cch + 16 * (f - 1) + i16; const bool ok = t >= 0 && t < L; const size_t r = (size_t)(rbase + (ok ? t : 0));
#pragma unroll
            for (int ks = 0; ks < 4; ++ks) { Sg.x[f][ks] = (u32x4){0u, 0u, 0u, 0u}; if (ok) Sg.x[f][ks] = *(const u32x4*)(PAQ + r * 1536 + seg * 512 + h * 128 + 32 * ks + 8 * g); } }
    };
    auto tap_prev = [&](unsigned own, unsigned before) -> unsigned {
        const int t0 = __builtin_amdgcn_update_dpp(0, (int)before, 0x121  , 0xF, 0xF, false);
        return (unsigned)__builtin_amdgcn_update_dpp(t0, (int)own, 0x111  , 0xF, 0xF, false); };
    auto tap_next = [&](unsigned own, unsigned after) -> unsigned {
        const int t0 = __builtin_amdgcn_update_dpp(0, (int)after, 0x12F  , 0xF, 0xF, false);
        return (unsigned)__builtin_amdgcn_update_dpp(t0, (int)own, 0x101  , 0xF, 0xF, false); };
    auto conv_compute = [&](int seg, int mt, const SegRows& Sg, bf16x8 (&F)[4]) {
        const int t = 64 * cch + 16 * mt + i16; const size_t r = (size_t)(rbase + t);
        float y[4][8]; float ss = 0.f;
#pragma unroll
        for (int ks = 0; ks < 4; ++ks) {
            const int wo_ = seg * 128 + 32 * ks + 8 * g;
            const u32x4 wa = *(const u32x4*)(cwl + wo_), wb = *(const u32x4*)(cwl + 384 + wo_), wc = *(const u32x4*)(cwl + 768 + wo_);
            const u32x4 o_ = Sg.x[1 + mt][ks], pb_ = Sg.x[mt][ks], nb_ = Sg.x[2 + mt][ks];
            const unsigned xb[4] = {o_.x, o_.y, o_.z, o_.w}, xa[4] = {tap_prev(o_.x, pb_.x), tap_prev(o_.y, pb_.y), tap_prev(o_.z, pb_.z), tap_prev(o_.w, pb_.w)}, xc[4] = {tap_next(o_.x, nb_.x), tap_next(o_.y, nb_.y), tap_next(o_.z, nb_.z), tap_next(o_.w, nb_.w)};
            const unsigned wA[4] = {wa.x, wa.y, wa.z, wa.w}, wB[4] = {wb.x, wb.y, wb.z, wb.w}, wC[4] = {wc.x, wc.y, wc.z, wc.w};
#pragma unroll
            for (int q = 0; q < 4; ++q) {
                const float v0 = siluf_(bflo(wA[q]) * bflo(xa[q]) + bflo(wB[q]) * bflo(xb[q]) + bflo(wC[q]) * bflo(xc[q])), v1 = siluf_(bfhi(wA[q]) * bfhi(xa[q]) + bfhi(wB[q]) * bfhi(xb[q]) + bfhi(wC[q]) * bfhi(xc[q]));
                y[ks][2 * q] = v0; y[ks][2 * q + 1] = v1; ss += v0 * v0 + v1 * v1; }
        }
        float sc = 1.0f;
        if (seg < 2) { ss += shx(ss, 16); ss += shx(ss, 32); sc = 1.0f / sqrtf(ss + EPS); if (seg == 0) sc *= 0.08838834764831845f; }
#pragma unroll
        for (int ks = 0; ks < 4; ++ks) { union { bf16x8 v; u32x4 w; } f;
            f.w.x = pk2(y[ks][0] * sc, y[ks][1] * sc); f.w.y = pk2(y[ks][2] * sc, y[ks][3] * sc); f.w.z = pk2(y[ks][4] * sc, y[ks][5] * sc); f.w.w = pk2(y[ks][6] * sc, y[ks][7] * sc);
            F[ks] = f.v;
            *(u32x4*)(DN + r * 1536 + seg * 512 + h * 128 + 32 * ks + 8 * g) = f.w; }
    };
    { PH_BEGIN(12); {
#pragma unroll 1
      for (int sg = 0; sg < 2; ++sg) { const int seg = sg == 0 ? 1 : 2;
        SegRows Sg; seg_load(seg, Sg);
#pragma unroll
        for (int mt = 0; mt < 4; ++mt) { bf16x8 F[4];
            conv_compute(seg, mt, Sg, F);
            if (seg == 1) {
#pragma unroll
                for (int ks = 0; ks < 4; ++ks) *(bf16x8*)(Kc + (16 * mt + i16) * KCP + 32 * ks + 8 * g) = F[ks]; } } } } PH_END(12); }
    asm volatile("s_waitcnt lgkmcnt(0)" ::: "memory");
    f32x4 Ut[10];
    { PH_BEGIN(13);
    bf16_t* QK0g = (bf16_t*)(p.ws + WS_TQ + (size_t)item0 * 16384 + 8192); bf16_t* QK1g = (bf16_t*)(p.ws + WS_TQ + (size_t)item1 * 16384 + 8192);
    auto qk_tiles = [&](int mt, const bf16x8 (&Qf)[4]) {
#pragma unroll 1
        for (int nt = 0; nt < 4; ++nt) { f32x4 acc = (f32x4){0.f, 0.f, 0.f, 0.f}; const int j = 16 * nt + i16;
#pragma unroll
            for (int ks = 0; ks < 4; ++ks) acc = __builtin_amdgcn_mfma_f32_16x16x32_bf16(Qf[ks], *(const bf16x8*)(Kc + (16 * nt + i16) * KCP + 32 * ks + 8 * g), acc, 0, 0, 0);
            const float gj = gc0[j], sj = sf1[j];
#pragma unroll
            for (int rg = 0; rg < 4; ++rg) { const int i = 16 * mt + 4 * g + rg;
                const float q0 = i >= j ? acc[rg] * __expf(gc0[i] - gj) : 0.f, q1 = i <= j ? acc[rg] * __expf(sf1[i] - sj) : 0.f;
                QK0g[i * 64 + j] = (bf16_t)f2bf(q0); QK1g[(63 - i) * 64 + (63 - j)] = (bf16_t)f2bf(q1); } } };
    { SegRows Sg; seg_load(0, Sg);
#pragma unroll
      for (int mt = 0; mt < 4; ++mt) { bf16x8 Qf[4]; conv_compute(0, mt, Sg, Qf); qk_tiles(mt, Qf); } }
#pragma unroll
    for (int mt = 0; mt < 4; ++mt) {
        bf16x8 A[4];
#pragma unroll
        for (int ks = 0; ks < 4; ++ks) A[ks] = *(const bf16x8*)(Kc + (16 * mt + i16) * KCP + 32 * ks + 8 * g);
#pragma unroll
        for (int nt = 0; nt < 4; ++nt) { f32x4 acc = (f32x4){0.f, 0.f, 0.f, 0.f};
#pragma unroll
            for (int ks = 0; ks < 4; ++ks) acc = __builtin_amdgcn_mfma_f32_16x16x32_bf16(A[ks], *(const bf16x8*)(Kc + (16 * nt + i16) * KCP + 32 * ks + 8 * g), acc, 0, 0, 0);
            const int j = 16 * nt + i16;
            if (mt >= nt) { const float gj = gc0[j]; f32x4 lv;
#pragma unroll
                for (int rg = 0; rg < 4; ++rg) { const int i = 16 * mt + 4 * g + rg; lv[rg] = i > j ? be0[i] * acc[rg] * __expf(gc0[i] - gj) : 0.f; }
                *(f32x4*)(Ls + ((mt * (mt + 1)) / 2 + nt) * 256 + i16 * 16 + 4 * g) = lv; }
            if (mt <= nt) { const float sj = sf1[j]; f32x4 uv;
#pragma unroll
                for (int rg = 0; rg < 4; ++rg) { const int i = 16 * mt + 4 * g + rg; uv[rg] = i < j ? be1[i] * acc[rg] * __expf(sf1[i] - sj) : 0.f; }
                Ut[(nt * (nt + 1)) / 2 + mt] = uv; }
            asm volatile("" ::: "memory"); }
    }
    PH_END(13); }
    asm volatile("s_waitcnt lgkmcnt(0)" ::: "memory");
    auto solve = [&](int itemd) {
        constexpr int LP = 72;
        bf16_t* Lb = (bf16_t*)(wlds + 10240); bf16_t* Tt = (bf16_t*)wlds; bf16_t* Dv = (bf16_t*)(wlds + 10240 + 17408 + 1024);
        {
            const int Bq = lane >> 4, cq = lane & 15; const float* lblk = Ls + ((Bq * (Bq + 1)) / 2 + Bq) * 256;
            float x[16];
#pragma unroll
            for (int ii = 0; ii < 16; ++ii) x[ii] = (ii == cq) ? 1.f : 0.f;
#pragma unroll
            for (int jj = 0; jj < 15; ++jj) { const float tj = x[jj]; const float* lc = lblk + jj * 16;
                const f32x4 l0 = *(const f32x4*)lc, l1 = *(const f32x4*)(lc + 4), l2 = *(const f32x4*)(lc + 8), l3 = *(const f32x4*)(lc + 12);
#pragma unroll
                for (int q = 0; q < 4; ++q) { if (q > jj) x[q] -= l0[q] * tj; if (4 + q > jj) x[4 + q] -= l1[q] * tj; if (8 + q > jj) x[8 + q] -= l2[q] * tj; if (12 + q > jj) x[12 + q] -= l3[q] * tj; } }
#pragma unroll
            for (int ii = 0; ii < 16; ++ii) Dv[(Bq * 16 + ii) * 16 + cq] = (bf16_t)f2bf(x[ii]);
        }
        {
            const int jl = lane >> 2, iq = lane & 3;
#pragma unroll
            for (int bi = 0; bi < 4; ++bi)
#pragma unroll
                for (int bj = 0; bj <= bi; ++bj) { const f32x4 lv = *(const f32x4*)(Ls + ((bi * (bi + 1)) / 2 + bj) * 256 + jl * 16 + 4 * iq);
#pragma unroll
                    for (int q = 0; q < 4; ++q) Lb[(16 * bi + 4 * iq + q) * LP + 16 * bj + jl] = (bf16_t)f2bf(lv[q]); }
        }
        asm volatile("s_waitcnt lgkmcnt(0)" ::: "memory");
        unsigned z_ = 0u; asm volatile("" : "+v"(z_));
        const u32x4 zz = (u32x4){z_, z_, z_, z_};
#pragma unroll
        for (int q = 0; q < 9; ++q) ((u32x4*)Tt)[q * 64 + lane] = zz;
#pragma unroll
        for (int q = 0; q < 8; ++q) ((u32x4*)Tl)[q * 64 + lane] = zz;
        asm volatile("s_waitcnt lgkmcnt(0)" ::: "memory");
#pragma unroll
        for (int B = 0; B < 4; ++B) {
            const bf16x8 aD = cat8(*(const s16x4*)(Dv + (B * 16 + i16) * 16 + 4 * g), (s16x4){0, 0, 0, 0});
#pragma unroll
            for (int nt = 0; nt <= B; ++nt) {
                f32x4 acc = (f32x4){0.f, 0.f, 0.f, 0.f};
#pragma unroll
                for (int ks = 0; ks < (B + 1) / 2; ++ks)
                    acc = __builtin_amdgcn_mfma_f32_16x16x32_bf16(*(const bf16x8*)(Lb + (16 * B + i16) * LP + 32 * ks + 8 * g), *(const bf16x8*)(Tt + (16 * nt + i16) * LP + 32 * ks + 8 * g), acc, 0, 0, 0);
                f32x4 sv;
#pragma unroll
                for (int r = 0; r < 4; ++r) sv[r] = ((nt == B && 4 * g + r == i16) ? 1.f : 0.f) - acc[r];
                const f32x4 tv = __builtin_amdgcn_mfma_f32_16x16x32_bf16(aD, pack8(sv, (f32x4){0.f, 0.f, 0.f, 0.f}), (f32x4){0.f, 0.f, 0.f, 0.f}, 0, 0, 0);
                u32x2 tw; tw.x = pk2(tv[0], tv[1]); tw.y = pk2(tv[2], tv[3]);
                *(u32x2*)(Tt + (16 * nt + i16) * LP + 16 * B + 4 * g) = tw;
#pragma unroll
                for (int r = 0; r < 4; ++r) Tl[(16 * B + 4 * g + r) * 64 + 16 * nt + i16] = (bf16_t)f2bf(tv[r]);
            }
            asm volatile("s_waitcnt lgkmcnt(0)" ::: "memory");
        }
        { const u32x4* srcl = (const u32x4*)Tl; u32x4* dstg = (u32x4*)(p.ws + WS_TQ + (size_t)itemd * 16384);
#pragma unroll
          for (int q = 0; q < 8; ++q) dstg[q * 64 + lane] = srcl[q * 64 + lane]; }
        asm volatile("s_waitcnt lgkmcnt(0)" ::: "memory");
    };
    { PH_BEGIN(14);
    solve(item0);
#pragma unroll
    for (int nt = 0; nt < 4; ++nt)
#pragma unroll
        for (int mt = 0; mt <= nt; ++mt) { const f32x4 uv = Ut[(nt * (nt + 1)) / 2 + mt]; const int bi_ = 3 - mt, bj_ = 3 - nt;
            *(f32x4*)(Ls + ((bi_ * (bi_ + 1)) / 2 + bj_) * 256 + (15 - i16) * 16 + (12 - 4 * g)) = (f32x4){uv[3], uv[2], uv[1], uv[0]}; }
    asm volatile("s_waitcnt lgkmcnt(0)" ::: "memory");
    solve(item1);
    PH_END(14); }
}

__device__ __forceinline__ void dn_chain_mfma(const P& p, int item, unsigned char* lds) {
    const int b = item >> 3, h = (item >> 1) & 3, dir = item & 1, tid = otid(), lane = tid & 63, w = tid >> 6, i16 = lane & 15, g = lane >> 4;
    constexpr int KP = 136, TP = 72;
    bf16_t* Ks = (bf16_t*)lds; bf16_t* Qs = Ks + 64 * KP; bf16_t* Vs = Qs + 64 * KP; bf16_t* Ts = Vs + 64 * KP; bf16_t* QKs = Ts + 64 * TP; float* vec = (float*)(QKs + 64 * TP);
    const bf16_t* DN = (const bf16_t*)(p.ws + WS_DNQKV); bf16_t* OA = (bf16_t*)(p.ws + WS_H) + (size_t)dir * T * 512;
    f32x4 S[8];
#pragma unroll
    for (int dt = 0; dt < 8; ++dt) S[dt] = (f32x4){0.f, 0.f, 0.f, 0.f};
    u32x4 pf[9];
    auto prefetch = [&](int n) {
        const int pitem = item * DN_NCH + n;
#pragma unroll
        for (int u = 0; u < 6; ++u) { const int q = tid + 512 * u, which = q >> 10, rem = q & 1023, s = rem >> 4, ch = rem & 15;
            pf[u] = *(const u32x4*)(DN + (size_t)dn_row(n, s, b, dir) * 1536 + (which == 0 ? 512 : which == 1 ? 0 : 1024) + h * 128 + ch * 8); }
#pragma unroll
        for (int u = 0; u < 2; ++u) pf[6 + u] = *(const u32x4*)(p.ws + WS_TQ + (size_t)pitem * 16384 + (size_t)u * 8192 + (size_t)tid * 16);
        if (tid < 64) pf[8] = *(const u32x4*)((const float*)(p.ws + WS_VEC) + (size_t)pitem * 256 + tid * 4);
    };
    prefetch(0);
    for (int n = 0; n < DN_NCH; ++n) {
        __syncthreads();
#pragma unroll
        for (int u = 0; u < 6; ++u) { const int q = tid + 512 * u, which = q >> 10, rem = q & 1023, s = rem >> 4, ch = rem & 15;
            *(u32x4*)((which == 0 ? Ks : which == 1 ? Qs : Vs) + s * KP + ch * 8) = pf[u]; }
#pragma unroll
        for (int u = 0; u < 2; ++u) *(u32x4*)((u == 0 ? Ts : QKs) + (tid >> 3) * TP + (tid & 7) * 8) = pf[6 + u];
        if (tid < 64) *(u32x4*)(vec + tid * 4) = pf[8];
        __syncthreads();
        if (n + 1 < DN_NCH) prefetch(n + 1);
        const float* egv = vec; const float* eklv = vec + 64; const float* bev = vec + 128; const float glast = vec[192];
#define SB __builtin_amdgcn_sched_barrier(0)
        bf16x8 Sb[4];
#pragma unroll
        for (int ks = 0; ks < 4; ++ks) Sb[ks] = pack8(S[2 * ks], S[2 * ks + 1]);
        f32x4 r_[4], o_[4];
        bf16x8 akA[4], aqA[4], akB[4], aqB[4];
#define DN_LDKQ(mt_, ak_, aq_) do { const bf16_t* kr = Ks + (16 * (mt_) + i16) * KP + 4 * g; const bf16_t* qr = Qs + (16 * (mt_) + i16) * KP + 4 * g; \
            _Pragma("unroll") for (int ks = 0; ks < 4; ++ks) { ak_[ks] = cat8(*(const s16x4*)(kr + 32 * ks), *(const s16x4*)(kr + 32 * ks + 16)); aq_[ks] = cat8(*(const s16x4*)(qr + 32 * ks), *(const s16x4*)(qr + 32 * ks + 16)); } } while (0)
#define DN_MMKQ(mt_, ak_, aq_) do { r_[mt_] = (f32x4){0.f, 0.f, 0.f, 0.f}; o_[mt_] = (f32x4){0.f, 0.f, 0.f, 0.f}; \
            _Pragma("unroll") for (int ks = 0; ks < 4; ++ks) { r_[mt_] = __builtin_amdgcn_mfma_f32_16x16x32_bf16(ak_[ks], Sb[ks], r_[mt_], 0, 0, 0); o_[mt_] = __builtin_amdgcn_mfma_f32_16x16x32_bf16(aq_[ks], Sb[ks], o_[mt_], 0, 0, 0); } } while (0)
        DN_LDKQ(0, akA, aqA); SB;
        DN_LDKQ(1, akB, aqB); DN_MMKQ(0, akA, aqA); SB;
        DN_LDKQ(2, akA, aqA); DN_MMKQ(1, akB, aqB); SB;
        DN_LDKQ(3, akB, aqB); DN_MMKQ(2, akA, aqA); SB;
        f32x4 eg[4], be[4]; float vv[4][4];
#pragma unroll
        for (int mt = 0; mt < 4; ++mt) { eg[mt] = *(const f32x4*)(egv + 16 * mt + 4 * g); be[mt] = *(const f32x4*)(bev + 16 * mt + 4 * g);
#pragma unroll
            for (int rg = 0; rg < 4; ++rg) vv[mt][rg] = bf2f(Vs[(16 * mt + 4 * g + rg) * KP + 16 * w + i16]); }
        DN_MMKQ(3, akB, aqB); SB;
#undef DN_LDKQ
#undef DN_MMKQ
        bf16x8 tf[4][2], qf[4][2];
#pragma unroll
        for (int mt = 0; mt < 4; ++mt) { const bf16_t* tr = Ts + (16 * mt + i16) * TP + 4 * g;
#pragma unroll
            for (int k2 = 0; k2 < 2; ++k2) tf[mt][k2] = cat8(*(const s16x4*)(tr + 32 * k2), *(const s16x4*)(tr + 32 * k2 + 16)); }
        f32x4 e0v[2], e1v[2];
#pragma unroll
        for (int k2 = 0; k2 < 2; ++k2) { e0v[k2] = *(const f32x4*)(eklv + 32 * k2 + 4 * g); e1v[k2] = *(const f32x4*)(eklv + 32 * k2 + 16 + 4 * g); }
#pragma unroll
        for (int mt = 0; mt < 4; ++mt)
#pragma unroll
            for (int rg = 0; rg < 4; ++rg) { r_[mt][rg] = be[mt][rg] * (vv[mt][rg] - eg[mt][rg] * r_[mt][rg]); o_[mt][rg] *= eg[mt][rg]; }
        bf16x8 Rb[2];
#pragma unroll
        for (int k2 = 0; k2 < 2; ++k2) Rb[k2] = pack8(r_[2 * k2], r_[2 * k2 + 1]);
        SB;
#pragma unroll
        for (int mt = 0; mt < 4; ++mt) { const bf16_t* qkr = QKs + (16 * mt + i16) * TP + 4 * g;
#pragma unroll
            for (int k2 = 0; k2 < 2; ++k2) qf[mt][k2] = cat8(*(const s16x4*)(qkr + 32 * k2), *(const s16x4*)(qkr + 32 * k2 + 16)); }
        f32x4 vn[4];
#pragma unroll
        for (int mt = 0; mt < 4; ++mt) { vn[mt] = (f32x4){0.f, 0.f, 0.f, 0.f};
#pragma unroll
            for (int k2 = 0; k2 < 2; ++k2) vn[mt] = __builtin_amdgcn_mfma_f32_16x16x32_bf16(tf[mt][k2], Rb[k2], vn[mt], 0, 0, 0); }
        SB;
        bf16x8 Vb[2], Wb[2];
#pragma unroll
        for (int k2 = 0; k2 < 2; ++k2) { Vb[k2] = pack8(vn[2 * k2], vn[2 * k2 + 1]); Wb[k2] = pack8(vn[2 * k2] * e0v[k2], vn[2 * k2 + 1] * e1v[k2]); }
        bf16x8 ktA[4][2], ktB[4][2];
#pragma unroll
        for (int dt = 0; dt < 4; ++dt)
#pragma unroll
            for (int k2 = 0; k2 < 2; ++k2) { const bf16_t* a0 = Ks + (32 * k2 + 4 * g + (i16 >> 2)) * KP + 16 * dt + 4 * (i16 & 3); ktA[dt][k2] = cat8(lds_tr(a0), lds_tr(a0 + 16 * KP)); }
#pragma unroll
        for (int mt = 0; mt < 4; ++mt)
#pragma unroll
            for (int k2 = 0; k2 < 2; ++k2) o_[mt] = __builtin_amdgcn_mfma_f32_16x16x32_bf16(qf[mt][k2], Vb[k2], o_[mt], 0, 0, 0);
        SB;
#pragma unroll
        for (int dt = 0; dt < 4; ++dt)
#pragma unroll
            for (int k2 = 0; k2 < 2; ++k2) { const bf16_t* a0 = Ks + (32 * k2 + 4 * g + (i16 >> 2)) * KP + 16 * (dt + 4) + 4 * (i16 & 3); ktB[dt][k2] = cat8(lds_tr(a0), lds_tr(a0 + 16 * KP)); }
#pragma unroll
        for (int dt = 0; dt < 4; ++dt) { S[dt] = S[dt] * glast;
#pragma unroll
            for (int k2 = 0; k2 < 2; ++k2) S[dt] = __builtin_amdgcn_mfma_f32_16x16x32_bf16(ktA[dt][k2], Wb[k2], S[dt], 0, 0, 0); }
        SB;
#pragma unroll
        for (int dt = 0; dt < 4; ++dt) { S[dt + 4] = S[dt + 4] * glast;
#pragma unroll
            for (int k2 = 0; k2 < 2; ++k2) S[dt + 4] = __builtin_amdgcn_mfma_f32_16x16x32_bf16(ktB[dt][k2], Wb[k2], S[dt + 4], 0, 0, 0); }
#undef SB
#pragma unroll
        for (int mt = 0; mt < 4; ++mt)
#pragma unroll
            for (int rg = 0; rg < 4; ++rg) OA[(size_t)dn_row(n, 16 * mt + 4 * g + rg, b, dir) * 512 + h * 128 + 16 * w + i16] = (bf16_t)f2bf(o_[mt][rg]);
    }
}

__device__ __forceinline__ void phase_prep(const P& p, int l, unsigned char* lds, int gw, int NGW, int lane) {
    unsigned char* ws = p.ws;
    bf16_t* PC = (bf16_t*)(ws + WS_PC); unsigned* ctl = (unsigned*)(ws + WS_CTL);
    float* rtab = (float*)(lds + PREP_NW * PREP_WLDS);
    { const int tid = otid();
#pragma unroll
      for (int u = 0; u < 2; ++u) { const int e = tid + 512 * u, pos = e >> 4, fi = e & 15; const float ang = (float)pos * exp2f(-(float)fi * 0.8304820237218406f);
          float sn, cs; sincosf(ang, &sn, &cs); rtab[2 * e] = cs; rtab[2 * e + 1] = sn; }
      __syncthreads(); }
    const int wv = gw % NWAVES, blk = gw / NWAVES, G_ = NGW / NWAVES;
    if (wv < PREP_NW) { for (int rep = 0; rep < REP_DNPREP; ++rep) for (int it = blk * PREP_NW + wv; it < DN_ITEMS; it += G_ * PREP_NW) dn_prep_item(p, l, it, lds + wv * PREP_WLDS, lane); return; }
    const int gt = (blk * (NWAVES - PREP_NW) + (wv - PREP_NW)) * 64 + lane, NGT = G_ * (NWAVES - PREP_NW) * 64;
    float kmx = 0.f; int kbb = -1;
    const int q_ = gt & 31, seg = q_ >> 4, hh = (q_ >> 2) & 3, mm = (q_ >> 1) & 1, half = q_ & 1;
    const int rows_per = (T + NGT / 32 - 1) / (NGT / 32);
    for (int k_ = 0; k_ < rows_per; ++k_) {
        const int r = (gt >> 5) * rows_per + k_; if (r >= T) break; const bool lat = r < TL; const int b = lat ? r / SEQ : (r - TL) / CTXL;
        bf16_t* base = PC + (size_t)r * 1536 + seg * 512 + hh * 128 + mm * 64 + half * 32;
        const u32x4 a0 = *(const u32x4*)base, a1 = *(const u32x4*)(base + 8), b0 = *(const u32x4*)(base + 16), b1 = *(const u32x4*)(base + 24);
        const unsigned xa[8] = {a0.x, a0.y, a0.z, a0.w, a1.x, a1.y, a1.z, a1.w}, xb[8] = {b0.x, b0.y, b0.z, b0.w, b1.x, b1.y, b1.z, b1.w};
        const int t = r % SEQ, pos = half ? (t & 63) : (t >> 6); const float* tb = rtab + pos * 32;
        const float sc = seg == 0 ? 0.18033688011112042f : 1.0f;
        unsigned o1[8], o2[8]; float ss = 0.f;
#pragma unroll
        for (int w2 = 0; w2 < 8; ++w2) { float x1[2] = {bflo(xa[w2]), bfhi(xa[w2])}, x2[2] = {bflo(xb[w2]), bfhi(xb[w2])}, y1[2], y2[2];
            const f32x4 cssn = *(const f32x4*)(tb + 4 * w2);
#pragma unroll
            for (int e = 0; e < 2; ++e) { const float cs = lat ? cssn[2 * e] : 1.0f, sn = lat ? cssn[2 * e + 1] : 0.0f;
                y1[e] = (x1[e] * cs - x2[e] * sn) * sc; y2[e] = (x2[e] * cs + x1[e] * sn) * sc; }
            o1[w2] = pk2(y1[0], y1[1]); o2[w2] = pk2(y2[0], y2[1]);
            ss += bflo(o1[w2]) * bflo(o1[w2]) + bfhi(o1[w2]) * bfhi(o1[w2]) + bflo(o2[w2]) * bflo(o2[w2]) + bfhi(o2[w2]) * bfhi(o2[w2]); }
        if (lat || seg == 0) { *(u32x4*)base = (u32x4){o1[0], o1[1], o1[2], o1[3]}; *(u32x4*)(base + 8) = (u32x4){o1[4], o1[5], o1[6], o1[7]};
                               *(u32x4*)(base + 16) = (u32x4){o2[0], o2[1], o2[2], o2[3]}; *(u32x4*)(base + 24) = (u32x4){o2[4], o2[5], o2[6], o2[7]}; }
        ss += shx(ss, 1);
        if (seg == 1) { if (b != kbb) { if (kbb >= 0 && half == 0) atomicMax(ctl + CW_KMAX + l * 64 + (kbb * 4 + hh) * 2 + mm, __builtin_bit_cast(unsigned, sqrtf(kmx))); kbb = b; kmx = 0.f; }
            kmx = fmaxf(kmx, ss); }
    }
    if (seg == 1 && kbb >= 0 && half == 0) atomicMax(ctl + CW_KMAX + l * 64 + (kbb * 4 + hh) * 2 + mm, __builtin_bit_cast(unsigned, sqrtf(kmx)));
    if (blk == 0 && wv == PREP_NW) { float a = 0.f, bq = 0.f; const float* lc = p.lam_c + (size_t)l * 256;
        a = wave_sum(lc[lane] * lc[64 + lane]); bq = wave_sum(lc[128 + lane] * lc[192 + lane]);
        const float lam_init = l == 0 ? 0.2f : 0.35550906758f;
        if (lane == 0) ((float*)(ws + WS_MISC))[MI_LAMF + l] = expf(a) - expf(bq) + lam_init; }
}

__device__ __forceinline__ void dn_chain(const P& p, int item, unsigned char* lds) {
    const int b = item >> 3, h = (item >> 1) & 3, dir = item & 1, tid = otid(), c = tid >> 2, ks = tid & 3;
    const bf16_t* DN = (const bf16_t*)(p.ws + WS_DNQKV); const float* GB = (const float*)(p.ws + WS_GB);
    bf16_t* OA = (bf16_t*)(p.ws + WS_H) + (size_t)dir * T * 512;
    constexpr int TB = 32;
    float* qs = (float*)lds; float* ksm = qs + TB * 128; float* vs = ksm + TB * 128; float* gs = vs + TB * 128; float* bs = gs + TB; float* ob = bs + TB;
    float S[32];
#pragma unroll
    for (int i = 0; i < 32; ++i) S[i] = 0.f;
    for (int part = 0; part < 2; ++part) {
        const int L = part == 0 ? CTXL : SEQ; const int rbase = part == 0 ? TL + b * CTXL : b * SEQ;
        for (int t0 = 0; t0 < L; t0 += TB) {
            __syncthreads();
            for (int i = tid; i < 3 * TB * 16; i += NTHREADS) { const int which = i / (TB * 16), rem = i % (TB * 16), tt = rem >> 4, ch = rem & 15;
                const int s = t0 + tt, t = dir ? L - 1 - s : s;
                const u32x4 w = *(const u32x4*)(DN + (size_t)(rbase + t) * 1536 + which * 512 + h * 128 + ch * 8);
                float* dst = (which == 0 ? qs : which == 1 ? ksm : vs) + tt * 128 + ch * 8;
                dst[0] = bflo(w.x); dst[1] = bfhi(w.x); dst[2] = bflo(w.y); dst[3] = bfhi(w.y); dst[4] = bflo(w.z); dst[5] = bfhi(w.z); dst[6] = bflo(w.w); dst[7] = bfhi(w.w); }
            if (tid < TB) { const int s = t0 + tid, t = dir ? L - 1 - s : s; gs[tid] = expf(GB[(size_t)(rbase + t) * 16 + dir * 4 + h]); bs[tid] = GB[(size_t)(rbase + t) * 16 + 8 + dir * 4 + h]; }
            __syncthreads();
            for (int tt = 0; tt < TB; ++tt) {
                const float eg = gs[tt], be = bs[tt];
                const float* kr = ksm + tt * 128 + ks * 32; const float* qr = qs + tt * 128 + ks * 32;
                float r = 0.f;
#pragma unroll
                for (int i = 0; i < 32; ++i) r += kr[i] * S[i];
                r += shx(r, 1); r += shx(r, 2);
                const float vn = be * (vs[tt * 128 + c] - eg * r);
                float o = 0.f;
#pragma unroll
                for (int i = 0; i < 32; ++i) { S[i] = eg * S[i] + kr[i] * vn; o += qr[i] * S[i]; }
                o += shx(o, 1); o += shx(o, 2);
                if (ks == 0) ob[tt * 128 + c] = o;
            }
            __syncthreads();
            for (int i = tid; i < TB * 64; i += NTHREADS) { const int tt = i >> 6, cp = i & 63; const int s = t0 + tt, t = dir ? L - 1 - s : s;
                *(unsigned*)(OA + (size_t)(rbase + t) * 512 + h * 128 + 2 * cp) = pk2(ob[tt * 128 + 2 * cp], ob[tt * 128 + 2 * cp + 1]); }
        }
    }
}
__device__ __forceinline__ void gla_chain_mfma(const P& p, int l, int item, unsigned char* lds) {
    const int b = item >> 3, h = (item >> 1) & 3, dir = item & 1, tid = otid(), lane = tid & 63, w = tid >> 6, i16 = lane & 15, g = lane >> 4;
    constexpr int RP = 72, VP = 136, GP = 40;
    constexpr int RAWE = 2 * 64 * RP + 64 * VP + 64 * GP;
    bf16_t* Qt = (bf16_t*)lds;
    bf16_t* Kt = Qt + 64 * RP;
    bf16_t* KgT = Kt + 64 * RP;
    bf16_t* raw0 = KgT + 64 * RP;
    float* tot = (float*)(raw0 + 2 * RAWE);
    float* gls = tot + 128;
    const bf16_t* PB = (const bf16_t*)(p.ws + WS_PB); const float* SMALL = (const float*)(p.ws + WS_SMALL);
    bf16_t* OB = (bf16_t*)(p.ws + WS_PAQ) + (size_t)dir * T * 512;
    const int nt_ = w & 3, hf = w >> 2, ch = 16 * nt_ + i16;
    bf16x8 wgB;
    { float wv[8];
#pragma unroll
      for (int j = 0; j < 8; ++j) wv[j] = g < 2 ? p.w_gate2[((size_t)l * 2 + dir) * 16 * 256 + (8 * g + j) * 256 + h * 64 + ch] : 0.f;
      union { bf16x8 v; unsigned u[4]; } t_; t_.u[0] = pk2(wv[0], wv[1]); t_.u[1] = pk2(wv[2], wv[3]); t_.u[2] = pk2(wv[4], wv[5]); t_.u[3] = pk2(wv[6], wv[7]); wgB = t_.v; }
    const float bgc = p.b_gate[((size_t)l * 2 + dir) * 256 + h * 64 + ch];
    f32x4 S[4];
#pragma unroll
    for (int dt = 0; dt < 4; ++dt) S[dt] = (f32x4){0.f, 0.f, 0.f, 0.f};
    __syncthreads();
    for (int i = tid; i < 64 * GP / 2; i += NTHREADS) { ((unsigned*)(raw0 + 2 * 64 * RP + 64 * VP))[i] = 0u; ((unsigned*)(raw0 + RAWE + 2 * 64 * RP + 64 * VP))[i] = 0u; }
    u32x4 pf[5];
    auto prefetch = [&](int n) {
        { const int s = tid >> 3, c8 = tid & 7; const size_t row = (size_t)dn_row(n, s, b, dir);
          pf[0] = *(const u32x4*)(PB + row * 1536 + h * 64 + c8 * 8); pf[1] = *(const u32x4*)(PB + row * 1536 + 256 + h * 64 + c8 * 8); }
#pragma unroll
        for (int u = 0; u < 2; ++u) { const int q = tid + 512 * u, s = q >> 4, c8 = q & 15; pf[2 + u] = *(const u32x4*)(PB + (size_t)dn_row(n, s, b, dir) * 1536 + 512 + h * 128 + c8 * 8); }
        if (tid < 256) { const int s = tid >> 2, c4 = tid & 3; pf[4] = *(const u32x4*)(SMALL + (size_t)dn_row(n, s, b, dir) * 64 + 16 + dir * 16 + c4 * 4); }
    };
    auto stage = [&](int bsel) { bf16_t* qraw = raw0 + bsel * RAWE; bf16_t* kraw = qraw + 64 * RP; bf16_t* Vs = kraw + 64 * RP; bf16_t* Gl = Vs + 64 * VP;
        { const int s = tid >> 3, c8 = tid & 7; *(u32x4*)(qraw + s * RP + c8 * 8) = pf[0]; *(u32x4*)(kraw + s * RP + c8 * 8) = pf[1]; }
#pragma unroll
        for (int u = 0; u < 2; ++u) { const int q = tid + 512 * u, s = q >> 4, c8 = q & 15; *(u32x4*)(Vs + s * VP + c8 * 8) = pf[2 + u]; }
        if (tid < 256) { const int s = tid >> 2, c4 = tid & 3; const f32x4 gv = __builtin_bit_cast(f32x4, pf[4]); u32x2 o2; o2.x = pk2(gv[0], gv[1]); o2.y = pk2(gv[2], gv[3]); *(u32x2*)(Gl + s * GP + 4 * c4) = o2; }
    };
    prefetch(0);
    __syncthreads();
    stage(0); prefetch(1);
    for (int n = 0; n < DN_NCH; ++n) {
        const bf16_t* qraw = raw0 + (n & 1) * RAWE; const bf16_t* kraw = qraw + 64 * RP; const bf16_t* Vs = kraw + 64 * RP; const bf16_t* Gl = Vs + 64 * VP;
        __syncthreads();
        f32x4 pr[2]; float E_[2], TT0;
        {
#pragma unroll
            for (int t = 0; t < 2; ++t) { const int mt = 2 * hf + t;
                f32x4 z = __builtin_amdgcn_mfma_f32_16x16x32_bf16(*(const bf16x8*)(Gl + (16 * mt + i16) * GP + 8 * g), wgB, (f32x4){bgc, bgc, bgc, bgc}, 0, 0, 0);
                float run = 0.f;
#pragma unroll
                for (int r = 0; r < 4; ++r) { run += logsigmoid_fast(z[r]) * 0.0625f; pr[t][r] = run; } }
            float TT[2];
#pragma unroll
            for (int t = 0; t < 2; ++t) { const float T_ = pr[t][3]; const float y1 = shup(T_, 16); const float s1 = T_ + (g >= 1 ? y1 : 0.f); const float y2 = shup(s1, 32); const float s2 = s1 + (g >= 2 ? y2 : 0.f);
                E_[t] = s2 - T_; TT[t] = shlane(s2, i16 + 48); }
            TT0 = TT[0];
            if (g == 0) tot[hf * 64 + ch] = TT[0] + TT[1];
        }
        __syncthreads();
        {
            const float t0 = tot[ch], t1 = tot[64 + ch], total = t0 + t1, base = hf ? t0 : 0.f;
            float qv_[2][4], kv_[2][4];
#pragma unroll
            for (int t = 0; t < 2; ++t)
#pragma unroll
                for (int r = 0; r < 4; ++r) { const int tk = 16 * (2 * hf + t) + 4 * g + r; qv_[t][r] = bf2f(qraw[tk * RP + ch]); kv_[t][r] = bf2f(kraw[tk * RP + ch]); }
            __builtin_amdgcn_sched_barrier(0);
            const float etot = __expf(total);
#pragma unroll
            for (int t = 0; t < 2; ++t) { const int mt = 2 * hf + t; const float off = base + (t ? TT0 : 0.f) + E_[t]; float kgv[4];
#pragma unroll
                for (int r = 0; r < 4; ++r) { const int tk = 16 * mt + 4 * g + r; const float gc = off + pr[t][r]; const float eg = __expf(gc), ieg = __builtin_amdgcn_rcpf(eg);
                    Qt[tk * RP + ch] = (bf16_t)f2bf(0.125f * qv_[t][r] * eg); const float kie = kv_[t][r] * ieg; Kt[tk * RP + ch] = (bf16_t)f2bf(kie); kgv[r] = kie * etot; }
                u32x2 kw; kw.x = pk2(kgv[0], kgv[1]); kw.y = pk2(kgv[2], kgv[3]); *(u32x2*)(KgT + ch * RP + 16 * mt + 4 * g) = kw; }
            if (hf == 0 && g == 0) gls[ch] = etot;
        }
        __syncthreads();
        if (n + 1 < DN_NCH) { stage((n + 1) & 1); if (n + 2 < DN_NCH) prefetch(n + 2); }
        { bf16x8 Sb[2], Vb[2];
#pragma unroll
          for (int ks = 0; ks < 2; ++ks) { Sb[ks] = pack8(S[2 * ks], S[2 * ks + 1]);
              const bf16_t* v0 = Vs + (32 * ks + 4 * g + (i16 >> 2)) * VP + 16 * w + 4 * (i16 & 3); Vb[ks] = cat8(lds_tr(v0), lds_tr(v0 + 16 * VP)); }
          bf16x8 aq[4][2], aa[4][2], ak[4][2];
          { bf16x8 kf[4][2], qn_[4][2];
#pragma unroll
            for (int t4 = 0; t4 < 4; ++t4)
#pragma unroll
                for (int k2 = 0; k2 < 2; ++k2) { kf[t4][k2] = *(const bf16x8*)(Kt + (16 * t4 + i16) * RP + 32 * k2 + 8 * g); qn_[t4][k2] = *(const bf16x8*)(Qt + (16 * t4 + i16) * RP + 32 * k2 + 8 * g); }
#pragma unroll
            for (int mt = 0; mt < 4; ++mt)
#pragma unroll
                for (int ks = 0; ks < 2; ++ks) { f32x4 th[2];
#pragma unroll
                    for (int hh = 0; hh < 2; ++hh) { const int jb = 2 * ks + hh; th[hh] = (f32x4){0.f, 0.f, 0.f, 0.f};
                        if (jb <= mt) {
#pragma unroll
                            for (int k2 = 0; k2 < 2; ++k2) th[hh] = __builtin_amdgcn_mfma_f32_16x16x32_bf16(kf[jb][k2], qn_[mt][k2], th[hh], 0, 0, 0);
                            if (jb == mt) {
#pragma unroll
                                for (int rg = 0; rg < 4; ++rg) th[hh][rg] = (i16 >= 4 * g + rg) ? th[hh][rg] : 0.f; } } }
                    aa[mt][ks] = pack8(th[0], th[1]); } }
#pragma unroll
          for (int mt = 0; mt < 4; ++mt)
#pragma unroll
              for (int ks = 0; ks < 2; ++ks) { const int o_ = (16 * mt + i16) * RP + 32 * ks + 4 * g;
                  aq[mt][ks] = cat8(*(const s16x4*)(Qt + o_), *(const s16x4*)(Qt + o_ + 16)); ak[mt][ks] = cat8(*(const s16x4*)(KgT + o_), *(const s16x4*)(KgT + o_ + 16)); }
#pragma unroll
          for (int mt = 0; mt < 4; ++mt) { f32x4 o = (f32x4){0.f, 0.f, 0.f, 0.f};
#pragma unroll
              for (int ks = 0; ks < 2; ++ks) { o = __builtin_amdgcn_mfma_f32_16x16x32_bf16(aq[mt][ks], Sb[ks], o, 0, 0, 0); o = __builtin_amdgcn_mfma_f32_16x16x32_bf16(aa[mt][ks], Vb[ks], o, 0, 0, 0); }
#pragma unroll
              for (int rg = 0; rg < 4; ++rg) OB[(size_t)dn_row(n, 16 * mt + 4 * g + rg, b, dir) * 512 + h * 128 + 16 * w + i16] = (bf16_t)f2bf(o[rg]); }
#pragma unroll
          for (int dt = 0; dt < 4; ++dt) { const f32x4 gl = *(const f32x4*)(gls + 16 * dt + 4 * g); S[dt] = S[dt] * gl;
#pragma unroll
              for (int ks = 0; ks < 2; ++ks) S[dt] = __builtin_amdgcn_mfma_f32_16x16x32_bf16(ak[dt][ks], Vb[ks], S[dt], 0, 0, 0); } }
    }
}
__device__ __forceinline__ void attn_tile(const P& p, int l, int b, int h, int qrow0  , bool ctxq, unsigned char* lds, bool do_store = true) {
    constexpr int QP = 72, KP = 72, VP = 160;
    bf16_t* Qs = (bf16_t*)lds;
    constexpr int KVB = 2 * 64 * KP + 64 * VP;
    bf16_t* KV0 = Qs + 2 * 128 * QP;
    float* Oex = (float*)lds;
    bf16_t* PC = (bf16_t*)(p.ws + WS_PC);
    const int tid = otid(), lane = tid & 63, w = tid >> 6, m = w & 1, rg = w >> 1, q31 = lane & 31, hi = lane >> 5, i16 = lane & 15, gg = lane >> 4;
    const int nkt = ctxq ? CTXL / 64 : (CTXL + SEQ) / 64;
    u32x4 pk_[2], pv_[2];
    auto prefetch = [&](int kt) { const int krow0 = kt < CTXL / 64 ? TL + b * CTXL + kt * 64 : b * SEQ + (kt - CTXL / 64) * 64;
#pragma unroll
        for (int u = 0; u < 2; ++u) { const int i = tid + 512 * u, r = i >> 4, ch = i & 15; const bf16_t* rowp = PC + (size_t)(krow0 + r) * 1536 + h * 128 + ch * 8;
            pk_[u] = *(const u32x4*)(rowp + 512); pv_[u] = *(const u32x4*)(rowp + 1024); } };
    prefetch(0);
    __syncthreads();
    for (int i = tid; i < 128 * 16; i += NTHREADS) { const int r = i >> 4, ch = i & 15, mm = ch >> 3, c8 = (ch & 7) * 8;
        *(u32x4*)(Qs + (mm * 128 + r) * QP + c8) = *(const u32x4*)(PC + (size_t)(qrow0 + r) * 1536 + h * 128 + ch * 8); }
    __syncthreads();
    const bf16_t* qrow = Qs + (m * 128 + rg * 32 + q31) * QP;
    bf16x8 bq[4]; float qn = 0.f;
#pragma unroll
    for (int kk = 0; kk < 4; ++kk) bq[kk] = *(const bf16x8*)(qrow + 16 * kk + 8 * hi);
#pragma unroll
    for (int d8 = 0; d8 < 8; ++d8) { const u32x4 q4 = *(const u32x4*)(qrow + 8 * d8);
        qn += bflo(q4.x) * bflo(q4.x) + bfhi(q4.x) * bfhi(q4.x) + bflo(q4.y) * bflo(q4.y) + bfhi(q4.y) * bfhi(q4.y) + bflo(q4.z) * bflo(q4.z) + bfhi(q4.z) * bfhi(q4.z) + bflo(q4.w) * bflo(q4.w) + bfhi(q4.w) * bfhi(q4.w); }
    const float kmax = __builtin_bit_cast(float, ((const unsigned*)(p.ws + WS_CTL))[CW_KMAX + l * 64 + (b * 4 + h) * 2 + m]);
    const float mrow = sqrtf(qn) * kmax * 1.002f + 1e-3f;
    f32x16 o[4]; float lsum4[4] = {0.f, 0.f, 0.f, 0.f};
#pragma unroll
    for (int dt = 0; dt < 4; ++dt)
#pragma unroll
        for (int r = 0; r < 16; ++r) o[dt][r] = 0.f;
    auto stage = [&](int buf) { bf16_t* Ks = KV0 + buf * KVB; bf16_t* Vs = Ks + 2 * 64 * KP;
#pragma unroll
        for (int u = 0; u < 2; ++u) { const int i = tid + 512 * u, r = i >> 4, ch = i & 15, mm = ch >> 3, c8 = (ch & 7) * 8;
            *(u32x4*)(Ks + (mm * 64 + r) * KP + c8) = pk_[u]; *(u32x4*)(Vs + r * VP + ch * 8) = pv_[u]; } };
    stage(0);
    if (nkt > 1) prefetch(1);
    __syncthreads();
    for (int kt = 0; kt < nkt; ++kt) {
        const bf16_t* Ks = KV0 + (kt & 1) * KVB; const bf16_t* Vs = Ks + 2 * 64 * KP;
        bf16x8 ka[2][4];
#pragma unroll
        for (int kh = 0; kh < 2; ++kh)
#pragma unroll
            for (int kk = 0; kk < 4; ++kk) ka[kh][kk] = *(const bf16x8*)(Ks + (m * 64 + kh * 32 + q31) * KP + 16 * kk + 8 * hi);
        s16x4 vlo[4][4], vhi[4][4];
#pragma unroll
        for (int st = 0; st < 1; ++st) { const bf16_t* v0 = Vs + (16 * st + 4 * hi + (i16 >> 2)) * VP + 16 * (gg & 1) + 4 * (i16 & 3);
#pragma unroll
            for (int dt = 0; dt < 4; ++dt) { vlo[st][dt] = lds_tr(v0 + 32 * dt); vhi[st][dt] = lds_tr(v0 + 32 * dt + 8 * VP); } }
        __builtin_amdgcn_sched_barrier(0);
        f32x16 s[2];
#pragma unroll
        for (int kh = 0; kh < 2; ++kh) {
#pragma unroll
            for (int r = 0; r < 16; ++r) s[kh][r] = 0.f;
#pragma unroll
            for (int kk = 0; kk < 4; ++kk) s[kh] = __builtin_amdgcn_mfma_f32_32x32x16_bf16(ka[kh][kk], bq[kk], s[kh], 0, 0, 0);
        }
#pragma unroll
        for (int st = 1; st < 4; ++st) { const bf16_t* v0 = Vs + (16 * st + 4 * hi + (i16 >> 2)) * VP + 16 * (gg & 1) + 4 * (i16 & 3);
#pragma unroll
            for (int dt = 0; dt < 4; ++dt) { vlo[st][dt] = lds_tr(v0 + 32 * dt); vhi[st][dt] = lds_tr(v0 + 32 * dt + 8 * VP); } }
        __builtin_amdgcn_sched_barrier(0);
#pragma unroll
        for (int kh = 0; kh < 2; ++kh)
#pragma unroll
            for (int r = 0; r < 16; ++r) { const float ev = __builtin_amdgcn_exp2f(s[kh][r] - mrow); s[kh][r] = ev; lsum4[r & 3] += ev; }
        if (kt + 1 < nkt) { stage((kt + 1) & 1); if (kt + 2 < nkt) prefetch(kt + 2); }
#pragma unroll
        for (int st = 0; st < 4; ++st) {
            const int kh = st >> 1, r0 = 8 * (st & 1);
            union { bf16x8 v; unsigned u[4]; } bp;
            bp.u[0] = pk2(s[kh][r0 + 0], s[kh][r0 + 1]); bp.u[1] = pk2(s[kh][r0 + 2], s[kh][r0 + 3]); bp.u[2] = pk2(s[kh][r0 + 4], s[kh][r0 + 5]); bp.u[3] = pk2(s[kh][r0 + 6], s[kh][r0 + 7]);
    #pragma unroll
            for (int dt = 0; dt < 4; ++dt) o[dt] = __builtin_amdgcn_mfma_f32_32x32x16_bf16(cat8(vlo[st][dt], vhi[st][dt]), bp.v, o[dt], 0, 0, 0);
            }
        __syncthreads();
    }
    float lsum = (lsum4[0] + lsum4[1]) + (lsum4[2] + lsum4[3]);
    const int tid_e = otid(), w_e = tid_e >> 6, m_e = w_e & 1, rg_e = w_e >> 1, q31_e = tid_e & 31, hi_e = (tid_e & 63) >> 5;
    lsum += shx(lsum, 32);
    const float lamf = ((const float*)(p.ws + WS_MISC))[MI_LAMF + l];
    const float sc = (m_e == 0 ? 1.0f : lamf) / lsum;
    __syncthreads();
    float* ox = Oex + (rg_e * 32 + q31_e) * 132;
    if (m_e == 1) {
#pragma unroll
        for (int dt = 0; dt < 4; ++dt)
#pragma unroll
            for (int r = 0; r < 16; ++r) ox[dt * 32 + (r & 3) + 8 * (r >> 2) + 4 * hi_e] = o[dt][r] * sc;
    }
    __syncthreads();
    if (m_e == 0) {
        float ss = 0.f;
#pragma unroll
        for (int dt = 0; dt < 4; ++dt)
#pragma unroll
            for (int r = 0; r < 16; ++r) { const float v = o[dt][r] * sc - ox[dt * 32 + (r & 3) + 8 * (r >> 2) + 4 * hi_e]; o[dt][r] = v; ss += v * v; }
        ss += shx(ss, 32);
        int lo_ = l; asm volatile("" : "+s"(lo_));
        const float lam_init = lo_ == 0 ? 0.2f : 0.35550906758f;
        const float rs = (1.0f - lam_init) / sqrtf(ss * (1.0f / 128.0f) + EPS);
        const float* gn = p.gn_c + l * 128;
        bf16_t* orow = (bf16_t*)(p.ws + WS_YD) + (size_t)(qrow0 + rg_e * 32 + q31_e) * 512 + h * 128;
#pragma unroll
        for (int dt = 0; dt < 4; ++dt)
#pragma unroll
            for (int g4 = 0; g4 < 4; ++g4) { const int dv = dt * 32 + 8 * g4 + 4 * hi_e; const f32x4 gv = *(const f32x4*)(gn + dv);
                u32x2 wv; wv.x = pk2(o[dt][4 * g4 + 0] * rs * gv[0], o[dt][4 * g4 + 1] * rs * gv[1]); wv.y = pk2(o[dt][4 * g4 + 2] * rs * gv[2], o[dt][4 * g4 + 3] * rs * gv[3]);
                if (do_store) *(u32x2*)(orow + dv) = wv; }
    }
}
__device__ __forceinline__ void phase_mix(const P& p, int l, unsigned char* lds) {
    unsigned* qhead = (unsigned*)(p.ws + WS_CTL) + CW_QUEUE + 64 * l;
    volatile int* slot = (volatile int*)(lds + LDS_BYTES - 64);
    const int n_att_l = BATCH * 4 * (SEQ / 128), n_att_c = (l == 0) ? BATCH * 4 * (CTXL / 128) : 0;
    const int total = 128 + n_att_l + n_att_c;
    for (;;) {
        __syncthreads();
        if (otid() == 0) *slot = (int)atomicAdd(qhead, 1u);
        __syncthreads();
        const int it = *slot;
        if (it >= total) break;
        if (it < 64) { for (int rep = 0; rep < REP_DN; ++rep) dn_chain_mfma(p, it, lds); }
        else if (it < 128) { for (int rep = 0; rep < REP_GLA; ++rep) gla_chain_mfma(p, l, it - 64, lds); }
        else if (it < 128 + n_att_l) { const int a = it - 128, b = a / (4 * (SEQ / 128)), rem = a % (4 * (SEQ / 128)), h = rem / (SEQ / 128), qt = rem % (SEQ / 128);
            for (int rep = 1; rep < REP_ATT; ++rep) attn_tile(p, l, b, h, b * SEQ + qt * 128, false, lds, false);
            attn_tile(p, l, b, h, b * SEQ + qt * 128, false, lds); }
        else { const int a = it - 128 - n_att_l, b = a / (4 * (CTXL / 128)), rem = a % (4 * (CTXL / 128)), h = rem / (CTXL / 128), qt = rem % (CTXL / 128);
            attn_tile(p, l, b, h, TL + b * CTXL + qt * 128, true, lds); }
    }
}

__device__ __forceinline__ void phase_post(const P& p, int l, int nrows, int gw, int NGW, int lane) {
    bf16_t* OA = (bf16_t*)(p.ws + WS_H); bf16_t* OBb = (bf16_t*)(p.ws + WS_PAQ);
    const bf16_t* PZ = (const bf16_t*)(p.ws + WS_PZ); const bf16_t* PB = (const bf16_t*)(p.ws + WS_PB);
    const int c8 = 8 * lane, cg = c8 & 127;
    const f32x4 ga0 = *(const f32x4*)(p.gn_a + l * 128 + cg), ga1 = *(const f32x4*)(p.gn_a + l * 128 + cg + 4), gb0 = *(const f32x4*)(p.gn_b + l * 128 + cg), gb1 = *(const f32x4*)(p.gn_b + l * 128 + cg + 4);
    for (int r0_ = gw; r0_ < nrows; r0_ += 2 * NGW)
#pragma unroll
    for (int rr_ = 0; rr_ < 2; ++rr_) { const int r = r0_ + rr_ * NGW; if (r >= nrows) break;
        const u32x4 af = *(const u32x4*)(OA + (size_t)r * 512 + c8), ab = *(const u32x4*)(OA + ((size_t)T + r) * 512 + c8), az = *(const u32x4*)(PZ + (size_t)r * 512 + c8);
        const u32x4 bf_ = *(const u32x4*)(OBb + (size_t)r * 512 + c8), bb = *(const u32x4*)(OBb + ((size_t)T + r) * 512 + c8), bz = *(const u32x4*)(PB + (size_t)r * 1536 + 1024 + c8);
        const unsigned afw[4] = {af.x, af.y, af.z, af.w}, abw[4] = {ab.x, ab.y, ab.z, ab.w}, azw[4] = {az.x, az.y, az.z, az.w}, bfw[4] = {bf_.x, bf_.y, bf_.z, bf_.w}, bbw[4] = {bb.x, bb.y, bb.z, bb.w}, bzw[4] = {bz.x, bz.y, bz.z, bz.w};
        float oa[8], ob[8], sa = 0.f, sb = 0.f;
#pragma unroll
        for (int q = 0; q < 4; ++q) { oa[2 * q] = bflo(afw[q]) + bflo(abw[q]); oa[2 * q + 1] = bfhi(afw[q]) + bfhi(abw[q]); ob[2 * q] = bflo(bfw[q]) + bflo(bbw[q]); ob[2 * q + 1] = bfhi(bfw[q]) + bfhi(bbw[q]);
            sa += oa[2 * q] * oa[2 * q] + oa[2 * q + 1] * oa[2 * q + 1]; sb += ob[2 * q] * ob[2 * q] + ob[2 * q + 1] * ob[2 * q + 1]; }
#pragma unroll
        for (int o = 1; o < 16; o <<= 1) { sa += shx(sa, o); sb += shx(sb, o); }
        const float ra = 1.0f / sqrtf(sa * (1.0f / 128.0f) + EPS), rb = 1.0f / sqrtf(sb * (1.0f / 128.0f) + EPS);
        unsigned wa[4], wb[4];
#pragma unroll
        for (int q = 0; q < 4; ++q) { const float g0 = q < 2 ? ga0[2 * q] : ga1[2 * q - 4], g1 = q < 2 ? ga0[2 * q + 1] : ga1[2 * q - 3], h0 = q < 2 ? gb0[2 * q] : gb1[2 * q - 4], h1 = q < 2 ? gb0[2 * q + 1] : gb1[2 * q - 3];
            wa[q] = pk2(oa[2 * q] * ra * g0 * siluf_(bflo(azw[q])), oa[2 * q + 1] * ra * g1 * siluf_(bfhi(azw[q])));
            wb[q] = pk2(ob[2 * q] * rb * h0 * siluf_(bflo(bzw[q])), ob[2 * q + 1] * rb * h1 * siluf_(bfhi(bzw[q]))); }
        *(u32x4*)(OA + (size_t)r * 512 + c8) = (u32x4){wa[0], wa[1], wa[2], wa[3]};
        *(u32x4*)(OBb + (size_t)r * 512 + c8) = (u32x4){wb[0], wb[1], wb[2], wb[3]};
    }
}

__device__ __forceinline__ void phase_moe_gather(const P& p, unsigned char* lds) {
    const int tid = otid();
    const int* route = (const int*)(p.ws + WS_ROUTE); int* slots = (int*)(p.ws + WS_SLOT); int* misc = (int*)(p.ws + WS_MISC);
    const unsigned* ecnt = (const unsigned*)(p.ws + WS_CTL) + CW_ECNT; unsigned* efill = (unsigned*)(p.ws + WS_CTL) + CW_EFILL;
    const bf16_t* H = (const bf16_t*)(p.ws + WS_H); bf16_t* MA = (bf16_t*)(p.ws + WS_MA);
    int* eoff = (int*)lds; unsigned* lcnt = (unsigned*)(eoff + 16); unsigned* lbase = lcnt + 8; int* myslot = (int*)(lbase + 8);
    if (tid == 0) { int off = 0, nt = 0;
#pragma unroll 1
        for (int e = 0; e < NE; ++e) { eoff[e] = off; const int tl = ((int)ecnt[e] + 255) / 256;
            if (blockIdx.x == 0) { for (int q = 0; q < tl; ++q) misc[MI_TILEE + nt + q] = e; }
            nt += tl; off += tl * 256; }
        eoff[NE] = off; if (blockIdx.x == 0) misc[MI_NTILES] = nt; }
    for (int grp = blockIdx.x; grp < TL / 64; grp += gridDim.x) {
        __syncthreads();
        if (tid < NE) lcnt[tid] = 0u;
        __syncthreads();
        int e = 0, rank = 0;
        if (tid < 128) { e = route[(grp * 64 + (tid >> 1)) * 4 + (tid & 1)]; rank = (int)atomicAdd(lcnt + e, 1u); }
        __syncthreads();
        if (tid < NE) lbase[tid] = lcnt[tid] ? atomicAdd(efill + tid, lcnt[tid]) : 0u;
        __syncthreads();
        if (tid < 128) { const int s = eoff[e] + (int)lbase[e] + rank; myslot[tid] = s; slots[(grp * 64 + (tid >> 1)) * 2 + (tid & 1)] = s; }
        __syncthreads();
        for (int i0 = tid; i0 < 128 * 128; i0 += 8 * NTHREADS) { u32x4 v[8];
#pragma unroll
            for (int u = 0; u < 8; ++u) { const int i = i0 + u * NTHREADS, a = i >> 7, ch = i & 127; v[u] = ((const u32x4*)(H + (size_t)(grp * 64 + (a >> 1)) * D))[ch]; }
#pragma unroll
            for (int u = 0; u < 8; ++u) { const int i = i0 + u * NTHREADS, a = i >> 7, ch = i & 127; ((u32x4*)(MA + (size_t)myslot[a] * D))[ch] = v[u]; } }
    }
}
__device__ __forceinline__ void phase_final(const P& p, int gw, int NGW, int lane) {
    const int* route = (const int*)(p.ws + WS_ROUTE); const int* slots = (const int*)(p.ws + WS_SLOT); const bf16_t* Y = (const bf16_t*)(p.ws + WS_MA);
    const float* MOD = (const float*)(p.ws + WS_MOD) + (size_t)1 * 9 * 6144;
    for (int r0_ = gw; r0_ < TL; r0_ += 2 * NGW)
#pragma unroll
    for (int rr_ = 0; rr_ < 2; ++rr_) { const int r = r0_ + rr_ * NGW; if (r >= TL) break; const int b = r / SEQ; const float w1 = ((const float*)route)[r * 4 + 2], w2 = ((const float*)route)[r * 4 + 3];
        const bf16_t* y1 = Y + (size_t)slots[r * 2] * D, *y2 = Y + (size_t)slots[r * 2 + 1] * D; float* xr = p.out + (size_t)r * D; const float* g2 = MOD + (size_t)b * 6144 + 5 * 1024;
        f32x4 v[4]; float ss = 0.f;
#pragma unroll
        for (int j = 0; j < 4; ++j) { const int c = 4 * lane + 256 * j; const u32x2 a = *(const u32x2*)(y1 + c), bq = *(const u32x2*)(y2 + c); const f32x4 g = *(const f32x4*)(g2 + c);
            f32x4 y; y[0] = w1 * bflo(a.x) + w2 * bflo(bq.x); y[1] = w1 * bfhi(a.x) + w2 * bfhi(bq.x); y[2] = w1 * bflo(a.y) + w2 * bflo(bq.y); y[3] = w1 * bfhi(a.y) + w2 * bfhi(bq.y);
            v[j] = *(const f32x4*)(xr + c) + g * y; ss += (v[j][0] * v[j][0] + v[j][1] * v[j][1]) + (v[j][2] * v[j][2] + v[j][3] * v[j][3]); }
        const float rs = 1.0f / sqrtf(wave_sum(ss) * (1.0f / D) + EPS);
#pragma unroll
        for (int j = 0; j < 4; ++j) { const int c = 4 * lane + 256 * j; *(f32x4*)(xr + c) = v[j] * rs * *(const f32x4*)(p.final_g + c); }
    }
}

typedef __attribute__((address_space(4))) const P* KArgs;
#define LOADP(p) asm volatile("" : "+s"(kp)); P p; __builtin_memcpy(&p, kp, sizeof(P))
__global__ void __launch_bounds__(NTHREADS, 2) mk_fwd(P p_unused) {
    extern __shared__ __attribute__((aligned(16))) unsigned char lds[];
    cg::grid_group grid = cg::this_grid();
    KArgs kp = (KArgs)__builtin_amdgcn_kernarg_segment_ptr();
    const int G = gridDim.x, NGW = G * NWAVES;
#define IDS() const int tid = otid(), lane = tid & 63, wave = __builtin_amdgcn_readfirstlane(tid >> 6), gw = blockIdx.x * NWAVES + wave; (void)tid; (void)lane; (void)gw; (void)wave
    PG8_LAS unsigned char* glds = (PG8_LAS unsigned char*)lds;
    volatile unsigned* bst = (volatile unsigned*)(lds + LDS_BYTES - 128);
    if (otid() == 0) { bst[0] = 0u; bst[1] = 0u; }
    __syncthreads();
    { LOADP(p); (void)xcd_barrier_post((unsigned*)(p.ws + WS_CTL) + CW_BAR, bst); }
#define GSYNC() do { LOADP(pb_); XcdBarrier bb_; bb_.bar = (unsigned*)(pb_.ws + WS_CTL) + CW_BAR; bb_.x = xb_xcc_id(); bb_.st = (volatile unsigned*)(lds + LDS_BYTES - 128); xcd_barrier(bb_); } while (0)

    { PH_BEGIN(31);
    {
        LOADP(p); IDS(); unsigned char* ws = p.ws;
        float* scr = (float*)(lds + wave * CONV_WLDS);
        for (int rep = 0; rep < REP_P0; ++rep)
        for (int l = 0; l < DEPTH; ++l) {
            convert_T(D, 8240, (bf16_t*)(ws + WB_WIN + l * WIN_BYTES), NIN, SmWin{p.w_in + (size_t)l * D * 8240}, scr, (gw + 37 * l) % NGW, NGW, lane);
            convert_T(512, D, (bf16_t*)(ws + WB_WO + (l * 3 + 0) * WO_BYTES), D, SmPlain{p.w_o_a + (size_t)l * 512 * D}, scr, (gw + 300 + 700 * l) % NGW, NGW, lane);
            convert_T(512, D, (bf16_t*)(ws + WB_WO + (l * 3 + 1) * WO_BYTES), D, SmPlain{p.w_o_b + (size_t)l * 512 * D}, scr, (gw + 556 + 700 * l) % NGW, NGW, lane);
            convert_T(512, D, (bf16_t*)(ws + WB_WO + (l * 3 + 2) * WO_BYTES), D, SmPlain{p.w_o_c + (size_t)l * 512 * D}, scr, (gw + 812 + 700 * l) % NGW, NGW, lane);
            convert_T(D, D, (bf16_t*)(ws + WB_WOUT + l * WOUT_BYTES), D, SmPlain{p.w_out + (size_t)l * D * D}, scr, (gw + 1068 + 512 * l) % NGW, NGW, lane);
        }
        convert_T(D, DFF, (bf16_t*)(ws + WB_WUP), NUP, SmUp{p.ffn_w1, (long)(p.ffn_w3 - p.ffn_w1)}, scr, (gw + 1500) % NGW, NGW, lane);
        convert_T(DFF, D, (bf16_t*)(ws + WB_WDN), D, SmPlain{p.ffn_w2}, scr, (gw + 900) % NGW, NGW, lane);
        __syncthreads();
        phase_mod(p, lds);
    }
    PH_END(31); }
    grid.sync();

    for (int l = 0; l < DEPTH; ++l) {
        const bool last = (l == DEPTH - 1);
        const int Mrows = last ? TL : T;
{ PH_BEGIN((l * 16 + 0));
        for (int rep = 0; rep < REP_ELT; ++rep)
        { LOADP(p); IDS(); unsigned char* ws = p.ws;
          phase_modulate(l == 0 ? p.x : p.out, l == 0 ? p.ctx : (const float*)(ws + WS_XC), T, p.norm1_g + l * D, (const float*)(ws + WS_MOD) + (size_t)l * 9 * 6144, 0, (bf16_t*)(ws + WS_H), nullptr, nullptr, nullptr, nullptr, gw, NGW, lane); }
        PH_END((l * 16 + 0)); }
        GSYNC();
{ PH_BEGIN((l * 16 + 1));
        for (int rep = 0; rep < REP_WIN; ++rep)
        { LOADP(p); unsigned char* ws = p.ws;
            pg8::Gemm g{(const bf16_t*)(ws + WS_H), (const bf16_t*)(ws + WB_WIN + l * WIN_BYTES), T, NIN, D, D};
            EpiWin E{(bf16_t*)(ws + WS_PAQ), (bf16_t*)(ws + WS_PZ), (bf16_t*)(ws + WS_PB), (bf16_t*)(ws + WS_PC), (bf16_t*)(ws + WS_PG), (float*)(ws + WS_SMALL)};
            WinLastOrder S; S.so.init(last ? TL : T, NIN, G, (int)blockIdx.x); S.G = G; S.c = (int)blockIdx.x; S.nextra = last ? (TC / 256) * 12 : 0;
            pg8::gemm_phase<EpiWin, WinLastOrder, true, true>(glds, g, S, E);
        }
        PH_END((l * 16 + 1)); }
        GSYNC();
{ PH_BEGIN((l * 16 + 2));
        for (int rep = 1; rep < REP_SYNC; ++rep) GSYNC();
        { LOADP(p); IDS(); phase_prep(p, l, lds, gw, NGW, lane); }
        PH_END((l * 16 + 2)); }
        GSYNC();
{ PH_BEGIN((l * 16 + 3));
        { LOADP(p); phase_mix(p, l, lds); }
        PH_END((l * 16 + 3)); }
        GSYNC();
{ PH_BEGIN((l * 16 + 4));
        { LOADP(p); IDS(); phase_post(p, l, Mrows, gw, NGW, lane); }
        PH_END((l * 16 + 4)); }
        GSYNC();
{ PH_BEGIN((l * 16 + 5));
        for (int rep = 0; rep < REP_MERGE; ++rep)
        { LOADP(p); unsigned char* ws = p.ws;
            pg8::Gemm g{(const bf16_t*)(ws + WS_H), (const bf16_t*)(ws + WB_WO + (l * 3 + 0) * WO_BYTES), Mrows, D, 512, 512,
                        (const bf16_t*)(ws + WS_PAQ), (const bf16_t*)(ws + WS_YD), (const bf16_t*)(ws + WB_WO + (l * 3 + 1) * WO_BYTES), (const bf16_t*)(ws + WB_WO + (l * 3 + 2) * WO_BYTES)};
            MergeOrder S; S.so.init(Mrows, D, G, (int)blockIdx.x);
            EpiGate E{(bf16_t*)(ws + WS_DNQKV), (const bf16_t*)(ws + WS_PG)};
            pg8::gemm_phase<EpiGate, MergeOrder, true, true>(glds, g, S, E);
        }
        PH_END((l * 16 + 5)); }
        GSYNC();
{ PH_BEGIN((l * 16 + 6));
        for (int rep = 0; rep < (l == 0 ? REP_WOUT0 : 1); ++rep)
        { LOADP(p); unsigned char* ws = p.ws;
            pg8::Gemm g{(const bf16_t*)(ws + WS_DNQKV), (const bf16_t*)(ws + WB_WOUT + l * WOUT_BYTES), Mrows, D, D, D}; pg8::StaticOrder S; S.init(Mrows, D, G, (int)blockIdx.x);
            EpiResid E{l == 0 ? p.x : p.out, l == 0 ? p.ctx : (const float*)(ws + WS_XC), p.out, (float*)(ws + WS_XC), (const float*)(ws + WS_MOD) + (size_t)l * 9 * 6144, 2};
            pg8::gemm_phase<EpiResid, pg8::StaticOrder, true, true>(glds, g, S, E);
        }
        PH_END((l * 16 + 6)); }
        GSYNC();
{ PH_BEGIN((l * 16 + 7));
        { LOADP(p); IDS(); unsigned char* ws = p.ws;
          phase_modulate(p.out, (const float*)(ws + WS_XC), Mrows, p.norm2_g + l * D, (const float*)(ws + WS_MOD) + (size_t)l * 9 * 6144, 3, (bf16_t*)(ws + WS_H), last ? p.router_w : nullptr, (int*)(ws + WS_ROUTE), (unsigned*)(ws + WS_CTL) + CW_ECNT, (unsigned*)lds, gw, NGW, lane); }
        PH_END((l * 16 + 7)); }
        if (!last) {
            GSYNC();
{ PH_BEGIN(8);
            for (int rep = 0; rep < REP_UP; ++rep)
            { LOADP(p); unsigned char* ws = p.ws;
                pg8::Gemm g{(const bf16_t*)(ws + WS_H), (const bf16_t*)(ws + WB_WUP), T, NUP, D, D}; pg8::StaticOrder S; S.init(T, NUP, G, (int)blockIdx.x);
                EpiSwiglu E{(bf16_t*)(ws + WS_H1), NUP / 256};
                pg8::gemm_phase<EpiSwiglu, pg8::StaticOrder, true, true>(glds, g, S, E);
            }
        PH_END(8); }
            GSYNC();
{ PH_BEGIN(9);
            { LOADP(p); unsigned char* ws = p.ws;
                pg8::Gemm g{(const bf16_t*)(ws + WS_H1), (const bf16_t*)(ws + WB_WDN), T, D, DFF, DFF}; pg8::StaticOrder S; S.init(T, D, G, (int)blockIdx.x);
                EpiResid E{p.out, (const float*)(ws + WS_XC), p.out, (float*)(ws + WS_XC), (const float*)(ws + WS_MOD) + (size_t)l * 9 * 6144, 5};
                pg8::gemm_phase<EpiResid, pg8::StaticOrder, true, true>(glds, g, S, E);
            }
        PH_END(9); }
            GSYNC();
        } else {
{ PH_BEGIN(24);
            { LOADP(p); IDS(); unsigned char* ws = p.ws;
                float* scr = (float*)(lds + wave * CONV_WLDS);
                for (int e = 0; e < NE; ++e) {
                    convert_T(D, DFF, (bf16_t*)(ws + WS_MWUP) + (size_t)e * NUP * D, NUP, SmUp{p.moe_w1 + (size_t)e * D * DFF, (long)(p.moe_w3 - p.moe_w1)}, scr, (gw + 211 * e) % NGW, NGW, lane);
                    convert_T(DFF, D, (bf16_t*)(ws + WS_MWDN) + (size_t)e * D * DFF, D, SmPlain{p.moe_w2 + (size_t)e * DFF * D}, scr, (gw + 173 * e + 1000) % NGW, NGW, lane); }
            }
        PH_END(24); }
            GSYNC();
{ PH_BEGIN(25);
            { LOADP(p); phase_moe_gather(p, lds); }
        PH_END(25); }
            GSYNC();
{ PH_BEGIN(26);
            for (int rep = 0; rep < REP_UP; ++rep)
            { LOADP(p); unsigned char* ws = p.ws; const int* misc = (const int*)(ws + WS_MISC);
                pg8::Gemm g{(const bf16_t*)(ws + WS_MA), (const bf16_t*)(ws + WS_MWUP), MOE_ROWS, NE * NUP, D, D};
                MoeOrder S{misc[MI_NTILES], NUP / 256, G, (int)blockIdx.x, misc + MI_TILEE};
                EpiSwiglu E{(bf16_t*)(ws + WS_MH1), NUP / 256};
                pg8::gemm_phase<EpiSwiglu, MoeOrder, true, true>(glds, g, S, E);
            }
        PH_END(26); }
            GSYNC();
{ PH_BEGIN(27);
            { LOADP(p); unsigned char* ws = p.ws; const int* misc = (const int*)(ws + WS_MISC);
                pg8::Gemm g{(const bf16_t*)(ws + WS_MH1), (const bf16_t*)(ws + WS_MWDN), MOE_ROWS, NE * D, DFF, DFF};
                MoeOrder S{misc[MI_NTILES], D / 256, G, (int)blockIdx.x, misc + MI_TILEE};
                EpiMoeDown E{(bf16_t*)(ws + WS_MA)};
                pg8::gemm_phase<EpiMoeDown, MoeOrder, true, true>(glds, g, S, E);
            }
        PH_END(27); }
            GSYNC();
{ PH_BEGIN(28);
            { LOADP(p); IDS(); phase_final(p, gw, NGW, lane); }
        PH_END(28); }
        }
    }
}

extern "C" void kernel_launch(void* const* d_in, const int* in_sizes, int n_in, void* d_out, int out_size, void* d_ws, size_t ws_size, hipStream_t stream) {
    static int grid_blocks = 0;
    if (grid_blocks == 0) {
        if (n_in != 30 || in_sizes[0] != TL * D || out_size != TL * D || ws_size < WS_END) {
            fprintf(stderr, "kernel_launch: built for 30 inputs, x/out of %d floats, >= %zu bytes of d_ws; got n_in %d, in0 %d, out %d, ws %zu; nothing launched\n", TL * D, (size_t)WS_END, n_in, n_in > 0 ? in_sizes[0] : -1, out_size, ws_size);
            grid_blocks = -1; return; }
        int dev = 0, cus = 0, per_cu = 0;
        hipGetDevice(&dev);
        hipDeviceGetAttribute(&cus, hipDeviceAttributeMultiprocessorCount, dev);
        hipFuncSetAttribute((const void*)mk_fwd, hipFuncAttributeMaxDynamicSharedMemorySize, LDS_BYTES);
        hipOccupancyMaxActiveBlocksPerMultiprocessor(&per_cu, (const void*)mk_fwd, NTHREADS, LDS_BYTES);
        if (per_cu < 1) { fprintf(stderr, "kernel_launch: occupancy query reports %d blocks/CU; nothing launched\n", per_cu); grid_blocks = -1; return; }
        grid_blocks = cus;
    }
    if (grid_blocks < 0) return;
    hipMemsetAsync((char*)d_ws + WS_CTL, 0, CTL_BYTES, stream);
    P p{};
    const float** f = (const float**)&p;
    for (int i = 0; i < 30; ++i) f[i] = (const float*)d_in[i];
    p.out = (float*)d_out; p.ws = (unsigned char*)d_ws;
    void* args[] = {&p};
    hipError_t e = hipLaunchCooperativeKernel((const void*)mk_fwd, dim3(grid_blocks), dim3(NTHREADS), args, LDS_BYTES, stream);
    if (e != hipSuccess) fprintf(stderr, "kernel_launch: cooperative launch failed: %s (grid %d)\n", hipGetErrorString(e), grid_blocks);
}
```

```cpp
#include <hip/hip_runtime.h>
#include <hip/hip_cooperative_groups.h>
#include <cstdio>
#include <cstdint>
namespace cg = cooperative_groups;
#ifndef REP_P0
#define REP_P0 1
#endif
#ifndef REP_WIN
#define REP_WIN 1
#endif
#ifndef REP_CHAIN
#define REP_CHAIN 1
#endif
#ifndef REP_UP
#define REP_UP 1
#endif
#ifndef REP_SYNC
#define REP_SYNC 1
#endif
#ifndef REP_ATT
#define REP_ATT 1
#endif
#ifndef REP_DNPREP
#define REP_DNPREP 1
#endif
#ifndef REP_ELT
#define REP_ELT 1
#endif
#ifndef REP_DN
#define REP_DN REP_CHAIN
#endif
#ifndef REP_GLA
#define REP_GLA REP_CHAIN
#endif
#ifndef REP_MERGE
#define REP_MERGE 1
#endif
#ifndef REP_WOUT0
#define REP_WOUT0 1
#endif
#ifndef PROBE_MASK
#define PROBE_MASK 0u
#endif
#define PH_BEGIN(k) const unsigned long long pt0_ = ((PROBE_MASK >> (k)) & 1u) ? __builtin_amdgcn_s_memrealtime() : 0ull
#define PH_END(k) do { if ((PROBE_MASK >> (k)) & 1u) { const unsigned long long pt1_ = __builtin_amdgcn_s_memrealtime(); while (__builtin_amdgcn_s_memrealtime() - pt1_ < pt1_ - pt0_) __builtin_amdgcn_s_sleep(4); } } while (0)

namespace pg8 {
#define PG8_LAS __attribute__((address_space(3)))
typedef unsigned short bf16_t;
typedef short bf16x8 __attribute__((ext_vector_type(8)));
typedef float f32x4 __attribute__((ext_vector_type(4)));
typedef unsigned u32x4 __attribute__((ext_vector_type(4)));
constexpr int BM = 256, BK = 64, HALF = 128, HTB = HALF * BK * 2  , STAGE_BYTES = 8 * HTB, NXCD = 8, WGM = 8;

__host__ __device__ __forceinline__ int lds_byte(int r, int c) { const int st = (r >> 4) * 2 + (c >> 5), rr = r & 15, cc = c & 31, ob = rr * 64 + cc * 2; return st * 1024 + (ob ^ (((ob >> 9) & 1) << 5)); }
__host__ __device__ __forceinline__ void stage_rc(int b, int& R, int& C) { const int st = b / 1024, sb = b % 1024, swz = sb ^ (((sb >> 9) & 1) << 5); R = (st >> 1) * 16 + swz / 64; C = (st & 1) * 32 + (swz % 64) / 2; }
__host__ __device__ __forceinline__ int perm32(int rho) { const int n = rho >> 4, i = rho & 15; return 8 * (i >> 2) + 4 * n + (i & 3); }

struct Unit { int pm, pn, br; };
struct Gemm { const bf16_t* A; const bf16_t* Bt; int M, N, K, lda; const bf16_t* A1; const bf16_t* A2; const bf16_t* B1; const bf16_t* B2; };

struct StaticOrder {
    int nM, nN, nwg, G, c;
    __host__ __device__ void init(int M, int N, int G_, int c_) { nM = M / BM; nN = N / BM; nwg = nM * nN; G = G_; c = c_; }
    __host__ __device__ bool next(int i, Unit& u) const {
        const long L = (long)i * G + c; if (L >= nwg) return false;
        int wgid = (int)L; { const int q = nwg / NXCD, r = nwg % NXCD, xcd = wgid % NXCD, off = wgid / NXCD; wgid = (xcd < r ? xcd * (q + 1) : r * (q + 1) + (xcd - r) * q) + off; }
        const int nig = WGM * nN, gid = wgid / nig, fm = gid * WGM, gsz = (nM - fm) < WGM ? (nM - fm) : WGM;
        u.pm = fm + ((wgid % nig) % gsz); u.pn = (wgid % nig) / gsz; u.br = 0; return true;
    }
    __device__ __forceinline__ void a_ready(const Unit&) const {}
    __device__ __forceinline__ void done(const Unit&) const {}
};


template <class Epi, class Sched, bool ALIGN_EPI = false, bool SP2 = false>
__device__ __forceinline__ void gemm_phase(PG8_LAS unsigned char* lds, const Gemm g, const Sched& S, const Epi& E) {
    int tid_o = threadIdx.x; asm volatile("" : "+v"(tid_o));
    const int tid = tid_o, wid = __builtin_amdgcn_readfirstlane(tid >> 6), lane = tid & 63, wr = wid >> 2, wc = wid & 3, fr = lane & 15, fq = lane >> 4;
    const int K = g.K, nt = K / BK;
    unsigned voffA[2], voffB[2];
#pragma unroll
    for (int i = 0; i < 2; ++i) { int R, C; stage_rc(tid * 16 + i * 8192, R, C); const int Rb = Epi::PERM ? ((R & ~31) + perm32(R & 31)) : R;
        voffA[i] = (unsigned)(R * g.lda + C) * 2u; voffB[i] = (unsigned)(Rb * K + C) * 2u; }
    const size_t kstep = (size_t)(BK * 2);
    const size_t hstepA = (size_t)HALF * g.lda * 2, hstepB = (size_t)HALF * K * 2;
    const size_t tstepA = 2 * hstepA, tstepB = 2 * hstepB;
    const unsigned ldsw = (unsigned)wid * 1024u;
    const int aoff = lds_byte(wr * 64 + fr, fq * 8), boff = lds_byte(wc * 32 + fr, fq * 8);
#define PG8_SA(b, h) (((b) * 2 + (h)) * HTB)
#define PG8_SB(b, h) ((4 + (b) * 2 + (h)) * HTB)
#define PG8_STAGE(bufoff, gbase, voff) do { _Pragma("unroll") for (int _i = 0; _i < 2; ++_i) \
        __builtin_amdgcn_global_load_lds((const unsigned*)((const char*)(gbase) + (voff)[_i]), (PG8_LAS unsigned*)(lds + (bufoff) + ldsw + _i * 8192), 16, 0, 0); } while (0)
#define PG8_LDA(dst, b, h) do { _Pragma("unroll") for (int m = 0; m < 4; ++m) _Pragma("unroll") for (int k = 0; k < 2; ++k) dst[m][k] = *(const PG8_LAS bf16x8*)(lds + PG8_SA(b, h) + aoff + m * 2048 + k * 1024); } while (0)
#define PG8_LDB(dst, b, h) do { _Pragma("unroll") for (int n = 0; n < 2; ++n) _Pragma("unroll") for (int k = 0; k < 2; ++k) dst[n][k] = *(const PG8_LAS bf16x8*)(lds + PG8_SB(b, h) + boff + n * 2048 + k * 1024); } while (0)
#define PG8_MMA(ai, bj, At, Bt) do { __builtin_amdgcn_s_setprio(1); _Pragma("unroll") for (int m = 0; m < 4; ++m) _Pragma("unroll") for (int n = 0; n < 2; ++n) _Pragma("unroll") for (int k = 0; k < 2; ++k) \
        acc[ai][bj][m][n] = __builtin_amdgcn_mfma_f32_16x16x32_bf16(Bt[n][k], At[m][k], acc[ai][bj][m][n], 0, 0, 0); __builtin_amdgcn_s_setprio(0); } while (0)
#define PG8_WAIT_V(n) asm volatile("s_waitcnt vmcnt(" #n ")" ::: "memory")
#define PG8_WAIT_L(n) asm volatile("s_waitcnt lgkmcnt(" #n ")" ::: "memory")
#define PG8_BAR __builtin_amdgcn_s_barrier()
#define PG8_SCHED __builtin_amdgcn_sched_barrier(0)
    Unit cur, nxt; int ui = 0;
    if (!S.next(0, cur)) return;
    f32x4 acc[2][2][4][2];
#pragma unroll
    for (int a = 0; a < 2; ++a)
#pragma unroll
        for (int b = 0; b < 2; ++b)
#pragma unroll
            for (int m = 0; m < 4; ++m)
#pragma unroll
                for (int n = 0; n < 2; ++n) acc[a][b][m][n] = (f32x4){0.f, 0.f, 0.f, 0.f};
    bf16x8 At[4][2], B0[2][2], B1[2][2];
    const char* cA = (const char*)(cur.br == 0 ? g.A : cur.br == 1 ? g.A1 : g.A2) + (size_t)cur.pm * tstepA; const char* cB = (const char*)(cur.br == 0 ? g.Bt : cur.br == 1 ? g.B1 : g.B2) + (size_t)cur.pn * tstepB;
    S.a_ready(cur);
    if constexpr (SP2) {
        PG8_STAGE(PG8_SB(0, 0), cB, voffB); PG8_STAGE(PG8_SB(0, 1), cB + hstepB, voffB); PG8_STAGE(PG8_SA(0, 0), cA, voffA); PG8_STAGE(PG8_SA(0, 1), cA + hstepA, voffA);
        if (wr == 1) PG8_BAR;
        PG8_WAIT_V(2); PG8_BAR;
        PG8_STAGE(PG8_SB(1, 0), cB + kstep, voffB); PG8_STAGE(PG8_SA(1, 0), cA + kstep, voffA); PG8_STAGE(PG8_SB(1, 1), cB + hstepB + kstep, voffB);
        PG8_WAIT_V(6); PG8_BAR;
    } else {
        PG8_STAGE(PG8_SB(0, 0), cB, voffB); PG8_STAGE(PG8_SA(0, 0), cA, voffA); PG8_STAGE(PG8_SB(0, 1), cB + hstepB, voffB); PG8_STAGE(PG8_SA(0, 1), cA + hstepA, voffA);
        if (wr == 1) PG8_BAR;
        PG8_WAIT_V(4); PG8_BAR;
        PG8_STAGE(PG8_SB(1, 0), cB + kstep, voffB); PG8_STAGE(PG8_SA(1, 0), cA + kstep, voffA); PG8_STAGE(PG8_SB(1, 1), cB + hstepB + kstep, voffB);
        PG8_WAIT_V(6); PG8_BAR;
    }
    for (;;) {
        const bool has_next = S.next(ui + 1, nxt);
        const char* nA = has_next ? (const char*)(nxt.br == 0 ? g.A : nxt.br == 1 ? g.A1 : g.A2) + (size_t)nxt.pm * tstepA : cA; const char* nB = has_next ? (const char*)(nxt.br == 0 ? g.Bt : nxt.br == 1 ? g.B1 : g.B2) + (size_t)nxt.pn * tstepB : cB;
        for (int t = 0; t < nt; t += 2) {
            const bool last = (t == nt - 2);
            const char* a1 = cA + (size_t)(t + 1) * kstep;
            const char* a2 = last ? nA : cA + (size_t)(t + 2) * kstep; const char* b2 = last ? nB : cB + (size_t)(t + 2) * kstep;
            const char* a3 = a2 + kstep; const char* b3 = b2 + kstep;
            if (last && has_next) S.a_ready(nxt);
            if constexpr (SP2) {
            PG8_LDB(B0, 0, 0); PG8_LDB(B1, 0, 1); PG8_SCHED; PG8_LDA(At, 0, 0); PG8_STAGE(PG8_SA(1, 1), a1 + hstepA, voffA);
            PG8_WAIT_V(8); PG8_WAIT_L(0); PG8_BAR; PG8_MMA(0, 0, At, B0); PG8_MMA(0, 1, At, B1); PG8_BAR; PG8_SCHED;
            PG8_LDA(At, 0, 1); PG8_STAGE(PG8_SB(0, 0), b2, voffB); PG8_STAGE(PG8_SB(0, 1), b2 + hstepB, voffB); PG8_STAGE(PG8_SA(0, 0), a2, voffA);
            PG8_WAIT_V(8); PG8_WAIT_L(0); PG8_BAR; PG8_MMA(1, 0, At, B0); PG8_MMA(1, 1, At, B1); PG8_BAR; PG8_SCHED;
            PG8_LDB(B0, 1, 0); PG8_LDB(B1, 1, 1); PG8_SCHED; PG8_LDA(At, 1, 0); PG8_STAGE(PG8_SA(0, 1), a2 + hstepA, voffA);
            PG8_WAIT_V(8); PG8_WAIT_L(0); PG8_BAR; PG8_MMA(0, 0, At, B0); PG8_MMA(0, 1, At, B1); PG8_BAR; PG8_SCHED;
            PG8_LDA(At, 1, 1); PG8_STAGE(PG8_SB(1, 0), b3, voffB); PG8_STAGE(PG8_SB(1, 1), b3 + hstepB, voffB); PG8_STAGE(PG8_SA(1, 0), a3, voffA);
            PG8_WAIT_V(8); PG8_WAIT_L(0); PG8_BAR; PG8_MMA(1, 0, At, B0); PG8_MMA(1, 1, At, B1); PG8_BAR; PG8_SCHED;
            } else {
            PG8_LDB(B0, 0, 0); PG8_SCHED; PG8_LDA(At, 0, 0); PG8_STAGE(PG8_SA(1, 1), a1 + hstepA, voffA);
            PG8_WAIT_L(8); PG8_BAR; PG8_WAIT_L(0); PG8_MMA(0, 0, At, B0); PG8_BAR; PG8_SCHED;
            PG8_LDB(B1, 0, 1); PG8_STAGE(PG8_SB(0, 0), b2, voffB);
            PG8_BAR; PG8_WAIT_L(0); PG8_MMA(0, 1, At, B1); PG8_BAR;
            PG8_LDA(At, 0, 1); PG8_STAGE(PG8_SA(0, 0), a2, voffA);
            PG8_BAR; PG8_WAIT_L(0); PG8_MMA(1, 0, At, B0); PG8_BAR; PG8_SCHED;
            PG8_STAGE(PG8_SB(0, 1), b2 + hstepB, voffB);
            PG8_WAIT_V(6); PG8_BAR; PG8_MMA(1, 1, At, B1); PG8_BAR;
            PG8_LDB(B0, 1, 0); PG8_SCHED; PG8_LDA(At, 1, 0); PG8_STAGE(PG8_SA(0, 1), a2 + hstepA, voffA);
            PG8_WAIT_L(8); PG8_BAR; PG8_WAIT_L(0); PG8_MMA(0, 0, At, B0); PG8_BAR; PG8_SCHED;
            PG8_LDB(B1, 1, 1); PG8_STAGE(PG8_SB(1, 0), b3, voffB);
            PG8_BAR; PG8_WAIT_L(0); PG8_MMA(0, 1, At, B1); PG8_BAR;
            PG8_LDA(At, 1, 1); PG8_STAGE(PG8_SA(1, 0), a3, voffA);
            PG8_BAR; PG8_WAIT_L(0); PG8_MMA(1, 0, At, B0); PG8_BAR; PG8_SCHED;
            PG8_STAGE(PG8_SB(1, 1), b3 + hstepB, voffB);
            PG8_WAIT_V(6); PG8_BAR; PG8_MMA(1, 1, At, B1); PG8_BAR;
            }
        }
        if constexpr (ALIGN_EPI) { if (wr == 0) PG8_BAR; }
        if constexpr (!Epi::AFTER_DRAIN) { E(acc, cur, wr, wc, fr, fq); S.done(cur); }
        if (!has_next) break;
        if (!(Epi::CHAIN && nxt.br != 0)) {
#pragma unroll
        for (int a = 0; a < 2; ++a)
#pragma unroll
            for (int b = 0; b < 2; ++b)
#pragma unroll
                for (int m = 0; m < 4; ++m)
#pragma unroll
                    for (int n = 0; n < 2; ++n) acc[a][b][m][n] = (f32x4){0.f, 0.f, 0.f, 0.f};
        }
        cur = nxt; cA = nA; cB = nB; ++ui;
        if constexpr (ALIGN_EPI) { if (wr == 1) PG8_BAR; }
    }
    PG8_WAIT_V(0);
    if constexpr (!ALIGN_EPI) { if (wr == 0) PG8_BAR; }
    PG8_BAR;
    if constexpr (Epi::AFTER_DRAIN) { E.fused(acc, cur, wr, wc, fr, fq, lds, wid, lane); S.done(cur); }
#undef PG8_SA
#undef PG8_SB
#undef PG8_STAGE
#undef PG8_LDA
#undef PG8_LDB
#undef PG8_MMA
#undef PG8_WAIT_V
#undef PG8_WAIT_L
#undef PG8_BAR
#undef PG8_SCHED
}
}


constexpr int BATCH = 8, SEQ = 2048, CTXL = 256, D = 1024, DEPTH = 2;
constexpr int TL = BATCH * SEQ, TC = BATCH * CTXL, T = TL + TC;
constexpr int NIN = 8448;
constexpr int DFF = 2816, NE = 8, NUP = 2 * DFF;
constexpr int MOE_ROWS = 2 * TL + NE * 256;
constexpr float EPS = 1e-6f;
constexpr int NTHREADS = 512, NWAVES = 8;
constexpr int LDS_BYTES = 163840;

typedef unsigned short bf16_t;
typedef float f32x4 __attribute__((ext_vector_type(4)));
typedef float f32x16 __attribute__((ext_vector_type(16)));
typedef unsigned u32x4 __attribute__((ext_vector_type(4)));
typedef unsigned u32x2 __attribute__((ext_vector_type(2)));
typedef short bf16x8 __attribute__((ext_vector_type(8)));
typedef short s16x4 __attribute__((ext_vector_type(4)));

constexpr size_t al256(size_t x) { return (x + 255) & ~(size_t)255; }
constexpr size_t WS_CTL   = 0;                                   constexpr size_t CTL_BYTES = 65536;
constexpr size_t WS_MOD   = WS_CTL + CTL_BYTES;                  constexpr size_t MOD_BYTES = (size_t)DEPTH * 9 * 6 * D * 4;
constexpr size_t WS_ROUTE = al256(WS_MOD + MOD_BYTES);           constexpr size_t ROUTE_BYTES = (size_t)TL * 16;
constexpr size_t WS_SLOT  = al256(WS_ROUTE + ROUTE_BYTES);       constexpr size_t SLOT_BYTES = (size_t)TL * 8;
constexpr size_t WS_MISC  = al256(WS_SLOT + SLOT_BYTES);         constexpr size_t MISC_BYTES = 4096;
constexpr size_t WS_GB    = al256(WS_MISC + MISC_BYTES);         constexpr size_t GB_BYTES = (size_t)T * 16 * 4;
constexpr size_t WS_SMALL = al256(WS_GB + GB_BYTES);             constexpr size_t SMALL_BYTES = (size_t)T * 64 * 4;
constexpr size_t WS_XC    = al256(WS_SMALL + SMALL_BYTES);       constexpr size_t XC_BYTES = (size_t)TC * D * 4;
constexpr size_t WS_WB    = al256(WS_XC + XC_BYTES);
constexpr size_t WB_WIN   = WS_WB;                               constexpr size_t WIN_BYTES = (size_t)NIN * D * 2;
constexpr size_t WB_WUP   = WB_WIN + DEPTH * WIN_BYTES;          constexpr size_t WUP_BYTES = (size_t)NUP * D * 2;
constexpr size_t WB_WDN   = WB_WUP + WUP_BYTES;                  constexpr size_t WDN_BYTES = (size_t)D * DFF * 2;
constexpr size_t WB_WO    = WB_WDN + WDN_BYTES;                  constexpr size_t WO_BYTES = (size_t)D * 512 * 2;
constexpr size_t WB_WOUT  = WB_WO + DEPTH * 3 * WO_BYTES;        constexpr size_t WOUT_BYTES = (size_t)D * D * 2;
constexpr size_t WB_END   = WB_WOUT + DEPTH * WOUT_BYTES;
constexpr size_t WS_H     = al256(WB_END);                       constexpr size_t H_BYTES = (size_t)T * D * 2;
constexpr size_t WS_PAQ   = al256(WS_H + H_BYTES);               constexpr size_t PAQ_BYTES = (size_t)T * 1536 * 2;
constexpr size_t WS_PZ    = al256(WS_PAQ + PAQ_BYTES);           constexpr size_t PZ_BYTES = (size_t)T * 512 * 2;
constexpr size_t WS_PB    = al256(WS_PZ + PZ_BYTES);             constexpr size_t PB_BYTES = (size_t)T * 1536 * 2;
constexpr size_t WS_PC    = al256(WS_PB + PB_BYTES);             constexpr size_t PC_BYTES = (size_t)T * 1536 * 2;
constexpr size_t WS_PG    = al256(WS_PC + PC_BYTES);             constexpr size_t PG_BYTES = (size_t)T * 3072 * 2;
constexpr size_t WS_DNQKV = al256(WS_PG + PG_BYTES);             constexpr size_t DNQKV_BYTES = (size_t)T * 1536 * 2;
constexpr size_t WS_TQ    = al256(WS_DNQKV + DNQKV_BYTES);       constexpr size_t TQ_BYTES = (size_t)BATCH * 4 * 2 * ((CTXL + SEQ) / 64) * 16384;
constexpr size_t WS_VEC   = al256(WS_TQ + TQ_BYTES);             constexpr size_t VEC_BYTES = (size_t)BATCH * 4 * 2 * ((CTXL + SEQ) / 64) * 1024;
constexpr size_t WS_END   = al256(WS_VEC + VEC_BYTES);
static_assert(WS_END <= (size_t)524288000, "d_ws map exceeds 500 MiB (documented minimum is 525,980,800 B)");
constexpr size_t WS_YD    = WS_PAQ + (size_t)2 * T * 512 * 2;
static_assert((size_t)3 * T * 512 * 2 <= PAQ_BYTES, "yd overlay");
constexpr size_t WS_H1    = WS_PB;
static_assert((size_t)T * DFF * 2 <= PB_BYTES + PC_BYTES, "h1 overlay");
constexpr size_t WS_MWDN  = WS_WB;                                constexpr size_t MWDN_BYTES = (size_t)NE * D * DFF * 2;
static_assert(MWDN_BYTES <= WB_WO - WS_WB, "moe wdn overlay: must not reach layer 1's w_o / w_out copies (live until its merge / w_out GEMMs)");
constexpr size_t WS_MWUP  = WS_PAQ;                               constexpr size_t MWUP_BYTES = (size_t)NE * NUP * D * 2;
constexpr size_t WS_MA    = al256(WS_MWUP + MWUP_BYTES);          constexpr size_t MA_BYTES = (size_t)MOE_ROWS * D * 2;
constexpr size_t WS_MH1   = al256(WS_MA + MA_BYTES);              constexpr size_t MH1_BYTES = (size_t)MOE_ROWS * DFF * 2;
static_assert(WS_MH1 + MH1_BYTES <= WS_END, "moe overlay");
constexpr int CW_QUEUE = 0;
constexpr int CW_KMAX = 256;
constexpr int CW_ECNT = 512;
constexpr int CW_EFILL = 576;
constexpr int CW_BAR = 4096;
constexpr int MI_LAMF = 0;
constexpr int MI_NTILES = 16;
constexpr int MI_EOFF = 32;
constexpr int MI_TILEE = 64;

typedef __bf16 bf16v2_t __attribute__((ext_vector_type(2)));
typedef float f32v2_t __attribute__((ext_vector_type(2)));
__device__ __forceinline__ unsigned pk2(float lo, float hi) { const f32v2_t v = {lo, hi}; return __builtin_bit_cast(unsigned, __builtin_convertvector(v, bf16v2_t)); }
__device__ __forceinline__ unsigned f2bf(float f) { return pk2(f, 0.f) & 0xffffu; }
__device__ __forceinline__ float bflo(unsigned w) { return __builtin_bit_cast(float, w << 16); }
__device__ __forceinline__ float bfhi(unsigned w) { return __builtin_bit_cast(float, w & 0xffff0000u); }
__device__ __forceinline__ float bf2f(bf16_t h) { return __builtin_bit_cast(float, (unsigned)h << 16); }
__device__ __forceinline__ int otid() { int t = threadIdx.x; asm volatile("" : "+v"(t)); return t; }
__device__ __forceinline__ float shx(float v, int o) { const int idx = ((otid() & 63) ^ o) << 2; return __builtin_bit_cast(float, __builtin_amdgcn_ds_bpermute(idx, __builtin_bit_cast(int, v))); }
__device__ __forceinline__ float shup(float v, int o) { const int idx = (((otid() & 63) - o) & 63) << 2; return __builtin_bit_cast(float, __builtin_amdgcn_ds_bpermute(idx, __builtin_bit_cast(int, v))); }
__device__ __forceinline__ float shlane(float v, int src) { return __builtin_bit_cast(float, __builtin_amdgcn_ds_bpermute(src << 2, __builtin_bit_cast(int, v))); }
__device__ __forceinline__ int shlane_i(int v, int src) { return __builtin_amdgcn_ds_bpermute(src << 2, v); }
__device__ __forceinline__ float wave_sum(float v) {
#pragma unroll
    for (int o = 1; o < 64; o <<= 1) v += shx(v, o);
    return v;
}
__device__ __forceinline__ float sigmoidf_(float x) { return __builtin_amdgcn_rcpf(1.0f + __expf(-x)); }
__device__ __forceinline__ float siluf_(float x) { return x * __builtin_amdgcn_rcpf(1.0f + __expf(-x)); }
__device__ __forceinline__ float softplusf_(float x) { return x > 20.f ? x : (x < -10.f ? __expf(x) : 0.6931471806f * __builtin_amdgcn_logf(1.0f + __builtin_amdgcn_exp2f(1.4426950409f * x))); }
__device__ __forceinline__ float logsigmoidf_(float x) { return fminf(x, 0.f) - log1pf(expf(-fabsf(x))); }
__device__ __forceinline__ float logsigmoid_fast(float z) { z = fmaxf(z, -80.f); return -0.6931471806f * __builtin_amdgcn_logf(1.0f + __builtin_amdgcn_exp2f(-1.4426950409f * z)); }

struct P {
    const float *x, *c, *ctx, *c_ctx, *w_mod, *b_mod, *norm1_g, *norm2_g, *w_in, *conv_a, *a_log, *dt_bias, *gn_a, *w_gate2, *b_gate, *gn_b,
                *lam_c, *gn_c, *w_o_a, *w_o_b, *w_o_c, *w_out, *ffn_w1, *ffn_w3, *ffn_w2, *router_w, *moe_w1, *moe_w3, *moe_w2, *final_g;
    float* out; unsigned char* ws;
};

constexpr long SM_ZERO = (long)1 << 62;
template <class SrcMap>
__device__ __forceinline__ void convert_T(int K, int ldw, bf16_t* WT, int Nrows, SrcMap sm, float* scr  , int gw, int NGW, int lane) {
    const int nblk = Nrows / 64, items = (K / 64) * nblk;
    for (int it = gw; it < items; it += NGW) {
        const int kb = it / nblk, nb = it % nblk, k0 = 64 * kb, n0 = 64 * nb;
        const long so_ = sm(n0 + 4 * (lane & 15)); const float* src = sm.W + (so_ != SM_ZERO ? so_ : 0L);
        f32x4 v[16];
#pragma unroll
        for (int i = 0; i < 16; ++i) { const int kk = 4 * i + (lane >> 4); const f32x4 ld = *(const f32x4*)(src + (size_t)(k0 + kk) * ldw); v[i] = so_ != SM_ZERO ? ld : (f32x4){0.f, 0.f, 0.f, 0.f}; }
#pragma unroll
        for (int i = 0; i < 16; ++i) { const int kk = 4 * i + (lane >> 4); float* d = scr + kk * 65 + 4 * (lane & 15); d[0] = v[i][0]; d[1] = v[i][1]; d[2] = v[i][2]; d[3] = v[i][3]; }
        asm volatile("s_waitcnt lgkmcnt(0)" ::: "memory");
        const int c = lane & 7;
#pragma unroll
        for (int j = 0; j < 8; ++j) { const int n = (lane >> 3) + 8 * j; const float* s = scr + (8 * c) * 65 + n;
            u32x4 o; o.x = pk2(s[0 * 65], s[1 * 65]); o.y = pk2(s[2 * 65], s[3 * 65]); o.z = pk2(s[4 * 65], s[5 * 65]); o.w = pk2(s[6 * 65], s[7 * 65]);
            *(u32x4*)(WT + (size_t)(n0 + n) * K + k0 + 8 * c) = o; }
        asm volatile("s_waitcnt lgkmcnt(0)" ::: "memory");
    }
}
struct SmPlain { const float* W; __device__ long operator()(int n) const { return n; } };
struct SmWin { const float* W; __device__ long operator()(int n) const {
    if (n < 2048) return n; if (n < 3584) return n + 16; if (n < 8192) return n + 48;
    const int j = n - 8192; if (j < 16) return 2048 + j; if (j < 48) return 3600 + (j - 16); return SM_ZERO; } };
struct SmUp { const float* W; long d31; __device__ long operator()(int n) const {
    const int tile = n >> 8, rr = n & 255; return (rr < 128 ? 0L : d31) + tile * 128 + (rr & 127); } };
constexpr int MOE_CV_SPLIT = 8;
constexpr int CONV_WLDS = 64 * 65 * 4;
typedef const f32x4 (&AccRef)[2][2][4][2];
struct EpiWin {
    static constexpr bool PERM = true, AFTER_DRAIN = false, CHAIN = false;
    bf16_t *paq, *pz, *pb, *pc, *pg; float* small_;
    __device__ __forceinline__ void operator()(AccRef acc, const pg8::Unit& u, int wr, int wc, int fr, int fq) const {
        const int row0 = u.pm * 256 + wr * 64 + fr, pn = u.pn;
        if (pn == 32) {
            if (wc < 2) {
#pragma unroll
                for (int ai = 0; ai < 2; ++ai)
#pragma unroll
                    for (int m = 0; m < 4; ++m) { float* p = small_ + (size_t)(row0 + ai * 128 + m * 16) * 64 + wc * 32 + 8 * fq;
                        *(f32x4*)p = acc[ai][0][m][0]; *(f32x4*)(p + 4) = acc[ai][0][m][1]; }
            }
            return;
        }
        bf16_t* base; int ldc, c0;
        if (pn < 6) { base = paq; ldc = 1536; c0 = pn * 256; } else if (pn < 8) { base = pz; ldc = 512; c0 = (pn - 6) * 256; }
        else if (pn < 14) { base = pb; ldc = 1536; c0 = (pn - 8) * 256; } else if (pn < 20) { base = pc; ldc = 1536; c0 = (pn - 14) * 256; }
        else { base = pg; ldc = 3072; c0 = (pn - 20) * 256; }
        const int col = c0 + wc * 32 + 8 * fq;
#pragma unroll
        for (int ai = 0; ai < 2; ++ai)
#pragma unroll
            for (int m = 0; m < 4; ++m) { bf16_t* rowp = base + (size_t)(row0 + ai * 128 + m * 16) * ldc + col;
#pragma unroll
                for (int bj = 0; bj < 2; ++bj) { const f32x4 v0 = acc[ai][bj][m][0], v1 = acc[ai][bj][m][1];
                    u32x4 w; w.x = pk2(v0[0], v0[1]); w.y = pk2(v0[2], v0[3]); w.z = pk2(v1[0], v1[1]); w.w = pk2(v1[2], v1[3]);
                    *(u32x4*)(rowp + bj * 128) = w; } }
    }
};
struct EpiGate {
    static constexpr bool PERM = true, AFTER_DRAIN = false, CHAIN = true;
    bf16_t* Mo; const bf16_t* pg;
    static __device__ __forceinline__ float em(float x) { return __expf(-fminf(fmaxf(x, -30.f), 30.f)); }
    __device__ __forceinline__ void operator()(f32x4 (&acc)[2][2][4][2], const pg8::Unit& u, int wr, int wc, int fr, int fq) const {
        const int row0 = u.pm * 256 + wr * 64 + fr, col = u.pn * 256 + wc * 32 + 8 * fq, br = u.br;
#pragma unroll
        for (int ai = 0; ai < 2; ++ai) {
            u32x4 gc[4][2], gn[4][2];
#pragma unroll
            for (int m = 0; m < 4; ++m)
#pragma unroll
                for (int bj = 0; bj < 2; ++bj) { const size_t row = (size_t)(row0 + ai * 128 + m * 16);
                    gc[m][bj] = *(const u32x4*)(pg + row * 3072 + br * 1024 + col + bj * 128);
                    gn[m][bj] = *(const u32x4*)(pg + row * 3072 + (br < 2 ? br + 1 : br) * 1024 + col + bj * 128); }
#pragma unroll
            for (int m = 0; m < 4; ++m) { const size_t row = (size_t)(row0 + ai * 128 + m * 16);
#pragma unroll
                for (int bj = 0; bj < 2; ++bj) {
                    const unsigned gcw[4] = {gc[m][bj].x, gc[m][bj].y, gc[m][bj].z, gc[m][bj].w}, gnw[4] = {gn[m][bj].x, gn[m][bj].y, gn[m][bj].z, gn[m][bj].w};
                    f32x4& v0 = acc[ai][bj][m][0]; f32x4& v1 = acc[ai][bj][m][1];
                    if (br < 2) {
#pragma unroll
                        for (int q = 0; q < 4; ++q) { const float r0 = (1.0f + em(bflo(gnw[q]))) * __builtin_amdgcn_rcpf(1.0f + em(bflo(gcw[q]))), r1 = (1.0f + em(bfhi(gnw[q]))) * __builtin_amdgcn_rcpf(1.0f + em(bfhi(gcw[q])));
                            if (q < 2) { v0[2 * q] *= r0; v0[2 * q + 1] *= r1; } else { v1[2 * q - 4] *= r0; v1[2 * q - 3] *= r1; } }
                    } else {
#pragma unroll
                        for (int q = 0; q < 4; ++q) { const float s0 = __builtin_amdgcn_rcpf(1.0f + em(bflo(gcw[q]))), s1 = __builtin_amdgcn_rcpf(1.0f + em(bfhi(gcw[q])));
                            if (q < 2) { v0[2 * q] *= s0; v0[2 * q + 1] *= s1; } else { v1[2 * q - 4] *= s0; v1[2 * q - 3] *= s1; } }
                        u32x4 w; w.x = pk2(v0[0], v0[1]); w.y = pk2(v0[2], v0[3]); w.z = pk2(v1[0], v1[1]); w.w = pk2(v1[2], v1[3]);
                        *(u32x4*)(Mo + row * 1024 + col + bj * 128) = w; } } }
        }
    }
};
struct MergeOrder {
    pg8::StaticOrder so;
    __device__ bool next(int i, pg8::Unit& u) const { const int t = i / 3; if (!so.next(t, u)) return false; u.br = i - 3 * t; return true; }
    __device__ __forceinline__ void a_ready(const pg8::Unit&) const {}
    __device__ __forceinline__ void done(const pg8::Unit&) const {}
};
struct WinLastOrder {
    pg8::StaticOrder so; int G, c, nextra;
    __device__ bool next(int i, pg8::Unit& u) const {
        pg8::Unit t; const bool ok = so.next(i, t);
        const int L = i * G + c - so.nwg; const bool ex = !ok && L >= 0 && L < nextra;
        const int q = L % 12, pn2 = q < 4 ? 2 + q : q < 7 ? 5 + q : q < 11 ? 9 + q : 32;
        u.pm = ok ? t.pm : TL / 256 + L / 12; u.pn = ok ? t.pn : pn2; u.br = 0; return ok || ex; }
    __device__ __forceinline__ void a_ready(const pg8::Unit&) const {}
    __device__ __forceinline__ void done(const pg8::Unit&) const {}
};
struct EpiResid {
    static constexpr bool PERM = false, AFTER_DRAIN = false, CHAIN = false;
    const float *old_l, *old_c; float *out_l, *out_c; const float* mod; int gidx;
    __device__ __forceinline__ void operator()(AccRef acc, const pg8::Unit& u, int wr, int wc, int fr, int fq) const {
        const int col0 = u.pn * 256 + wc * 32 + 4 * fq;
        const bool isctx = u.pm >= TL / 256; const int b = isctx ? 8 : u.pm / (SEQ / 256);
        const float* g = mod + (size_t)b * 6144 + gidx * 1024 + col0;
        const float* ob = isctx ? old_c - (size_t)TL * D : old_l; float* wb = isctx ? out_c - (size_t)TL * D : out_l;
        f32x4 gv[2][2];
#pragma unroll
        for (int bj = 0; bj < 2; ++bj)
#pragma unroll
            for (int n = 0; n < 2; ++n) gv[bj][n] = *(const f32x4*)(g + bj * 128 + n * 16);
#pragma unroll
        for (int ai = 0; ai < 2; ++ai) {
            f32x4 xo[4][2][2];
#pragma unroll
            for (int m = 0; m < 4; ++m) { const size_t off = (size_t)(u.pm * 256 + ai * 128 + wr * 64 + m * 16 + fr) * D + col0;
#pragma unroll
                for (int bj = 0; bj < 2; ++bj)
#pragma unroll
                    for (int n = 0; n < 2; ++n) xo[m][bj][n] = *(const f32x4*)(ob + off + bj * 128 + n * 16); }
#pragma unroll
            for (int m = 0; m < 4; ++m) { const size_t off = (size_t)(u.pm * 256 + ai * 128 + wr * 64 + m * 16 + fr) * D + col0;
#pragma unroll
                for (int bj = 0; bj < 2; ++bj)
#pragma unroll
                    for (int n = 0; n < 2; ++n) *(f32x4*)(wb + off + bj * 128 + n * 16) = xo[m][bj][n] + gv[bj][n] * acc[ai][bj][m][n]; }
        }
    }
};
struct EpiSwiglu {
    static constexpr bool PERM = true, AFTER_DRAIN = false, CHAIN = false;
    bf16_t* h1; int NJ;
    __device__ __forceinline__ void operator()(AccRef acc, const pg8::Unit& u, int wr, int wc, int fr, int fq) const {
        const int row0 = u.pm * 256 + wr * 64 + fr, col = (u.pn % NJ) * 128 + wc * 32 + 8 * fq;
#pragma unroll
        for (int ai = 0; ai < 2; ++ai)
#pragma unroll
            for (int m = 0; m < 4; ++m) { const f32x4 a0 = acc[ai][0][m][0], a1 = acc[ai][0][m][1], b0 = acc[ai][1][m][0], b1 = acc[ai][1][m][1];
                u32x4 w; w.x = pk2(siluf_(a0[0]) * b0[0], siluf_(a0[1]) * b0[1]); w.y = pk2(siluf_(a0[2]) * b0[2], siluf_(a0[3]) * b0[3]);
                w.z = pk2(siluf_(a1[0]) * b1[0], siluf_(a1[1]) * b1[1]); w.w = pk2(siluf_(a1[2]) * b1[2], siluf_(a1[3]) * b1[3]);
                *(u32x4*)(h1 + (size_t)(row0 + ai * 128 + m * 16) * DFF + col) = w; }
    }
};
struct EpiMoeDown {
    static constexpr bool PERM = true, AFTER_DRAIN = false, CHAIN = false;
    bf16_t* y;
    __device__ __forceinline__ void operator()(AccRef acc, const pg8::Unit& u, int wr, int wc, int fr, int fq) const {
        const int row0 = u.pm * 256 + wr * 64 + fr, col = (u.pn % 4) * 256 + wc * 32 + 8 * fq;
#pragma unroll
        for (int ai = 0; ai < 2; ++ai)
#pragma unroll
            for (int m = 0; m < 4; ++m) { bf16_t* rowp = y + (size_t)(row0 + ai * 128 + m * 16) * D + col;
#pragma unroll
                for (int bj = 0; bj < 2; ++bj) { const f32x4 v0 = acc[ai][bj][m][0], v1 = acc[ai][bj][m][1];
                    u32x4 w; w.x = pk2(v0[0], v0[1]); w.y = pk2(v0[2], v0[3]); w.z = pk2(v1[0], v1[1]); w.w = pk2(v1[2], v1[3]);
                    *(u32x4*)(rowp + bj * 128) = w; } }
    }
};
struct MoeOrder {
    int ntiles, NJ, G, c; const int* tile_e;
    __device__ bool next(int i, pg8::Unit& u) const { const long L = (long)i * G + c; if (L >= (long)ntiles * NJ) return false;
        const int t = (int)(L / NJ), j = (int)(L % NJ); u.pm = t; u.pn = tile_e[t] * NJ + j; u.br = 0; return true; }
    __device__ __forceinline__ void a_ready(const pg8::Unit&) const {}
    __device__ __forceinline__ void done(const pg8::Unit&) const {}
};

#define XB_TMO      128
#define XB_XCNT(j)  (256  + 64 * (j))
#define XB_XSUB(j)  (1280 + 64 * (j))
#define XB_XGEN(j)  (2304 + 64 * (j))
#define XB_TOP      3328
#define XB_TOPGEN   3392
#define XCD_BAR_WORDS 3456
#define XB_SPIN_CAP (1u << 18)

__device__ __forceinline__ unsigned xb_ld(unsigned* p)              { return __hip_atomic_load(p, __ATOMIC_RELAXED, __HIP_MEMORY_SCOPE_AGENT); }
__device__ __forceinline__ unsigned xb_add(unsigned* p, unsigned v) { return __hip_atomic_fetch_add(p, v, __ATOMIC_RELAXED, __HIP_MEMORY_SCOPE_AGENT); }
__device__ __forceinline__ unsigned xb_xcc_id() { return (unsigned)__builtin_amdgcn_s_getreg((3 << 11) | 20) & 0xFu; }
#define XB_SPIN(cond, bar) do { unsigned _sp = 0; while (cond) { __builtin_amdgcn_s_sleep(1); \
    if ((++_sp & 255u) == 0u) { if (xb_ld(&(bar)[XB_TMO])) break; if (_sp > XB_SPIN_CAP) { atomicAdd(&(bar)[XB_TMO], 1u); break; } } } } while (0)

struct XcdBarrier {
    unsigned* bar; unsigned x;
    volatile unsigned* st;
};

__device__ __forceinline__ XcdBarrier xcd_barrier_post(unsigned* bar, volatile unsigned* st) {
    XcdBarrier b; b.bar = bar; b.x = xb_xcc_id(); b.st = st;
    if (threadIdx.x == 0) (void)xb_add(&bar[XB_XCNT(b.x)], 1u);
    return b;
}
__device__ __forceinline__ void xcd_barrier_complete(unsigned* bar, unsigned x, unsigned& nloc, unsigned& nx) {
    const unsigned G = gridDim.x * gridDim.y * gridDim.z;
    unsigned sum, cnt, mine, sp = 0u;
    for (;;) {
        sum = 0u; cnt = 0u; mine = 0u;
#pragma unroll
        for (unsigned j = 0; j < 16; ++j) { const unsigned c = xb_ld(&bar[XB_XCNT(j)]); sum += c; cnt += (c > 0u) ? 1u : 0u; mine = (j == x) ? c : mine; }
        if (sum == G) break;
        __builtin_amdgcn_s_sleep(1);
        if ((++sp & 255u) == 0u) { if (xb_ld(&bar[XB_TMO])) break; if (sp > XB_SPIN_CAP) { atomicAdd(&bar[XB_TMO], 1u); break; } }
    }
    nloc = mine > 0u ? mine : 1u; nx = cnt > 0u ? cnt : 1u;
}

__device__ __forceinline__ void xcd_barrier(const XcdBarrier& b) {
    asm volatile("s_waitcnt vmcnt(0)" ::: "memory");
    __syncthreads();
    if (threadIdx.x == 0) {
        unsigned* bar = b.bar;
        __builtin_amdgcn_s_waitcnt(0);
        unsigned nloc = b.st[0], nx = b.st[1];
        if (nloc == 0u) { xcd_barrier_complete(bar, b.x, nloc, nx); b.st[0] = nloc; b.st[1] = nx; }
        const unsigned old = xb_add(&bar[XB_XSUB(b.x)], 1u);
        const unsigned gen = old / nloc;
        if (old + 1u == (gen + 1u) * nloc) {
            __builtin_amdgcn_fence(__ATOMIC_RELEASE, "agent");
            asm volatile("s_waitcnt vmcnt(0)" ::: "memory");
            const unsigned og = xb_add(&bar[XB_TOP], 1u);
            const unsigned tg = og / nx;
            if (og + 1u == (tg + 1u) * nx) xb_add(&bar[XB_TOPGEN], 1u);
            else XB_SPIN(xb_ld(&bar[XB_TOPGEN]) == tg, bar);
            __builtin_amdgcn_fence(__ATOMIC_ACQUIRE, "agent");
            xb_add(&bar[XB_XGEN(b.x)], 1u);
            asm volatile("s_waitcnt vmcnt(0)" ::: "memory");
        } else {
            XB_SPIN(xb_ld(&bar[XB_XGEN(b.x)]) == gen, bar);
            __builtin_amdgcn_fence(__ATOMIC_ACQUIRE, "agent");
            asm volatile("s_waitcnt vmcnt(0)" ::: "memory");
        }
    }
    __syncthreads();
}

__device__ __forceinline__ void phase_mod(const P& p, unsigned char* lds) {
    float* sc = (float*)lds;
    float* red = sc + 9 * 1024;
    const int tid = otid();
    for (int i = tid; i < 9 * 1024; i += NTHREADS) { const int r = i >> 10, k = i & 1023; const float v = r < 8 ? p.c[r * 1024 + k] : p.c_ctx[k]; sc[i] = siluf_(v); }
    __syncthreads();
    float* MOD = (float*)(p.ws + WS_MOD);
    const int cj = tid % 48, ks = tid / 48;
    for (int grp = blockIdx.x; grp < DEPTH * 6144 / 48; grp += gridDim.x) {
        const int l = grp / 128, j = (grp % 128) * 48 + cj;
        float a[9];
#pragma unroll
        for (int r = 0; r < 9; ++r) a[r] = 0.f;
        if (ks < 10) {
            const float* w = p.w_mod + (size_t)l * 1024 * 6144 + j;
            for (int k = ks; k < 1024; k += 10) { const float wv = w[(size_t)k * 6144];
#pragma unroll
                for (int r = 0; r < 9; ++r) a[r] += sc[r * 1024 + k] * wv; }
#pragma unroll
            for (int r = 0; r < 9; ++r) red[(ks * 9 + r) * 48 + cj] = a[r];
        }
        __syncthreads();
        if (tid < 9 * 48) { const int r = tid / 48, c2 = tid % 48; float s = 0.f;
#pragma unroll
            for (int q = 0; q < 10; ++q) s += red[(q * 9 + r) * 48 + c2];
            const int jj = (grp % 128) * 48 + c2;
            MOD[((size_t)l * 9 + r) * 6144 + jj] = s + p.b_mod[l * 6144 + jj]; }
        __syncthreads();
    }
}

__device__ __forceinline__ void phase_modulate(const float* src_l, const float* src_c, int nrows, const float* gain, const float* mod, int shift_idx,
                                               bf16_t* H, const float* router_w, int* route, unsigned* ecnt, unsigned* lcnt  , int gw, int NGW, int lane) {
    if (router_w) { if (otid() < NE) lcnt[otid()] = 0u; __syncthreads(); }
    for (int r0_ = gw; r0_ < nrows; r0_ += 4 * NGW)
#pragma unroll
    for (int rr_ = 0; rr_ < 4; ++rr_) { const int r = r0_ + rr_ * NGW; if (r >= nrows) break;
        const bool isctx = r >= TL; const int b = isctx ? 8 : r / SEQ;
        const float* xr = isctx ? src_c + (size_t)(r - TL) * D : src_l + (size_t)r * D;
        const float* sh = mod + (size_t)b * 6144 + shift_idx * 1024; const float* scl = sh + 1024;
        f32x4 v[4]; float ss = 0.f;
#pragma unroll
        for (int j = 0; j < 4; ++j) { v[j] = *(const f32x4*)(xr + 4 * lane + 256 * j); ss += (v[j][0] * v[j][0] + v[j][1] * v[j][1]) + (v[j][2] * v[j][2] + v[j][3] * v[j][3]); }
        const float rs = 1.0f / sqrtf(wave_sum(ss) * (1.0f / D) + EPS);
#pragma unroll
        for (int j = 0; j < 4; ++j) { const int c = 4 * lane + 256 * j; const f32x4 g = *(const f32x4*)(gain + c), s1 = *(const f32x4*)(scl + c), s0 = *(const f32x4*)(sh + c);
            v[j] = v[j] * rs * g * (1.0f + s1) + s0;
            u32x2 w; w.x = pk2(v[j][0], v[j][1]); w.y = pk2(v[j][2], v[j][3]);
            *(u32x2*)(H + (size_t)r * D + c) = w; }
        if (router_w) {
            float lg[NE];
#pragma unroll
            for (int e = 0; e < NE; ++e) lg[e] = 0.f;
#pragma unroll
            for (int j = 0; j < 4; ++j)
#pragma unroll
                for (int q = 0; q < 4; ++q) { const float* rw = router_w + (size_t)(4 * lane + 256 * j + q) * NE; const f32x4 r0 = *(const f32x4*)rw, r1 = *(const f32x4*)(rw + 4); const float hv = v[j][q];
                    lg[0] += hv * r0[0]; lg[1] += hv * r0[1]; lg[2] += hv * r0[2]; lg[3] += hv * r0[3]; lg[4] += hv * r1[0]; lg[5] += hv * r1[1]; lg[6] += hv * r1[2]; lg[7] += hv * r1[3]; }
#pragma unroll
            for (int e = 0; e < NE; ++e) lg[e] = wave_sum(lg[e]);
            int e1 = 0; float v1 = lg[0];
#pragma unroll
            for (int e = 1; e < NE; ++e) if (lg[e] > v1) { v1 = lg[e]; e1 = e; }
            int e2 = e1 == 0 ? 1 : 0; float v2 = lg[e2];
#pragma unroll
            for (int e = 0; e < NE; ++e) if (e != e1 && lg[e] > v2) { v2 = lg[e]; e2 = e; }
            const float w2 = 1.0f / (1.0f + expf(v1 - v2)), w1 = 1.0f - w2;
            if (lane == 0) { route[r * 4 + 0] = e1; route[r * 4 + 1] = e2; ((float*)route)[r * 4 + 2] = w1; ((float*)route)[r * 4 + 3] = w2;
                atomicAdd(lcnt + e1, 1u); atomicAdd(lcnt + e2, 1u); }
        }
    }
    if (router_w) { __syncthreads(); if (otid() < NE && lcnt[otid()]) atomicAdd(ecnt + otid(), lcnt[otid()]); }
}


typedef short v4i16_t __attribute__((ext_vector_type(4)));
__device__ __forceinline__ s16x4 lds_tr(const bf16_t* pp) { return __builtin_bit_cast(s16x4, __builtin_amdgcn_ds_read_tr16_b64_v4i16((__attribute__((address_space(3))) v4i16_t*)pp)); }
__device__ __forceinline__ bf16x8 cat8(s16x4 a, s16x4 b) { union { bf16x8 v; s16x4 h[2]; } u; u.h[0] = a; u.h[1] = b; return u.v; }
__device__ __forceinline__ bf16x8 pack8(f32x4 a, f32x4 b) { union { bf16x8 v; unsigned u[4]; } r; r.u[0] = pk2(a[0], a[1]); r.u[1] = pk2(a[2], a[3]); r.u[2] = pk2(b[0], b[1]); r.u[3] = pk2(b[2], b[3]); return r.v; }
constexpr int DN_NCH = (CTXL + SEQ) / 64;
constexpr int DN_ITEMS = BATCH * 4 * DN_NCH;
constexpr int PREP_WLDS = 10240 + 17408 + 1024 + 2304;
constexpr int PREP_NW = 5;

__device__ __forceinline__ int dn_row(int n, int s, int b, int dir) {
    const bool isctx = n < CTXL / 64; const int L = isctx ? CTXL : SEQ, c = isctx ? n : n - CTXL / 64, u = 64 * c + s, t = dir ? L - 1 - u : u;
    return (isctx ? TL + b * CTXL : b * SEQ) + t;
}
__device__ __forceinline__ void dn_prep_item(const P& p, int l, int item, unsigned char* wlds, int lane) {
    asm volatile("" : "+v"(lane));
    const int cn = item % DN_NCH, bh = item / DN_NCH, h = bh & 3, b = bh >> 2;
    const bool isctx = cn < CTXL / 64; const int L = isctx ? CTXL : SEQ, cch = isctx ? cn : cn - CTXL / 64, rbase = isctx ? TL + b * CTXL : b * SEQ, nchp = L / 64;
    const int item0 = (bh * 2 + 0) * DN_NCH + cn, item1 = (bh * 2 + 1) * DN_NCH + (isctx ? nchp - 1 - cch : CTXL / 64 + nchp - 1 - cch);
    const int i16 = lane & 15, g = lane >> 4;
    const bf16_t* PAQ = (const bf16_t*)(p.ws + WS_PAQ); bf16_t* DN = (bf16_t*)(p.ws + WS_DNQKV); const float* SMALL = (const float*)(p.ws + WS_SMALL);
    const float* cw = p.conv_a + (size_t)l * 3 * 1536;
    constexpr int KCP = 136;
    float* Ls = (float*)wlds; bf16_t* Kc = (bf16_t*)(wlds + 10240); bf16_t* Tl = (bf16_t*)(wlds + 10240 + 9216);
    float* gc0 = (float*)(wlds + 10240 + 17408); float* be0 = gc0 + 64; float* sf1 = be0 + 64; float* be1 = sf1 + 64;
    bf16_t* cwl = (bf16_t*)(wlds + 10240 + 17408 + 1024);
    for (int i = lane; i < 3 * 384 / 2; i += 64) { const int tap = i / 192, c2 = (i % 192) * 2, sg = c2 >> 7, cc = c2 & 127; const float* src_ = cw + tap * 1536 + sg * 512 + h * 128 + cc;
        *(unsigned*)(cwl + tap * 384 + c2) = pk2(src_[0], src_[1]); }
    {
        const size_t r = (size_t)(rbase + 64 * cch + lane);
        const f32x4 s0 = *(const f32x4*)(SMALL + r * 64), s1 = *(const f32x4*)(SMALL + r * 64 + 4), s2 = *(const f32x4*)(SMALL + r * 64 + 8), s3 = *(const f32x4*)(SMALL + r * 64 + 12);
        const float g0v = -expf(p.a_log[l * 8 + h]) * softplusf_(s2[h] + p.dt_bias[l * 8 + h]), g1v = -expf(p.a_log[l * 8 + 4 + h]) * softplusf_(s3[h] + p.dt_bias[l * 8 + 4 + h]);
        const float b0v = sigmoidf_(s0[h]), b1v = sigmoidf_(s1[h]);
        float c0 = g0v, c1 = g1v;
#pragma unroll
        for (int o = 1; o < 64; o <<= 1) { const float u0 = shup(c0, o), u1 = shup(c1, o); if (lane >= o) { c0 += u0; c1 += u1; } }
        const float t0 = shlane(c0, 63), t1 = shlane(c1, 63), sf = t1 - c1 + g1v;
        gc0[lane] = c0; be0[lane] = b0v; sf1[lane] = sf; be1[lane] = b1v;
        float* v0 = (float*)(p.ws + WS_VEC) + (size_t)item0 * 256; float* v1 = (float*)(p.ws + WS_VEC) + (size_t)item1 * 256;
        v0[lane] = expf(c0); v0[64 + lane] = expf(t0 - c0); v0[128 + lane] = b0v; v0[192 + lane] = expf(t0);
        v1[63 - lane] = expf(sf); v1[64 + 63 - lane] = expf(t1 - sf); v1[128 + 63 - lane] = b1v; v1[192 + lane] = expf(t1);
    }
    struct SegRows { u32x4 x[6][4]; };
    auto seg_load = [&](int seg, SegRows& Sg) {
        int lo_ = lane; asm volatile("" : "+v"(lo_));
        const int i16 = lo_ & 15, g = lo_ >> 4;
#pragma unroll
        for (int f = 0; f < 6; ++f) { const int t = 64 * cch + 16 * (f - 1) + i16; const bool ok = t >= 0 && t < L; const size_t r = (size_t)(rbase + (ok ? t : 0));
#pragma unroll
            for (int ks = 0; ks < 4; ++ks) { Sg.x[f][ks] = (u32x4){0u, 0u, 0u, 0u}; if (ok) Sg.x[f][ks] = *(const u32x4*)(PAQ + r * 1536 + seg * 512 + h * 128 + 32 * ks + 8 * g); } }
    };
    auto tap_prev = [&](unsigned own, unsigned before) -> unsigned {
        const int t0 = __builtin_amdgcn_update_dpp(0, (int)before, 0x121  , 0xF, 0xF, false);
        return (unsigned)__builtin_amdgcn_update_dpp(t0, (int)own, 0x111  , 0xF, 0xF, false); };
    auto tap_next = [&](unsigned own, unsigned after) -> unsigned {
        const int t0 = __builtin_amdgcn_update_dpp(0, (int)after, 0x12F  , 0xF, 0xF, false);
        return (unsigned)__builtin_amdgcn_update_dpp(t0, (int)own, 0x101  , 0xF, 0xF, false); };
    auto conv_compute = [&](int seg, int mt, const SegRows& Sg, bf16x8 (&F)[4]) {
        const int t = 64 * cch + 16 * mt + i16; const size_t r = (size_t)(rbase + t);
        float y[4][8]; float ss = 0.f;
#pragma unroll
        for (int ks = 0; ks < 4; ++ks) {
            const int wo_ = seg * 128 + 32 * ks + 8 * g;
            const u32x4 wa = *(const u32x4*)(cwl + wo_), wb = *(const u32x4*)(cwl + 384 + wo_), wc = *(const u32x4*)(cwl + 768 + wo_);
            const u32x4 o_ = Sg.x[1 + mt][ks], pb_ = Sg.x[mt][ks], nb_ = Sg.x[2 + mt][ks];
            const unsigned xb[4] = {o_.x, o_.y, o_.z, o_.w}, xa[4] = {tap_prev(o_.x, pb_.x), tap_prev(o_.y, pb_.y), tap_prev(o_.z, pb_.z), tap_prev(o_.w, pb_.w)}, xc[4] = {tap_next(o_.x, nb_.x), tap_next(o_.y, nb_.y), tap_next(o_.z, nb_.z), tap_next(o_.w, nb_.w)};
            const unsigned wA[4] = {wa.x, wa.y, wa.z, wa.w}, wB[4] = {wb.x, wb.y, wb.z, wb.w}, wC[4] = {wc.x, wc.y, wc.z, wc.w};
#pragma unroll
            for (int q = 0; q < 4; ++q) {
                const float v0 = siluf_(bflo(wA[q]) * bflo(xa[q]) + bflo(wB[q]) * bflo(xb[q]) + bflo(wC[q]) * bflo(xc[q])), v1 = siluf_(bfhi(wA[q]) * bfhi(xa[q]) + bfhi(wB[q]) * bfhi(xb[q]) + bfhi(wC[q]) * bfhi(xc[q]));
                y[ks][2 * q] = v0; y[ks][2 * q + 1] = v1; ss += v0 * v0 + v1 * v1; }
        }
        float sc = 1.0f;
        if (seg < 2) { ss += shx(ss, 16); ss += shx(ss, 32); sc = 1.0f / sqrtf(ss + EPS); if (seg == 0) sc *= 0.08838834764831845f; }
#pragma unroll
        for (int ks = 0; ks < 4; ++ks) { union { bf16x8 v; u32x4 w; } f;
            f.w.x = pk2(y[ks][0] * sc, y[ks][1] * sc); f.w.y = pk2(y[ks][2] * sc, y[ks][3] * sc); f.w.z = pk2(y[ks][4] * sc, y[ks][5] * sc); f.w.w = pk2(y[ks][6] * sc, y[ks][7] * sc);
            F[ks] = f.v;
            *(u32x4*)(DN + r * 1536 + seg * 512 + h * 128 + 32 * ks + 8 * g) = f.w; }
    };
    { PH_BEGIN(12); {
#pragma unroll 1
      for (int sg = 0; sg < 2; ++sg) { const int seg = sg == 0 ? 1 : 2;
        SegRows Sg; seg_load(seg, Sg);
#pragma unroll
        for (int mt = 0; mt < 4; ++mt) { bf16x8 F[4];
            conv_compute(seg, mt, Sg, F);
            if (seg == 1) {
#pragma unroll
                for (int ks = 0; ks < 4; ++ks) *(bf16x8*)(Kc + (16 * mt + i16) * KCP + 32 * ks + 8 * g) = F[ks]; } } } } PH_END(12); }
    asm volatile("s_waitcnt lgkmcnt(0)" ::: "memory");
    f32x4 Ut[10];
    { PH_BEGIN(13);
    bf16_t* QK0g = (bf16_t*)(p.ws + WS_TQ + (size_t)item0 * 16384 + 8192); bf16_t* QK1g = (bf16_t*)(p.ws + WS_TQ + (size_t)item1 * 16384 + 8192);
    auto qk_tiles = [&](int mt, const bf16x8 (&Qf)[4]) {
#pragma unroll 1
        for (int nt = 0; nt < 4; ++nt) { f32x4 acc = (f32x4){0.f, 0.f, 0.f, 0.f}; const int j = 16 * nt + i16;
#pragma unroll
            for (int ks = 0; ks < 4; ++ks) acc = __builtin_amdgcn_mfma_f32_16x16x32_bf16(Qf[ks], *(const bf16x8*)(Kc + (16 * nt + i16) * KCP + 32 * ks + 8 * g), acc, 0, 0, 0);
            const float gj = gc0[j], sj = sf1[j];
#pragma unroll
            for (int rg = 0; rg < 4; ++rg) { const int i = 16 * mt + 4 * g + rg;
                const float q0 = i >= j ? acc[rg] * __expf(gc0[i] - gj) : 0.f, q1 = i <= j ? acc[rg] * __expf(sf1[i] - sj) : 0.f;
                QK0g[i * 64 + j] = (bf16_t)f2bf(q0); QK1g[(63 - i) * 64 + (63 - j)] = (bf16_t)f2bf(q1); } } };
    { SegRows Sg; seg_load(0, Sg);
#pragma unroll
      for (int mt = 0; mt < 4; ++mt) { bf16x8 Qf[4]; conv_compute(0, mt, Sg, Qf); qk_tiles(mt, Qf); } }
#pragma unroll
    for (int mt = 0; mt < 4; ++mt) {
        bf16x8 A[4];
#pragma unroll
        for (int ks = 0; ks < 4; ++ks) A[ks] = *(const bf16x8*)(Kc + (16 * mt + i16) * KCP + 32 * ks + 8 * g);
#pragma unroll
        for (int nt = 0; nt < 4; ++nt) { f32x4 acc = (f32x4){0.f, 0.f, 0.f, 0.f};
#pragma unroll
            for (int ks = 0; ks < 4; ++ks) acc = __builtin_amdgcn_mfma_f32_16x16x32_bf16(A[ks], *(const bf16x8*)(Kc + (16 * nt + i16) * KCP + 32 * ks + 8 * g), acc, 0, 0, 0);
            const int j = 16 * nt + i16;
            if (mt >= nt) { const float gj = gc0[j]; f32x4 lv;
#pragma unroll
                for (int rg = 0; rg < 4; ++rg) { const int i = 16 * mt + 4 * g + rg; lv[rg] = i > j ? be0[i] * acc[rg] * __expf(gc0[i] - gj) : 0.f; }
                *(f32x4*)(Ls + ((mt * (mt + 1)) / 2 + nt) * 256 + i16 * 16 + 4 * g) = lv; }
            if (mt <= nt) { const float sj = sf1[j]; f32x4 uv;
#pragma unroll
                for (int rg = 0; rg < 4; ++rg) { const int i = 16 * mt + 4 * g + rg; uv[rg] = i < j ? be1[i] * acc[rg] * __expf(sf1[i] - sj) : 0.f; }
                Ut[(nt * (nt + 1)) / 2 + mt] = uv; }
            asm volatile("" ::: "memory"); }
    }
    PH_END(13); }
    asm volatile("s_waitcnt lgkmcnt(0)" ::: "memory");
    auto solve = [&](int itemd) {
        constexpr int LP = 72;
        bf16_t* Lb = (bf16_t*)(wlds + 10240); bf16_t* Tt = (bf16_t*)wlds; bf16_t* Dv = (bf16_t*)(wlds + 10240 + 17408 + 1024);
        {
            const int Bq = lane >> 4, cq = lane & 15; const float* lblk = Ls + ((Bq * (Bq + 1)) / 2 + Bq) * 256;
            float x[16];
#pragma unroll
            for (int ii = 0; ii < 16; ++ii) x[ii] = (ii == cq) ? 1.f : 0.f;
#pragma unroll
            for (int jj = 0; jj < 15; ++jj) { const float tj = x[jj]; const float* lc = lblk + jj * 16;
                const f32x4 l0 = *(const f32x4*)lc, l1 = *(const f32x4*)(lc + 4), l2 = *(const f32x4*)(lc + 8), l3 = *(const f32x4*)(lc + 12);
#pragma unroll
                for (int q = 0; q < 4; ++q) { if (q > jj) x[q] -= l0[q] * tj; if (4 + q > jj) x[4 + q] -= l1[q] * tj; if (8 + q > jj) x[8 + q] -= l2[q] * tj; if (12 + q > jj) x[12 + q] -= l3[q] * tj; } }
#pragma unroll
            for (int ii = 0; ii < 16; ++ii) Dv[(Bq * 16 + ii) * 16 + cq] = (bf16_t)f2bf(x[ii]);
        }
        {
            const int jl = lane >> 2, iq = lane & 3;
#pragma unroll
            for (int bi = 0; bi < 4; ++bi)
#pragma unroll
                for (int bj = 0; bj <= bi; ++bj) { const f32x4 lv = *(const f32x4*)(Ls + ((bi * (bi + 1)) / 2 + bj) * 256 + jl * 16 + 4 * iq);
#pragma unroll
                    for (int q = 0; q < 4; ++q) Lb[(16 * bi + 4 * iq + q) * LP + 16 * bj + jl] = (bf16_t)f2bf(lv[q]); }
        }
        asm volatile("s_waitcnt lgkmcnt(0)" ::: "memory");
        unsigned z_ = 0u; asm volatile("" : "+v"(z_));
        const u32x4 zz = (u32x4){z_, z_, z_, z_};
#pragma unroll
        for (int q = 0; q < 9; ++q) ((u32x4*)Tt)[q * 64 + lane] = zz;
#pragma unroll
        for (int q = 0; q < 8; ++q) ((u32x4*)Tl)[q * 64 + lane] = zz;
        asm volatile("s_waitcnt lgkmcnt(0)" ::: "memory");
#pragma unroll
        for (int B = 0; B < 4; ++B) {
            const bf16x8 aD = cat8(*(const s16x4*)(Dv + (B * 16 + i16) * 16 + 4 * g), (s16x4){0, 0, 0, 0});
#pragma unroll
            for (int nt = 0; nt <= B; ++nt) {
                f32x4 acc = (f32x4){0.f, 0.f, 0.f, 0.f};
#pragma unroll
                for (int ks = 0; ks < (B + 1) / 2; ++ks)
                    acc = __builtin_amdgcn_mfma_f32_16x16x32_bf16(*(const bf16x8*)(Lb + (16 * B + i16) * LP + 32 * ks + 8 * g), *(const bf16x8*)(Tt + (16 * nt + i16) * LP + 32 * ks + 8 * g), acc, 0, 0, 0);
                f32x4 sv;
#pragma unroll
                for (int r = 0; r < 4; ++r) sv[r] = ((nt == B && 4 * g + r == i16) ? 1.f : 0.f) - acc[r];
                const f32x4 tv = __builtin_amdgcn_mfma_f32_16x16x32_bf16(aD, pack8(sv, (f32x4){0.f, 0.f, 0.f, 0.f}), (f32x4){0.f, 0.f, 0.f, 0.f}, 0, 0, 0);
                u32x2 tw; tw.x = pk2(tv[0], tv[1]); tw.y = pk2(tv[2], tv[3]);
                *(u32x2*)(Tt + (16 * nt + i16) * LP + 16 * B + 4 * g) = tw;
#pragma unroll
                for (int r = 0; r < 4; ++r) Tl[(16 * B + 4 * g + r) * 64 + 16 * nt + i16] = (bf16_t)f2bf(tv[r]);
            }
            asm volatile("s_waitcnt lgkmcnt(0)" ::: "memory");
        }
        { const u32x4* srcl = (const u32x4*)Tl; u32x4* dstg = (u32x4*)(p.ws + WS_TQ + (size_t)itemd * 16384);
#pragma unroll
          for (int q = 0; q < 8; ++q) dstg[q * 64 + lane] = srcl[q * 64 + lane]; }
        asm volatile("s_waitcnt lgkmcnt(0)" ::: "memory");
    };
    { PH_BEGIN(14);
    solve(item0);
#pragma unroll
    for (int nt = 0; nt < 4; ++nt)
#pragma unroll
        for (int mt = 0; mt <= nt; ++mt) { const f32x4 uv = Ut[(nt * (nt + 1)) / 2 + mt]; const int bi_ = 3 - mt, bj_ = 3 - nt;
            *(f32x4*)(Ls + ((bi_ * (bi_ + 1)) / 2 + bj_) * 256 + (15 - i16) * 16 + (12 - 4 * g)) = (f32x4){uv[3], uv[2], uv[1], uv[0]}; }
    asm volatile("s_waitcnt lgkmcnt(0)" ::: "memory");
    solve(item1);
    PH_END(14); }
}

__device__ __forceinline__ void dn_chain_mfma(const P& p, int item, unsigned char* lds) {
    const int b = item >> 3, h = (item >> 1) & 3, dir = item & 1, tid = otid(), lane = tid & 63, w = tid >> 6, i16 = lane & 15, g = lane >> 4;
    constexpr int KP = 136, TP = 72;
    bf16_t* Ks = (bf16_t*)lds; bf16_t* Qs = Ks + 64 * KP; bf16_t* Vs = Qs + 64 * KP; bf16_t* Ts = Vs + 64 * KP; bf16_t* QKs = Ts + 64 * TP; float* vec = (float*)(QKs + 64 * TP);
    const bf16_t* DN = (const bf16_t*)(p.ws + WS_DNQKV); bf16_t* OA = (bf16_t*)(p.ws + WS_H) + (size_t)dir * T * 512;
    f32x4 S[8];
#pragma unroll
    for (int dt = 0; dt < 8; ++dt) S[dt] = (f32x4){0.f, 0.f, 0.f, 0.f};
    u32x4 pf[9];
    auto prefetch = [&](int n) {
        const int pitem = item * DN_NCH + n;
#pragma unroll
        for (int u = 0; u < 6; ++u) { const int q = tid + 512 * u, which = q >> 10, rem = q & 1023, s = rem >> 4, ch = rem & 15;
            pf[u] = *(const u32x4*)(DN + (size_t)dn_row(n, s, b, dir) * 1536 + (which == 0 ? 512 : which == 1 ? 0 : 1024) + h * 128 + ch * 8); }
#pragma unroll
        for (int u = 0; u < 2; ++u) pf[6 + u] = *(const u32x4*)(p.ws + WS_TQ + (size_t)pitem * 16384 + (size_t)u * 8192 + (size_t)tid * 16);
        if (tid < 64) pf[8] = *(const u32x4*)((const float*)(p.ws + WS_VEC) + (size_t)pitem * 256 + tid * 4);
    };
    prefetch(0);
    for (int n = 0; n < DN_NCH; ++n) {
        __syncthreads();
#pragma unroll
        for (int u = 0; u < 6; ++u) { const int q = tid + 512 * u, which = q >> 10, rem = q & 1023, s = rem >> 4, ch = rem & 15;
            *(u32x4*)((which == 0 ? Ks : which == 1 ? Qs : Vs) + s * KP + ch * 8) = pf[u]; }
#pragma unroll
        for (int u = 0; u < 2; ++u) *(u32x4*)((u == 0 ? Ts : QKs) + (tid >> 3) * TP + (tid & 7) * 8) = pf[6 + u];
        if (tid < 64) *(u32x4*)(vec + tid * 4) = pf[8];
        __syncthreads();
        if (n + 1 < DN_NCH) prefetch(n + 1);
        const float* egv = vec; const float* eklv = vec + 64; const float* bev = vec + 128; const float glast = vec[192];
#define SB __builtin_amdgcn_sched_barrier(0)
        bf16x8 Sb[4];
#pragma unroll
        for (int ks = 0; ks < 4; ++ks) Sb[ks] = pack8(S[2 * ks], S[2 * ks + 1]);
        f32x4 r_[4], o_[4];
        bf16x8 akA[4], aqA[4], akB[4], aqB[4];
#define DN_LDKQ(mt_, ak_, aq_) do { const bf16_t* kr = Ks + (16 * (mt_) + i16) * KP + 4 * g; const bf16_t* qr = Qs + (16 * (mt_) + i16) * KP + 4 * g; \
            _Pragma("unroll") for (int ks = 0; ks < 4; ++ks) { ak_[ks] = cat8(*(const s16x4*)(kr + 32 * ks), *(const s16x4*)(kr + 32 * ks + 16)); aq_[ks] = cat8(*(const s16x4*)(qr + 32 * ks), *(const s16x4*)(qr + 32 * ks + 16)); } } while (0)
#define DN_MMKQ(mt_, ak_, aq_) do { r_[mt_] = (f32x4){0.f, 0.f, 0.f, 0.f}; o_[mt_] = (f32x4){0.f, 0.f, 0.f, 0.f}; \
            _Pragma("unroll") for (int ks = 0; ks < 4; ++ks) { r_[mt_] = __builtin_amdgcn_mfma_f32_16x16x32_bf16(ak_[ks], Sb[ks], r_[mt_], 0, 0, 0); o_[mt_] = __builtin_amdgcn_mfma_f32_16x16x32_bf16(aq_[ks], Sb[ks], o_[mt_], 0, 0, 0); } } while (0)
        DN_LDKQ(0, akA, aqA); SB;
        DN_LDKQ(1, akB, aqB); DN_MMKQ(0, akA, aqA); SB;
        DN_LDKQ(2, akA, aqA); DN_MMKQ(1, akB, aqB); SB;
        DN_LDKQ(3, akB, aqB); DN_MMKQ(2, akA, aqA); SB;
        f32x4 eg[4], be[4]; float vv[4][4];
#pragma unroll
        for (int mt = 0; mt < 4; ++mt) { eg[mt] = *(const f32x4*)(egv + 16 * mt + 4 * g); be[mt] = *(const f32x4*)(bev + 16 * mt + 4 * g);
#pragma unroll
            for (int rg = 0; rg < 4; ++rg) vv[mt][rg] = bf2f(Vs[(16 * mt + 4 * g + rg) * KP + 16 * w + i16]); }
        DN_MMKQ(3, akB, aqB); SB;
#undef DN_LDKQ
#undef DN_MMKQ
        bf16x8 tf[4][2], qf[4][2];
#pragma unroll
        for (int mt = 0; mt < 4; ++mt) { const bf16_t* tr = Ts + (16 * mt + i16) * TP + 4 * g;
#pragma unroll
            for (int k2 = 0; k2 < 2; ++k2) tf[mt][k2] = cat8(*(const s16x4*)(tr + 32 * k2), *(const s16x4*)(tr + 32 * k2 + 16)); }
        f32x4 e0v[2], e1v[2];
#pragma unroll
        for (int k2 = 0; k2 < 2; ++k2) { e0v[k2] = *(const f32x4*)(eklv + 32 * k2 + 4 * g); e1v[k2] = *(const f32x4*)(eklv + 32 * k2 + 16 + 4 * g); }
#pragma unroll
        for (int mt = 0; mt < 4; ++mt)
#pragma unroll
            for (int rg = 0; rg < 4; ++rg) { r_[mt][rg] = be[mt][rg] * (vv[mt][rg] - eg[mt][rg] * r_[mt][rg]); o_[mt][rg] *= eg[mt][rg]; }
        bf16x8 Rb[2];
#pragma unroll
        for (int k2 = 0; k2 < 2; ++k2) Rb[k2] = pack8(r_[2 * k2], r_[2 * k2 + 1]);
        SB;
#pragma unroll
        for (int mt = 0; mt < 4; ++mt) { const bf16_t* qkr = QKs + (16 * mt + i16) * TP + 4 * g;
#pragma unroll
            for (int k2 = 0; k2 < 2; ++k2) qf[mt][k2] = cat8(*(const s16x4*)(qkr + 32 * k2), *(const s16x4*)(qkr + 32 * k2 + 16)); }
        f32x4 vn[4];
#pragma unroll
        for (int mt = 0; mt < 4; ++mt) { vn[mt] = (f32x4){0.f, 0.f, 0.f, 0.f};
#pragma unroll
            for (int k2 = 0; k2 < 2; ++k2) vn[mt] = __builtin_amdgcn_mfma_f32_16x16x32_bf16(tf[mt][k2], Rb[k2], vn[mt], 0, 0, 0); }
        SB;
        bf16x8 Vb[2], Wb[2];
#pragma unroll
        for (int k2 = 0; k2 < 2; ++k2) { Vb[k2] = pack8(vn[2 * k2], vn[2 * k2 + 1]); Wb[k2] = pack8(vn[2 * k2] * e0v[k2], vn[2 * k2 + 1] * e1v[k2]); }
        bf16x8 ktA[4][2], ktB[4][2];
#pragma unroll
        for (int dt = 0; dt < 4; ++dt)
#pragma unroll
            for (int k2 = 0; k2 < 2; ++k2) { const bf16_t* a0 = Ks + (32 * k2 + 4 * g + (i16 >> 2)) * KP + 16 * dt + 4 * (i16 & 3); ktA[dt][k2] = cat8(lds_tr(a0), lds_tr(a0 + 16 * KP)); }
#pragma unroll
        for (int mt = 0; mt < 4; ++mt)
#pragma unroll
            for (int k2 = 0; k2 < 2; ++k2) o_[mt] = __builtin_amdgcn_mfma_f32_16x16x32_bf16(qf[mt][k2], Vb[k2], o_[mt], 0, 0, 0);
        SB;
#pragma unroll
        for (int dt = 0; dt < 4; ++dt)
#pragma unroll
            for (int k2 = 0; k2 < 2; ++k2) { const bf16_t* a0 = Ks + (32 * k2 + 4 * g + (i16 >> 2)) * KP + 16 * (dt + 4) + 4 * (i16 & 3); ktB[dt][k2] = cat8(lds_tr(a0), lds_tr(a0 + 16 * KP)); }
#pragma unroll
        for (int dt = 0; dt < 4; ++dt) { S[dt] = S[dt] * glast;
#pragma unroll
            for (int k2 = 0; k2 < 2; ++k2) S[dt] = __builtin_amdgcn_mfma_f32_16x16x32_bf16(ktA[dt][k2], Wb[k2], S[dt], 0, 0, 0); }
        SB;
#pragma unroll
        for (int dt = 0; dt < 4; ++dt) { S[dt + 4] = S[dt + 4] * glast;
#pragma unroll
            for (int k2 = 0; k2 < 2; ++k2) S[dt + 4] = __builtin_amdgcn_mfma_f32_16x16x32_bf16(ktB[dt][k2], Wb[k2], S[dt + 4], 0, 0, 0); }
#undef SB
#pragma unroll
        for (int mt = 0; mt < 4; ++mt)
#pragma unroll
            for (int rg = 0; rg < 4; ++rg) OA[(size_t)dn_row(n, 16 * mt + 4 * g + rg, b, dir) * 512 + h * 128 + 16 * w + i16] = (bf16_t)f2bf(o_[mt][rg]);
    }
}

__device__ __forceinline__ void phase_prep(const P& p, int l, unsigned char* lds, int gw, int NGW, int lane) {
    unsigned char* ws = p.ws;
    bf16_t* PC = (bf16_t*)(ws + WS_PC); unsigned* ctl = (unsigned*)(ws + WS_CTL);
    float* rtab = (float*)(lds + PREP_NW * PREP_WLDS);
    { const int tid = otid();
#pragma unroll
      for (int u = 0; u < 2; ++u) { const int e = tid + 512 * u, pos = e >> 4, fi = e & 15; const float ang = (float)pos * exp2f(-(float)fi * 0.8304820237218406f);
          float sn, cs; sincosf(ang, &sn, &cs); rtab[2 * e] = cs; rtab[2 * e + 1] = sn; }
      __syncthreads(); }
    const int wv = gw % NWAVES, blk = gw / NWAVES, G_ = NGW / NWAVES;
    if (wv < PREP_NW) { for (int rep = 0; rep < REP_DNPREP; ++rep) for (int it = blk * PREP_NW + wv; it < DN_ITEMS; it += G_ * PREP_NW) dn_prep_item(p, l, it, lds + wv * PREP_WLDS, lane); return; }
    const int gt = (blk * (NWAVES - PREP_NW) + (wv - PREP_NW)) * 64 + lane, NGT = G_ * (NWAVES - PREP_NW) * 64;
    float kmx = 0.f; int kbb = -1;
    const int q_ = gt & 31, seg = q_ >> 4, hh = (q_ >> 2) & 3, mm = (q_ >> 1) & 1, half = q_ & 1;
    const int rows_per = (T + NGT / 32 - 1) / (NGT / 32);
    for (int k_ = 0; k_ < rows_per; ++k_) {
        const int r = (gt >> 5) * rows_per + k_; if (r >= T) break; const bool lat = r < TL; const int b = lat ? r / SEQ : (r - TL) / CTXL;
        bf16_t* base = PC + (size_t)r * 1536 + seg * 512 + hh * 128 + mm * 64 + half * 32;
        const u32x4 a0 = *(const u32x4*)base, a1 = *(const u32x4*)(base + 8), b0 = *(const u32x4*)(base + 16), b1 = *(const u32x4*)(base + 24);
        const unsigned xa[8] = {a0.x, a0.y, a0.z, a0.w, a1.x, a1.y, a1.z, a1.w}, xb[8] = {b0.x, b0.y, b0.z, b0.w, b1.x, b1.y, b1.z, b1.w};
        const int t = r % SEQ, pos = half ? (t & 63) : (t >> 6); const float* tb = rtab + pos * 32;
        const float sc = seg == 0 ? 0.18033688011112042f : 1.0f;
        unsigned o1[8], o2[8]; float ss = 0.f;
#pragma unroll
        for (int w2 = 0; w2 < 8; ++w2) { float x1[2] = {bflo(xa[w2]), bfhi(xa[w2])}, x2[2] = {bflo(xb[w2]), bfhi(xb[w2])}, y1[2], y2[2];
            const f32x4 cssn = *(const f32x4*)(tb + 4 * w2);
#pragma unroll
            for (int e = 0; e < 2; ++e) { const float cs = lat ? cssn[2 * e] : 1.0f, sn = lat ? cssn[2 * e + 1] : 0.0f;
                y1[e] = (x1[e] * cs - x2[e] * sn) * sc; y2[e] = (x2[e] * cs + x1[e] * sn) * sc; }
            o1[w2] = pk2(y1[0], y1[1]); o2[w2] = pk2(y2[0], y2[1]);
            ss += bflo(o1[w2]) * bflo(o1[w2]) + bfhi(o1[w2]) * bfhi(o1[w2]) + bflo(o2[w2]) * bflo(o2[w2]) + bfhi(o2[w2]) * bfhi(o2[w2]); }
        if (lat || seg == 0) { *(u32x4*)base = (u32x4){o1[0], o1[1], o1[2], o1[3]}; *(u32x4*)(base + 8) = (u32x4){o1[4], o1[5], o1[6], o1[7]};
                               *(u32x4*)(base + 16) = (u32x4){o2[0], o2[1], o2[2], o2[3]}; *(u32x4*)(base + 24) = (u32x4){o2[4], o2[5], o2[6], o2[7]}; }
        ss += shx(ss, 1);
        if (seg == 1) { if (b != kbb) { if (kbb >= 0 && half == 0) atomicMax(ctl + CW_KMAX + l * 64 + (kbb * 4 + hh) * 2 + mm, __builtin_bit_cast(unsigned, sqrtf(kmx))); kbb = b; kmx = 0.f; }
            kmx = fmaxf(kmx, ss); }
    }
    if (seg == 1 && kbb >= 0 && half == 0) atomicMax(ctl + CW_KMAX + l * 64 + (kbb * 4 + hh) * 2 + mm, __builtin_bit_cast(unsigned, sqrtf(kmx)));
    if (blk == 0 && wv == PREP_NW) { float a = 0.f, bq = 0.f; const float* lc = p.lam_c + (size_t)l * 256;
        a = wave_sum(lc[lane] * lc[64 + lane]); bq = wave_sum(lc[128 + lane] * lc[192 + lane]);
        const float lam_init = l == 0 ? 0.2f : 0.35550906758f;
        if (lane == 0) ((float*)(ws + WS_MISC))[MI_LAMF + l] = expf(a) - expf(bq) + lam_init; }
}

__device__ __forceinline__ void dn_chain(const P& p, int item, unsigned char* lds) {
    const int b = item >> 3, h = (item >> 1) & 3, dir = item & 1, tid = otid(), c = tid >> 2, ks = tid & 3;
    const bf16_t* DN = (const bf16_t*)(p.ws + WS_DNQKV); const float* GB = (const float*)(p.ws + WS_GB);
    bf16_t* OA = (bf16_t*)(p.ws + WS_H) + (size_t)dir * T * 512;
    constexpr int TB = 32;
    float* qs = (float*)lds; float* ksm = qs + TB * 128; float* vs = ksm + TB * 128; float* gs = vs + TB * 128; float* bs = gs + TB; float* ob = bs + TB;
    float S[32];
#pragma unroll
    for (int i = 0; i < 32; ++i) S[i] = 0.f;
    for (int part = 0; part < 2; ++part) {
        const int L = part == 0 ? CTXL : SEQ; const int rbase = part == 0 ? TL + b * CTXL : b * SEQ;
        for (int t0 = 0; t0 < L; t0 += TB) {
            __syncthreads();
            for (int i = tid; i < 3 * TB * 16; i += NTHREADS) { const int which = i / (TB * 16), rem = i % (TB * 16), tt = rem >> 4, ch = rem & 15;
                const int s = t0 + tt, t = dir ? L - 1 - s : s;
                const u32x4 w = *(const u32x4*)(DN + (size_t)(rbase + t) * 1536 + which * 512 + h * 128 + ch * 8);
                float* dst = (which == 0 ? qs : which == 1 ? ksm : vs) + tt * 128 + ch * 8;
                dst[0] = bflo(w.x); dst[1] = bfhi(w.x); dst[2] = bflo(w.y); dst[3] = bfhi(w.y); dst[4] = bflo(w.z); dst[5] = bfhi(w.z); dst[6] = bflo(w.w); dst[7] = bfhi(w.w); }
            if (tid < TB) { const int s = t0 + tid, t = dir ? L - 1 - s : s; gs[tid] = expf(GB[(size_t)(rbase + t) * 16 + dir * 4 + h]); bs[tid] = GB[(size_t)(rbase + t) * 16 + 8 + dir * 4 + h]; }
            __syncthreads();
            for (int tt = 0; tt < TB; ++tt) {
                const float eg = gs[tt], be = bs[tt];
                const float* kr = ksm + tt * 128 + ks * 32; const float* qr = qs + tt * 128 + ks * 32;
                float r = 0.f;
#pragma unroll
                for (int i = 0; i < 32; ++i) r += kr[i] * S[i];
                r += shx(r, 1); r += shx(r, 2);
                const float vn = be * (vs[tt * 128 + c] - eg * r);
                float o = 0.f;
#pragma unroll
                for (int i = 0; i < 32; ++i) { S[i] = eg * S[i] + kr[i] * vn; o += qr[i] * S[i]; }
                o += shx(o, 1); o += shx(o, 2);
                if (ks == 0) ob[tt * 128 + c] = o;
            }
            __syncthreads();
            for (int i = tid; i < TB * 64; i += NTHREADS) { const int tt = i >> 6, cp = i & 63; const int s = t0 + tt, t = dir ? L - 1 - s : s;
                *(unsigned*)(OA + (size_t)(rbase + t) * 512 + h * 128 + 2 * cp) = pk2(ob[tt * 128 + 2 * cp], ob[tt * 128 + 2 * cp + 1]); }
        }
    }
}
__device__ __forceinline__ void gla_chain_mfma(const P& p, int l, int item, unsigned char* lds) {
    const int b = item >> 3, h = (item >> 1) & 3, dir = item & 1, tid = otid(), lane = tid & 63, w = tid >> 6, i16 = lane & 15, g = lane >> 4;
    constexpr int RP = 72, VP = 136, GP = 40;
    constexpr int RAWE = 2 * 64 * RP + 64 * VP + 64 * GP;
    bf16_t* Qt = (bf16_t*)lds;
    bf16_t* Kt = Qt + 64 * RP;
    bf16_t* KgT = Kt + 64 * RP;
    bf16_t* raw0 = KgT + 64 * RP;
    float* tot = (float*)(raw0 + 2 * RAWE);
    float* gls = tot + 128;
    const bf16_t* PB = (const bf16_t*)(p.ws + WS_PB); const float* SMALL = (const float*)(p.ws + WS_SMALL);
    bf16_t* OB = (bf16_t*)(p.ws + WS_PAQ) + (size_t)dir * T * 512;
    const int nt_ = w & 3, hf = w >> 2, ch = 16 * nt_ + i16;
    bf16x8 wgB;
    { float wv[8];
#pragma unroll
      for (int j = 0; j < 8; ++j) wv[j] = g < 2 ? p.w_gate2[((size_t)l * 2 + dir) * 16 * 256 + (8 * g + j) * 256 + h * 64 + ch] : 0.f;
      union { bf16x8 v; unsigned u[4]; } t_; t_.u[0] = pk2(wv[0], wv[1]); t_.u[1] = pk2(wv[2], wv[3]); t_.u[2] = pk2(wv[4], wv[5]); t_.u[3] = pk2(wv[6], wv[7]); wgB = t_.v; }
    const float bgc = p.b_gate[((size_t)l * 2 + dir) * 256 + h * 64 + ch];
    f32x4 S[4];
#pragma unroll
    for (int dt = 0; dt < 4; ++dt) S[dt] = (f32x4){0.f, 0.f, 0.f, 0.f};
    __syncthreads();
    for (int i = tid; i < 64 * GP / 2; i += NTHREADS) { ((unsigned*)(raw0 + 2 * 64 * RP + 64 * VP))[i] = 0u; ((unsigned*)(raw0 + RAWE + 2 * 64 * RP + 64 * VP))[i] = 0u; }
    u32x4 pf[5];
    auto prefetch = [&](int n) {
        { const int s = tid >> 3, c8 = tid & 7; const size_t row = (size_t)dn_row(n, s, b, dir);
          pf[0] = *(const u32x4*)(PB + row * 1536 + h * 64 + c8 * 8); pf[1] = *(const u32x4*)(PB + row * 1536 + 256 + h * 64 + c8 * 8); }
#pragma unroll
        for (int u = 0; u < 2; ++u) { const int q = tid + 512 * u, s = q >> 4, c8 = q & 15; pf[2 + u] = *(const u32x4*)(PB + (size_t)dn_row(n, s, b, dir) * 1536 + 512 + h * 128 + c8 * 8); }
        if (tid < 256) { const int s = tid >> 2, c4 = tid & 3; pf[4] = *(const u32x4*)(SMALL + (size_t)dn_row(n, s, b, dir) * 64 + 16 + dir * 16 + c4 * 4); }
    };
    auto stage = [&](int bsel) { bf16_t* qraw = raw0 + bsel * RAWE; bf16_t* kraw = qraw + 64 * RP; bf16_t* Vs = kraw + 64 * RP; bf16_t* Gl = Vs + 64 * VP;
        { const int s = tid >> 3, c8 = tid & 7; *(u32x4*)(qraw + s * RP + c8 * 8) = pf[0]; *(u32x4*)(kraw + s * RP + c8 * 8) = pf[1]; }
#pragma unroll
        for (int u = 0; u < 2; ++u) { const int q = tid + 512 * u, s = q >> 4, c8 = q & 15; *(u32x4*)(Vs + s * VP + c8 * 8) = pf[2 + u]; }
        if (tid < 256) { const int s = tid >> 2, c4 = tid & 3; const f32x4 gv = __builtin_bit_cast(f32x4, pf[4]); u32x2 o2; o2.x = pk2(gv[0], gv[1]); o2.y = pk2(gv[2], gv[3]); *(u32x2*)(Gl + s * GP + 4 * c4) = o2; }
    };
    prefetch(0);
    __syncthreads();
    stage(0); prefetch(1);
    for (int n = 0; n < DN_NCH; ++n) {
        const bf16_t* qraw = raw0 + (n & 1) * RAWE; const bf16_t* kraw = qraw + 64 * RP; const bf16_t* Vs = kraw + 64 * RP; const bf16_t* Gl = Vs + 64 * VP;
        __syncthreads();
        f32x4 pr[2]; float E_[2], TT0;
        {
#pragma unroll
            for (int t = 0; t < 2; ++t) { const int mt = 2 * hf + t;
                f32x4 z = __builtin_amdgcn_mfma_f32_16x16x32_bf16(*(const bf16x8*)(Gl + (16 * mt + i16) * GP + 8 * g), wgB, (f32x4){bgc, bgc, bgc, bgc}, 0, 0, 0);
                float run = 0.f;
#pragma unroll
                for (int r = 0; r < 4; ++r) { run += logsigmoid_fast(z[r]) * 0.0625f; pr[t][r] = run; } }
            float TT[2];
#pragma unroll
            for (int t = 0; t < 2; ++t) { const float T_ = pr[t][3]; const float y1 = shup(T_, 16); const float s1 = T_ + (g >= 1 ? y1 : 0.f); const float y2 = shup(s1, 32); const float s2 = s1 + (g >= 2 ? y2 : 0.f);
                E_[t] = s2 - T_; TT[t] = shlane(s2, i16 + 48); }
            TT0 = TT[0];
            if (g == 0) tot[hf * 64 + ch] = TT[0] + TT[1];
        }
        __syncthreads();
        {
            const float t0 = tot[ch], t1 = tot[64 + ch], total = t0 + t1, base = hf ? t0 : 0.f;
            float qv_[2][4], kv_[2][4];
#pragma unroll
            for (int t = 0; t < 2; ++t)
#pragma unroll
                for (int r = 0; r < 4; ++r) { const int tk = 16 * (2 * hf + t) + 4 * g + r; qv_[t][r] = bf2f(qraw[tk * RP + ch]); kv_[t][r] = bf2f(kraw[tk * RP + ch]); }
            __builtin_amdgcn_sched_barrier(0);
            const float etot = __expf(total);
#pragma unroll
            for (int t = 0; t < 2; ++t) { const int mt = 2 * hf + t; const float off = base + (t ? TT0 : 0.f) + E_[t]; float kgv[4];
#pragma unroll
                for (int r = 0; r < 4; ++r) { const int tk = 16 * mt + 4 * g + r; const float gc = off + pr[t][r]; const float eg = __expf(gc), ieg = __builtin_amdgcn_rcpf(eg);
                    Qt[tk * RP + ch] = (bf16_t)f2bf(0.125f * qv_[t][r] * eg); const float kie = kv_[t][r] * ieg; Kt[tk * RP + ch] = (bf16_t)f2bf(kie); kgv[r] = kie * etot; }
                u32x2 kw; kw.x = pk2(kgv[0], kgv[1]); kw.y = pk2(kgv[2], kgv[3]); *(u32x2*)(KgT + ch * RP + 16 * mt + 4 * g) = kw; }
            if (hf == 0 && g == 0) gls[ch] = etot;
        }
        __syncthreads();
        if (n + 1 < DN_NCH) { stage((n + 1) & 1); if (n + 2 < DN_NCH) prefetch(n + 2); }
        { bf16x8 Sb[2], Vb[2];
#pragma unroll
          for (int ks = 0; ks < 2; ++ks) { Sb[ks] = pack8(S[2 * ks], S[2 * ks + 1]);
              const bf16_t* v0 = Vs + (32 * ks + 4 * g + (i16 >> 2)) * VP + 16 * w + 4 * (i16 & 3); Vb[ks] = cat8(lds_tr(v0), lds_tr(v0 + 16 * VP)); }
          bf16x8 aq[4][2], aa[4][2], ak[4][2];
          { bf16x8 kf[4][2], qn_[4][2];
#pragma unroll
            for (int t4 = 0; t4 < 4; ++t4)
#pragma unroll
                for (int k2 = 0; k2 < 2; ++k2) { kf[t4][k2] = *(const bf16x8*)(Kt + (16 * t4 + i16) * RP + 32 * k2 + 8 * g); qn_[t4][k2] = *(const bf16x8*)(Qt + (16 * t4 + i16) * RP + 32 * k2 + 8 * g); }
#pragma unroll
            for (int mt = 0; mt < 4; ++mt)
#pragma unroll
                for (int ks = 0; ks < 2; ++ks) { f32x4 th[2];
#pragma unroll
                    for (int hh = 0; hh < 2; ++hh) { const int jb = 2 * ks + hh; th[hh] = (f32x4){0.f, 0.f, 0.f, 0.f};
                        if (jb <= mt) {
#pragma unroll
                            for (int k2 = 0; k2 < 2; ++k2) th[hh] = __builtin_amdgcn_mfma_f32_16x16x32_bf16(kf[jb][k2], qn_[mt][k2], th[hh], 0, 0, 0);
                            if (jb == mt) {
#pragma unroll
                                for (int rg = 0; rg < 4; ++rg) th[hh][rg] = (i16 >= 4 * g + rg) ? th[hh][rg] : 0.f; } } }
                    aa[mt][ks] = pack8(th[0], th[1]); } }
#pragma unroll
          for (int mt = 0; mt < 4; ++mt)
#pragma unroll
              for (int ks = 0; ks < 2; ++ks) { const int o_ = (16 * mt + i16) * RP + 32 * ks + 4 * g;
                  aq[mt][ks] = cat8(*(const s16x4*)(Qt + o_), *(const s16x4*)(Qt + o_ + 16)); ak[mt][ks] = cat8(*(const s16x4*)(KgT + o_), *(const s16x4*)(KgT + o_ + 16)); }
#pragma unroll
          for (int mt = 0; mt < 4; ++mt) { f32x4 o = (f32x4){0.f, 0.f, 0.f, 0.f};
#pragma unroll
              for (int ks = 0; ks < 2; ++ks) { o = __builtin_amdgcn_mfma_f32_16x16x32_bf16(aq[mt][ks], Sb[ks], o, 0, 0, 0); o = __builtin_amdgcn_mfma_f32_16x16x32_bf16(aa[mt][ks], Vb[ks], o, 0, 0, 0); }
#pragma unroll
              for (int rg = 0; rg < 4; ++rg) OB[(size_t)dn_row(n, 16 * mt + 4 * g + rg, b, dir) * 512 + h * 128 + 16 * w + i16] = (bf16_t)f2bf(o[rg]); }
#pragma unroll
          for (int dt = 0; dt < 4; ++dt) { const f32x4 gl = *(const f32x4*)(gls + 16 * dt + 4 * g); S[dt] = S[dt] * gl;
#pragma unroll
              for (int ks = 0; ks < 2; ++ks) S[dt] = __builtin_amdgcn_mfma_f32_16x16x32_bf16(ak[dt][ks], Vb[ks], S[dt], 0, 0, 0); } }
    }
}
__device__ __forceinline__ void attn_tile(const P& p, int l, int b, int h, int qrow0  , bool ctxq, unsigned char* lds, bool do_store = true) {
    constexpr int QP = 72, KP = 72, VP = 160;
    bf16_t* Qs = (bf16_t*)lds;
    constexpr int KVB = 2 * 64 * KP + 64 * VP;
    bf16_t* KV0 = Qs + 2 * 128 * QP;
    float* Oex = (float*)lds;
    bf16_t* PC = (bf16_t*)(p.ws + WS_PC);
    const int tid = otid(), lane = tid & 63, w = tid >> 6, m = w & 1, rg = w >> 1, q31 = lane & 31, hi = lane >> 5, i16 = lane & 15, gg = lane >> 4;
    const int nkt = ctxq ? CTXL / 64 : (CTXL + SEQ) / 64;
    u32x4 pk_[2], pv_[2];
    auto prefetch = [&](int kt) { const int krow0 = kt < CTXL / 64 ? TL + b * CTXL + kt * 64 : b * SEQ + (kt - CTXL / 64) * 64;
#pragma unroll
        for (int u = 0; u < 2; ++u) { const int i = tid + 512 * u, r = i >> 4, ch = i & 15; const bf16_t* rowp = PC + (size_t)(krow0 + r) * 1536 + h * 128 + ch * 8;
            pk_[u] = *(const u32x4*)(rowp + 512); pv_[u] = *(const u32x4*)(rowp + 1024); } };
    prefetch(0);
    __syncthreads();
    for (int i = tid; i < 128 * 16; i += NTHREADS) { const int r = i >> 4, ch = i & 15, mm = ch >> 3, c8 = (ch & 7) * 8;
        *(u32x4*)(Qs + (mm * 128 + r) * QP + c8) = *(const u32x4*)(PC + (size_t)(qrow0 + r) * 1536 + h * 128 + ch * 8); }
    __syncthreads();
    const bf16_t* qrow = Qs + (m * 128 + rg * 32 + q31) * QP;
    bf16x8 bq[4]; float qn = 0.f;
#pragma unroll
    for (int kk = 0; kk < 4; ++kk) bq[kk] = *(const bf16x8*)(qrow + 16 * kk + 8 * hi);
#pragma unroll
    for (int d8 = 0; d8 < 8; ++d8) { const u32x4 q4 = *(const u32x4*)(qrow + 8 * d8);
        qn += bflo(q4.x) * bflo(q4.x) + bfhi(q4.x) * bfhi(q4.x) + bflo(q4.y) * bflo(q4.y) + bfhi(q4.y) * bfhi(q4.y) + bflo(q4.z) * bflo(q4.z) + bfhi(q4.z) * bfhi(q4.z) + bflo(q4.w) * bflo(q4.w) + bfhi(q4.w) * bfhi(q4.w); }
    const float kmax = __builtin_bit_cast(float, ((const unsigned*)(p.ws + WS_CTL))[CW_KMAX + l * 64 + (b * 4 + h) * 2 + m]);
    const float mrow = sqrtf(qn) * kmax * 1.002f + 1e-3f;
    f32x16 o[4]; float lsum4[4] = {0.f, 0.f, 0.f, 0.f};
#pragma unroll
    for (int dt = 0; dt < 4; ++dt)
#pragma unroll
        for (int r = 0; r < 16; ++r) o[dt][r] = 0.f;
    auto stage = [&](int buf) { bf16_t* Ks = KV0 + buf * KVB; bf16_t* Vs = Ks + 2 * 64 * KP;
#pragma unroll
        for (int u = 0; u < 2; ++u) { const int i = tid + 512 * u, r = i >> 4, ch = i & 15, mm = ch >> 3, c8 = (ch & 7) * 8;
            *(u32x4*)(Ks + (mm * 64 + r) * KP + c8) = pk_[u]; *(u32x4*)(Vs + r * VP + ch * 8) = pv_[u]; } };
    stage(0);
    if (nkt > 1) prefetch(1);
    __syncthreads();
    for (int kt = 0; kt < nkt; ++kt) {
        const bf16_t* Ks = KV0 + (kt & 1) * KVB; const bf16_t* Vs = Ks + 2 * 64 * KP;
        bf16x8 ka[2][4];
#pragma unroll
        for (int kh = 0; kh < 2; ++kh)
#pragma unroll
            for (int kk = 0; kk < 4; ++kk) ka[kh][kk] = *(const bf16x8*)(Ks + (m * 64 + kh * 32 + q31) * KP + 16 * kk + 8 * hi);
        s16x4 vlo[4][4], vhi[4][4];
#pragma unroll
        for (int st = 0; st < 1; ++st) { const bf16_t* v0 = Vs + (16 * st + 4 * hi + (i16 >> 2)) * VP + 16 * (gg & 1) + 4 * (i16 & 3);
#pragma unroll
            for (int dt = 0; dt < 4; ++dt) { vlo[st][dt] = lds_tr(v0 + 32 * dt); vhi[st][dt] = lds_tr(v0 + 32 * dt + 8 * VP); } }
        __builtin_amdgcn_sched_barrier(0);
        f32x16 s[2];
#pragma unroll
        for (int kh = 0; kh < 2; ++kh) {
#pragma unroll
            for (int r = 0; r < 16; ++r) s[kh][r] = 0.f;
#pragma unroll
            for (int kk = 0; kk < 4; ++kk) s[kh] = __builtin_amdgcn_mfma_f32_32x32x16_bf16(ka[kh][kk], bq[kk], s[kh], 0, 0, 0);
        }
#pragma unroll
        for (int st = 1; st < 4; ++st) { const bf16_t* v0 = Vs + (16 * st + 4 * hi + (i16 >> 2)) * VP + 16 * (gg & 1) + 4 * (i16 & 3);
#pragma unroll
            for (int dt = 0; dt < 4; ++dt) { vlo[st][dt] = lds_tr(v0 + 32 * dt); vhi[st][dt] = lds_tr(v0 + 32 * dt + 8 * VP); } }
        __builtin_amdgcn_sched_barrier(0);
#pragma unroll
        for (int kh = 0; kh < 2; ++kh)
#pragma unroll
            for (int r = 0; r < 16; ++r) { const float ev = __builtin_amdgcn_exp2f(s[kh][r] - mrow); s[kh][r] = ev; lsum4[r & 3] += ev; }
        if (kt + 1 < nkt) { stage((kt + 1) & 1); if (kt + 2 < nkt) prefetch(kt + 2); }
#pragma unroll
        for (int st = 0; st < 4; ++st) {
            const int kh = st >> 1, r0 = 8 * (st & 1);
            union { bf16x8 v; unsigned u[4]; } bp;
            bp.u[0] = pk2(s[kh][r0 + 0], s[kh][r0 + 1]); bp.u[1] = pk2(s[kh][r0 + 2], s[kh][r0 + 3]); bp.u[2] = pk2(s[kh][r0 + 4], s[kh][r0 + 5]); bp.u[3] = pk2(s[kh][r0 + 6], s[kh][r0 + 7]);
    #pragma unroll
            for (int dt = 0; dt < 4; ++dt) o[dt] = __builtin_amdgcn_mfma_f32_32x32x16_bf16(cat8(vlo[st][dt], vhi[st][dt]), bp.v, o[dt], 0, 0, 0);
            }
        __syncthreads();
    }
    float lsum = (lsum4[0] + lsum4[1]) + (lsum4[2] + lsum4[3]);
    const int tid_e = otid(), w_e = tid_e >> 6, m_e = w_e & 1, rg_e = w_e >> 1, q31_e = tid_e & 31, hi_e = (tid_e & 63) >> 5;
    lsum += shx(lsum, 32);
    const float lamf = ((const float*)(p.ws + WS_MISC))[MI_LAMF + l];
    const float sc = (m_e == 0 ? 1.0f : lamf) / lsum;
    __syncthreads();
    float* ox = Oex + (rg_e * 32 + q31_e) * 132;
    if (m_e == 1) {
#pragma unroll
        for (int dt = 0; dt < 4; ++dt)
#pragma unroll
            for (int r = 0; r < 16; ++r) ox[dt * 32 + (r & 3) + 8 * (r >> 2) + 4 * hi_e] = o[dt][r] * sc;
    }
    __syncthreads();
    if (m_e == 0) {
        float ss = 0.f;
#pragma unroll
        for (int dt = 0; dt < 4; ++dt)
#pragma unroll
            for (int r = 0; r < 16; ++r) { const float v = o[dt][r] * sc - ox[dt * 32 + (r & 3) + 8 * (r >> 2) + 4 * hi_e]; o[dt][r] = v; ss += v * v; }
        ss += shx(ss, 32);
        int lo_ = l; asm volatile("" : "+s"(lo_));
        const float lam_init = lo_ == 0 ? 0.2f : 0.35550906758f;
        const float rs = (1.0f - lam_init) / sqrtf(ss * (1.0f / 128.0f) + EPS);
        const float* gn = p.gn_c + l * 128;
        bf16_t* orow = (bf16_t*)(p.ws + WS_YD) + (size_t)(qrow0 + rg_e * 32 + q31_e) * 512 + h * 128;
#pragma unroll
        for (int dt = 0; dt < 4; ++dt)
#pragma unroll
            for (int g4 = 0; g4 < 4; ++g4) { const int dv = dt * 32 + 8 * g4 + 4 * hi_e; const f32x4 gv = *(const f32x4*)(gn + dv);
                u32x2 wv; wv.x = pk2(o[dt][4 * g4 + 0] * rs * gv[0], o[dt][4 * g4 + 1] * rs * gv[1]); wv.y = pk2(o[dt][4 * g4 + 2] * rs * gv[2], o[dt][4 * g4 + 3] * rs * gv[3]);
                if (do_store) *(u32x2*)(orow + dv) = wv; }
    }
}
__device__ __forceinline__ void phase_mix(const P& p, int l, unsigned char* lds) {
    unsigned* qhead = (unsigned*)(p.ws + WS_CTL) + CW_QUEUE + 64 * l;
    volatile int* slot = (volatile int*)(lds + LDS_BYTES - 64);
    const int n_att_l = BATCH * 4 * (SEQ / 128), n_att_c = (l == 0) ? BATCH * 4 * (CTXL / 128) : 0;
    const int n_cv = (l == DEPTH - 1) ? NE * MOE_CV_SPLIT : 0;
    const int total = 128 + n_att_l + n_att_c + n_cv;
    for (;;) {
        __syncthreads();
        if (otid() == 0) *slot = (int)atomicAdd(qhead, 1u);
        __syncthreads();
        const int it = *slot;
        if (it >= total) break;
        if (it < 64) { for (int rep = 0; rep < REP_DN; ++rep) dn_chain_mfma(p, it, lds); }
        else if (it < 128) { for (int rep = 0; rep < REP_GLA; ++rep) gla_chain_mfma(p, l, it - 64, lds); }
        else if (it < 128 + n_att_l) { const int a = it - 128, b = a / (4 * (SEQ / 128)), rem = a % (4 * (SEQ / 128)), h = rem / (SEQ / 128), qt = rem % (SEQ / 128);
            for (int rep = 1; rep < REP_ATT; ++rep) attn_tile(p, l, b, h, b * SEQ + qt * 128, false, lds, false);
            attn_tile(p, l, b, h, b * SEQ + qt * 128, false, lds); }
        else if (it < 128 + n_att_l + n_att_c) { const int a = it - 128 - n_att_l, b = a / (4 * (CTXL / 128)), rem = a % (4 * (CTXL / 128)), h = rem / (CTXL / 128), qt = rem % (CTXL / 128);
            attn_tile(p, l, b, h, TL + b * CTXL + qt * 128, true, lds); }
        else { const int a = it - 128 - n_att_l - n_att_c, e = a / MOE_CV_SPLIT, sub = a % MOE_CV_SPLIT; const int tid_ = otid(), wave_ = tid_ >> 6;
            convert_T(DFF, D, (bf16_t*)(p.ws + WS_MWDN) + (size_t)e * D * DFF, D, SmPlain{p.moe_w2 + (size_t)e * DFF * D}, (float*)(lds + wave_ * CONV_WLDS), sub * NWAVES + wave_, MOE_CV_SPLIT * NWAVES, tid_ & 63); }
    }
}

__device__ __forceinline__ void phase_post(const P& p, int l, int nrows, int gw, int NGW, int lane) {
    bf16_t* OA = (bf16_t*)(p.ws + WS_H); bf16_t* OBb = (bf16_t*)(p.ws + WS_PAQ);
    const bf16_t* PZ = (const bf16_t*)(p.ws + WS_PZ); const bf16_t* PB = (const bf16_t*)(p.ws + WS_PB);
    const int c8 = 8 * lane, cg = c8 & 127;
    const f32x4 ga0 = *(const f32x4*)(p.gn_a + l * 128 + cg), ga1 = *(const f32x4*)(p.gn_a + l * 128 + cg + 4), gb0 = *(const f32x4*)(p.gn_b + l * 128 + cg), gb1 = *(const f32x4*)(p.gn_b + l * 128 + cg + 4);
    for (int r0_ = gw; r0_ < nrows; r0_ += 2 * NGW)
#pragma unroll
    for (int rr_ = 0; rr_ < 2; ++rr_) { const int r = r0_ + rr_ * NGW; if (r >= nrows) break;
        const u32x4 af = *(const u32x4*)(OA + (size_t)r * 512 + c8), ab = *(const u32x4*)(OA + ((size_t)T + r) * 512 + c8), az = *(const u32x4*)(PZ + (size_t)r * 512 + c8);
        const u32x4 bf_ = *(const u32x4*)(OBb + (size_t)r * 512 + c8), bb = *(const u32x4*)(OBb + ((size_t)T + r) * 512 + c8), bz = *(const u32x4*)(PB + (size_t)r * 1536 + 1024 + c8);
        const unsigned afw[4] = {af.x, af.y, af.z, af.w}, abw[4] = {ab.x, ab.y, ab.z, ab.w}, azw[4] = {az.x, az.y, az.z, az.w}, bfw[4] = {bf_.x, bf_.y, bf_.z, bf_.w}, bbw[4] = {bb.x, bb.y, bb.z, bb.w}, bzw[4] = {bz.x, bz.y, bz.z, bz.w};
        float oa[8], ob[8], sa = 0.f, sb = 0.f;
#pragma unroll
        for (int q = 0; q < 4; ++q) { oa[2 * q] = bflo(afw[q]) + bflo(abw[q]); oa[2 * q + 1] = bfhi(afw[q]) + bfhi(abw[q]); ob[2 * q] = bflo(bfw[q]) + bflo(bbw[q]); ob[2 * q + 1] = bfhi(bfw[q]) + bfhi(bbw[q]);
            sa += oa[2 * q] * oa[2 * q] + oa[2 * q + 1] * oa[2 * q + 1]; sb += ob[2 * q] * ob[2 * q] + ob[2 * q + 1] * ob[2 * q + 1]; }
#pragma unroll
        for (int o = 1; o < 16; o <<= 1) { sa += shx(sa, o); sb += shx(sb, o); }
        const float ra = 1.0f / sqrtf(sa * (1.0f / 128.0f) + EPS), rb = 1.0f / sqrtf(sb * (1.0f / 128.0f) + EPS);
        unsigned wa[4], wb[4];
#pragma unroll
        for (int q = 0; q < 4; ++q) { const float g0 = q < 2 ? ga0[2 * q] : ga1[2 * q - 4], g1 = q < 2 ? ga0[2 * q + 1] : ga1[2 * q - 3], h0 = q < 2 ? gb0[2 * q] : gb1[2 * q - 4], h1 = q < 2 ? gb0[2 * q + 1] : gb1[2 * q - 3];
            wa[q] = pk2(oa[2 * q] * ra * g0 * siluf_(bflo(azw[q])), oa[2 * q + 1] * ra * g1 * siluf_(bfhi(azw[q])));
            wb[q] = pk2(ob[2 * q] * rb * h0 * siluf_(bflo(bzw[q])), ob[2 * q + 1] * rb * h1 * siluf_(bfhi(bzw[q]))); }
        *(u32x4*)(OA + (size_t)r * 512 + c8) = (u32x4){wa[0], wa[1], wa[2], wa[3]};
        *(u32x4*)(OBb + (size_t)r * 512 + c8) = (u32x4){wb[0], wb[1], wb[2], wb[3]};
    }
}

__device__ __forceinline__ void phase_moe_gather(const P& p, unsigned char* lds) {
    const int tid = otid();
    const int* route = (const int*)(p.ws + WS_ROUTE); int* slots = (int*)(p.ws + WS_SLOT); int* misc = (int*)(p.ws + WS_MISC);
    const unsigned* ecnt = (const unsigned*)(p.ws + WS_CTL) + CW_ECNT; unsigned* efill = (unsigned*)(p.ws + WS_CTL) + CW_EFILL;
    const bf16_t* H = (const bf16_t*)(p.ws + WS_H); bf16_t* MA = (bf16_t*)(p.ws + WS_MA);
    int* eoff = (int*)lds; unsigned* lcnt = (unsigned*)(eoff + 16); unsigned* lbase = lcnt + 8; int* myslot = (int*)(lbase + 8);
    if (tid == 0) { int off = 0, nt = 0;
#pragma unroll 1
        for (int e = 0; e < NE; ++e) { eoff[e] = off; const int tl = ((int)ecnt[e] + 255) / 256;
            if (blockIdx.x == 0) { for (int q = 0; q < tl; ++q) misc[MI_TILEE + nt + q] = e; }
            nt += tl; off += tl * 256; }
        eoff[NE] = off; if (blockIdx.x == 0) misc[MI_NTILES] = nt; }
    for (int grp = blockIdx.x; grp < TL / 64; grp += gridDim.x) {
        __syncthreads();
        if (tid < NE) lcnt[tid] = 0u;
        __syncthreads();
        int e = 0, rank = 0;
        if (tid < 128) { e = route[(grp * 64 + (tid >> 1)) * 4 + (tid & 1)]; rank = (int)atomicAdd(lcnt + e, 1u); }
        __syncthreads();
        if (tid < NE) lbase[tid] = lcnt[tid] ? atomicAdd(efill + tid, lcnt[tid]) : 0u;
        __syncthreads();
        if (tid < 128) { const int s = eoff[e] + (int)lbase[e] + rank; myslot[tid] = s; slots[(grp * 64 + (tid >> 1)) * 2 + (tid & 1)] = s; }
        __syncthreads();
        for (int i0 = tid; i0 < 128 * 128; i0 += 8 * NTHREADS) { u32x4 v[8];
#pragma unroll
            for (int u = 0; u < 8; ++u) { const int i = i0 + u * NTHREADS, a = i >> 7, ch = i & 127; v[u] = ((const u32x4*)(H + (size_t)(grp * 64 + (a >> 1)) * D))[ch]; }
#pragma unroll
            for (int u = 0; u < 8; ++u) { const int i = i0 + u * NTHREADS, a = i >> 7, ch = i & 127; ((u32x4*)(MA + (size_t)myslot[a] * D))[ch] = v[u]; } }
    }
}
__device__ __forceinline__ void phase_final(const P& p, int gw, int NGW, int lane) {
    const int* route = (const int*)(p.ws + WS_ROUTE); const int* slots = (const int*)(p.ws + WS_SLOT); const bf16_t* Y = (const bf16_t*)(p.ws + WS_MA);
    const float* MOD = (const float*)(p.ws + WS_MOD) + (size_t)1 * 9 * 6144;
    for (int r0_ = gw; r0_ < TL; r0_ += 2 * NGW)
#pragma unroll
    for (int rr_ = 0; rr_ < 2; ++rr_) { const int r = r0_ + rr_ * NGW; if (r >= TL) break; const int b = r / SEQ; const float w1 = ((const float*)route)[r * 4 + 2], w2 = ((const float*)route)[r * 4 + 3];
        const bf16_t* y1 = Y + (size_t)slots[r * 2] * D, *y2 = Y + (size_t)slots[r * 2 + 1] * D; float* xr = p.out + (size_t)r * D; const float* g2 = MOD + (size_t)b * 6144 + 5 * 1024;
        f32x4 v[4]; float ss = 0.f;
#pragma unroll
        for (int j = 0; j < 4; ++j) { const int c = 4 * lane + 256 * j; const u32x2 a = *(const u32x2*)(y1 + c), bq = *(const u32x2*)(y2 + c); const f32x4 g = *(const f32x4*)(g2 + c);
            f32x4 y; y[0] = w1 * bflo(a.x) + w2 * bflo(bq.x); y[1] = w1 * bfhi(a.x) + w2 * bfhi(bq.x); y[2] = w1 * bflo(a.y) + w2 * bflo(bq.y); y[3] = w1 * bfhi(a.y) + w2 * bfhi(bq.y);
            v[j] = *(const f32x4*)(xr + c) + g * y; ss += (v[j][0] * v[j][0] + v[j][1] * v[j][1]) + (v[j][2] * v[j][2] + v[j][3] * v[j][3]); }
        const float rs = 1.0f / sqrtf(wave_sum(ss) * (1.0f / D) + EPS);
#pragma unroll
        for (int j = 0; j < 4; ++j) { const int c = 4 * lane + 256 * j; *(f32x4*)(xr + c) = v[j] * rs * *(const f32x4*)(p.final_g + c); }
    }
}

typedef __attribute__((address_space(4))) const P* KArgs;
#define LOADP(p) asm volatile("" : "+s"(kp)); P p; __builtin_memcpy(&p, kp, sizeof(P))
__global__ void __launch_bounds__(NTHREADS, 2) mk_fwd(P p_unused) {
    extern __shared__ __attribute__((aligned(16))) unsigned char lds[];
    cg::grid_group grid = cg::this_grid();
    KArgs kp = (KArgs)__builtin_amdgcn_kernarg_segment_ptr();
    const int G = gridDim.x, NGW = G * NWAVES;
#define IDS() const int tid = otid(), lane = tid & 63, wave = __builtin_amdgcn_readfirstlane(tid >> 6), gw = blockIdx.x * NWAVES + wave; (void)tid; (void)lane; (void)gw; (void)wave
    PG8_LAS unsigned char* glds = (PG8_LAS unsigned char*)lds;
    volatile unsigned* bst = (volatile unsigned*)(lds + LDS_BYTES - 128);
    if (otid() == 0) { bst[0] = 0u; bst[1] = 0u; }
    __syncthreads();
    { LOADP(p); (void)xcd_barrier_post((unsigned*)(p.ws + WS_CTL) + CW_BAR, bst); }
#define GSYNC() do { LOADP(pb_); XcdBarrier bb_; bb_.bar = (unsigned*)(pb_.ws + WS_CTL) + CW_BAR; bb_.x = xb_xcc_id(); bb_.st = (volatile unsigned*)(lds + LDS_BYTES - 128); xcd_barrier(bb_); } while (0)

    { PH_BEGIN(31);
    {
        LOADP(p); IDS(); unsigned char* ws = p.ws;
        float* scr = (float*)(lds + wave * CONV_WLDS);
        for (int rep = 0; rep < REP_P0; ++rep)
        for (int l = 0; l < DEPTH; ++l) {
            convert_T(D, 8240, (bf16_t*)(ws + WB_WIN + l * WIN_BYTES), NIN, SmWin{p.w_in + (size_t)l * D * 8240}, scr, (gw + 37 * l) % NGW, NGW, lane);
            convert_T(512, D, (bf16_t*)(ws + WB_WO + (l * 3 + 0) * WO_BYTES), D, SmPlain{p.w_o_a + (size_t)l * 512 * D}, scr, (gw + 300 + 700 * l) % NGW, NGW, lane);
            convert_T(512, D, (bf16_t*)(ws + WB_WO + (l * 3 + 1) * WO_BYTES), D, SmPlain{p.w_o_b + (size_t)l * 512 * D}, scr, (gw + 556 + 700 * l) % NGW, NGW, lane);
            convert_T(512, D, (bf16_t*)(ws + WB_WO + (l * 3 + 2) * WO_BYTES), D, SmPlain{p.w_o_c + (size_t)l * 512 * D}, scr, (gw + 812 + 700 * l) % NGW, NGW, lane);
            convert_T(D, D, (bf16_t*)(ws + WB_WOUT + l * WOUT_BYTES), D, SmPlain{p.w_out + (size_t)l * D * D}, scr, (gw + 1068 + 512 * l) % NGW, NGW, lane);
        }
        convert_T(D, DFF, (bf16_t*)(ws + WB_WUP), NUP, SmUp{p.ffn_w1, (long)(p.ffn_w3 - p.ffn_w1)}, scr, (gw + 1500) % NGW, NGW, lane);
        convert_T(DFF, D, (bf16_t*)(ws + WB_WDN), D, SmPlain{p.ffn_w2}, scr, (gw + 900) % NGW, NGW, lane);
        __syncthreads();
        phase_mod(p, lds);
    }
    PH_END(31); }
    grid.sync();

    for (int l = 0; l < DEPTH; ++l) {
        const bool last = (l == DEPTH - 1);
        const int Mrows = last ? TL : T;
{ PH_BEGIN((l * 16 + 0));
        for (int rep = 0; rep < REP_ELT; ++rep)
        { LOADP(p); IDS(); unsigned char* ws = p.ws;
          phase_modulate(l == 0 ? p.x : p.out, l == 0 ? p.ctx : (const float*)(ws + WS_XC), T, p.norm1_g + l * D, (const float*)(ws + WS_MOD) + (size_t)l * 9 * 6144, 0, (bf16_t*)(ws + WS_H), nullptr, nullptr, nullptr, nullptr, gw, NGW, lane); }
        PH_END((l * 16 + 0)); }
        GSYNC();
{ PH_BEGIN((l * 16 + 1));
        for (int rep = 0; rep < REP_WIN; ++rep)
        { LOADP(p); unsigned char* ws = p.ws;
            pg8::Gemm g{(const bf16_t*)(ws + WS_H), (const bf16_t*)(ws + WB_WIN + l * WIN_BYTES), T, NIN, D, D};
            EpiWin E{(bf16_t*)(ws + WS_PAQ), (bf16_t*)(ws + WS_PZ), (bf16_t*)(ws + WS_PB), (bf16_t*)(ws + WS_PC), (bf16_t*)(ws + WS_PG), (float*)(ws + WS_SMALL)};
            WinLastOrder S; S.so.init(last ? TL : T, NIN, G, (int)blockIdx.x); S.G = G; S.c = (int)blockIdx.x; S.nextra = last ? (TC / 256) * 12 : 0;
            pg8::gemm_phase<EpiWin, WinLastOrder, true, true>(glds, g, S, E);
        }
        PH_END((l * 16 + 1)); }
        GSYNC();
{ PH_BEGIN((l * 16 + 2));
        for (int rep = 1; rep < REP_SYNC; ++rep) GSYNC();
        { LOADP(p); IDS(); phase_prep(p, l, lds, gw, NGW, lane); }
        PH_END((l * 16 + 2)); }
        GSYNC();
{ PH_BEGIN((l * 16 + 3));
        { LOADP(p); phase_mix(p, l, lds); }
        PH_END((l * 16 + 3)); }
        GSYNC();
{ PH_BEGIN((l * 16 + 4));
        { LOADP(p); IDS(); phase_post(p, l, Mrows, gw, NGW, lane); }
        PH_END((l * 16 + 4)); }
        GSYNC();
{ PH_BEGIN((l * 16 + 5));
        for (int rep = 0; rep < REP_MERGE; ++rep)
        { LOADP(p); unsigned char* ws = p.ws;
            pg8::Gemm g{(const bf16_t*)(ws + WS_H), (const bf16_t*)(ws + WB_WO + (l * 3 + 0) * WO_BYTES), Mrows, D, 512, 512,
                        (const bf16_t*)(ws + WS_PAQ), (const bf16_t*)(ws + WS_YD), (const bf16_t*)(ws + WB_WO + (l * 3 + 1) * WO_BYTES), (const bf16_t*)(ws + WB_WO + (l * 3 + 2) * WO_BYTES)};
            MergeOrder S; S.so.init(Mrows, D, G, (int)blockIdx.x);
            EpiGate E{(bf16_t*)(ws + WS_DNQKV), (const bf16_t*)(ws + WS_PG)};
            pg8::gemm_phase<EpiGate, MergeOrder, true, true>(glds, g, S, E);
        }
        PH_END((l * 16 + 5)); }
        GSYNC();
{ PH_BEGIN((l * 16 + 6));
        for (int rep = 0; rep < (l == 0 ? REP_WOUT0 : 1); ++rep)
        { LOADP(p); unsigned char* ws = p.ws;
            pg8::Gemm g{(const bf16_t*)(ws + WS_DNQKV), (const bf16_t*)(ws + WB_WOUT + l * WOUT_BYTES), Mrows, D, D, D}; pg8::StaticOrder S; S.init(Mrows, D, G, (int)blockIdx.x);
            EpiResid E{l == 0 ? p.x : p.out, l == 0 ? p.ctx : (const float*)(ws + WS_XC), p.out, (float*)(ws + WS_XC), (const float*)(ws + WS_MOD) + (size_t)l * 9 * 6144, 2};
            pg8::gemm_phase<EpiResid, pg8::StaticOrder, true, true>(glds, g, S, E);
        }
        PH_END((l * 16 + 6)); }
        GSYNC();
{ PH_BEGIN((l * 16 + 7));
        { LOADP(p); IDS(); unsigned char* ws = p.ws;
          phase_modulate(p.out, (const float*)(ws + WS_XC), Mrows, p.norm2_g + l * D, (const float*)(ws + WS_MOD) + (size_t)l * 9 * 6144, 3, (bf16_t*)(ws + WS_H), last ? p.router_w : nullptr, (int*)(ws + WS_ROUTE), (unsigned*)(ws + WS_CTL) + CW_ECNT, (unsigned*)lds, gw, NGW, lane); }
        PH_END((l * 16 + 7)); }
        if (!last) {
            GSYNC();
{ PH_BEGIN(8);
            for (int rep = 0; rep < REP_UP; ++rep)
            { LOADP(p); unsigned char* ws = p.ws;
                pg8::Gemm g{(const bf16_t*)(ws + WS_H), (const bf16_t*)(ws + WB_WUP), T, NUP, D, D}; pg8::StaticOrder S; S.init(T, NUP, G, (int)blockIdx.x);
                EpiSwiglu E{(bf16_t*)(ws + WS_H1), NUP / 256};
                pg8::gemm_phase<EpiSwiglu, pg8::StaticOrder, true, true>(glds, g, S, E);
            }
        PH_END(8); }
            GSYNC();
{ PH_BEGIN(9);
            { LOADP(p); unsigned char* ws = p.ws;
                pg8::Gemm g{(const bf16_t*)(ws + WS_H1), (const bf16_t*)(ws + WB_WDN), T, D, DFF, DFF}; pg8::StaticOrder S; S.init(T, D, G, (int)blockIdx.x);
                EpiResid E{p.out, (const float*)(ws + WS_XC), p.out, (float*)(ws + WS_XC), (const float*)(ws + WS_MOD) + (size_t)l * 9 * 6144, 5};
                pg8::gemm_phase<EpiResid, pg8::StaticOrder, true, true>(glds, g, S, E);
            }
        PH_END(9); }
            GSYNC();
        } else {
{ PH_BEGIN(24);
            { LOADP(p); IDS(); unsigned char* ws = p.ws;
                float* scr = (float*)(lds + wave * CONV_WLDS);
                for (int e = 0; e < NE; ++e) {
                    convert_T(D, DFF, (bf16_t*)(ws + WS_MWUP) + (size_t)e * NUP * D, NUP, SmUp{p.moe_w1 + (size_t)e * D * DFF, (long)(p.moe_w3 - p.moe_w1)}, scr, (gw + 211 * e) % NGW, NGW, lane);
                }
            }
        PH_END(24); }
            GSYNC();
{ PH_BEGIN(25);
            { LOADP(p); phase_moe_gather(p, lds); }
        PH_END(25); }
            GSYNC();
{ PH_BEGIN(26);
            for (int rep = 0; rep < REP_UP; ++rep)
            { LOADP(p); unsigned char* ws = p.ws; const int* misc = (const int*)(ws + WS_MISC);
                pg8::Gemm g{(const bf16_t*)(ws + WS_MA), (const bf16_t*)(ws + WS_MWUP), MOE_ROWS, NE * NUP, D, D};
                MoeOrder S{misc[MI_NTILES], NUP / 256, G, (int)blockIdx.x, misc + MI_TILEE};
                EpiSwiglu E{(bf16_t*)(ws + WS_MH1), NUP / 256};
                pg8::gemm_phase<EpiSwiglu, MoeOrder, true, true>(glds, g, S, E);
            }
        PH_END(26); }
            GSYNC();
{ PH_BEGIN(27);
            { LOADP(p); unsigned char* ws = p.ws; const int* misc = (const int*)(ws + WS_MISC);
                pg8::Gemm g{(const bf16_t*)(ws + WS_MH1), (const bf16_t*)(ws + WS_MWDN), MOE_ROWS, NE * D, DFF, DFF};
                MoeOrder S{misc[MI_NTILES], D / 256, G, (int)blockIdx.x, misc + MI_TILEE};
                EpiMoeDown E{(bf16_t*)(ws + WS_MA)};
                pg8::gemm_phase<EpiMoeDown, MoeOrder, true, true>(glds, g, S, E);
            }
        PH_END(27); }
            GSYNC();
{ PH_BEGIN(28);
            { LOADP(p); IDS(); phase_final(p, gw, NGW, lane); }
        PH_END(28); }
        }
    }
}

extern "C" void kernel_launch(void* const* d_in, const int* in_sizes, int n_in, void* d_out, int out_size, void* d_ws, size_t ws_size, hipStream_t stream) {
    static int grid_blocks = 0;
    if (grid_blocks == 0) {
        if (n_in != 30 || in_sizes[0] != TL * D || out_size != TL * D || ws_size < WS_END) {
            fprintf(stderr, "kernel_launch: built for 30 inputs, x/out of %d floats, >= %zu bytes of d_ws; got n_in %d, in0 %d, out %d, ws %zu; nothing launched\n", TL * D, (size_t)WS_END, n_in, n_in > 0 ? in_sizes[0] : -1, out_size, ws_size);
            grid_blocks = -1; return; }
        int dev = 0, cus = 0, per_cu = 0;
        hipGetDevice(&dev);
        hipDeviceGetAttribute(&cus, hipDeviceAttributeMultiprocessorCount, dev);
        hipFuncSetAttribute((const void*)mk_fwd, hipFuncAttributeMaxDynamicSharedMemorySize, LDS_BYTES);
        hipOccupancyMaxActiveBlocksPerMultiprocessor(&per_cu, (const void*)mk_fwd, NTHREADS, LDS_BYTES);
        if (per_cu < 1) { fprintf(stderr, "kernel_launch: occupancy query reports %d blocks/CU; nothing launched\n", per_cu); grid_blocks = -1; return; }
        grid_blocks = cus;
    }
    if (grid_blocks < 0) return;
    hipMemsetAsync((char*)d_ws + WS_CTL, 0, CTL_BYTES, stream);
    P p{};
    const float** f = (const float**)&p;
    for (int i = 0; i < 30; ++i) f[i] = (const float*)d_in[i];
    p.out = (float*)d_out; p.ws = (unsigned char*)d_ws;
    void* args[] = {&p};
    hipError_t e = hipLaunchCooperativeKernel((const void*)mk_fwd, dim3(grid_blocks), dim3(NTHREADS), args, LDS_BYTES, stream);
    if (e != hipSuccess) fprintf(stderr, "kernel_launch: cooperative launch failed: %s (grid %d)\n", hipGetErrorString(e), grid_blocks);
}
```

```cpp
#include <hip/hip_runtime.h>
#include <hip/hip_cooperative_groups.h>
#include <cstdio>
#include <cstdint>
namespace cg = cooperative_groups;
#ifndef REP_P0
#define REP_P0 1
#endif
#ifndef REP_WIN
#define REP_WIN 1
#endif
#ifndef REP_CHAIN
#define REP_CHAIN 1
#endif
#ifndef REP_UP
#define REP_UP 1
#endif
#ifndef REP_SYNC
#define REP_SYNC 1
#endif
#ifndef REP_ATT
#define REP_ATT 1
#endif
#ifndef REP_DNPREP
#define REP_DNPREP 1
#endif
#ifndef REP_ELT
#define REP_ELT 1
#endif
#ifndef REP_DN
#define REP_DN REP_CHAIN
#endif
#ifndef REP_GLA
#define REP_GLA REP_CHAIN
#endif
#ifndef REP_MERGE
#define REP_MERGE 1
#endif
#ifndef REP_WOUT0
#define REP_WOUT0 1
#endif
#ifndef PROBE_MASK
#define PROBE_MASK 0u
#endif
#define PH_BEGIN(k) const unsigned long long pt0_ = ((PROBE_MASK >> (k)) & 1u) ? __builtin_amdgcn_s_memrealtime() : 0ull
#define PH_END(k) do { if ((PROBE_MASK >> (k)) & 1u) { const unsigned long long pt1_ = __builtin_amdgcn_s_memrealtime(); while (__builtin_amdgcn_s_memrealtime() - pt1_ < pt1_ - pt0_) __builtin_amdgcn_s_sleep(4); } } while (0)

namespace pg8 {
#define PG8_LAS __attribute__((address_space(3)))
typedef unsigned short bf16_t;
typedef short bf16x8 __attribute__((ext_vector_type(8)));
typedef float f32x4 __attribute__((ext_vector_type(4)));
typedef unsigned u32x4 __attribute__((ext_vector_type(4)));
constexpr int BM = 256, BK = 64, HALF = 128, HTB = HALF * BK * 2  , STAGE_BYTES = 8 * HTB, NXCD = 8, WGM = 8;

__host__ __device__ __forceinline__ int lds_byte(int r, int c) { const int st = (r >> 4) * 2 + (c >> 5), rr = r & 15, cc = c & 31, ob = rr * 64 + cc * 2; return st * 1024 + (ob ^ (((ob >> 9) & 1) << 5)); }
__host__ __device__ __forceinline__ void stage_rc(int b, int& R, int& C) { const int st = b / 1024, sb = b % 1024, swz = sb ^ (((sb >> 9) & 1) << 5); R = (st >> 1) * 16 + swz / 64; C = (st & 1) * 32 + (swz % 64) / 2; }
__host__ __device__ __forceinline__ int perm32(int rho) { const int n = rho >> 4, i = rho & 15; return 8 * (i >> 2) + 4 * n + (i & 3); }

struct Unit { int pm, pn, br; };
struct Gemm { const bf16_t* A; const bf16_t* Bt; int M, N, K, lda; const bf16_t* A1; const bf16_t* A2; const bf16_t* B1; const bf16_t* B2; };

struct StaticOrder {
    int nM, nN, nwg, G, c;
    __host__ __device__ void init(int M, int N, int G_, int c_) { nM = M / BM; nN = N / BM; nwg = nM * nN; G = G_; c = c_; }
    __host__ __device__ bool next(int i, Unit& u) const {
        const long L = (long)i * G + c; if (L >= nwg) return false;
        int wgid = (int)L; { const int q = nwg / NXCD, r = nwg % NXCD, xcd = wgid % NXCD, off = wgid / NXCD; wgid = (xcd < r ? xcd * (q + 1) : r * (q + 1) + (xcd - r) * q) + off; }
        const int nig = WGM * nN, gid = wgid / nig, fm = gid * WGM, gsz = (nM - fm) < WGM ? (nM - fm) : WGM;
        u.pm = fm + ((wgid % nig) % gsz); u.pn = (wgid % nig) / gsz; u.br = 0; return true;
    }
    __device__ __forceinline__ void a_ready(const Unit&) const {}
    __device__ __forceinline__ void done(const Unit&) const {}
};


template <class Epi, class Sched, bool ALIGN_EPI = false, bool SP2 = false>
__device__ __forceinline__ void gemm_phase(PG8_LAS unsigned char* lds, const Gemm g, const Sched& S, const Epi& E) {
    int tid_o = threadIdx.x; asm volatile("" : "+v"(tid_o));
    const int tid = tid_o, wid = __builtin_amdgcn_readfirstlane(tid >> 6), lane = tid & 63, wr = wid >> 2, wc = wid & 3, fr = lane & 15, fq = lane >> 4;
    const int K = g.K, nt = K / BK;
    unsigned voffA[2], voffB[2];
#pragma unroll
    for (int i = 0; i < 2; ++i) { int R, C; stage_rc(tid * 16 + i * 8192, R, C); const int Rb = Epi::PERM ? ((R & ~31) + perm32(R & 31)) : R;
        voffA[i] = (unsigned)(R * g.lda + C) * 2u; voffB[i] = (unsigned)(Rb * K + C) * 2u; }
    const size_t kstep = (size_t)(BK * 2);
    const size_t hstepA = (size_t)HALF * g.lda * 2, hstepB = (size_t)HALF * K * 2;
    const size_t tstepA = 2 * hstepA, tstepB = 2 * hstepB;
    const unsigned ldsw = (unsigned)wid * 1024u;
    const int aoff = lds_byte(wr * 64 + fr, fq * 8), boff = lds_byte(wc * 32 + fr, fq * 8);
#define PG8_SA(b, h) (((b) * 2 + (h)) * HTB)
#define PG8_SB(b, h) ((4 + (b) * 2 + (h)) * HTB)
#define PG8_STAGE(bufoff, gbase, voff) do { _Pragma("unroll") for (int _i = 0; _i < 2; ++_i) \
        __builtin_amdgcn_global_load_lds((const unsigned*)((const char*)(gbase) + (voff)[_i]), (PG8_LAS unsigned*)(lds + (bufoff) + ldsw + _i * 8192), 16, 0, 0); } while (0)
#define PG8_LDA(dst, b, h) do { _Pragma("unroll") for (int m = 0; m < 4; ++m) _Pragma("unroll") for (int k = 0; k < 2; ++k) dst[m][k] = *(const PG8_LAS bf16x8*)(lds + PG8_SA(b, h) + aoff + m * 2048 + k * 1024); } while (0)
#define PG8_LDB(dst, b, h) do { _Pragma("unroll") for (int n = 0; n < 2; ++n) _Pragma("unroll") for (int k = 0; k < 2; ++k) dst[n][k] = *(const PG8_LAS bf16x8*)(lds + PG8_SB(b, h) + boff + n * 2048 + k * 1024); } while (0)
#define PG8_MMA(ai, bj, At, Bt) do { __builtin_amdgcn_s_setprio(1); _Pragma("unroll") for (int m = 0; m < 4; ++m) _Pragma("unroll") for (int n = 0; n < 2; ++n) _Pragma("unroll") for (int k = 0; k < 2; ++k) \
        acc[ai][bj][m][n] = __builtin_amdgcn_mfma_f32_16x16x32_bf16(Bt[n][k], At[m][k], acc[ai][bj][m][n], 0, 0, 0); __builtin_amdgcn_s_setprio(0); } while (0)
#define PG8_WAIT_V(n) asm volatile("s_waitcnt vmcnt(" #n ")" ::: "memory")
#define PG8_WAIT_L(n) asm volatile("s_waitcnt lgkmcnt(" #n ")" ::: "memory")
#define PG8_BAR __builtin_amdgcn_s_barrier()
#define PG8_SCHED __builtin_amdgcn_sched_barrier(0)
    Unit cur, nxt; int ui = 0;
    if (!S.next(0, cur)) return;
    f32x4 acc[2][2][4][2];
#pragma unroll
    for (int a = 0; a < 2; ++a)
#pragma unroll
        for (int b = 0; b < 2; ++b)
#pragma unroll
            for (int m = 0; m < 4; ++m)
#pragma unroll
                for (int n = 0; n < 2; ++n) acc[a][b][m][n] = (f32x4){0.f, 0.f, 0.f, 0.f};
    bf16x8 At[4][2], B0[2][2], B1[2][2];
    const char* cA = (const char*)(cur.br == 0 ? g.A : cur.br == 1 ? g.A1 : g.A2) + (size_t)cur.pm * tstepA; const char* cB = (const char*)(cur.br == 0 ? g.Bt : cur.br == 1 ? g.B1 : g.B2) + (size_t)cur.pn * tstepB;
    S.a_ready(cur);
    if constexpr (SP2) {
        PG8_STAGE(PG8_SB(0, 0), cB, voffB); PG8_STAGE(PG8_SB(0, 1), cB + hstepB, voffB); PG8_STAGE(PG8_SA(0, 0), cA, voffA); PG8_STAGE(PG8_SA(0, 1), cA + hstepA, voffA);
        if (wr == 1) PG8_BAR;
        PG8_WAIT_V(2); PG8_BAR;
        PG8_STAGE(PG8_SB(1, 0), cB + kstep, voffB); PG8_STAGE(PG8_SA(1, 0), cA + kstep, voffA); PG8_STAGE(PG8_SB(1, 1), cB + hstepB + kstep, voffB);
        PG8_WAIT_V(6); PG8_BAR;
    } else {
        PG8_STAGE(PG8_SB(0, 0), cB, voffB); PG8_STAGE(PG8_SA(0, 0), cA, voffA); PG8_STAGE(PG8_SB(0, 1), cB + hstepB, voffB); PG8_STAGE(PG8_SA(0, 1), cA + hstepA, voffA);
        if (wr == 1) PG8_BAR;
        PG8_WAIT_V(4); PG8_BAR;
        PG8_STAGE(PG8_SB(1, 0), cB + kstep, voffB); PG8_STAGE(PG8_SA(1, 0), cA + kstep, voffA); PG8_STAGE(PG8_SB(1, 1), cB + hstepB + kstep, voffB);
        PG8_WAIT_V(6); PG8_BAR;
    }
    for (;;) {
        const bool has_next = S.next(ui + 1, nxt);
        const char* nA = has_next ? (const char*)(nxt.br == 0 ? g.A : nxt.br == 1 ? g.A1 : g.A2) + (size_t)nxt.pm * tstepA : cA; const char* nB = has_next ? (const char*)(nxt.br == 0 ? g.Bt : nxt.br == 1 ? g.B1 : g.B2) + (size_t)nxt.pn * tstepB : cB;
        for (int t = 0; t < nt; t += 2) {
            const bool last = (t == nt - 2);
            const char* a1 = cA + (size_t)(t + 1) * kstep;
            const char* a2 = last ? nA : cA + (size_t)(t + 2) * kstep; const char* b2 = last ? nB : cB + (size_t)(t + 2) * kstep;
            const char* a3 = a2 + kstep; const char* b3 = b2 + kstep;
            if (last && has_next) S.a_ready(nxt);
            if constexpr (SP2) {
            PG8_LDB(B0, 0, 0); PG8_LDB(B1, 0, 1); PG8_SCHED; PG8_LDA(At, 0, 0); PG8_STAGE(PG8_SA(1, 1), a1 + hstepA, voffA);
            PG8_WAIT_V(8); PG8_WAIT_L(0); PG8_BAR; PG8_MMA(0, 0, At, B0); PG8_MMA(0, 1, At, B1); PG8_BAR; PG8_SCHED;
            PG8_LDA(At, 0, 1); PG8_STAGE(PG8_SB(0, 0), b2, voffB); PG8_STAGE(PG8_SB(0, 1), b2 + hstepB, voffB); PG8_STAGE(PG8_SA(0, 0), a2, voffA);
            PG8_WAIT_V(8); PG8_WAIT_L(0); PG8_BAR; PG8_MMA(1, 0, At, B0); PG8_MMA(1, 1, At, B1); PG8_BAR; PG8_SCHED;
            PG8_LDB(B0, 1, 0); PG8_LDB(B1, 1, 1); PG8_SCHED; PG8_LDA(At, 1, 0); PG8_STAGE(PG8_SA(0, 1), a2 + hstepA, voffA);
            PG8_WAIT_V(8); PG8_WAIT_L(0); PG8_BAR; PG8_MMA(0, 0, At, B0); PG8_MMA(0, 1, At, B1); PG8_BAR; PG8_SCHED;
            PG8_LDA(At, 1, 1); PG8_STAGE(PG8_SB(1, 0), b3, voffB); PG8_STAGE(PG8_SB(1, 1), b3 + hstepB, voffB); PG8_STAGE(PG8_SA(1, 0), a3, voffA);
            PG8_WAIT_V(8); PG8_WAIT_L(0); PG8_BAR; PG8_MMA(1, 0, At, B0); PG8_MMA(1, 1, At, B1); PG8_BAR; PG8_SCHED;
            } else {
            PG8_LDB(B0, 0, 0); PG8_SCHED; PG8_LDA(At, 0, 0); PG8_STAGE(PG8_SA(1, 1), a1 + hstepA, voffA);
            PG8_WAIT_L(8); PG8_BAR; PG8_WAIT_L(0); PG8_MMA(0, 0, At, B0); PG8_BAR; PG8_SCHED;
            PG8_LDB(B1, 0, 1); PG8_STAGE(PG8_SB(0, 0), b2, voffB);
            PG8_BAR; PG8_WAIT_L(0); PG8_MMA(0, 1, At, B1); PG8_BAR;
            PG8_LDA(At, 0, 1); PG8_STAGE(PG8_SA(0, 0), a2, voffA);
            PG8_BAR; PG8_WAIT_L(0); PG8_MMA(1, 0, At, B0); PG8_BAR; PG8_SCHED;
            PG8_STAGE(PG8_SB(0, 1), b2 + hstepB, voffB);
            PG8_WAIT_V(6); PG8_BAR; PG8_MMA(1, 1, At, B1); PG8_BAR;
            PG8_LDB(B0, 1, 0); PG8_SCHED; PG8_LDA(At, 1, 0); PG8_STAGE(PG8_SA(0, 1), a2 + hstepA, voffA);
            PG8_WAIT_L(8); PG8_BAR; PG8_WAIT_L(0); PG8_MMA(0, 0, At, B0); PG8_BAR; PG8_SCHED;
            PG8_LDB(B1, 1, 1); PG8_STAGE(PG8_SB(1, 0), b3, voffB);
            PG8_BAR; PG8_WAIT_L(0); PG8_MMA(0, 1, At, B1); PG8_BAR;
            PG8_LDA(At, 1, 1); PG8_STAGE(PG8_SA(1, 0), a3, voffA);
            PG8_BAR; PG8_WAIT_L(0); PG8_MMA(1, 0, At, B0); PG8_BAR; PG8_SCHED;
            PG8_STAGE(PG8_SB(1, 1), b3 + hstepB, voffB);
            PG8_WAIT_V(6); PG8_BAR; PG8_MMA(1, 1, At, B1); PG8_BAR;
            }
        }
        if constexpr (ALIGN_EPI) { if (wr == 0) PG8_BAR; }
        if constexpr (!Epi::AFTER_DRAIN) { E(acc, cur, wr, wc, fr, fq); S.done(cur); }
        if (!has_next) break;
        if (!(Epi::CHAIN && nxt.br != 0)) {
#pragma unroll
        for (int a = 0; a < 2; ++a)
#pragma unroll
            for (int b = 0; b < 2; ++b)
#pragma unroll
                for (int m = 0; m < 4; ++m)
#pragma unroll
                    for (int n = 0; n < 2; ++n) acc[a][b][m][n] = (f32x4){0.f, 0.f, 0.f, 0.f};
        }
        cur = nxt; cA = nA; cB = nB; ++ui;
        if constexpr (ALIGN_EPI) { if (wr == 1) PG8_BAR; }
    }
    PG8_WAIT_V(0);
    if constexpr (!ALIGN_EPI) { if (wr == 0) PG8_BAR; }
    PG8_BAR;
    if constexpr (Epi::AFTER_DRAIN) { E.fused(acc, cur, wr, wc, fr, fq, lds, wid, lane); S.done(cur); }
#undef PG8_SA
#undef PG8_SB
#undef PG8_STAGE
#undef PG8_LDA
#undef PG8_LDB
#undef PG8_MMA
#undef PG8_WAIT_V
#undef PG8_WAIT_L
#undef PG8_BAR
#undef PG8_SCHED
}
}


constexpr int BATCH = 8, SEQ = 2048, CTXL = 256, D = 1024, DEPTH = 2;
constexpr int TL = BATCH * SEQ, TC = BATCH * CTXL, T = TL + TC;
constexpr int NIN = 8448;
constexpr int DFF = 2816, NE = 8, NUP = 2 * DFF;
constexpr int MOE_ROWS = 2 * TL + NE * 256;
constexpr float EPS = 1e-6f;
constexpr int NTHREADS = 512, NWAVES = 8;
constexpr int LDS_BYTES = 163840;

typedef unsigned short bf16_t;
typedef float f32x4 __attribute__((ext_vector_type(4)));
typedef float f32x16 __attribute__((ext_vector_type(16)));
typedef unsigned u32x4 __attribute__((ext_vector_type(4)));
typedef unsigned u32x2 __attribute__((ext_vector_type(2)));
typedef short bf16x8 __attribute__((ext_vector_type(8)));
typedef short s16x4 __attribute__((ext_vector_type(4)));

constexpr size_t al256(size_t x) { return (x + 255) & ~(size_t)255; }
constexpr size_t WS_CTL   = 0;                                   constexpr size_t CTL_BYTES = 65536;
constexpr size_t WS_MOD   = WS_CTL + CTL_BYTES;                  constexpr size_t MOD_BYTES = (size_t)DEPTH * 9 * 6 * D * 4;
constexpr size_t WS_ROUTE = al256(WS_MOD + MOD_BYTES);           constexpr size_t ROUTE_BYTES = (size_t)TL * 16;
constexpr size_t WS_SLOT  = al256(WS_ROUTE + ROUTE_BYTES);       constexpr size_t SLOT_BYTES = (size_t)TL * 8;
constexpr size_t WS_MISC  = al256(WS_SLOT + SLOT_BYTES);         constexpr size_t MISC_BYTES = 4096;
constexpr size_t WS_GB    = al256(WS_MISC + MISC_BYTES);         constexpr size_t GB_BYTES = (size_t)T * 16 * 4;
constexpr size_t WS_SMALL = al256(WS_GB + GB_BYTES);             constexpr size_t SMALL_BYTES = (size_t)T * 64 * 4;
constexpr size_t WS_XC    = al256(WS_SMALL + SMALL_BYTES);       constexpr size_t XC_BYTES = (size_t)TC * D * 4;
constexpr size_t WS_WB    = al256(WS_XC + XC_BYTES);
constexpr size_t WB_WIN   = WS_WB;                               constexpr size_t WIN_BYTES = (size_t)NIN * D * 2;
constexpr size_t WB_WUP   = WB_WIN + DEPTH * WIN_BYTES;          constexpr size_t WUP_BYTES = (size_t)NUP * D * 2;
constexpr size_t WB_WDN   = WB_WUP + WUP_BYTES;                  constexpr size_t WDN_BYTES = (size_t)D * DFF * 2;
constexpr size_t WB_WO    = WB_WDN + WDN_BYTES;                  constexpr size_t WO_BYTES = (size_t)D * 512 * 2;
constexpr size_t WB_WOUT  = WB_WO + DEPTH * 3 * WO_BYTES;        constexpr size_t WOUT_BYTES = (size_t)D * D * 2;
constexpr size_t WB_END   = WB_WOUT + DEPTH * WOUT_BYTES;
constexpr size_t WS_H     = al256(WB_END);                       constexpr size_t H_BYTES = (size_t)T * D * 2;
constexpr size_t WS_PAQ   = al256(WS_H + H_BYTES);               constexpr size_t PAQ_BYTES = (size_t)T * 1536 * 2;
constexpr size_t WS_PZ    = al256(WS_PAQ + PAQ_BYTES);           constexpr size_t PZ_BYTES = (size_t)T * 512 * 2;
constexpr size_t WS_PB    = al256(WS_PZ + PZ_BYTES);             constexpr size_t PB_BYTES = (size_t)T * 1536 * 2;
constexpr size_t WS_PC    = al256(WS_PB + PB_BYTES);             constexpr size_t PC_BYTES = (size_t)T * 1536 * 2;
constexpr size_t WS_PG    = al256(WS_PC + PC_BYTES);             constexpr size_t PG_BYTES = (size_t)T * 3072 * 2;
constexpr size_t WS_DNQKV = al256(WS_PG + PG_BYTES);             constexpr size_t DNQKV_BYTES = (size_t)T * 1536 * 2;
constexpr size_t WS_TQ    = al256(WS_DNQKV + DNQKV_BYTES);       constexpr size_t TQ_BYTES = (size_t)BATCH * 4 * 2 * ((CTXL + SEQ) / 64) * 16384;
constexpr size_t WS_VEC   = al256(WS_TQ + TQ_BYTES);             constexpr size_t VEC_BYTES = (size_t)BATCH * 4 * 2 * ((CTXL + SEQ) / 64) * 1024;
constexpr size_t WS_END   = al256(WS_VEC + VEC_BYTES);
static_assert(WS_END <= (size_t)524288000, "d_ws map exceeds 500 MiB (documented minimum is 525,980,800 B)");
constexpr size_t WS_YD    = WS_PAQ + (size_t)2 * T * 512 * 2;
static_assert((size_t)3 * T * 512 * 2 <= PAQ_BYTES, "yd overlay");
constexpr size_t WS_H1    = WS_PB;
static_assert((size_t)T * DFF * 2 <= PB_BYTES + PC_BYTES, "h1 overlay");
constexpr size_t WS_MWDN  = WS_WB;                                constexpr size_t MWDN_BYTES = (size_t)NE * D * DFF * 2;
static_assert(MWDN_BYTES <= WB_WO - WS_WB, "moe wdn overlay: must not reach layer 1's w_o / w_out copies (live until its merge / w_out GEMMs)");
constexpr size_t WS_MWUP  = WS_PAQ;                               constexpr size_t MWUP_BYTES = (size_t)NE * NUP * D * 2;
constexpr size_t WS_MA    = al256(WS_MWUP + MWUP_BYTES);          constexpr size_t MA_BYTES = (size_t)MOE_ROWS * D * 2;
constexpr size_t WS_MH1   = al256(WS_MA + MA_BYTES);              constexpr size_t MH1_BYTES = (size_t)MOE_ROWS * DFF * 2;
static_assert(WS_MH1 + MH1_BYTES <= WS_END, "moe overlay");
constexpr int CW_QUEUE = 0;
constexpr int CW_KMAX = 256;
constexpr int CW_ECNT = 512;
constexpr int CW_EFILL = 576;
constexpr int CW_BAR = 4096;
constexpr int MI_LAMF = 0;
constexpr int MI_NTILES = 16;
constexpr int MI_EOFF = 32;
constexpr int MI_TILEE = 64;

typedef __bf16 bf16v2_t __attribute__((ext_vector_type(2)));
typedef float f32v2_t __attribute__((ext_vector_type(2)));
__device__ __forceinline__ unsigned pk2(float lo, float hi) { const f32v2_t v = {lo, hi}; return __builtin_bit_cast(unsigned, __builtin_convertvector(v, bf16v2_t)); }
__device__ __forceinline__ unsigned f2bf(float f) { return pk2(f, 0.f) & 0xffffu; }
__device__ __forceinline__ float bflo(unsigned w) { return __builtin_bit_cast(float, w << 16); }
__device__ __forceinline__ float bfhi(unsigned w) { return __builtin_bit_cast(float, w & 0xffff0000u); }
__device__ __forceinline__ float bf2f(bf16_t h) { return __builtin_bit_cast(float, (unsigned)h << 16); }
__device__ __forceinline__ int otid() { int t = threadIdx.x; asm volatile("" : "+v"(t)); return t; }
__device__ __forceinline__ float shx(float v, int o) { const int idx = ((otid() & 63) ^ o) << 2; return __builtin_bit_cast(float, __builtin_amdgcn_ds_bpermute(idx, __builtin_bit_cast(int, v))); }
__device__ __forceinline__ float shup(float v, int o) { const int idx = (((otid() & 63) - o) & 63) << 2; return __builtin_bit_cast(float, __builtin_amdgcn_ds_bpermute(idx, __builtin_bit_cast(int, v))); }
__device__ __forceinline__ float shlane(float v, int src) { return __builtin_bit_cast(float, __builtin_amdgcn_ds_bpermute(src << 2, __builtin_bit_cast(int, v))); }
__device__ __forceinline__ int shlane_i(int v, int src) { return __builtin_amdgcn_ds_bpermute(src << 2, v); }
__device__ __forceinline__ float wave_sum(float v) {
#pragma unroll
    for (int o = 1; o < 64; o <<= 1) v += shx(v, o);
    return v;
}
__device__ __forceinline__ float sigmoidf_(float x) { return __builtin_amdgcn_rcpf(1.0f + __expf(-x)); }
__device__ __forceinline__ float siluf_(float x) { return x * __builtin_amdgcn_rcpf(1.0f + __expf(-x)); }
__device__ __forceinline__ float softplusf_(float x) { return x > 20.f ? x : (x < -10.f ? __expf(x) : 0.6931471806f * __builtin_amdgcn_logf(1.0f + __builtin_amdgcn_exp2f(1.4426950409f * x))); }
__device__ __forceinline__ float logsigmoidf_(float x) { return fminf(x, 0.f) - log1pf(expf(-fabsf(x))); }
__device__ __forceinline__ float logsigmoid_fast(float z) { z = fmaxf(z, -80.f); return -0.6931471806f * __builtin_amdgcn_logf(1.0f + __builtin_amdgcn_exp2f(-1.4426950409f * z)); }

struct P {
    const float *x, *c, *ctx, *c_ctx, *w_mod, *b_mod, *norm1_g, *norm2_g, *w_in, *conv_a, *a_log, *dt_bias, *gn_a, *w_gate2, *b_gate, *gn_b,
                *lam_c, *gn_c, *w_o_a, *w_o_b, *w_o_c, *w_out, *ffn_w1, *ffn_w3, *ffn_w2, *router_w, *moe_w1, *moe_w3, *moe_w2, *final_g;
    float* out; unsigned char* ws;
};

constexpr long SM_ZERO = (long)1 << 62;
template <class SrcMap>
__device__ __forceinline__ void convert_T(int K, int ldw, bf16_t* WT, int Nrows, SrcMap sm, float* scr  , int gw, int NGW, int lane) {
    const int nblk = Nrows / 64, items = (K / 64) * nblk;
    for (int it = gw; it < items; it += NGW) {
        const int kb = it / nblk, nb = it % nblk, k0 = 64 * kb, n0 = 64 * nb;
        const long so_ = sm(n0 + 4 * (lane & 15)); const float* src = sm.W + (so_ != SM_ZERO ? so_ : 0L);
        f32x4 v[16];
#pragma unroll
        for (int i = 0; i < 16; ++i) { const int kk = 4 * i + (lane >> 4); const f32x4 ld = *(const f32x4*)(src + (size_t)(k0 + kk) * ldw); v[i] = so_ != SM_ZERO ? ld : (f32x4){0.f, 0.f, 0.f, 0.f}; }
#pragma unroll
        for (int i = 0; i < 16; ++i) { const int kk = 4 * i + (lane >> 4); float* d = scr + kk * 65 + 4 * (lane & 15); d[0] = v[i][0]; d[1] = v[i][1]; d[2] = v[i][2]; d[3] = v[i][3]; }
        asm volatile("s_waitcnt lgkmcnt(0)" ::: "memory");
        const int c = lane & 7;
#pragma unroll
        for (int j = 0; j < 8; ++j) { const int n = (lane >> 3) + 8 * j; const float* s = scr + (8 * c) * 65 + n;
            u32x4 o; o.x = pk2(s[0 * 65], s[1 * 65]); o.y = pk2(s[2 * 65], s[3 * 65]); o.z = pk2(s[4 * 65], s[5 * 65]); o.w = pk2(s[6 * 65], s[7 * 65]);
            *(u32x4*)(WT + (size_t)(n0 + n) * K + k0 + 8 * c) = o; }
        asm volatile("s_waitcnt lgkmcnt(0)" ::: "memory");
    }
}
struct SmPlain { const float* W; __device__ long operator()(int n) const { return n; } };
struct SmWin { const float* W; __device__ long operator()(int n) const {
    if (n < 2048) return n; if (n < 3584) return n + 16; if (n < 8192) return n + 48;
    const int j = n - 8192; if (j < 16) return 2048 + j; if (j < 48) return 3600 + (j - 16); return SM_ZERO; } };
struct SmUp { const float* W; long d31; __device__ long operator()(int n) const {
    const int tile = n >> 8, rr = n & 255; return (rr < 128 ? 0L : d31) + tile * 128 + (rr & 127); } };
constexpr int MOE_CV_SPLIT = 8;
constexpr int WIN0_BUSY = (T / 256) * (NIN / 256) - 9 * 256, MRG0_BUSY = (T / 256) * (D / 256) - 256;
constexpr int CONV_WLDS = 64 * 65 * 4;
typedef const f32x4 (&AccRef)[2][2][4][2];
struct EpiWin {
    static constexpr bool PERM = true, AFTER_DRAIN = false, CHAIN = false;
    bf16_t *paq, *pz, *pb, *pc, *pg; float* small_;
    __device__ __forceinline__ void operator()(AccRef acc, const pg8::Unit& u, int wr, int wc, int fr, int fq) const {
        const int row0 = u.pm * 256 + wr * 64 + fr, pn = u.pn;
        if (pn == 32) {
            if (wc < 2) {
#pragma unroll
                for (int ai = 0; ai < 2; ++ai)
#pragma unroll
                    for (int m = 0; m < 4; ++m) { float* p = small_ + (size_t)(row0 + ai * 128 + m * 16) * 64 + wc * 32 + 8 * fq;
                        *(f32x4*)p = acc[ai][0][m][0]; *(f32x4*)(p + 4) = acc[ai][0][m][1]; }
            }
            return;
        }
        bf16_t* base; int ldc, c0;
        if (pn < 6) { base = paq; ldc = 1536; c0 = pn * 256; } else if (pn < 8) { base = pz; ldc = 512; c0 = (pn - 6) * 256; }
        else if (pn < 14) { base = pb; ldc = 1536; c0 = (pn - 8) * 256; } else if (pn < 20) { base = pc; ldc = 1536; c0 = (pn - 14) * 256; }
        else { base = pg; ldc = 3072; c0 = (pn - 20) * 256; }
        const int col = c0 + wc * 32 + 8 * fq;
#pragma unroll
        for (int ai = 0; ai < 2; ++ai)
#pragma unroll
            for (int m = 0; m < 4; ++m) { bf16_t* rowp = base + (size_t)(row0 + ai * 128 + m * 16) * ldc + col;
#pragma unroll
                for (int bj = 0; bj < 2; ++bj) { const f32x4 v0 = acc[ai][bj][m][0], v1 = acc[ai][bj][m][1];
                    u32x4 w; w.x = pk2(v0[0], v0[1]); w.y = pk2(v0[2], v0[3]); w.z = pk2(v1[0], v1[1]); w.w = pk2(v1[2], v1[3]);
                    *(u32x4*)(rowp + bj * 128) = w; } }
    }
};
struct EpiGate {
    static constexpr bool PERM = true, AFTER_DRAIN = false, CHAIN = true;
    bf16_t* Mo; const bf16_t* pg;
    static __device__ __forceinline__ float em(float x) { return __expf(-fminf(fmaxf(x, -30.f), 30.f)); }
    __device__ __forceinline__ void operator()(f32x4 (&acc)[2][2][4][2], const pg8::Unit& u, int wr, int wc, int fr, int fq) const {
        const int row0 = u.pm * 256 + wr * 64 + fr, col = u.pn * 256 + wc * 32 + 8 * fq, br = u.br;
#pragma unroll
        for (int ai = 0; ai < 2; ++ai) {
            u32x4 gc[4][2], gn[4][2];
#pragma unroll
            for (int m = 0; m < 4; ++m)
#pragma unroll
                for (int bj = 0; bj < 2; ++bj) { const size_t row = (size_t)(row0 + ai * 128 + m * 16);
                    gc[m][bj] = *(const u32x4*)(pg + row * 3072 + br * 1024 + col + bj * 128);
                    gn[m][bj] = *(const u32x4*)(pg + row * 3072 + (br < 2 ? br + 1 : br) * 1024 + col + bj * 128); }
#pragma unroll
            for (int m = 0; m < 4; ++m) { const size_t row = (size_t)(row0 + ai * 128 + m * 16);
#pragma unroll
                for (int bj = 0; bj < 2; ++bj) {
                    const unsigned gcw[4] = {gc[m][bj].x, gc[m][bj].y, gc[m][bj].z, gc[m][bj].w}, gnw[4] = {gn[m][bj].x, gn[m][bj].y, gn[m][bj].z, gn[m][bj].w};
                    f32x4& v0 = acc[ai][bj][m][0]; f32x4& v1 = acc[ai][bj][m][1];
                    if (br < 2) {
#pragma unroll
                        for (int q = 0; q < 4; ++q) { const float r0 = (1.0f + em(bflo(gnw[q]))) * __builtin_amdgcn_rcpf(1.0f + em(bflo(gcw[q]))), r1 = (1.0f + em(bfhi(gnw[q]))) * __builtin_amdgcn_rcpf(1.0f + em(bfhi(gcw[q])));
                            if (q < 2) { v0[2 * q] *= r0; v0[2 * q + 1] *= r1; } else { v1[2 * q - 4] *= r0; v1[2 * q - 3] *= r1; } }
                    } else {
#pragma unroll
                        for (int q = 0; q < 4; ++q) { const float s0 = __builtin_amdgcn_rcpf(1.0f + em(bflo(gcw[q]))), s1 = __builtin_amdgcn_rcpf(1.0f + em(bfhi(gcw[q])));
                            if (q < 2) { v0[2 * q] *= s0; v0[2 * q + 1] *= s1; } else { v1[2 * q - 4] *= s0; v1[2 * q - 3] *= s1; } }
                        u32x4 w; w.x = pk2(v0[0], v0[1]); w.y = pk2(v0[2], v0[3]); w.z = pk2(v1[0], v1[1]); w.w = pk2(v1[2], v1[3]);
                        *(u32x4*)(Mo + row * 1024 + col + bj * 128) = w; } } }
        }
    }
};
struct MergeOrder {
    pg8::StaticOrder so;
    __device__ bool next(int i, pg8::Unit& u) const { const int t = i / 3; if (!so.next(t, u)) return false; u.br = i - 3 * t; return true; }
    __device__ __forceinline__ void a_ready(const pg8::Unit&) const {}
    __device__ __forceinline__ void done(const pg8::Unit&) const {}
};
struct WinLastOrder {
    pg8::StaticOrder so; int G, c, nextra;
    __device__ bool next(int i, pg8::Unit& u) const {
        pg8::Unit t; const bool ok = so.next(i, t);
        const int L = i * G + c - so.nwg; const bool ex = !ok && L >= 0 && L < nextra;
        const int q = L % 12, pn2 = q < 4 ? 2 + q : q < 7 ? 5 + q : q < 11 ? 9 + q : 32;
        u.pm = ok ? t.pm : TL / 256 + L / 12; u.pn = ok ? t.pn : pn2; u.br = 0; return ok || ex; }
    __device__ __forceinline__ void a_ready(const pg8::Unit&) const {}
    __device__ __forceinline__ void done(const pg8::Unit&) const {}
};
struct EpiResid {
    static constexpr bool PERM = false, AFTER_DRAIN = false, CHAIN = false;
    const float *old_l, *old_c; float *out_l, *out_c; const float* mod; int gidx;
    __device__ __forceinline__ void operator()(AccRef acc, const pg8::Unit& u, int wr, int wc, int fr, int fq) const {
        const int col0 = u.pn * 256 + wc * 32 + 4 * fq;
        const bool isctx = u.pm >= TL / 256; const int b = isctx ? 8 : u.pm / (SEQ / 256);
        const float* g = mod + (size_t)b * 6144 + gidx * 1024 + col0;
        const float* ob = isctx ? old_c - (size_t)TL * D : old_l; float* wb = isctx ? out_c - (size_t)TL * D : out_l;
        f32x4 gv[2][2];
#pragma unroll
        for (int bj = 0; bj < 2; ++bj)
#pragma unroll
            for (int n = 0; n < 2; ++n) gv[bj][n] = *(const f32x4*)(g + bj * 128 + n * 16);
#pragma unroll
        for (int ai = 0; ai < 2; ++ai) {
            f32x4 xo[4][2][2];
#pragma unroll
            for (int m = 0; m < 4; ++m) { const size_t off = (size_t)(u.pm * 256 + ai * 128 + wr * 64 + m * 16 + fr) * D + col0;
#pragma unroll
                for (int bj = 0; bj < 2; ++bj)
#pragma unroll
                    for (int n = 0; n < 2; ++n) xo[m][bj][n] = *(const f32x4*)(ob + off + bj * 128 + n * 16); }
#pragma unroll
            for (int m = 0; m < 4; ++m) { const size_t off = (size_t)(u.pm * 256 + ai * 128 + wr * 64 + m * 16 + fr) * D + col0;
#pragma unroll
                for (int bj = 0; bj < 2; ++bj)
#pragma unroll
                    for (int n = 0; n < 2; ++n) *(f32x4*)(wb + off + bj * 128 + n * 16) = xo[m][bj][n] + gv[bj][n] * acc[ai][bj][m][n]; }
        }
    }
};
struct EpiSwiglu {
    static constexpr bool PERM = true, AFTER_DRAIN = false, CHAIN = false;
    bf16_t* h1; int NJ;
    __device__ __forceinline__ void operator()(AccRef acc, const pg8::Unit& u, int wr, int wc, int fr, int fq) const {
        const int row0 = u.pm * 256 + wr * 64 + fr, col = (u.pn % NJ) * 128 + wc * 32 + 8 * fq;
#pragma unroll
        for (int ai = 0; ai < 2; ++ai)
#pragma unroll
            for (int m = 0; m < 4; ++m) { const f32x4 a0 = acc[ai][0][m][0], a1 = acc[ai][0][m][1], b0 = acc[ai][1][m][0], b1 = acc[ai][1][m][1];
                u32x4 w; w.x = pk2(siluf_(a0[0]) * b0[0], siluf_(a0[1]) * b0[1]); w.y = pk2(siluf_(a0[2]) * b0[2], siluf_(a0[3]) * b0[3]);
                w.z = pk2(siluf_(a1[0]) * b1[0], siluf_(a1[1]) * b1[1]); w.w = pk2(siluf_(a1[2]) * b1[2], siluf_(a1[3]) * b1[3]);
                *(u32x4*)(h1 + (size_t)(row0 + ai * 128 + m * 16) * DFF + col) = w; }
    }
};
struct EpiMoeDown {
    static constexpr bool PERM = true, AFTER_DRAIN = false, CHAIN = false;
    bf16_t* y;
    __device__ __forceinline__ void operator()(AccRef acc, const pg8::Unit& u, int wr, int wc, int fr, int fq) const {
        const int row0 = u.pm * 256 + wr * 64 + fr, col = (u.pn % 4) * 256 + wc * 32 + 8 * fq;
#pragma unroll
        for (int ai = 0; ai < 2; ++ai)
#pragma unroll
            for (int m = 0; m < 4; ++m) { bf16_t* rowp = y + (size_t)(row0 + ai * 128 + m * 16) * D + col;
#pragma unroll
                for (int bj = 0; bj < 2; ++bj) { const f32x4 v0 = acc[ai][bj][m][0], v1 = acc[ai][bj][m][1];
                    u32x4 w; w.x = pk2(v0[0], v0[1]); w.y = pk2(v0[2], v0[3]); w.z = pk2(v1[0], v1[1]); w.w = pk2(v1[2], v1[3]);
                    *(u32x4*)(rowp + bj * 128) = w; } }
    }
};
struct MoeOrder {
    int ntiles, NJ, G, c; const int* tile_e;
    __device__ bool next(int i, pg8::Unit& u) const { const long L = (long)i * G + c; if (L >= (long)ntiles * NJ) return false;
        const int t = (int)(L / NJ), j = (int)(L % NJ); u.pm = t; u.pn = tile_e[t] * NJ + j; u.br = 0; return true; }
    __device__ __forceinline__ void a_ready(const pg8::Unit&) const {}
    __device__ __forceinline__ void done(const pg8::Unit&) const {}
};

#define XB_TMO      128
#define XB_XCNT(j)  (256  + 64 * (j))
#define XB_XSUB(j)  (1280 + 64 * (j))
#define XB_XGEN(j)  (2304 + 64 * (j))
#define XB_TOP      3328
#define XB_TOPGEN   3392
#define XCD_BAR_WORDS 3456
#define XB_SPIN_CAP (1u << 18)

__device__ __forceinline__ unsigned xb_ld(unsigned* p)              { return __hip_atomic_load(p, __ATOMIC_RELAXED, __HIP_MEMORY_SCOPE_AGENT); }
__device__ __forceinline__ unsigned xb_add(unsigned* p, unsigned v) { return __hip_atomic_fetch_add(p, v, __ATOMIC_RELAXED, __HIP_MEMORY_SCOPE_AGENT); }
__device__ __forceinline__ unsigned xb_xcc_id() { return (unsigned)__builtin_amdgcn_s_getreg((3 << 11) | 20) & 0xFu; }
#define XB_SPIN(cond, bar) do { unsigned _sp = 0; while (cond) { __builtin_amdgcn_s_sleep(1); \
    if ((++_sp & 255u) == 0u) { if (xb_ld(&(bar)[XB_TMO])) break; if (_sp > XB_SPIN_CAP) { atomicAdd(&(bar)[XB_TMO], 1u); break; } } } } while (0)

struct XcdBarrier {
    unsigned* bar; unsigned x;
    volatile unsigned* st;
};

__device__ __forceinline__ XcdBarrier xcd_barrier_post(unsigned* bar, volatile unsigned* st) {
    XcdBarrier b; b.bar = bar; b.x = xb_xcc_id(); b.st = st;
    if (threadIdx.x == 0) (void)xb_add(&bar[XB_XCNT(b.x)], 1u);
    return b;
}
__device__ __forceinline__ void xcd_barrier_complete(unsigned* bar, unsigned x, unsigned& nloc, unsigned& nx) {
    const unsigned G = gridDim.x * gridDim.y * gridDim.z;
    unsigned sum, cnt, mine, sp = 0u;
    for (;;) {
        sum = 0u; cnt = 0u; mine = 0u;
#pragma unroll
        for (unsigned j = 0; j < 16; ++j) { const unsigned c = xb_ld(&bar[XB_XCNT(j)]); sum += c; cnt += (c > 0u) ? 1u : 0u; mine = (j == x) ? c : mine; }
        if (sum == G) break;
        __builtin_amdgcn_s_sleep(1);
        if ((++sp & 255u) == 0u) { if (xb_ld(&bar[XB_TMO])) break; if (sp > XB_SPIN_CAP) { atomicAdd(&bar[XB_TMO], 1u); break; } }
    }
    nloc = mine > 0u ? mine : 1u; nx = cnt > 0u ? cnt : 1u;
}

__device__ __forceinline__ void xcd_barrier(const XcdBarrier& b) {
    asm volatile("s_waitcnt vmcnt(0)" ::: "memory");
    __syncthreads();
    if (threadIdx.x == 0) {
        unsigned* bar = b.bar;
        __builtin_amdgcn_s_waitcnt(0);
        unsigned nloc = b.st[0], nx = b.st[1];
        if (nloc == 0u) { xcd_barrier_complete(bar, b.x, nloc, nx); b.st[0] = nloc; b.st[1] = nx; }
        const unsigned old = xb_add(&bar[XB_XSUB(b.x)], 1u);
        const unsigned gen = old / nloc;
        if (old + 1u == (gen + 1u) * nloc) {
            __builtin_amdgcn_fence(__ATOMIC_RELEASE, "agent");
            asm volatile("s_waitcnt vmcnt(0)" ::: "memory");
            const unsigned og = xb_add(&bar[XB_TOP], 1u);
            const unsigned tg = og / nx;
            if (og + 1u == (tg + 1u) * nx) xb_add(&bar[XB_TOPGEN], 1u);
            else XB_SPIN(xb_ld(&bar[XB_TOPGEN]) == tg, bar);
            __builtin_amdgcn_fence(__ATOMIC_ACQUIRE, "agent");
            xb_add(&bar[XB_XGEN(b.x)], 1u);
            asm volatile("s_waitcnt vmcnt(0)" ::: "memory");
        } else {
            XB_SPIN(xb_ld(&bar[XB_XGEN(b.x)]) == gen, bar);
            __builtin_amdgcn_fence(__ATOMIC_ACQUIRE, "agent");
            asm volatile("s_waitcnt vmcnt(0)" ::: "memory");
        }
    }
    __syncthreads();
}

__device__ __forceinline__ void phase_mod(const P& p, unsigned char* lds) {
    float* sc = (float*)lds;
    float* red = sc + 9 * 1024;
    const int tid = otid();
    for (int i = tid; i < 9 * 1024; i += NTHREADS) { const int r = i >> 10, k = i & 1023; const float v = r < 8 ? p.c[r * 1024 + k] : p.c_ctx[k]; sc[i] = siluf_(v); }
    __syncthreads();
    float* MOD = (float*)(p.ws + WS_MOD);
    const int cj = tid % 48, ks = tid / 48;
    for (int grp = blockIdx.x; grp < DEPTH * 6144 / 48; grp += gridDim.x) {
        const int l = grp / 128, j = (grp % 128) * 48 + cj;
        float a[9];
#pragma unroll
        for (int r = 0; r < 9; ++r) a[r] = 0.f;
        if (ks < 10) {
            const float* w = p.w_mod + (size_t)l * 1024 * 6144 + j;
            for (int k = ks; k < 1024; k += 10) { const float wv = w[(size_t)k * 6144];
#pragma unroll
                for (int r = 0; r < 9; ++r) a[r] += sc[r * 1024 + k] * wv; }
#pragma unroll
            for (int r = 0; r < 9; ++r) red[(ks * 9 + r) * 48 + cj] = a[r];
        }
        __syncthreads();
        if (tid < 9 * 48) { const int r = tid / 48, c2 = tid % 48; float s = 0.f;
#pragma unroll
            for (int q = 0; q < 10; ++q) s += red[(q * 9 + r) * 48 + c2];
            const int jj = (grp % 128) * 48 + c2;
            MOD[((size_t)l * 9 + r) * 6144 + jj] = s + p.b_mod[l * 6144 + jj]; }
        __syncthreads();
    }
}

__device__ __forceinline__ void phase_modulate(const float* src_l, const float* src_c, int nrows, const float* gain, const float* mod, int shift_idx,
                                               bf16_t* H, const float* router_w, int* route, unsigned* ecnt, unsigned* lcnt  , int gw, int NGW, int lane) {
    if (router_w) { if (otid() < NE) lcnt[otid()] = 0u; __syncthreads(); }
    for (int r0_ = gw; r0_ < nrows; r0_ += 4 * NGW)
#pragma unroll
    for (int rr_ = 0; rr_ < 4; ++rr_) { const int r = r0_ + rr_ * NGW; if (r >= nrows) break;
        const bool isctx = r >= TL; const int b = isctx ? 8 : r / SEQ;
        const float* xr = isctx ? src_c + (size_t)(r - TL) * D : src_l + (size_t)r * D;
        const float* sh = mod + (size_t)b * 6144 + shift_idx * 1024; const float* scl = sh + 1024;
        f32x4 v[4]; float ss = 0.f;
#pragma unroll
        for (int j = 0; j < 4; ++j) { v[j] = *(const f32x4*)(xr + 4 * lane + 256 * j); ss += (v[j][0] * v[j][0] + v[j][1] * v[j][1]) + (v[j][2] * v[j][2] + v[j][3] * v[j][3]); }
        const float rs = 1.0f / sqrtf(wave_sum(ss) * (1.0f / D) + EPS);
#pragma unroll
        for (int j = 0; j < 4; ++j) { const int c = 4 * lane + 256 * j; const f32x4 g = *(const f32x4*)(gain + c), s1 = *(const f32x4*)(scl + c), s0 = *(const f32x4*)(sh + c);
            v[j] = v[j] * rs * g * (1.0f + s1) + s0;
            u32x2 w; w.x = pk2(v[j][0], v[j][1]); w.y = pk2(v[j][2], v[j][3]);
            *(u32x2*)(H + (size_t)r * D + c) = w; }
        if (router_w) {
            float lg[NE];
#pragma unroll
            for (int e = 0; e < NE; ++e) lg[e] = 0.f;
#pragma unroll
            for (int j = 0; j < 4; ++j)
#pragma unroll
                for (int q = 0; q < 4; ++q) { const float* rw = router_w + (size_t)(4 * lane + 256 * j + q) * NE; const f32x4 r0 = *(const f32x4*)rw, r1 = *(const f32x4*)(rw + 4); const float hv = v[j][q];
                    lg[0] += hv * r0[0]; lg[1] += hv * r0[1]; lg[2] += hv * r0[2]; lg[3] += hv * r0[3]; lg[4] += hv * r1[0]; lg[5] += hv * r1[1]; lg[6] += hv * r1[2]; lg[7] += hv * r1[3]; }
#pragma unroll
            for (int e = 0; e < NE; ++e) lg[e] = wave_sum(lg[e]);
            int e1 = 0; float v1 = lg[0];
#pragma unroll
            for (int e = 1; e < NE; ++e) if (lg[e] > v1) { v1 = lg[e]; e1 = e; }
            int e2 = e1 == 0 ? 1 : 0; float v2 = lg[e2];
#pragma unroll
            for (int e = 0; e < NE; ++e) if (e != e1 && lg[e] > v2) { v2 = lg[e]; e2 = e; }
            const float w2 = 1.0f / (1.0f + expf(v1 - v2)), w1 = 1.0f - w2;
            if (lane == 0) { route[r * 4 + 0] = e1; route[r * 4 + 1] = e2; ((float*)route)[r * 4 + 2] = w1; ((float*)route)[r * 4 + 3] = w2;
                atomicAdd(lcnt + e1, 1u); atomicAdd(lcnt + e2, 1u); }
        }
    }
    if (router_w) { __syncthreads(); if (otid() < NE && lcnt[otid()]) atomicAdd(ecnt + otid(), lcnt[otid()]); }
}


typedef short v4i16_t __attribute__((ext_vector_type(4)));
__device__ __forceinline__ s16x4 lds_tr(const bf16_t* pp) { return __builtin_bit_cast(s16x4, __builtin_amdgcn_ds_read_tr16_b64_v4i16((__attribute__((address_space(3))) v4i16_t*)pp)); }
__device__ __forceinline__ bf16x8 cat8(s16x4 a, s16x4 b) { union { bf16x8 v; s16x4 h[2]; } u; u.h[0] = a; u.h[1] = b; return u.v; }
__device__ __forceinline__ bf16x8 pack8(f32x4 a, f32x4 b) { union { bf16x8 v; unsigned u[4]; } r; r.u[0] = pk2(a[0], a[1]); r.u[1] = pk2(a[2], a[3]); r.u[2] = pk2(b[0], b[1]); r.u[3] = pk2(b[2], b[3]); return r.v; }
constexpr int DN_NCH = (CTXL + SEQ) / 64;
constexpr int DN_ITEMS = BATCH * 4 * DN_NCH;
constexpr int PREP_WLDS = 10240 + 17408 + 1024 + 2304;
constexpr int PREP_NW = 5;

__device__ __forceinline__ int dn_row(int n, int s, int b, int dir) {
    const bool isctx = n < CTXL / 64; const int L = isctx ? CTXL : SEQ, c = isctx ? n : n - CTXL / 64, u = 64 * c + s, t = dir ? L - 1 - u : u;
    return (isctx ? TL + b * CTXL : b * SEQ) + t;
}
__device__ __forceinline__ void dn_prep_item(const P& p, int l, int item, unsigned char* wlds, int lane) {
    asm volatile("" : "+v"(lane));
    const int cn = item % DN_NCH, bh = item / DN_NCH, h = bh & 3, b = bh >> 2;
    const bool isctx = cn < CTXL / 64; const int L = isctx ? CTXL : SEQ, cch = isctx ? cn : cn - CTXL / 64, rbase = isctx ? TL + b * CTXL : b * SEQ, nchp = L / 64;
    const int item0 = (bh * 2 + 0) * DN_NCH + cn, item1 = (bh * 2 + 1) * DN_NCH + (isctx ? nchp - 1 - cch : CTXL / 64 + nchp - 1 - cch);
    const int i16 = lane & 15, g = lane >> 4;
    const bf16_t* PAQ = (const bf16_t*)(p.ws + WS_PAQ); bf16_t* DN = (bf16_t*)(p.ws + WS_DNQKV); const float* SMALL = (const float*)(p.ws + WS_SMALL);
    const float* cw = p.conv_a + (size_t)l * 3 * 1536;
    constexpr int KCP = 136;
    float* Ls = (float*)wlds; bf16_t* Kc = (bf16_t*)(wlds + 10240); bf16_t* Tl = (bf16_t*)(wlds + 10240 + 9216);
    float* gc0 = (float*)(wlds + 10240 + 17408); float* be0 = gc0 + 64; float* sf1 = be0 + 64; float* be1 = sf1 + 64;
    bf16_t* cwl = (bf16_t*)(wlds + 10240 + 17408 + 1024);
    for (int i = lane; i < 3 * 384 / 2; i += 64) { const int tap = i / 192, c2 = (i % 192) * 2, sg = c2 >> 7, cc = c2 & 127; const float* src_ = cw + tap * 1536 + sg * 512 + h * 128 + cc;
        *(unsigned*)(cwl + tap * 384 + c2) = pk2(src_[0], src_[1]); }
    {
        const size_t r = (size_t)(rbase + 64 * cch + lane);
        const f32x4 s0 = *(const f32x4*)(SMALL + r * 64), s1 = *(const f32x4*)(SMALL + r * 64 + 4), s2 = *(const f32x4*)(SMALL + r * 64 + 8), s3 = *(const f32x4*)(SMALL + r * 64 + 12);
        const float g0v = -expf(p.a_log[l * 8 + h]) * softplusf_(s2[h] + p.dt_bias[l * 8 + h]), g1v = -expf(p.a_log[l * 8 + 4 + h]) * softplusf_(s3[h] + p.dt_bias[l * 8 + 4 + h]);
        const float b0v = sigmoidf_(s0[h]), b1v = sigmoidf_(s1[h]);
        float c0 = g0v, c1 = g1v;
#pragma unroll
        for (int o = 1; o < 64; o <<= 1) { const float u0 = shup(c0, o), u1 = shup(c1, o); if (lane >= o) { c0 += u0; c1 += u1; } }
        const float t0 = shlane(c0, 63), t1 = shlane(c1, 63), sf = t1 - c1 + g1v;
        gc0[lane] = c0; be0[lane] = b0v; sf1[lane] = sf; be1[lane] = b1v;
        float* v0 = (float*)(p.ws + WS_VEC) + (size_t)item0 * 256; float* v1 = (float*)(p.ws + WS_VEC) + (size_t)item1 * 256;
        v0[lane] = expf(c0); v0[64 + lane] = expf(t0 - c0); v0[128 + lane] = b0v; v0[192 + lane] = expf(t0);
        v1[63 - lane] = expf(sf); v1[64 + 63 - lane] = expf(t1 - sf); v1[128 + 63 - lane] = b1v; v1[192 + lane] = expf(t1);
    }
    struct SegRows { u32x4 x[6][4]; };
    auto seg_load = [&](int seg, SegRows& Sg) {
        int lo_ = lane; asm volatile("" : "+v"(lo_));
        const int i16 = lo_ & 15, g = lo_ >> 4;
#pragma unroll
        for (int f = 0; f < 6; ++f) { const int t = 64 * cch + 16 * (f - 1) + i16; const bool ok = t >= 0 && t < L; const size_t r = (size_t)(rbase + (ok ? t : 0));
#pragma unroll
            for (int ks = 0; ks < 4; ++ks) { Sg.x[f][ks] = (u32x4){0u, 0u, 0u, 0u}; if (ok) Sg.x[f][ks] = *(const u32x4*)(PAQ + r * 1536 + seg * 512 + h * 128 + 32 * ks + 8 * g); } }
    };
    auto tap_prev = [&](unsigned own, unsigned before) -> unsigned {
        const int t0 = __builtin_amdgcn_update_dpp(0, (int)before, 0x121  , 0xF, 0xF, false);
        return (unsigned)__builtin_amdgcn_update_dpp(t0, (int)own, 0x111  , 0xF, 0xF, false); };
    auto tap_next = [&](unsigned own, unsigned after) -> unsigned {
        const int t0 = __builtin_amdgcn_update_dpp(0, (int)after, 0x12F  , 0xF, 0xF, false);
        return (unsigned)__builtin_amdgcn_update_dpp(t0, (int)own, 0x101  , 0xF, 0xF, false); };
    auto conv_compute = [&](int seg, int mt, const SegRows& Sg, bf16x8 (&F)[4]) {
        const int t = 64 * cch + 16 * mt + i16; const size_t r = (size_t)(rbase + t);
        float y[4][8]; float ss = 0.f;
#pragma unroll
        for (int ks = 0; ks < 4; ++ks) {
            const int wo_ = seg * 128 + 32 * ks + 8 * g;
            const u32x4 wa = *(const u32x4*)(cwl + wo_), wb = *(const u32x4*)(cwl + 384 + wo_), wc = *(const u32x4*)(cwl + 768 + wo_);
            const u32x4 o_ = Sg.x[1 + mt][ks], pb_ = Sg.x[mt][ks], nb_ = Sg.x[2 + mt][ks];
            const unsigned xb[4] = {o_.x, o_.y, o_.z, o_.w}, xa[4] = {tap_prev(o_.x, pb_.x), tap_prev(o_.y, pb_.y), tap_prev(o_.z, pb_.z), tap_prev(o_.w, pb_.w)}, xc[4] = {tap_next(o_.x, nb_.x), tap_next(o_.y, nb_.y), tap_next(o_.z, nb_.z), tap_next(o_.w, nb_.w)};
            const unsigned wA[4] = {wa.x, wa.y, wa.z, wa.w}, wB[4] = {wb.x, wb.y, wb.z, wb.w}, wC[4] = {wc.x, wc.y, wc.z, wc.w};
#pragma unroll
            for (int q = 0; q < 4; ++q) {
                const float v0 = siluf_(bflo(wA[q]) * bflo(xa[q]) + bflo(wB[q]) * bflo(xb[q]) + bflo(wC[q]) * bflo(xc[q])), v1 = siluf_(bfhi(wA[q]) * bfhi(xa[q]) + bfhi(wB[q]) * bfhi(xb[q]) + bfhi(wC[q]) * bfhi(xc[q]));
                y[ks][2 * q] = v0; y[ks][2 * q + 1] = v1; ss += v0 * v0 + v1 * v1; }
        }
        float sc = 1.0f;
        if (seg < 2) { ss += shx(ss, 16); ss += shx(ss, 32); sc = 1.0f / sqrtf(ss + EPS); if (seg == 0) sc *= 0.08838834764831845f; }
#pragma unroll
        for (int ks = 0; ks < 4; ++ks) { union { bf16x8 v; u32x4 w; } f;
            f.w.x = pk2(y[ks][0] * sc, y[ks][1] * sc); f.w.y = pk2(y[ks][2] * sc, y[ks][3] * sc); f.w.z = pk2(y[ks][4] * sc, y[ks][5] * sc); f.w.w = pk2(y[ks][6] * sc, y[ks][7] * sc);
            F[ks] = f.v;
            *(u32x4*)(DN + r * 1536 + seg * 512 + h * 128 + 32 * ks + 8 * g) = f.w; }
    };
    { PH_BEGIN(12); {
#pragma unroll 1
      for (int sg = 0; sg < 2; ++sg) { const int seg = sg == 0 ? 1 : 2;
        SegRows Sg; seg_load(seg, Sg);
#pragma unroll
        for (int mt = 0; mt < 4; ++mt) { bf16x8 F[4];
            conv_compute(seg, mt, Sg, F);
            if (seg == 1) {
#pragma unroll
                for (int ks = 0; ks < 4; ++ks) *(bf16x8*)(Kc + (16 * mt + i16) * KCP + 32 * ks + 8 * g) = F[ks]; } } } } PH_END(12); }
    asm volatile("s_waitcnt lgkmcnt(0)" ::: "memory");
    f32x4 Ut[10];
    { PH_BEGIN(13);
    bf16_t* QK0g = (bf16_t*)(p.ws + WS_TQ + (size_t)item0 * 16384 + 8192); bf16_t* QK1g = (bf16_t*)(p.ws + WS_TQ + (size_t)item1 * 16384 + 8192);
    auto qk_tiles = [&](int mt, const bf16x8 (&Qf)[4]) {
#pragma unroll 1
        for (int nt = 0; nt < 4; ++nt) { f32x4 acc = (f32x4){0.f, 0.f, 0.f, 0.f}; const int j = 16 * nt + i16;
#pragma unroll
            for (int ks = 0; ks < 4; ++ks) acc = __builtin_amdgcn_mfma_f32_16x16x32_bf16(Qf[ks], *(const bf16x8*)(Kc + (16 * nt + i16) * KCP + 32 * ks + 8 * g), acc, 0, 0, 0);
            const float gj = gc0[j], sj = sf1[j];
#pragma unroll
            for (int rg = 0; rg < 4; ++rg) { const int i = 16 * mt + 4 * g + rg;
                const float q0 = i >= j ? acc[rg] * __expf(gc0[i] - gj) : 0.f, q1 = i <= j ? acc[rg] * __expf(sf1[i] - sj) : 0.f;
                QK0g[i * 64 + j] = (bf16_t)f2bf(q0); QK1g[(63 - i) * 64 + (63 - j)] = (bf16_t)f2bf(q1); } } };
    { SegRows Sg; seg_load(0, Sg);
#pragma unroll
      for (int mt = 0; mt < 4; ++mt) { bf16x8 Qf[4]; conv_compute(0, mt, Sg, Qf); qk_tiles(mt, Qf); } }
#pragma unroll
    for (int mt = 0; mt < 4; ++mt) {
        bf16x8 A[4];
#pragma unroll
        for (int ks = 0; ks < 4; ++ks) A[ks] = *(const bf16x8*)(Kc + (16 * mt + i16) * KCP + 32 * ks + 8 * g);
#pragma unroll
        for (int nt = 0; nt < 4; ++nt) { f32x4 acc = (f32x4){0.f, 0.f, 0.f, 0.f};
#pragma unroll
            for (int ks = 0; ks < 4; ++ks) acc = __builtin_amdgcn_mfma_f32_16x16x32_bf16(A[ks], *(const bf16x8*)(Kc + (16 * nt + i16) * KCP + 32 * ks + 8 * g), acc, 0, 0, 0);
            const int j = 16 * nt + i16;
            if (mt >= nt) { const float gj = gc0[j]; f32x4 lv;
#pragma unroll
                for (int rg = 0; rg < 4; ++rg) { const int i = 16 * mt + 4 * g + rg; lv[rg] = i > j ? be0[i] * acc[rg] * __expf(gc0[i] - gj) : 0.f; }
                *(f32x4*)(Ls + ((mt * (mt + 1)) / 2 + nt) * 256 + i16 * 16 + 4 * g) = lv; }
            if (mt <= nt) { const float sj = sf1[j]; f32x4 uv;
#pragma unroll
                for (int rg = 0; rg < 4; ++rg) { const int i = 16 * mt + 4 * g + rg; uv[rg] = i < j ? be1[i] * acc[rg] * __expf(sf1[i] - sj) : 0.f; }
                Ut[(nt * (nt + 1)) / 2 + mt] = uv; }
            asm volatile("" ::: "memory"); }
    }
    PH_END(13); }
    asm volatile("s_waitcnt lgkmcnt(0)" ::: "memory");
    auto solve = [&](int itemd) {
        constexpr int LP = 72;
        bf16_t* Lb = (bf16_t*)(wlds + 10240); bf16_t* Tt = (bf16_t*)wlds; bf16_t* Dv = (bf16_t*)(wlds + 10240 + 17408 + 1024);
        {
            const int Bq = lane >> 4, cq = lane & 15; const float* lblk = Ls + ((Bq * (Bq + 1)) / 2 + Bq) * 256;
            float x[16];
#pragma unroll
            for (int ii = 0; ii < 16; ++ii) x[ii] = (ii == cq) ? 1.f : 0.f;
#pragma unroll
            for (int jj = 0; jj < 15; ++jj) { const float tj = x[jj]; const float* lc = lblk + jj * 16;
                const f32x4 l0 = *(const f32x4*)lc, l1 = *(const f32x4*)(lc + 4), l2 = *(const f32x4*)(lc + 8), l3 = *(const f32x4*)(lc + 12);
#pragma unroll
                for (int q = 0; q < 4; ++q) { if (q > jj) x[q] -= l0[q] * tj; if (4 + q > jj) x[4 + q] -= l1[q] * tj; if (8 + q > jj) x[8 + q] -= l2[q] * tj; if (12 + q > jj) x[12 + q] -= l3[q] * tj; } }
#pragma unroll
            for (int ii = 0; ii < 16; ++ii) Dv[(Bq * 16 + ii) * 16 + cq] = (bf16_t)f2bf(x[ii]);
        }
        {
            const int jl = lane >> 2, iq = lane & 3;
#pragma unroll
            for (int bi = 0; bi < 4; ++bi)
#pragma unroll
                for (int bj = 0; bj <= bi; ++bj) { const f32x4 lv = *(const f32x4*)(Ls + ((bi * (bi + 1)) / 2 + bj) * 256 + jl * 16 + 4 * iq);
#pragma unroll
                    for (int q = 0; q < 4; ++q) Lb[(16 * bi + 4 * iq + q) * LP + 16 * bj + jl] = (bf16_t)f2bf(lv[q]); }
        }
        asm volatile("s_waitcnt lgkmcnt(0)" ::: "memory");
        unsigned z_ = 0u; asm volatile("" : "+v"(z_));
        const u32x4 zz = (u32x4){z_, z_, z_, z_};
#pragma unroll
        for (int q = 0; q < 9; ++q) ((u32x4*)Tt)[q * 64 + lane] = zz;
#pragma unroll
        for (int q = 0; q < 8; ++q) ((u32x4*)Tl)[q * 64 + lane] = zz;
        asm volatile("s_waitcnt lgkmcnt(0)" ::: "memory");
#pragma unroll
        for (int B = 0; B < 4; ++B) {
            const bf16x8 aD = cat8(*(const s16x4*)(Dv + (B * 16 + i16) * 16 + 4 * g), (s16x4){0, 0, 0, 0});
#pragma unroll
            for (int nt = 0; nt <= B; ++nt) {
                f32x4 acc = (f32x4){0.f, 0.f, 0.f, 0.f};
#pragma unroll
                for (int ks = 0; ks < (B + 1) / 2; ++ks)
                    acc = __builtin_amdgcn_mfma_f32_16x16x32_bf16(*(const bf16x8*)(Lb + (16 * B + i16) * LP + 32 * ks + 8 * g), *(const bf16x8*)(Tt + (16 * nt + i16) * LP + 32 * ks + 8 * g), acc, 0, 0, 0);
                f32x4 sv;
#pragma unroll
                for (int r = 0; r < 4; ++r) sv[r] = ((nt == B && 4 * g + r == i16) ? 1.f : 0.f) - acc[r];
                const f32x4 tv = __builtin_amdgcn_mfma_f32_16x16x32_bf16(aD, pack8(sv, (f32x4){0.f, 0.f, 0.f, 0.f}), (f32x4){0.f, 0.f, 0.f, 0.f}, 0, 0, 0);
                u32x2 tw; tw.x = pk2(tv[0], tv[1]); tw.y = pk2(tv[2], tv[3]);
                *(u32x2*)(Tt + (16 * nt + i16) * LP + 16 * B + 4 * g) = tw;
#pragma unroll
                for (int r = 0; r < 4; ++r) Tl[(16 * B + 4 * g + r) * 64 + 16 * nt + i16] = (bf16_t)f2bf(tv[r]);
            }
            asm volatile("s_waitcnt lgkmcnt(0)" ::: "memory");
        }
        { const u32x4* srcl = (const u32x4*)Tl; u32x4* dstg = (u32x4*)(p.ws + WS_TQ + (size_t)itemd * 16384);
#pragma unroll
          for (int q = 0; q < 8; ++q) dstg[q * 64 + lane] = srcl[q * 64 + lane]; }
        asm volatile("s_waitcnt lgkmcnt(0)" ::: "memory");
    };
    { PH_BEGIN(14);
    solve(item0);
#pragma unroll
    for (int nt = 0; nt < 4; ++nt)
#pragma unroll
        for (int mt = 0; mt <= nt; ++mt) { const f32x4 uv = Ut[(nt * (nt + 1)) / 2 + mt]; const int bi_ = 3 - mt, bj_ = 3 - nt;
            *(f32x4*)(Ls + ((bi_ * (bi_ + 1)) / 2 + bj_) * 256 + (15 - i16) * 16 + (12 - 4 * g)) = (f32x4){uv[3], uv[2], uv[1], uv[0]}; }
    asm volatile("s_waitcnt lgkmcnt(0)" ::: "memory");
    solve(item1);
    PH_END(14); }
}

__device__ __forceinline__ void dn_chain_mfma(const P& p, int item, unsigned char* lds) {
    const int b = item >> 3, h = (item >> 1) & 3, dir = item & 1, tid = otid(), lane = tid & 63, w = tid >> 6, i16 = lane & 15, g = lane >> 4;
    constexpr int KP = 136, TP = 72;
    bf16_t* Ks = (bf16_t*)lds; bf16_t* Qs = Ks + 64 * KP; bf16_t* Vs = Qs + 64 * KP; bf16_t* Ts = Vs + 64 * KP; bf16_t* QKs = Ts + 64 * TP; float* vec = (float*)(QKs + 64 * TP);
    const bf16_t* DN = (const bf16_t*)(p.ws + WS_DNQKV); bf16_t* OA = (bf16_t*)(p.ws + WS_H) + (size_t)dir * T * 512;
    f32x4 S[8];
#pragma unroll
    for (int dt = 0; dt < 8; ++dt) S[dt] = (f32x4){0.f, 0.f, 0.f, 0.f};
    u32x4 pf[9];
    auto prefetch = [&](int n) {
        const int pitem = item * DN_NCH + n;
#pragma unroll
        for (int u = 0; u < 6; ++u) { const int q = tid + 512 * u, which = q >> 10, rem = q & 1023, s = rem >> 4, ch = rem & 15;
            pf[u] = *(const u32x4*)(DN + (size_t)dn_row(n, s, b, dir) * 1536 + (which == 0 ? 512 : which == 1 ? 0 : 1024) + h * 128 + ch * 8); }
#pragma unroll
        for (int u = 0; u < 2; ++u) pf[6 + u] = *(const u32x4*)(p.ws + WS_TQ + (size_t)pitem * 16384 + (size_t)u * 8192 + (size_t)tid * 16);
        if (tid < 64) pf[8] = *(const u32x4*)((const float*)(p.ws + WS_VEC) + (size_t)pitem * 256 + tid * 4);
    };
    prefetch(0);
    for (int n = 0; n < DN_NCH; ++n) {
        __syncthreads();
#pragma unroll
        for (int u = 0; u < 6; ++u) { const int q = tid + 512 * u, which = q >> 10, rem = q & 1023, s = rem >> 4, ch = rem & 15;
            *(u32x4*)((which == 0 ? Ks : which == 1 ? Qs : Vs) + s * KP + ch * 8) = pf[u]; }
#pragma unroll
        for (int u = 0; u < 2; ++u) *(u32x4*)((u == 0 ? Ts : QKs) + (tid >> 3) * TP + (tid & 7) * 8) = pf[6 + u];
        if (tid < 64) *(u32x4*)(vec + tid * 4) = pf[8];
        __syncthreads();
        if (n + 1 < DN_NCH) prefetch(n + 1);
        const float* egv = vec; const float* eklv = vec + 64; const float* bev = vec + 128; const float glast = vec[192];
#define SB __builtin_amdgcn_sched_barrier(0)
        bf16x8 Sb[4];
#pragma unroll
        for (int ks = 0; ks < 4; ++ks) Sb[ks] = pack8(S[2 * ks], S[2 * ks + 1]);
        f32x4 r_[4], o_[4];
        bf16x8 akA[4], aqA[4], akB[4], aqB[4];
#define DN_LDKQ(mt_, ak_, aq_) do { const bf16_t* kr = Ks + (16 * (mt_) + i16) * KP + 4 * g; const bf16_t* qr = Qs + (16 * (mt_) + i16) * KP + 4 * g; \
            _Pragma("unroll") for (int ks = 0; ks < 4; ++ks) { ak_[ks] = cat8(*(const s16x4*)(kr + 32 * ks), *(const s16x4*)(kr + 32 * ks + 16)); aq_[ks] = cat8(*(const s16x4*)(qr + 32 * ks), *(const s16x4*)(qr + 32 * ks + 16)); } } while (0)
#define DN_MMKQ(mt_, ak_, aq_) do { r_[mt_] = (f32x4){0.f, 0.f, 0.f, 0.f}; o_[mt_] = (f32x4){0.f, 0.f, 0.f, 0.f}; \
            _Pragma("unroll") for (int ks = 0; ks < 4; ++ks) { r_[mt_] = __builtin_amdgcn_mfma_f32_16x16x32_bf16(ak_[ks], Sb[ks], r_[mt_], 0, 0, 0); o_[mt_] = __builtin_amdgcn_mfma_f32_16x16x32_bf16(aq_[ks], Sb[ks], o_[mt_], 0, 0, 0); } } while (0)
        DN_LDKQ(0, akA, aqA); SB;
        DN_LDKQ(1, akB, aqB); DN_MMKQ(0, akA, aqA); SB;
        DN_LDKQ(2, akA, aqA); DN_MMKQ(1, akB, aqB); SB;
        DN_LDKQ(3, akB, aqB); DN_MMKQ(2, akA, aqA); SB;
        f32x4 eg[4], be[4]; float vv[4][4];
#pragma unroll
        for (int mt = 0; mt < 4; ++mt) { eg[mt] = *(const f32x4*)(egv + 16 * mt + 4 * g); be[mt] = *(const f32x4*)(bev + 16 * mt + 4 * g);
#pragma unroll
            for (int rg = 0; rg < 4; ++rg) vv[mt][rg] = bf2f(Vs[(16 * mt + 4 * g + rg) * KP + 16 * w + i16]); }
        DN_MMKQ(3, akB, aqB); SB;
#undef DN_LDKQ
#undef DN_MMKQ
        bf16x8 tf[4][2], qf[4][2];
#pragma unroll
        for (int mt = 0; mt < 4; ++mt) { const bf16_t* tr = Ts + (16 * mt + i16) * TP + 4 * g;
#pragma unroll
            for (int k2 = 0; k2 < 2; ++k2) tf[mt][k2] = cat8(*(const s16x4*)(tr + 32 * k2), *(const s16x4*)(tr + 32 * k2 + 16)); }
        f32x4 e0v[2], e1v[2];
#pragma unroll
        for (int k2 = 0; k2 < 2; ++k2) { e0v[k2] = *(const f32x4*)(eklv + 32 * k2 + 4 * g); e1v[k2] = *(const f32x4*)(eklv + 32 * k2 + 16 + 4 * g); }
#pragma unroll
        for (int mt = 0; mt < 4; ++mt)
#pragma unroll
            for (int rg = 0; rg < 4; ++rg) { r_[mt][rg] = be[mt][rg] * (vv[mt][rg] - eg[mt][rg] * r_[mt][rg]); o_[mt][rg] *= eg[mt][rg]; }
        bf16x8 Rb[2];
#pragma unroll
        for (int k2 = 0; k2 < 2; ++k2) Rb[k2] = pack8(r_[2 * k2], r_[2 * k2 + 1]);
        SB;
#pragma unroll
        for (int mt = 0; mt < 4; ++mt) { const bf16_t* qkr = QKs + (16 * mt + i16) * TP + 4 * g;
#pragma unroll
            for (int k2 = 0; k2 < 2; ++k2) qf[mt][k2] = cat8(*(const s16x4*)(qkr + 32 * k2), *(const s16x4*)(qkr + 32 * k2 + 16)); }
        f32x4 vn[4];
#pragma unroll
        for (int mt = 0; mt < 4; ++mt) { vn[mt] = (f32x4){0.f, 0.f, 0.f, 0.f};
#pragma unroll
            for (int k2 = 0; k2 < 2; ++k2) vn[mt] = __builtin_amdgcn_mfma_f32_16x16x32_bf16(tf[mt][k2], Rb[k2], vn[mt], 0, 0, 0); }
        SB;
        bf16x8 Vb[2], Wb[2];
#pragma unroll
        for (int k2 = 0; k2 < 2; ++k2) { Vb[k2] = pack8(vn[2 * k2], vn[2 * k2 + 1]); Wb[k2] = pack8(vn[2 * k2] * e0v[k2], vn[2 * k2 + 1] * e1v[k2]); }
        bf16x8 ktA[4][2], ktB[4][2];
#pragma unroll
        for (int dt = 0; dt < 4; ++dt)
#pragma unroll
            for (int k2 = 0; k2 < 2; ++k2) { const bf16_t* a0 = Ks + (32 * k2 + 4 * g + (i16 >> 2)) * KP + 16 * dt + 4 * (i16 & 3); ktA[dt][k2] = cat8(lds_tr(a0), lds_tr(a0 + 16 * KP)); }
#pragma unroll
        for (int mt = 0; mt < 4; ++mt)
#pragma unroll
            for (int k2 = 0; k2 < 2; ++k2) o_[mt] = __builtin_amdgcn_mfma_f32_16x16x32_bf16(qf[mt][k2], Vb[k2], o_[mt], 0, 0, 0);
        SB;
#pragma unroll
        for (int dt = 0; dt < 4; ++dt)
#pragma unroll
            for (int k2 = 0; k2 < 2; ++k2) { const bf16_t* a0 = Ks + (32 * k2 + 4 * g + (i16 >> 2)) * KP + 16 * (dt + 4) + 4 * (i16 & 3); ktB[dt][k2] = cat8(lds_tr(a0), lds_tr(a0 + 16 * KP)); }
#pragma unroll
        for (int dt = 0; dt < 4; ++dt) { S[dt] = S[dt] * glast;
#pragma unroll
            for (int k2 = 0; k2 < 2; ++k2) S[dt] = __builtin_amdgcn_mfma_f32_16x16x32_bf16(ktA[dt][k2], Wb[k2], S[dt], 0, 0, 0); }
        SB;
#pragma unroll
        for (int dt = 0; dt < 4; ++dt) { S[dt + 4] = S[dt + 4] * glast;
#pragma unroll
            for (int k2 = 0; k2 < 2; ++k2) S[dt + 4] = __builtin_amdgcn_mfma_f32_16x16x32_bf16(ktB[dt][k2], Wb[k2], S[dt + 4], 0, 0, 0); }
#undef SB
#pragma unroll
        for (int mt = 0; mt < 4; ++mt)
#pragma unroll
            for (int rg = 0; rg < 4; ++rg) OA[(size_t)dn_row(n, 16 * mt + 4 * g + rg, b, dir) * 512 + h * 128 + 16 * w + i16] = (bf16_t)f2bf(o_[mt][rg]);
    }
}

__device__ __forceinline__ void phase_prep(const P& p, int l, unsigned char* lds, int gw, int NGW, int lane) {
    unsigned char* ws = p.ws;
    bf16_t* PC = (bf16_t*)(ws + WS_PC); unsigned* ctl = (unsigned*)(ws + WS_CTL);
    float* rtab = (float*)(lds + PREP_NW * PREP_WLDS);
    { const int tid = otid();
#pragma unroll
      for (int u = 0; u < 2; ++u) { const int e = tid + 512 * u, pos = e >> 4, fi = e & 15; const float ang = (float)pos * exp2f(-(float)fi * 0.8304820237218406f);
          float sn, cs; sincosf(ang, &sn, &cs); rtab[2 * e] = cs; rtab[2 * e + 1] = sn; }
      __syncthreads(); }
    const int wv = gw % NWAVES, blk = gw / NWAVES, G_ = NGW / NWAVES;
    if (wv < PREP_NW) { for (int rep = 0; rep < REP_DNPREP; ++rep) for (int it = blk * PREP_NW + wv; it < DN_ITEMS; it += G_ * PREP_NW) dn_prep_item(p, l, it, lds + wv * PREP_WLDS, lane); return; }
    const int gt = (blk * (NWAVES - PREP_NW) + (wv - PREP_NW)) * 64 + lane, NGT = G_ * (NWAVES - PREP_NW) * 64;
    float kmx = 0.f; int kbb = -1;
    const int q_ = gt & 31, seg = q_ >> 4, hh = (q_ >> 2) & 3, mm = (q_ >> 1) & 1, half = q_ & 1;
    const int rows_per = (T + NGT / 32 - 1) / (NGT / 32);
    for (int k_ = 0; k_ < rows_per; ++k_) {
        const int r = (gt >> 5) * rows_per + k_; if (r >= T) break; const bool lat = r < TL; const int b = lat ? r / SEQ : (r - TL) / CTXL;
        bf16_t* base = PC + (size_t)r * 1536 + seg * 512 + hh * 128 + mm * 64 + half * 32;
        const u32x4 a0 = *(const u32x4*)base, a1 = *(const u32x4*)(base + 8), b0 = *(const u32x4*)(base + 16), b1 = *(const u32x4*)(base + 24);
        const unsigned xa[8] = {a0.x, a0.y, a0.z, a0.w, a1.x, a1.y, a1.z, a1.w}, xb[8] = {b0.x, b0.y, b0.z, b0.w, b1.x, b1.y, b1.z, b1.w};
        const int t = r % SEQ, pos = half ? (t & 63) : (t >> 6); const float* tb = rtab + pos * 32;
        const float sc = seg == 0 ? 0.18033688011112042f : 1.0f;
        unsigned o1[8], o2[8]; float ss = 0.f;
#pragma unroll
        for (int w2 = 0; w2 < 8; ++w2) { float x1[2] = {bflo(xa[w2]), bfhi(xa[w2])}, x2[2] = {bflo(xb[w2]), bfhi(xb[w2])}, y1[2], y2[2];
            const f32x4 cssn = *(const f32x4*)(tb + 4 * w2);
#pragma unroll
            for (int e = 0; e < 2; ++e) { const float cs = lat ? cssn[2 * e] : 1.0f, sn = lat ? cssn[2 * e + 1] : 0.0f;
                y1[e] = (x1[e] * cs - x2[e] * sn) * sc; y2[e] = (x2[e] * cs + x1[e] * sn) * sc; }
            o1[w2] = pk2(y1[0], y1[1]); o2[w2] = pk2(y2[0], y2[1]);
            ss += bflo(o1[w2]) * bflo(o1[w2]) + bfhi(o1[w2]) * bfhi(o1[w2]) + bflo(o2[w2]) * bflo(o2[w2]) + bfhi(o2[w2]) * bfhi(o2[w2]); }
        if (lat || seg == 0) { *(u32x4*)base = (u32x4){o1[0], o1[1], o1[2], o1[3]}; *(u32x4*)(base + 8) = (u32x4){o1[4], o1[5], o1[6], o1[7]};
                               *(u32x4*)(base + 16) = (u32x4){o2[0], o2[1], o2[2], o2[3]}; *(u32x4*)(base + 24) = (u32x4){o2[4], o2[5], o2[6], o2[7]}; }
        ss += shx(ss, 1);
        if (seg == 1) { if (b != kbb) { if (kbb >= 0 && half == 0) atomicMax(ctl + CW_KMAX + l * 64 + (kbb * 4 + hh) * 2 + mm, __builtin_bit_cast(unsigned, sqrtf(kmx))); kbb = b; kmx = 0.f; }
            kmx = fmaxf(kmx, ss); }
    }
    if (seg == 1 && kbb >= 0 && half == 0) atomicMax(ctl + CW_KMAX + l * 64 + (kbb * 4 + hh) * 2 + mm, __builtin_bit_cast(unsigned, sqrtf(kmx)));
    if (blk == 0 && wv == PREP_NW) { float a = 0.f, bq = 0.f; const float* lc = p.lam_c + (size_t)l * 256;
        a = wave_sum(lc[lane] * lc[64 + lane]); bq = wave_sum(lc[128 + lane] * lc[192 + lane]);
        const float lam_init = l == 0 ? 0.2f : 0.35550906758f;
        if (lane == 0) ((float*)(ws + WS_MISC))[MI_LAMF + l] = expf(a) - expf(bq) + lam_init; }
}

__device__ __forceinline__ void dn_chain(const P& p, int item, unsigned char* lds) {
    const int b = item >> 3, h = (item >> 1) & 3, dir = item & 1, tid = otid(), c = tid >> 2, ks = tid & 3;
    const bf16_t* DN = (const bf16_t*)(p.ws + WS_DNQKV); const float* GB = (const float*)(p.ws + WS_GB);
    bf16_t* OA = (bf16_t*)(p.ws + WS_H) + (size_t)dir * T * 512;
    constexpr int TB = 32;
    float* qs = (float*)lds; float* ksm = qs + TB * 128; float* vs = ksm + TB * 128; float* gs = vs + TB * 128; float* bs = gs + TB; float* ob = bs + TB;
    float S[32];
#pragma unroll
    for (int i = 0; i < 32; ++i) S[i] = 0.f;
    for (int part = 0; part < 2; ++part) {
        const int L = part == 0 ? CTXL : SEQ; const int rbase = part == 0 ? TL + b * CTXL : b * SEQ;
        for (int t0 = 0; t0 < L; t0 += TB) {
            __syncthreads();
            for (int i = tid; i < 3 * TB * 16; i += NTHREADS) { const int which = i / (TB * 16), rem = i % (TB * 16), tt = rem >> 4, ch = rem & 15;
                const int s = t0 + tt, t = dir ? L - 1 - s : s;
                const u32x4 w = *(const u32x4*)(DN + (size_t)(rbase + t) * 1536 + which * 512 + h * 128 + ch * 8);
                float* dst = (which == 0 ? qs : which == 1 ? ksm : vs) + tt * 128 + ch * 8;
                dst[0] = bflo(w.x); dst[1] = bfhi(w.x); dst[2] = bflo(w.y); dst[3] = bfhi(w.y); dst[4] = bflo(w.z); dst[5] = bfhi(w.z); dst[6] = bflo(w.w); dst[7] = bfhi(w.w); }
            if (tid < TB) { const int s = t0 + tid, t = dir ? L - 1 - s : s; gs[tid] = expf(GB[(size_t)(rbase + t) * 16 + dir * 4 + h]); bs[tid] = GB[(size_t)(rbase + t) * 16 + 8 + dir * 4 + h]; }
            __syncthreads();
            for (int tt = 0; tt < TB; ++tt) {
                const float eg = gs[tt], be = bs[tt];
                const float* kr = ksm + tt * 128 + ks * 32; const float* qr = qs + tt * 128 + ks * 32;
                float r = 0.f;
#pragma unroll
                for (int i = 0; i < 32; ++i) r += kr[i] * S[i];
                r += shx(r, 1); r += shx(r, 2);
                const float vn = be * (vs[tt * 128 + c] - eg * r);
                float o = 0.f;
#pragma unroll
                for (int i = 0; i < 32; ++i) { S[i] = eg * S[i] + kr[i] * vn; o += qr[i] * S[i]; }
                o += shx(o, 1); o += shx(o, 2);
                if (ks == 0) ob[tt * 128 + c] = o;
            }
            __syncthreads();
            for (int i = tid; i < TB * 64; i += NTHREADS) { const int tt = i >> 6, cp = i & 63; const int s = t0 + tt, t = dir ? L - 1 - s : s;
                *(unsigned*)(OA + (size_t)(rbase + t) * 512 + h * 128 + 2 * cp) = pk2(ob[tt * 128 + 2 * cp], ob[tt * 128 + 2 * cp + 1]); }
        }
    }
}
__device__ __forceinline__ void gla_chain_mfma(const P& p, int l, int item, unsigned char* lds) {
    const int b = item >> 3, h = (item >> 1) & 3, dir = item & 1, tid = otid(), lane = tid & 63, w = tid >> 6, i16 = lane & 15, g = lane >> 4;
    constexpr int RP = 72, VP = 136, GP = 40;
    constexpr int RAWE = 2 * 64 * RP + 64 * VP + 64 * GP;
    bf16_t* Qt = (bf16_t*)lds;
    bf16_t* Kt = Qt + 64 * RP;
    bf16_t* KgT = Kt + 64 * RP;
    bf16_t* raw0 = KgT + 64 * RP;
    float* tot = (float*)(raw0 + 2 * RAWE);
    float* gls = tot + 128;
    const bf16_t* PB = (const bf16_t*)(p.ws + WS_PB); const float* SMALL = (const float*)(p.ws + WS_SMALL);
    bf16_t* OB = (bf16_t*)(p.ws + WS_PAQ) + (size_t)dir * T * 512;
    const int nt_ = w & 3, hf = w >> 2, ch = 16 * nt_ + i16;
    bf16x8 wgB;
    { float wv[8];
#pragma unroll
      for (int j = 0; j < 8; ++j) wv[j] = g < 2 ? p.w_gate2[((size_t)l * 2 + dir) * 16 * 256 + (8 * g + j) * 256 + h * 64 + ch] : 0.f;
      union { bf16x8 v; unsigned u[4]; } t_; t_.u[0] = pk2(wv[0], wv[1]); t_.u[1] = pk2(wv[2], wv[3]); t_.u[2] = pk2(wv[4], wv[5]); t_.u[3] = pk2(wv[6], wv[7]); wgB = t_.v; }
    const float bgc = p.b_gate[((size_t)l * 2 + dir) * 256 + h * 64 + ch];
    f32x4 S[4];
#pragma unroll
    for (int dt = 0; dt < 4; ++dt) S[dt] = (f32x4){0.f, 0.f, 0.f, 0.f};
    __syncthreads();
    for (int i = tid; i < 64 * GP / 2; i += NTHREADS) { ((unsigned*)(raw0 + 2 * 64 * RP + 64 * VP))[i] = 0u; ((unsigned*)(raw0 + RAWE + 2 * 64 * RP + 64 * VP))[i] = 0u; }
    u32x4 pf[5];
    auto prefetch = [&](int n) {
        { const int s = tid >> 3, c8 = tid & 7; const size_t row = (size_t)dn_row(n, s, b, dir);
          pf[0] = *(const u32x4*)(PB + row * 1536 + h * 64 + c8 * 8); pf[1] = *(const u32x4*)(PB + row * 1536 + 256 + h * 64 + c8 * 8); }
#pragma unroll
        for (int u = 0; u < 2; ++u) { const int q = tid + 512 * u, s = q >> 4, c8 = q & 15; pf[2 + u] = *(const u32x4*)(PB + (size_t)dn_row(n, s, b, dir) * 1536 + 512 + h * 128 + c8 * 8); }
        if (tid < 256) { const int s = tid >> 2, c4 = tid & 3; pf[4] = *(const u32x4*)(SMALL + (size_t)dn_row(n, s, b, dir) * 64 + 16 + dir * 16 + c4 * 4); }
    };
    auto stage = [&](int bsel) { bf16_t* qraw = raw0 + bsel * RAWE; bf16_t* kraw = qraw + 64 * RP; bf16_t* Vs = kraw + 64 * RP; bf16_t* Gl = Vs + 64 * VP;
        { const int s = tid >> 3, c8 = tid & 7; *(u32x4*)(qraw + s * RP + c8 * 8) = pf[0]; *(u32x4*)(kraw + s * RP + c8 * 8) = pf[1]; }
#pragma unroll
        for (int u = 0; u < 2; ++u) { const int q = tid + 512 * u, s = q >> 4, c8 = q & 15; *(u32x4*)(Vs + s * VP + c8 * 8) = pf[2 + u]; }
        if (tid < 256) { const int s = tid >> 2, c4 = tid & 3; const f32x4 gv = __builtin_bit_cast(f32x4, pf[4]); u32x2 o2; o2.x = pk2(gv[0], gv[1]); o2.y = pk2(gv[2], gv[3]); *(u32x2*)(Gl + s * GP + 4 * c4) = o2; }
    };
    prefetch(0);
    __syncthreads();
    stage(0); prefetch(1);
    for (int n = 0; n < DN_NCH; ++n) {
        const bf16_t* qraw = raw0 + (n & 1) * RAWE; const bf16_t* kraw = qraw + 64 * RP; const bf16_t* Vs = kraw + 64 * RP; const bf16_t* Gl = Vs + 64 * VP;
        __syncthreads();
        f32x4 pr[2]; float E_[2], TT0;
        {
#pragma unroll
            for (int t = 0; t < 2; ++t) { const int mt = 2 * hf + t;
                f32x4 z = __builtin_amdgcn_mfma_f32_16x16x32_bf16(*(const bf16x8*)(Gl + (16 * mt + i16) * GP + 8 * g), wgB, (f32x4){bgc, bgc, bgc, bgc}, 0, 0, 0);
                float run = 0.f;
#pragma unroll
                for (int r = 0; r < 4; ++r) { run += logsigmoid_fast(z[r]) * 0.0625f; pr[t][r] = run; } }
            float TT[2];
#pragma unroll
            for (int t = 0; t < 2; ++t) { const float T_ = pr[t][3]; const float y1 = shup(T_, 16); const float s1 = T_ + (g >= 1 ? y1 : 0.f); const float y2 = shup(s1, 32); const float s2 = s1 + (g >= 2 ? y2 : 0.f);
                E_[t] = s2 - T_; TT[t] = shlane(s2, i16 + 48); }
            TT0 = TT[0];
            if (g == 0) tot[hf * 64 + ch] = TT[0] + TT[1];
        }
        __syncthreads();
        {
            const float t0 = tot[ch], t1 = tot[64 + ch], total = t0 + t1, base = hf ? t0 : 0.f;
            float qv_[2][4], kv_[2][4];
#pragma unroll
            for (int t = 0; t < 2; ++t)
#pragma unroll
                for (int r = 0; r < 4; ++r) { const int tk = 16 * (2 * hf + t) + 4 * g + r; qv_[t][r] = bf2f(qraw[tk * RP + ch]); kv_[t][r] = bf2f(kraw[tk * RP + ch]); }
            __builtin_amdgcn_sched_barrier(0);
            const float etot = __expf(total);
#pragma unroll
            for (int t = 0; t < 2; ++t) { const int mt = 2 * hf + t; const float off = base + (t ? TT0 : 0.f) + E_[t]; float kgv[4];
#pragma unroll
                for (int r = 0; r < 4; ++r) { const int tk = 16 * mt + 4 * g + r; const float gc = off + pr[t][r]; const float eg = __expf(gc), ieg = __builtin_amdgcn_rcpf(eg);
                    Qt[tk * RP + ch] = (bf16_t)f2bf(0.125f * qv_[t][r] * eg); const float kie = kv_[t][r] * ieg; Kt[tk * RP + ch] = (bf16_t)f2bf(kie); kgv[r] = kie * etot; }
                u32x2 kw; kw.x = pk2(kgv[0], kgv[1]); kw.y = pk2(kgv[2], kgv[3]); *(u32x2*)(KgT + ch * RP + 16 * mt + 4 * g) = kw; }
            if (hf == 0 && g == 0) gls[ch] = etot;
        }
        __syncthreads();
        if (n + 1 < DN_NCH) { stage((n + 1) & 1); if (n + 2 < DN_NCH) prefetch(n + 2); }
        { bf16x8 Sb[2], Vb[2];
#pragma unroll
          for (int ks = 0; ks < 2; ++ks) { Sb[ks] = pack8(S[2 * ks], S[2 * ks + 1]);
              const bf16_t* v0 = Vs + (32 * ks + 4 * g + (i16 >> 2)) * VP + 16 * w + 4 * (i16 & 3); Vb[ks] = cat8(lds_tr(v0), lds_tr(v0 + 16 * VP)); }
          bf16x8 aq[4][2], aa[4][2], ak[4][2];
          { bf16x8 kf[4][2], qn_[4][2];
#pragma unroll
            for (int t4 = 0; t4 < 4; ++t4)
#pragma unroll
                for (int k2 = 0; k2 < 2; ++k2) { kf[t4][k2] = *(const bf16x8*)(Kt + (16 * t4 + i16) * RP + 32 * k2 + 8 * g); qn_[t4][k2] = *(const bf16x8*)(Qt + (16 * t4 + i16) * RP + 32 * k2 + 8 * g); }
#pragma unroll
            for (int mt = 0; mt < 4; ++mt)
#pragma unroll
                for (int ks = 0; ks < 2; ++ks) { f32x4 th[2];
#pragma unroll
                    for (int hh = 0; hh < 2; ++hh) { const int jb = 2 * ks + hh; th[hh] = (f32x4){0.f, 0.f, 0.f, 0.f};
                        if (jb <= mt) {
#pragma unroll
                            for (int k2 = 0; k2 < 2; ++k2) th[hh] = __builtin_amdgcn_mfma_f32_16x16x32_bf16(kf[jb][k2], qn_[mt][k2], th[hh], 0, 0, 0);
                            if (jb == mt) {
#pragma unroll
                                for (int rg = 0; rg < 4; ++rg) th[hh][rg] = (i16 >= 4 * g + rg) ? th[hh][rg] : 0.f; } } }
                    aa[mt][ks] = pack8(th[0], th[1]); } }
#pragma unroll
          for (int mt = 0; mt < 4; ++mt)
#pragma unroll
              for (int ks = 0; ks < 2; ++ks) { const int o_ = (16 * mt + i16) * RP + 32 * ks + 4 * g;
                  aq[mt][ks] = cat8(*(const s16x4*)(Qt + o_), *(const s16x4*)(Qt + o_ + 16)); ak[mt][ks] = cat8(*(const s16x4*)(KgT + o_), *(const s16x4*)(KgT + o_ + 16)); }
#pragma unroll
          for (int mt = 0; mt < 4; ++mt) { f32x4 o = (f32x4){0.f, 0.f, 0.f, 0.f};
#pragma unroll
              for (int ks = 0; ks < 2; ++ks) { o = __builtin_amdgcn_mfma_f32_16x16x32_bf16(aq[mt][ks], Sb[ks], o, 0, 0, 0); o = __builtin_amdgcn_mfma_f32_16x16x32_bf16(aa[mt][ks], Vb[ks], o, 0, 0, 0); }
#pragma unroll
              for (int rg = 0; rg < 4; ++rg) OB[(size_t)dn_row(n, 16 * mt + 4 * g + rg, b, dir) * 512 + h * 128 + 16 * w + i16] = (bf16_t)f2bf(o[rg]); }
#pragma unroll
          for (int dt = 0; dt < 4; ++dt) { const f32x4 gl = *(const f32x4*)(gls + 16 * dt + 4 * g); S[dt] = S[dt] * gl;
#pragma unroll
              for (int ks = 0; ks < 2; ++ks) S[dt] = __builtin_amdgcn_mfma_f32_16x16x32_bf16(ak[dt][ks], Vb[ks], S[dt], 0, 0, 0); } }
    }
}
__device__ __forceinline__ void attn_tile(const P& p, int l, int b, int h, int qrow0  , bool ctxq, unsigned char* lds, bool do_store = true) {
    constexpr int QP = 72, KP = 72, VP = 160;
    bf16_t* Qs = (bf16_t*)lds;
    constexpr int KVB = 2 * 64 * KP + 64 * VP;
    bf16_t* KV0 = Qs + 2 * 128 * QP;
    float* Oex = (float*)lds;
    bf16_t* PC = (bf16_t*)(p.ws + WS_PC);
    const int tid = otid(), lane = tid & 63, w = tid >> 6, m = w & 1, rg = w >> 1, q31 = lane & 31, hi = lane >> 5, i16 = lane & 15, gg = lane >> 4;
    const int nkt = ctxq ? CTXL / 64 : (CTXL + SEQ) / 64;
    u32x4 pk_[2], pv_[2];
    auto prefetch = [&](int kt) { const int krow0 = kt < CTXL / 64 ? TL + b * CTXL + kt * 64 : b * SEQ + (kt - CTXL / 64) * 64;
#pragma unroll
        for (int u = 0; u < 2; ++u) { const int i = tid + 512 * u, r = i >> 4, ch = i & 15; const bf16_t* rowp = PC + (size_t)(krow0 + r) * 1536 + h * 128 + ch * 8;
            pk_[u] = *(const u32x4*)(rowp + 512); pv_[u] = *(const u32x4*)(rowp + 1024); } };
    prefetch(0);
    __syncthreads();
    for (int i = tid; i < 128 * 16; i += NTHREADS) { const int r = i >> 4, ch = i & 15, mm = ch >> 3, c8 = (ch & 7) * 8;
        *(u32x4*)(Qs + (mm * 128 + r) * QP + c8) = *(const u32x4*)(PC + (size_t)(qrow0 + r) * 1536 + h * 128 + ch * 8); }
    __syncthreads();
    const bf16_t* qrow = Qs + (m * 128 + rg * 32 + q31) * QP;
    bf16x8 bq[4]; float qn = 0.f;
#pragma unroll
    for (int kk = 0; kk < 4; ++kk) bq[kk] = *(const bf16x8*)(qrow + 16 * kk + 8 * hi);
#pragma unroll
    for (int d8 = 0; d8 < 8; ++d8) { const u32x4 q4 = *(const u32x4*)(qrow + 8 * d8);
        qn += bflo(q4.x) * bflo(q4.x) + bfhi(q4.x) * bfhi(q4.x) + bflo(q4.y) * bflo(q4.y) + bfhi(q4.y) * bfhi(q4.y) + bflo(q4.z) * bflo(q4.z) + bfhi(q4.z) * bfhi(q4.z) + bflo(q4.w) * bflo(q4.w) + bfhi(q4.w) * bfhi(q4.w); }
    const float kmax = __builtin_bit_cast(float, ((const unsigned*)(p.ws + WS_CTL))[CW_KMAX + l * 64 + (b * 4 + h) * 2 + m]);
    const float mrow = sqrtf(qn) * kmax * 1.002f + 1e-3f;
    f32x16 o[4]; float lsum4[4] = {0.f, 0.f, 0.f, 0.f};
#pragma unroll
    for (int dt = 0; dt < 4; ++dt)
#pragma unroll
        for (int r = 0; r < 16; ++r) o[dt][r] = 0.f;
    auto stage = [&](int buf) { bf16_t* Ks = KV0 + buf * KVB; bf16_t* Vs = Ks + 2 * 64 * KP;
#pragma unroll
        for (int u = 0; u < 2; ++u) { const int i = tid + 512 * u, r = i >> 4, ch = i & 15, mm = ch >> 3, c8 = (ch & 7) * 8;
            *(u32x4*)(Ks + (mm * 64 + r) * KP + c8) = pk_[u]; *(u32x4*)(Vs + r * VP + ch * 8) = pv_[u]; } };
    stage(0);
    if (nkt > 1) prefetch(1);
    __syncthreads();
    for (int kt = 0; kt < nkt; ++kt) {
        const bf16_t* Ks = KV0 + (kt & 1) * KVB; const bf16_t* Vs = Ks + 2 * 64 * KP;
        bf16x8 ka[2][4];
#pragma unroll
        for (int kh = 0; kh < 2; ++kh)
#pragma unroll
            for (int kk = 0; kk < 4; ++kk) ka[kh][kk] = *(const bf16x8*)(Ks + (m * 64 + kh * 32 + q31) * KP + 16 * kk + 8 * hi);
        s16x4 vlo[4][4], vhi[4][4];
#pragma unroll
        for (int st = 0; st < 1; ++st) { const bf16_t* v0 = Vs + (16 * st + 4 * hi + (i16 >> 2)) * VP + 16 * (gg & 1) + 4 * (i16 & 3);
#pragma unroll
            for (int dt = 0; dt < 4; ++dt) { vlo[st][dt] = lds_tr(v0 + 32 * dt); vhi[st][dt] = lds_tr(v0 + 32 * dt + 8 * VP); } }
        __builtin_amdgcn_sched_barrier(0);
        f32x16 s[2];
#pragma unroll
        for (int kh = 0; kh < 2; ++kh) {
#pragma unroll
            for (int r = 0; r < 16; ++r) s[kh][r] = 0.f;
#pragma unroll
            for (int kk = 0; kk < 4; ++kk) s[kh] = __builtin_amdgcn_mfma_f32_32x32x16_bf16(ka[kh][kk], bq[kk], s[kh], 0, 0, 0);
        }
#pragma unroll
        for (int st = 1; st < 4; ++st) { const bf16_t* v0 = Vs + (16 * st + 4 * hi + (i16 >> 2)) * VP + 16 * (gg & 1) + 4 * (i16 & 3);
#pragma unroll
            for (int dt = 0; dt < 4; ++dt) { vlo[st][dt] = lds_tr(v0 + 32 * dt); vhi[st][dt] = lds_tr(v0 + 32 * dt + 8 * VP); } }
        __builtin_amdgcn_sched_barrier(0);
#pragma unroll
        for (int kh = 0; kh < 2; ++kh)
#pragma unroll
            for (int r = 0; r < 16; ++r) { const float ev = __builtin_amdgcn_exp2f(s[kh][r] - mrow); s[kh][r] = ev; lsum4[r & 3] += ev; }
        if (kt + 1 < nkt) { stage((kt + 1) & 1); if (kt + 2 < nkt) prefetch(kt + 2); }
#pragma unroll
        for (int st = 0; st < 4; ++st) {
            const int kh = st >> 1, r0 = 8 * (st & 1);
            union { bf16x8 v; unsigned u[4]; } bp;
            bp.u[0] = pk2(s[kh][r0 + 0], s[kh][r0 + 1]); bp.u[1] = pk2(s[kh][r0 + 2], s[kh][r0 + 3]); bp.u[2] = pk2(s[kh][r0 + 4], s[kh][r0 + 5]); bp.u[3] = pk2(s[kh][r0 + 6], s[kh][r0 + 7]);
    #pragma unroll
            for (int dt = 0; dt < 4; ++dt) o[dt] = __builtin_amdgcn_mfma_f32_32x32x16_bf16(cat8(vlo[st][dt], vhi[st][dt]), bp.v, o[dt], 0, 0, 0);
            }
        __syncthreads();
    }
    float lsum = (lsum4[0] + lsum4[1]) + (lsum4[2] + lsum4[3]);
    const int tid_e = otid(), w_e = tid_e >> 6, m_e = w_e & 1, rg_e = w_e >> 1, q31_e = tid_e & 31, hi_e = (tid_e & 63) >> 5;
    lsum += shx(lsum, 32);
    const float lamf = ((const float*)(p.ws + WS_MISC))[MI_LAMF + l];
    const float sc = (m_e == 0 ? 1.0f : lamf) / lsum;
    __syncthreads();
    float* ox = Oex + (rg_e * 32 + q31_e) * 132;
    if (m_e == 1) {
#pragma unroll
        for (int dt = 0; dt < 4; ++dt)
#pragma unroll
            for (int r = 0; r < 16; ++r) ox[dt * 32 + (r & 3) + 8 * (r >> 2) + 4 * hi_e] = o[dt][r] * sc;
    }
    __syncthreads();
    if (m_e == 0) {
        float ss = 0.f;
#pragma unroll
        for (int dt = 0; dt < 4; ++dt)
#pragma unroll
            for (int r = 0; r < 16; ++r) { const float v = o[dt][r] * sc - ox[dt * 32 + (r & 3) + 8 * (r >> 2) + 4 * hi_e]; o[dt][r] = v; ss += v * v; }
        ss += shx(ss, 32);
        int lo_ = l; asm volatile("" : "+s"(lo_));
        const float lam_init = lo_ == 0 ? 0.2f : 0.35550906758f;
        const float rs = (1.0f - lam_init) / sqrtf(ss * (1.0f / 128.0f) + EPS);
        const float* gn = p.gn_c + l * 128;
        bf16_t* orow = (bf16_t*)(p.ws + WS_YD) + (size_t)(qrow0 + rg_e * 32 + q31_e) * 512 + h * 128;
#pragma unroll
        for (int dt = 0; dt < 4; ++dt)
#pragma unroll
            for (int g4 = 0; g4 < 4; ++g4) { const int dv = dt * 32 + 8 * g4 + 4 * hi_e; const f32x4 gv = *(const f32x4*)(gn + dv);
                u32x2 wv; wv.x = pk2(o[dt][4 * g4 + 0] * rs * gv[0], o[dt][4 * g4 + 1] * rs * gv[1]); wv.y = pk2(o[dt][4 * g4 + 2] * rs * gv[2], o[dt][4 * g4 + 3] * rs * gv[3]);
                if (do_store) *(u32x2*)(orow + dv) = wv; }
    }
}
__device__ __forceinline__ void phase_mix(const P& p, int l, unsigned char* lds) {
    unsigned* qhead = (unsigned*)(p.ws + WS_CTL) + CW_QUEUE + 64 * l;
    volatile int* slot = (volatile int*)(lds + LDS_BYTES - 64);
    const int n_att_l = BATCH * 4 * (SEQ / 128), n_att_c = (l == 0) ? BATCH * 4 * (CTXL / 128) : 0;
    const int n_cv = (l == DEPTH - 1) ? NE * MOE_CV_SPLIT : 0;
    const int total = 128 + n_att_l + n_att_c + n_cv;
    for (;;) {
        __syncthreads();
        if (otid() == 0) *slot = (int)atomicAdd(qhead, 1u);
        __syncthreads();
        const int it = *slot;
        if (it >= total) break;
        if (it < 64) { for (int rep = 0; rep < REP_DN; ++rep) dn_chain_mfma(p, it, lds); }
        else if (it < 128) { for (int rep = 0; rep < REP_GLA; ++rep) gla_chain_mfma(p, l, it - 64, lds); }
        else if (it < 128 + n_att_l) { const int a = it - 128, b = a / (4 * (SEQ / 128)), rem = a % (4 * (SEQ / 128)), h = rem / (SEQ / 128), qt = rem % (SEQ / 128);
            for (int rep = 1; rep < REP_ATT; ++rep) attn_tile(p, l, b, h, b * SEQ + qt * 128, false, lds, false);
            attn_tile(p, l, b, h, b * SEQ + qt * 128, false, lds); }
        else if (it < 128 + n_att_l + n_att_c) { const int a = it - 128 - n_att_l, b = a / (4 * (CTXL / 128)), rem = a % (4 * (CTXL / 128)), h = rem / (CTXL / 128), qt = rem % (CTXL / 128);
            attn_tile(p, l, b, h, TL + b * CTXL + qt * 128, true, lds); }
        else { const int a = it - 128 - n_att_l - n_att_c, e = a / MOE_CV_SPLIT, sub = a % MOE_CV_SPLIT; const int tid_ = otid(), wave_ = tid_ >> 6;
            convert_T(DFF, D, (bf16_t*)(p.ws + WS_MWDN) + (size_t)e * D * DFF, D, SmPlain{p.moe_w2 + (size_t)e * DFF * D}, (float*)(lds + wave_ * CONV_WLDS), sub * NWAVES + wave_, MOE_CV_SPLIT * NWAVES, tid_ & 63); }
    }
}

__device__ __forceinline__ void phase_post(const P& p, int l, int nrows, int gw, int NGW, int lane) {
    bf16_t* OA = (bf16_t*)(p.ws + WS_H); bf16_t* OBb = (bf16_t*)(p.ws + WS_PAQ);
    const bf16_t* PZ = (const bf16_t*)(p.ws + WS_PZ); const bf16_t* PB = (const bf16_t*)(p.ws + WS_PB);
    const int c8 = 8 * lane, cg = c8 & 127;
    const f32x4 ga0 = *(const f32x4*)(p.gn_a + l * 128 + cg), ga1 = *(const f32x4*)(p.gn_a + l * 128 + cg + 4), gb0 = *(const f32x4*)(p.gn_b + l * 128 + cg), gb1 = *(const f32x4*)(p.gn_b + l * 128 + cg + 4);
    for (int r0_ = gw; r0_ < nrows; r0_ += 2 * NGW)
#pragma unroll
    for (int rr_ = 0; rr_ < 2; ++rr_) { const int r = r0_ + rr_ * NGW; if (r >= nrows) break;
        const u32x4 af = *(const u32x4*)(OA + (size_t)r * 512 + c8), ab = *(const u32x4*)(OA + ((size_t)T + r) * 512 + c8), az = *(const u32x4*)(PZ + (size_t)r * 512 + c8);
        const u32x4 bf_ = *(const u32x4*)(OBb + (size_t)r * 512 + c8), bb = *(const u32x4*)(OBb + ((size_t)T + r) * 512 + c8), bz = *(const u32x4*)(PB + (size_t)r * 1536 + 1024 + c8);
        const unsigned afw[4] = {af.x, af.y, af.z, af.w}, abw[4] = {ab.x, ab.y, ab.z, ab.w}, azw[4] = {az.x, az.y, az.z, az.w}, bfw[4] = {bf_.x, bf_.y, bf_.z, bf_.w}, bbw[4] = {bb.x, bb.y, bb.z, bb.w}, bzw[4] = {bz.x, bz.y, bz.z, bz.w};
        float oa[8], ob[8], sa = 0.f, sb = 0.f;
#pragma unroll
        for (int q = 0; q < 4; ++q) { oa[2 * q] = bflo(afw[q]) + bflo(abw[q]); oa[2 * q + 1] = bfhi(afw[q]) + bfhi(abw[q]); ob[2 * q] = bflo(bfw[q]) + bflo(bbw[q]); ob[2 * q + 1] = bfhi(bfw[q]) + bfhi(bbw[q]);
            sa += oa[2 * q] * oa[2 * q] + oa[2 * q + 1] * oa[2 * q + 1]; sb += ob[2 * q] * ob[2 * q] + ob[2 * q + 1] * ob[2 * q + 1]; }
#pragma unroll
        for (int o = 1; o < 16; o <<= 1) { sa += shx(sa, o); sb += shx(sb, o); }
        const float ra = 1.0f / sqrtf(sa * (1.0f / 128.0f) + EPS), rb = 1.0f / sqrtf(sb * (1.0f / 128.0f) + EPS);
        unsigned wa[4], wb[4];
#pragma unroll
        for (int q = 0; q < 4; ++q) { const float g0 = q < 2 ? ga0[2 * q] : ga1[2 * q - 4], g1 = q < 2 ? ga0[2 * q + 1] : ga1[2 * q - 3], h0 = q < 2 ? gb0[2 * q] : gb1[2 * q - 4], h1 = q < 2 ? gb0[2 * q + 1] : gb1[2 * q - 3];
            wa[q] = pk2(oa[2 * q] * ra * g0 * siluf_(bflo(azw[q])), oa[2 * q + 1] * ra * g1 * siluf_(bfhi(azw[q])));
            wb[q] = pk2(ob[2 * q] * rb * h0 * siluf_(bflo(bzw[q])), ob[2 * q + 1] * rb * h1 * siluf_(bfhi(bzw[q]))); }
        *(u32x4*)(OA + (size_t)r * 512 + c8) = (u32x4){wa[0], wa[1], wa[2], wa[3]};
        *(u32x4*)(OBb + (size_t)r * 512 + c8) = (u32x4){wb[0], wb[1], wb[2], wb[3]};
    }
}

__device__ __forceinline__ void phase_moe_gather(const P& p, unsigned char* lds) {
    const int tid = otid();
    const int* route = (const int*)(p.ws + WS_ROUTE); int* slots = (int*)(p.ws + WS_SLOT); int* misc = (int*)(p.ws + WS_MISC);
    const unsigned* ecnt = (const unsigned*)(p.ws + WS_CTL) + CW_ECNT; unsigned* efill = (unsigned*)(p.ws + WS_CTL) + CW_EFILL;
    const bf16_t* H = (const bf16_t*)(p.ws + WS_H); bf16_t* MA = (bf16_t*)(p.ws + WS_MA);
    int* eoff = (int*)lds; unsigned* lcnt = (unsigned*)(eoff + 16); unsigned* lbase = lcnt + 8; int* myslot = (int*)(lbase + 8);
    if (tid == 0) { int off = 0, nt = 0;
#pragma unroll 1
        for (int e = 0; e < NE; ++e) { eoff[e] = off; const int tl = ((int)ecnt[e] + 255) / 256;
            if (blockIdx.x == 0) { for (int q = 0; q < tl; ++q) misc[MI_TILEE + nt + q] = e; }
            nt += tl; off += tl * 256; }
        eoff[NE] = off; if (blockIdx.x == 0) misc[MI_NTILES] = nt; }
    for (int grp = blockIdx.x; grp < TL / 64; grp += gridDim.x) {
        __syncthreads();
        if (tid < NE) lcnt[tid] = 0u;
        __syncthreads();
        int e = 0, rank = 0;
        if (tid < 128) { e = route[(grp * 64 + (tid >> 1)) * 4 + (tid & 1)]; rank = (int)atomicAdd(lcnt + e, 1u); }
        __syncthreads();
        if (tid < NE) lbase[tid] = lcnt[tid] ? atomicAdd(efill + tid, lcnt[tid]) : 0u;
        __syncthreads();
        if (tid < 128) { const int s = eoff[e] + (int)lbase[e] + rank; myslot[tid] = s; slots[(grp * 64 + (tid >> 1)) * 2 + (tid & 1)] = s; }
        __syncthreads();
        for (int i0 = tid; i0 < 128 * 128; i0 += 8 * NTHREADS) { u32x4 v[8];
#pragma unroll
            for (int u = 0; u < 8; ++u) { const int i = i0 + u * NTHREADS, a = i >> 7, ch = i & 127; v[u] = ((const u32x4*)(H + (size_t)(grp * 64 + (a >> 1)) * D))[ch]; }
#pragma unroll
            for (int u = 0; u < 8; ++u) { const int i = i0 + u * NTHREADS, a = i >> 7, ch = i & 127; ((u32x4*)(MA + (size_t)myslot[a] * D))[ch] = v[u]; } }
    }
}
__device__ __forceinline__ void phase_final(const P& p, int gw, int NGW, int lane) {
    const int* route = (const int*)(p.ws + WS_ROUTE); const int* slots = (const int*)(p.ws + WS_SLOT); const bf16_t* Y = (const bf16_t*)(p.ws + WS_MA);
    const float* MOD = (const float*)(p.ws + WS_MOD) + (size_t)1 * 9 * 6144;
    for (int r0_ = gw; r0_ < TL; r0_ += 2 * NGW)
#pragma unroll
    for (int rr_ = 0; rr_ < 2; ++rr_) { const int r = r0_ + rr_ * NGW; if (r >= TL) break; const int b = r / SEQ; const float w1 = ((const float*)route)[r * 4 + 2], w2 = ((const float*)route)[r * 4 + 3];
        const bf16_t* y1 = Y + (size_t)slots[r * 2] * D, *y2 = Y + (size_t)slots[r * 2 + 1] * D; float* xr = p.out + (size_t)r * D; const float* g2 = MOD + (size_t)b * 6144 + 5 * 1024;
        f32x4 v[4]; float ss = 0.f;
#pragma unroll
        for (int j = 0; j < 4; ++j) { const int c = 4 * lane + 256 * j; const u32x2 a = *(const u32x2*)(y1 + c), bq = *(const u32x2*)(y2 + c); const f32x4 g = *(const f32x4*)(g2 + c);
            f32x4 y; y[0] = w1 * bflo(a.x) + w2 * bflo(bq.x); y[1] = w1 * bfhi(a.x) + w2 * bfhi(bq.x); y[2] = w1 * bflo(a.y) + w2 * bflo(bq.y); y[3] = w1 * bfhi(a.y) + w2 * bfhi(bq.y);
            v[j] = *(const f32x4*)(xr + c) + g * y; ss += (v[j][0] * v[j][0] + v[j][1] * v[j][1]) + (v[j][2] * v[j][2] + v[j][3] * v[j][3]); }
        const float rs = 1.0f / sqrtf(wave_sum(ss) * (1.0f / D) + EPS);
#pragma unroll
        for (int j = 0; j < 4; ++j) { const int c = 4 * lane + 256 * j; *(f32x4*)(xr + c) = v[j] * rs * *(const f32x4*)(p.final_g + c); }
    }
}

typedef __attribute__((address_space(4))) const P* KArgs;
#define LOADP(p) asm volatile("" : "+s"(kp)); P p; __builtin_memcpy(&p, kp, sizeof(P))
__global__ void __launch_bounds__(NTHREADS, 2) mk_fwd(P p_unused) {
    extern __shared__ __attribute__((aligned(16))) unsigned char lds[];
    cg::grid_group grid = cg::this_grid();
    KArgs kp = (KArgs)__builtin_amdgcn_kernarg_segment_ptr();
    const int G = gridDim.x, NGW = G * NWAVES;
#define IDS() const int tid = otid(), lane = tid & 63, wave = __builtin_amdgcn_readfirstlane(tid >> 6), gw = blockIdx.x * NWAVES + wave; (void)tid; (void)lane; (void)gw; (void)wave
    PG8_LAS unsigned char* glds = (PG8_LAS unsigned char*)lds;
    volatile unsigned* bst = (volatile unsigned*)(lds + LDS_BYTES - 128);
    if (otid() == 0) { bst[0] = 0u; bst[1] = 0u; }
    __syncthreads();
    { LOADP(p); (void)xcd_barrier_post((unsigned*)(p.ws + WS_CTL) + CW_BAR, bst); }
#define GSYNC() do { LOADP(pb_); XcdBarrier bb_; bb_.bar = (unsigned*)(pb_.ws + WS_CTL) + CW_BAR; bb_.x = xb_xcc_id(); bb_.st = (volatile unsigned*)(lds + LDS_BYTES - 128); xcd_barrier(bb_); } while (0)

    { PH_BEGIN(31);
    {
        LOADP(p); IDS(); unsigned char* ws = p.ws;
        float* scr = (float*)(lds + wave * CONV_WLDS);
        for (int rep = 0; rep < REP_P0; ++rep)
        for (int l = 0; l < 1; ++l) {
            convert_T(D, 8240, (bf16_t*)(ws + WB_WIN + l * WIN_BYTES), NIN, SmWin{p.w_in + (size_t)l * D * 8240}, scr, (gw + 37 * l) % NGW, NGW, lane);
            convert_T(512, D, (bf16_t*)(ws + WB_WO + (l * 3 + 0) * WO_BYTES), D, SmPlain{p.w_o_a + (size_t)l * 512 * D}, scr, (gw + 300 + 700 * l) % NGW, NGW, lane);
            convert_T(512, D, (bf16_t*)(ws + WB_WO + (l * 3 + 1) * WO_BYTES), D, SmPlain{p.w_o_b + (size_t)l * 512 * D}, scr, (gw + 556 + 700 * l) % NGW, NGW, lane);
            convert_T(512, D, (bf16_t*)(ws + WB_WO + (l * 3 + 2) * WO_BYTES), D, SmPlain{p.w_o_c + (size_t)l * 512 * D}, scr, (gw + 812 + 700 * l) % NGW, NGW, lane);
            convert_T(D, D, (bf16_t*)(ws + WB_WOUT + l * WOUT_BYTES), D, SmPlain{p.w_out + (size_t)l * D * D}, scr, (gw + 1068 + 512 * l) % NGW, NGW, lane);
        }
        __syncthreads();
        phase_mod(p, lds);
    }
    PH_END(31); }
    grid.sync();

    for (int l = 0; l < DEPTH; ++l) {
        const bool last = (l == DEPTH - 1);
        const int Mrows = last ? TL : T;
{ PH_BEGIN((l * 16 + 0));
        for (int rep = 0; rep < REP_ELT; ++rep)
        { LOADP(p); IDS(); unsigned char* ws = p.ws;
          phase_modulate(l == 0 ? p.x : p.out, l == 0 ? p.ctx : (const float*)(ws + WS_XC), T, p.norm1_g + l * D, (const float*)(ws + WS_MOD) + (size_t)l * 9 * 6144, 0, (bf16_t*)(ws + WS_H), nullptr, nullptr, nullptr, nullptr, gw, NGW, lane); }
        PH_END((l * 16 + 0)); }
        GSYNC();
{ PH_BEGIN((l * 16 + 1));
        for (int rep = 0; rep < REP_WIN; ++rep)
        { LOADP(p); unsigned char* ws = p.ws;
            pg8::Gemm g{(const bf16_t*)(ws + WS_H), (const bf16_t*)(ws + WB_WIN + l * WIN_BYTES), T, NIN, D, D};
            EpiWin E{(bf16_t*)(ws + WS_PAQ), (bf16_t*)(ws + WS_PZ), (bf16_t*)(ws + WS_PB), (bf16_t*)(ws + WS_PC), (bf16_t*)(ws + WS_PG), (float*)(ws + WS_SMALL)};
            WinLastOrder S; S.so.init(last ? TL : T, NIN, G, (int)blockIdx.x); S.G = G; S.c = (int)blockIdx.x; S.nextra = last ? (TC / 256) * 12 : 0;
            pg8::gemm_phase<EpiWin, WinLastOrder, true, true>(glds, g, S, E);
        }
        if (l == 0 && (int)blockIdx.x >= WIN0_BUSY) {
            LOADP(p); IDS(); unsigned char* ws = p.ws; float* scr = (float*)(lds + wave * CONV_WLDS);
            const int hgw = ((int)blockIdx.x - WIN0_BUSY) * NWAVES + wave, HNGW = (G - WIN0_BUSY) * NWAVES;
            convert_T(D, 8240, (bf16_t*)(ws + WB_WIN + WIN_BYTES), NIN, SmWin{p.w_in + (size_t)D * 8240}, scr, hgw, HNGW, lane);
        }
        PH_END((l * 16 + 1)); }
        GSYNC();
{ PH_BEGIN((l * 16 + 2));
        for (int rep = 1; rep < REP_SYNC; ++rep) GSYNC();
        { LOADP(p); IDS(); phase_prep(p, l, lds, gw, NGW, lane); }
        PH_END((l * 16 + 2)); }
        GSYNC();
{ PH_BEGIN((l * 16 + 3));
        { LOADP(p); phase_mix(p, l, lds); }
        PH_END((l * 16 + 3)); }
        GSYNC();
{ PH_BEGIN((l * 16 + 4));
        { LOADP(p); IDS(); phase_post(p, l, Mrows, gw, NGW, lane); }
        PH_END((l * 16 + 4)); }
        GSYNC();
{ PH_BEGIN((l * 16 + 5));
        for (int rep = 0; rep < REP_MERGE; ++rep)
        { LOADP(p); unsigned char* ws = p.ws;
            pg8::Gemm g{(const bf16_t*)(ws + WS_H), (const bf16_t*)(ws + WB_WO + (l * 3 + 0) * WO_BYTES), Mrows, D, 512, 512,
                        (const bf16_t*)(ws + WS_PAQ), (const bf16_t*)(ws + WS_YD), (const bf16_t*)(ws + WB_WO + (l * 3 + 1) * WO_BYTES), (const bf16_t*)(ws + WB_WO + (l * 3 + 2) * WO_BYTES)};
            MergeOrder S; S.so.init(Mrows, D, G, (int)blockIdx.x);
            EpiGate E{(bf16_t*)(ws + WS_DNQKV), (const bf16_t*)(ws + WS_PG)};
            pg8::gemm_phase<EpiGate, MergeOrder, true, true>(glds, g, S, E);
        }
        if (l == 0 && (int)blockIdx.x >= MRG0_BUSY) {
            LOADP(p); IDS(); unsigned char* ws = p.ws; float* scr = (float*)(lds + wave * CONV_WLDS);
            const int hgw = ((int)blockIdx.x - MRG0_BUSY) * NWAVES + wave, HNGW = (G - MRG0_BUSY) * NWAVES;
            convert_T(D, DFF, (bf16_t*)(ws + WB_WUP), NUP, SmUp{p.ffn_w1, (long)(p.ffn_w3 - p.ffn_w1)}, scr, hgw, HNGW, lane);
            convert_T(DFF, D, (bf16_t*)(ws + WB_WDN), D, SmPlain{p.ffn_w2}, scr, (hgw + 900) % HNGW, HNGW, lane);
            convert_T(512, D, (bf16_t*)(ws + WB_WO + 3 * WO_BYTES), D, SmPlain{p.w_o_a + (size_t)512 * D}, scr, (hgw + 300) % HNGW, HNGW, lane);
            convert_T(512, D, (bf16_t*)(ws + WB_WO + 4 * WO_BYTES), D, SmPlain{p.w_o_b + (size_t)512 * D}, scr, (hgw + 556) % HNGW, HNGW, lane);
            convert_T(512, D, (bf16_t*)(ws + WB_WO + 5 * WO_BYTES), D, SmPlain{p.w_o_c + (size_t)512 * D}, scr, (hgw + 812) % HNGW, HNGW, lane);
            convert_T(D, D, (bf16_t*)(ws + WB_WOUT + WOUT_BYTES), D, SmPlain{p.w_out + (size_t)D * D}, scr, (hgw + 1068) % HNGW, HNGW, lane);
        }
        PH_END((l * 16 + 5)); }
        GSYNC();
{ PH_BEGIN((l * 16 + 6));
        for (int rep = 0; rep < (l == 0 ? REP_WOUT0 : 1); ++rep)
        { LOADP(p); unsigned char* ws = p.ws;
            pg8::Gemm g{(const bf16_t*)(ws + WS_DNQKV), (const bf16_t*)(ws + WB_WOUT + l * WOUT_BYTES), Mrows, D, D, D}; pg8::StaticOrder S; S.init(Mrows, D, G, (int)blockIdx.x);
            EpiResid E{l == 0 ? p.x : p.out, l == 0 ? p.ctx : (const float*)(ws + WS_XC), p.out, (float*)(ws + WS_XC), (const float*)(ws + WS_MOD) + (size_t)l * 9 * 6144, 2};
            pg8::gemm_phase<EpiResid, pg8::StaticOrder, true, true>(glds, g, S, E);
        }
        PH_END((l * 16 + 6)); }
        GSYNC();
{ PH_BEGIN((l * 16 + 7));
        { LOADP(p); IDS(); unsigned char* ws = p.ws;
          phase_modulate(p.out, (const float*)(ws + WS_XC), Mrows, p.norm2_g + l * D, (const float*)(ws + WS_MOD) + (size_t)l * 9 * 6144, 3, (bf16_t*)(ws + WS_H), last ? p.router_w : nullptr, (int*)(ws + WS_ROUTE), (unsigned*)(ws + WS_CTL) + CW_ECNT, (unsigned*)lds, gw, NGW, lane); }
        PH_END((l * 16 + 7)); }
        if (!last) {
            GSYNC();
{ PH_BEGIN(8);
            for (int rep = 0; rep < REP_UP; ++rep)
            { LOADP(p); unsigned char* ws = p.ws;
                pg8::Gemm g{(const bf16_t*)(ws + WS_H), (const bf16_t*)(ws + WB_WUP), T, NUP, D, D}; pg8::StaticOrder S; S.init(T, NUP, G, (int)blockIdx.x);
                EpiSwiglu E{(bf16_t*)(ws + WS_H1), NUP / 256};
                pg8::gemm_phase<EpiSwiglu, pg8::StaticOrder, true, true>(glds, g, S, E);
            }
        PH_END(8); }
            GSYNC();
{ PH_BEGIN(9);
            { LOADP(p); unsigned char* ws = p.ws;
                pg8::Gemm g{(const bf16_t*)(ws + WS_H1), (const bf16_t*)(ws + WB_WDN), T, D, DFF, DFF}; pg8::StaticOrder S; S.init(T, D, G, (int)blockIdx.x);
                EpiResid E{p.out, (const float*)(ws + WS_XC), p.out, (float*)(ws + WS_XC), (const float*)(ws + WS_MOD) + (size_t)l * 9 * 6144, 5};
                pg8::gemm_phase<EpiResid, pg8::StaticOrder, true, true>(glds, g, S, E);
            }
        PH_END(9); }
            GSYNC();
        } else {
{ PH_BEGIN(24);
            { LOADP(p); IDS(); unsigned char* ws = p.ws;
                float* scr = (float*)(lds + wave * CONV_WLDS);
                for (int e = 0; e < NE; ++e) {
                    convert_T(D, DFF, (bf16_t*)(ws + WS_MWUP) + (size_t)e * NUP * D, NUP, SmUp{p.moe_w1 + (size_t)e * D * DFF, (long)(p.moe_w3 - p.moe_w1)}, scr, (gw + 211 * e) % NGW, NGW, lane);
                }
            }
        PH_END(24); }
            GSYNC();
{ PH_BEGIN(25);
            { LOADP(p); phase_moe_gather(p, lds); }
        PH_END(25); }
            GSYNC();
{ PH_BEGIN(26);
            for (int rep = 0; rep < REP_UP; ++rep)
            { LOADP(p); unsigned char* ws = p.ws; const int* misc = (const int*)(ws + WS_MISC);
                pg8::Gemm g{(const bf16_t*)(ws + WS_MA), (const bf16_t*)(ws + WS_MWUP), MOE_ROWS, NE * NUP, D, D};
                MoeOrder S{misc[MI_NTILES], NUP / 256, G, (int)blockIdx.x, misc + MI_TILEE};
                EpiSwiglu E{(bf16_t*)(ws + WS_MH1), NUP / 256};
                pg8::gemm_phase<EpiSwiglu, MoeOrder, true, true>(glds, g, S, E);
            }
        PH_END(26); }
            GSYNC();
{ PH_BEGIN(27);
            { LOADP(p); unsigned char* ws = p.ws; const int* misc = (const int*)(ws + WS_MISC);
                pg8::Gemm g{(const bf16_t*)(ws + WS_MH1), (const bf16_t*)(ws + WS_MWDN), MOE_ROWS, NE * D, DFF, DFF};
                MoeOrder S{misc[MI_NTILES], D / 256, G, (int)blockIdx.x, misc + MI_TILEE};
                EpiMoeDown E{(bf16_t*)(ws + WS_MA)};
                pg8::gemm_phase<EpiMoeDown, MoeOrder, true, true>(glds, g, S, E);
            }
        PH_END(27); }
            GSYNC();
{ PH_BEGIN(28);
            { LOADP(p); IDS(); phase_final(p, gw, NGW, lane); }
        PH_END(28); }
        }
    }
}

extern "C" void kernel_launch(void* const* d_in, const int* in_sizes, int n_in, void* d_out, int out_size, void* d_ws, size_t ws_size, hipStream_t stream) {
    static int grid_blocks = 0;
    if (grid_blocks == 0) {
        if (n_in != 30 || in_sizes[0] != TL * D || out_size != TL * D || ws_size < WS_END) {
            fprintf(stderr, "kernel_launch: built for 30 inputs, x/out of %d floats, >= %zu bytes of d_ws; got n_in %d, in0 %d, out %d, ws %zu; nothing launched\n", TL * D, (size_t)WS_END, n_in, n_in > 0 ? in_sizes[0] : -1, out_size, ws_size);
            grid_blocks = -1; return; }
        int dev = 0, cus = 0, per_cu = 0;
        hipGetDevice(&dev);
        hipDeviceGetAttribute(&cus, hipDeviceAttributeMultiprocessorCount, dev);
        hipFuncSetAttribute((const void*)mk_fwd, hipFuncAttributeMaxDynamicSharedMemorySize, LDS_BYTES);
        hipOccupancyMaxActiveBlocksPerMultiprocessor(&per_cu, (const void*)mk_fwd, NTHREADS, LDS_BYTES);
        if (per_cu < 1) { fprintf(stderr, "kernel_launch: occupancy query reports %d blocks/CU; nothing launched\n", per_cu); grid_blocks = -1; return; }
        grid_blocks = cus;
    }
    if (grid_blocks < 0) return;
    hipMemsetAsync((char*)d_ws + WS_CTL, 0, CTL_BYTES, stream);
    P p{};
    const float** f = (const float**)&p;
    for (int i = 0; i < 30; ++i) f[i] = (const float*)d_in[i];
    p.out = (float*)d_out; p.ws = (unsigned char*)d_ws;
    void* args[] = {&p};
    hipError_t e = hipLaunchCooperativeKernel((const void*)mk_fwd, dim3(grid_blocks), dim3(NTHREADS), args, LDS_BYTES, stream);
    if (e != hipSuccess) fprintf(stderr, "kernel_launch: cooperative launch failed: %s (grid %d)\n", hipGetErrorString(e), grid_blocks);
}
```

```cpp
#include <hip/hip_runtime.h>
#include <hip/hip_cooperative_groups.h>
#include <cstdio>
#include <cstdint>
namespace cg = cooperative_groups;
#ifndef REP_P0
#define REP_P0 1
#endif
#ifndef REP_WIN
#define REP_WIN 1
#endif
#ifndef REP_CHAIN
#define REP_CHAIN 1
#endif
#ifndef REP_UP
#define REP_UP 1
#endif
#ifndef REP_SYNC
#define REP_SYNC 1
#endif
#ifndef REP_ATT
#define REP_ATT 1
#endif
#ifndef REP_DNPREP
#define REP_DNPREP 1
#endif
#ifndef REP_ELT
#define REP_ELT 1
#endif
#ifndef REP_DN
#define REP_DN REP_CHAIN
#endif
#ifndef REP_GLA
#define REP_GLA REP_CHAIN
#endif
#ifndef REP_MERGE
#define REP_MERGE 1
#endif
#ifndef REP_WOUT0
#define REP_WOUT0 1
#endif
#ifndef PROBE_MASK
#define PROBE_MASK 0u
#endif
#define PH_BEGIN(k) const unsigned long long pt0_ = ((PROBE_MASK >> (k)) & 1u) ? __builtin_amdgcn_s_memrealtime() : 0ull
#define PH_END(k) do { if ((PROBE_MASK >> (k)) & 1u) { const unsigned long long pt1_ = __builtin_amdgcn_s_memrealtime(); while (__builtin_amdgcn_s_memrealtime() - pt1_ < pt1_ - pt0_) __builtin_amdgcn_s_sleep(4); } } while (0)

namespace pg8 {
#define PG8_LAS __attribute__((address_space(3)))
typedef unsigned short bf16_t;
typedef short bf16x8 __attribute__((ext_vector_type(8)));
typedef float f32x4 __attribute__((ext_vector_type(4)));
typedef unsigned u32x4 __attribute__((ext_vector_type(4)));
constexpr int BM = 256, BK = 64, HALF = 128, HTB = HALF * BK * 2  , STAGE_BYTES = 8 * HTB, NXCD = 8, WGM = 8;

__host__ __device__ __forceinline__ int lds_byte(int r, int c) { const int st = (r >> 4) * 2 + (c >> 5), rr = r & 15, cc = c & 31, ob = rr * 64 + cc * 2; return st * 1024 + (ob ^ (((ob >> 9) & 1) << 5)); }
__host__ __device__ __forceinline__ void stage_rc(int b, int& R, int& C) { const int st = b / 1024, sb = b % 1024, swz = sb ^ (((sb >> 9) & 1) << 5); R = (st >> 1) * 16 + swz / 64; C = (st & 1) * 32 + (swz % 64) / 2; }
__host__ __device__ __forceinline__ int perm32(int rho) { const int n = rho >> 4, i = rho & 15; return 8 * (i >> 2) + 4 * n + (i & 3); }

struct Unit { int pm, pn, br; };
struct Gemm { const bf16_t* A; const bf16_t* Bt; int M, N, K, lda; const bf16_t* A1; const bf16_t* A2; const bf16_t* B1; const bf16_t* B2; };

struct StaticOrder {
    int nM, nN, nwg, G, c;
    __host__ __device__ void init(int M, int N, int G_, int c_) { nM = M / BM; nN = N / BM; nwg = nM * nN; G = G_; c = c_; }
    __host__ __device__ bool next(int i, Unit& u) const {
        const long L = (long)i * G + c; if (L >= nwg) return false;
        int wgid = (int)L; { const int q = nwg / NXCD, r = nwg % NXCD, xcd = wgid % NXCD, off = wgid / NXCD; wgid = (xcd < r ? xcd * (q + 1) : r * (q + 1) + (xcd - r) * q) + off; }
        const int nig = WGM * nN, gid = wgid / nig, fm = gid * WGM, gsz = (nM - fm) < WGM ? (nM - fm) : WGM;
        u.pm = fm + ((wgid % nig) % gsz); u.pn = (wgid % nig) / gsz; u.br = 0; return true;
    }
    __device__ __forceinline__ void a_ready(const Unit&) const {}
    __device__ __forceinline__ void done(const Unit&) const {}
};


template <class Epi, class Sched, bool ALIGN_EPI = false, bool SP2 = false>
__device__ __forceinline__ void gemm_phase(PG8_LAS unsigned char* lds, const Gemm g, const Sched& S, const Epi& E) {
    int tid_o = threadIdx.x; asm volatile("" : "+v"(tid_o));
    const int tid = tid_o, wid = __builtin_amdgcn_readfirstlane(tid >> 6), lane = tid & 63, wr = wid >> 2, wc = wid & 3, fr = lane & 15, fq = lane >> 4;
    const int K = g.K, nt = K / BK;
    unsigned voffA[2], voffB[2];
#pragma unroll
    for (int i = 0; i < 2; ++i) { int R, C; stage_rc(tid * 16 + i * 8192, R, C); const int Rb = Epi::PERM ? ((R & ~31) + perm32(R & 31)) : R;
        voffA[i] = (unsigned)(R * g.lda + C) * 2u; voffB[i] = (unsigned)(Rb * K + C) * 2u; }
    const size_t kstep = (size_t)(BK * 2);
    const size_t hstepA = (size_t)HALF * g.lda * 2, hstepB = (size_t)HALF * K * 2;
    const size_t tstepA = 2 * hstepA, tstepB = 2 * hstepB;
    const unsigned ldsw = (unsigned)wid * 1024u;
    const int aoff = lds_byte(wr * 64 + fr, fq * 8), boff = lds_byte(wc * 32 + fr, fq * 8);
#define PG8_SA(b, h) (((b) * 2 + (h)) * HTB)
#define PG8_SB(b, h) ((4 + (b) * 2 + (h)) * HTB)
#define PG8_STAGE(bufoff, gbase, voff) do { _Pragma("unroll") for (int _i = 0; _i < 2; ++_i) \
        __builtin_amdgcn_global_load_lds((const unsigned*)((const char*)(gbase) + (voff)[_i]), (PG8_LAS unsigned*)(lds + (bufoff) + ldsw + _i * 8192), 16, 0, 0); } while (0)
#define PG8_LDA(dst, b, h) do { _Pragma("unroll") for (int m = 0; m < 4; ++m) _Pragma("unroll") for (int k = 0; k < 2; ++k) dst[m][k] = *(const PG8_LAS bf16x8*)(lds + PG8_SA(b, h) + aoff + m * 2048 + k * 1024); } while (0)
#define PG8_LDB(dst, b, h) do { _Pragma("unroll") for (int n = 0; n < 2; ++n) _Pragma("unroll") for (int k = 0; k < 2; ++k) dst[n][k] = *(const PG8_LAS bf16x8*)(lds + PG8_SB(b, h) + boff + n * 2048 + k * 1024); } while (0)
#define PG8_MMA(ai, bj, At, Bt) do { __builtin_amdgcn_s_setprio(1); _Pragma("unroll") for (int m = 0; m < 4; ++m) _Pragma("unroll") for (int n = 0; n < 2; ++n) _Pragma("unroll") for (int k = 0; k < 2; ++k) \
        acc[ai][bj][m][n] = __builtin_amdgcn_mfma_f32_16x16x32_bf16(Bt[n][k], At[m][k], acc[ai][bj][m][n], 0, 0, 0); __builtin_amdgcn_s_setprio(0); } while (0)
#define PG8_WAIT_V(n) asm volatile("s_waitcnt vmcnt(" #n ")" ::: "memory")
#define PG8_WAIT_L(n) asm volatile("s_waitcnt lgkmcnt(" #n ")" ::: "memory")
#define PG8_BAR __builtin_amdgcn_s_barrier()
#define PG8_SCHED __builtin_amdgcn_sched_barrier(0)
    Unit cur, nxt; int ui = 0;
    if (!S.next(0, cur)) return;
    f32x4 acc[2][2][4][2];
#pragma unroll
    for (int a = 0; a < 2; ++a)
#pragma unroll
        for (int b = 0; b < 2; ++b)
#pragma unroll
            for (int m = 0; m < 4; ++m)
#pragma unroll
                for (int n = 0; n < 2; ++n) acc[a][b][m][n] = (f32x4){0.f, 0.f, 0.f, 0.f};
    bf16x8 At[4][2], B0[2][2], B1[2][2];
    const char* cA = (const char*)(cur.br == 0 ? g.A : cur.br == 1 ? g.A1 : g.A2) + (size_t)cur.pm * tstepA; const char* cB = (const char*)(cur.br == 0 ? g.Bt : cur.br == 1 ? g.B1 : g.B2) + (size_t)cur.pn * tstepB;
    S.a_ready(cur);
    if constexpr (SP2) {
        PG8_STAGE(PG8_SB(0, 0), cB, voffB); PG8_STAGE(PG8_SB(0, 1), cB + hstepB, voffB); PG8_STAGE(PG8_SA(0, 0), cA, voffA); PG8_STAGE(PG8_SA(0, 1), cA + hstepA, voffA);
        if (wr == 1) PG8_BAR;
        PG8_WAIT_V(2); PG8_BAR;
        PG8_STAGE(PG8_SB(1, 0), cB + kstep, voffB); PG8_STAGE(PG8_SA(1, 0), cA + kstep, voffA); PG8_STAGE(PG8_SB(1, 1), cB + hstepB + kstep, voffB);
        PG8_WAIT_V(6); PG8_BAR;
    } else {
        PG8_STAGE(PG8_SB(0, 0), cB, voffB); PG8_STAGE(PG8_SA(0, 0), cA, voffA); PG8_STAGE(PG8_SB(0, 1), cB + hstepB, voffB); PG8_STAGE(PG8_SA(0, 1), cA + hstepA, voffA);
        if (wr == 1) PG8_BAR;
        PG8_WAIT_V(4); PG8_BAR;
        PG8_STAGE(PG8_SB(1, 0), cB + kstep, voffB); PG8_STAGE(PG8_SA(1, 0), cA + kstep, voffA); PG8_STAGE(PG8_SB(1, 1), cB + hstepB + kstep, voffB);
        PG8_WAIT_V(6); PG8_BAR;
    }
    for (;;) {
        const bool has_next = S.next(ui + 1, nxt);
        const char* nA = has_next ? (const char*)(nxt.br == 0 ? g.A : nxt.br == 1 ? g.A1 : g.A2) + (size_t)nxt.pm * tstepA : cA; const char* nB = has_next ? (const char*)(nxt.br == 0 ? g.Bt : nxt.br == 1 ? g.B1 : g.B2) + (size_t)nxt.pn * tstepB : cB;
        for (int t = 0; t < nt; t += 2) {
            const bool last = (t == nt - 2);
            const char* a1 = cA + (size_t)(t + 1) * kstep;
            const char* a2 = last ? nA : cA + (size_t)(t + 2) * kstep; const char* b2 = last ? nB : cB + (size_t)(t + 2) * kstep;
            const char* a3 = a2 + kstep; const char* b3 = b2 + kstep;
            if (last && has_next) S.a_ready(nxt);
            if constexpr (SP2) {
            PG8_LDB(B0, 0, 0); PG8_LDB(B1, 0, 1); PG8_SCHED; PG8_LDA(At, 0, 0); PG8_STAGE(PG8_SA(1, 1), a1 + hstepA, voffA);
            PG8_WAIT_V(8); PG8_WAIT_L(0); PG8_BAR; PG8_MMA(0, 0, At, B0); PG8_MMA(0, 1, At, B1); PG8_BAR; PG8_SCHED;
            PG8_LDA(At, 0, 1); PG8_STAGE(PG8_SB(0, 0), b2, voffB); PG8_STAGE(PG8_SB(0, 1), b2 + hstepB, voffB); PG8_STAGE(PG8_SA(0, 0), a2, voffA);
            PG8_WAIT_V(8); PG8_WAIT_L(0); PG8_BAR; PG8_MMA(1, 0, At, B0); PG8_MMA(1, 1, At, B1); PG8_BAR; PG8_SCHED;
            PG8_LDB(B0, 1, 0); PG8_LDB(B1, 1, 1); PG8_SCHED; PG8_LDA(At, 1, 0); PG8_STAGE(PG8_SA(0, 1), a2 + hstepA, voffA);
            PG8_WAIT_V(8); PG8_WAIT_L(0); PG8_BAR; PG8_MMA(0, 0, At, B0); PG8_MMA(0, 1, At, B1); PG8_BAR; PG8_SCHED;
            PG8_LDA(At, 1, 1); PG8_STAGE(PG8_SB(1, 0), b3, voffB); PG8_STAGE(PG8_SB(1, 1), b3 + hstepB, voffB); PG8_STAGE(PG8_SA(1, 0), a3, voffA);
            PG8_WAIT_V(8); PG8_WAIT_L(0); PG8_BAR; PG8_MMA(1, 0, At, B0); PG8_MMA(1, 1, At, B1); PG8_BAR; PG8_SCHED;
            } else {
            PG8_LDB(B0, 0, 0); PG8_SCHED; PG8_LDA(At, 0, 0); PG8_STAGE(PG8_SA(1, 1), a1 + hstepA, voffA);
            PG8_WAIT_L(8); PG8_BAR; PG8_WAIT_L(0); PG8_MMA(0, 0, At, B0); PG8_BAR; PG8_SCHED;
            PG8_LDB(B1, 0, 1); PG8_STAGE(PG8_SB(0, 0), b2, voffB);
            PG8_BAR; PG8_WAIT_L(0); PG8_MMA(0, 1, At, B1); PG8_BAR;
            PG8_LDA(At, 0, 1); PG8_STAGE(PG8_SA(0, 0), a2, voffA);
            PG8_BAR; PG8_WAIT_L(0); PG8_MMA(1, 0, At, B0); PG8_BAR; PG8_SCHED;
            PG8_STAGE(PG8_SB(0, 1), b2 + hstepB, voffB);
            PG8_WAIT_V(6); PG8_BAR; PG8_MMA(1, 1, At, B1); PG8_BAR;
            PG8_LDB(B0, 1, 0); PG8_SCHED; PG8_LDA(At, 1, 0); PG8_STAGE(PG8_SA(0, 1), a2 + hstepA, voffA);
            PG8_WAIT_L(8); PG8_BAR; PG8_WAIT_L(0); PG8_MMA(0, 0, At, B0); PG8_BAR; PG8_SCHED;
            PG8_LDB(B1, 1, 1); PG8_STAGE(PG8_SB(1, 0), b3, voffB);
            PG8_BAR; PG8_WAIT_L(0); PG8_MMA(0, 1, At, B1); PG8_BAR;
            PG8_LDA(At, 1, 1); PG8_STAGE(PG8_SA(1, 0), a3, voffA);
            PG8_BAR; PG8_WAIT_L(0); PG8_MMA(1, 0, At, B0); PG8_BAR; PG8_SCHED;
            PG8_STAGE(PG8_SB(1, 1), b3 + hstepB, voffB);
            PG8_WAIT_V(6); PG8_BAR; PG8_MMA(1, 1, At, B1); PG8_BAR;
            }
        }
        if constexpr (ALIGN_EPI) { if (wr == 0) PG8_BAR; }
        if constexpr (!Epi::AFTER_DRAIN) { E(acc, cur, wr, wc, fr, fq); S.done(cur); }
        if (!has_next) break;
        if (!(Epi::CHAIN && nxt.br != 0)) {
#pragma unroll
        for (int a = 0; a < 2; ++a)
#pragma unroll
            for (int b = 0; b < 2; ++b)
#pragma unroll
                for (int m = 0; m < 4; ++m)
#pragma unroll
                    for (int n = 0; n < 2; ++n) acc[a][b][m][n] = (f32x4){0.f, 0.f, 0.f, 0.f};
        }
        cur = nxt; cA = nA; cB = nB; ++ui;
        if constexpr (ALIGN_EPI) { if (wr == 1) PG8_BAR; }
    }
    PG8_WAIT_V(0);
    if constexpr (!ALIGN_EPI) { if (wr == 0) PG8_BAR; }
    PG8_BAR;
    if constexpr (Epi::AFTER_DRAIN) { E.fused(acc, cur, wr, wc, fr, fq, lds, wid, lane); S.done(cur); }
#undef PG8_SA
#undef PG8_SB
#undef PG8_STAGE
#undef PG8_LDA
#undef PG8_LDB
#undef PG8_MMA
#undef PG8_WAIT_V
#undef PG8_WAIT_L
#undef PG8_BAR
#undef PG8_SCHED
}
}


constexpr int BATCH = 8, SEQ = 2048, CTXL = 256, D = 1024, DEPTH = 2;
constexpr int TL = BATCH * SEQ, TC = BATCH * CTXL, T = TL + TC;
constexpr int NIN = 8448;
constexpr int DFF = 2816, NE = 8, NUP = 2 * DFF;
constexpr int MOE_ROWS = 2 * TL + NE * 256;
constexpr float EPS = 1e-6f;
constexpr int NTHREADS = 512, NWAVES = 8;
constexpr int LDS_BYTES = 163840;

typedef unsigned short bf16_t;
typedef float f32x4 __attribute__((ext_vector_type(4)));
typedef float f32x16 __attribute__((ext_vector_type(16)));
typedef unsigned u32x4 __attribute__((ext_vector_type(4)));
typedef unsigned u32x2 __attribute__((ext_vector_type(2)));
typedef short bf16x8 __attribute__((ext_vector_type(8)));
typedef short s16x4 __attribute__((ext_vector_type(4)));

constexpr size_t al256(size_t x) { return (x + 255) & ~(size_t)255; }
constexpr size_t WS_CTL   = 0;                                   constexpr size_t CTL_BYTES = 65536;
constexpr size_t WS_MOD   = WS_CTL + CTL_BYTES;                  constexpr size_t MOD_BYTES = (size_t)DEPTH * 9 * 6 * D * 4;
constexpr size_t WS_ROUTE = al256(WS_MOD + MOD_BYTES);           constexpr size_t ROUTE_BYTES = (size_t)TL * 16;
constexpr size_t WS_SLOT  = al256(WS_ROUTE + ROUTE_BYTES);       constexpr size_t SLOT_BYTES = (size_t)TL * 8;
constexpr size_t WS_MISC  = al256(WS_SLOT + SLOT_BYTES);         constexpr size_t MISC_BYTES = 4096;
constexpr size_t WS_GB    = al256(WS_MISC + MISC_BYTES);         constexpr size_t GB_BYTES = (size_t)T * 16 * 4;
constexpr size_t WS_SMALL = al256(WS_GB + GB_BYTES);             constexpr size_t SMALL_BYTES = (size_t)T * 64 * 4;
constexpr size_t WS_XC    = al256(WS_SMALL + SMALL_BYTES);       constexpr size_t XC_BYTES = (size_t)TC * D * 4;
constexpr size_t WS_WB    = al256(WS_XC + XC_BYTES);
constexpr size_t WB_WIN   = WS_WB;                               constexpr size_t WIN_BYTES = (size_t)NIN * D * 2;
constexpr size_t WB_WUP   = WB_WIN + DEPTH * WIN_BYTES;          constexpr size_t WUP_BYTES = (size_t)NUP * D * 2;
constexpr size_t WB_WDN   = WB_WUP + WUP_BYTES;                  constexpr size_t WDN_BYTES = (size_t)D * DFF * 2;
constexpr size_t WB_WO    = WB_WDN + WDN_BYTES;                  constexpr size_t WO_BYTES = (size_t)D * 512 * 2;
constexpr size_t WB_WOUT  = WB_WO + DEPTH * 3 * WO_BYTES;        constexpr size_t WOUT_BYTES = (size_t)D * D * 2;
constexpr size_t WB_END   = WB_WOUT + DEPTH * WOUT_BYTES;
constexpr size_t WS_H     = al256(WB_END);                       constexpr size_t H_BYTES = (size_t)T * D * 2;
constexpr size_t WS_PAQ   = al256(WS_H + H_BYTES);               constexpr size_t PAQ_BYTES = (size_t)T * 1536 * 2;
constexpr size_t WS_PZ    = al256(WS_PAQ + PAQ_BYTES);           constexpr size_t PZ_BYTES = (size_t)T * 512 * 2;
constexpr size_t WS_PB    = al256(WS_PZ + PZ_BYTES);             constexpr size_t PB_BYTES = (size_t)T * 1536 * 2;
constexpr size_t WS_PC    = al256(WS_PB + PB_BYTES);             constexpr size_t PC_BYTES = (size_t)T * 1536 * 2;
constexpr size_t WS_PG    = al256(WS_PC + PC_BYTES);             constexpr size_t PG_BYTES = (size_t)T * 3072 * 2;
constexpr size_t WS_DNQKV = al256(WS_PG + PG_BYTES);             constexpr size_t DNQKV_BYTES = (size_t)T * 1536 * 2;
constexpr size_t WS_TQ    = al256(WS_DNQKV + DNQKV_BYTES);       constexpr size_t TQ_BYTES = (size_t)BATCH * 4 * 2 * ((CTXL + SEQ) / 64) * 16384;
constexpr size_t WS_VEC   = al256(WS_TQ + TQ_BYTES);             constexpr size_t VEC_BYTES = (size_t)BATCH * 4 * 2 * ((CTXL + SEQ) / 64) * 1024;
constexpr size_t WS_END   = al256(WS_VEC + VEC_BYTES);
static_assert(WS_END <= (size_t)524288000, "d_ws map exceeds 500 MiB (documented minimum is 525,980,800 B)");
constexpr size_t WS_YD    = WS_PAQ + (size_t)2 * T * 512 * 2;
static_assert((size_t)3 * T * 512 * 2 <= PAQ_BYTES, "yd overlay");
constexpr size_t WS_H1    = WS_PB;
static_assert((size_t)T * DFF * 2 <= PB_BYTES + PC_BYTES, "h1 overlay");
constexpr size_t WS_MWDN  = WS_WB;                                constexpr size_t MWDN_BYTES = (size_t)NE * D * DFF * 2;
static_assert(MWDN_BYTES <= WB_WO - WS_WB, "moe wdn overlay: must not reach layer 1's w_o / w_out copies (live until its merge / w_out GEMMs)");
constexpr size_t WS_MWUP  = WS_PAQ;                               constexpr size_t MWUP_BYTES = (size_t)NE * NUP * D * 2;
constexpr size_t WS_MA    = al256(WS_MWUP + MWUP_BYTES);          constexpr size_t MA_BYTES = (size_t)MOE_ROWS * D * 2;
constexpr size_t WS_MH1   = al256(WS_MA + MA_BYTES);              constexpr size_t MH1_BYTES = (size_t)MOE_ROWS * DFF * 2;
static_assert(WS_MH1 + MH1_BYTES <= WS_END, "moe overlay");
constexpr int CW_QUEUE = 0;
constexpr int CW_KMAX = 256;
constexpr int CW_ECNT = 512;
constexpr int CW_EFILL = 576;
constexpr int CW_BAR = 4096;
constexpr int MI_LAMF = 0;
constexpr int MI_NTILES = 16;
constexpr int MI_EOFF = 32;
constexpr int MI_TILEE = 64;

typedef __bf16 bf16v2_t __attribute__((ext_vector_type(2)));
typedef float f32v2_t __attribute__((ext_vector_type(2)));
__device__ __forceinline__ unsigned pk2(float lo, float hi) { const f32v2_t v = {lo, hi}; return __builtin_bit_cast(unsigned, __builtin_convertvector(v, bf16v2_t)); }
__device__ __forceinline__ unsigned f2bf(float f) { return pk2(f, 0.f) & 0xffffu; }
__device__ __forceinline__ float bflo(unsigned w) { return __builtin_bit_cast(float, w << 16); }
__device__ __forceinline__ float bfhi(unsigned w) { return __builtin_bit_cast(float, w & 0xffff0000u); }
__device__ __forceinline__ float bf2f(bf16_t h) { return __builtin_bit_cast(float, (unsigned)h << 16); }
__device__ __forceinline__ int otid() { int t = threadIdx.x; asm volatile("" : "+v"(t)); return t; }
__device__ __forceinline__ float shx(float v, int o) { const int idx = ((otid() & 63) ^ o) << 2; return __builtin_bit_cast(float, __builtin_amdgcn_ds_bpermute(idx, __builtin_bit_cast(int, v))); }
__device__ __forceinline__ float shup(float v, int o) { const int idx = (((otid() & 63) - o) & 63) << 2; return __builtin_bit_cast(float, __builtin_amdgcn_ds_bpermute(idx, __builtin_bit_cast(int, v))); }
__device__ __forceinline__ float shlane(float v, int src) { return __builtin_bit_cast(float, __builtin_amdgcn_ds_bpermute(src << 2, __builtin_bit_cast(int, v))); }
__device__ __forceinline__ int shlane_i(int v, int src) { return __builtin_amdgcn_ds_bpermute(src << 2, v); }
__device__ __forceinline__ float wave_sum(float v) {
#pragma unroll
    for (int o = 1; o < 64; o <<= 1) v += shx(v, o);
    return v;
}
__device__ __forceinline__ float sigmoidf_(float x) { return __builtin_amdgcn_rcpf(1.0f + __expf(-x)); }
__device__ __forceinline__ float siluf_(float x) { return x * __builtin_amdgcn_rcpf(1.0f + __expf(-x)); }
__device__ __forceinline__ float softplusf_(float x) { return x > 20.f ? x : (x < -10.f ? __expf(x) : 0.6931471806f * __builtin_amdgcn_logf(1.0f + __builtin_amdgcn_exp2f(1.4426950409f * x))); }
__device__ __forceinline__ float logsigmoidf_(float x) { return fminf(x, 0.f) - log1pf(expf(-fabsf(x))); }
__device__ __forceinline__ float logsigmoid_fast(float z) { z = fmaxf(z, -80.f); return -0.6931471806f * __builtin_amdgcn_logf(1.0f + __builtin_amdgcn_exp2f(-1.4426950409f * z)); }

struct P {
    const float *x, *c, *ctx, *c_ctx, *w_mod, *b_mod, *norm1_g, *norm2_g, *w_in, *conv_a, *a_log, *dt_bias, *gn_a, *w_gate2, *b_gate, *gn_b,
                *lam_c, *gn_c, *w_o_a, *w_o_b, *w_o_c, *w_out, *ffn_w1, *ffn_w3, *ffn_w2, *router_w, *moe_w1, *moe_w3, *moe_w2, *final_g;
    float* out; unsigned char* ws;
};

constexpr long SM_ZERO = (long)1 << 62;
template <class SrcMap>
__device__ __forceinline__ void convert_T(int K, int ldw, bf16_t* WT, int Nrows, SrcMap sm, float* scr  , int gw, int NGW, int lane) {
    const int nblk = Nrows / 64, items = (K / 64) * nblk;
    for (int it = gw; it < items; it += NGW) {
        const int kb = it / nblk, nb = it % nblk, k0 = 64 * kb, n0 = 64 * nb;
        const long so_ = sm(n0 + 4 * (lane & 15)); const float* src = sm.W + (so_ != SM_ZERO ? so_ : 0L);
        f32x4 v[16];
#pragma unroll
        for (int i = 0; i < 16; ++i) { const int kk = 4 * i + (lane >> 4); const f32x4 ld = __builtin_nontemporal_load((const f32x4*)(src + (size_t)(k0 + kk) * ldw));     v[i] = so_ != SM_ZERO ? ld : (f32x4){0.f, 0.f, 0.f, 0.f}; }
#pragma unroll
        for (int i = 0; i < 16; ++i) { const int kk = 4 * i + (lane >> 4); float* d = scr + kk * 65 + 4 * (lane & 15); d[0] = v[i][0]; d[1] = v[i][1]; d[2] = v[i][2]; d[3] = v[i][3]; }
        asm volatile("s_waitcnt lgkmcnt(0)" ::: "memory");
        const int c = lane & 7;
#pragma unroll
        for (int j = 0; j < 8; ++j) { const int n = (lane >> 3) + 8 * j; const float* s = scr + (8 * c) * 65 + n;
            u32x4 o; o.x = pk2(s[0 * 65], s[1 * 65]); o.y = pk2(s[2 * 65], s[3 * 65]); o.z = pk2(s[4 * 65], s[5 * 65]); o.w = pk2(s[6 * 65], s[7 * 65]);
            *(u32x4*)(WT + (size_t)(n0 + n) * K + k0 + 8 * c) = o; }
        asm volatile("s_waitcnt lgkmcnt(0)" ::: "memory");
    }
}
struct SmPlain { const float* W; __device__ long operator()(int n) const { return n; } };
struct SmWin { const float* W; __device__ long operator()(int n) const {
    if (n < 2048) return n; if (n < 3584) return n + 16; if (n < 8192) return n + 48;
    const int j = n - 8192; if (j < 16) return 2048 + j; if (j < 48) return 3600 + (j - 16); return SM_ZERO; } };
struct SmUp { const float* W; long d31; __device__ long operator()(int n) const {
    const int tile = n >> 8, rr = n & 255; return (rr < 128 ? 0L : d31) + tile * 128 + (rr & 127); } };
constexpr int MOE_CV_SPLIT = 16;
constexpr int WIN0_BUSY = (T / 256) * (NIN / 256) - 9 * 256, MRG0_BUSY = (T / 256) * (D / 256) - 256;
constexpr int CONV_WLDS = 64 * 65 * 4;
typedef const f32x4 (&AccRef)[2][2][4][2];
struct EpiWin {
    static constexpr bool PERM = true, AFTER_DRAIN = false, CHAIN = false;
    bf16_t *paq, *pz, *pb, *pc, *pg; float* small_;
    __device__ __forceinline__ void operator()(AccRef acc, const pg8::Unit& u, int wr, int wc, int fr, int fq) const {
        const int row0 = u.pm * 256 + wr * 64 + fr, pn = u.pn;
        if (pn == 32) {
            if (wc < 2) {
#pragma unroll
                for (int ai = 0; ai < 2; ++ai)
#pragma unroll
                    for (int m = 0; m < 4; ++m) { float* p = small_ + (size_t)(row0 + ai * 128 + m * 16) * 64 + wc * 32 + 8 * fq;
                        *(f32x4*)p = acc[ai][0][m][0]; *(f32x4*)(p + 4) = acc[ai][0][m][1]; }
            }
            return;
        }
        bf16_t* base; int ldc, c0;
        if (pn < 6) { base = paq; ldc = 1536; c0 = pn * 256; } else if (pn < 8) { base = pz; ldc = 512; c0 = (pn - 6) * 256; }
        else if (pn < 14) { base = pb; ldc = 1536; c0 = (pn - 8) * 256; } else if (pn < 20) { base = pc; ldc = 1536; c0 = (pn - 14) * 256; }
        else { base = pg; ldc = 3072; c0 = (pn - 20) * 256; }
        const int col = c0 + wc * 32 + 8 * fq;
#pragma unroll
        for (int ai = 0; ai < 2; ++ai)
#pragma unroll
            for (int m = 0; m < 4; ++m) { bf16_t* rowp = base + (size_t)(row0 + ai * 128 + m * 16) * ldc + col;
#pragma unroll
                for (int bj = 0; bj < 2; ++bj) { const f32x4 v0 = acc[ai][bj][m][0], v1 = acc[ai][bj][m][1];
                    u32x4 w; w.x = pk2(v0[0], v0[1]); w.y = pk2(v0[2], v0[3]); w.z = pk2(v1[0], v1[1]); w.w = pk2(v1[2], v1[3]);
                    *(u32x4*)(rowp + bj * 128) = w; } }
    }
};
struct EpiGate {
    static constexpr bool PERM = true, AFTER_DRAIN = false, CHAIN = true;
    bf16_t* Mo; const bf16_t* pg;
    static __device__ __forceinline__ float em(float x) { return __expf(-fminf(fmaxf(x, -30.f), 30.f)); }
    __device__ __forceinline__ void operator()(f32x4 (&acc)[2][2][4][2], const pg8::Unit& u, int wr, int wc, int fr, int fq) const {
        const int row0 = u.pm * 256 + wr * 64 + fr, col = u.pn * 256 + wc * 32 + 8 * fq, br = u.br;
#pragma unroll
        for (int ai = 0; ai < 2; ++ai) {
            u32x4 gc[4][2], gn[4][2];
#pragma unroll
            for (int m = 0; m < 4; ++m)
#pragma unroll
                for (int bj = 0; bj < 2; ++bj) { const size_t row = (size_t)(row0 + ai * 128 + m * 16);
                    gc[m][bj] = *(const u32x4*)(pg + row * 3072 + br * 1024 + col + bj * 128);
                    gn[m][bj] = *(const u32x4*)(pg + row * 3072 + (br < 2 ? br + 1 : br) * 1024 + col + bj * 128); }
#pragma unroll
            for (int m = 0; m < 4; ++m) { const size_t row = (size_t)(row0 + ai * 128 + m * 16);
#pragma unroll
                for (int bj = 0; bj < 2; ++bj) {
                    const unsigned gcw[4] = {gc[m][bj].x, gc[m][bj].y, gc[m][bj].z, gc[m][bj].w}, gnw[4] = {gn[m][bj].x, gn[m][bj].y, gn[m][bj].z, gn[m][bj].w};
                    f32x4& v0 = acc[ai][bj][m][0]; f32x4& v1 = acc[ai][bj][m][1];
                    if (br < 2) {
#pragma unroll
                        for (int q = 0; q < 4; ++q) { const float r0 = (1.0f + em(bflo(gnw[q]))) * __builtin_amdgcn_rcpf(1.0f + em(bflo(gcw[q]))), r1 = (1.0f + em(bfhi(gnw[q]))) * __builtin_amdgcn_rcpf(1.0f + em(bfhi(gcw[q])));
                            if (q < 2) { v0[2 * q] *= r0; v0[2 * q + 1] *= r1; } else { v1[2 * q - 4] *= r0; v1[2 * q - 3] *= r1; } }
                    } else {
#pragma unroll
                        for (int q = 0; q < 4; ++q) { const float s0 = __builtin_amdgcn_rcpf(1.0f + em(bflo(gcw[q]))), s1 = __builtin_amdgcn_rcpf(1.0f + em(bfhi(gcw[q])));
                            if (q < 2) { v0[2 * q] *= s0; v0[2 * q + 1] *= s1; } else { v1[2 * q - 4] *= s0; v1[2 * q - 3] *= s1; } }
                        u32x4 w; w.x = pk2(v0[0], v0[1]); w.y = pk2(v0[2], v0[3]); w.z = pk2(v1[0], v1[1]); w.w = pk2(v1[2], v1[3]);
                        *(u32x4*)(Mo + row * 1024 + col + bj * 128) = w; } } }
        }
    }
};
struct MergeOrder {
    pg8::StaticOrder so;
    __device__ bool next(int i, pg8::Unit& u) const { const int t = i / 3; if (!so.next(t, u)) return false; u.br = i - 3 * t; return true; }
    __device__ __forceinline__ void a_ready(const pg8::Unit&) const {}
    __device__ __forceinline__ void done(const pg8::Unit&) const {}
};
struct WinLastOrder {
    pg8::StaticOrder so; int G, c, nextra;
    __device__ bool next(int i, pg8::Unit& u) const {
        pg8::Unit t; const bool ok = so.next(i, t);
        const int L = i * G + c - so.nwg; const bool ex = !ok && L >= 0 && L < nextra;
        const int q = L % 12, pn2 = q < 4 ? 2 + q : q < 7 ? 5 + q : q < 11 ? 9 + q : 32;
        u.pm = ok ? t.pm : TL / 256 + L / 12; u.pn = ok ? t.pn : pn2; u.br = 0; return ok || ex; }
    __device__ __forceinline__ void a_ready(const pg8::Unit&) const {}
    __device__ __forceinline__ void done(const pg8::Unit&) const {}
};
struct EpiResid {
    static constexpr bool PERM = false, AFTER_DRAIN = false, CHAIN = false;
    const float *old_l, *old_c; float *out_l, *out_c; const float* mod; int gidx;
    __device__ __forceinline__ void operator()(AccRef acc, const pg8::Unit& u, int wr, int wc, int fr, int fq) const {
        const int col0 = u.pn * 256 + wc * 32 + 4 * fq;
        const bool isctx = u.pm >= TL / 256; const int b = isctx ? 8 : u.pm / (SEQ / 256);
        const float* g = mod + (size_t)b * 6144 + gidx * 1024 + col0;
        const float* ob = isctx ? old_c - (size_t)TL * D : old_l; float* wb = isctx ? out_c - (size_t)TL * D : out_l;
        f32x4 gv[2][2];
#pragma unroll
        for (int bj = 0; bj < 2; ++bj)
#pragma unroll
            for (int n = 0; n < 2; ++n) gv[bj][n] = *(const f32x4*)(g + bj * 128 + n * 16);
#pragma unroll
        for (int ai = 0; ai < 2; ++ai) {
            f32x4 xo[4][2][2];
#pragma unroll
            for (int m = 0; m < 4; ++m) { const size_t off = (size_t)(u.pm * 256 + ai * 128 + wr * 64 + m * 16 + fr) * D + col0;
#pragma unroll
                for (int bj = 0; bj < 2; ++bj)
#pragma unroll
                    for (int n = 0; n < 2; ++n) xo[m][bj][n] = *(const f32x4*)(ob + off + bj * 128 + n * 16); }
#pragma unroll
            for (int m = 0; m < 4; ++m) { const size_t off = (size_t)(u.pm * 256 + ai * 128 + wr * 64 + m * 16 + fr) * D + col0;
#pragma unroll
                for (int bj = 0; bj < 2; ++bj)
#pragma unroll
                    for (int n = 0; n < 2; ++n) *(f32x4*)(wb + off + bj * 128 + n * 16) = xo[m][bj][n] + gv[bj][n] * acc[ai][bj][m][n]; }
        }
    }
};
struct EpiSwiglu {
    static constexpr bool PERM = true, AFTER_DRAIN = false, CHAIN = false;
    bf16_t* h1; int NJ;
    __device__ __forceinline__ void operator()(AccRef acc, const pg8::Unit& u, int wr, int wc, int fr, int fq) const {
        const int row0 = u.pm * 256 + wr * 64 + fr, col = (u.pn % NJ) * 128 + wc * 32 + 8 * fq;
#pragma unroll
        for (int ai = 0; ai < 2; ++ai)
#pragma unroll
            for (int m = 0; m < 4; ++m) { const f32x4 a0 = acc[ai][0][m][0], a1 = acc[ai][0][m][1], b0 = acc[ai][1][m][0], b1 = acc[ai][1][m][1];
                u32x4 w; w.x = pk2(siluf_(a0[0]) * b0[0], siluf_(a0[1]) * b0[1]); w.y = pk2(siluf_(a0[2]) * b0[2], siluf_(a0[3]) * b0[3]);
                w.z = pk2(siluf_(a1[0]) * b1[0], siluf_(a1[1]) * b1[1]); w.w = pk2(siluf_(a1[2]) * b1[2], siluf_(a1[3]) * b1[3]);
                *(u32x4*)(h1 + (size_t)(row0 + ai * 128 + m * 16) * DFF + col) = w; }
    }
};
struct EpiMoeDown {
    static constexpr bool PERM = true, AFTER_DRAIN = false, CHAIN = false;
    bf16_t* y;
    __device__ __forceinline__ void operator()(AccRef acc, const pg8::Unit& u, int wr, int wc, int fr, int fq) const {
        const int row0 = u.pm * 256 + wr * 64 + fr, col = (u.pn % 4) * 256 + wc * 32 + 8 * fq;
#pragma unroll
        for (int ai = 0; ai < 2; ++ai)
#pragma unroll
            for (int m = 0; m < 4; ++m) { bf16_t* rowp = y + (size_t)(row0 + ai * 128 + m * 16) * D + col;
#pragma unroll
                for (int bj = 0; bj < 2; ++bj) { const f32x4 v0 = acc[ai][bj][m][0], v1 = acc[ai][bj][m][1];
                    u32x4 w; w.x = pk2(v0[0], v0[1]); w.y = pk2(v0[2], v0[3]); w.z = pk2(v1[0], v1[1]); w.w = pk2(v1[2], v1[3]);
                    *(u32x4*)(rowp + bj * 128) = w; } }
    }
};
struct MoeOrder {
    int ntiles, NJ, G, c; const int* tile_e;
    __device__ bool next(int i, pg8::Unit& u) const { const long L = (long)i * G + c; if (L >= (long)ntiles * NJ) return false;
        const int t = (int)(L / NJ), j = (int)(L % NJ); u.pm = t; u.pn = tile_e[t] * NJ + j; u.br = 0; return true; }
    __device__ __forceinline__ void a_ready(const pg8::Unit&) const {}
    __device__ __forceinline__ void done(const pg8::Unit&) const {}
};

#define XB_TMO      128
#define XB_XCNT(j)  (256  + 64 * (j))
#define XB_XSUB(j)  (1280 + 64 * (j))
#define XB_XGEN(j)  (2304 + 64 * (j))
#define XB_TOP      3328
#define XB_TOPGEN   3392
#define XCD_BAR_WORDS 3456
#define XB_SPIN_CAP (1u << 18)

__device__ __forceinline__ unsigned xb_ld(unsigned* p)              { return __hip_atomic_load(p, __ATOMIC_RELAXED, __HIP_MEMORY_SCOPE_AGENT); }
__device__ __forceinline__ unsigned xb_add(unsigned* p, unsigned v) { return __hip_atomic_fetch_add(p, v, __ATOMIC_RELAXED, __HIP_MEMORY_SCOPE_AGENT); }
__device__ __forceinline__ unsigned xb_xcc_id() { return (unsigned)__builtin_amdgcn_s_getreg((3 << 11) | 20) & 0xFu; }
#define XB_SPIN(cond, bar) do { unsigned _sp = 0; while (cond) { __builtin_amdgcn_s_sleep(1); \
    if ((++_sp & 255u) == 0u) { if (xb_ld(&(bar)[XB_TMO])) break; if (_sp > XB_SPIN_CAP) { atomicAdd(&(bar)[XB_TMO], 1u); break; } } } } while (0)

struct XcdBarrier {
    unsigned* bar; unsigned x;
    volatile unsigned* st;
};

__device__ __forceinline__ XcdBarrier xcd_barrier_post(unsigned* bar, volatile unsigned* st) {
    XcdBarrier b; b.bar = bar; b.x = xb_xcc_id(); b.st = st;
    if (threadIdx.x == 0) (void)xb_add(&bar[XB_XCNT(b.x)], 1u);
    return b;
}
__device__ __forceinline__ void xcd_barrier_complete(unsigned* bar, unsigned x, unsigned& nloc, unsigned& nx) {
    const unsigned G = gridDim.x * gridDim.y * gridDim.z;
    unsigned sum, cnt, mine, sp = 0u;
    for (;;) {
        sum = 0u; cnt = 0u; mine = 0u;
#pragma unroll
        for (unsigned j = 0; j < 16; ++j) { const unsigned c = xb_ld(&bar[XB_XCNT(j)]); sum += c; cnt += (c > 0u) ? 1u : 0u; mine = (j == x) ? c : mine; }
        if (sum == G) break;
        __builtin_amdgcn_s_sleep(1);
        if ((++sp & 255u) == 0u) { if (xb_ld(&bar[XB_TMO])) break; if (sp > XB_SPIN_CAP) { atomicAdd(&bar[XB_TMO], 1u); break; } }
    }
    nloc = mine > 0u ? mine : 1u; nx = cnt > 0u ? cnt : 1u;
}

__device__ __forceinline__ void xcd_barrier(const XcdBarrier& b) {
    asm volatile("s_waitcnt vmcnt(0)" ::: "memory");
    __syncthreads();
    if (threadIdx.x == 0) {
        unsigned* bar = b.bar;
        __builtin_amdgcn_s_waitcnt(0);
        unsigned nloc = b.st[0], nx = b.st[1];
        if (nloc == 0u) { xcd_barrier_complete(bar, b.x, nloc, nx); b.st[0] = nloc; b.st[1] = nx; }
        const unsigned old = xb_add(&bar[XB_XSUB(b.x)], 1u);
        const unsigned gen = old / nloc;
        if (old + 1u == (gen + 1u) * nloc) {
            __builtin_amdgcn_fence(__ATOMIC_RELEASE, "agent");
            asm volatile("s_waitcnt vmcnt(0)" ::: "memory");
            const unsigned og = xb_add(&bar[XB_TOP], 1u);
            const unsigned tg = og / nx;
            if (og + 1u == (tg + 1u) * nx) xb_add(&bar[XB_TOPGEN], 1u);
            else XB_SPIN(xb_ld(&bar[XB_TOPGEN]) == tg, bar);
            __builtin_amdgcn_fence(__ATOMIC_ACQUIRE, "agent");
            xb_add(&bar[XB_XGEN(b.x)], 1u);
            asm volatile("s_waitcnt vmcnt(0)" ::: "memory");
        } else {
            XB_SPIN(xb_ld(&bar[XB_XGEN(b.x)]) == gen, bar);
            __builtin_amdgcn_fence(__ATOMIC_ACQUIRE, "agent");
            asm volatile("s_waitcnt vmcnt(0)" ::: "memory");
        }
    }
    __syncthreads();
}

__device__ __forceinline__ void phase_mod(const P& p, unsigned char* lds) {
    float* sc = (float*)lds;
    float* red = sc + 9 * 1024;
    const int tid = otid();
    for (int i = tid; i < 9 * 1024; i += NTHREADS) { const int r = i >> 10, k = i & 1023; const float v = r < 8 ? p.c[r * 1024 + k] : p.c_ctx[k]; sc[i] = siluf_(v); }
    __syncthreads();
    float* MOD = (float*)(p.ws + WS_MOD);
    const int c4 = tid % 12, ks = tid / 12;
    for (int grp = blockIdx.x; grp < DEPTH * 6144 / 48; grp += gridDim.x) {
        const int l = grp / 128, j = (grp % 128) * 48 + 4 * c4;
        f32x4 a[9];
#pragma unroll
        for (int r = 0; r < 9; ++r) a[r] = (f32x4){0.f, 0.f, 0.f, 0.f};
        if (ks < 40) {
            const float* w = p.w_mod + (size_t)l * 1024 * 6144 + j;
#pragma unroll 2
            for (int k0 = ks; k0 < 1024; k0 += 160) {
                f32x4 wv[4];
#pragma unroll
                for (int u = 0; u < 4; ++u) { const int k = k0 + 40 * u; wv[u] = (f32x4){0.f, 0.f, 0.f, 0.f}; if (k < 1024) wv[u] = __builtin_nontemporal_load((const f32x4*)(w + (size_t)k * 6144)); }
#pragma unroll
                for (int u = 0; u < 4; ++u) { const int k = k0 + 40 * u; const int kc = k < 1024 ? k : 0;
#pragma unroll
                    for (int r = 0; r < 9; ++r) a[r] += sc[r * 1024 + kc] * wv[u]; } }
#pragma unroll
            for (int r = 0; r < 9; ++r) *(f32x4*)(red + (ks * 9 + r) * 48 + 4 * c4) = a[r];
        }
        __syncthreads();
        if (tid < 9 * 48) { const int r = tid / 48, c2 = tid % 48; float s = 0.f;
#pragma unroll
            for (int q = 0; q < 40; ++q) s += red[(q * 9 + r) * 48 + c2];
            const int jj = (grp % 128) * 48 + c2;
            MOD[((size_t)l * 9 + r) * 6144 + jj] = s + p.b_mod[l * 6144 + jj]; }
        __syncthreads();
    }
}

__device__ __forceinline__ void phase_modulate(const float* src_l, const float* src_c, int nrows, const float* gain, const float* mod, int shift_idx,
                                               bf16_t* H, const float* router_w, int* route, unsigned* ecnt, unsigned* lcnt  , int gw, int NGW, int lane) {
    if (router_w) { if (otid() < NE) lcnt[otid()] = 0u; __syncthreads(); }
    for (int r0_ = gw; r0_ < nrows; r0_ += 4 * NGW)
#pragma unroll
    for (int rr_ = 0; rr_ < 4; ++rr_) { const int r = r0_ + rr_ * NGW; if (r >= nrows) break;
        const bool isctx = r >= TL; const int b = isctx ? 8 : r / SEQ;
        const float* xr = isctx ? src_c + (size_t)(r - TL) * D : src_l + (size_t)r * D;
        const float* sh = mod + (size_t)b * 6144 + shift_idx * 1024; const float* scl = sh + 1024;
        f32x4 v[4]; float ss = 0.f;
#pragma unroll
        for (int j = 0; j < 4; ++j) { v[j] = *(const f32x4*)(xr + 4 * lane + 256 * j); ss += (v[j][0] * v[j][0] + v[j][1] * v[j][1]) + (v[j][2] * v[j][2] + v[j][3] * v[j][3]); }
        const float rs = 1.0f / sqrtf(wave_sum(ss) * (1.0f / D) + EPS);
#pragma unroll
        for (int j = 0; j < 4; ++j) { const int c = 4 * lane + 256 * j; const f32x4 g = *(const f32x4*)(gain + c), s1 = *(const f32x4*)(scl + c), s0 = *(const f32x4*)(sh + c);
            v[j] = v[j] * rs * g * (1.0f + s1) + s0;
            u32x2 w; w.x = pk2(v[j][0], v[j][1]); w.y = pk2(v[j][2], v[j][3]);
            *(u32x2*)(H + (size_t)r * D + c) = w; }
        if (router_w) {
            float lg[NE];
#pragma unroll
            for (int e = 0; e < NE; ++e) lg[e] = 0.f;
#pragma unroll
            for (int j = 0; j < 4; ++j)
#pragma unroll
                for (int q = 0; q < 4; ++q) { const float* rw = router_w + (size_t)(4 * lane + 256 * j + q) * NE; const f32x4 r0 = *(const f32x4*)rw, r1 = *(const f32x4*)(rw + 4); const float hv = v[j][q];
                    lg[0] += hv * r0[0]; lg[1] += hv * r0[1]; lg[2] += hv * r0[2]; lg[3] += hv * r0[3]; lg[4] += hv * r1[0]; lg[5] += hv * r1[1]; lg[6] += hv * r1[2]; lg[7] += hv * r1[3]; }
#pragma unroll
            for (int e = 0; e < NE; ++e) lg[e] = wave_sum(lg[e]);
            int e1 = 0; float v1 = lg[0];
#pragma unroll
            for (int e = 1; e < NE; ++e) if (lg[e] > v1) { v1 = lg[e]; e1 = e; }
            int e2 = e1 == 0 ? 1 : 0; float v2 = lg[e2];
#pragma unroll
            for (int e = 0; e < NE; ++e) if (e != e1 && lg[e] > v2) { v2 = lg[e]; e2 = e; }
            const float w2 = 1.0f / (1.0f + expf(v1 - v2)), w1 = 1.0f - w2;
            if (lane == 0) { route[r * 4 + 0] = e1; route[r * 4 + 1] = e2; ((float*)route)[r * 4 + 2] = w1; ((float*)route)[r * 4 + 3] = w2;
                atomicAdd(lcnt + e1, 1u); atomicAdd(lcnt + e2, 1u); }
        }
    }
    if (router_w) { __syncthreads(); if (otid() < NE && lcnt[otid()]) atomicAdd(ecnt + otid(), lcnt[otid()]); }
}


typedef short v4i16_t __attribute__((ext_vector_type(4)));
__device__ __forceinline__ s16x4 lds_tr(const bf16_t* pp) { return __builtin_bit_cast(s16x4, __builtin_amdgcn_ds_read_tr16_b64_v4i16((__attribute__((address_space(3))) v4i16_t*)pp)); }
__device__ __forceinline__ bf16x8 cat8(s16x4 a, s16x4 b) { union { bf16x8 v; s16x4 h[2]; } u; u.h[0] = a; u.h[1] = b; return u.v; }
__device__ __forceinline__ bf16x8 pack8(f32x4 a, f32x4 b) { union { bf16x8 v; unsigned u[4]; } r; r.u[0] = pk2(a[0], a[1]); r.u[1] = pk2(a[2], a[3]); r.u[2] = pk2(b[0], b[1]); r.u[3] = pk2(b[2], b[3]); return r.v; }
constexpr int DN_NCH = (CTXL + SEQ) / 64;
constexpr int DN_ITEMS = BATCH * 4 * DN_NCH;
constexpr int PREP_WLDS = 10240 + 17408 + 1024 + 2304;
constexpr int PREP_NW = 5;

__device__ __forceinline__ int dn_row(int n, int s, int b, int dir) {
    const bool isctx = n < CTXL / 64; const int L = isctx ? CTXL : SEQ, c = isctx ? n : n - CTXL / 64, u = 64 * c + s, t = dir ? L - 1 - u : u;
    return (isctx ? TL + b * CTXL : b * SEQ) + t;
}
__device__ __forceinline__ void dn_prep_item(const P& p, int l, int item, unsigned char* wlds, int lane) {
    asm volatile("" : "+v"(lane));
    const int cn = item % DN_NCH, bh = item / DN_NCH, h = bh & 3, b = bh >> 2;
    const bool isctx = cn < CTXL / 64; const int L = isctx ? CTXL : SEQ, cch = isctx ? cn : cn - CTXL / 64, rbase = isctx ? TL + b * CTXL : b * SEQ, nchp = L / 64;
    const int item0 = (bh * 2 + 0) * DN_NCH + cn, item1 = (bh * 2 + 1) * DN_NCH + (isctx ? nchp - 1 - cch : CTXL / 64 + nchp - 1 - cch);
    const int i16 = lane & 15, g = lane >> 4;
    const bf16_t* PAQ = (const bf16_t*)(p.ws + WS_PAQ); bf16_t* DN = (bf16_t*)(p.ws + WS_DNQKV); const float* SMALL = (const float*)(p.ws + WS_SMALL);
    const float* cw = p.conv_a + (size_t)l * 3 * 1536;
    constexpr int KCP = 136;
    float* Ls = (float*)wlds; bf16_t* Kc = (bf16_t*)(wlds + 10240); bf16_t* Tl = (bf16_t*)(wlds + 10240 + 9216);
    float* gc0 = (float*)(wlds + 10240 + 17408); float* be0 = gc0 + 64; float* sf1 = be0 + 64; float* be1 = sf1 + 64;
    bf16_t* cwl = (bf16_t*)(wlds + 10240 + 17408 + 1024);
    for (int i = lane; i < 3 * 384 / 2; i += 64) { const int tap = i / 192, c2 = (i % 192) * 2, sg = c2 >> 7, cc = c2 & 127; const float* src_ = cw + tap * 1536 + sg * 512 + h * 128 + cc;
        *(unsigned*)(cwl + tap * 384 + c2) = pk2(src_[0], src_[1]); }
    {
        const size_t r = (size_t)(rbase + 64 * cch + lane);
        const f32x4 s0 = *(const f32x4*)(SMALL + r * 64), s1 = *(const f32x4*)(SMALL + r * 64 + 4), s2 = *(const f32x4*)(SMALL + r * 64 + 8), s3 = *(const f32x4*)(SMALL + r * 64 + 12);
        const float g0v = -__expf(p.a_log[l * 8 + h]) * softplusf_(s2[h] + p.dt_bias[l * 8 + h]), g1v = -__expf(p.a_log[l * 8 + 4 + h]) * softplusf_(s3[h] + p.dt_bias[l * 8 + 4 + h]);
        const float b0v = sigmoidf_(s0[h]), b1v = sigmoidf_(s1[h]);
        float c0 = g0v, c1 = g1v;
#pragma unroll
        for (int o = 1; o < 64; o <<= 1) { const float u0 = shup(c0, o), u1 = shup(c1, o); if (lane >= o) { c0 += u0; c1 += u1; } }
        const float t0 = shlane(c0, 63), t1 = shlane(c1, 63), sf = t1 - c1 + g1v;
        gc0[lane] = c0; be0[lane] = b0v; sf1[lane] = sf; be1[lane] = b1v;
        float* v0 = (float*)(p.ws + WS_VEC) + (size_t)item0 * 256; float* v1 = (float*)(p.ws + WS_VEC) + (size_t)item1 * 256;
        v0[lane] = __expf(c0); v0[64 + lane] = __expf(t0 - c0); v0[128 + lane] = b0v; v0[192 + lane] = __expf(t0);
        v1[63 - lane] = __expf(sf); v1[64 + 63 - lane] = __expf(t1 - sf); v1[128 + 63 - lane] = b1v; v1[192 + lane] = __expf(t1);
    }
    struct SegRows { u32x4 x[6][4]; };
    auto seg_load = [&](int seg, SegRows& Sg) {
        int lo_ = lane; asm volatile("" : "+v"(lo_));
        const int i16 = lo_ & 15, g = lo_ >> 4;
#pragma unroll
        for (int f = 0; f < 6; ++f) { const int t = 64 * cch + 16 * (f - 1) + i16; const bool ok = t >= 0 && t < L; const size_t r = (size_t)(rbase + (ok ? t : 0));
#pragma unroll
            for (int ks = 0; ks < 4; ++ks) { Sg.x[f][ks] = (u32x4){0u, 0u, 0u, 0u}; if (ok) Sg.x[f][ks] = *(const u32x4*)(PAQ + r * 1536 + seg * 512 + h * 128 + 32 * ks + 8 * g); } }
    };
    auto tap_prev = [&](unsigned own, unsigned before) -> unsigned {
        const int t0 = __builtin_amdgcn_update_dpp(0, (int)before, 0x121  , 0xF, 0xF, false);
        return (unsigned)__builtin_amdgcn_update_dpp(t0, (int)own, 0x111  , 0xF, 0xF, false); };
    auto tap_next = [&](unsigned own, unsigned after) -> unsigned {
        const int t0 = __builtin_amdgcn_update_dpp(0, (int)after, 0x12F  , 0xF, 0xF, false);
        return (unsigned)__builtin_amdgcn_update_dpp(t0, (int)own, 0x101  , 0xF, 0xF, false); };
    auto conv_compute = [&](int seg, int mt, const SegRows& Sg, bf16x8 (&F)[4]) {
        const int t = 64 * cch + 16 * mt + i16; const size_t r = (size_t)(rbase + t);
        float y[4][8]; float ss = 0.f;
#pragma unroll
        for (int ks = 0; ks < 4; ++ks) {
            const int wo_ = seg * 128 + 32 * ks + 8 * g;
            const u32x4 wa = *(const u32x4*)(cwl + wo_), wb = *(const u32x4*)(cwl + 384 + wo_), wc = *(const u32x4*)(cwl + 768 + wo_);
            const u32x4 o_ = Sg.x[1 + mt][ks], pb_ = Sg.x[mt][ks], nb_ = Sg.x[2 + mt][ks];
            const unsigned xb[4] = {o_.x, o_.y, o_.z, o_.w}, xa[4] = {tap_prev(o_.x, pb_.x), tap_prev(o_.y, pb_.y), tap_prev(o_.z, pb_.z), tap_prev(o_.w, pb_.w)}, xc[4] = {tap_next(o_.x, nb_.x), tap_next(o_.y, nb_.y), tap_next(o_.z, nb_.z), tap_next(o_.w, nb_.w)};
            const unsigned wA[4] = {wa.x, wa.y, wa.z, wa.w}, wB[4] = {wb.x, wb.y, wb.z, wb.w}, wC[4] = {wc.x, wc.y, wc.z, wc.w};
#pragma unroll
            for (int q = 0; q < 4; ++q) {
                const float v0 = siluf_(bflo(wA[q]) * bflo(xa[q]) + bflo(wB[q]) * bflo(xb[q]) + bflo(wC[q]) * bflo(xc[q])), v1 = siluf_(bfhi(wA[q]) * bfhi(xa[q]) + bfhi(wB[q]) * bfhi(xb[q]) + bfhi(wC[q]) * bfhi(xc[q]));
                y[ks][2 * q] = v0; y[ks][2 * q + 1] = v1; ss += v0 * v0 + v1 * v1; }
        }
        float sc = 1.0f;
        if (seg < 2) { ss += shx(ss, 16); ss += shx(ss, 32); sc = __builtin_amdgcn_rsqf(ss + EPS); if (seg == 0) sc *= 0.08838834764831845f; }
#pragma unroll
        for (int ks = 0; ks < 4; ++ks) { union { bf16x8 v; u32x4 w; } f;
            f.w.x = pk2(y[ks][0] * sc, y[ks][1] * sc); f.w.y = pk2(y[ks][2] * sc, y[ks][3] * sc); f.w.z = pk2(y[ks][4] * sc, y[ks][5] * sc); f.w.w = pk2(y[ks][6] * sc, y[ks][7] * sc);
            F[ks] = f.v;
            *(u32x4*)(DN + r * 1536 + seg * 512 + h * 128 + 32 * ks + 8 * g) = f.w; }
    };
    { PH_BEGIN(12); {
#pragma unroll 1
      for (int sg = 0; sg < 2; ++sg) { const int seg = sg == 0 ? 1 : 2;
        SegRows Sg; seg_load(seg, Sg);
#pragma unroll
        for (int mt = 0; mt < 4; ++mt) { bf16x8 F[4];
            conv_compute(seg, mt, Sg, F);
            if (seg == 1) {
#pragma unroll
                for (int ks = 0; ks < 4; ++ks) *(bf16x8*)(Kc + (16 * mt + i16) * KCP + 32 * ks + 8 * g) = F[ks]; } } } } PH_END(12); }
    asm volatile("s_waitcnt lgkmcnt(0)" ::: "memory");
    f32x4 Ut[10];
    { PH_BEGIN(13);
    bf16_t* QK0g = (bf16_t*)(p.ws + WS_TQ + (size_t)item0 * 16384 + 8192); bf16_t* QK1g = (bf16_t*)(p.ws + WS_TQ + (size_t)item1 * 16384 + 8192);
    auto qk_tiles = [&](int mt, const bf16x8 (&Qf)[4]) {
        const int i = 16 * mt + i16; const float gi = gc0[i], si = sf1[i];
#pragma unroll 1
        for (int nt = 0; nt < 4; ++nt) { f32x4 acc = (f32x4){0.f, 0.f, 0.f, 0.f}; const int j0 = 16 * nt + 4 * g;
#pragma unroll
            for (int ks = 0; ks < 4; ++ks) acc = __builtin_amdgcn_mfma_f32_16x16x32_bf16(*(const bf16x8*)(Kc + (16 * nt + i16) * KCP + 32 * ks + 8 * g), Qf[ks], acc, 0, 0, 0);
            const f32x4 gj = *(const f32x4*)(gc0 + j0), sj = *(const f32x4*)(sf1 + j0);
            float q0[4], q1[4];
#pragma unroll
            for (int rg = 0; rg < 4; ++rg) { const int j = j0 + rg;
                q0[rg] = i >= j ? acc[rg] * __expf(gi - gj[rg]) : 0.f; q1[rg] = i <= j ? acc[rg] * __expf(si - sj[rg]) : 0.f; }
            u32x2 w0, w1; w0.x = pk2(q0[0], q0[1]); w0.y = pk2(q0[2], q0[3]); w1.x = pk2(q1[3], q1[2]); w1.y = pk2(q1[1], q1[0]);
            *(u32x2*)(QK0g + i * 64 + j0) = w0; *(u32x2*)(QK1g + (63 - i) * 64 + (60 - j0)) = w1; } };
    { SegRows Sg; seg_load(0, Sg);
#pragma unroll
      for (int mt = 0; mt < 4; ++mt) { bf16x8 Qf[4]; conv_compute(0, mt, Sg, Qf); qk_tiles(mt, Qf); } }
#pragma unroll
    for (int mt = 0; mt < 4; ++mt) {
        bf16x8 A[4];
#pragma unroll
        for (int ks = 0; ks < 4; ++ks) A[ks] = *(const bf16x8*)(Kc + (16 * mt + i16) * KCP + 32 * ks + 8 * g);
#pragma unroll
        for (int nt = 0; nt < 4; ++nt) { f32x4 acc = (f32x4){0.f, 0.f, 0.f, 0.f};
#pragma unroll
            for (int ks = 0; ks < 4; ++ks) acc = __builtin_amdgcn_mfma_f32_16x16x32_bf16(A[ks], *(const bf16x8*)(Kc + (16 * nt + i16) * KCP + 32 * ks + 8 * g), acc, 0, 0, 0);
            const int j = 16 * nt + i16;
            if (mt >= nt) { const float gj = gc0[j]; f32x4 lv;
#pragma unroll
                for (int rg = 0; rg < 4; ++rg) { const int i = 16 * mt + 4 * g + rg; lv[rg] = i > j ? be0[i] * acc[rg] * __expf(gc0[i] - gj) : 0.f; }
                *(f32x4*)(Ls + ((mt * (mt + 1)) / 2 + nt) * 256 + i16 * 16 + 4 * g) = lv; }
            if (mt <= nt) { const float sj = sf1[j]; f32x4 uv;
#pragma unroll
                for (int rg = 0; rg < 4; ++rg) { const int i = 16 * mt + 4 * g + rg; uv[rg] = i < j ? be1[i] * acc[rg] * __expf(sf1[i] - sj) : 0.f; }
                Ut[(nt * (nt + 1)) / 2 + mt] = uv; }
            asm volatile("" ::: "memory"); }
    }
    PH_END(13); }
    asm volatile("s_waitcnt lgkmcnt(0)" ::: "memory");
    auto solve = [&](int itemd) {
        constexpr int LP = 72;
        bf16_t* Lb = (bf16_t*)(wlds + 10240); bf16_t* Tt = (bf16_t*)wlds; bf16_t* Dv = (bf16_t*)(wlds + 10240 + 17408 + 1024);
        {
            const int Bq = lane >> 4, cq = lane & 15; const float* lblk = Ls + ((Bq * (Bq + 1)) / 2 + Bq) * 256;
            float x[16];
#pragma unroll
            for (int ii = 0; ii < 16; ++ii) x[ii] = (ii == cq) ? 1.f : 0.f;
#pragma unroll
            for (int jj = 0; jj < 15; ++jj) { const float tj = x[jj]; const float* lc = lblk + jj * 16;
                const f32x4 l0 = *(const f32x4*)lc, l1 = *(const f32x4*)(lc + 4), l2 = *(const f32x4*)(lc + 8), l3 = *(const f32x4*)(lc + 12);
#pragma unroll
                for (int q = 0; q < 4; ++q) { if (q > jj) x[q] -= l0[q] * tj; if (4 + q > jj) x[4 + q] -= l1[q] * tj; if (8 + q > jj) x[8 + q] -= l2[q] * tj; if (12 + q > jj) x[12 + q] -= l3[q] * tj; } }
#pragma unroll
            for (int ii = 0; ii < 16; ++ii) Dv[(Bq * 16 + ii) * 16 + cq] = (bf16_t)f2bf(x[ii]);
        }
        {
            const int jl = lane >> 2, iq = lane & 3;
#pragma unroll
            for (int bi = 0; bi < 4; ++bi)
#pragma unroll
                for (int bj = 0; bj <= bi; ++bj) { const f32x4 lv = *(const f32x4*)(Ls + ((bi * (bi + 1)) / 2 + bj) * 256 + jl * 16 + 4 * iq);
#pragma unroll
                    for (int q = 0; q < 4; ++q) Lb[(16 * bi + 4 * iq + q) * LP + 16 * bj + jl] = (bf16_t)f2bf(lv[q]); }
        }
        asm volatile("s_waitcnt lgkmcnt(0)" ::: "memory");
        unsigned z_ = 0u; asm volatile("" : "+v"(z_));
        const u32x4 zz = (u32x4){z_, z_, z_, z_};
#pragma unroll
        for (int q = 0; q < 9; ++q) ((u32x4*)Tt)[q * 64 + lane] = zz;
#pragma unroll
        for (int q = 0; q < 8; ++q) ((u32x4*)Tl)[q * 64 + lane] = zz;
        asm volatile("s_waitcnt lgkmcnt(0)" ::: "memory");
#pragma unroll
        for (int B = 0; B < 4; ++B) {
            const bf16x8 aD = cat8(*(const s16x4*)(Dv + (B * 16 + i16) * 16 + 4 * g), (s16x4){0, 0, 0, 0});
#pragma unroll
            for (int nt = 0; nt <= B; ++nt) {
                f32x4 acc = (f32x4){0.f, 0.f, 0.f, 0.f};
#pragma unroll
                for (int ks = 0; ks < (B + 1) / 2; ++ks)
                    acc = __builtin_amdgcn_mfma_f32_16x16x32_bf16(*(const bf16x8*)(Lb + (16 * B + i16) * LP + 32 * ks + 8 * g), *(const bf16x8*)(Tt + (16 * nt + i16) * LP + 32 * ks + 8 * g), acc, 0, 0, 0);
                f32x4 sv;
#pragma unroll
                for (int r = 0; r < 4; ++r) sv[r] = ((nt == B && 4 * g + r == i16) ? 1.f : 0.f) - acc[r];
                const f32x4 tv = __builtin_amdgcn_mfma_f32_16x16x32_bf16(aD, pack8(sv, (f32x4){0.f, 0.f, 0.f, 0.f}), (f32x4){0.f, 0.f, 0.f, 0.f}, 0, 0, 0);
                u32x2 tw; tw.x = pk2(tv[0], tv[1]); tw.y = pk2(tv[2], tv[3]);
                *(u32x2*)(Tt + (16 * nt + i16) * LP + 16 * B + 4 * g) = tw;
#pragma unroll
                for (int r = 0; r < 4; ++r) Tl[(16 * B + 4 * g + r) * 64 + 16 * nt + i16] = (bf16_t)f2bf(tv[r]);
            }
            asm volatile("s_waitcnt lgkmcnt(0)" ::: "memory");
        }
        { const u32x4* srcl = (const u32x4*)Tl; u32x4* dstg = (u32x4*)(p.ws + WS_TQ + (size_t)itemd * 16384);
#pragma unroll
          for (int q = 0; q < 8; ++q) dstg[q * 64 + lane] = srcl[q * 64 + lane]; }
        asm volatile("s_waitcnt lgkmcnt(0)" ::: "memory");
    };
    { PH_BEGIN(14);
    solve(item0);
#pragma unroll
    for (int nt = 0; nt < 4; ++nt)
#pragma unroll
        for (int mt = 0; mt <= nt; ++mt) { const f32x4 uv = Ut[(nt * (nt + 1)) / 2 + mt]; const int bi_ = 3 - mt, bj_ = 3 - nt;
            *(f32x4*)(Ls + ((bi_ * (bi_ + 1)) / 2 + bj_) * 256 + (15 - i16) * 16 + (12 - 4 * g)) = (f32x4){uv[3], uv[2], uv[1], uv[0]}; }
    asm volatile("s_waitcnt lgkmcnt(0)" ::: "memory");
    solve(item1);
    PH_END(14); }
}

__device__ __forceinline__ void dn_chain_mfma(const P& p, int item, unsigned char* lds) {
    const int b = item >> 3, h = (item >> 1) & 3, dir = item & 1, tid = otid(), lane = tid & 63, w = tid >> 6, i16 = lane & 15, g = lane >> 4;
    constexpr int KP = 136, TP = 72;
    bf16_t* Ks = (bf16_t*)lds; bf16_t* Qs = Ks + 64 * KP; bf16_t* Vs = Qs + 64 * KP; bf16_t* Ts = Vs + 64 * KP; bf16_t* QKs = Ts + 64 * TP; float* vec = (float*)(QKs + 64 * TP);
    const bf16_t* DN = (const bf16_t*)(p.ws + WS_DNQKV); bf16_t* OA = (bf16_t*)(p.ws + WS_H) + (size_t)dir * T * 512;
    f32x4 S[8];
#pragma unroll
    for (int dt = 0; dt < 8; ++dt) S[dt] = (f32x4){0.f, 0.f, 0.f, 0.f};
    u32x4 pf[9];
    auto prefetch = [&](int n) {
        const int pitem = item * DN_NCH + n;
#pragma unroll
        for (int u = 0; u < 6; ++u) { const int q = tid + 512 * u, which = q >> 10, rem = q & 1023, s = rem >> 4, ch = rem & 15;
            pf[u] = *(const u32x4*)(DN + (size_t)dn_row(n, s, b, dir) * 1536 + (which == 0 ? 512 : which == 1 ? 0 : 1024) + h * 128 + ch * 8); }
#pragma unroll
        for (int u = 0; u < 2; ++u) pf[6 + u] = *(const u32x4*)(p.ws + WS_TQ + (size_t)pitem * 16384 + (size_t)u * 8192 + (size_t)tid * 16);
        if (tid < 64) pf[8] = *(const u32x4*)((const float*)(p.ws + WS_VEC) + (size_t)pitem * 256 + tid * 4);
    };
    prefetch(0);
    for (int n = 0; n < DN_NCH; ++n) {
        __syncthreads();
#pragma unroll
        for (int u = 0; u < 6; ++u) { const int q = tid + 512 * u, which = q >> 10, rem = q & 1023, s = rem >> 4, ch = rem & 15;
            *(u32x4*)((which == 0 ? Ks : which == 1 ? Qs : Vs) + s * KP + ch * 8) = pf[u]; }
#pragma unroll
        for (int u = 0; u < 2; ++u) *(u32x4*)((u == 0 ? Ts : QKs) + (tid >> 3) * TP + (tid & 7) * 8) = pf[6 + u];
        if (tid < 64) *(u32x4*)(vec + tid * 4) = pf[8];
        __syncthreads();
        if (n + 1 < DN_NCH) prefetch(n + 1);
        const float* egv = vec; const float* eklv = vec + 64; const float* bev = vec + 128; const float glast = vec[192];
#define SB __builtin_amdgcn_sched_barrier(0)
        bf16x8 Sb[4];
#pragma unroll
        for (int ks = 0; ks < 4; ++ks) Sb[ks] = pack8(S[2 * ks], S[2 * ks + 1]);
        f32x4 r_[4], o_[4];
        bf16x8 akA[4], aqA[4], akB[4], aqB[4];
#define DN_LDKQ(mt_, ak_, aq_) do { const bf16_t* kr = Ks + (16 * (mt_) + i16) * KP + 4 * g; const bf16_t* qr = Qs + (16 * (mt_) + i16) * KP + 4 * g; \
            _Pragma("unroll") for (int ks = 0; ks < 4; ++ks) { ak_[ks] = cat8(*(const s16x4*)(kr + 32 * ks), *(const s16x4*)(kr + 32 * ks + 16)); aq_[ks] = cat8(*(const s16x4*)(qr + 32 * ks), *(const s16x4*)(qr + 32 * ks + 16)); } } while (0)
#define DN_MMKQ(mt_, ak_, aq_) do { r_[mt_] = (f32x4){0.f, 0.f, 0.f, 0.f}; o_[mt_] = (f32x4){0.f, 0.f, 0.f, 0.f}; \
            _Pragma("unroll") for (int ks = 0; ks < 4; ++ks) { r_[mt_] = __builtin_amdgcn_mfma_f32_16x16x32_bf16(ak_[ks], Sb[ks], r_[mt_], 0, 0, 0); o_[mt_] = __builtin_amdgcn_mfma_f32_16x16x32_bf16(aq_[ks], Sb[ks], o_[mt_], 0, 0, 0); } } while (0)
        DN_LDKQ(0, akA, aqA); SB;
        DN_LDKQ(1, akB, aqB); DN_MMKQ(0, akA, aqA); SB;
        DN_LDKQ(2, akA, aqA); DN_MMKQ(1, akB, aqB); SB;
        DN_LDKQ(3, akB, aqB); DN_MMKQ(2, akA, aqA); SB;
        f32x4 eg[4], be[4]; float vv[4][4];
#pragma unroll
        for (int mt = 0; mt < 4; ++mt) { eg[mt] = *(const f32x4*)(egv + 16 * mt + 4 * g); be[mt] = *(const f32x4*)(bev + 16 * mt + 4 * g);
            { const s16x4 vt = lds_tr(Vs + (16 * mt + 4 * g + (i16 >> 2)) * KP + 16 * w + 4 * (i16 & 3));
#pragma unroll
              for (int rg = 0; rg < 4; ++rg) vv[mt][rg] = bf2f((bf16_t)vt[rg]); } }
        DN_MMKQ(3, akB, aqB); SB;
#undef DN_LDKQ
#undef DN_MMKQ
        bf16x8 tf[4][2], qf[4][2];
#pragma unroll
        for (int mt = 0; mt < 4; ++mt) { const bf16_t* tr = Ts + (16 * mt + i16) * TP + 4 * g;
#pragma unroll
            for (int k2 = 0; k2 < 2; ++k2) tf[mt][k2] = cat8(*(const s16x4*)(tr + 32 * k2), *(const s16x4*)(tr + 32 * k2 + 16)); }
        f32x4 e0v[2], e1v[2];
#pragma unroll
        for (int k2 = 0; k2 < 2; ++k2) { e0v[k2] = *(const f32x4*)(eklv + 32 * k2 + 4 * g); e1v[k2] = *(const f32x4*)(eklv + 32 * k2 + 16 + 4 * g); }
#pragma unroll
        for (int mt = 0; mt < 4; ++mt)
#pragma unroll
            for (int rg = 0; rg < 4; ++rg) { r_[mt][rg] = be[mt][rg] * (vv[mt][rg] - eg[mt][rg] * r_[mt][rg]); o_[mt][rg] *= eg[mt][rg]; }
        bf16x8 Rb[2];
#pragma unroll
        for (int k2 = 0; k2 < 2; ++k2) Rb[k2] = pack8(r_[2 * k2], r_[2 * k2 + 1]);
        SB;
#pragma unroll
        for (int mt = 0; mt < 4; ++mt) { const bf16_t* qkr = QKs + (16 * mt + i16) * TP + 4 * g;
#pragma unroll
            for (int k2 = 0; k2 < 2; ++k2) qf[mt][k2] = cat8(*(const s16x4*)(qkr + 32 * k2), *(const s16x4*)(qkr + 32 * k2 + 16)); }
        f32x4 vn[4];
#pragma unroll
        for (int mt = 0; mt < 4; ++mt) { vn[mt] = (f32x4){0.f, 0.f, 0.f, 0.f};
#pragma unroll
            for (int k2 = 0; k2 < 2; ++k2) vn[mt] = __builtin_amdgcn_mfma_f32_16x16x32_bf16(tf[mt][k2], Rb[k2], vn[mt], 0, 0, 0); }
        SB;
        bf16x8 Vb[2], Wb[2];
#pragma unroll
        for (int k2 = 0; k2 < 2; ++k2) { Vb[k2] = pack8(vn[2 * k2], vn[2 * k2 + 1]); Wb[k2] = pack8(vn[2 * k2] * e0v[k2], vn[2 * k2 + 1] * e1v[k2]); }
        bf16x8 ktA[4][2], ktB[4][2];
#pragma unroll
        for (int dt = 0; dt < 4; ++dt)
#pragma unroll
            for (int k2 = 0; k2 < 2; ++k2) { const bf16_t* a0 = Ks + (32 * k2 + 4 * g + (i16 >> 2)) * KP + 16 * dt + 4 * (i16 & 3); ktA[dt][k2] = cat8(lds_tr(a0), lds_tr(a0 + 16 * KP)); }
#pragma unroll
        for (int mt = 0; mt < 4; ++mt)
#pragma unroll
            for (int k2 = 0; k2 < 2; ++k2) o_[mt] = __builtin_amdgcn_mfma_f32_16x16x32_bf16(qf[mt][k2], Vb[k2], o_[mt], 0, 0, 0);
        SB;
#pragma unroll
        for (int dt = 0; dt < 4; ++dt)
#pragma unroll
            for (int k2 = 0; k2 < 2; ++k2) { const bf16_t* a0 = Ks + (32 * k2 + 4 * g + (i16 >> 2)) * KP + 16 * (dt + 4) + 4 * (i16 & 3); ktB[dt][k2] = cat8(lds_tr(a0), lds_tr(a0 + 16 * KP)); }
#pragma unroll
        for (int dt = 0; dt < 4; ++dt) { S[dt] = S[dt] * glast;
#pragma unroll
            for (int k2 = 0; k2 < 2; ++k2) S[dt] = __builtin_amdgcn_mfma_f32_16x16x32_bf16(ktA[dt][k2], Wb[k2], S[dt], 0, 0, 0); }
        SB;
#pragma unroll
        for (int dt = 0; dt < 4; ++dt) { S[dt + 4] = S[dt + 4] * glast;
#pragma unroll
            for (int k2 = 0; k2 < 2; ++k2) S[dt + 4] = __builtin_amdgcn_mfma_f32_16x16x32_bf16(ktB[dt][k2], Wb[k2], S[dt + 4], 0, 0, 0); }
#undef SB
#pragma unroll
        for (int mt = 0; mt < 4; ++mt)
#pragma unroll
            for (int rg = 0; rg < 4; ++rg) OA[(size_t)dn_row(n, 16 * mt + 4 * g + rg, b, dir) * 512 + h * 128 + 16 * w + i16] = (bf16_t)f2bf(o_[mt][rg]);
    }
}

__device__ __forceinline__ void phase_prep(const P& p, int l, unsigned char* lds, int gw, int NGW, int lane) {
    unsigned char* ws = p.ws;
    bf16_t* PC = (bf16_t*)(ws + WS_PC); unsigned* ctl = (unsigned*)(ws + WS_CTL);
    float* rtab = (float*)(lds + PREP_NW * PREP_WLDS);
    { const int tid = otid();
#pragma unroll
      for (int u = 0; u < 2; ++u) { const int e = tid + 512 * u, pos = e >> 4, fi = e & 15; const float ang = (float)pos * __builtin_amdgcn_exp2f(-(float)fi * 0.8304820237218406f);
          const float sn = __sinf(ang), cs = __cosf(ang); rtab[2 * e] = cs; rtab[2 * e + 1] = sn; }
      __syncthreads(); }
    const int wv = gw % NWAVES, blk = gw / NWAVES, G_ = NGW / NWAVES;
    if (wv < PREP_NW) { for (int rep = 0; rep < REP_DNPREP; ++rep) for (int it = wv * G_ + blk; it < DN_ITEMS; it += G_ * PREP_NW) dn_prep_item(p, l, it, lds + wv * PREP_WLDS, lane); return; }
    const int gt = (blk * (NWAVES - PREP_NW) + (wv - PREP_NW)) * 64 + lane, NGT = G_ * (NWAVES - PREP_NW) * 64;
    float kmx = 0.f; int kbb = -1;
    const int q_ = gt & 31, seg = q_ >> 4, hh = (q_ >> 2) & 3, mm = (q_ >> 1) & 1, half = q_ & 1;
    const int rows_per = (T + NGT / 32 - 1) / (NGT / 32);
    for (int k_ = 0; k_ < rows_per; ++k_) {
        const int r = (gt >> 5) * rows_per + k_; if (r >= T) break; const bool lat = r < TL; const int b = lat ? r / SEQ : (r - TL) / CTXL;
        bf16_t* base = PC + (size_t)r * 1536 + seg * 512 + hh * 128 + mm * 64 + half * 32;
        const u32x4 a0 = *(const u32x4*)base, a1 = *(const u32x4*)(base + 8), b0 = *(const u32x4*)(base + 16), b1 = *(const u32x4*)(base + 24);
        const unsigned xa[8] = {a0.x, a0.y, a0.z, a0.w, a1.x, a1.y, a1.z, a1.w}, xb[8] = {b0.x, b0.y, b0.z, b0.w, b1.x, b1.y, b1.z, b1.w};
        const int t = r % SEQ, pos = half ? (t & 63) : (t >> 6); const float* tb = rtab + pos * 32;
        const float sc = seg == 0 ? 0.18033688011112042f : 1.0f;
        unsigned o1[8], o2[8]; float ss = 0.f;
#pragma unroll
        for (int w2 = 0; w2 < 8; ++w2) { float x1[2] = {bflo(xa[w2]), bfhi(xa[w2])}, x2[2] = {bflo(xb[w2]), bfhi(xb[w2])}, y1[2], y2[2];
            const f32x4 cssn = *(const f32x4*)(tb + 4 * w2);
#pragma unroll
            for (int e = 0; e < 2; ++e) { const float cs = lat ? cssn[2 * e] : 1.0f, sn = lat ? cssn[2 * e + 1] : 0.0f;
                y1[e] = (x1[e] * cs - x2[e] * sn) * sc; y2[e] = (x2[e] * cs + x1[e] * sn) * sc; }
            o1[w2] = pk2(y1[0], y1[1]); o2[w2] = pk2(y2[0], y2[1]);
            ss += bflo(o1[w2]) * bflo(o1[w2]) + bfhi(o1[w2]) * bfhi(o1[w2]) + bflo(o2[w2]) * bflo(o2[w2]) + bfhi(o2[w2]) * bfhi(o2[w2]); }
        if (lat || seg == 0) { *(u32x4*)base = (u32x4){o1[0], o1[1], o1[2], o1[3]}; *(u32x4*)(base + 8) = (u32x4){o1[4], o1[5], o1[6], o1[7]};
                               *(u32x4*)(base + 16) = (u32x4){o2[0], o2[1], o2[2], o2[3]}; *(u32x4*)(base + 24) = (u32x4){o2[4], o2[5], o2[6], o2[7]}; }
        ss += shx(ss, 1);
        if (seg == 1) { if (b != kbb) { if (kbb >= 0 && half == 0) atomicMax(ctl + CW_KMAX + l * 64 + (kbb * 4 + hh) * 2 + mm, __builtin_bit_cast(unsigned, sqrtf(kmx))); kbb = b; kmx = 0.f; }
            kmx = fmaxf(kmx, ss); }
    }
    if (seg == 1 && kbb >= 0 && half == 0) atomicMax(ctl + CW_KMAX + l * 64 + (kbb * 4 + hh) * 2 + mm, __builtin_bit_cast(unsigned, sqrtf(kmx)));
    if (blk == 0 && wv == PREP_NW) { float a = 0.f, bq = 0.f; const float* lc = p.lam_c + (size_t)l * 256;
        a = wave_sum(lc[lane] * lc[64 + lane]); bq = wave_sum(lc[128 + lane] * lc[192 + lane]);
        const float lam_init = l == 0 ? 0.2f : 0.35550906758f;
        if (lane == 0) ((float*)(ws + WS_MISC))[MI_LAMF + l] = expf(a) - expf(bq) + lam_init; }
}

__device__ __forceinline__ void dn_chain(const P& p, int item, unsigned char* lds) {
    const int b = item >> 3, h = (item >> 1) & 3, dir = item & 1, tid = otid(), c = tid >> 2, ks = tid & 3;
    const bf16_t* DN = (const bf16_t*)(p.ws + WS_DNQKV); const float* GB = (const float*)(p.ws + WS_GB);
    bf16_t* OA = (bf16_t*)(p.ws + WS_H) + (size_t)dir * T * 512;
    constexpr int TB = 32;
    float* qs = (float*)lds; float* ksm = qs + TB * 128; float* vs = ksm + TB * 128; float* gs = vs + TB * 128; float* bs = gs + TB; float* ob = bs + TB;
    float S[32];
#pragma unroll
    for (int i = 0; i < 32; ++i) S[i] = 0.f;
    for (int part = 0; part < 2; ++part) {
        const int L = part == 0 ? CTXL : SEQ; const int rbase = part == 0 ? TL + b * CTXL : b * SEQ;
        for (int t0 = 0; t0 < L; t0 += TB) {
            __syncthreads();
            for (int i = tid; i < 3 * TB * 16; i += NTHREADS) { const int which = i / (TB * 16), rem = i % (TB * 16), tt = rem >> 4, ch = rem & 15;
                const int s = t0 + tt, t = dir ? L - 1 - s : s;
                const u32x4 w = *(const u32x4*)(DN + (size_t)(rbase + t) * 1536 + which * 512 + h * 128 + ch * 8);
                float* dst = (which == 0 ? qs : which == 1 ? ksm : vs) + tt * 128 + ch * 8;
                dst[0] = bflo(w.x); dst[1] = bfhi(w.x); dst[2] = bflo(w.y); dst[3] = bfhi(w.y); dst[4] = bflo(w.z); dst[5] = bfhi(w.z); dst[6] = bflo(w.w); dst[7] = bfhi(w.w); }
            if (tid < TB) { const int s = t0 + tid, t = dir ? L - 1 - s : s; gs[tid] = expf(GB[(size_t)(rbase + t) * 16 + dir * 4 + h]); bs[tid] = GB[(size_t)(rbase + t) * 16 + 8 + dir * 4 + h]; }
            __syncthreads();
            for (int tt = 0; tt < TB; ++tt) {
                const float eg = gs[tt], be = bs[tt];
                const float* kr = ksm + tt * 128 + ks * 32; const float* qr = qs + tt * 128 + ks * 32;
                float r = 0.f;
#pragma unroll
                for (int i = 0; i < 32; ++i) r += kr[i] * S[i];
                r += shx(r, 1); r += shx(r, 2);
                const float vn = be * (vs[tt * 128 + c] - eg * r);
                float o = 0.f;
#pragma unroll
                for (int i = 0; i < 32; ++i) { S[i] = eg * S[i] + kr[i] * vn; o += qr[i] * S[i]; }
                o += shx(o, 1); o += shx(o, 2);
                if (ks == 0) ob[tt * 128 + c] = o;
            }
            __syncthreads();
            for (int i = tid; i < TB * 64; i += NTHREADS) { const int tt = i >> 6, cp = i & 63; const int s = t0 + tt, t = dir ? L - 1 - s : s;
                *(unsigned*)(OA + (size_t)(rbase + t) * 512 + h * 128 + 2 * cp) = pk2(ob[tt * 128 + 2 * cp], ob[tt * 128 + 2 * cp + 1]); }
        }
    }
}
__device__ __forceinline__ void gla_chain_mfma(const P& p, int l, int item, unsigned char* lds) {
    const int b = item >> 3, h = (item >> 1) & 3, dir = item & 1, tid = otid(), lane = tid & 63, w = tid >> 6, i16 = lane & 15, g = lane >> 4;
    constexpr int RP = 72, VP = 136, GP = 40;
    constexpr int RAWE = 2 * 64 * RP + 64 * VP + 64 * GP;
    bf16_t* Qt = (bf16_t*)lds;
    bf16_t* Kt = Qt + 64 * RP;
    bf16_t* KgT = Kt + 64 * RP;
    bf16_t* raw0 = KgT + 64 * RP;
    float* tot = (float*)(raw0 + 2 * RAWE);
    float* gls = tot + 128;
    const bf16_t* PB = (const bf16_t*)(p.ws + WS_PB); const float* SMALL = (const float*)(p.ws + WS_SMALL);
    bf16_t* OB = (bf16_t*)(p.ws + WS_PAQ) + (size_t)dir * T * 512;
    const int nt_ = w & 3, hf = w >> 2, ch = 16 * nt_ + i16;
    u32x4 pf[5];
    auto prefetch = [&](int n) {
        { const int s = tid >> 3, c8 = tid & 7; const size_t row = (size_t)dn_row(n, s, b, dir);
          pf[0] = *(const u32x4*)(PB + row * 1536 + h * 64 + c8 * 8); pf[1] = *(const u32x4*)(PB + row * 1536 + 256 + h * 64 + c8 * 8); }
#pragma unroll
        for (int u = 0; u < 2; ++u) { const int q = tid + 512 * u, s = q >> 4, c8 = q & 15; pf[2 + u] = *(const u32x4*)(PB + (size_t)dn_row(n, s, b, dir) * 1536 + 512 + h * 128 + c8 * 8); }
        if (tid < 256) { const int s = tid >> 2, c4 = tid & 3; pf[4] = *(const u32x4*)(SMALL + (size_t)dn_row(n, s, b, dir) * 64 + 16 + dir * 16 + c4 * 4); }
    };
    prefetch(0);
    bf16x8 wgB;
    { float wv[8];
#pragma unroll
      for (int j = 0; j < 8; ++j) wv[j] = g < 2 ? p.w_gate2[((size_t)l * 2 + dir) * 16 * 256 + (8 * g + j) * 256 + h * 64 + ch] : 0.f;
      union { bf16x8 v; unsigned u[4]; } t_; t_.u[0] = pk2(wv[0], wv[1]); t_.u[1] = pk2(wv[2], wv[3]); t_.u[2] = pk2(wv[4], wv[5]); t_.u[3] = pk2(wv[6], wv[7]); wgB = t_.v; }
    const float bgc = p.b_gate[((size_t)l * 2 + dir) * 256 + h * 64 + ch];
    f32x4 S[4];
#pragma unroll
    for (int dt = 0; dt < 4; ++dt) S[dt] = (f32x4){0.f, 0.f, 0.f, 0.f};
    __syncthreads();
    for (int i = tid; i < 64 * GP / 2; i += NTHREADS) { ((unsigned*)(raw0 + 2 * 64 * RP + 64 * VP))[i] = 0u; ((unsigned*)(raw0 + RAWE + 2 * 64 * RP + 64 * VP))[i] = 0u; }
    auto stage = [&](int bsel) { bf16_t* qraw = raw0 + bsel * RAWE; bf16_t* kraw = qraw + 64 * RP; bf16_t* Vs = kraw + 64 * RP; bf16_t* Gl = Vs + 64 * VP;
        { const int s = tid >> 3, c8 = tid & 7; *(u32x4*)(qraw + s * RP + c8 * 8) = pf[0]; *(u32x4*)(kraw + s * RP + c8 * 8) = pf[1]; }
#pragma unroll
        for (int u = 0; u < 2; ++u) { const int q = tid + 512 * u, s = q >> 4, c8 = q & 15; *(u32x4*)(Vs + s * VP + c8 * 8) = pf[2 + u]; }
        if (tid < 256) { const int s = tid >> 2, c4 = tid & 3; const f32x4 gv = __builtin_bit_cast(f32x4, pf[4]); u32x2 o2; o2.x = pk2(gv[0], gv[1]); o2.y = pk2(gv[2], gv[3]); *(u32x2*)(Gl + s * GP + 4 * c4) = o2; }
    };
    __syncthreads();
    stage(0); prefetch(1);
    for (int n = 0; n < DN_NCH; ++n) {
        const bf16_t* qraw = raw0 + (n & 1) * RAWE; const bf16_t* kraw = qraw + 64 * RP; const bf16_t* Vs = kraw + 64 * RP; const bf16_t* Gl = Vs + 64 * VP;
        __syncthreads();
        f32x4 pr[2]; float E_[2], TT0;
        {
#pragma unroll
            for (int t = 0; t < 2; ++t) { const int mt = 2 * hf + t;
                f32x4 z = __builtin_amdgcn_mfma_f32_16x16x32_bf16(*(const bf16x8*)(Gl + (16 * mt + i16) * GP + 8 * g), wgB, (f32x4){bgc, bgc, bgc, bgc}, 0, 0, 0);
                float run = 0.f;
#pragma unroll
                for (int r = 0; r < 4; ++r) { run += logsigmoid_fast(z[r]) * 0.0625f; pr[t][r] = run; } }
            float TT[2];
#pragma unroll
            for (int t = 0; t < 2; ++t) { const float T_ = pr[t][3]; const float y1 = shup(T_, 16); const float s1 = T_ + (g >= 1 ? y1 : 0.f); const float y2 = shup(s1, 32); const float s2 = s1 + (g >= 2 ? y2 : 0.f);
                E_[t] = s2 - T_; TT[t] = shlane(s2, i16 + 48); }
            TT0 = TT[0];
            if (g == 0) tot[hf * 64 + ch] = TT[0] + TT[1];
        }
        __syncthreads();
        {
            const float t0 = tot[ch], t1 = tot[64 + ch], total = t0 + t1, base = hf ? t0 : 0.f;
            float qv_[2][4], kv_[2][4];
#pragma unroll
            for (int t = 0; t < 2; ++t)
                { const int o_ = (16 * (2 * hf + t) + 4 * g + (i16 >> 2)) * RP + 16 * nt_ + 4 * (i16 & 3); const s16x4 qt4 = lds_tr(qraw + o_), kt4 = lds_tr(kraw + o_);
#pragma unroll
                  for (int r = 0; r < 4; ++r) { qv_[t][r] = bf2f((bf16_t)qt4[r]); kv_[t][r] = bf2f((bf16_t)kt4[r]); } }
            __builtin_amdgcn_sched_barrier(0);
            const float etot = __expf(total);
#pragma unroll
            for (int t = 0; t < 2; ++t) { const int mt = 2 * hf + t; const float off = base + (t ? TT0 : 0.f) + E_[t]; float kgv[4];
#pragma unroll
                for (int r = 0; r < 4; ++r) { const int tk = 16 * mt + 4 * g + r; const float gc = off + pr[t][r]; const float eg = __expf(gc), ieg = __builtin_amdgcn_rcpf(eg);
                    Qt[tk * RP + ch] = (bf16_t)f2bf(0.125f * qv_[t][r] * eg); const float kie = kv_[t][r] * ieg; Kt[tk * RP + ch] = (bf16_t)f2bf(kie); kgv[r] = kie * etot; }
                u32x2 kw; kw.x = pk2(kgv[0], kgv[1]); kw.y = pk2(kgv[2], kgv[3]); *(u32x2*)(KgT + ch * RP + 16 * mt + 4 * g) = kw; }
            if (hf == 0 && g == 0) gls[ch] = etot;
        }
        __syncthreads();
        if (n + 1 < DN_NCH) { stage((n + 1) & 1); if (n + 2 < DN_NCH) prefetch(n + 2); }
        { bf16x8 Sb[2], Vb[2];
#pragma unroll
          for (int ks = 0; ks < 2; ++ks) { Sb[ks] = pack8(S[2 * ks], S[2 * ks + 1]);
              const bf16_t* v0 = Vs + (32 * ks + 4 * g + (i16 >> 2)) * VP + 16 * w + 4 * (i16 & 3); Vb[ks] = cat8(lds_tr(v0), lds_tr(v0 + 16 * VP)); }
          bf16x8 aq[4][2], aa[4][2], ak[4][2];
          { bf16x8 kf[4][2], qn_[4][2];
#pragma unroll
            for (int t4 = 0; t4 < 4; ++t4)
#pragma unroll
                for (int k2 = 0; k2 < 2; ++k2) { kf[t4][k2] = *(const bf16x8*)(Kt + (16 * t4 + i16) * RP + 32 * k2 + 8 * g); qn_[t4][k2] = *(const bf16x8*)(Qt + (16 * t4 + i16) * RP + 32 * k2 + 8 * g); }
#pragma unroll
            for (int mt = 0; mt < 4; ++mt)
#pragma unroll
                for (int ks = 0; ks < 2; ++ks) { f32x4 th[2];
#pragma unroll
                    for (int hh = 0; hh < 2; ++hh) { const int jb = 2 * ks + hh; th[hh] = (f32x4){0.f, 0.f, 0.f, 0.f};
                        if (jb <= mt) {
#pragma unroll
                            for (int k2 = 0; k2 < 2; ++k2) th[hh] = __builtin_amdgcn_mfma_f32_16x16x32_bf16(kf[jb][k2], qn_[mt][k2], th[hh], 0, 0, 0);
                            if (jb == mt) {
#pragma unroll
                                for (int rg = 0; rg < 4; ++rg) th[hh][rg] = (i16 >= 4 * g + rg) ? th[hh][rg] : 0.f; } } }
                    aa[mt][ks] = pack8(th[0], th[1]); } }
#pragma unroll
          for (int mt = 0; mt < 4; ++mt)
#pragma unroll
              for (int ks = 0; ks < 2; ++ks) { const int o_ = (16 * mt + i16) * RP + 32 * ks + 4 * g;
                  aq[mt][ks] = cat8(*(const s16x4*)(Qt + o_), *(const s16x4*)(Qt + o_ + 16)); ak[mt][ks] = cat8(*(const s16x4*)(KgT + o_), *(const s16x4*)(KgT + o_ + 16)); }
#pragma unroll
          for (int mt = 0; mt < 4; ++mt) { f32x4 o = (f32x4){0.f, 0.f, 0.f, 0.f};
#pragma unroll
              for (int ks = 0; ks < 2; ++ks) { o = __builtin_amdgcn_mfma_f32_16x16x32_bf16(aq[mt][ks], Sb[ks], o, 0, 0, 0); o = __builtin_amdgcn_mfma_f32_16x16x32_bf16(aa[mt][ks], Vb[ks], o, 0, 0, 0); }
#pragma unroll
              for (int rg = 0; rg < 4; ++rg) OB[(size_t)dn_row(n, 16 * mt + 4 * g + rg, b, dir) * 512 + h * 128 + 16 * w + i16] = (bf16_t)f2bf(o[rg]); }
#pragma unroll
          for (int dt = 0; dt < 4; ++dt) { const f32x4 gl = *(const f32x4*)(gls + 16 * dt + 4 * g); S[dt] = S[dt] * gl;
#pragma unroll
              for (int ks = 0; ks < 2; ++ks) S[dt] = __builtin_amdgcn_mfma_f32_16x16x32_bf16(ak[dt][ks], Vb[ks], S[dt], 0, 0, 0); } }
    }
}
__device__ __forceinline__ void attn_tile(const P& p, int l, int b, int h, int qrow0  , bool ctxq, unsigned char* lds, bool do_store = true, bool draw = false) {
    constexpr int QP = 72, KP = 72, VP = 160;
    bf16_t* Qs = (bf16_t*)lds;
    constexpr int KVB = 2 * 64 * KP + 64 * VP;
    bf16_t* KV0 = Qs + 2 * 128 * QP;
    float* Oex = (float*)lds;
    bf16_t* PC = (bf16_t*)(p.ws + WS_PC);
    const int tid = otid(), lane = tid & 63, w = tid >> 6, m = w & 1, rg = w >> 1, q31 = lane & 31, hi = lane >> 5, i16 = lane & 15, gg = lane >> 4;
    const int nkt = ctxq ? CTXL / 64 : (CTXL + SEQ) / 64;
    constexpr int KB_E = 2 * 64 * KP, VB_E = 64 * VP;
    bf16_t* Kb0 = Qs + 2 * 128 * QP; bf16_t* Vb0 = Kb0 + 3 * KB_E;
    u32x4 pk_[2], pv_[2];
    auto rowp_ = [&](int kt, int u) { const int krow0 = kt < CTXL / 64 ? TL + b * CTXL + kt * 64 : b * SEQ + (kt - CTXL / 64) * 64; const int i = tid + 512 * u, r = i >> 4, ch = i & 15; return PC + (size_t)(krow0 + r) * 1536 + h * 128 + ch * 8; };
    auto prefK = [&](int kt) {
#pragma unroll
        for (int u = 0; u < 2; ++u) pk_[u] = *(const u32x4*)(rowp_(kt, u) + 512); };
    auto prefV = [&](int kt) {
#pragma unroll
        for (int u = 0; u < 2; ++u) pv_[u] = *(const u32x4*)(rowp_(kt, u) + 1024); };
    auto stageK = [&](int slot) { bf16_t* Ks = Kb0 + slot * KB_E;
#pragma unroll
        for (int u = 0; u < 2; ++u) { const int i = tid + 512 * u, r = i >> 4, ch = i & 15, mm = ch >> 3, c8 = (ch & 7) * 8; *(u32x4*)(Ks + (mm * 64 + r) * KP + c8) = pk_[u]; } };
    auto stageV = [&](int slot) { bf16_t* Vs = Vb0 + slot * VB_E;
#pragma unroll
        for (int u = 0; u < 2; ++u) { const int i = tid + 512 * u, r = i >> 4, ch = i & 15; *(u32x4*)(Vs + r * VP + ch * 8) = pv_[u]; } };
    const float lamf = ((const float*)(p.ws + WS_MISC))[MI_LAMF + l];
    const float kmax = __builtin_bit_cast(float, __builtin_nontemporal_load((const unsigned*)(p.ws + WS_CTL) + CW_KMAX + l * 64 + (b * 4 + h) * 2 + m));
    prefK(0); prefV(0);
    __syncthreads();
    for (int i = tid; i < 128 * 16; i += NTHREADS) { const int r = i >> 4, ch = i & 15, mm = ch >> 3, c8 = (ch & 7) * 8;
        *(u32x4*)(Qs + (mm * 128 + r) * QP + c8) = *(const u32x4*)(PC + (size_t)(qrow0 + r) * 1536 + h * 128 + ch * 8); }
    stageK(0); stageV(0);
    prefK(1); prefV(1);
    __syncthreads();
    const bf16_t* qrow = Qs + (m * 128 + rg * 32 + q31) * QP;
    bf16x8 bq[4]; float qn = 0.f;
#pragma unroll
    for (int kk = 0; kk < 4; ++kk) bq[kk] = *(const bf16x8*)(qrow + 16 * kk + 8 * hi);
#pragma unroll
    for (int d8 = 0; d8 < 8; ++d8) { const u32x4 q4 = *(const u32x4*)(qrow + 8 * d8);
        qn += bflo(q4.x) * bflo(q4.x) + bfhi(q4.x) * bfhi(q4.x) + bflo(q4.y) * bflo(q4.y) + bfhi(q4.y) * bfhi(q4.y) + bflo(q4.z) * bflo(q4.z) + bfhi(q4.z) * bfhi(q4.z) + bflo(q4.w) * bflo(q4.w) + bfhi(q4.w) * bfhi(q4.w); }
    const float mrow = sqrtf(qn) * kmax * 1.002f + 1e-3f;
    bf16x8 bqm;
    { const unsigned short mh = (unsigned short)f2bf(-mrow); const unsigned short ml = (unsigned short)f2bf(-mrow - bf2f(mh));
      union { bf16x8 v; unsigned u[4]; } b_;
      b_.u[0] = hi == 0 ? ((unsigned)mh | ((unsigned)ml << 16)) : 0u; b_.u[1] = 0u; b_.u[2] = 0u; b_.u[3] = 0u; bqm = b_.v; }
    f32x16 o[4]; f32x16 osum;
#pragma unroll
    for (int r = 0; r < 16; ++r) osum[r] = 0.f;
    bf16x8 onesA; { unsigned one_ = 0x3F803F80u; asm volatile("" : "+v"(one_));
      union { bf16x8 v; unsigned u[4]; } o1_; o1_.u[0] = one_; o1_.u[1] = one_; o1_.u[2] = one_; o1_.u[3] = one_; onesA = o1_.v; }
#pragma unroll
    for (int dt = 0; dt < 4; ++dt)
#pragma unroll
        for (int r = 0; r < 16; ++r) o[dt][r] = 0.f;
#define ATT_QK(S_, slot_) do { const bf16_t* Ks_ = Kb0 + (slot_) * KB_E; bf16x8 ka_[2][4]; \
        _Pragma("unroll") for (int kh = 0; kh < 2; ++kh) _Pragma("unroll") for (int kk = 0; kk < 4; ++kk) ka_[kh][kk] = *(const bf16x8*)(Ks_ + (m * 64 + kh * 32 + q31) * KP + 16 * kk + 8 * hi); \
        _Pragma("unroll") for (int kh = 0; kh < 2; ++kh) { _Pragma("unroll") for (int r = 0; r < 16; ++r) S_[kh][r] = 0.f; \
            if (stab) S_[kh] = __builtin_amdgcn_mfma_f32_32x32x16_bf16(onesA, bqm, S_[kh], 0, 0, 0); \
            _Pragma("unroll") for (int kk = 0; kk < 4; ++kk) S_[kh] = __builtin_amdgcn_mfma_f32_32x32x16_bf16(ka_[kh][kk], bq[kk], S_[kh], 0, 0, 0); } } while (0)
    const bool stab = !__all(mrow < 96.0f);
    f32x16 sA[2], sB[2];
    ATT_QK(sA, 0);
    stageK(1); prefK(2);
    __syncthreads();
    int ks1 = 1, ks2 = 2;
#define ATT_TILE(kt_, SC, SN) do { const int kt = (kt_); \
        const bf16_t* Vs = Vb0 + (kt & 1) * VB_E; \
        ATT_QK(SN, ks1); \
        _Pragma("unroll") for (int kh = 0; kh < 2; ++kh) _Pragma("unroll") for (int r = 0; r < 16; ++r) { SC[kh][r] = __builtin_amdgcn_exp2f(SC[kh][r]); } \
        __builtin_amdgcn_sched_barrier(0); \
        stageK(ks2); stageV((kt + 1) & 1); \
        prefK(kt + 3 < nkt ? kt + 3 : nkt - 1); prefV(kt + 2 < nkt ? kt + 2 : nkt - 1); \
        _Pragma("unroll") for (int st = 0; st < 4; ++st) { const int kh = st >> 1, r0 = 8 * (st & 1); \
            const bf16_t* v0 = Vs + (16 * st + 4 * hi + (i16 >> 2)) * VP + 16 * (gg & 1) + 4 * (i16 & 3); \
            s16x4 vlo[4], vhi[4]; \
            _Pragma("unroll") for (int dt = 0; dt < 4; ++dt) { vlo[dt] = lds_tr(v0 + 32 * dt); vhi[dt] = lds_tr(v0 + 32 * dt + 8 * VP); } \
            union { bf16x8 v; unsigned u[4]; } bp; \
            bp.u[0] = pk2(SC[kh][r0 + 0], SC[kh][r0 + 1]); bp.u[1] = pk2(SC[kh][r0 + 2], SC[kh][r0 + 3]); bp.u[2] = pk2(SC[kh][r0 + 4], SC[kh][r0 + 5]); bp.u[3] = pk2(SC[kh][r0 + 6], SC[kh][r0 + 7]); \
            _Pragma("unroll") for (int dt = 0; dt < 4; ++dt) o[dt] = __builtin_amdgcn_mfma_f32_32x32x16_bf16(cat8(vlo[dt], vhi[dt]), bp.v, o[dt], 0, 0, 0); \
            osum = __builtin_amdgcn_mfma_f32_32x32x16_bf16(onesA, bp.v, osum, 0, 0, 0); } \
        ks1 = ks2; ks2 = ks2 == 2 ? 0 : ks2 + 1; \
        __syncthreads(); } while (0)
#pragma unroll 1
    for (int kt2 = 0; kt2 < nkt; kt2 += 2) {
        ATT_TILE(kt2, sA, sB);
        ATT_TILE(kt2 + 1, sB, sA);
    }
#undef ATT_TILE
#undef ATT_QK
    asm volatile("" ::: "memory");
    const float lsum = osum[0];
    const int tid_e = otid(), w_e = tid_e >> 6, m_e = w_e & 1, rg_e = w_e >> 1, q31_e = tid_e & 31, hi_e = (tid_e & 63) >> 5;
    const float sc = (m_e == 0 ? 1.0f : lamf) / lsum;
    __syncthreads();
    int nxt_ticket = 0;
    if (draw && otid() == 0) nxt_ticket = (int)atomicAdd((unsigned*)(p.ws + WS_CTL) + CW_QUEUE + 64 * l, 1u);
    float* ox = Oex + (rg_e * 32 + q31_e) * 132;
    if (m_e == 1) {
#pragma unroll
        for (int dt = 0; dt < 4; ++dt)
#pragma unroll
            for (int r = 0; r < 16; ++r) ox[dt * 32 + (r & 3) + 8 * (r >> 2) + 4 * hi_e] = o[dt][r] * sc;
    }
    __syncthreads();
    if (m_e == 0) {
        float ss = 0.f;
#pragma unroll
        for (int dt = 0; dt < 4; ++dt)
#pragma unroll
            for (int r = 0; r < 16; ++r) { const float v = o[dt][r] * sc - ox[dt * 32 + (r & 3) + 8 * (r >> 2) + 4 * hi_e]; o[dt][r] = v; ss += v * v; }
        ss += shx(ss, 32);
        int lo_ = l; asm volatile("" : "+s"(lo_));
        const float lam_init = lo_ == 0 ? 0.2f : 0.35550906758f;
        const float rs = (1.0f - lam_init) / sqrtf(ss * (1.0f / 128.0f) + EPS);
        const float* gn = p.gn_c + l * 128;
        bf16_t* orow = (bf16_t*)(p.ws + WS_YD) + (size_t)(qrow0 + rg_e * 32 + q31_e) * 512 + h * 128;
#pragma unroll
        for (int dt = 0; dt < 4; ++dt)
#pragma unroll
            for (int g4 = 0; g4 < 4; ++g4) { const int dv = dt * 32 + 8 * g4 + 4 * hi_e; const f32x4 gv = *(const f32x4*)(gn + dv);
                u32x2 wv; wv.x = pk2(o[dt][4 * g4 + 0] * rs * gv[0], o[dt][4 * g4 + 1] * rs * gv[1]); wv.y = pk2(o[dt][4 * g4 + 2] * rs * gv[2], o[dt][4 * g4 + 3] * rs * gv[3]);
                if (do_store) *(u32x2*)(orow + dv) = wv; }
    }
    if (draw && otid() == 0) *(volatile int*)(lds + LDS_BYTES - 64) = nxt_ticket;
}
__device__ __forceinline__ void phase_mix(const P& p, int l, unsigned char* lds) {
    unsigned* qhead = (unsigned*)(p.ws + WS_CTL) + CW_QUEUE + 64 * l;
    volatile int* slot = (volatile int*)(lds + LDS_BYTES - 64);
    const int n_att_l = BATCH * 4 * (SEQ / 128), n_att_c = (l == 0) ? BATCH * 4 * (CTXL / 128) : 0;
    const int n_cv = (l == DEPTH - 1) ? NE * MOE_CV_SPLIT : 0;
    const int total = 128 + n_att_l + n_att_c + n_cv;
    __syncthreads();
    if (otid() == 0) *slot = (int)atomicAdd(qhead, 1u);
    for (;;) {
        __syncthreads();
        const int it = *slot;
        if (it >= total) break;
        const bool self_draw = it >= 128 && it < 128 + n_att_l + n_att_c;
        if (it < 64) { for (int rep = 0; rep < REP_DN; ++rep) dn_chain_mfma(p, it, lds); }
        else if (it < 128) { for (int rep = 0; rep < REP_GLA; ++rep) gla_chain_mfma(p, l, it - 64, lds); }
        else if (it < 128 + n_att_l) { const int a = it - 128, b = a / (4 * (SEQ / 128)), rem = a % (4 * (SEQ / 128)), h = rem / (SEQ / 128), qt = rem % (SEQ / 128);
            for (int rep = 1; rep < REP_ATT; ++rep) attn_tile(p, l, b, h, b * SEQ + qt * 128, false, lds, false);
            attn_tile(p, l, b, h, b * SEQ + qt * 128, false, lds, true, true); }
        else if (it < 128 + n_att_l + n_att_c) { const int a = it - 128 - n_att_l, b = a / (4 * (CTXL / 128)), rem = a % (4 * (CTXL / 128)), h = rem / (CTXL / 128), qt = rem % (CTXL / 128);
            attn_tile(p, l, b, h, TL + b * CTXL + qt * 128, true, lds, true, true); }
        else { const int a = it - 128 - n_att_l - n_att_c, e = a / MOE_CV_SPLIT, sub = a % MOE_CV_SPLIT; const int tid_ = otid(), wave_ = tid_ >> 6;
            convert_T(DFF, D, (bf16_t*)(p.ws + WS_MWDN) + (size_t)e * D * DFF, D, SmPlain{p.moe_w2 + (size_t)e * DFF * D}, (float*)(lds + wave_ * CONV_WLDS), sub * NWAVES + wave_, MOE_CV_SPLIT * NWAVES, tid_ & 63); }
        if (!self_draw) { __syncthreads(); if (otid() == 0) *slot = (int)atomicAdd(qhead, 1u); }
    }
}

__device__ __forceinline__ void phase_post(const P& p, int l, int nrows, int gw, int NGW, int lane) {
    bf16_t* OA = (bf16_t*)(p.ws + WS_H); bf16_t* OBb = (bf16_t*)(p.ws + WS_PAQ);
    const bf16_t* PZ = (const bf16_t*)(p.ws + WS_PZ); const bf16_t* PB = (const bf16_t*)(p.ws + WS_PB);
    const int c8 = 8 * lane, cg = c8 & 127;
    const f32x4 ga0 = *(const f32x4*)(p.gn_a + l * 128 + cg), ga1 = *(const f32x4*)(p.gn_a + l * 128 + cg + 4), gb0 = *(const f32x4*)(p.gn_b + l * 128 + cg), gb1 = *(const f32x4*)(p.gn_b + l * 128 + cg + 4);
    for (int r0_ = gw; r0_ < nrows; r0_ += 2 * NGW)
#pragma unroll
    for (int rr_ = 0; rr_ < 2; ++rr_) { const int r = r0_ + rr_ * NGW; if (r >= nrows) break;
        const u32x4 af = *(const u32x4*)(OA + (size_t)r * 512 + c8), ab = *(const u32x4*)(OA + ((size_t)T + r) * 512 + c8), az = *(const u32x4*)(PZ + (size_t)r * 512 + c8);
        const u32x4 bf_ = *(const u32x4*)(OBb + (size_t)r * 512 + c8), bb = *(const u32x4*)(OBb + ((size_t)T + r) * 512 + c8), bz = *(const u32x4*)(PB + (size_t)r * 1536 + 1024 + c8);
        const unsigned afw[4] = {af.x, af.y, af.z, af.w}, abw[4] = {ab.x, ab.y, ab.z, ab.w}, azw[4] = {az.x, az.y, az.z, az.w}, bfw[4] = {bf_.x, bf_.y, bf_.z, bf_.w}, bbw[4] = {bb.x, bb.y, bb.z, bb.w}, bzw[4] = {bz.x, bz.y, bz.z, bz.w};
        float oa[8], ob[8], sa = 0.f, sb = 0.f;
#pragma unroll
        for (int q = 0; q < 4; ++q) { oa[2 * q] = bflo(afw[q]) + bflo(abw[q]); oa[2 * q + 1] = bfhi(afw[q]) + bfhi(abw[q]); ob[2 * q] = bflo(bfw[q]) + bflo(bbw[q]); ob[2 * q + 1] = bfhi(bfw[q]) + bfhi(bbw[q]);
            sa += oa[2 * q] * oa[2 * q] + oa[2 * q + 1] * oa[2 * q + 1]; sb += ob[2 * q] * ob[2 * q] + ob[2 * q + 1] * ob[2 * q + 1]; }
#pragma unroll
        for (int o = 1; o < 16; o <<= 1) { sa += shx(sa, o); sb += shx(sb, o); }
        const float ra = 1.0f / sqrtf(sa * (1.0f / 128.0f) + EPS), rb = 1.0f / sqrtf(sb * (1.0f / 128.0f) + EPS);
        unsigned wa[4], wb[4];
#pragma unroll
        for (int q = 0; q < 4; ++q) { const float g0 = q < 2 ? ga0[2 * q] : ga1[2 * q - 4], g1 = q < 2 ? ga0[2 * q + 1] : ga1[2 * q - 3], h0 = q < 2 ? gb0[2 * q] : gb1[2 * q - 4], h1 = q < 2 ? gb0[2 * q + 1] : gb1[2 * q - 3];
            wa[q] = pk2(oa[2 * q] * ra * g0 * siluf_(bflo(azw[q])), oa[2 * q + 1] * ra * g1 * siluf_(bfhi(azw[q])));
            wb[q] = pk2(ob[2 * q] * rb * h0 * siluf_(bflo(bzw[q])), ob[2 * q + 1] * rb * h1 * siluf_(bfhi(bzw[q]))); }
        *(u32x4*)(OA + (size_t)r * 512 + c8) = (u32x4){wa[0], wa[1], wa[2], wa[3]};
        *(u32x4*)(OBb + (size_t)r * 512 + c8) = (u32x4){wb[0], wb[1], wb[2], wb[3]};
    }
}

__device__ __forceinline__ void phase_moe_gather(const P& p, unsigned char* lds) {
    const int tid = otid();
    const int* route = (const int*)(p.ws + WS_ROUTE); int* slots = (int*)(p.ws + WS_SLOT); int* misc = (int*)(p.ws + WS_MISC);
    const unsigned* ecnt = (const unsigned*)(p.ws + WS_CTL) + CW_ECNT; unsigned* efill = (unsigned*)(p.ws + WS_CTL) + CW_EFILL;
    const bf16_t* H = (const bf16_t*)(p.ws + WS_H); bf16_t* MA = (bf16_t*)(p.ws + WS_MA);
    int* eoff = (int*)lds; unsigned* lcnt = (unsigned*)(eoff + 16); unsigned* lbase = lcnt + 8; int* myslot = (int*)(lbase + 8);
    if (tid == 0) { int off = 0, nt = 0;
#pragma unroll 1
        for (int e = 0; e < NE; ++e) { eoff[e] = off; const int tl = ((int)ecnt[e] + 255) / 256;
            if (blockIdx.x == 0) { for (int q = 0; q < tl; ++q) misc[MI_TILEE + nt + q] = e; }
            nt += tl; off += tl * 256; }
        eoff[NE] = off; if (blockIdx.x == 0) misc[MI_NTILES] = nt; }
    for (int grp = blockIdx.x; grp < TL / 64; grp += gridDim.x) {
        __syncthreads();
        if (tid < NE) lcnt[tid] = 0u;
        __syncthreads();
        int e = 0, rank = 0;
        if (tid < 128) { e = route[(grp * 64 + (tid >> 1)) * 4 + (tid & 1)]; rank = (int)atomicAdd(lcnt + e, 1u); }
        __syncthreads();
        if (tid < NE) lbase[tid] = lcnt[tid] ? atomicAdd(efill + tid, lcnt[tid]) : 0u;
        __syncthreads();
        if (tid < 128) { const int s = eoff[e] + (int)lbase[e] + rank; myslot[tid] = s; slots[(grp * 64 + (tid >> 1)) * 2 + (tid & 1)] = s; }
        __syncthreads();
        for (int i0 = tid; i0 < 128 * 128; i0 += 8 * NTHREADS) { u32x4 v[8];
#pragma unroll
            for (int u = 0; u < 8; ++u) { const int i = i0 + u * NTHREADS, a = i >> 7, ch = i & 127; v[u] = ((const u32x4*)(H + (size_t)(grp * 64 + (a >> 1)) * D))[ch]; }
#pragma unroll
            for (int u = 0; u < 8; ++u) { const int i = i0 + u * NTHREADS, a = i >> 7, ch = i & 127; ((u32x4*)(MA + (size_t)myslot[a] * D))[ch] = v[u]; } }
    }
}
__device__ __forceinline__ void phase_final(const P& p, int gw, int NGW, int lane) {
    const int* route = (const int*)(p.ws + WS_ROUTE); const int* slots = (const int*)(p.ws + WS_SLOT); const bf16_t* Y = (const bf16_t*)(p.ws + WS_MA);
    const float* MOD = (const float*)(p.ws + WS_MOD) + (size_t)1 * 9 * 6144;
    for (int r0_ = gw; r0_ < TL; r0_ += 2 * NGW)
#pragma unroll
    for (int rr_ = 0; rr_ < 2; ++rr_) { const int r = r0_ + rr_ * NGW; if (r >= TL) break; const int b = r / SEQ; const float w1 = ((const float*)route)[r * 4 + 2], w2 = ((const float*)route)[r * 4 + 3];
        const bf16_t* y1 = Y + (size_t)slots[r * 2] * D, *y2 = Y + (size_t)slots[r * 2 + 1] * D; float* xr = p.out + (size_t)r * D; const float* g2 = MOD + (size_t)b * 6144 + 5 * 1024;
        f32x4 v[4]; float ss = 0.f;
#pragma unroll
        for (int j = 0; j < 4; ++j) { const int c = 4 * lane + 256 * j; const u32x2 a = *(const u32x2*)(y1 + c), bq = *(const u32x2*)(y2 + c); const f32x4 g = *(const f32x4*)(g2 + c);
            f32x4 y; y[0] = w1 * bflo(a.x) + w2 * bflo(bq.x); y[1] = w1 * bfhi(a.x) + w2 * bfhi(bq.x); y[2] = w1 * bflo(a.y) + w2 * bflo(bq.y); y[3] = w1 * bfhi(a.y) + w2 * bfhi(bq.y);
            v[j] = *(const f32x4*)(xr + c) + g * y; ss += (v[j][0] * v[j][0] + v[j][1] * v[j][1]) + (v[j][2] * v[j][2] + v[j][3] * v[j][3]); }
        const float rs = 1.0f / sqrtf(wave_sum(ss) * (1.0f / D) + EPS);
#pragma unroll
        for (int j = 0; j < 4; ++j) { const int c = 4 * lane + 256 * j; *(f32x4*)(xr + c) = v[j] * rs * *(const f32x4*)(p.final_g + c); }
    }
}

typedef __attribute__((address_space(4))) const P* KArgs;
#define LOADP(p) asm volatile("" : "+s"(kp)); P p; __builtin_memcpy(&p, kp, sizeof(P))
__global__ void __launch_bounds__(NTHREADS, 2) mk_fwd(P p_unused) {
    extern __shared__ __attribute__((aligned(16))) unsigned char lds[];
    cg::grid_group grid = cg::this_grid();
    KArgs kp = (KArgs)__builtin_amdgcn_kernarg_segment_ptr();
    const int G = gridDim.x, NGW = G * NWAVES;
#define IDS() const int tid = otid(), lane = tid & 63, wave = __builtin_amdgcn_readfirstlane(tid >> 6), gw = blockIdx.x * NWAVES + wave; (void)tid; (void)lane; (void)gw; (void)wave
    PG8_LAS unsigned char* glds = (PG8_LAS unsigned char*)lds;
    volatile unsigned* bst = (volatile unsigned*)(lds + LDS_BYTES - 128);
    if (otid() == 0) { bst[0] = 0u; bst[1] = 0u; }
    __syncthreads();
    { LOADP(p); (void)xcd_barrier_post((unsigned*)(p.ws + WS_CTL) + CW_BAR, bst); }
#define GSYNC() do { LOADP(pb_); XcdBarrier bb_; bb_.bar = (unsigned*)(pb_.ws + WS_CTL) + CW_BAR; bb_.x = xb_xcc_id(); bb_.st = (volatile unsigned*)(lds + LDS_BYTES - 128); xcd_barrier(bb_); } while (0)

    { PH_BEGIN(31);
    {
        LOADP(p); IDS(); unsigned char* ws = p.ws;
        float* scr = (float*)(lds + wave * CONV_WLDS);
        for (int rep = 0; rep < REP_P0; ++rep)
        for (int l = 0; l < 1; ++l) {
            convert_T(D, 8240, (bf16_t*)(ws + WB_WIN + l * WIN_BYTES), NIN, SmWin{p.w_in + (size_t)l * D * 8240}, scr, (gw + 37 * l) % NGW, NGW, lane);
            convert_T(512, D, (bf16_t*)(ws + WB_WO + (l * 3 + 0) * WO_BYTES), D, SmPlain{p.w_o_a + (size_t)l * 512 * D}, scr, (gw + 300 + 700 * l) % NGW, NGW, lane);
            convert_T(512, D, (bf16_t*)(ws + WB_WO + (l * 3 + 1) * WO_BYTES), D, SmPlain{p.w_o_b + (size_t)l * 512 * D}, scr, (gw + 556 + 700 * l) % NGW, NGW, lane);
            convert_T(512, D, (bf16_t*)(ws + WB_WO + (l * 3 + 2) * WO_BYTES), D, SmPlain{p.w_o_c + (size_t)l * 512 * D}, scr, (gw + 812 + 700 * l) % NGW, NGW, lane);
            convert_T(D, D, (bf16_t*)(ws + WB_WOUT + l * WOUT_BYTES), D, SmPlain{p.w_out + (size_t)l * D * D}, scr, (gw + 1068 + 512 * l) % NGW, NGW, lane);
        }
        __syncthreads();
        phase_mod(p, lds);
    }
    PH_END(31); }
    grid.sync();

    for (int l = 0; l < DEPTH; ++l) {
        const bool last = (l == DEPTH - 1);
        const int Mrows = last ? TL : T;
{ PH_BEGIN((l * 16 + 0));
        for (int rep = 0; rep < REP_ELT; ++rep)
        { LOADP(p); IDS(); unsigned char* ws = p.ws;
          phase_modulate(l == 0 ? p.x : p.out, l == 0 ? p.ctx : (const float*)(ws + WS_XC), T, p.norm1_g + l * D, (const float*)(ws + WS_MOD) + (size_t)l * 9 * 6144, 0, (bf16_t*)(ws + WS_H), nullptr, nullptr, nullptr, nullptr, gw, NGW, lane); }
        PH_END((l * 16 + 0)); }
        GSYNC();
{ PH_BEGIN((l * 16 + 1));
        for (int rep = 0; rep < REP_WIN; ++rep)
        { LOADP(p); unsigned char* ws = p.ws;
            pg8::Gemm g{(const bf16_t*)(ws + WS_H), (const bf16_t*)(ws + WB_WIN + l * WIN_BYTES), T, NIN, D, D};
            EpiWin E{(bf16_t*)(ws + WS_PAQ), (bf16_t*)(ws + WS_PZ), (bf16_t*)(ws + WS_PB), (bf16_t*)(ws + WS_PC), (bf16_t*)(ws + WS_PG), (float*)(ws + WS_SMALL)};
            WinLastOrder S; S.so.init(last ? TL : T, NIN, G, (int)blockIdx.x); S.G = G; S.c = (int)blockIdx.x; S.nextra = last ? (TC / 256) * 12 : 0;
            pg8::gemm_phase<EpiWin, WinLastOrder, true, true>(glds, g, S, E);
        }
        if (l == 0 && (int)blockIdx.x >= WIN0_BUSY) {
            LOADP(p); IDS(); unsigned char* ws = p.ws; float* scr = (float*)(lds + wave * CONV_WLDS);
            const int hgw = ((int)blockIdx.x - WIN0_BUSY) * NWAVES + wave, HNGW = (G - WIN0_BUSY) * NWAVES;
            convert_T(D, 8240, (bf16_t*)(ws + WB_WIN + WIN_BYTES), NIN, SmWin{p.w_in + (size_t)D * 8240}, scr, hgw, HNGW, lane);
        }
        PH_END((l * 16 + 1)); }
        GSYNC();
{ PH_BEGIN((l * 16 + 2));
        for (int rep = 1; rep < REP_SYNC; ++rep) GSYNC();
        { LOADP(p); IDS(); phase_prep(p, l, lds, gw, NGW, lane); }
        PH_END((l * 16 + 2)); }
        GSYNC();
{ PH_BEGIN((l * 16 + 3));
        { LOADP(p); phase_mix(p, l, lds); }
        PH_END((l * 16 + 3)); }
        GSYNC();
{ PH_BEGIN((l * 16 + 4));
        { LOADP(p); IDS(); phase_post(p, l, Mrows, gw, NGW, lane); }
        PH_END((l * 16 + 4)); }
        GSYNC();
{ PH_BEGIN((l * 16 + 5));
        for (int rep = 0; rep < REP_MERGE; ++rep)
        { LOADP(p); unsigned char* ws = p.ws;
            pg8::Gemm g{(const bf16_t*)(ws + WS_H), (const bf16_t*)(ws + WB_WO + (l * 3 + 0) * WO_BYTES), Mrows, D, 512, 512,
                        (const bf16_t*)(ws + WS_PAQ), (const bf16_t*)(ws + WS_YD), (const bf16_t*)(ws + WB_WO + (l * 3 + 1) * WO_BYTES), (const bf16_t*)(ws + WB_WO + (l * 3 + 2) * WO_BYTES)};
            MergeOrder S; S.so.init(Mrows, D, G, (int)blockIdx.x);
            EpiGate E{(bf16_t*)(ws + WS_DNQKV), (const bf16_t*)(ws + WS_PG)};
            pg8::gemm_phase<EpiGate, MergeOrder, true, true>(glds, g, S, E);
        }
        if (l == 0 && (int)blockIdx.x >= MRG0_BUSY) {
            LOADP(p); IDS(); unsigned char* ws = p.ws; float* scr = (float*)(lds + wave * CONV_WLDS);
            const int hgw = ((int)blockIdx.x - MRG0_BUSY) * NWAVES + wave, HNGW = (G - MRG0_BUSY) * NWAVES;
            convert_T(D, DFF, (bf16_t*)(ws + WB_WUP), NUP, SmUp{p.ffn_w1, (long)(p.ffn_w3 - p.ffn_w1)}, scr, hgw, HNGW, lane);
            convert_T(DFF, D, (bf16_t*)(ws + WB_WDN), D, SmPlain{p.ffn_w2}, scr, (hgw + 900) % HNGW, HNGW, lane);
            convert_T(512, D, (bf16_t*)(ws + WB_WO + 3 * WO_BYTES), D, SmPlain{p.w_o_a + (size_t)512 * D}, scr, (hgw + 300) % HNGW, HNGW, lane);
            convert_T(512, D, (bf16_t*)(ws + WB_WO + 4 * WO_BYTES), D, SmPlain{p.w_o_b + (size_t)512 * D}, scr, (hgw + 556) % HNGW, HNGW, lane);
            convert_T(512, D, (bf16_t*)(ws + WB_WO + 5 * WO_BYTES), D, SmPlain{p.w_o_c + (size_t)512 * D}, scr, (hgw + 812) % HNGW, HNGW, lane);
            convert_T(D, D, (bf16_t*)(ws + WB_WOUT + WOUT_BYTES), D, SmPlain{p.w_out + (size_t)D * D}, scr, (hgw + 1068) % HNGW, HNGW, lane);
        }
        PH_END((l * 16 + 5)); }
        GSYNC();
{ PH_BEGIN((l * 16 + 6));
        for (int rep = 0; rep < (l == 0 ? REP_WOUT0 : 1); ++rep)
        { LOADP(p); unsigned char* ws = p.ws;
            pg8::Gemm g{(const bf16_t*)(ws + WS_DNQKV), (const bf16_t*)(ws + WB_WOUT + l * WOUT_BYTES), Mrows, D, D, D}; pg8::StaticOrder S; S.init(Mrows, D, G, (int)blockIdx.x);
            EpiResid E{l == 0 ? p.x : p.out, l == 0 ? p.ctx : (const float*)(ws + WS_XC), p.out, (float*)(ws + WS_XC), (const float*)(ws + WS_MOD) + (size_t)l * 9 * 6144, 2};
            pg8::gemm_phase<EpiResid, pg8::StaticOrder, true, true>(glds, g, S, E);
        }
        PH_END((l * 16 + 6)); }
        GSYNC();
{ PH_BEGIN((l * 16 + 7));
        { LOADP(p); IDS(); unsigned char* ws = p.ws;
          phase_modulate(p.out, (const float*)(ws + WS_XC), Mrows, p.norm2_g + l * D, (const float*)(ws + WS_MOD) + (size_t)l * 9 * 6144, 3, (bf16_t*)(ws + WS_H), last ? p.router_w : nullptr, (int*)(ws + WS_ROUTE), (unsigned*)(ws + WS_CTL) + CW_ECNT, (unsigned*)lds, gw, NGW, lane); }
        PH_END((l * 16 + 7)); }
        if (!last) {
            GSYNC();
{ PH_BEGIN(8);
            for (int rep = 0; rep < REP_UP; ++rep)
            { LOADP(p); unsigned char* ws = p.ws;
                pg8::Gemm g{(const bf16_t*)(ws + WS_H), (const bf16_t*)(ws + WB_WUP), T, NUP, D, D}; pg8::StaticOrder S; S.init(T, NUP, G, (int)blockIdx.x);
                EpiSwiglu E{(bf16_t*)(ws + WS_H1), NUP / 256};
                pg8::gemm_phase<EpiSwiglu, pg8::StaticOrder, true, true>(glds, g, S, E);
            }
        PH_END(8); }
            GSYNC();
{ PH_BEGIN(9);
            { LOADP(p); unsigned char* ws = p.ws;
                pg8::Gemm g{(const bf16_t*)(ws + WS_H1), (const bf16_t*)(ws + WB_WDN), T, D, DFF, DFF}; pg8::StaticOrder S; S.init(T, D, G, (int)blockIdx.x);
                EpiResid E{p.out, (const float*)(ws + WS_XC), p.out, (float*)(ws + WS_XC), (const float*)(ws + WS_MOD) + (size_t)l * 9 * 6144, 5};
                pg8::gemm_phase<EpiResid, pg8::StaticOrder, true, true>(glds, g, S, E);
            }
        PH_END(9); }
            GSYNC();
        } else {
{ PH_BEGIN(24);
            { LOADP(p); IDS(); unsigned char* ws = p.ws;
                float* scr = (float*)(lds + wave * CONV_WLDS);
                for (int e = 0; e < NE; ++e) {
                    convert_T(D, DFF, (bf16_t*)(ws + WS_MWUP) + (size_t)e * NUP * D, NUP, SmUp{p.moe_w1 + (size_t)e * D * DFF, (long)(p.moe_w3 - p.moe_w1)}, scr, (gw + 211 * e) % NGW, NGW, lane);
                }
            }
        PH_END(24); }
            GSYNC();
{ PH_BEGIN(25);
            { LOADP(p); phase_moe_gather(p, lds); }
        PH_END(25); }
            GSYNC();
{ PH_BEGIN(26);
            for (int rep = 0; rep < REP_UP; ++rep)
            { LOADP(p); unsigned char* ws = p.ws; const int* misc = (const int*)(ws + WS_MISC);
                pg8::Gemm g{(const bf16_t*)(ws + WS_MA), (const bf16_t*)(ws + WS_MWUP), MOE_ROWS, NE * NUP, D, D};
                MoeOrder S{misc[MI_NTILES], NUP / 256, G, (int)blockIdx.x, misc + MI_TILEE};
                EpiSwiglu E{(bf16_t*)(ws + WS_MH1), NUP / 256};
                pg8::gemm_phase<EpiSwiglu, MoeOrder, true, true>(glds, g, S, E);
            }
        PH_END(26); }
            GSYNC();
{ PH_BEGIN(27);
            { LOADP(p); unsigned char* ws = p.ws; const int* misc = (const int*)(ws + WS_MISC);
                pg8::Gemm g{(const bf16_t*)(ws + WS_MH1), (const bf16_t*)(ws + WS_MWDN), MOE_ROWS, NE * D, DFF, DFF};
                MoeOrder S{misc[MI_NTILES], D / 256, G, (int)blockIdx.x, misc + MI_TILEE};
                EpiMoeDown E{(bf16_t*)(ws + WS_MA)};
                pg8::gemm_phase<EpiMoeDown, MoeOrder, true, true>(glds, g, S, E);
            }
        PH_END(27); }
            GSYNC();
{ PH_BEGIN(28);
            { LOADP(p); IDS(); phase_final(p, gw, NGW, lane); }
        PH_END(28); }
        }
    }
}

extern "C" void kernel_launch(void* const* d_in, const int* in_sizes, int n_in, void* d_out, int out_size, void* d_ws, size_t ws_size, hipStream_t stream) {
    static int grid_blocks = 0;
    if (grid_blocks == 0) {
        if (n_in != 30 || in_sizes[0] != TL * D || out_size != TL * D || ws_size < WS_END) {
            fprintf(stderr, "kernel_launch: built for 30 inputs, x/out of %d floats, >= %zu bytes of d_ws; got n_in %d, in0 %d, out %d, ws %zu; nothing launched\n", TL * D, (size_t)WS_END, n_in, n_in > 0 ? in_sizes[0] : -1, out_size, ws_size);
            grid_blocks = -1; return; }
        int dev = 0, cus = 0, per_cu = 0;
        hipGetDevice(&dev);
        hipDeviceGetAttribute(&cus, hipDeviceAttributeMultiprocessorCount, dev);
        hipFuncSetAttribute((const void*)mk_fwd, hipFuncAttributeMaxDynamicSharedMemorySize, LDS_BYTES);
        hipOccupancyMaxActiveBlocksPerMultiprocessor(&per_cu, (const void*)mk_fwd, NTHREADS, LDS_BYTES);
        if (per_cu < 1) { fprintf(stderr, "kernel_launch: occupancy query reports %d blocks/CU; nothing launched\n", per_cu); grid_blocks = -1; return; }
        grid_blocks = cus;
    }
    if (grid_blocks < 0) return;
    hipMemsetAsync((char*)d_ws + WS_CTL, 0, CTL_BYTES, stream);
    P p{};
    const float** f = (const float**)&p;
    for (int i = 0; i < 30; ++i) f[i] = (const float*)d_in[i];
    p.out = (float*)d_out; p.ws = (unsigned char*)d_ws;
    void* args[] = {&p};
    hipError_t e = hipLaunchCooperativeKernel((const void*)mk_fwd, dim3(grid_blocks), dim3(NTHREADS), args, LDS_BYTES, stream);
    if (e != hipSuccess) fprintf(stderr, "kernel_launch: cooperative launch failed: %s (grid %d)\n", hipGetErrorString(e), grid_blocks);
}
```
